# Optimizing an MI355X kernel written in HIP

```python
import jax, jax.numpy as jnp
from jax import lax
import numpy as np

D_MODEL = 1024
BATCH = 16
SEQ = 256
DEPTH = 2
DEC_BATCH = 2
DEC_SEQ = 2048
PAST_LEN = 256

GRID_W = 64
EPS = 1e-6
N_AB = (DEPTH + 1) // 2
N_C = DEPTH // 2
MLA_HEADS = 8
Q_RANK = 256
KV_RANK = 256
NOPE_DIM = 64
ROPE_DIM = 32
V_DIM = 64
ROPE_THETA = 10000.0
Q_BLOCK = 128
SSD_HEADS = 8
SSD_GROUPS = 2
SSD_HPG = SSD_HEADS // SSD_GROUPS
SSD_HEAD_DIM = 64
SSD_STATE = 128
D_SSD = SSD_HEADS * SSD_HEAD_DIM
CONV_W = 5
CONV_CH = D_SSD + 2 * SSD_GROUPS * SSD_STATE
CHUNK = 128
IN_SPLITS = (Q_RANK, KV_RANK, ROPE_DIM, D_SSD, CONV_CH, SSD_HEADS, SSD_HEADS)
IN_AB = sum(IN_SPLITS)
OUT_AB = MLA_HEADS * V_DIM + D_SSD
POOL_WINDOWS = (2, 4, 8, 16)
POOL_GC = D_MODEL // len(POOL_WINDOWS)
D_FF = ((8 * D_MODEL + 3 * 256 - 1) // (3 * 256)) * 256

kernel_name = "hybrid_mla_ssd_pool_diffusion_step"


def rmsnorm(x, g):
    xf = x.astype(jnp.float32)
    y = xf * lax.rsqrt(jnp.mean(xf * xf, axis=-1, keepdims=True) + EPS)
    return (y * g.astype(jnp.float32)).astype(x.dtype)


def split_last(x, sizes):
    idx = np.cumsum(np.array(sizes))[:-1].tolist()
    return jnp.split(x, idx, axis=-1)


def modulation(cvec, w_mod, b_mod):
    m = jnp.expand_dims(jax.nn.silu(cvec) @ w_mod + b_mod, -2)
    return split_last(m, (D_MODEL,) * 6)


def modulate(x, g, shift, scale):
    return rmsnorm(x, g) * (1 + scale) + shift


def axial_rope_tables(n_tokens):
    rows = n_tokens // GRID_W
    row = jnp.repeat(jnp.arange(rows, dtype=jnp.float32), GRID_W)
    col = jnp.tile(jnp.arange(GRID_W, dtype=jnp.float32), rows)
    half = ROPE_DIM // 2
    inv_freq = jnp.power(ROPE_THETA, -jnp.arange(0, half, 2, dtype=jnp.float32) / half)
    ang = jnp.concatenate([row[:, None] * inv_freq, col[:, None] * inv_freq], axis=-1)
    return jnp.cos(ang), jnp.sin(ang)


def apply_rope(x, cos, sin):
    xf = x.astype(jnp.float32)
    x1, x2 = xf[..., : ROPE_DIM // 2], xf[..., ROPE_DIM // 2:]
    return jnp.concatenate([x1 * cos - x2 * sin, x1 * sin + x2 * cos], axis=-1).astype(x.dtype)


def ab_project(h, w_in, q_norm, w_uq, kv_norm):
    b, L, _ = h.shape
    cq, ckv, k_pe, z, xbc, dt_f, dt_b = split_last(h @ w_in, IN_SPLITS)
    q = (rmsnorm(cq, q_norm) @ w_uq).reshape(b, L, MLA_HEADS, NOPE_DIM + ROPE_DIM)
    return q[..., :NOPE_DIM], q[..., NOPE_DIM:], rmsnorm(ckv, kv_norm), k_pe, z, xbc, dt_f, dt_b


def mla_expand_kv(ckv_n, w_ukv):
    b, L, _ = ckv_n.shape
    kv = (ckv_n @ w_ukv).reshape(b, L, MLA_HEADS, NOPE_DIM + V_DIM)
    return kv[..., :NOPE_DIM], kv[..., NOPE_DIM:]


def mla_attend(q_nope, q_pe, k_nope, k_pe, v):
    b, lq, h, _ = q_nope.shape
    nb = lq // Q_BLOCK
    scale = (NOPE_DIM + ROPE_DIM) ** -0.5

    def block(qs):
        qn, qp = qs
        s = jnp.einsum('bqhd,bkhd->bhqk', qn, k_nope) + jnp.einsum('bqhr,bkr->bhqk', qp, k_pe)
        p = jax.nn.softmax(s.astype(jnp.float32) * scale, axis=-1)
        return jnp.einsum('bhqk,bkhd->bqhd', p.astype(v.dtype), v)

    qn_b = q_nope.reshape(b, nb, Q_BLOCK, h, NOPE_DIM).transpose(1, 0, 2, 3, 4)
    qp_b = q_pe.reshape(b, nb, Q_BLOCK, h, ROPE_DIM).transpose(1, 0, 2, 3, 4)
    out = lax.map(block, (qn_b, qp_b))
    return out.transpose(1, 0, 2, 3, 4).reshape(b, lq, h * V_DIM)


def dwconv_centred(x, w, bias):
    y = lax.conv_general_dilated(x, w[:, None, :], window_strides=(1,),
                                 padding=[(CONV_W // 2, CONV_W // 2)],
                                 dimension_numbers=('NWC', 'WIO', 'NWC'),
                                 feature_group_count=x.shape[-1])
    return y + bias


def ssd_chunked(x, dt, A, Bm, Cm, h0):
    b, L, g, hg, p = x.shape
    n = Bm.shape[-1]
    nc = L // CHUNK
    f32 = jnp.float32
    dtf = dt.astype(f32)
    xdt = (x.astype(f32) * dtf[..., None]).reshape(b, nc, CHUNK, g, hg, p)
    a = (dtf * A.astype(f32)).reshape(b, nc, CHUNK, g, hg)
    Bc = Bm.astype(f32).reshape(b, nc, CHUNK, g, n)
    Cc = Cm.astype(f32).reshape(b, nc, CHUNK, g, n)
    acum = jnp.cumsum(a, axis=2)
    seg = acum[:, :, :, None] - acum[:, :, None, :]
    lower = jnp.tril(jnp.ones((CHUNK, CHUNK), dtype=bool))[:, :, None, None]
    decay = jnp.where(lower, jnp.exp(jnp.where(lower, seg, 0.0)), 0.0)
    cb = jnp.einsum('bcign,bcjgn->bcijg', Cc, Bc)
    y_diag = jnp.einsum('bcijg,bcijgh,bcjghp->bcighp', cb, decay, xdt)
    decay_end = jnp.exp(acum[:, :, -1:] - acum)
    chunk_states = jnp.einsum('bcjgn,bcjgh,bcjghp->bcghpn', Bc, decay_end, xdt)
    chunk_decay = jnp.exp(acum[:, :, -1])

    def step(h, inp):
        s, d = inp
        return d[..., None, None] * h + s, h

    h_final, h_prev = lax.scan(step, h0.astype(f32),
                               (jnp.moveaxis(chunk_states, 1, 0), jnp.moveaxis(chunk_decay, 1, 0)))
    h_prev = jnp.moveaxis(h_prev, 0, 1)
    y_off = jnp.einsum('bcign,bcghpn,bcigh->bcighp', Cc, h_prev, jnp.exp(acum))
    y = (y_diag + y_off).reshape(b, L, g, hg, p)
    return y.astype(x.dtype), h_final.astype(x.dtype)


def ssd_mixer(z, xbc, dt_f, dt_b, conv_w, conv_b, dt_bias_f, dt_bias_b, a_log_f, a_log_b,
              d_skip, norm_g, h0_f, h0_b):
    b, L, _ = z.shape
    xbc = jax.nn.silu(dwconv_centred(xbc, conv_w, conv_b))
    xs, Bm, Cm = split_last(xbc, (D_SSD, SSD_GROUPS * SSD_STATE, SSD_GROUPS * SSD_STATE))
    xs = xs.reshape(b, L, SSD_GROUPS, SSD_HPG, SSD_HEAD_DIM)
    Bm = Bm.reshape(b, L, SSD_GROUPS, SSD_STATE)
    Cm = Cm.reshape(b, L, SSD_GROUPS, SSD_STATE)

    def run_dir(dt_raw, dt_bias, a_log, h0, reverse):
        dt = jax.nn.softplus((dt_raw + dt_bias).astype(jnp.float32)).reshape(b, L, SSD_GROUPS, SSD_HPG)
        A = -jnp.exp(a_log.astype(jnp.float32)).reshape(SSD_GROUPS, SSD_HPG)
        xd, dd, Bd, Cd = xs, dt, Bm, Cm
        if reverse:
            xd, dd, Bd, Cd = jnp.flip(xd, 1), jnp.flip(dd, 1), jnp.flip(Bd, 1), jnp.flip(Cd, 1)
        y, hN = ssd_chunked(xd, dd, A, Bd, Cd,
                            h0.reshape(b, SSD_GROUPS, SSD_HPG, SSD_HEAD_DIM, SSD_STATE))
        if reverse:
            y = jnp.flip(y, 1)
        return y, hN.reshape(b, SSD_HEADS, SSD_HEAD_DIM, SSD_STATE)

    y_f, h_f = run_dir(dt_f, dt_bias_f, a_log_f, h0_f, False)
    y_b, h_b = run_dir(dt_b, dt_bias_b, a_log_b, h0_b, True)
    y = y_f + y_b + d_skip.reshape(SSD_GROUPS, SSD_HPG)[..., None] * xs
    y = y.reshape(b, L, D_SSD) * jax.nn.silu(z)
    y = rmsnorm(y.reshape(b, L, SSD_GROUPS, D_SSD // SSD_GROUPS),
                norm_g.reshape(SSD_GROUPS, D_SSD // SSD_GROUPS)).reshape(b, L, D_SSD)
    return y, h_f, h_b


def pool_mixer(h, w_pool, pool_scale):
    b, L, d = h.shape
    hf = h.astype(jnp.float32)
    cs = jnp.concatenate([jnp.zeros((b, 1, d), jnp.float32), jnp.cumsum(hf, axis=1)], axis=1)
    t = np.arange(L)
    outs = []
    for gi, w in enumerate(POOL_WINDOWS):
        lo = np.clip(t - w // 2, 0, L)
        hi = np.clip(t + w // 2, 0, L)
        cnt = jnp.asarray((hi - lo).astype(np.float32))[None, :, None]
        csg = cs[..., gi * POOL_GC:(gi + 1) * POOL_GC]
        mean = (jnp.take(csg, jnp.asarray(hi), axis=1) - jnp.take(csg, jnp.asarray(lo), axis=1)) / cnt
        outs.append(mean - hf[..., gi * POOL_GC:(gi + 1) * POOL_GC])
    pooled = jnp.stack(outs, axis=2).astype(h.dtype)
    out = jnp.einsum('blgc,gcd->blgd', pooled, w_pool).reshape(b, L, d)
    return out * pool_scale


def swiglu(h, w_gate, w_up, w_down):
    return (jax.nn.silu(h @ w_gate) * (h @ w_up)) @ w_down


def setup_inputs(seed: int = 0) -> dict:
    key = jax.random.key(seed)
    ks = jax.random.split(key, 40)
    nrm = jax.random.normal
    D = D_MODEL
    dt0 = jnp.exp(jax.random.uniform(ks[14], (N_AB, SSD_HEADS), minval=np.log(1e-3), maxval=np.log(1e-1)))
    dt1 = jnp.exp(jax.random.uniform(ks[15], (N_AB, SSD_HEADS), minval=np.log(1e-3), maxval=np.log(1e-1)))
    return {
        "x_prompt": nrm(ks[0], (BATCH, SEQ, D), jnp.float32),
        "x_sample": nrm(ks[1], (DEC_BATCH, DEC_SEQ, D), jnp.float32),
        "c": nrm(ks[2], (DEC_BATCH, D), jnp.float32),
        "cache_mla_ckv": nrm(ks[3], (DEC_BATCH, N_AB, PAST_LEN, KV_RANK), jnp.float32),
        "cache_mla_krope": nrm(ks[4], (DEC_BATCH, N_AB, PAST_LEN, ROPE_DIM), jnp.float32),
        "state_ssd_fwd": 0.1 * nrm(ks[5], (DEC_BATCH, N_AB, SSD_HEADS, SSD_HEAD_DIM, SSD_STATE), jnp.float32),
        "state_ssd_bwd": 0.1 * nrm(ks[6], (DEC_BATCH, N_AB, SSD_HEADS, SSD_HEAD_DIM, SSD_STATE), jnp.float32),
        "c_ctx": nrm(ks[7], (D,), jnp.float32),
        "w_mod": 0.5 * D ** -0.5 * nrm(ks[8], (DEPTH, D, 6 * D), jnp.float32),
        "b_mod": 0.01 * nrm(ks[9], (DEPTH, 6 * D), jnp.float32),
        "norm_pre_mix": 1.0 + 0.05 * nrm(ks[10], (DEPTH, D), jnp.float32),
        "norm_post_mix": 1.0 + 0.05 * nrm(ks[11], (DEPTH, D), jnp.float32),
        "norm_pre_ffn": 1.0 + 0.05 * nrm(ks[12], (DEPTH, D), jnp.float32),
        "norm_post_ffn": 1.0 + 0.05 * nrm(ks[13], (DEPTH, D), jnp.float32),
        "w_in_ab": D ** -0.5 * nrm(ks[16], (N_AB, D, IN_AB), jnp.float32),
        "q_norm": 1.0 + 0.05 * nrm(ks[17], (N_AB, Q_RANK), jnp.float32),
        "w_uq": Q_RANK ** -0.5 * nrm(ks[18], (N_AB, Q_RANK, MLA_HEADS * (NOPE_DIM + ROPE_DIM)), jnp.float32),
        "kv_norm": 1.0 + 0.05 * nrm(ks[19], (N_AB, KV_RANK), jnp.float32),
        "w_ukv": KV_RANK ** -0.5 * nrm(ks[20], (N_AB, KV_RANK, MLA_HEADS * (NOPE_DIM + V_DIM)), jnp.float32),
        "ssd_conv_w": CONV_W ** -0.5 * nrm(ks[21], (N_AB, CONV_W, CONV_CH), jnp.float32),
        "ssd_conv_b": 0.01 * nrm(ks[22], (N_AB, CONV_CH), jnp.float32),
        "ssd_dt_bias_fwd": jnp.log(jnp.expm1(dt0)),
        "ssd_dt_bias_bwd": jnp.log(jnp.expm1(dt1)),
        "ssd_a_log_fwd": jnp.log(jax.random.uniform(ks[23], (N_AB, SSD_HEADS), minval=1.0, maxval=16.0)),
        "ssd_a_log_bwd": jnp.log(jax.random.uniform(ks[24], (N_AB, SSD_HEADS), minval=1.0, maxval=16.0)),
        "ssd_d": 1.0 + 0.1 * nrm(ks[25], (N_AB, SSD_HEADS), jnp.float32),
        "ssd_norm": 1.0 + 0.05 * nrm(ks[26], (N_AB, D_SSD), jnp.float32),
        "w_out_ab": OUT_AB ** -0.5 * nrm(ks[27], (N_AB, OUT_AB, D), jnp.float32),
        "pool_w": POOL_GC ** -0.5 * nrm(ks[28], (N_C, len(POOL_WINDOWS), POOL_GC, POOL_GC), jnp.float32),
        "pool_scale": 1.0 + 0.05 * nrm(ks[29], (N_C, D), jnp.float32),
        "ffn_w_gate": D ** -0.5 * nrm(ks[30], (DEPTH, D, D_FF), jnp.float32),
        "ffn_w_up": D ** -0.5 * nrm(ks[31], (DEPTH, D, D_FF), jnp.float32),
        "ffn_w_down": D_FF ** -0.5 * nrm(ks[32], (DEPTH, D_FF, D), jnp.float32),
    }


def reference(x_prompt, x_sample, c, cache_mla_ckv, cache_mla_krope, state_ssd_fwd, state_ssd_bwd, c_ctx,
              w_mod, b_mod, norm_pre_mix, norm_post_mix, norm_pre_ffn, norm_post_ffn,
              w_in_ab, q_norm, w_uq, kv_norm, w_ukv, ssd_conv_w, ssd_conv_b,
              ssd_dt_bias_fwd, ssd_dt_bias_bwd, ssd_a_log_fwd, ssd_a_log_bwd, ssd_d, ssd_norm, w_out_ab,
              pool_w, pool_scale, ffn_w_gate, ffn_w_up, ffn_w_down):
    xp, xs = x_prompt, x_sample
    cos, sin = axial_rope_tables(x_sample.shape[1])
    new_ckv, new_kpe, new_hf, new_hb = [], [], [], []
    for l in range(DEPTH):
        sh_p, sc_p, g_p, shf_p, scf_p, gf_p = modulation(c_ctx, w_mod[l], b_mod[l])
        sh_s, sc_s, g_s, shf_s, scf_s, gf_s = modulation(c, w_mod[l], b_mod[l])
        hp = modulate(xp, norm_pre_mix[l], sh_p, sc_p)
        hs = modulate(xs, norm_pre_mix[l], sh_s, sc_s)
        if l % 2 == 0:
            i = l // 2
            ssd_args = (ssd_conv_w[i], ssd_conv_b[i], ssd_dt_bias_fwd[i], ssd_dt_bias_bwd[i],
                        ssd_a_log_fwd[i], ssd_a_log_bwd[i], ssd_d[i], ssd_norm[i])
            qn, qpe, ckv_n, kpe, z, xbc, dtf, dtb = ab_project(hp, w_in_ab[i], q_norm[i], w_uq[i], kv_norm[i])
            kn, v = mla_expand_kv(ckv_n, w_ukv[i])
            att_p = mla_attend(qn, qpe, kn, kpe, v)
            h_zero = jnp.zeros((xp.shape[0], SSD_HEADS, SSD_HEAD_DIM, SSD_STATE), xp.dtype)
            ssd_p, hf, hb = ssd_mixer(z, xbc, dtf, dtb, *ssd_args, h_zero, h_zero)
            mix_p = jnp.concatenate([att_p, ssd_p], axis=-1) @ w_out_ab[i]
            new_ckv.append(ckv_n)
            new_kpe.append(kpe)
            new_hf.append(hf)
            new_hb.append(hb)
            qn, qpe, ckv_s, kpe_s, z, xbc, dtf, dtb = ab_project(hs, w_in_ab[i], q_norm[i], w_uq[i], kv_norm[i])
            qpe = apply_rope(qpe, cos[:, None, :], sin[:, None, :])
            kpe_s = apply_rope(kpe_s, cos, sin)
            ckv_all = jnp.concatenate([cache_mla_ckv[:, i].astype(ckv_s.dtype), ckv_s], axis=1)
            kpe_all = jnp.concatenate([cache_mla_krope[:, i].astype(kpe_s.dtype), kpe_s], axis=1)
            kn, v = mla_expand_kv(ckv_all, w_ukv[i])
            att_s = mla_attend(qn, qpe, kn, kpe_all, v)
            ssd_s, _, _ = ssd_mixer(z, xbc, dtf, dtb, *ssd_args, state_ssd_fwd[:, i], state_ssd_bwd[:, i])
            mix_s = jnp.concatenate([att_s, ssd_s], axis=-1) @ w_out_ab[i]
        else:
            j = l // 2
            mix_p = pool_mixer(hp, pool_w[j], pool_scale[j])
            mix_s = pool_mixer(hs, pool_w[j], pool_scale[j])
        xp = xp + g_p * rmsnorm(mix_p, norm_post_mix[l])
        xs = xs + g_s * rmsnorm(mix_s, norm_post_mix[l])
        fp = swiglu(modulate(xp, norm_pre_ffn[l], shf_p, scf_p), ffn_w_gate[l], ffn_w_up[l], ffn_w_down[l])
        fs = swiglu(modulate(xs, norm_pre_ffn[l], shf_s, scf_s), ffn_w_gate[l], ffn_w_up[l], ffn_w_down[l])
        xp = xp + gf_p * rmsnorm(fp, norm_post_ffn[l])
        xs = xs + gf_s * rmsnorm(fs, norm_post_ffn[l])
    new_mla_ckv = jnp.stack(new_ckv, axis=1)
    new_mla_krope = jnp.stack(new_kpe, axis=1)
    new_ssd_fwd = jnp.stack(new_hf, axis=1)
    new_ssd_bwd = jnp.stack(new_hb, axis=1)
    return (xp, xs, new_mla_ckv, new_mla_krope, new_ssd_fwd, new_ssd_bwd)
```

```cpp
#include <hip/hip_runtime.h>
#include <hip/hip_cooperative_groups.h>
#include <stdint.h>
#include <stdio.h>
namespace cg = cooperative_groups;

#ifndef SINGLE_LAUNCH
#define SINGLE_LAUNCH 1
#endif

typedef __attribute__((ext_vector_type(8))) short bf16x8;
typedef __attribute__((ext_vector_type(4))) float f32x4;
typedef unsigned short bf16_t;

#define DEVI __device__ __forceinline__

constexpr size_t OFF_WIN   = 0;
constexpr size_t OFF_WUQ   = OFF_WIN   + (size_t)2176*1024*2;
constexpr size_t OFF_WUKV  = OFF_WUQ   + (size_t)768*256*2;
constexpr size_t OFF_WOUT  = OFF_WUKV  + (size_t)1024*256*2;
constexpr size_t OFF_WPOOL = OFF_WOUT  + (size_t)1024*1024*2;
constexpr size_t OFF_WGU   = OFF_WPOOL + (size_t)4*256*256*2;
constexpr size_t OFF_WDN   = OFF_WGU   + (size_t)2*5632*1024*2;
constexpr size_t OFF_MOD   = OFF_WDN   + (size_t)2*1024*2816*2;
constexpr size_t OFF_R1    = OFF_MOD   + (size_t)2*3*6144*4;
constexpr size_t OFF_R2    = OFF_R1    + (size_t)8192*2096*4;
constexpr size_t OFF_H     = OFF_R2    + (size_t)8192*1024*4;
constexpr size_t OFF_CAT   = OFF_H     + (size_t)8192*1024*2;
constexpr size_t OFF_Q     = OFF_CAT   + (size_t)8192*1024*2;
constexpr size_t OFF_KN    = OFF_Q     + (size_t)8192*768*2;
constexpr size_t OFF_VT    = OFF_KN    + (size_t)8704*512*2;
constexpr size_t OFF_CQN   = OFF_VT    + (size_t)8704*512*2;
constexpr size_t OFF_CKV   = OFF_CQN   + (size_t)8192*256*2;
constexpr size_t OFF_KPE   = OFF_CKV   + (size_t)8704*256*2;
constexpr size_t OFF_XS    = OFF_KPE   + (size_t)8704*32*2;
constexpr size_t OFF_XST   = OFF_XS    + (size_t)8192*512*2;
constexpr size_t OFF_BM    = OFF_XST   + (size_t)8192*512*2;
constexpr size_t OFF_BT    = OFF_BM    + (size_t)8192*256*2;
constexpr size_t OFF_CM    = OFF_BT    + (size_t)8192*256*2;
constexpr size_t OFF_DTV   = OFF_CM    + (size_t)8192*256*2;
constexpr size_t OFF_CUM   = OFF_DTV   + (size_t)2*8192*8*4;
constexpr size_t OFF_TOT   = OFF_CUM   + (size_t)2*8192*8*4;
constexpr size_t OFF_END   = OFF_TOT   + 4096;

constexpr size_t OUT_CKV = 8388608, OUT_KR = 9437184, OUT_SF = 9568256, OUT_SB = 10616832;

struct P {
  const float *x_prompt, *x_sample, *c, *cache_ckv, *cache_kr, *st_f, *st_b, *c_ctx;
  const float *w_mod, *b_mod, *n_pre_mix, *n_post_mix, *n_pre_ffn, *n_post_ffn;
  const float *w_in, *q_norm, *w_uq, *kv_norm, *w_ukv, *conv_w, *conv_b, *dtb_f, *dtb_b, *alog_f, *alog_b;
  const float *ssd_d, *ssd_norm, *w_out, *pool_w, *pool_scale, *w_gate, *w_up, *w_down;
  float* out;
  char* ws;
};

#define WSB(off) ((bf16_t*)(p.ws + (off)))
#define WSF(off) ((float*)(p.ws + (off)))

DEVI bf16_t f2bf(float f) {
  unsigned u = __float_as_uint(f);
  u += 0x7fffu + ((u >> 16) & 1u);
  return (bf16_t)(u >> 16);
}
DEVI float bf2f(bf16_t b) { return __uint_as_float(((unsigned)b) << 16); }
DEVI unsigned pack2(float a, float b) { return (unsigned)f2bf(a) | ((unsigned)f2bf(b) << 16); }
DEVI float silu(float x) { return x / (1.f + __expf(-x)); }
DEVI float wave_sum(float v) {
#pragma unroll
  for (int o = 32; o > 0; o >>= 1) v += __shfl_xor(v, o, 64);
  return v;
}
DEVI f32x4 mfma16(bf16x8 a, bf16x8 b, f32x4 c) { return __builtin_amdgcn_mfma_f32_16x16x32_bf16(a, b, c, 0, 0, 0); }

DEVI float rope_freq(int m) { return exp2f(-(float)m * 1.6609640474436813f); }
DEVI void fast_sincos(float ang, float& sn, float& cs) {
  float rev = ang * 0.15915494309189535f;
  rev -= rintf(rev);
  sn = __builtin_amdgcn_sinf(rev);
  cs = __builtin_amdgcn_cosf(rev);
}
DEVI int swz_tile(int t, int T) {
  int q = T >> 3, r = T & 7, x = t & 7, off = t >> 3;
  return (x < r ? x * (q + 1) : r * (q + 1) + (x - r) * q) + off;
}

__shared__ __attribute__((aligned(16))) char g_smem[73728];
#define NOINL __device__ __forceinline__

constexpr int LDT = 72;
constexpr int TILE_E = 128 * LDT;

template <class Epi>
DEVI void gemm_tile(const bf16_t* __restrict__ A, int lda, const bf16_t* __restrict__ B, int ldb, int K,
                    int m0, int n0, char* smem, Epi epi) {
  const int tid = threadIdx.x, lane = tid & 63, wave = tid >> 6, wm = wave >> 1, wn = wave & 1;
  const int lr = lane & 15, lg = lane >> 4;
  bf16_t* sA = (bf16_t*)smem;
  bf16_t* sB = sA + 2 * TILE_E;
  f32x4 acc[4][4];
#pragma unroll
  for (int i = 0; i < 4; ++i)
#pragma unroll
    for (int j = 0; j < 4; ++j) acc[i][j] = (f32x4){0.f, 0.f, 0.f, 0.f};
  const int lrow = tid >> 3, lkc = (tid & 7) * 8;
  const bf16_t* gA = A + (size_t)(m0 + lrow) * lda + lkc;
  const bf16_t* gB = B + (size_t)(n0 + lrow) * ldb + lkc;
  uint4 ra[4], rb[4];
#pragma unroll
  for (int i = 0; i < 4; ++i) {
    ra[i] = *(const uint4*)(gA + (size_t)(32 * i) * lda);
    rb[i] = *(const uint4*)(gB + (size_t)(32 * i) * ldb);
  }
#pragma unroll
  for (int i = 0; i < 4; ++i) {
    *(uint4*)(sA + (lrow + 32 * i) * LDT + lkc) = ra[i];
    *(uint4*)(sB + (lrow + 32 * i) * LDT + lkc) = rb[i];
  }
  __syncthreads();
  const int nk = K >> 6;
  for (int kt = 0; kt < nk; ++kt) {
    const int cur = kt & 1;
    if (kt + 1 < nk) {
      const int k0 = (kt + 1) << 6;
#pragma unroll
      for (int i = 0; i < 4; ++i) {
        ra[i] = *(const uint4*)(gA + (size_t)(32 * i) * lda + k0);
        rb[i] = *(const uint4*)(gB + (size_t)(32 * i) * ldb + k0);
      }
    }
    const bf16_t* cA = sA + cur * TILE_E + (wm * 64 + lr) * LDT + lg * 8;
    const bf16_t* cB = sB + cur * TILE_E + (wn * 64 + lr) * LDT + lg * 8;
#pragma unroll
    for (int ks = 0; ks < 2; ++ks) {
      bf16x8 af[4], bfr[4];
#pragma unroll
      for (int i = 0; i < 4; ++i) {
        af[i] = *(const bf16x8*)(cA + i * 16 * LDT + ks * 32);
        bfr[i] = *(const bf16x8*)(cB + i * 16 * LDT + ks * 32);
      }
#pragma unroll
      for (int i = 0; i < 4; ++i)
#pragma unroll
        for (int j = 0; j < 4; ++j) acc[i][j] = mfma16(af[i], bfr[j], acc[i][j]);
    }
    if (kt + 1 < nk) {
      const int nx = cur ^ 1;
#pragma unroll
      for (int i = 0; i < 4; ++i) {
        *(uint4*)(sA + nx * TILE_E + (lrow + 32 * i) * LDT + lkc) = ra[i];
        *(uint4*)(sB + nx * TILE_E + (lrow + 32 * i) * LDT + lkc) = rb[i];
      }
    }
    __syncthreads();
  }
#pragma unroll
  for (int i = 0; i < 4; ++i)
#pragma unroll
    for (int j = 0; j < 4; j += 2)
      epi(m0 + wm * 64 + i * 16 + lg * 4, n0 + wn * 64 + j * 16 + lr, acc[i][j], acc[i][j + 1]);
}

DEVI void tile_mn(int t, int nM, int nN, int& m, int& n) {
  int id = swz_tile(t, nM * nN);
  int per = 8 * nN;
  int gq = id / per, rem = id - gq * per;
  int gsz = min(8, nM - gq * 8);
  m = gq * 8 + rem % gsz;
  n = rem / gsz;
}

NOINL void gemv_tile(const P& p, int t) {
  char* smem = g_smem;
  const int tid = threadIdx.x;
  float* sv = (float*)smem;
  float* red = sv + 3072;
  const int l = t / 192, n0 = (t % 192) * 32;
  for (int i = tid; i < 3072; i += 256) {
    int v = i >> 10, k = i & 1023;
    float cv = (v == 0) ? p.c_ctx[k] : p.c[(v - 1) * 1024 + k];
    sv[i] = cv / (1.f + expf(-cv));
  }
  __syncthreads();
  const int cgp = tid & 7, ks = tid >> 3;
  const float* w = p.w_mod + (size_t)l * 1024 * 6144 + n0 + cgp * 4;
  float a0[4] = {0, 0, 0, 0}, a1[4] = {0, 0, 0, 0}, a2[4] = {0, 0, 0, 0};
#pragma unroll 8
  for (int kk = 0; kk < 32; ++kk) {
    const int k = ks * 32 + kk;
    const float4 wv = *(const float4*)(w + (size_t)k * 6144);
    const float s0 = sv[k], s1 = sv[1024 + k], s2 = sv[2048 + k];
    a0[0] += s0 * wv.x; a0[1] += s0 * wv.y; a0[2] += s0 * wv.z; a0[3] += s0 * wv.w;
    a1[0] += s1 * wv.x; a1[1] += s1 * wv.y; a1[2] += s1 * wv.z; a1[3] += s1 * wv.w;
    a2[0] += s2 * wv.x; a2[1] += s2 * wv.y; a2[2] += s2 * wv.z; a2[3] += s2 * wv.w;
  }
#pragma unroll
  for (int j = 0; j < 4; ++j) {
    red[(ks * 3 + 0) * 32 + cgp * 4 + j] = a0[j];
    red[(ks * 3 + 1) * 32 + cgp * 4 + j] = a1[j];
    red[(ks * 3 + 2) * 32 + cgp * 4 + j] = a2[j];
  }
  __syncthreads();
  if (tid < 96) {
    const int v = tid >> 5, col = tid & 31;
    float s = 0.f;
    for (int q = 0; q < 32; ++q) s += red[(q * 3 + v) * 32 + col];
    s += p.b_mod[l * 6144 + n0 + col];
    WSF(OFF_MOD)[(l * 3 + v) * 6144 + n0 + col] = s;
  }
  __syncthreads();
}

NOINL void transpose_tile(const P& p, int t) {
  char* smem = g_smem;
  const int tid = threadIdx.x;
  const float* src; bf16_t* dst; int K, N, ntn, mode = 0;
  if (t < 544) { src = p.w_in; dst = WSB(OFF_WIN); K = 1024; N = 2096; ntn = 34; }
  else if ((t -= 544) < 48) { src = p.w_uq; dst = WSB(OFF_WUQ); K = 256; N = 768; ntn = 12; }
  else if ((t -= 48) < 64) { src = p.w_ukv; dst = WSB(OFF_WUKV); K = 256; N = 1024; ntn = 16; }
  else if ((t -= 64) < 256) { src = p.w_out; dst = WSB(OFF_WOUT); K = 1024; N = 1024; ntn = 16; }
  else if ((t -= 256) < 64) { int g = t >> 4; t &= 15; src = p.pool_w + (size_t)g * 65536; dst = WSB(OFF_WPOOL) + (size_t)g * 65536; K = 256; N = 256; ntn = 4; }
  else if ((t -= 64) < 1408) { int l = t / 704; t -= l * 704; src = p.w_gate + (size_t)l * 1024 * 2816; dst = WSB(OFF_WGU) + (size_t)l * 5632 * 1024; K = 1024; N = 2816; ntn = 44; mode = 1; }
  else if ((t -= 1408) < 1408) { int l = t / 704; t -= l * 704; src = p.w_up + (size_t)l * 1024 * 2816; dst = WSB(OFF_WGU) + (size_t)l * 5632 * 1024; K = 1024; N = 2816; ntn = 44; mode = 2; }
  else { t -= 1408; int l = t / 704; t -= l * 704; src = p.w_down + (size_t)l * 2816 * 1024; dst = WSB(OFF_WDN) + (size_t)l * 1024 * 2816; K = 2816; N = 1024; ntn = 16; }
  const int kt = t / ntn, nt_ = t - kt * ntn;
  const int k0 = kt * 64, n0 = nt_ * 64;
  float* tile = (float*)smem;
  {
    const int nn = tid & 63, kk0 = tid >> 6;
    const int n = n0 + nn;
#pragma unroll 4
    for (int i = 0; i < 16; ++i) {
      const int kk = kk0 + 4 * i;
      tile[kk * 65 + nn] = (n < N) ? src[(size_t)(k0 + kk) * N + n] : 0.f;
    }
  }
  __syncthreads();
#pragma unroll
  for (int i = 0; i < 2; ++i) {
    const int id = tid + 256 * i;
    const int nn = id >> 3, kc = id & 7;
    const int n = n0 + nn;
    uint4 pk;
    pk.x = pack2(tile[(kc * 8 + 0) * 65 + nn], tile[(kc * 8 + 1) * 65 + nn]);
    pk.y = pack2(tile[(kc * 8 + 2) * 65 + nn], tile[(kc * 8 + 3) * 65 + nn]);
    pk.z = pack2(tile[(kc * 8 + 4) * 65 + nn], tile[(kc * 8 + 5) * 65 + nn]);
    pk.w = pack2(tile[(kc * 8 + 6) * 65 + nn], tile[(kc * 8 + 7) * 65 + nn]);
    int drow = n;
    if (mode == 1) drow = (n >> 4) * 32 + (n & 15);
    else if (mode == 2) drow = (n >> 4) * 32 + 16 + (n & 15);
    *(uint4*)(dst + (size_t)drow * K + k0 + kc * 8) = pk;
  }
  __syncthreads();
}

template <bool UPD, bool MOD, bool FIRST>
DEVI void rowop(const P& p, const float* msrc, const float* wpost, int gate_idx, const float* wpre, int shift_idx,
                int scale_idx, int layer_g, int layer_m) {
  const int lane = threadIdx.x & 63, wave = threadIdx.x >> 6;
  const float* modg = WSF(OFF_MOD) + (size_t)layer_g * 3 * 6144;
  const float* modm = WSF(OFF_MOD) + (size_t)layer_m * 3 * 6144;
  bf16_t* hbuf = WSB(OFF_H);
  for (int r = blockIdx.x * 4 + wave; r < 8192; r += gridDim.x * 4) {
    const int v = r < 4096 ? 0 : 1 + ((r - 4096) >> 11);
    const float* mvg = modg + v * 6144;
    const float* mvm = modm + v * 6144;
    const float* xin = FIRST ? (r < 4096 ? p.x_prompt + (size_t)r * 1024 : p.x_sample + (size_t)(r - 4096) * 1024)
                             : p.out + (size_t)r * 1024;
    float4 x[4];
#pragma unroll
    for (int i = 0; i < 4; ++i) x[i] = *(const float4*)(xin + lane * 4 + 256 * i);
    if (UPD) {
      float4 m[4];
      float ss = 0.f;
#pragma unroll
      for (int i = 0; i < 4; ++i) {
        m[i] = *(const float4*)(msrc + (size_t)r * 1024 + lane * 4 + 256 * i);
        ss += m[i].x * m[i].x + m[i].y * m[i].y + m[i].z * m[i].z + m[i].w * m[i].w;
      }
      ss = wave_sum(ss);
      const float rs = rsqrtf(ss * (1.f / 1024.f) + 1e-6f);
#pragma unroll
      for (int i = 0; i < 4; ++i) {
        const int col = lane * 4 + 256 * i;
        const float4 wp = *(const float4*)(wpost + col);
        const float4 g = *(const float4*)(mvg + gate_idx * 1024 + col);
        x[i].x += g.x * (m[i].x * rs * wp.x);
        x[i].y += g.y * (m[i].y * rs * wp.y);
        x[i].z += g.z * (m[i].z * rs * wp.z);
        x[i].w += g.w * (m[i].w * rs * wp.w);
        *(float4*)(p.out + (size_t)r * 1024 + col) = x[i];
      }
    }
    if (MOD) {
      float ss = 0.f;
#pragma unroll
      for (int i = 0; i < 4; ++i) ss += x[i].x * x[i].x + x[i].y * x[i].y + x[i].z * x[i].z + x[i].w * x[i].w;
      ss = wave_sum(ss);
      const float rs = rsqrtf(ss * (1.f / 1024.f) + 1e-6f);
#pragma unroll
      for (int i = 0; i < 4; ++i) {
        const int col = lane * 4 + 256 * i;
        const float4 wp = *(const float4*)(wpre + col);
        const float4 sh = *(const float4*)(mvm + shift_idx * 1024 + col);
        const float4 sc = *(const float4*)(mvm + scale_idx * 1024 + col);
        uint2 o;
        o.x = pack2(x[i].x * rs * wp.x * (1.f + sc.x) + sh.x, x[i].y * rs * wp.y * (1.f + sc.y) + sh.y);
        o.y = pack2(x[i].z * rs * wp.z * (1.f + sc.z) + sh.z, x[i].w * rs * wp.w * (1.f + sc.w) + sh.w);
        *(uint2*)(hbuf + (size_t)r * 1024 + col) = o;
      }
    }
  }
}

NOINL void prep_rows(const P& p) {
  const int lane = threadIdx.x & 63, wave = threadIdx.x >> 6;
  const float* proj = WSF(OFF_R1);
  for (int r = blockIdx.x * 4 + wave; r < 8192; r += gridDim.x * 4) {
    const float* pr = proj + (size_t)r * 2096;
    const int kvrow = r < 4096 ? r : 4096 + ((r - 4096) >> 11) * 2304 + 256 + ((r - 4096) & 2047);
    {
      const float4 a = *(const float4*)(pr + lane * 4);
      float ss = wave_sum(a.x * a.x + a.y * a.y + a.z * a.z + a.w * a.w);
      const float rs = rsqrtf(ss * (1.f / 256.f) + 1e-6f);
      const float4 g = *(const float4*)(p.q_norm + lane * 4);
      uint2 o;
      o.x = pack2(a.x * rs * g.x, a.y * rs * g.y);
      o.y = pack2(a.z * rs * g.z, a.w * rs * g.w);
      *(uint2*)(WSB(OFF_CQN) + (size_t)r * 256 + lane * 4) = o;
    }
    {
      const float4 a = *(const float4*)(pr + 256 + lane * 4);
      float ss = wave_sum(a.x * a.x + a.y * a.y + a.z * a.z + a.w * a.w);
      const float rs = rsqrtf(ss * (1.f / 256.f) + 1e-6f);
      const float4 g = *(const float4*)(p.kv_norm + lane * 4);
      float4 vv;
      vv.x = a.x * rs * g.x; vv.y = a.y * rs * g.y; vv.z = a.z * rs * g.z; vv.w = a.w * rs * g.w;
      if (r < 4096) *(float4*)(p.out + OUT_CKV + (size_t)r * 256 + lane * 4) = vv;
      uint2 o;
      o.x = pack2(vv.x, vv.y);
      o.y = pack2(vv.z, vv.w);
      *(uint2*)(WSB(OFF_CKV) + (size_t)kvrow * 256 + lane * 4) = o;
    }
    {
      const float kv = (lane < 32) ? pr[512 + lane] : 0.f;
      const float partner = __shfl_xor(kv, 16, 64);
      if (r < 4096) {
        if (lane < 32) {
          p.out[OUT_KR + (size_t)r * 32 + lane] = kv;
          WSB(OFF_KPE)[(size_t)kvrow * 32 + lane] = f2bf(kv);
        }
      } else {
        const int t = (r - 4096) & 2047;
        const int ii = lane & 15;
        const float pos = (ii < 8) ? (float)(t >> 6) : (float)(t & 63);
        const float fr = rope_freq(ii & 7);
        const float ang = pos * fr;
        float cs, sn;
        fast_sincos(ang, sn, cs);
        const float o = (lane < 16) ? (kv * cs - partner * sn) : (partner * sn + kv * cs);
        if (lane < 32) WSB(OFF_KPE)[(size_t)kvrow * 32 + lane] = f2bf(o);
      }
    }
    if (lane < 16) {
      const int dir = lane >> 3, hh = lane & 7;
      const float raw = pr[2080 + lane] + (dir ? p.dtb_b[hh] : p.dtb_f[hh]);
      const float sp = raw > 20.f ? raw : log1pf(expf(raw));
      WSF(OFF_DTV)[((size_t)dir * 8192 + r) * 8 + hh] = sp;
    }
  }
}

NOINL void prep_cache(const P& p) {
  const int gt = blockIdx.x * 256 + threadIdx.x, gs = gridDim.x * 256;
  for (int i = gt; i < 2 * 256 * 256; i += gs) {
    int b = i >> 16, rem = i & 65535;
    WSB(OFF_CKV)[(size_t)(4096 + b * 2304) * 256 + rem] = f2bf(p.cache_ckv[i]);
  }
  for (int i = gt; i < 2 * 256 * 32; i += gs) {
    int b = i >> 13, rem = i & 8191;
    WSB(OFF_KPE)[(size_t)(4096 + b * 2304) * 32 + rem] = f2bf(p.cache_kr[i]);
  }
}

NOINL void conv_tile(const P& p, int t) {
  char* smem = g_smem;
  const int tid = threadIdx.x;
  float* sin_ = (float*)smem;
  float* sout = sin_ + 68 * 64;
  const int tt_ = t >> 4, ct = t & 15;
  const int r0 = tt_ * 64, c0 = ct * 64;
  int s0, s1;
  if (r0 < 4096) { s0 = r0 & ~255; s1 = s0 + 256; } else { s0 = 4096 + ((r0 - 4096) & ~2047); s1 = s0 + 2048; }
  const float* proj = WSF(OFF_R1);
  for (int i = tid; i < 68 * 64; i += 256) {
    const int rr = i >> 6, cc = i & 63;
    const int r = r0 - 2 + rr;
    float v = 0.f;
    if (r >= s0 && r < s1) v = proj[(size_t)r * 2096 + 1056 + c0 + cc];
    sin_[i] = v;
  }
  __syncthreads();
  {
    const int cc = tid & 63, tq = tid >> 6;
    const int c = c0 + cc;
    const float w0 = p.conv_w[c], w1 = p.conv_w[1024 + c], w2 = p.conv_w[2048 + c], w3 = p.conv_w[3072 + c],
                w4 = p.conv_w[4096 + c], bias = p.conv_b[c];
#pragma unroll 4
    for (int i = 0; i < 16; ++i) {
      const int tt = tq * 16 + i;
      float y = bias + w0 * sin_[tt * 64 + cc] + w1 * sin_[(tt + 1) * 64 + cc] + w2 * sin_[(tt + 2) * 64 + cc] +
                w3 * sin_[(tt + 3) * 64 + cc] + w4 * sin_[(tt + 4) * 64 + cc];
      y = y / (1.f + __expf(-y));
      sout[tt * 65 + cc] = y;
      const bf16_t b = f2bf(y);
      const size_t r = r0 + tt;
      if (c < 512) WSB(OFF_XS)[r * 512 + c] = b;
      else if (c < 768) WSB(OFF_BM)[r * 256 + (c - 512)] = b;
      else WSB(OFF_CM)[r * 256 + (c - 768)] = b;
    }
  }
  __syncthreads();
  if (c0 < 768) {
    const int cl = tid >> 2, q4 = tid & 3;
    uint4 o0, o1;
    const float* sp = sout + (q4 * 16) * 65 + cl;
    o0.x = pack2(sp[0 * 65], sp[1 * 65]);   o0.y = pack2(sp[2 * 65], sp[3 * 65]);
    o0.z = pack2(sp[4 * 65], sp[5 * 65]);   o0.w = pack2(sp[6 * 65], sp[7 * 65]);
    o1.x = pack2(sp[8 * 65], sp[9 * 65]);   o1.y = pack2(sp[10 * 65], sp[11 * 65]);
    o1.z = pack2(sp[12 * 65], sp[13 * 65]); o1.w = pack2(sp[14 * 65], sp[15 * 65]);
    bf16_t* dst = (c0 < 512) ? WSB(OFF_XST) + (size_t)(c0 + cl) * 8192 : WSB(OFF_BT) + (size_t)(c0 - 512 + cl) * 8192;
    dst += r0 + q4 * 16;
    *(uint4*)(dst) = o0;
    *(uint4*)(dst + 8) = o1;
  }
  __syncthreads();
}

NOINL void chunk_state_item(const P& p, int item) {
  char* smem = g_smem;
  const int tid = threadIdx.x, lane = tid & 63, wave = tid >> 6, lr = lane & 15, lg = lane >> 4;
  const int cidx = item >> 3, hh = item & 7, g = hh >> 2;
  const int r0 = cidx * 128;
  constexpr int LDS_ = 136;
  bf16_t* sAs = (bf16_t*)smem;
  bf16_t* sBs = sAs + 2 * 64 * LDS_;
  float* fa = (float*)(sBs + 128 * LDS_);
  float* fcum = fa + 256;
  float* fw = fa + 512;
  float* fdt = fa + 768;
  {
    const int dir = tid >> 7, j = tid & 127;
    const float dt = WSF(OFF_DTV)[((size_t)dir * 8192 + r0 + j) * 8 + hh];
    const float Aco = -expf(dir ? p.alog_b[hh] : p.alog_f[hh]);
    fa[tid] = dt * Aco;
    fdt[tid] = dt;
  }
  __syncthreads();
  {
    const int dir = tid >> 7, j = tid & 127;
    float s = 0.f;
    if (dir == 0) { for (int k = 0; k <= j; ++k) s += fa[k]; }
    else { for (int k = 127; k >= j; --k) s += fa[128 + k]; }
    fcum[tid] = s;
    WSF(OFF_CUM)[((size_t)dir * 8192 + r0 + j) * 8 + hh] = s;
  }
  __syncthreads();
  {
    const int dir = tid >> 7;
    const float ce = dir ? fcum[128] : fcum[127];
    fw[tid] = __expf(ce - fcum[tid]) * fdt[tid];
    if ((tid & 127) == 0) WSF(OFF_TOT)[(dir * 64 + cidx) * 8 + hh] = __expf(ce);
  }
  __syncthreads();
#pragma unroll
  for (int i = 0; i < 4; ++i) {
    const int id = tid + 256 * i;
    const int pp = id >> 4, jc = (id & 15) * 8;
    const uint4 raw = *(const uint4*)(WSB(OFF_XST) + (size_t)(hh * 64 + pp) * 8192 + r0 + jc);
    const unsigned rw[4] = {raw.x, raw.y, raw.z, raw.w};
    unsigned of[4], ob[4];
#pragma unroll
    for (int q = 0; q < 4; ++q) {
      const float x0 = __uint_as_float(rw[q] << 16), x1 = __uint_as_float(rw[q] & 0xffff0000u);
      of[q] = pack2(x0 * fw[jc + 2 * q], x1 * fw[jc + 2 * q + 1]);
      ob[q] = pack2(x0 * fw[128 + jc + 2 * q], x1 * fw[128 + jc + 2 * q + 1]);
    }
    *(uint4*)(sAs + pp * LDS_ + jc) = make_uint4(of[0], of[1], of[2], of[3]);
    *(uint4*)(sAs + 64 * LDS_ + pp * LDS_ + jc) = make_uint4(ob[0], ob[1], ob[2], ob[3]);
  }
#pragma unroll
  for (int i = 0; i < 8; ++i) {
    const int id = tid + 256 * i;
    const int nn = id >> 4, jc = (id & 15) * 8;
    *(uint4*)(sBs + nn * LDS_ + jc) = *(const uint4*)(WSB(OFF_BT) + (size_t)(g * 128 + nn) * 8192 + r0 + jc);
  }
  __syncthreads();
  {
    const int dir = wave >> 1, nh = wave & 1;
    f32x4 acc[4][4];
#pragma unroll
    for (int i = 0; i < 4; ++i)
#pragma unroll
      for (int j = 0; j < 4; ++j) acc[i][j] = (f32x4){0.f, 0.f, 0.f, 0.f};
    const bf16_t* cA = sAs + dir * 64 * LDS_ + lr * LDS_ + lg * 8;
    const bf16_t* cB = sBs + (nh * 64 + lr) * LDS_ + lg * 8;
#pragma unroll 1
    for (int ks = 0; ks < 4; ++ks) {
      bf16x8 af[4], bfr[4];
#pragma unroll
      for (int i = 0; i < 4; ++i) {
        af[i] = *(const bf16x8*)(cA + i * 16 * LDS_ + ks * 32);
        bfr[i] = *(const bf16x8*)(cB + i * 16 * LDS_ + ks * 32);
      }
#pragma unroll
      for (int i = 0; i < 4; ++i)
#pragma unroll
        for (int j = 0; j < 4; ++j) acc[i][j] = mfma16(af[i], bfr[j], acc[i][j]);
    }
    float* S = WSF(OFF_R2) + ((size_t)(dir * 64 + cidx) * 8 + hh) * 8192;
#pragma unroll
    for (int i = 0; i < 4; ++i)
#pragma unroll
      for (int j = 0; j < 4; ++j)
#pragma unroll
        for (int q = 0; q < 4; ++q) S[(i * 16 + lg * 4 + q) * 128 + nh * 64 + j * 16 + lr] = acc[i][j][q];
  }
  __syncthreads();
}

NOINL void scan_states(const P& p) {
  const int total = 2 * 18 * 8 * 64 * 32;
  for (int idx = blockIdx.x * 256 + threadIdx.x; idx < total; idx += gridDim.x * 256) {
    const int n4 = idx & 31, pp = (idx >> 5) & 63, hh = (idx >> 11) & 7;
    const int sd = idx >> 14;
    const int s = sd % 18, dir = sd / 18;
    const int nc = s < 16 ? 2 : 16;
    const int cb = s < 16 ? s * 2 : 32 + (s - 16) * 16;
    float4 h = make_float4(0.f, 0.f, 0.f, 0.f);
    if (s >= 16) {
      const float* st = (dir ? p.st_b : p.st_f) + ((size_t)((s - 16) * 8 + hh) * 64 + pp) * 128 + n4 * 4;
      h = *(const float4*)st;
    }
    const size_t eoff = (size_t)pp * 128 + n4 * 4;
    for (int c = 0; c < nc; ++c) {
      const int cidx = cb + (dir ? nc - 1 - c : c);
      const size_t base = ((size_t)(dir * 64 + cidx) * 8 + hh) * 8192 + eoff;
      uint2 o;
      o.x = pack2(h.x, h.y);
      o.y = pack2(h.z, h.w);
      *(uint2*)(WSB(OFF_H) + base) = o;
      const float d = WSF(OFF_TOT)[(dir * 64 + cidx) * 8 + hh];
      const float4 sv = *(const float4*)(WSF(OFF_R2) + base);
      h.x = d * h.x + sv.x; h.y = d * h.y + sv.y; h.z = d * h.z + sv.z; h.w = d * h.w + sv.w;
    }
    if (s < 16) {
      float* o = p.out + (dir ? OUT_SB : OUT_SF) + ((size_t)(s * 8 + hh) * 64 + pp) * 128 + n4 * 4;
      *(float4*)o = h;
    }
  }
}

NOINL void attn_item(const P& p, int id) {
  char* smem = g_smem;
  const int tid = threadIdx.x, lane = tid & 63, wave = tid >> 6, lr = lane & 15, lg = lane >> 4;
  int row0, kvbase, Lk, hh;
  if (id < 512) { const int b = id >> 8; hh = (id >> 5) & 7; const int qb = id & 31; row0 = 4096 + b * 2048 + qb * 64; kvbase = 4096 + b * 2304; Lk = 2304; }
  else { const int i2 = id - 512; const int b = i2 >> 5; hh = (i2 >> 2) & 7; const int qb = i2 & 3; row0 = b * 256 + qb * 64; kvbase = b * 256; Lk = 256; }
  constexpr int LDK = 104, LDV = 72;
  bf16_t* sK = (bf16_t*)smem;
  bf16_t* sV = sK + 64 * LDK;
  const int qrow = row0 + wave * 16 + lr;
  bf16x8 qf[3];
#pragma unroll
  for (int ks = 0; ks < 3; ++ks) qf[ks] = *(const bf16x8*)(WSB(OFF_Q) + (size_t)qrow * 768 + hh * 96 + ks * 32 + lg * 8);
  f32x4 oacc[4];
#pragma unroll
  for (int i = 0; i < 4; ++i) oacc[i] = (f32x4){0.f, 0.f, 0.f, 0.f};
  float mrun = -1e30f, lrun = 0.f;
  const int nkt = Lk >> 6;
  for (int kt = 0; kt < nkt; ++kt) {
    const int kr0 = kvbase + kt * 64;
#pragma unroll
    for (int i = 0; i < 3; ++i) {
      const int c = tid + 256 * i;
      const int key = c / 12, cc = c - key * 12;
      const bf16_t* src = (cc < 8) ? WSB(OFF_KN) + (size_t)(kr0 + key) * 512 + hh * 64 + cc * 8
                                   : WSB(OFF_KPE) + (size_t)(kr0 + key) * 32 + (cc - 8) * 8;
      *(uint4*)(sK + key * LDK + cc * 8) = *(const uint4*)src;
    }
#pragma unroll
    for (int i = 0; i < 2; ++i) {
      const int c = tid + 256 * i;
      const int d = c >> 3, cc = c & 7;
      *(uint4*)(sV + d * LDV + cc * 8) = *(const uint4*)(WSB(OFF_VT) + (size_t)(hh * 64 + d) * 8704 + kr0 + cc * 8);
    }
    __syncthreads();
    f32x4 sacc[4];
#pragma unroll
    for (int n = 0; n < 4; ++n) sacc[n] = (f32x4){0.f, 0.f, 0.f, 0.f};
#pragma unroll
    for (int ks = 0; ks < 3; ++ks)
#pragma unroll
      for (int n = 0; n < 4; ++n) {
        const bf16x8 a = *(const bf16x8*)(sK + (n * 16 + lr) * LDK + ks * 32 + lg * 8);
        sacc[n] = mfma16(a, qf[ks], sacc[n]);
      }
    float mx = sacc[0][0];
#pragma unroll
    for (int n = 0; n < 4; ++n)
#pragma unroll
      for (int q = 0; q < 4; ++q) mx = fmaxf(mx, sacc[n][q]);
    mx = fmaxf(mx, __shfl_xor(mx, 16, 64));
    mx = fmaxf(mx, __shfl_xor(mx, 32, 64));
    const float mnew = fmaxf(mrun, mx);
    const float alpha = __expf(mrun - mnew);
    mrun = mnew;
    float ps = 0.f;
#pragma unroll
    for (int n = 0; n < 4; ++n)
#pragma unroll
      for (int q = 0; q < 4; ++q) { const float e = __expf(sacc[n][q] - mnew); sacc[n][q] = e; ps += e; }
    lrun = lrun * alpha + ps;
#pragma unroll
    for (int i = 0; i < 4; ++i)
#pragma unroll
      for (int q = 0; q < 4; ++q) oacc[i][q] *= alpha;
#pragma unroll
    for (int ks = 0; ks < 2; ++ks) {
      union { bf16x8 v; unsigned u[4]; } pf;
      pf.u[0] = pack2(sacc[2 * ks][0], sacc[2 * ks][1]);
      pf.u[1] = pack2(sacc[2 * ks][2], sacc[2 * ks][3]);
      pf.u[2] = pack2(sacc[2 * ks + 1][0], sacc[2 * ks + 1][1]);
      pf.u[3] = pack2(sacc[2 * ks + 1][2], sacc[2 * ks + 1][3]);
#pragma unroll
      for (int m = 0; m < 4; ++m) {
        union { bf16x8 v; uint2 h[2]; } av;
        const bf16_t* vp = sV + (m * 16 + lr) * LDV + ks * 32 + lg * 4;
        av.h[0] = *(const uint2*)(vp);
        av.h[1] = *(const uint2*)(vp + 16);
        oacc[m] = mfma16(av.v, pf.v, oacc[m]);
      }
    }
    __syncthreads();
  }
  lrun += __shfl_xor(lrun, 16, 64);
  lrun += __shfl_xor(lrun, 32, 64);
  const float inv = 1.f / lrun;
#pragma unroll
  for (int m = 0; m < 4; ++m) {
    uint2 o;
    o.x = pack2(oacc[m][0] * inv, oacc[m][1] * inv);
    o.y = pack2(oacc[m][2] * inv, oacc[m][3] * inv);
    *(uint2*)(WSB(OFF_CAT) + (size_t)qrow * 1024 + hh * 64 + m * 16 + lg * 4) = o;
  }
}

NOINL void ssd_y_item(const P& p, int item) {
  char* smem = g_smem;
  const int tid = threadIdx.x, lane = tid & 63, wave = tid >> 6, lr = lane & 15, lg = lane >> 4;
  const int cidx = item >> 2, half = (item >> 1) & 1, g = item & 1;
  const int r0 = cidx * 128;
  const int hh = g * 4 + wave;
  constexpr int LDC = 136, LDM = 72;
  bf16_t* sC = (bf16_t*)smem;
  bf16_t* sB = sC + 64 * LDC;
  bf16_t* sM = sB + 64 * LDC + wave * 64 * LDM;
  float* rowss = (float*)((bf16_t*)smem + 2 * 64 * LDC + 4 * 64 * LDM);
  const float* cum = WSF(OFF_CUM);
  const float* dtv = WSF(OFF_DTV);
#pragma unroll
  for (int i = 0; i < 4; ++i) {
    const int id = tid + 256 * i;
    const int rr = id >> 4, nc = (id & 15) * 8;
    *(uint4*)(sC + rr * LDC + nc) = *(const uint4*)(WSB(OFF_CM) + (size_t)(r0 + half * 64 + rr) * 256 + g * 128 + nc);
  }
  f32x4 Y[4][4];
#pragma unroll
  for (int i = 0; i < 4; ++i)
#pragma unroll
    for (int j = 0; j < 4; ++j) Y[i][j] = (f32x4){0.f, 0.f, 0.f, 0.f};
  for (int jh = 0; jh < 2; ++jh) {
    __syncthreads();
#pragma unroll
    for (int i = 0; i < 4; ++i) {
      const int id = tid + 256 * i;
      const int rr = id >> 4, nc = (id & 15) * 8;
      *(uint4*)(sB + rr * LDC + nc) = *(const uint4*)(WSB(OFF_BM) + (size_t)(r0 + jh * 64 + rr) * 256 + g * 128 + nc);
    }
    __syncthreads();
    for (int dir = 0; dir < 2; ++dir) {
      const bool use = dir == 0 ? (jh <= half) : (jh >= half);
      if (!use) continue;
      float cj[4], dj[4];
#pragma unroll
      for (int j = 0; j < 4; ++j) {
        const size_t tj = (size_t)dir * 8192 + r0 + jh * 64 + j * 16 + lr;
        cj[j] = cum[tj * 8 + hh];
        dj[j] = dtv[tj * 8 + hh];
      }
#pragma unroll
      for (int i = 0; i < 4; ++i) {
        f32x4 cb[4];
#pragma unroll
        for (int j = 0; j < 4; ++j) cb[j] = (f32x4){0.f, 0.f, 0.f, 0.f};
#pragma unroll 1
        for (int ks = 0; ks < 4; ++ks) {
          const bf16x8 a = *(const bf16x8*)(sC + (i * 16 + lr) * LDC + ks * 32 + lg * 8);
#pragma unroll
          for (int j = 0; j < 4; ++j) {
            const bf16x8 b = *(const bf16x8*)(sB + (j * 16 + lr) * LDC + ks * 32 + lg * 8);
            cb[j] = mfma16(a, b, cb[j]);
          }
        }
#pragma unroll
        for (int q = 0; q < 4; ++q) {
          const int il = i * 16 + lg * 4 + q;
          const int ti = half * 64 + il;
          const float ci = cum[((size_t)dir * 8192 + r0 + ti) * 8 + hh];
#pragma unroll
          for (int j = 0; j < 4; ++j) {
            const int tj = jh * 64 + j * 16 + lr;
            const bool ok = dir == 0 ? (tj <= ti) : (tj >= ti);
            const float val = ok ? cb[j][q] * __expf(ci - cj[j]) * dj[j] : 0.f;
            sM[il * LDM + j * 16 + lr] = f2bf(val);
          }
        }
        __builtin_amdgcn_sched_barrier(0);
      }
      __syncthreads();
#pragma unroll 1
      for (int ks = 0; ks < 2; ++ks) {
        bf16x8 af[4], bfr[4];
#pragma unroll
        for (int i = 0; i < 4; ++i) {
          af[i] = *(const bf16x8*)(sM + (i * 16 + lr) * LDM + ks * 32 + lg * 8);
          bfr[i] = *(const bf16x8*)(WSB(OFF_XST) + (size_t)(hh * 64 + i * 16 + lr) * 8192 + r0 + jh * 64 + ks * 32 + lg * 8);
        }
#pragma unroll
        for (int i = 0; i < 4; ++i)
#pragma unroll
          for (int j = 0; j < 4; ++j) Y[i][j] = mfma16(af[i], bfr[j], Y[i][j]);
      }
      __syncthreads();
    }
  }
  for (int dir = 0; dir < 2; ++dir) {
    const bf16_t* hp = WSB(OFF_H) + ((size_t)(dir * 64 + cidx) * 8 + hh) * 8192;
#pragma unroll
    for (int i = 0; i < 4; ++i) {
      f32x4 T[4];
#pragma unroll
      for (int j = 0; j < 4; ++j) T[j] = (f32x4){0.f, 0.f, 0.f, 0.f};
#pragma unroll 1
      for (int ks = 0; ks < 4; ++ks) {
        const bf16x8 a = *(const bf16x8*)(sC + (i * 16 + lr) * LDC + ks * 32 + lg * 8);
#pragma unroll
        for (int j = 0; j < 4; ++j) {
          const bf16x8 b = *(const bf16x8*)(hp + (size_t)(j * 16 + lr) * 128 + ks * 32 + lg * 8);
          T[j] = mfma16(a, b, T[j]);
        }
      }
#pragma unroll
      for (int q = 0; q < 4; ++q) {
        const int ti = half * 64 + i * 16 + lg * 4 + q;
        const float e = __expf(cum[((size_t)dir * 8192 + r0 + ti) * 8 + hh]);
#pragma unroll
        for (int j = 0; j < 4; ++j) Y[i][j][q] += e * T[j][q];
      }
      __builtin_amdgcn_sched_barrier(0);
    }
  }
  const float dsk = p.ssd_d[hh];
  const float* proj = WSF(OFF_R1);
#pragma unroll
  for (int i = 0; i < 4; ++i)
#pragma unroll
    for (int q = 0; q < 4; ++q) {
      const int il = i * 16 + lg * 4 + q;
      const size_t r = (size_t)r0 + half * 64 + il;
      float ss = 0.f;
#pragma unroll
      for (int j = 0; j < 4; ++j) {
        const int ch = hh * 64 + j * 16 + lr;
        const float xs = bf2f(WSB(OFF_XS)[r * 512 + ch]);
        const float z = proj[r * 2096 + 544 + ch];
        const float y = (Y[i][j][q] + dsk * xs) * silu(z);
        Y[i][j][q] = y;
        ss += y * y;
      }
      ss += __shfl_xor(ss, 1, 64);
      ss += __shfl_xor(ss, 2, 64);
      ss += __shfl_xor(ss, 4, 64);
      ss += __shfl_xor(ss, 8, 64);
      if (lr == 0) rowss[wave * 64 + il] = ss;
      __builtin_amdgcn_sched_barrier(0);
    }
  __syncthreads();
#pragma unroll
  for (int i = 0; i < 4; ++i)
#pragma unroll
    for (int q = 0; q < 4; ++q) {
      const int il = i * 16 + lg * 4 + q;
      const size_t r = (size_t)r0 + half * 64 + il;
      const float tot = rowss[il] + rowss[64 + il] + rowss[128 + il] + rowss[192 + il];
      const float rs = rsqrtf(tot * (1.f / 256.f) + 1e-6f);
#pragma unroll
      for (int j = 0; j < 4; ++j) {
        const int ch = hh * 64 + j * 16 + lr;
        WSB(OFF_CAT)[r * 1024 + 512 + ch] = f2bf(Y[i][j][q] * rs * p.ssd_norm[ch]);
      }
    }
  __syncthreads();
}

NOINL void pool_phase(const P& p) {
  const bf16_t* h = WSB(OFF_H);
  bf16_t* dst = WSB(OFF_CAT);
  const int total = 8192 * 128;
  for (int idx = blockIdx.x * 256 + threadIdx.x; idx < total; idx += gridDim.x * 256) {
    const int r = idx >> 7, cc = (idx & 127) * 8;
    int s0, L;
    if (r < 4096) { s0 = r & ~255; L = 256; } else { s0 = 4096 + ((r - 4096) & ~2047); L = 2048; }
    const int t = r - s0;
    const int w2 = 1 << (cc >> 8);
    const int lo = max(t - w2, 0), hi = min(t + w2, L);
    float acc[8] = {0, 0, 0, 0, 0, 0, 0, 0};
    for (int u = lo; u < hi; ++u) {
      const uint4 v = *(const uint4*)(h + (size_t)(s0 + u) * 1024 + cc);
      acc[0] += __uint_as_float(v.x << 16); acc[1] += __uint_as_float(v.x & 0xffff0000u);
      acc[2] += __uint_as_float(v.y << 16); acc[3] += __uint_as_float(v.y & 0xffff0000u);
      acc[4] += __uint_as_float(v.z << 16); acc[5] += __uint_as_float(v.z & 0xffff0000u);
      acc[6] += __uint_as_float(v.w << 16); acc[7] += __uint_as_float(v.w & 0xffff0000u);
    }
    const float inv = 1.f / (float)(hi - lo);
    const uint4 v = *(const uint4*)(h + (size_t)r * 1024 + cc);
    uint4 o;
    o.x = pack2(acc[0] * inv - __uint_as_float(v.x << 16), acc[1] * inv - __uint_as_float(v.x & 0xffff0000u));
    o.y = pack2(acc[2] * inv - __uint_as_float(v.y << 16), acc[3] * inv - __uint_as_float(v.y & 0xffff0000u));
    o.z = pack2(acc[4] * inv - __uint_as_float(v.z << 16), acc[5] * inv - __uint_as_float(v.z & 0xffff0000u));
    o.w = pack2(acc[6] * inv - __uint_as_float(v.w << 16), acc[7] * inv - __uint_as_float(v.w & 0xffff0000u));
    *(uint4*)(dst + (size_t)r * 1024 + cc) = o;
  }
}

NOINL void ph_gemm_proj(const P& p) {
  char* smem = g_smem;
  float* proj = WSF(OFF_R1);
  const int nM = 64, nN = 17;
  for (int t = blockIdx.x; t < nM * nN; t += gridDim.x) {
    int m, n; tile_mn(t, nM, nN, m, n);
    gemm_tile(WSB(OFF_H), 1024, WSB(OFF_WIN), 1024, 1024, m * 128, n * 128, smem,
      [&](int row, int col, f32x4 v0, f32x4 v1) {
#pragma unroll
        for (int q = 0; q < 4; ++q) {
          if (col < 2096) proj[(size_t)(row + q) * 2096 + col] = v0[q];
          if (col + 16 < 2096) proj[(size_t)(row + q) * 2096 + col + 16] = v1[q];
        }
      });
  }
}

NOINL void ph_gemm_f32out(const P& p, const bf16_t* A, int lda, const bf16_t* B, int ldb, int K, float* C, int N) {
  char* smem = g_smem;
  const int nM = 64, nN = N / 128;
  for (int t = blockIdx.x; t < nM * nN; t += gridDim.x) {
    int m, n; tile_mn(t, nM, nN, m, n);
    gemm_tile(A, lda, B, ldb, K, m * 128, n * 128, smem,
      [&](int row, int col, f32x4 v0, f32x4 v1) {
#pragma unroll
        for (int q = 0; q < 4; ++q) {
          C[(size_t)(row + q) * N + col] = v0[q];
          C[(size_t)(row + q) * N + col + 16] = v1[q];
        }
      });
  }
}

NOINL void ph_gemm_q(const P& p, int t) {
  char* smem = g_smem;
  int m, n; tile_mn(t, 64, 6, m, n);
  bf16_t* qo = WSB(OFF_Q);
  gemm_tile(WSB(OFF_CQN), 256, WSB(OFF_WUQ), 256, 256, m * 128, n * 128, smem,
    [&](int row, int col, f32x4 v0, f32x4 v1) {
      const float scl = 0.10206207261596575f;
      const int tn = col >> 4;
      const bool rope = ((tn % 6) == 4) && (row >= 4096);
      const int ii = col & 15;
      const float fr = rope_freq(ii & 7);
#pragma unroll
      for (int q = 0; q < 4; ++q) {
        float a = v0[q], b = v1[q];
        if (rope) {
          const int tt = (row + q - 4096) & 2047;
          const float pos = (ii < 8) ? (float)(tt >> 6) : (float)(tt & 63);
          const float ang = pos * fr;
          float cs, sn;
          fast_sincos(ang, sn, cs);
          const float x1 = a, x2 = b;
          a = x1 * cs - x2 * sn;
          b = x1 * sn + x2 * cs;
        }
        qo[(size_t)(row + q) * 768 + col] = f2bf(a * scl);
        qo[(size_t)(row + q) * 768 + col + 16] = f2bf(b * scl);
      }
    });
}

NOINL void ph_gemm_kv(const P& p, int t) {
  char* smem = g_smem;
  int m, n; tile_mn(t, 68, 8, m, n);
  bf16_t* kn = WSB(OFF_KN);
  bf16_t* vt = WSB(OFF_VT);
  gemm_tile(WSB(OFF_CKV), 256, WSB(OFF_WUKV), 256, 256, m * 128, n * 128, smem,
    [&](int row, int col, f32x4 v0, f32x4 v1) {
      const int hh = col >> 7, j = col & 127;
      if (j < 64) {
#pragma unroll
        for (int q = 0; q < 4; ++q) {
          kn[(size_t)(row + q) * 512 + hh * 64 + j] = f2bf(v0[q]);
          kn[(size_t)(row + q) * 512 + hh * 64 + j + 16] = f2bf(v1[q]);
        }
      } else {
        uint2 o0, o1;
        o0.x = pack2(v0[0], v0[1]); o0.y = pack2(v0[2], v0[3]);
        o1.x = pack2(v1[0], v1[1]); o1.y = pack2(v1[2], v1[3]);
        *(uint2*)(vt + (size_t)(hh * 64 + j - 64) * 8704 + row) = o0;
        *(uint2*)(vt + (size_t)(hh * 64 + j - 64 + 16) * 8704 + row) = o1;
      }
    });
}

NOINL void ph_gemm_ffn_up(const P& p, int layer) {
  char* smem = g_smem;
  bf16_t* gu = WSB(OFF_R1);
  const bf16_t* B = WSB(OFF_WGU) + (size_t)layer * 5632 * 1024;
  const int nM = 64, nN = 44;
  for (int t = blockIdx.x; t < nM * nN; t += gridDim.x) {
    int m, n; tile_mn(t, nM, nN, m, n);
    gemm_tile(WSB(OFF_H), 1024, B, 1024, 1024, m * 128, n * 128, smem,
      [&](int row, int col, f32x4 v0, f32x4 v1) {
        const int oc = (col >> 5) * 16 + (col & 15);
#pragma unroll
        for (int q = 0; q < 4; ++q) gu[(size_t)(row + q) * 2816 + oc] = f2bf(silu(v0[q]) * v1[q]);
      });
  }
}

NOINL void ph_gemm_pool(const P& p) {
  char* smem = g_smem;
  float* mix = WSF(OFF_R1);
  for (int t = blockIdx.x; t < 512; t += gridDim.x) {
    const int id = swz_tile(t, 512);
    const int g = id >> 7, rem = id & 127;
    const int m = rem >> 1, n = rem & 1;
    gemm_tile(WSB(OFF_CAT) + g * 256, 1024, WSB(OFF_WPOOL) + (size_t)g * 65536, 256, 256, m * 128, n * 128, smem,
      [&](int row, int col, f32x4 v0, f32x4 v1) {
        const int c0 = g * 256 + col;
        const float s0 = p.pool_scale[c0], s1 = p.pool_scale[c0 + 16];
#pragma unroll
        for (int q = 0; q < 4; ++q) {
          mix[(size_t)(row + q) * 1024 + c0] = v0[q] * s0;
          mix[(size_t)(row + q) * 1024 + c0 + 16] = v1[q] * s1;
        }
      });
  }
}

constexpr int NPHASE = 18;
#ifndef PHMASK
#define PHMASK 0x3ffff
#endif
#define PH(n) if constexpr ((PHMASK >> (n)) & 1)

__global__ void __launch_bounds__(256, 1) mega(P p, int lo, int hi) {
  PH(0) if (lo <= 0 && 0 < hi) {
        for (int t = blockIdx.x; t < 384 + 5200; t += gridDim.x) {
          if (t < 384) gemv_tile(p, t); else transpose_tile(p, t - 384);
        }
  }
  if (lo <= 0 && 0 + 1 < hi) cg::this_grid().sync();
  PH(1) if (lo <= 1 && 1 < hi) {
        rowop<false, true, true>(p, nullptr, nullptr, 0, p.n_pre_mix, 0, 1, 0, 0);
  }
  if (lo <= 1 && 1 + 1 < hi) cg::this_grid().sync();
  PH(2) if (lo <= 2 && 2 < hi) {
        ph_gemm_proj(p);
  }
  if (lo <= 2 && 2 + 1 < hi) cg::this_grid().sync();
  PH(3) if (lo <= 3 && 3 < hi) {
        prep_rows(p);
        prep_cache(p);
        for (int t = blockIdx.x; t < 2048; t += gridDim.x) conv_tile(p, t);
  }
  if (lo <= 3 && 3 + 1 < hi) cg::this_grid().sync();
  PH(4) if (lo <= 4 && 4 < hi) {
        for (int t = blockIdx.x; t < 384 + 544 + 512; t += gridDim.x) {
#ifndef P4SEL
#define P4SEL 7
#endif
          if (t < 384) { if constexpr (P4SEL & 1) ph_gemm_q(p, t); }
          else if (t < 928) { if constexpr (P4SEL & 2) ph_gemm_kv(p, t - 384); }
          else { if constexpr (P4SEL & 4) chunk_state_item(p, t - 928); }
        }
  }
  if (lo <= 4 && 4 + 1 < hi) cg::this_grid().sync();
  PH(5) if (lo <= 5 && 5 < hi) {
        scan_states(p);
  }
  if (lo <= 5 && 5 + 1 < hi) cg::this_grid().sync();
  PH(6) if (lo <= 6 && 6 < hi) {
        for (int t = blockIdx.x; t < 1024 + 256; t += gridDim.x) {
#ifndef P6SEL
#define P6SEL 3
#endif
          if (t < 1024) { if constexpr (P6SEL & 1) attn_item(p, t); } else { if constexpr (P6SEL & 2) ssd_y_item(p, t - 1024); }
        }
  }
  if (lo <= 6 && 6 + 1 < hi) cg::this_grid().sync();
  PH(7) if (lo <= 7 && 7 < hi) {
        ph_gemm_f32out(p, WSB(OFF_CAT), 1024, WSB(OFF_WOUT), 1024, 1024, WSF(OFF_R1), 1024);
  }
  if (lo <= 7 && 7 + 1 < hi) cg::this_grid().sync();
  PH(8) if (lo <= 8 && 8 < hi) {
        rowop<true, true, true>(p, WSF(OFF_R1), p.n_post_mix, 2, p.n_pre_ffn, 3, 4, 0, 0);
  }
  if (lo <= 8 && 8 + 1 < hi) cg::this_grid().sync();
  PH(9) if (lo <= 9 && 9 < hi) {
        ph_gemm_ffn_up(p, 0);
  }
  if (lo <= 9 && 9 + 1 < hi) cg::this_grid().sync();
  PH(10) if (lo <= 10 && 10 < hi) {
        ph_gemm_f32out(p, WSB(OFF_R1), 2816, WSB(OFF_WDN), 2816, 2816, WSF(OFF_R2), 1024);
  }
  if (lo <= 10 && 10 + 1 < hi) cg::this_grid().sync();
  PH(11) if (lo <= 11 && 11 < hi) {
        rowop<true, true, false>(p, WSF(OFF_R2), p.n_post_ffn, 5, p.n_pre_mix + 1024, 0, 1, 0, 1);
  }
  if (lo <= 11 && 11 + 1 < hi) cg::this_grid().sync();
  PH(12) if (lo <= 12 && 12 < hi) {
        pool_phase(p);
  }
  if (lo <= 12 && 12 + 1 < hi) cg::this_grid().sync();
  PH(13) if (lo <= 13 && 13 < hi) {
        ph_gemm_pool(p);
  }
  if (lo <= 13 && 13 + 1 < hi) cg::this_grid().sync();
  PH(14) if (lo <= 14 && 14 < hi) {
        rowop<true, true, false>(p, WSF(OFF_R1), p.n_post_mix + 1024, 2, p.n_pre_ffn + 1024, 3, 4, 1, 1);
  }
  if (lo <= 14 && 14 + 1 < hi) cg::this_grid().sync();
  PH(15) if (lo <= 15 && 15 < hi) {
        ph_gemm_ffn_up(p, 1);
  }
  if (lo <= 15 && 15 + 1 < hi) cg::this_grid().sync();
  PH(16) if (lo <= 16 && 16 < hi) {
        ph_gemm_f32out(p, WSB(OFF_R1), 2816, WSB(OFF_WDN) + (size_t)1024 * 2816, 2816, 2816, WSF(OFF_R2), 1024);
  }
  if (lo <= 16 && 16 + 1 < hi) cg::this_grid().sync();
  PH(17) if (lo <= 17 && 17 < hi) {
        rowop<true, false, false>(p, WSF(OFF_R2), p.n_post_ffn + 1024, 5, nullptr, 0, 0, 1, 1);
  }
}

extern "C" void kernel_launch(void* const* d_in, const int* in_sizes, int n_in, void* d_out, int out_size, void* d_ws,
                              size_t ws_size, hipStream_t stream) {
  P p{};
  const float** f = (const float**)&p;
  for (int i = 0; i < 33; ++i) f[i] = (const float*)d_in[i];
  p.out = (float*)d_out;
  p.ws = (char*)d_ws;
  static int grid_blocks = 0;
  if (!grid_blocks) {
    int dev = 0, cus = 0, per_cu = 0;
    hipGetDevice(&dev);
    hipDeviceGetAttribute(&cus, hipDeviceAttributeMultiprocessorCount, dev);
    hipOccupancyMaxActiveBlocksPerMultiprocessor(&per_cu, mega, 256, 0);
    if (per_cu > 2) per_cu = 2;
    if (per_cu < 1) per_cu = 1;
    grid_blocks = cus * per_cu;
  }
#if SINGLE_LAUNCH
  int lo = 0, hi = NPHASE;
  void* args[] = {&p, &lo, &hi};
  hipError_t e = hipLaunchCooperativeKernel((void*)mega, dim3(grid_blocks), dim3(256), args, 0, stream);
  if (e != hipSuccess) fprintf(stderr, "cooperative launch failed: %s (grid %d)\n", hipGetErrorString(e), grid_blocks);
#else
  for (int ph = 0; ph < NPHASE; ++ph) mega<<<grid_blocks, 256, 0, stream>>>(p, ph, ph + 1);
#endif
}
```

```cpp
#include <hip/hip_runtime.h>
#include <hip/hip_cooperative_groups.h>
#include <stdint.h>
#include <stdio.h>
namespace cg = cooperative_groups;

#ifndef SINGLE_LAUNCH
#define SINGLE_LAUNCH 1
#endif

typedef __attribute__((ext_vector_type(8))) short bf16x8;
typedef __attribute__((ext_vector_type(4))) float f32x4;
typedef unsigned short bf16_t;

#define DEVI __device__ __forceinline__

constexpr size_t OFF_WIN   = 0;
constexpr size_t OFF_WUQ   = OFF_WIN   + (size_t)2176*1024*2;
constexpr size_t OFF_WUKV  = OFF_WUQ   + (size_t)768*256*2;
constexpr size_t OFF_WOUT  = OFF_WUKV  + (size_t)1024*256*2;
constexpr size_t OFF_WPOOL = OFF_WOUT  + (size_t)1024*1024*2;
constexpr size_t OFF_WGU   = OFF_WPOOL + (size_t)4*256*256*2;
constexpr size_t OFF_WDN   = OFF_WGU   + (size_t)2*5632*1024*2;
constexpr size_t OFF_MOD   = OFF_WDN   + (size_t)2*1024*2816*2;
constexpr size_t OFF_R1    = OFF_MOD   + (size_t)2*3*6144*4;
constexpr size_t OFF_R2    = OFF_R1    + (size_t)8192*2096*4;
constexpr size_t OFF_H     = OFF_R2    + (size_t)8192*1024*4;
constexpr size_t OFF_CAT   = OFF_H     + (size_t)8192*1024*2;
constexpr size_t OFF_Q     = OFF_CAT   + (size_t)8192*1024*2;
constexpr size_t OFF_KN    = OFF_Q     + (size_t)8192*768*2;
constexpr size_t OFF_VT    = OFF_KN    + (size_t)8704*512*2;
constexpr size_t OFF_CQN   = OFF_VT    + (size_t)8704*512*2;
constexpr size_t OFF_CKV   = OFF_CQN   + (size_t)8192*256*2;
constexpr size_t OFF_KPE   = OFF_CKV   + (size_t)8704*256*2;
constexpr size_t OFF_XS    = OFF_KPE   + (size_t)8704*32*2;
constexpr size_t OFF_XST   = OFF_XS    + (size_t)8192*512*2;
constexpr size_t OFF_BM    = OFF_XST   + (size_t)8192*512*2;
constexpr size_t OFF_BT    = OFF_BM    + (size_t)8192*256*2;
constexpr size_t OFF_CM    = OFF_BT    + (size_t)8192*256*2;
constexpr size_t OFF_DTV   = OFF_CM    + (size_t)8192*256*2;
constexpr size_t OFF_CUM   = OFF_DTV   + (size_t)2*8192*8*4;
constexpr size_t OFF_TOT   = OFF_CUM   + (size_t)2*8192*8*4;
constexpr size_t OFF_BAR   = OFF_TOT   + 4096;
constexpr size_t OFF_END   = OFF_BAR   + 16384;

constexpr size_t OUT_CKV = 8388608, OUT_KR = 9437184, OUT_SF = 9568256, OUT_SB = 10616832;

struct P {
  const float *x_prompt, *x_sample, *c, *cache_ckv, *cache_kr, *st_f, *st_b, *c_ctx;
  const float *w_mod, *b_mod, *n_pre_mix, *n_post_mix, *n_pre_ffn, *n_post_ffn;
  const float *w_in, *q_norm, *w_uq, *kv_norm, *w_ukv, *conv_w, *conv_b, *dtb_f, *dtb_b, *alog_f, *alog_b;
  const float *ssd_d, *ssd_norm, *w_out, *pool_w, *pool_scale, *w_gate, *w_up, *w_down;
  float* out;
  char* ws;
};

#define WSB(off) ((bf16_t*)(p.ws + (off)))
#define WSF(off) ((float*)(p.ws + (off)))

DEVI bf16_t f2bf(float f) {
  unsigned u = __float_as_uint(f);
  u += 0x7fffu + ((u >> 16) & 1u);
  return (bf16_t)(u >> 16);
}
DEVI float bf2f(bf16_t b) { return __uint_as_float(((unsigned)b) << 16); }
DEVI unsigned pack2(float a, float b) { return (unsigned)f2bf(a) | ((unsigned)f2bf(b) << 16); }
DEVI float silu(float x) { return x / (1.f + __expf(-x)); }
DEVI float wave_sum(float v) {
#pragma unroll
  for (int o = 32; o > 0; o >>= 1) v += __shfl_xor(v, o, 64);
  return v;
}
DEVI f32x4 mfma16(bf16x8 a, bf16x8 b, f32x4 c) { return __builtin_amdgcn_mfma_f32_16x16x32_bf16(a, b, c, 0, 0, 0); }

DEVI float rope_freq(int m) { return exp2f(-(float)m * 1.6609640474436813f); }
DEVI void fast_sincos(float ang, float& sn, float& cs) {
  float rev = ang * 0.15915494309189535f;
  rev -= rintf(rev);
  sn = __builtin_amdgcn_sinf(rev);
  cs = __builtin_amdgcn_cosf(rev);
}
DEVI int swz_tile(int t, int T) {
  int q = T >> 3, r = T & 7, x = t & 7, off = t >> 3;
  return (x < r ? x * (q + 1) : r * (q + 1) + (x - r) * q) + off;
}

__shared__ __attribute__((aligned(16))) char g_smem[73728];
#define NOINL __device__ __forceinline__

constexpr int LDT = 72;
constexpr int TILE_E = 128 * LDT;

template <class Epi>
DEVI void gemm_tile(const bf16_t* __restrict__ A, int lda, const bf16_t* __restrict__ B, int ldb, int K,
                    int m0, int n0, char* smem, Epi epi) {
  const int tid = threadIdx.x, lane = tid & 63, wave = tid >> 6, wm = wave >> 1, wn = wave & 1;
  const int lr = lane & 15, lg = lane >> 4;
  bf16_t* sA = (bf16_t*)smem;
  bf16_t* sB = sA + 2 * TILE_E;
  f32x4 acc[4][4];
#pragma unroll
  for (int i = 0; i < 4; ++i)
#pragma unroll
    for (int j = 0; j < 4; ++j) acc[i][j] = (f32x4){0.f, 0.f, 0.f, 0.f};
  const int lrow = tid >> 3, lkc = (tid & 7) * 8;
  const bf16_t* gA = A + (size_t)(m0 + lrow) * lda + lkc;
  const bf16_t* gB = B + (size_t)(n0 + lrow) * ldb + lkc;
  uint4 ra[4], rb[4];
#pragma unroll
  for (int i = 0; i < 4; ++i) {
    ra[i] = *(const uint4*)(gA + (size_t)(32 * i) * lda);
    rb[i] = *(const uint4*)(gB + (size_t)(32 * i) * ldb);
  }
#pragma unroll
  for (int i = 0; i < 4; ++i) {
    *(uint4*)(sA + (lrow + 32 * i) * LDT + lkc) = ra[i];
    *(uint4*)(sB + (lrow + 32 * i) * LDT + lkc) = rb[i];
  }
  __syncthreads();
  const int nk = K >> 6;
  for (int kt = 0; kt < nk; ++kt) {
    const int cur = kt & 1;
    if (kt + 1 < nk) {
      const int k0 = (kt + 1) << 6;
#pragma unroll
      for (int i = 0; i < 4; ++i) {
        ra[i] = *(const uint4*)(gA + (size_t)(32 * i) * lda + k0);
        rb[i] = *(const uint4*)(gB + (size_t)(32 * i) * ldb + k0);
      }
    }
    const bf16_t* cA = sA + cur * TILE_E + (wm * 64 + lr) * LDT + lg * 8;
    const bf16_t* cB = sB + cur * TILE_E + (wn * 64 + lr) * LDT + lg * 8;
#pragma unroll
    for (int ks = 0; ks < 2; ++ks) {
      bf16x8 af[4], bfr[4];
#pragma unroll
      for (int i = 0; i < 4; ++i) {
        af[i] = *(const bf16x8*)(cA + i * 16 * LDT + ks * 32);
        bfr[i] = *(const bf16x8*)(cB + i * 16 * LDT + ks * 32);
      }
#pragma unroll
      for (int i = 0; i < 4; ++i)
#pragma unroll
        for (int j = 0; j < 4; ++j) acc[i][j] = mfma16(af[i], bfr[j], acc[i][j]);
    }
    if (kt + 1 < nk) {
      const int nx = cur ^ 1;
#pragma unroll
      for (int i = 0; i < 4; ++i) {
        *(uint4*)(sA + nx * TILE_E + (lrow + 32 * i) * LDT + lkc) = ra[i];
        *(uint4*)(sB + nx * TILE_E + (lrow + 32 * i) * LDT + lkc) = rb[i];
      }
    }
    __syncthreads();
  }
#pragma unroll
  for (int i = 0; i < 4; ++i)
#pragma unroll
    for (int j = 0; j < 4; j += 2)
      epi(m0 + wm * 64 + i * 16 + lg * 4, n0 + wn * 64 + j * 16 + lr, acc[i][j], acc[i][j + 1]);
}

DEVI void tile_mn(int t, int nM, int nN, int& m, int& n) {
  int id = swz_tile(t, nM * nN);
  int per = 8 * nN;
  int gq = id / per, rem = id - gq * per;
  int gsz = min(8, nM - gq * 8);
  m = gq * 8 + rem % gsz;
  n = rem / gsz;
}

NOINL void gemv_tile(const P& p, int t) {
  char* smem = g_smem;
  const int tid = threadIdx.x;
  float* sv = (float*)smem;
  float* red = sv + 3072;
  const int l = t / 192, n0 = (t % 192) * 32;
  for (int i = tid; i < 3072; i += 256) {
    int v = i >> 10, k = i & 1023;
    float cv = (v == 0) ? p.c_ctx[k] : p.c[(v - 1) * 1024 + k];
    sv[i] = cv / (1.f + expf(-cv));
  }
  __syncthreads();
  const int cgp = tid & 7, ks = tid >> 3;
  const float* w = p.w_mod + (size_t)l * 1024 * 6144 + n0 + cgp * 4;
  float a0[4] = {0, 0, 0, 0}, a1[4] = {0, 0, 0, 0}, a2[4] = {0, 0, 0, 0};
#pragma unroll 8
  for (int kk = 0; kk < 32; ++kk) {
    const int k = ks * 32 + kk;
    const float4 wv = *(const float4*)(w + (size_t)k * 6144);
    const float s0 = sv[k], s1 = sv[1024 + k], s2 = sv[2048 + k];
    a0[0] += s0 * wv.x; a0[1] += s0 * wv.y; a0[2] += s0 * wv.z; a0[3] += s0 * wv.w;
    a1[0] += s1 * wv.x; a1[1] += s1 * wv.y; a1[2] += s1 * wv.z; a1[3] += s1 * wv.w;
    a2[0] += s2 * wv.x; a2[1] += s2 * wv.y; a2[2] += s2 * wv.z; a2[3] += s2 * wv.w;
  }
#pragma unroll
  for (int j = 0; j < 4; ++j) {
    red[(ks * 3 + 0) * 32 + cgp * 4 + j] = a0[j];
    red[(ks * 3 + 1) * 32 + cgp * 4 + j] = a1[j];
    red[(ks * 3 + 2) * 32 + cgp * 4 + j] = a2[j];
  }
  __syncthreads();
  if (tid < 96) {
    const int v = tid >> 5, col = tid & 31;
    float s = 0.f;
    for (int q = 0; q < 32; ++q) s += red[(q * 3 + v) * 32 + col];
    s += p.b_mod[l * 6144 + n0 + col];
    WSF(OFF_MOD)[(l * 3 + v) * 6144 + n0 + col] = s;
  }
  __syncthreads();
}

NOINL void transpose_tile(const P& p, int t) {
  char* smem = g_smem;
  const int tid = threadIdx.x;
  const float* src; bf16_t* dst; int K, N, ntn, mode = 0;
  if (t < 544) { src = p.w_in; dst = WSB(OFF_WIN); K = 1024; N = 2096; ntn = 34; }
  else if ((t -= 544) < 48) { src = p.w_uq; dst = WSB(OFF_WUQ); K = 256; N = 768; ntn = 12; }
  else if ((t -= 48) < 64) { src = p.w_ukv; dst = WSB(OFF_WUKV); K = 256; N = 1024; ntn = 16; }
  else if ((t -= 64) < 256) { src = p.w_out; dst = WSB(OFF_WOUT); K = 1024; N = 1024; ntn = 16; }
  else if ((t -= 256) < 64) { int g = t >> 4; t &= 15; src = p.pool_w + (size_t)g * 65536; dst = WSB(OFF_WPOOL) + (size_t)g * 65536; K = 256; N = 256; ntn = 4; }
  else if ((t -= 64) < 1408) { int l = t / 704; t -= l * 704; src = p.w_gate + (size_t)l * 1024 * 2816; dst = WSB(OFF_WGU) + (size_t)l * 5632 * 1024; K = 1024; N = 2816; ntn = 44; mode = 1; }
  else if ((t -= 1408) < 1408) { int l = t / 704; t -= l * 704; src = p.w_up + (size_t)l * 1024 * 2816; dst = WSB(OFF_WGU) + (size_t)l * 5632 * 1024; K = 1024; N = 2816; ntn = 44; mode = 2; }
  else { t -= 1408; int l = t / 704; t -= l * 704; src = p.w_down + (size_t)l * 2816 * 1024; dst = WSB(OFF_WDN) + (size_t)l * 1024 * 2816; K = 2816; N = 1024; ntn = 16; }
  const int kt = t / ntn, nt_ = t - kt * ntn;
  const int k0 = kt * 64, n0 = nt_ * 64;
  float* tile = (float*)smem;
  {
    const int nn = tid & 63, kk0 = tid >> 6;
    const int n = n0 + nn;
#pragma unroll 4
    for (int i = 0; i < 16; ++i) {
      const int kk = kk0 + 4 * i;
      tile[kk * 65 + nn] = (n < N) ? src[(size_t)(k0 + kk) * N + n] : 0.f;
    }
  }
  __syncthreads();
#pragma unroll
  for (int i = 0; i < 2; ++i) {
    const int id = tid + 256 * i;
    const int nn = id >> 3, kc = id & 7;
    const int n = n0 + nn;
    uint4 pk;
    pk.x = pack2(tile[(kc * 8 + 0) * 65 + nn], tile[(kc * 8 + 1) * 65 + nn]);
    pk.y = pack2(tile[(kc * 8 + 2) * 65 + nn], tile[(kc * 8 + 3) * 65 + nn]);
    pk.z = pack2(tile[(kc * 8 + 4) * 65 + nn], tile[(kc * 8 + 5) * 65 + nn]);
    pk.w = pack2(tile[(kc * 8 + 6) * 65 + nn], tile[(kc * 8 + 7) * 65 + nn]);
    int drow = n;
    if (mode == 1) drow = (n >> 4) * 32 + (n & 15);
    else if (mode == 2) drow = (n >> 4) * 32 + 16 + (n & 15);
    *(uint4*)(dst + (size_t)drow * K + k0 + kc * 8) = pk;
  }
  __syncthreads();
}

template <bool UPD, bool MOD, bool FIRST>
DEVI void rowop(const P& p, const float* msrc, const float* wpost, int gate_idx, const float* wpre, int shift_idx,
                int scale_idx, int layer_g, int layer_m) {
  const int lane = threadIdx.x & 63, wave = threadIdx.x >> 6;
  const float* modg = WSF(OFF_MOD) + (size_t)layer_g * 3 * 6144;
  const float* modm = WSF(OFF_MOD) + (size_t)layer_m * 3 * 6144;
  bf16_t* hbuf = WSB(OFF_H);
  for (int r = blockIdx.x * 4 + wave; r < 8192; r += gridDim.x * 4) {
    const int v = r < 4096 ? 0 : 1 + ((r - 4096) >> 11);
    const float* mvg = modg + v * 6144;
    const float* mvm = modm + v * 6144;
    const float* xin = FIRST ? (r < 4096 ? p.x_prompt + (size_t)r * 1024 : p.x_sample + (size_t)(r - 4096) * 1024)
                             : p.out + (size_t)r * 1024;
    float4 x[4];
#pragma unroll
    for (int i = 0; i < 4; ++i) x[i] = *(const float4*)(xin + lane * 4 + 256 * i);
    if (UPD) {
      float4 m[4];
      float ss = 0.f;
#pragma unroll
      for (int i = 0; i < 4; ++i) {
        m[i] = *(const float4*)(msrc + (size_t)r * 1024 + lane * 4 + 256 * i);
        ss += m[i].x * m[i].x + m[i].y * m[i].y + m[i].z * m[i].z + m[i].w * m[i].w;
      }
      ss = wave_sum(ss);
      const float rs = rsqrtf(ss * (1.f / 1024.f) + 1e-6f);
#pragma unroll
      for (int i = 0; i < 4; ++i) {
        const int col = lane * 4 + 256 * i;
        const float4 wp = *(const float4*)(wpost + col);
        const float4 g = *(const float4*)(mvg + gate_idx * 1024 + col);
        x[i].x += g.x * (m[i].x * rs * wp.x);
        x[i].y += g.y * (m[i].y * rs * wp.y);
        x[i].z += g.z * (m[i].z * rs * wp.z);
        x[i].w += g.w * (m[i].w * rs * wp.w);
        *(float4*)(p.out + (size_t)r * 1024 + col) = x[i];
      }
    }
    if (MOD) {
      float ss = 0.f;
#pragma unroll
      for (int i = 0; i < 4; ++i) ss += x[i].x * x[i].x + x[i].y * x[i].y + x[i].z * x[i].z + x[i].w * x[i].w;
      ss = wave_sum(ss);
      const float rs = rsqrtf(ss * (1.f / 1024.f) + 1e-6f);
#pragma unroll
      for (int i = 0; i < 4; ++i) {
        const int col = lane * 4 + 256 * i;
        const float4 wp = *(const float4*)(wpre + col);
        const float4 sh = *(const float4*)(mvm + shift_idx * 1024 + col);
        const float4 sc = *(const float4*)(mvm + scale_idx * 1024 + col);
        uint2 o;
        o.x = pack2(x[i].x * rs * wp.x * (1.f + sc.x) + sh.x, x[i].y * rs * wp.y * (1.f + sc.y) + sh.y);
        o.y = pack2(x[i].z * rs * wp.z * (1.f + sc.z) + sh.z, x[i].w * rs * wp.w * (1.f + sc.w) + sh.w);
        *(uint2*)(hbuf + (size_t)r * 1024 + col) = o;
      }
    }
  }
}

NOINL void prep_rows(const P& p) {
  const int lane = threadIdx.x & 63, wave = threadIdx.x >> 6;
  const float* proj = WSF(OFF_R1);
  for (int r = blockIdx.x * 4 + wave; r < 8192; r += gridDim.x * 4) {
    const float* pr = proj + (size_t)r * 2096;
    const int kvrow = r < 4096 ? r : 4096 + ((r - 4096) >> 11) * 2304 + 256 + ((r - 4096) & 2047);
    {
      const float4 a = *(const float4*)(pr + lane * 4);
      float ss = wave_sum(a.x * a.x + a.y * a.y + a.z * a.z + a.w * a.w);
      const float rs = rsqrtf(ss * (1.f / 256.f) + 1e-6f);
      const float4 g = *(const float4*)(p.q_norm + lane * 4);
      uint2 o;
      o.x = pack2(a.x * rs * g.x, a.y * rs * g.y);
      o.y = pack2(a.z * rs * g.z, a.w * rs * g.w);
      *(uint2*)(WSB(OFF_CQN) + (size_t)r * 256 + lane * 4) = o;
    }
    {
      const float4 a = *(const float4*)(pr + 256 + lane * 4);
      float ss = wave_sum(a.x * a.x + a.y * a.y + a.z * a.z + a.w * a.w);
      const float rs = rsqrtf(ss * (1.f / 256.f) + 1e-6f);
      const float4 g = *(const float4*)(p.kv_norm + lane * 4);
      float4 vv;
      vv.x = a.x * rs * g.x; vv.y = a.y * rs * g.y; vv.z = a.z * rs * g.z; vv.w = a.w * rs * g.w;
      if (r < 4096) *(float4*)(p.out + OUT_CKV + (size_t)r * 256 + lane * 4) = vv;
      uint2 o;
      o.x = pack2(vv.x, vv.y);
      o.y = pack2(vv.z, vv.w);
      *(uint2*)(WSB(OFF_CKV) + (size_t)kvrow * 256 + lane * 4) = o;
    }
    {
      const float kv = (lane < 32) ? pr[512 + lane] : 0.f;
      const float partner = __shfl_xor(kv, 16, 64);
      if (r < 4096) {
        if (lane < 32) {
          p.out[OUT_KR + (size_t)r * 32 + lane] = kv;
          WSB(OFF_KPE)[(size_t)kvrow * 32 + lane] = f2bf(kv);
        }
      } else {
        const int t = (r - 4096) & 2047;
        const int ii = lane & 15;
        const float pos = (ii < 8) ? (float)(t >> 6) : (float)(t & 63);
        const float fr = rope_freq(ii & 7);
        const float ang = pos * fr;
        float cs, sn;
        fast_sincos(ang, sn, cs);
        const float o = (lane < 16) ? (kv * cs - partner * sn) : (partner * sn + kv * cs);
        if (lane < 32) WSB(OFF_KPE)[(size_t)kvrow * 32 + lane] = f2bf(o);
      }
    }
    if (lane < 16) {
      const int dir = lane >> 3, hh = lane & 7;
      const float raw = pr[2080 + lane] + (dir ? p.dtb_b[hh] : p.dtb_f[hh]);
      const float sp = raw > 20.f ? raw : log1pf(expf(raw));
      WSF(OFF_DTV)[((size_t)dir * 8192 + r) * 8 + hh] = sp;
    }
  }
}

NOINL void prep_cache(const P& p) {
  const int gt = blockIdx.x * 256 + threadIdx.x, gs = gridDim.x * 256;
  for (int i = gt; i < 2 * 256 * 256; i += gs) {
    int b = i >> 16, rem = i & 65535;
    WSB(OFF_CKV)[(size_t)(4096 + b * 2304) * 256 + rem] = f2bf(p.cache_ckv[i]);
  }
  for (int i = gt; i < 2 * 256 * 32; i += gs) {
    int b = i >> 13, rem = i & 8191;
    WSB(OFF_KPE)[(size_t)(4096 + b * 2304) * 32 + rem] = f2bf(p.cache_kr[i]);
  }
}

NOINL void conv_tile(const P& p, int t) {
  char* smem = g_smem;
  const int tid = threadIdx.x;
  float* sin_ = (float*)smem;
  float* sout = sin_ + 68 * 64;
  const int tt_ = t >> 4, ct = t & 15;
  const int r0 = tt_ * 64, c0 = ct * 64;
  int s0, s1;
  if (r0 < 4096) { s0 = r0 & ~255; s1 = s0 + 256; } else { s0 = 4096 + ((r0 - 4096) & ~2047); s1 = s0 + 2048; }
  const float* proj = WSF(OFF_R1);
  for (int i = tid; i < 68 * 64; i += 256) {
    const int rr = i >> 6, cc = i & 63;
    const int r = r0 - 2 + rr;
    float v = 0.f;
    if (r >= s0 && r < s1) v = proj[(size_t)r * 2096 + 1056 + c0 + cc];
    sin_[i] = v;
  }
  __syncthreads();
  {
    const int cc = tid & 63, tq = tid >> 6;
    const int c = c0 + cc;
    const float w0 = p.conv_w[c], w1 = p.conv_w[1024 + c], w2 = p.conv_w[2048 + c], w3 = p.conv_w[3072 + c],
                w4 = p.conv_w[4096 + c], bias = p.conv_b[c];
#pragma unroll 4
    for (int i = 0; i < 16; ++i) {
      const int tt = tq * 16 + i;
      float y = bias + w0 * sin_[tt * 64 + cc] + w1 * sin_[(tt + 1) * 64 + cc] + w2 * sin_[(tt + 2) * 64 + cc] +
                w3 * sin_[(tt + 3) * 64 + cc] + w4 * sin_[(tt + 4) * 64 + cc];
      y = y / (1.f + __expf(-y));
      sout[tt * 65 + cc] = y;
      const bf16_t b = f2bf(y);
      const size_t r = r0 + tt;
      if (c < 512) WSB(OFF_XS)[r * 512 + c] = b;
      else if (c < 768) WSB(OFF_BM)[r * 256 + (c - 512)] = b;
      else WSB(OFF_CM)[r * 256 + (c - 768)] = b;
    }
  }
  __syncthreads();
  if (c0 < 768) {
    const int cl = tid >> 2, q4 = tid & 3;
    uint4 o0, o1;
    const float* sp = sout + (q4 * 16) * 65 + cl;
    o0.x = pack2(sp[0 * 65], sp[1 * 65]);   o0.y = pack2(sp[2 * 65], sp[3 * 65]);
    o0.z = pack2(sp[4 * 65], sp[5 * 65]);   o0.w = pack2(sp[6 * 65], sp[7 * 65]);
    o1.x = pack2(sp[8 * 65], sp[9 * 65]);   o1.y = pack2(sp[10 * 65], sp[11 * 65]);
    o1.z = pack2(sp[12 * 65], sp[13 * 65]); o1.w = pack2(sp[14 * 65], sp[15 * 65]);
    bf16_t* dst = (c0 < 512) ? WSB(OFF_XST) + (size_t)(c0 + cl) * 8192 : WSB(OFF_BT) + (size_t)(c0 - 512 + cl) * 8192;
    dst += r0 + q4 * 16;
    *(uint4*)(dst) = o0;
    *(uint4*)(dst + 8) = o1;
  }
  __syncthreads();
}

NOINL void chunk_state_item(const P& p, int item) {
  char* smem = g_smem;
  const int tid = threadIdx.x, lane = tid & 63, wave = tid >> 6, lr = lane & 15, lg = lane >> 4;
  const int cidx = item >> 3, hh = item & 7, g = hh >> 2;
  const int r0 = cidx * 128;
  constexpr int LDS_ = 136;
  bf16_t* sAs = (bf16_t*)smem;
  bf16_t* sBs = sAs + 2 * 64 * LDS_;
  float* fa = (float*)(sBs + 128 * LDS_);
  float* fcum = fa + 256;
  float* fw = fa + 512;
  float* fdt = fa + 768;
  {
    const int dir = tid >> 7, j = tid & 127;
    const float dt = WSF(OFF_DTV)[((size_t)dir * 8192 + r0 + j) * 8 + hh];
    const float Aco = -expf(dir ? p.alog_b[hh] : p.alog_f[hh]);
    fa[tid] = dt * Aco;
    fdt[tid] = dt;
  }
  __syncthreads();
  {
    const int dir = tid >> 7, j = tid & 127;
    float s = 0.f;
    if (dir == 0) { for (int k = 0; k <= j; ++k) s += fa[k]; }
    else { for (int k = 127; k >= j; --k) s += fa[128 + k]; }
    fcum[tid] = s;
    WSF(OFF_CUM)[((size_t)dir * 8192 + r0 + j) * 8 + hh] = s;
  }
  __syncthreads();
  {
    const int dir = tid >> 7;
    const float ce = dir ? fcum[128] : fcum[127];
    fw[tid] = __expf(ce - fcum[tid]) * fdt[tid];
    if ((tid & 127) == 0) WSF(OFF_TOT)[(dir * 64 + cidx) * 8 + hh] = __expf(ce);
  }
  __syncthreads();
#pragma unroll
  for (int i = 0; i < 4; ++i) {
    const int id = tid + 256 * i;
    const int pp = id >> 4, jc = (id & 15) * 8;
    const uint4 raw = *(const uint4*)(WSB(OFF_XST) + (size_t)(hh * 64 + pp) * 8192 + r0 + jc);
    const unsigned rw[4] = {raw.x, raw.y, raw.z, raw.w};
    unsigned of[4], ob[4];
#pragma unroll
    for (int q = 0; q < 4; ++q) {
      const float x0 = __uint_as_float(rw[q] << 16), x1 = __uint_as_float(rw[q] & 0xffff0000u);
      of[q] = pack2(x0 * fw[jc + 2 * q], x1 * fw[jc + 2 * q + 1]);
      ob[q] = pack2(x0 * fw[128 + jc + 2 * q], x1 * fw[128 + jc + 2 * q + 1]);
    }
    *(uint4*)(sAs + pp * LDS_ + jc) = make_uint4(of[0], of[1], of[2], of[3]);
    *(uint4*)(sAs + 64 * LDS_ + pp * LDS_ + jc) = make_uint4(ob[0], ob[1], ob[2], ob[3]);
  }
#pragma unroll
  for (int i = 0; i < 8; ++i) {
    const int id = tid + 256 * i;
    const int nn = id >> 4, jc = (id & 15) * 8;
    *(uint4*)(sBs + nn * LDS_ + jc) = *(const uint4*)(WSB(OFF_BT) + (size_t)(g * 128 + nn) * 8192 + r0 + jc);
  }
  __syncthreads();
  {
    const int dir = wave >> 1, nh = wave & 1;
    f32x4 acc[4][4];
#pragma unroll
    for (int i = 0; i < 4; ++i)
#pragma unroll
      for (int j = 0; j < 4; ++j) acc[i][j] = (f32x4){0.f, 0.f, 0.f, 0.f};
    const bf16_t* cA = sAs + dir * 64 * LDS_ + lr * LDS_ + lg * 8;
    const bf16_t* cB = sBs + (nh * 64 + lr) * LDS_ + lg * 8;
#pragma unroll 1
    for (int ks = 0; ks < 4; ++ks) {
      bf16x8 af[4], bfr[4];
#pragma unroll
      for (int i = 0; i < 4; ++i) {
        af[i] = *(const bf16x8*)(cA + i * 16 * LDS_ + ks * 32);
        bfr[i] = *(const bf16x8*)(cB + i * 16 * LDS_ + ks * 32);
      }
#pragma unroll
      for (int i = 0; i < 4; ++i)
#pragma unroll
        for (int j = 0; j < 4; ++j) acc[i][j] = mfma16(af[i], bfr[j], acc[i][j]);
    }
    float* S = WSF(OFF_R2) + ((size_t)(dir * 64 + cidx) * 8 + hh) * 8192 + (lg * 4) * 128 + nh * 64 + lr;
#pragma unroll
    for (int i = 0; i < 4; ++i) {
#pragma unroll
      for (int q = 0; q < 4; ++q) {
#pragma unroll
        for (int j = 0; j < 4; ++j) S[j * 16] = acc[i][j][q];
        S += 128;
      }
      S += 12 * 128;
      __builtin_amdgcn_sched_barrier(0);
    }
  }
  __syncthreads();
}

NOINL void scan_states(const P& p) {
  const int total = 2 * 18 * 8 * 64 * 32;
  for (int idx = blockIdx.x * 256 + threadIdx.x; idx < total; idx += gridDim.x * 256) {
    const int n4 = idx & 31, pp = (idx >> 5) & 63, hh = (idx >> 11) & 7;
    const int sd = idx >> 14;
    const int s = sd % 18, dir = sd / 18;
    const int nc = s < 16 ? 2 : 16;
    const int cb = s < 16 ? s * 2 : 32 + (s - 16) * 16;
    float4 h = make_float4(0.f, 0.f, 0.f, 0.f);
    if (s >= 16) {
      const float* st = (dir ? p.st_b : p.st_f) + ((size_t)((s - 16) * 8 + hh) * 64 + pp) * 128 + n4 * 4;
      h = *(const float4*)st;
    }
    const size_t eoff = (size_t)pp * 128 + n4 * 4;
    for (int c = 0; c < nc; ++c) {
      const int cidx = cb + (dir ? nc - 1 - c : c);
      const size_t base = ((size_t)(dir * 64 + cidx) * 8 + hh) * 8192 + eoff;
      uint2 o;
      o.x = pack2(h.x, h.y);
      o.y = pack2(h.z, h.w);
      *(uint2*)(WSB(OFF_H) + base) = o;
      const float d = WSF(OFF_TOT)[(dir * 64 + cidx) * 8 + hh];
      const float4 sv = *(const float4*)(WSF(OFF_R2) + base);
      h.x = d * h.x + sv.x; h.y = d * h.y + sv.y; h.z = d * h.z + sv.z; h.w = d * h.w + sv.w;
    }
    if (s < 16) {
      float* o = p.out + (dir ? OUT_SB : OUT_SF) + ((size_t)(s * 8 + hh) * 64 + pp) * 128 + n4 * 4;
      *(float4*)o = h;
    }
  }
}

NOINL void attn_item(const P& p, int id) {
  char* smem = g_smem;
  const int tid = threadIdx.x, lane = tid & 63, wave = tid >> 6, lr = lane & 15, lg = lane >> 4;
  int row0, kvbase, Lk, hh;
  if (id < 512) { const int b = id >> 8; hh = (id >> 5) & 7; const int qb = id & 31; row0 = 4096 + b * 2048 + qb * 64; kvbase = 4096 + b * 2304; Lk = 2304; }
  else { const int i2 = id - 512; const int b = i2 >> 5; hh = (i2 >> 2) & 7; const int qb = i2 & 3; row0 = b * 256 + qb * 64; kvbase = b * 256; Lk = 256; }
  constexpr int LDK = 104, LDV = 72;
  bf16_t* sK = (bf16_t*)smem;
  bf16_t* sV = sK + 64 * LDK;
  const int qrow = row0 + wave * 16 + lr;
  bf16x8 qf[3];
#pragma unroll
  for (int ks = 0; ks < 3; ++ks) qf[ks] = *(const bf16x8*)(WSB(OFF_Q) + (size_t)qrow * 768 + hh * 96 + ks * 32 + lg * 8);
  f32x4 oacc[4];
#pragma unroll
  for (int i = 0; i < 4; ++i) oacc[i] = (f32x4){0.f, 0.f, 0.f, 0.f};
  float mrun = -1e30f, lrun = 0.f;
  const int nkt = Lk >> 6;
  for (int kt = 0; kt < nkt; ++kt) {
    const int kr0 = kvbase + kt * 64;
#pragma unroll
    for (int i = 0; i < 3; ++i) {
      const int c = tid + 256 * i;
      const int key = c / 12, cc = c - key * 12;
      const bf16_t* src = (cc < 8) ? WSB(OFF_KN) + (size_t)(kr0 + key) * 512 + hh * 64 + cc * 8
                                   : WSB(OFF_KPE) + (size_t)(kr0 + key) * 32 + (cc - 8) * 8;
      *(uint4*)(sK + key * LDK + cc * 8) = *(const uint4*)src;
    }
#pragma unroll
    for (int i = 0; i < 2; ++i) {
      const int c = tid + 256 * i;
      const int d = c >> 3, cc = c & 7;
      *(uint4*)(sV + d * LDV + cc * 8) = *(const uint4*)(WSB(OFF_VT) + (size_t)(hh * 64 + d) * 8704 + kr0 + cc * 8);
    }
    __syncthreads();
    f32x4 sacc[4];
#pragma unroll
    for (int n = 0; n < 4; ++n) sacc[n] = (f32x4){0.f, 0.f, 0.f, 0.f};
#pragma unroll
    for (int ks = 0; ks < 3; ++ks)
#pragma unroll
      for (int n = 0; n < 4; ++n) {
        const bf16x8 a = *(const bf16x8*)(sK + (n * 16 + lr) * LDK + ks * 32 + lg * 8);
        sacc[n] = mfma16(a, qf[ks], sacc[n]);
      }
    float mx = sacc[0][0];
#pragma unroll
    for (int n = 0; n < 4; ++n)
#pragma unroll
      for (int q = 0; q < 4; ++q) mx = fmaxf(mx, sacc[n][q]);
    mx = fmaxf(mx, __shfl_xor(mx, 16, 64));
    mx = fmaxf(mx, __shfl_xor(mx, 32, 64));
    const float mnew = fmaxf(mrun, mx);
    const float alpha = __expf(mrun - mnew);
    mrun = mnew;
    float ps = 0.f;
#pragma unroll
    for (int n = 0; n < 4; ++n)
#pragma unroll
      for (int q = 0; q < 4; ++q) { const float e = __expf(sacc[n][q] - mnew); sacc[n][q] = e; ps += e; }
    lrun = lrun * alpha + ps;
#pragma unroll
    for (int i = 0; i < 4; ++i)
#pragma unroll
      for (int q = 0; q < 4; ++q) oacc[i][q] *= alpha;
#pragma unroll
    for (int ks = 0; ks < 2; ++ks) {
      union { bf16x8 v; unsigned u[4]; } pf;
      pf.u[0] = pack2(sacc[2 * ks][0], sacc[2 * ks][1]);
      pf.u[1] = pack2(sacc[2 * ks][2], sacc[2 * ks][3]);
      pf.u[2] = pack2(sacc[2 * ks + 1][0], sacc[2 * ks + 1][1]);
      pf.u[3] = pack2(sacc[2 * ks + 1][2], sacc[2 * ks + 1][3]);
#pragma unroll
      for (int m = 0; m < 4; ++m) {
        union { bf16x8 v; uint2 h[2]; } av;
        const bf16_t* vp = sV + (m * 16 + lr) * LDV + ks * 32 + lg * 4;
        av.h[0] = *(const uint2*)(vp);
        av.h[1] = *(const uint2*)(vp + 16);
        oacc[m] = mfma16(av.v, pf.v, oacc[m]);
      }
    }
    __syncthreads();
  }
  lrun += __shfl_xor(lrun, 16, 64);
  lrun += __shfl_xor(lrun, 32, 64);
  const float inv = 1.f / lrun;
#pragma unroll
  for (int m = 0; m < 4; ++m) {
    uint2 o;
    o.x = pack2(oacc[m][0] * inv, oacc[m][1] * inv);
    o.y = pack2(oacc[m][2] * inv, oacc[m][3] * inv);
    *(uint2*)(WSB(OFF_CAT) + (size_t)qrow * 1024 + hh * 64 + m * 16 + lg * 4) = o;
  }
}

NOINL void ssd_y_item(const P& p, int item) {
  char* smem = g_smem;
  const int tid = threadIdx.x, lane = tid & 63, wave = tid >> 6, lr = lane & 15, lg = lane >> 4;
  const int cidx = item >> 2, half = (item >> 1) & 1, g = item & 1;
  const int r0 = cidx * 128;
  const int hh = g * 4 + wave;
  constexpr int LDC = 136, LDM = 72;
  bf16_t* sC = (bf16_t*)smem;
  bf16_t* sB = sC + 64 * LDC;
  bf16_t* sM = sB + 64 * LDC + wave * 64 * LDM;
  float* rowss = (float*)((bf16_t*)smem + 2 * 64 * LDC + 4 * 64 * LDM);
  const float* cum = WSF(OFF_CUM);
  const float* dtv = WSF(OFF_DTV);
#pragma unroll
  for (int i = 0; i < 4; ++i) {
    const int id = tid + 256 * i;
    const int rr = id >> 4, nc = (id & 15) * 8;
    *(uint4*)(sC + rr * LDC + nc) = *(const uint4*)(WSB(OFF_CM) + (size_t)(r0 + half * 64 + rr) * 256 + g * 128 + nc);
  }
  f32x4 Y[4][4];
#pragma unroll
  for (int i = 0; i < 4; ++i)
#pragma unroll
    for (int j = 0; j < 4; ++j) Y[i][j] = (f32x4){0.f, 0.f, 0.f, 0.f};
#pragma unroll 1
  for (int jh = 0; jh < 2; ++jh) {
    __syncthreads();
#pragma unroll
    for (int i = 0; i < 4; ++i) {
      const int id = tid + 256 * i;
      const int rr = id >> 4, nc = (id & 15) * 8;
      *(uint4*)(sB + rr * LDC + nc) = *(const uint4*)(WSB(OFF_BM) + (size_t)(r0 + jh * 64 + rr) * 256 + g * 128 + nc);
    }
    __syncthreads();
#pragma unroll 1
    for (int dir = 0; dir < 2; ++dir) {
      const bool use = dir == 0 ? (jh <= half) : (jh >= half);
      if (!use) continue;
      float cj[4], dj[4];
#pragma unroll
      for (int j = 0; j < 4; ++j) {
        const size_t tj = (size_t)dir * 8192 + r0 + jh * 64 + j * 16 + lr;
        cj[j] = cum[tj * 8 + hh];
        dj[j] = dtv[tj * 8 + hh];
      }
#pragma unroll
      for (int i = 0; i < 4; ++i) {
        f32x4 cb[4];
#pragma unroll
        for (int j = 0; j < 4; ++j) cb[j] = (f32x4){0.f, 0.f, 0.f, 0.f};
#pragma unroll 1
        for (int ks = 0; ks < 4; ++ks) {
          const bf16x8 a = *(const bf16x8*)(sC + (i * 16 + lr) * LDC + ks * 32 + lg * 8);
#pragma unroll
          for (int j = 0; j < 4; ++j) {
            const bf16x8 b = *(const bf16x8*)(sB + (j * 16 + lr) * LDC + ks * 32 + lg * 8);
            cb[j] = mfma16(a, b, cb[j]);
          }
        }
#pragma unroll
        for (int q = 0; q < 4; ++q) {
          const int il = i * 16 + lg * 4 + q;
          const int ti = half * 64 + il;
          const float ci = cum[((size_t)dir * 8192 + r0 + ti) * 8 + hh];
#pragma unroll
          for (int j = 0; j < 4; ++j) {
            const int tj = jh * 64 + j * 16 + lr;
            const bool ok = dir == 0 ? (tj <= ti) : (tj >= ti);
            const float val = ok ? cb[j][q] * __expf(ci - cj[j]) * dj[j] : 0.f;
            sM[il * LDM + j * 16 + lr] = f2bf(val);
          }
        }
        __builtin_amdgcn_sched_barrier(0);
      }
      __syncthreads();
#pragma unroll 1
      for (int ks = 0; ks < 2; ++ks) {
        bf16x8 af[4], bfr[4];
#pragma unroll
        for (int i = 0; i < 4; ++i) {
          af[i] = *(const bf16x8*)(sM + (i * 16 + lr) * LDM + ks * 32 + lg * 8);
          bfr[i] = *(const bf16x8*)(WSB(OFF_XST) + (size_t)(hh * 64 + i * 16 + lr) * 8192 + r0 + jh * 64 + ks * 32 + lg * 8);
        }
#pragma unroll
        for (int i = 0; i < 4; ++i)
#pragma unroll
          for (int j = 0; j < 4; ++j) Y[i][j] = mfma16(af[i], bfr[j], Y[i][j]);
      }
      __syncthreads();
    }
  }
#pragma unroll 1
  for (int dir = 0; dir < 2; ++dir) {
    const bf16_t* hp = WSB(OFF_H) + ((size_t)(dir * 64 + cidx) * 8 + hh) * 8192;
#pragma unroll
    for (int i = 0; i < 4; ++i) {
      f32x4 T[4];
#pragma unroll
      for (int j = 0; j < 4; ++j) T[j] = (f32x4){0.f, 0.f, 0.f, 0.f};
#pragma unroll 1
      for (int ks = 0; ks < 4; ++ks) {
        const bf16x8 a = *(const bf16x8*)(sC + (i * 16 + lr) * LDC + ks * 32 + lg * 8);
#pragma unroll
        for (int j = 0; j < 4; ++j) {
          const bf16x8 b = *(const bf16x8*)(hp + (size_t)(j * 16 + lr) * 128 + ks * 32 + lg * 8);
          T[j] = mfma16(a, b, T[j]);
        }
      }
#pragma unroll
      for (int q = 0; q < 4; ++q) {
        const int ti = half * 64 + i * 16 + lg * 4 + q;
        const float e = __expf(cum[((size_t)dir * 8192 + r0 + ti) * 8 + hh]);
#pragma unroll
        for (int j = 0; j < 4; ++j) Y[i][j][q] += e * T[j][q];
      }
      __builtin_amdgcn_sched_barrier(0);
    }
  }
  const float dsk = p.ssd_d[hh];
  const float* proj = WSF(OFF_R1);
#pragma unroll
  for (int i = 0; i < 4; ++i)
#pragma unroll
    for (int q = 0; q < 4; ++q) {
      const int il = i * 16 + lg * 4 + q;
      const size_t r = (size_t)r0 + half * 64 + il;
      float ss = 0.f;
#pragma unroll
      for (int j = 0; j < 4; ++j) {
        const int ch = hh * 64 + j * 16 + lr;
        const float xs = bf2f(WSB(OFF_XS)[r * 512 + ch]);
        const float z = proj[r * 2096 + 544 + ch];
        const float y = (Y[i][j][q] + dsk * xs) * silu(z);
        Y[i][j][q] = y;
        ss += y * y;
      }
      ss += __shfl_xor(ss, 1, 64);
      ss += __shfl_xor(ss, 2, 64);
      ss += __shfl_xor(ss, 4, 64);
      ss += __shfl_xor(ss, 8, 64);
      if (lr == 0) rowss[wave * 64 + il] = ss;
      __builtin_amdgcn_sched_barrier(0);
    }
  __syncthreads();
#pragma unroll
  for (int i = 0; i < 4; ++i)
#pragma unroll
    for (int q = 0; q < 4; ++q) {
      const int il = i * 16 + lg * 4 + q;
      const size_t r = (size_t)r0 + half * 64 + il;
      const float tot = rowss[il] + rowss[64 + il] + rowss[128 + il] + rowss[192 + il];
      const float rs = rsqrtf(tot * (1.f / 256.f) + 1e-6f);
#pragma unroll
      for (int j = 0; j < 4; ++j) {
        const int ch = hh * 64 + j * 16 + lr;
        WSB(OFF_CAT)[r * 1024 + 512 + ch] = f2bf(Y[i][j][q] * rs * p.ssd_norm[ch]);
      }
    }
  __syncthreads();
}

NOINL void pool_phase(const P& p) {
  const bf16_t* h = WSB(OFF_H);
  bf16_t* dst = WSB(OFF_CAT);
  const int total = 8192 * 128;
  for (int idx = blockIdx.x * 256 + threadIdx.x; idx < total; idx += gridDim.x * 256) {
    const int r = idx >> 7, cc = (idx & 127) * 8;
    int s0, L;
    if (r < 4096) { s0 = r & ~255; L = 256; } else { s0 = 4096 + ((r - 4096) & ~2047); L = 2048; }
    const int t = r - s0;
    const int w2 = 1 << (cc >> 8);
    const int lo = max(t - w2, 0), hi = min(t + w2, L);
    float acc[8] = {0, 0, 0, 0, 0, 0, 0, 0};
    for (int u = lo; u < hi; ++u) {
      const uint4 v = *(const uint4*)(h + (size_t)(s0 + u) * 1024 + cc);
      acc[0] += __uint_as_float(v.x << 16); acc[1] += __uint_as_float(v.x & 0xffff0000u);
      acc[2] += __uint_as_float(v.y << 16); acc[3] += __uint_as_float(v.y & 0xffff0000u);
      acc[4] += __uint_as_float(v.z << 16); acc[5] += __uint_as_float(v.z & 0xffff0000u);
      acc[6] += __uint_as_float(v.w << 16); acc[7] += __uint_as_float(v.w & 0xffff0000u);
    }
    const float inv = 1.f / (float)(hi - lo);
    const uint4 v = *(const uint4*)(h + (size_t)r * 1024 + cc);
    uint4 o;
    o.x = pack2(acc[0] * inv - __uint_as_float(v.x << 16), acc[1] * inv - __uint_as_float(v.x & 0xffff0000u));
    o.y = pack2(acc[2] * inv - __uint_as_float(v.y << 16), acc[3] * inv - __uint_as_float(v.y & 0xffff0000u));
    o.z = pack2(acc[4] * inv - __uint_as_float(v.z << 16), acc[5] * inv - __uint_as_float(v.z & 0xffff0000u));
    o.w = pack2(acc[6] * inv - __uint_as_float(v.w << 16), acc[7] * inv - __uint_as_float(v.w & 0xffff0000u));
    *(uint4*)(dst + (size_t)r * 1024 + cc) = o;
  }
}

NOINL void ph_gemm_proj(const P& p) {
  char* smem = g_smem;
  float* proj = WSF(OFF_R1);
  const int nM = 64, nN = 17;
  for (int t = blockIdx.x; t < nM * nN; t += gridDim.x) {
    int m, n; tile_mn(t, nM, nN, m, n);
    gemm_tile(WSB(OFF_H), 1024, WSB(OFF_WIN), 1024, 1024, m * 128, n * 128, smem,
      [&](int row, int col, f32x4 v0, f32x4 v1) {
#pragma unroll
        for (int q = 0; q < 4; ++q) {
          if (col < 2096) proj[(size_t)(row + q) * 2096 + col] = v0[q];
          if (col + 16 < 2096) proj[(size_t)(row + q) * 2096 + col + 16] = v1[q];
        }
      });
  }
}

NOINL void ph_gemm_f32out(const P& p, const bf16_t* A, int lda, const bf16_t* B, int ldb, int K, float* C, int N) {
  char* smem = g_smem;
  const int nM = 64, nN = N / 128;
  for (int t = blockIdx.x; t < nM * nN; t += gridDim.x) {
    int m, n; tile_mn(t, nM, nN, m, n);
    gemm_tile(A, lda, B, ldb, K, m * 128, n * 128, smem,
      [&](int row, int col, f32x4 v0, f32x4 v1) {
#pragma unroll
        for (int q = 0; q < 4; ++q) {
          C[(size_t)(row + q) * N + col] = v0[q];
          C[(size_t)(row + q) * N + col + 16] = v1[q];
        }
      });
  }
}

NOINL void ph_gemm_q(const P& p, int t) {
  char* smem = g_smem;
  int m, n; tile_mn(t, 64, 6, m, n);
  bf16_t* qo = WSB(OFF_Q);
  gemm_tile(WSB(OFF_CQN), 256, WSB(OFF_WUQ), 256, 256, m * 128, n * 128, smem,
    [&](int row, int col, f32x4 v0, f32x4 v1) {
      const float scl = 0.10206207261596575f;
      const int tn = col >> 4;
      const bool rope = ((tn % 6) == 4) && (row >= 4096);
      const int ii = col & 15;
      const float fr = rope_freq(ii & 7);
#pragma unroll
      for (int q = 0; q < 4; ++q) {
        float a = v0[q], b = v1[q];
        if (rope) {
          const int tt = (row + q - 4096) & 2047;
          const float pos = (ii < 8) ? (float)(tt >> 6) : (float)(tt & 63);
          const float ang = pos * fr;
          float cs, sn;
          fast_sincos(ang, sn, cs);
          const float x1 = a, x2 = b;
          a = x1 * cs - x2 * sn;
          b = x1 * sn + x2 * cs;
        }
        qo[(size_t)(row + q) * 768 + col] = f2bf(a * scl);
        qo[(size_t)(row + q) * 768 + col + 16] = f2bf(b * scl);
      }
    });
}

NOINL void ph_gemm_kv(const P& p, int t) {
  char* smem = g_smem;
  int m, n; tile_mn(t, 68, 8, m, n);
  bf16_t* kn = WSB(OFF_KN);
  bf16_t* vt = WSB(OFF_VT);
  gemm_tile(WSB(OFF_CKV), 256, WSB(OFF_WUKV), 256, 256, m * 128, n * 128, smem,
    [&](int row, int col, f32x4 v0, f32x4 v1) {
      const int hh = col >> 7, j = col & 127;
      if (j < 64) {
#pragma unroll
        for (int q = 0; q < 4; ++q) {
          kn[(size_t)(row + q) * 512 + hh * 64 + j] = f2bf(v0[q]);
          kn[(size_t)(row + q) * 512 + hh * 64 + j + 16] = f2bf(v1[q]);
        }
      } else {
        uint2 o0, o1;
        o0.x = pack2(v0[0], v0[1]); o0.y = pack2(v0[2], v0[3]);
        o1.x = pack2(v1[0], v1[1]); o1.y = pack2(v1[2], v1[3]);
        *(uint2*)(vt + (size_t)(hh * 64 + j - 64) * 8704 + row) = o0;
        *(uint2*)(vt + (size_t)(hh * 64 + j - 64 + 16) * 8704 + row) = o1;
      }
    });
}

NOINL void ph_gemm_ffn_up(const P& p, int layer) {
  char* smem = g_smem;
  bf16_t* gu = WSB(OFF_R1);
  const bf16_t* B = WSB(OFF_WGU) + (size_t)layer * 5632 * 1024;
  const int nM = 64, nN = 44;
  for (int t = blockIdx.x; t < nM * nN; t += gridDim.x) {
    int m, n; tile_mn(t, nM, nN, m, n);
    gemm_tile(WSB(OFF_H), 1024, B, 1024, 1024, m * 128, n * 128, smem,
      [&](int row, int col, f32x4 v0, f32x4 v1) {
        const int oc = (col >> 5) * 16 + (col & 15);
#pragma unroll
        for (int q = 0; q < 4; ++q) gu[(size_t)(row + q) * 2816 + oc] = f2bf(silu(v0[q]) * v1[q]);
      });
  }
}

NOINL void ph_gemm_pool(const P& p) {
  char* smem = g_smem;
  float* mix = WSF(OFF_R1);
  for (int t = blockIdx.x; t < 512; t += gridDim.x) {
    const int id = swz_tile(t, 512);
    const int g = id >> 7, rem = id & 127;
    const int m = rem >> 1, n = rem & 1;
    gemm_tile(WSB(OFF_CAT) + g * 256, 1024, WSB(OFF_WPOOL) + (size_t)g * 65536, 256, 256, m * 128, n * 128, smem,
      [&](int row, int col, f32x4 v0, f32x4 v1) {
        const int c0 = g * 256 + col;
        const float s0 = p.pool_scale[c0], s1 = p.pool_scale[c0 + 16];
#pragma unroll
        for (int q = 0; q < 4; ++q) {
          mix[(size_t)(row + q) * 1024 + c0] = v0[q] * s0;
          mix[(size_t)(row + q) * 1024 + c0 + 16] = v1[q] * s1;
        }
      });
  }
}


#define XB_TMO      128
#define XB_XCNT(j)  (256  + 64 * (j))
#define XB_XSUB(j)  (1280 + 64 * (j))
#define XB_XGEN(j)  (2304 + 64 * (j))
#define XB_TOP      3328
#define XB_TOPGEN   3392
#define XCD_BAR_WORDS 3456
#define XB_SPIN_CAP (1u << 22)
#define LAS __attribute__((address_space(3)))
DEVI unsigned xb_ld(unsigned* p) { return __hip_atomic_load(p, __ATOMIC_RELAXED, __HIP_MEMORY_SCOPE_AGENT); }
DEVI unsigned xb_add(unsigned* p, unsigned v) { return __hip_atomic_fetch_add(p, v, __ATOMIC_RELAXED, __HIP_MEMORY_SCOPE_AGENT); }
DEVI unsigned xb_xcc_id() { return (unsigned)__builtin_amdgcn_s_getreg((3 << 11) | 20) & 0xFu; }
#define XB_SPIN(cond, bar) do { unsigned _sp = 0; while (cond) { __builtin_amdgcn_s_sleep(1); \
    if ((++_sp & 255u) == 0u) { if (xb_ld(&(bar)[XB_TMO])) break; if (_sp > XB_SPIN_CAP) { atomicAdd(&(bar)[XB_TMO], 1u); break; } } } } while (0)
struct XcdBarrier { unsigned* bar; unsigned x; volatile LAS unsigned* st; };
DEVI XcdBarrier xcd_barrier_post(unsigned* bar, volatile LAS unsigned* st) {
  XcdBarrier b; b.bar = bar; b.x = xb_xcc_id(); b.st = st;
  if (threadIdx.x == 0) (void)xb_add(&bar[XB_XCNT(b.x)], 1u);
  return b;
}
DEVI void xcd_barrier_complete(unsigned* bar, unsigned x, unsigned& nloc, unsigned& nx) {
  const unsigned G = gridDim.x * gridDim.y * gridDim.z;
  unsigned sum, cnt, mine, sp = 0u;
  for (;;) {
    sum = 0u; cnt = 0u; mine = 0u;
#pragma unroll
    for (unsigned j = 0; j < 16; ++j) { const unsigned c = xb_ld(&bar[XB_XCNT(j)]); sum += c; cnt += (c > 0u) ? 1u : 0u; mine = (j == x) ? c : mine; }
    if (sum == G) break;
    __builtin_amdgcn_s_sleep(1);
    if ((++sp & 255u) == 0u) { if (xb_ld(&bar[XB_TMO])) break; if (sp > XB_SPIN_CAP) { atomicAdd(&bar[XB_TMO], 1u); break; } }
  }
  nloc = mine > 0u ? mine : 1u; nx = cnt > 0u ? cnt : 1u;
}
DEVI void xcd_barrier(const XcdBarrier& b) {
  asm volatile("s_waitcnt vmcnt(0)" ::: "memory");
  __syncthreads();
  if (threadIdx.x == 0) {
    unsigned* bar = b.bar;
    __builtin_amdgcn_s_waitcnt(0);
    unsigned nloc = b.st[0], nx = b.st[1];
    if (nloc == 0u) { xcd_barrier_complete(bar, b.x, nloc, nx); b.st[0] = nloc; b.st[1] = nx; }
    const unsigned old = xb_add(&bar[XB_XSUB(b.x)], 1u);
    const unsigned gen = old / nloc;
    if (old + 1u == (gen + 1u) * nloc) {
      __builtin_amdgcn_fence(__ATOMIC_RELEASE, "agent");
      asm volatile("s_waitcnt vmcnt(0)" ::: "memory");
      const unsigned og = xb_add(&bar[XB_TOP], 1u);
      const unsigned tg = og / nx;
      if (og + 1u == (tg + 1u) * nx) xb_add(&bar[XB_TOPGEN], 1u);
      else XB_SPIN(xb_ld(&bar[XB_TOPGEN]) == tg, bar);
      __builtin_amdgcn_fence(__ATOMIC_ACQUIRE, "agent");
      xb_add(&bar[XB_XGEN(b.x)], 1u);
      asm volatile("s_waitcnt vmcnt(0)" ::: "memory");
    } else {
      XB_SPIN(xb_ld(&bar[XB_XGEN(b.x)]) == gen, bar);
      __builtin_amdgcn_fence(__ATOMIC_ACQUIRE, "agent");
      asm volatile("s_waitcnt vmcnt(0)" ::: "memory");
    }
  }
  __syncthreads();
}

constexpr int NPHASE = 18;
#ifndef PHMASK
#define PHMASK 0x3ffff
#endif
#define PH(n) if constexpr ((PHMASK >> (n)) & 1)

__global__ void __launch_bounds__(256, 2) mega(P p, int lo, int hi) {
  __shared__ uint4 xb_words;
  if (threadIdx.x == 0) xb_words = make_uint4(0u, 0u, 0u, 0u);
  __syncthreads();
  XcdBarrier xb = xcd_barrier_post((unsigned*)(p.ws + OFF_BAR), (volatile LAS unsigned*)&xb_words);
  if (lo < 0) cg::this_grid().sync();
  PH(0) if (lo <= 0 && 0 < hi) {
        for (int t = blockIdx.x; t < 384 + 5200; t += gridDim.x) {
          if (t < 384) gemv_tile(p, t); else transpose_tile(p, t - 384);
        }
  }
  if (lo <= 0 && 0 + 1 < hi) xcd_barrier(xb);
  PH(1) if (lo <= 1 && 1 < hi) {
        rowop<false, true, true>(p, nullptr, nullptr, 0, p.n_pre_mix, 0, 1, 0, 0);
  }
  if (lo <= 1 && 1 + 1 < hi) xcd_barrier(xb);
  PH(2) if (lo <= 2 && 2 < hi) {
        ph_gemm_proj(p);
  }
  if (lo <= 2 && 2 + 1 < hi) xcd_barrier(xb);
  PH(3) if (lo <= 3 && 3 < hi) {
        prep_rows(p);
        prep_cache(p);
        for (int t = blockIdx.x; t < 2048; t += gridDim.x) conv_tile(p, t);
  }
  if (lo <= 3 && 3 + 1 < hi) xcd_barrier(xb);
  PH(4) if (lo <= 4 && 4 < hi) {
        for (int t = blockIdx.x; t < 384 + 544 + 512; t += gridDim.x) {
#ifndef P4SEL
#define P4SEL 7
#endif
          if (t < 384) { if constexpr (P4SEL & 1) ph_gemm_q(p, t); }
          else if (t < 928) { if constexpr (P4SEL & 2) ph_gemm_kv(p, t - 384); }
          else { if constexpr (P4SEL & 4) chunk_state_item(p, t - 928); }
        }
  }
  if (lo <= 4 && 4 + 1 < hi) xcd_barrier(xb);
  PH(5) if (lo <= 5 && 5 < hi) {
        scan_states(p);
  }
  if (lo <= 5 && 5 + 1 < hi) xcd_barrier(xb);
  PH(6) if (lo <= 6 && 6 < hi) {
        for (int t = blockIdx.x; t < 1024 + 256; t += gridDim.x) {
#ifndef P6SEL
#define P6SEL 3
#endif
          if (t < 1024) { if constexpr (P6SEL & 1) attn_item(p, t); } else { if constexpr (P6SEL & 2) ssd_y_item(p, t - 1024); }
        }
  }
  if (lo <= 6 && 6 + 1 < hi) xcd_barrier(xb);
  PH(7) if (lo <= 7 && 7 < hi) {
        ph_gemm_f32out(p, WSB(OFF_CAT), 1024, WSB(OFF_WOUT), 1024, 1024, WSF(OFF_R1), 1024);
  }
  if (lo <= 7 && 7 + 1 < hi) xcd_barrier(xb);
  PH(8) if (lo <= 8 && 8 < hi) {
        rowop<true, true, true>(p, WSF(OFF_R1), p.n_post_mix, 2, p.n_pre_ffn, 3, 4, 0, 0);
  }
  if (lo <= 8 && 8 + 1 < hi) xcd_barrier(xb);
  PH(9) if (lo <= 9 && 9 < hi) {
        ph_gemm_ffn_up(p, 0);
  }
  if (lo <= 9 && 9 + 1 < hi) xcd_barrier(xb);
  PH(10) if (lo <= 10 && 10 < hi) {
        ph_gemm_f32out(p, WSB(OFF_R1), 2816, WSB(OFF_WDN), 2816, 2816, WSF(OFF_R2), 1024);
  }
  if (lo <= 10 && 10 + 1 < hi) xcd_barrier(xb);
  PH(11) if (lo <= 11 && 11 < hi) {
        rowop<true, true, false>(p, WSF(OFF_R2), p.n_post_ffn, 5, p.n_pre_mix + 1024, 0, 1, 0, 1);
  }
  if (lo <= 11 && 11 + 1 < hi) xcd_barrier(xb);
  PH(12) if (lo <= 12 && 12 < hi) {
        pool_phase(p);
  }
  if (lo <= 12 && 12 + 1 < hi) xcd_barrier(xb);
  PH(13) if (lo <= 13 && 13 < hi) {
        ph_gemm_pool(p);
  }
  if (lo <= 13 && 13 + 1 < hi) xcd_barrier(xb);
  PH(14) if (lo <= 14 && 14 < hi) {
        rowop<true, true, false>(p, WSF(OFF_R1), p.n_post_mix + 1024, 2, p.n_pre_ffn + 1024, 3, 4, 1, 1);
  }
  if (lo <= 14 && 14 + 1 < hi) xcd_barrier(xb);
  PH(15) if (lo <= 15 && 15 < hi) {
        ph_gemm_ffn_up(p, 1);
  }
  if (lo <= 15 && 15 + 1 < hi) xcd_barrier(xb);
  PH(16) if (lo <= 16 && 16 < hi) {
        ph_gemm_f32out(p, WSB(OFF_R1), 2816, WSB(OFF_WDN) + (size_t)1024 * 2816, 2816, 2816, WSF(OFF_R2), 1024);
  }
  if (lo <= 16 && 16 + 1 < hi) xcd_barrier(xb);
  PH(17) if (lo <= 17 && 17 < hi) {
        rowop<true, false, false>(p, WSF(OFF_R2), p.n_post_ffn + 1024, 5, nullptr, 0, 0, 1, 1);
  }
}

extern "C" void kernel_launch(void* const* d_in, const int* in_sizes, int n_in, void* d_out, int out_size, void* d_ws,
                              size_t ws_size, hipStream_t stream) {
  P p{};
  const float** f = (const float**)&p;
  for (int i = 0; i < 33; ++i) f[i] = (const float*)d_in[i];
  p.out = (float*)d_out;
  p.ws = (char*)d_ws;
  static int grid_blocks = 0;
  if (!grid_blocks) {
    int dev = 0, cus = 0, per_cu = 0;
    hipGetDevice(&dev);
    hipDeviceGetAttribute(&cus, hipDeviceAttributeMultiprocessorCount, dev);
    hipOccupancyMaxActiveBlocksPerMultiprocessor(&per_cu, mega, 256, 0);
    if (per_cu > 2) per_cu = 2;
    if (per_cu < 1) per_cu = 1;
    grid_blocks = cus * per_cu;
  }
  hipMemsetAsync((char*)d_ws + OFF_BAR, 0, XCD_BAR_WORDS * 4, stream);
#if SINGLE_LAUNCH
  int lo = 0, hi = NPHASE;
  void* args[] = {&p, &lo, &hi};
  hipError_t e = hipLaunchCooperativeKernel((void*)mega, dim3(grid_blocks), dim3(256), args, 0, stream);
  if (e != hipSuccess) fprintf(stderr, "cooperative launch failed: %s (grid %d)\n", hipGetErrorString(e), grid_blocks);
#else
  for (int ph = 0; ph < NPHASE; ++ph) mega<<<grid_blocks, 256, 0, stream>>>(p, ph, ph + 1);
#endif
}
```

```cpp
#include <hip/hip_runtime.h>
#include <hip/hip_cooperative_groups.h>
#include <stdint.h>
#include <stdio.h>
namespace cg = cooperative_groups;

#ifndef SINGLE_LAUNCH
#define SINGLE_LAUNCH 1
#endif

typedef __attribute__((ext_vector_type(8))) short bf16x8;
typedef __attribute__((ext_vector_type(4))) float f32x4;
typedef unsigned short bf16_t;

#define DEVI __device__ __forceinline__

constexpr size_t OFF_WIN   = 0;
constexpr size_t OFF_WUQ   = OFF_WIN   + (size_t)2176*1024*2;
constexpr size_t OFF_WUKV  = OFF_WUQ   + (size_t)768*256*2;
constexpr size_t OFF_WOUT  = OFF_WUKV  + (size_t)1024*256*2;
constexpr size_t OFF_WPOOL = OFF_WOUT  + (size_t)1024*1024*2;
constexpr size_t OFF_WGU   = OFF_WPOOL + (size_t)4*256*256*2;
constexpr size_t OFF_WDN   = OFF_WGU   + (size_t)2*5632*1024*2;
constexpr size_t OFF_MOD   = OFF_WDN   + (size_t)2*1024*2816*2;
constexpr size_t OFF_R1    = OFF_MOD   + (size_t)2*3*6144*4;
constexpr size_t OFF_R2    = OFF_R1    + (size_t)8192*2096*4;
constexpr size_t OFF_H     = OFF_R2    + (size_t)8192*1024*4;
constexpr size_t OFF_CAT   = OFF_H     + (size_t)8192*1024*2;
constexpr size_t OFF_Q     = OFF_CAT   + (size_t)8192*1024*2;
constexpr size_t OFF_KN    = OFF_Q     + (size_t)8192*768*2;
constexpr size_t OFF_VT    = OFF_KN    + (size_t)8704*512*2;
constexpr size_t OFF_CQN   = OFF_VT    + (size_t)8704*512*2;
constexpr size_t OFF_CKV   = OFF_CQN   + (size_t)8192*256*2;
constexpr size_t OFF_KPE   = OFF_CKV   + (size_t)8704*256*2;
constexpr size_t OFF_XS    = OFF_KPE   + (size_t)8704*32*2;
constexpr size_t OFF_XST   = OFF_XS    + (size_t)8192*512*2;
constexpr size_t OFF_BM    = OFF_XST   + (size_t)8192*512*2;
constexpr size_t OFF_BT    = OFF_BM    + (size_t)8192*256*2;
constexpr size_t OFF_CM    = OFF_BT    + (size_t)8192*256*2;
constexpr size_t OFF_DTV   = OFF_CM    + (size_t)8192*256*2;
constexpr size_t OFF_CUM   = OFF_DTV   + (size_t)2*8192*8*4;
constexpr size_t OFF_TOT   = OFF_CUM   + (size_t)2*8192*8*4;
constexpr size_t OFF_BAR   = OFF_TOT   + 4096;
constexpr size_t OFF_END   = OFF_BAR   + 16384;

constexpr size_t OUT_CKV = 8388608, OUT_KR = 9437184, OUT_SF = 9568256, OUT_SB = 10616832;

struct P {
  const float *x_prompt, *x_sample, *c, *cache_ckv, *cache_kr, *st_f, *st_b, *c_ctx;
  const float *w_mod, *b_mod, *n_pre_mix, *n_post_mix, *n_pre_ffn, *n_post_ffn;
  const float *w_in, *q_norm, *w_uq, *kv_norm, *w_ukv, *conv_w, *conv_b, *dtb_f, *dtb_b, *alog_f, *alog_b;
  const float *ssd_d, *ssd_norm, *w_out, *pool_w, *pool_scale, *w_gate, *w_up, *w_down;
  float* out;
  char* ws;
};

#define WSB(off) ((bf16_t*)(p.ws + (off)))
#define WSF(off) ((float*)(p.ws + (off)))

DEVI bf16_t f2bf(float f) {
  unsigned u = __float_as_uint(f);
  u += 0x7fffu + ((u >> 16) & 1u);
  return (bf16_t)(u >> 16);
}
DEVI float bf2f(bf16_t b) { return __uint_as_float(((unsigned)b) << 16); }
DEVI unsigned pack2(float a, float b) { return (unsigned)f2bf(a) | ((unsigned)f2bf(b) << 16); }
DEVI float silu(float x) { return x / (1.f + __expf(-x)); }
DEVI float wave_sum(float v) {
#pragma unroll
  for (int o = 32; o > 0; o >>= 1) v += __shfl_xor(v, o, 64);
  return v;
}
DEVI f32x4 mfma16(bf16x8 a, bf16x8 b, f32x4 c) { return __builtin_amdgcn_mfma_f32_16x16x32_bf16(a, b, c, 0, 0, 0); }

DEVI float rope_freq(int m) { return exp2f(-(float)m * 1.6609640474436813f); }
DEVI void fast_sincos(float ang, float& sn, float& cs) {
  float rev = ang * 0.15915494309189535f;
  rev -= rintf(rev);
  sn = __builtin_amdgcn_sinf(rev);
  cs = __builtin_amdgcn_cosf(rev);
}
DEVI int swz_tile(int t, int T) {
  int q = T >> 3, r = T & 7, x = t & 7, off = t >> 3;
  return (x < r ? x * (q + 1) : r * (q + 1) + (x - r) * q) + off;
}

__shared__ __attribute__((aligned(16))) char g_smem[73728];
#define NOINL __device__ __forceinline__

constexpr int LDT = 72;
constexpr int TILE_E = 128 * LDT;

template <class Epi>
DEVI void gemm_tile(const bf16_t* __restrict__ A, int lda, const bf16_t* __restrict__ B, int ldb, int K,
                    int m0, int n0, char* smem, Epi epi) {
  const int tid = threadIdx.x, lane = tid & 63, wave = tid >> 6, wm = wave >> 1, wn = wave & 1;
  const int lr = lane & 15, lg = lane >> 4;
  bf16_t* sA = (bf16_t*)smem;
  bf16_t* sB = sA + 2 * TILE_E;
  f32x4 acc[4][4];
#pragma unroll
  for (int i = 0; i < 4; ++i)
#pragma unroll
    for (int j = 0; j < 4; ++j) acc[i][j] = (f32x4){0.f, 0.f, 0.f, 0.f};
  const int lrow = tid >> 3, lkc = (tid & 7) * 8;
  const bf16_t* gA = A + (size_t)(m0 + lrow) * lda + lkc;
  const bf16_t* gB = B + (size_t)(n0 + lrow) * ldb + lkc;
  uint4 ra[4], rb[4];
#pragma unroll
  for (int i = 0; i < 4; ++i) {
    ra[i] = *(const uint4*)(gA + (size_t)(32 * i) * lda);
    rb[i] = *(const uint4*)(gB + (size_t)(32 * i) * ldb);
  }
#pragma unroll
  for (int i = 0; i < 4; ++i) {
    *(uint4*)(sA + (lrow + 32 * i) * LDT + lkc) = ra[i];
    *(uint4*)(sB + (lrow + 32 * i) * LDT + lkc) = rb[i];
  }
  __syncthreads();
  const int nk = K >> 6;
  for (int kt = 0; kt < nk; ++kt) {
    const int cur = kt & 1;
    if (kt + 1 < nk) {
      const int k0 = (kt + 1) << 6;
#pragma unroll
      for (int i = 0; i < 4; ++i) {
        ra[i] = *(const uint4*)(gA + (size_t)(32 * i) * lda + k0);
        rb[i] = *(const uint4*)(gB + (size_t)(32 * i) * ldb + k0);
      }
    }
    const bf16_t* cA = sA + cur * TILE_E + (wm * 64 + lr) * LDT + lg * 8;
    const bf16_t* cB = sB + cur * TILE_E + (wn * 64 + lr) * LDT + lg * 8;
#pragma unroll
    for (int ks = 0; ks < 2; ++ks) {
      bf16x8 af[4], bfr[4];
#pragma unroll
      for (int i = 0; i < 4; ++i) {
        af[i] = *(const bf16x8*)(cA + i * 16 * LDT + ks * 32);
        bfr[i] = *(const bf16x8*)(cB + i * 16 * LDT + ks * 32);
      }
#pragma unroll
      for (int i = 0; i < 4; ++i)
#pragma unroll
        for (int j = 0; j < 4; ++j) acc[i][j] = mfma16(af[i], bfr[j], acc[i][j]);
    }
    if (kt + 1 < nk) {
      const int nx = cur ^ 1;
#pragma unroll
      for (int i = 0; i < 4; ++i) {
        *(uint4*)(sA + nx * TILE_E + (lrow + 32 * i) * LDT + lkc) = ra[i];
        *(uint4*)(sB + nx * TILE_E + (lrow + 32 * i) * LDT + lkc) = rb[i];
      }
    }
    __syncthreads();
  }
#pragma unroll
  for (int i = 0; i < 4; ++i)
#pragma unroll
    for (int j = 0; j < 4; j += 2)
      epi(m0 + wm * 64 + i * 16 + lg * 4, n0 + wn * 64 + j * 16 + lr, acc[i][j], acc[i][j + 1]);
}

struct TileInfo { const bf16_t* a; const bf16_t* b; int m0, n0, ctx; };
template <class TileFn, class Epi>
DEVI void gemm_stream(int T, int lda, int ldb, int K, char* smem, TileFn tf, Epi epi) {
  int t = blockIdx.x;
  if (t >= T) return;
  const int tid = threadIdx.x, lane = tid & 63, wave = tid >> 6, wm = wave >> 1, wn = wave & 1;
  const int lr = lane & 15, lg = lane >> 4;
  bf16_t* sA = (bf16_t*)smem;
  bf16_t* sB = sA + 2 * TILE_E;
  const int lrow = tid >> 3, lkc = (tid & 7) * 8;
  TileInfo ti = tf(t);
  const bf16_t* gA = ti.a + (size_t)lrow * lda + lkc;
  const bf16_t* gB = ti.b + (size_t)lrow * ldb + lkc;
  int m0 = ti.m0, n0 = ti.n0, ctx = ti.ctx;
  uint4 ra0, ra1, ra2, ra3, rb0, rb1, rb2, rb3;
#define GS_LOAD(pa, pb) \
  ra0 = *(const uint4*)((pa)); ra1 = *(const uint4*)((pa) + (size_t)32 * lda); \
  ra2 = *(const uint4*)((pa) + (size_t)64 * lda); ra3 = *(const uint4*)((pa) + (size_t)96 * lda); \
  rb0 = *(const uint4*)((pb)); rb1 = *(const uint4*)((pb) + (size_t)32 * ldb); \
  rb2 = *(const uint4*)((pb) + (size_t)64 * ldb); rb3 = *(const uint4*)((pb) + (size_t)96 * ldb);
#define GS_WRITE(buf) { \
  bf16_t* wa = sA + (buf) * TILE_E + lrow * LDT + lkc; bf16_t* wb = sB + (buf) * TILE_E + lrow * LDT + lkc; \
  *(uint4*)(wa) = ra0; *(uint4*)(wa + 32 * LDT) = ra1; *(uint4*)(wa + 64 * LDT) = ra2; *(uint4*)(wa + 96 * LDT) = ra3; \
  *(uint4*)(wb) = rb0; *(uint4*)(wb + 32 * LDT) = rb1; *(uint4*)(wb + 64 * LDT) = rb2; *(uint4*)(wb + 96 * LDT) = rb3; }
  GS_LOAD(gA, gB)
  GS_WRITE(0)
  __syncthreads();
  int cur = 0;
  const int nk = K >> 6;
  for (;;) {
    f32x4 acc[4][4];
#pragma unroll
    for (int i = 0; i < 4; ++i)
#pragma unroll
      for (int j = 0; j < 4; ++j) acc[i][j] = (f32x4){0.f, 0.f, 0.f, 0.f};
    const int tn = t + gridDim.x;
    const bool have_next = tn < T;
    const bf16_t *nA = gA, *nB = gB;
    int nm0 = 0, nn0 = 0, nctx = 0;
    if (have_next) {
      const TileInfo tj = tf(tn);
      nA = tj.a + (size_t)lrow * lda + lkc;
      nB = tj.b + (size_t)lrow * ldb + lkc;
      nm0 = tj.m0; nn0 = tj.n0; nctx = tj.ctx;
    }
    for (int kt = 0; kt < nk; ++kt) {
      const bool last = (kt + 1 == nk);
      {
        const bf16_t* pa = last ? nA : gA + ((kt + 1) << 6);
        const bf16_t* pb = last ? nB : gB + ((kt + 1) << 6);
        GS_LOAD(pa, pb)
      }
      const bf16_t* cA = sA + cur * TILE_E + (wm * 64 + lr) * LDT + lg * 8;
      const bf16_t* cB = sB + cur * TILE_E + (wn * 64 + lr) * LDT + lg * 8;
#pragma unroll
      for (int ks = 0; ks < 2; ++ks) {
        bf16x8 af[4], bfr[4];
#pragma unroll
        for (int i = 0; i < 4; ++i) {
          af[i] = *(const bf16x8*)(cA + i * 16 * LDT + ks * 32);
          bfr[i] = *(const bf16x8*)(cB + i * 16 * LDT + ks * 32);
        }
        __builtin_amdgcn_s_setprio(1);
#pragma unroll
        for (int i = 0; i < 4; ++i)
#pragma unroll
          for (int j = 0; j < 4; ++j) acc[i][j] = mfma16(af[i], bfr[j], acc[i][j]);
        __builtin_amdgcn_s_setprio(0);
      }
      GS_WRITE(cur ^ 1)
      __syncthreads();
      cur ^= 1;
    }
#pragma unroll
    for (int i = 0; i < 4; ++i)
#pragma unroll
      for (int j = 0; j < 4; j += 2)
        epi(ctx, m0 + wm * 64 + i * 16 + lg * 4, n0 + wn * 64 + j * 16 + lr, acc[i][j], acc[i][j + 1]);
    if (!have_next) break;
    t = tn; gA = nA; gB = nB; m0 = nm0; n0 = nn0; ctx = nctx;
  }
}

DEVI void tile_mn(int t, int nM, int nN, int& m, int& n) {
  int id = swz_tile(t, nM * nN);
  int per = 8 * nN;
  int gq = id / per, rem = id - gq * per;
  int gsz = min(8, nM - gq * 8);
  m = gq * 8 + rem % gsz;
  n = rem / gsz;
}

NOINL void gemv_tile(const P& p, int t) {
  char* smem = g_smem;
  const int tid = threadIdx.x;
  float* sv = (float*)smem;
  float* red = sv + 3072;
  const int l = t / 192, n0 = (t % 192) * 32;
  for (int i = tid; i < 3072; i += 256) {
    int v = i >> 10, k = i & 1023;
    float cv = (v == 0) ? p.c_ctx[k] : p.c[(v - 1) * 1024 + k];
    sv[i] = cv / (1.f + expf(-cv));
  }
  __syncthreads();
  const int cgp = tid & 7, ks = tid >> 3;
  const float* w = p.w_mod + (size_t)l * 1024 * 6144 + n0 + cgp * 4;
  float a0[4] = {0, 0, 0, 0}, a1[4] = {0, 0, 0, 0}, a2[4] = {0, 0, 0, 0};
#pragma unroll 8
  for (int kk = 0; kk < 32; ++kk) {
    const int k = ks * 32 + kk;
    const float4 wv = *(const float4*)(w + (size_t)k * 6144);
    const float s0 = sv[k], s1 = sv[1024 + k], s2 = sv[2048 + k];
    a0[0] += s0 * wv.x; a0[1] += s0 * wv.y; a0[2] += s0 * wv.z; a0[3] += s0 * wv.w;
    a1[0] += s1 * wv.x; a1[1] += s1 * wv.y; a1[2] += s1 * wv.z; a1[3] += s1 * wv.w;
    a2[0] += s2 * wv.x; a2[1] += s2 * wv.y; a2[2] += s2 * wv.z; a2[3] += s2 * wv.w;
  }
#pragma unroll
  for (int j = 0; j < 4; ++j) {
    red[(ks * 3 + 0) * 32 + cgp * 4 + j] = a0[j];
    red[(ks * 3 + 1) * 32 + cgp * 4 + j] = a1[j];
    red[(ks * 3 + 2) * 32 + cgp * 4 + j] = a2[j];
  }
  __syncthreads();
  if (tid < 96) {
    const int v = tid >> 5, col = tid & 31;
    float s = 0.f;
    for (int q = 0; q < 32; ++q) s += red[(q * 3 + v) * 32 + col];
    s += p.b_mod[l * 6144 + n0 + col];
    WSF(OFF_MOD)[(l * 3 + v) * 6144 + n0 + col] = s;
  }
  __syncthreads();
}

NOINL void transpose_tile(const P& p, int t) {
  char* smem = g_smem;
  const int tid = threadIdx.x;
  const float* src; bf16_t* dst; int K, N, ntn, mode = 0;
  if (t < 544) { src = p.w_in; dst = WSB(OFF_WIN); K = 1024; N = 2096; ntn = 34; }
  else if ((t -= 544) < 48) { src = p.w_uq; dst = WSB(OFF_WUQ); K = 256; N = 768; ntn = 12; }
  else if ((t -= 48) < 64) { src = p.w_ukv; dst = WSB(OFF_WUKV); K = 256; N = 1024; ntn = 16; }
  else if ((t -= 64) < 256) { src = p.w_out; dst = WSB(OFF_WOUT); K = 1024; N = 1024; ntn = 16; }
  else if ((t -= 256) < 64) { int g = t >> 4; t &= 15; src = p.pool_w + (size_t)g * 65536; dst = WSB(OFF_WPOOL) + (size_t)g * 65536; K = 256; N = 256; ntn = 4; }
  else if ((t -= 64) < 1408) { int l = t / 704; t -= l * 704; src = p.w_gate + (size_t)l * 1024 * 2816; dst = WSB(OFF_WGU) + (size_t)l * 5632 * 1024; K = 1024; N = 2816; ntn = 44; mode = 1; }
  else if ((t -= 1408) < 1408) { int l = t / 704; t -= l * 704; src = p.w_up + (size_t)l * 1024 * 2816; dst = WSB(OFF_WGU) + (size_t)l * 5632 * 1024; K = 1024; N = 2816; ntn = 44; mode = 2; }
  else { t -= 1408; int l = t / 704; t -= l * 704; src = p.w_down + (size_t)l * 2816 * 1024; dst = WSB(OFF_WDN) + (size_t)l * 1024 * 2816; K = 2816; N = 1024; ntn = 16; }
  const int kt = t / ntn, nt_ = t - kt * ntn;
  const int k0 = kt * 64, n0 = nt_ * 64;
  float* tile = (float*)smem;
  {
    const int nn = tid & 63, kk0 = tid >> 6;
    const int n = n0 + nn;
#pragma unroll 4
    for (int i = 0; i < 16; ++i) {
      const int kk = kk0 + 4 * i;
      tile[kk * 65 + nn] = (n < N) ? src[(size_t)(k0 + kk) * N + n] : 0.f;
    }
  }
  __syncthreads();
#pragma unroll
  for (int i = 0; i < 2; ++i) {
    const int id = tid + 256 * i;
    const int nn = id >> 3, kc = id & 7;
    const int n = n0 + nn;
    uint4 pk;
    pk.x = pack2(tile[(kc * 8 + 0) * 65 + nn], tile[(kc * 8 + 1) * 65 + nn]);
    pk.y = pack2(tile[(kc * 8 + 2) * 65 + nn], tile[(kc * 8 + 3) * 65 + nn]);
    pk.z = pack2(tile[(kc * 8 + 4) * 65 + nn], tile[(kc * 8 + 5) * 65 + nn]);
    pk.w = pack2(tile[(kc * 8 + 6) * 65 + nn], tile[(kc * 8 + 7) * 65 + nn]);
    int drow = n;
    if (mode == 1) drow = (n >> 4) * 32 + (n & 15);
    else if (mode == 2) drow = (n >> 4) * 32 + 16 + (n & 15);
    *(uint4*)(dst + (size_t)drow * K + k0 + kc * 8) = pk;
  }
  __syncthreads();
}

template <bool UPD, bool MOD, bool FIRST>
DEVI void rowop(const P& p, const float* msrc, const float* wpost, int gate_idx, const float* wpre, int shift_idx,
                int scale_idx, int layer_g, int layer_m) {
  const int lane = threadIdx.x & 63, wave = threadIdx.x >> 6;
  const float* modg = WSF(OFF_MOD) + (size_t)layer_g * 3 * 6144;
  const float* modm = WSF(OFF_MOD) + (size_t)layer_m * 3 * 6144;
  bf16_t* hbuf = WSB(OFF_H);
  for (int r = blockIdx.x * 4 + wave; r < 8192; r += gridDim.x * 4) {
    const int v = r < 4096 ? 0 : 1 + ((r - 4096) >> 11);
    const float* mvg = modg + v * 6144;
    const float* mvm = modm + v * 6144;
    const float* xin = FIRST ? (r < 4096 ? p.x_prompt + (size_t)r * 1024 : p.x_sample + (size_t)(r - 4096) * 1024)
                             : p.out + (size_t)r * 1024;
    float4 x[4];
#pragma unroll
    for (int i = 0; i < 4; ++i) x[i] = *(const float4*)(xin + lane * 4 + 256 * i);
    if (UPD) {
      float4 m[4];
      float ss = 0.f;
#pragma unroll
      for (int i = 0; i < 4; ++i) {
        m[i] = *(const float4*)(msrc + (size_t)r * 1024 + lane * 4 + 256 * i);
        ss += m[i].x * m[i].x + m[i].y * m[i].y + m[i].z * m[i].z + m[i].w * m[i].w;
      }
      ss = wave_sum(ss);
      const float rs = rsqrtf(ss * (1.f / 1024.f) + 1e-6f);
#pragma unroll
      for (int i = 0; i < 4; ++i) {
        const int col = lane * 4 + 256 * i;
        const float4 wp = *(const float4*)(wpost + col);
        const float4 g = *(const float4*)(mvg + gate_idx * 1024 + col);
        x[i].x += g.x * (m[i].x * rs * wp.x);
        x[i].y += g.y * (m[i].y * rs * wp.y);
        x[i].z += g.z * (m[i].z * rs * wp.z);
        x[i].w += g.w * (m[i].w * rs * wp.w);
        *(float4*)(p.out + (size_t)r * 1024 + col) = x[i];
      }
    }
    if (MOD) {
      float ss = 0.f;
#pragma unroll
      for (int i = 0; i < 4; ++i) ss += x[i].x * x[i].x + x[i].y * x[i].y + x[i].z * x[i].z + x[i].w * x[i].w;
      ss = wave_sum(ss);
      const float rs = rsqrtf(ss * (1.f / 1024.f) + 1e-6f);
#pragma unroll
      for (int i = 0; i < 4; ++i) {
        const int col = lane * 4 + 256 * i;
        const float4 wp = *(const float4*)(wpre + col);
        const float4 sh = *(const float4*)(mvm + shift_idx * 1024 + col);
        const float4 sc = *(const float4*)(mvm + scale_idx * 1024 + col);
        uint2 o;
        o.x = pack2(x[i].x * rs * wp.x * (1.f + sc.x) + sh.x, x[i].y * rs * wp.y * (1.f + sc.y) + sh.y);
        o.y = pack2(x[i].z * rs * wp.z * (1.f + sc.z) + sh.z, x[i].w * rs * wp.w * (1.f + sc.w) + sh.w);
        *(uint2*)(hbuf + (size_t)r * 1024 + col) = o;
      }
    }
  }
}

NOINL void prep_rows(const P& p) {
  const int lane = threadIdx.x & 63, wave = threadIdx.x >> 6;
  const float* proj = WSF(OFF_R1);
  for (int r = blockIdx.x * 4 + wave; r < 8192; r += gridDim.x * 4) {
    const float* pr = proj + (size_t)r * 2096;
    const int kvrow = r < 4096 ? r : 4096 + ((r - 4096) >> 11) * 2304 + 256 + ((r - 4096) & 2047);
    {
      const float4 a = *(const float4*)(pr + lane * 4);
      float ss = wave_sum(a.x * a.x + a.y * a.y + a.z * a.z + a.w * a.w);
      const float rs = rsqrtf(ss * (1.f / 256.f) + 1e-6f);
      const float4 g = *(const float4*)(p.q_norm + lane * 4);
      uint2 o;
      o.x = pack2(a.x * rs * g.x, a.y * rs * g.y);
      o.y = pack2(a.z * rs * g.z, a.w * rs * g.w);
      *(uint2*)(WSB(OFF_CQN) + (size_t)r * 256 + lane * 4) = o;
    }
    {
      const float4 a = *(const float4*)(pr + 256 + lane * 4);
      float ss = wave_sum(a.x * a.x + a.y * a.y + a.z * a.z + a.w * a.w);
      const float rs = rsqrtf(ss * (1.f / 256.f) + 1e-6f);
      const float4 g = *(const float4*)(p.kv_norm + lane * 4);
      float4 vv;
      vv.x = a.x * rs * g.x; vv.y = a.y * rs * g.y; vv.z = a.z * rs * g.z; vv.w = a.w * rs * g.w;
      if (r < 4096) *(float4*)(p.out + OUT_CKV + (size_t)r * 256 + lane * 4) = vv;
      uint2 o;
      o.x = pack2(vv.x, vv.y);
      o.y = pack2(vv.z, vv.w);
      *(uint2*)(WSB(OFF_CKV) + (size_t)kvrow * 256 + lane * 4) = o;
    }
    {
      const float kv = (lane < 32) ? pr[512 + lane] : 0.f;
      const float partner = __shfl_xor(kv, 16, 64);
      if (r < 4096) {
        if (lane < 32) {
          p.out[OUT_KR + (size_t)r * 32 + lane] = kv;
          WSB(OFF_KPE)[(size_t)kvrow * 32 + lane] = f2bf(kv);
        }
      } else {
        const int t = (r - 4096) & 2047;
        const int ii = lane & 15;
        const float pos = (ii < 8) ? (float)(t >> 6) : (float)(t & 63);
        const float fr = rope_freq(ii & 7);
        const float ang = pos * fr;
        float cs, sn;
        fast_sincos(ang, sn, cs);
        const float o = (lane < 16) ? (kv * cs - partner * sn) : (partner * sn + kv * cs);
        if (lane < 32) WSB(OFF_KPE)[(size_t)kvrow * 32 + lane] = f2bf(o);
      }
    }
    if (lane < 16) {
      const int dir = lane >> 3, hh = lane & 7;
      const float raw = pr[2080 + lane] + (dir ? p.dtb_b[hh] : p.dtb_f[hh]);
      const float sp = raw > 20.f ? raw : log1pf(expf(raw));
      WSF(OFF_DTV)[((size_t)dir * 8192 + r) * 8 + hh] = sp;
    }
  }
}

NOINL void prep_cache(const P& p) {
  const int gt = blockIdx.x * 256 + threadIdx.x, gs = gridDim.x * 256;
  for (int i = gt; i < 2 * 256 * 256; i += gs) {
    int b = i >> 16, rem = i & 65535;
    WSB(OFF_CKV)[(size_t)(4096 + b * 2304) * 256 + rem] = f2bf(p.cache_ckv[i]);
  }
  for (int i = gt; i < 2 * 256 * 32; i += gs) {
    int b = i >> 13, rem = i & 8191;
    WSB(OFF_KPE)[(size_t)(4096 + b * 2304) * 32 + rem] = f2bf(p.cache_kr[i]);
  }
}

NOINL void conv_tile(const P& p, int t) {
  char* smem = g_smem;
  const int tid = threadIdx.x;
  float* sin_ = (float*)smem;
  float* sout = sin_ + 68 * 64;
  const int tt_ = t >> 4, ct = t & 15;
  const int r0 = tt_ * 64, c0 = ct * 64;
  int s0, s1;
  if (r0 < 4096) { s0 = r0 & ~255; s1 = s0 + 256; } else { s0 = 4096 + ((r0 - 4096) & ~2047); s1 = s0 + 2048; }
  const float* proj = WSF(OFF_R1);
  for (int i = tid; i < 68 * 64; i += 256) {
    const int rr = i >> 6, cc = i & 63;
    const int r = r0 - 2 + rr;
    float v = 0.f;
    if (r >= s0 && r < s1) v = proj[(size_t)r * 2096 + 1056 + c0 + cc];
    sin_[i] = v;
  }
  __syncthreads();
  {
    const int cc = tid & 63, tq = tid >> 6;
    const int c = c0 + cc;
    const float w0 = p.conv_w[c], w1 = p.conv_w[1024 + c], w2 = p.conv_w[2048 + c], w3 = p.conv_w[3072 + c],
                w4 = p.conv_w[4096 + c], bias = p.conv_b[c];
#pragma unroll 4
    for (int i = 0; i < 16; ++i) {
      const int tt = tq * 16 + i;
      float y = bias + w0 * sin_[tt * 64 + cc] + w1 * sin_[(tt + 1) * 64 + cc] + w2 * sin_[(tt + 2) * 64 + cc] +
                w3 * sin_[(tt + 3) * 64 + cc] + w4 * sin_[(tt + 4) * 64 + cc];
      y = y / (1.f + __expf(-y));
      sout[tt * 65 + cc] = y;
      const bf16_t b = f2bf(y);
      const size_t r = r0 + tt;
      if (c < 512) WSB(OFF_XS)[r * 512 + c] = b;
      else if (c < 768) WSB(OFF_BM)[r * 256 + (c - 512)] = b;
      else WSB(OFF_CM)[r * 256 + (c - 768)] = b;
    }
  }
  __syncthreads();
  if (c0 < 768) {
    const int cl = tid >> 2, q4 = tid & 3;
    uint4 o0, o1;
    const float* sp = sout + (q4 * 16) * 65 + cl;
    o0.x = pack2(sp[0 * 65], sp[1 * 65]);   o0.y = pack2(sp[2 * 65], sp[3 * 65]);
    o0.z = pack2(sp[4 * 65], sp[5 * 65]);   o0.w = pack2(sp[6 * 65], sp[7 * 65]);
    o1.x = pack2(sp[8 * 65], sp[9 * 65]);   o1.y = pack2(sp[10 * 65], sp[11 * 65]);
    o1.z = pack2(sp[12 * 65], sp[13 * 65]); o1.w = pack2(sp[14 * 65], sp[15 * 65]);
    bf16_t* dst = (c0 < 512) ? WSB(OFF_XST) + (size_t)(c0 + cl) * 8192 : WSB(OFF_BT) + (size_t)(c0 - 512 + cl) * 8192;
    dst += r0 + q4 * 16;
    *(uint4*)(dst) = o0;
    *(uint4*)(dst + 8) = o1;
  }
  __syncthreads();
}

NOINL void chunk_state_item(const P& p, int item) {
  char* smem = g_smem;
  const int tid = threadIdx.x, lane = tid & 63, wave = tid >> 6, lr = lane & 15, lg = lane >> 4;
  const int cidx = item >> 3, hh = item & 7, g = hh >> 2;
  const int r0 = cidx * 128;
  constexpr int LDS_ = 136;
  bf16_t* sAs = (bf16_t*)smem;
  bf16_t* sBs = sAs + 2 * 64 * LDS_;
  float* fa = (float*)(sBs + 128 * LDS_);
  float* fcum = fa + 256;
  float* fw = fa + 512;
  float* fdt = fa + 768;
  {
    const int dir = tid >> 7, j = tid & 127;
    const float dt = WSF(OFF_DTV)[((size_t)dir * 8192 + r0 + j) * 8 + hh];
    const float Aco = -expf(dir ? p.alog_b[hh] : p.alog_f[hh]);
    fa[tid] = dt * Aco;
    fdt[tid] = dt;
  }
  __syncthreads();
  {
    const int dir = tid >> 7, j = tid & 127;
    float s = 0.f;
    if (dir == 0) { for (int k = 0; k <= j; ++k) s += fa[k]; }
    else { for (int k = 127; k >= j; --k) s += fa[128 + k]; }
    fcum[tid] = s;
    WSF(OFF_CUM)[((size_t)dir * 8192 + r0 + j) * 8 + hh] = s;
  }
  __syncthreads();
  {
    const int dir = tid >> 7;
    const float ce = dir ? fcum[128] : fcum[127];
    fw[tid] = __expf(ce - fcum[tid]) * fdt[tid];
    if ((tid & 127) == 0) WSF(OFF_TOT)[(dir * 64 + cidx) * 8 + hh] = __expf(ce);
  }
  __syncthreads();
#pragma unroll
  for (int i = 0; i < 4; ++i) {
    const int id = tid + 256 * i;
    const int pp = id >> 4, jc = (id & 15) * 8;
    const uint4 raw = *(const uint4*)(WSB(OFF_XST) + (size_t)(hh * 64 + pp) * 8192 + r0 + jc);
    const unsigned rw[4] = {raw.x, raw.y, raw.z, raw.w};
    unsigned of[4], ob[4];
#pragma unroll
    for (int q = 0; q < 4; ++q) {
      const float x0 = __uint_as_float(rw[q] << 16), x1 = __uint_as_float(rw[q] & 0xffff0000u);
      of[q] = pack2(x0 * fw[jc + 2 * q], x1 * fw[jc + 2 * q + 1]);
      ob[q] = pack2(x0 * fw[128 + jc + 2 * q], x1 * fw[128 + jc + 2 * q + 1]);
    }
    *(uint4*)(sAs + pp * LDS_ + jc) = make_uint4(of[0], of[1], of[2], of[3]);
    *(uint4*)(sAs + 64 * LDS_ + pp * LDS_ + jc) = make_uint4(ob[0], ob[1], ob[2], ob[3]);
  }
#pragma unroll
  for (int i = 0; i < 8; ++i) {
    const int id = tid + 256 * i;
    const int nn = id >> 4, jc = (id & 15) * 8;
    *(uint4*)(sBs + nn * LDS_ + jc) = *(const uint4*)(WSB(OFF_BT) + (size_t)(g * 128 + nn) * 8192 + r0 + jc);
  }
  __syncthreads();
  {
    const int dir = wave >> 1, nh = wave & 1;
    f32x4 acc[4][4];
#pragma unroll
    for (int i = 0; i < 4; ++i)
#pragma unroll
      for (int j = 0; j < 4; ++j) acc[i][j] = (f32x4){0.f, 0.f, 0.f, 0.f};
    const bf16_t* cA = sAs + dir * 64 * LDS_ + lr * LDS_ + lg * 8;
    const bf16_t* cB = sBs + (nh * 64 + lr) * LDS_ + lg * 8;
#pragma unroll 1
    for (int ks = 0; ks < 4; ++ks) {
      bf16x8 af[4], bfr[4];
#pragma unroll
      for (int i = 0; i < 4; ++i) {
        af[i] = *(const bf16x8*)(cA + i * 16 * LDS_ + ks * 32);
        bfr[i] = *(const bf16x8*)(cB + i * 16 * LDS_ + ks * 32);
      }
#pragma unroll
      for (int i = 0; i < 4; ++i)
#pragma unroll
        for (int j = 0; j < 4; ++j) acc[i][j] = mfma16(af[i], bfr[j], acc[i][j]);
    }
    float* S = WSF(OFF_R2) + ((size_t)(dir * 64 + cidx) * 8 + hh) * 8192 + (lg * 4) * 128 + nh * 64 + lr;
#pragma unroll
    for (int i = 0; i < 4; ++i) {
#pragma unroll
      for (int q = 0; q < 4; ++q) {
#pragma unroll
        for (int j = 0; j < 4; ++j) S[j * 16] = acc[i][j][q];
        S += 128;
      }
      S += 12 * 128;
      __builtin_amdgcn_sched_barrier(0);
    }
  }
  __syncthreads();
}

NOINL void scan_states(const P& p) {
  const int total = 2 * 18 * 8 * 64 * 32;
  for (int idx = blockIdx.x * 256 + threadIdx.x; idx < total; idx += gridDim.x * 256) {
    const int n4 = idx & 31, pp = (idx >> 5) & 63, hh = (idx >> 11) & 7;
    const int sd = idx >> 14;
    const int s = sd % 18, dir = sd / 18;
    const int nc = s < 16 ? 2 : 16;
    const int cb = s < 16 ? s * 2 : 32 + (s - 16) * 16;
    float4 h = make_float4(0.f, 0.f, 0.f, 0.f);
    if (s >= 16) {
      const float* st = (dir ? p.st_b : p.st_f) + ((size_t)((s - 16) * 8 + hh) * 64 + pp) * 128 + n4 * 4;
      h = *(const float4*)st;
    }
    const size_t eoff = (size_t)pp * 128 + n4 * 4;
    for (int c = 0; c < nc; ++c) {
      const int cidx = cb + (dir ? nc - 1 - c : c);
      const size_t base = ((size_t)(dir * 64 + cidx) * 8 + hh) * 8192 + eoff;
      uint2 o;
      o.x = pack2(h.x, h.y);
      o.y = pack2(h.z, h.w);
      *(uint2*)(WSB(OFF_H) + base) = o;
      const float d = WSF(OFF_TOT)[(dir * 64 + cidx) * 8 + hh];
      const float4 sv = *(const float4*)(WSF(OFF_R2) + base);
      h.x = d * h.x + sv.x; h.y = d * h.y + sv.y; h.z = d * h.z + sv.z; h.w = d * h.w + sv.w;
    }
    if (s < 16) {
      float* o = p.out + (dir ? OUT_SB : OUT_SF) + ((size_t)(s * 8 + hh) * 64 + pp) * 128 + n4 * 4;
      *(float4*)o = h;
    }
  }
}

NOINL void attn_item(const P& p, int id) {
  char* smem = g_smem;
  const int tid = threadIdx.x, lane = tid & 63, wave = tid >> 6, lr = lane & 15, lg = lane >> 4;
  int row0, kvbase, Lk, hh;
  if (id < 512) { const int b = id >> 8; hh = (id >> 5) & 7; const int qb = id & 31; row0 = 4096 + b * 2048 + qb * 64; kvbase = 4096 + b * 2304; Lk = 2304; }
  else { const int i2 = id - 512; const int b = i2 >> 5; hh = (i2 >> 2) & 7; const int qb = i2 & 3; row0 = b * 256 + qb * 64; kvbase = b * 256; Lk = 256; }
  constexpr int LDK = 104, LDV = 72;
  bf16_t* sK = (bf16_t*)smem;
  bf16_t* sV = sK + 64 * LDK;
  const int qrow = row0 + wave * 16 + lr;
  bf16x8 qf[3];
#pragma unroll
  for (int ks = 0; ks < 3; ++ks) qf[ks] = *(const bf16x8*)(WSB(OFF_Q) + (size_t)qrow * 768 + hh * 96 + ks * 32 + lg * 8);
  f32x4 oacc[4];
#pragma unroll
  for (int i = 0; i < 4; ++i) oacc[i] = (f32x4){0.f, 0.f, 0.f, 0.f};
  float mrun = -1e30f, lrun = 0.f;
  const int nkt = Lk >> 6;
  for (int kt = 0; kt < nkt; ++kt) {
    const int kr0 = kvbase + kt * 64;
#pragma unroll
    for (int i = 0; i < 3; ++i) {
      const int c = tid + 256 * i;
      const int key = c / 12, cc = c - key * 12;
      const bf16_t* src = (cc < 8) ? WSB(OFF_KN) + (size_t)(kr0 + key) * 512 + hh * 64 + cc * 8
                                   : WSB(OFF_KPE) + (size_t)(kr0 + key) * 32 + (cc - 8) * 8;
      *(uint4*)(sK + key * LDK + cc * 8) = *(const uint4*)src;
    }
#pragma unroll
    for (int i = 0; i < 2; ++i) {
      const int c = tid + 256 * i;
      const int d = c >> 3, cc = c & 7;
      *(uint4*)(sV + d * LDV + cc * 8) = *(const uint4*)(WSB(OFF_VT) + (size_t)(hh * 64 + d) * 8704 + kr0 + cc * 8);
    }
    __syncthreads();
    f32x4 sacc[4];
#pragma unroll
    for (int n = 0; n < 4; ++n) sacc[n] = (f32x4){0.f, 0.f, 0.f, 0.f};
#pragma unroll
    for (int ks = 0; ks < 3; ++ks)
#pragma unroll
      for (int n = 0; n < 4; ++n) {
        const bf16x8 a = *(const bf16x8*)(sK + (n * 16 + lr) * LDK + ks * 32 + lg * 8);
        sacc[n] = mfma16(a, qf[ks], sacc[n]);
      }
    float mx = sacc[0][0];
#pragma unroll
    for (int n = 0; n < 4; ++n)
#pragma unroll
      for (int q = 0; q < 4; ++q) mx = fmaxf(mx, sacc[n][q]);
    mx = fmaxf(mx, __shfl_xor(mx, 16, 64));
    mx = fmaxf(mx, __shfl_xor(mx, 32, 64));
    const float mnew = fmaxf(mrun, mx);
    const float alpha = __expf(mrun - mnew);
    mrun = mnew;
    float ps = 0.f;
#pragma unroll
    for (int n = 0; n < 4; ++n)
#pragma unroll
      for (int q = 0; q < 4; ++q) { const float e = __expf(sacc[n][q] - mnew); sacc[n][q] = e; ps += e; }
    lrun = lrun * alpha + ps;
#pragma unroll
    for (int i = 0; i < 4; ++i)
#pragma unroll
      for (int q = 0; q < 4; ++q) oacc[i][q] *= alpha;
#pragma unroll
    for (int ks = 0; ks < 2; ++ks) {
      union { bf16x8 v; unsigned u[4]; } pf;
      pf.u[0] = pack2(sacc[2 * ks][0], sacc[2 * ks][1]);
      pf.u[1] = pack2(sacc[2 * ks][2], sacc[2 * ks][3]);
      pf.u[2] = pack2(sacc[2 * ks + 1][0], sacc[2 * ks + 1][1]);
      pf.u[3] = pack2(sacc[2 * ks + 1][2], sacc[2 * ks + 1][3]);
#pragma unroll
      for (int m = 0; m < 4; ++m) {
        union { bf16x8 v; uint2 h[2]; } av;
        const bf16_t* vp = sV + (m * 16 + lr) * LDV + ks * 32 + lg * 4;
        av.h[0] = *(const uint2*)(vp);
        av.h[1] = *(const uint2*)(vp + 16);
        oacc[m] = mfma16(av.v, pf.v, oacc[m]);
      }
    }
    __syncthreads();
  }
  lrun += __shfl_xor(lrun, 16, 64);
  lrun += __shfl_xor(lrun, 32, 64);
  const float inv = 1.f / lrun;
#pragma unroll
  for (int m = 0; m < 4; ++m) {
    uint2 o;
    o.x = pack2(oacc[m][0] * inv, oacc[m][1] * inv);
    o.y = pack2(oacc[m][2] * inv, oacc[m][3] * inv);
    *(uint2*)(WSB(OFF_CAT) + (size_t)qrow * 1024 + hh * 64 + m * 16 + lg * 4) = o;
  }
}

NOINL void ssd_y_item(const P& p, int item) {
  char* smem = g_smem;
  const int tid = threadIdx.x, lane = tid & 63, wave = tid >> 6, lr = lane & 15, lg = lane >> 4;
  const int cidx = item >> 2, half = (item >> 1) & 1, g = item & 1;
  const int r0 = cidx * 128;
  const int hh = g * 4 + wave;
  constexpr int LDC = 136, LDM = 72;
  bf16_t* sC = (bf16_t*)smem;
  bf16_t* sB = sC + 64 * LDC;
  bf16_t* sM = sB + 64 * LDC + wave * 64 * LDM;
  float* rowss = (float*)((bf16_t*)smem + 2 * 64 * LDC + 4 * 64 * LDM);
  const float* cum = WSF(OFF_CUM);
  const float* dtv = WSF(OFF_DTV);
#pragma unroll
  for (int i = 0; i < 4; ++i) {
    const int id = tid + 256 * i;
    const int rr = id >> 4, nc = (id & 15) * 8;
    *(uint4*)(sC + rr * LDC + nc) = *(const uint4*)(WSB(OFF_CM) + (size_t)(r0 + half * 64 + rr) * 256 + g * 128 + nc);
  }
  f32x4 Y[4][4];
#pragma unroll
  for (int i = 0; i < 4; ++i)
#pragma unroll
    for (int j = 0; j < 4; ++j) Y[i][j] = (f32x4){0.f, 0.f, 0.f, 0.f};
#pragma unroll 1
  for (int jh = 0; jh < 2; ++jh) {
    __syncthreads();
#pragma unroll
    for (int i = 0; i < 4; ++i) {
      const int id = tid + 256 * i;
      const int rr = id >> 4, nc = (id & 15) * 8;
      *(uint4*)(sB + rr * LDC + nc) = *(const uint4*)(WSB(OFF_BM) + (size_t)(r0 + jh * 64 + rr) * 256 + g * 128 + nc);
    }
    __syncthreads();
#pragma unroll 1
    for (int dir = 0; dir < 2; ++dir) {
      const bool use = dir == 0 ? (jh <= half) : (jh >= half);
      if (!use) continue;
      float cj[4], dj[4];
#pragma unroll
      for (int j = 0; j < 4; ++j) {
        const size_t tj = (size_t)dir * 8192 + r0 + jh * 64 + j * 16 + lr;
        cj[j] = cum[tj * 8 + hh];
        dj[j] = dtv[tj * 8 + hh];
      }
#pragma unroll
      for (int i = 0; i < 4; ++i) {
        f32x4 cb[4];
#pragma unroll
        for (int j = 0; j < 4; ++j) cb[j] = (f32x4){0.f, 0.f, 0.f, 0.f};
#pragma unroll 1
        for (int ks = 0; ks < 4; ++ks) {
          const bf16x8 a = *(const bf16x8*)(sC + (i * 16 + lr) * LDC + ks * 32 + lg * 8);
#pragma unroll
          for (int j = 0; j < 4; ++j) {
            const bf16x8 b = *(const bf16x8*)(sB + (j * 16 + lr) * LDC + ks * 32 + lg * 8);
            cb[j] = mfma16(a, b, cb[j]);
          }
        }
#pragma unroll
        for (int q = 0; q < 4; ++q) {
          const int il = i * 16 + lg * 4 + q;
          const int ti = half * 64 + il;
          const float ci = cum[((size_t)dir * 8192 + r0 + ti) * 8 + hh];
#pragma unroll
          for (int j = 0; j < 4; ++j) {
            const int tj = jh * 64 + j * 16 + lr;
            const bool ok = dir == 0 ? (tj <= ti) : (tj >= ti);
            const float val = ok ? cb[j][q] * __expf(ci - cj[j]) * dj[j] : 0.f;
            sM[il * LDM + j * 16 + lr] = f2bf(val);
          }
        }
        __builtin_amdgcn_sched_barrier(0);
      }
      __syncthreads();
#pragma unroll 1
      for (int ks = 0; ks < 2; ++ks) {
        bf16x8 af[4], bfr[4];
#pragma unroll
        for (int i = 0; i < 4; ++i) {
          af[i] = *(const bf16x8*)(sM + (i * 16 + lr) * LDM + ks * 32 + lg * 8);
          bfr[i] = *(const bf16x8*)(WSB(OFF_XST) + (size_t)(hh * 64 + i * 16 + lr) * 8192 + r0 + jh * 64 + ks * 32 + lg * 8);
        }
#pragma unroll
        for (int i = 0; i < 4; ++i)
#pragma unroll
          for (int j = 0; j < 4; ++j) Y[i][j] = mfma16(af[i], bfr[j], Y[i][j]);
      }
      __syncthreads();
    }
  }
#pragma unroll 1
  for (int dir = 0; dir < 2; ++dir) {
    const bf16_t* hp = WSB(OFF_H) + ((size_t)(dir * 64 + cidx) * 8 + hh) * 8192;
#pragma unroll
    for (int i = 0; i < 4; ++i) {
      f32x4 T[4];
#pragma unroll
      for (int j = 0; j < 4; ++j) T[j] = (f32x4){0.f, 0.f, 0.f, 0.f};
#pragma unroll 1
      for (int ks = 0; ks < 4; ++ks) {
        const bf16x8 a = *(const bf16x8*)(sC + (i * 16 + lr) * LDC + ks * 32 + lg * 8);
#pragma unroll
        for (int j = 0; j < 4; ++j) {
          const bf16x8 b = *(const bf16x8*)(hp + (size_t)(j * 16 + lr) * 128 + ks * 32 + lg * 8);
          T[j] = mfma16(a, b, T[j]);
        }
      }
#pragma unroll
      for (int q = 0; q < 4; ++q) {
        const int ti = half * 64 + i * 16 + lg * 4 + q;
        const float e = __expf(cum[((size_t)dir * 8192 + r0 + ti) * 8 + hh]);
#pragma unroll
        for (int j = 0; j < 4; ++j) Y[i][j][q] += e * T[j][q];
      }
      __builtin_amdgcn_sched_barrier(0);
    }
  }
  const float dsk = p.ssd_d[hh];
  const float* proj = WSF(OFF_R1);
#pragma unroll
  for (int i = 0; i < 4; ++i)
#pragma unroll
    for (int q = 0; q < 4; ++q) {
      const int il = i * 16 + lg * 4 + q;
      const size_t r = (size_t)r0 + half * 64 + il;
      float ss = 0.f;
#pragma unroll
      for (int j = 0; j < 4; ++j) {
        const int ch = hh * 64 + j * 16 + lr;
        const float xs = bf2f(WSB(OFF_XS)[r * 512 + ch]);
        const float z = proj[r * 2096 + 544 + ch];
        const float y = (Y[i][j][q] + dsk * xs) * silu(z);
        Y[i][j][q] = y;
        ss += y * y;
      }
      ss += __shfl_xor(ss, 1, 64);
      ss += __shfl_xor(ss, 2, 64);
      ss += __shfl_xor(ss, 4, 64);
      ss += __shfl_xor(ss, 8, 64);
      if (lr == 0) rowss[wave * 64 + il] = ss;
      __builtin_amdgcn_sched_barrier(0);
    }
  __syncthreads();
#pragma unroll
  for (int i = 0; i < 4; ++i)
#pragma unroll
    for (int q = 0; q < 4; ++q) {
      const int il = i * 16 + lg * 4 + q;
      const size_t r = (size_t)r0 + half * 64 + il;
      const float tot = rowss[il] + rowss[64 + il] + rowss[128 + il] + rowss[192 + il];
      const float rs = rsqrtf(tot * (1.f / 256.f) + 1e-6f);
#pragma unroll
      for (int j = 0; j < 4; ++j) {
        const int ch = hh * 64 + j * 16 + lr;
        WSB(OFF_CAT)[r * 1024 + 512 + ch] = f2bf(Y[i][j][q] * rs * p.ssd_norm[ch]);
      }
    }
  __syncthreads();
}

NOINL void pool_phase(const P& p) {
  const bf16_t* h = WSB(OFF_H);
  bf16_t* dst = WSB(OFF_CAT);
  const int total = 8192 * 128;
  for (int idx = blockIdx.x * 256 + threadIdx.x; idx < total; idx += gridDim.x * 256) {
    const int r = idx >> 7, cc = (idx & 127) * 8;
    int s0, L;
    if (r < 4096) { s0 = r & ~255; L = 256; } else { s0 = 4096 + ((r - 4096) & ~2047); L = 2048; }
    const int t = r - s0;
    const int w2 = 1 << (cc >> 8);
    const int lo = max(t - w2, 0), hi = min(t + w2, L);
    float acc[8] = {0, 0, 0, 0, 0, 0, 0, 0};
    for (int u = lo; u < hi; ++u) {
      const uint4 v = *(const uint4*)(h + (size_t)(s0 + u) * 1024 + cc);
      acc[0] += __uint_as_float(v.x << 16); acc[1] += __uint_as_float(v.x & 0xffff0000u);
      acc[2] += __uint_as_float(v.y << 16); acc[3] += __uint_as_float(v.y & 0xffff0000u);
      acc[4] += __uint_as_float(v.z << 16); acc[5] += __uint_as_float(v.z & 0xffff0000u);
      acc[6] += __uint_as_float(v.w << 16); acc[7] += __uint_as_float(v.w & 0xffff0000u);
    }
    const float inv = 1.f / (float)(hi - lo);
    const uint4 v = *(const uint4*)(h + (size_t)r * 1024 + cc);
    uint4 o;
    o.x = pack2(acc[0] * inv - __uint_as_float(v.x << 16), acc[1] * inv - __uint_as_float(v.x & 0xffff0000u));
    o.y = pack2(acc[2] * inv - __uint_as_float(v.y << 16), acc[3] * inv - __uint_as_float(v.y & 0xffff0000u));
    o.z = pack2(acc[4] * inv - __uint_as_float(v.z << 16), acc[5] * inv - __uint_as_float(v.z & 0xffff0000u));
    o.w = pack2(acc[6] * inv - __uint_as_float(v.w << 16), acc[7] * inv - __uint_as_float(v.w & 0xffff0000u));
    *(uint4*)(dst + (size_t)r * 1024 + cc) = o;
  }
}

NOINL void ph_gemm_proj(const P& p) {
  float* proj = WSF(OFF_R1);
  const bf16_t* A = WSB(OFF_H);
  const bf16_t* B = WSB(OFF_WIN);
  gemm_stream(64 * 17, 1024, 1024, 1024, g_smem,
    [=](int t) {
      TileInfo r;
      int m, n; tile_mn(t, 64, 17, m, n);
      r.m0 = m * 128; r.n0 = n * 128; r.ctx = 0;
      r.a = A + (size_t)r.m0 * 1024; r.b = B + (size_t)r.n0 * 1024;
      return r;
    },
    [&](int ctx, int row, int col, f32x4 v0, f32x4 v1) {
#pragma unroll
      for (int q = 0; q < 4; ++q) {
        if (col < 2096) proj[(size_t)(row + q) * 2096 + col] = v0[q];
        if (col + 16 < 2096) proj[(size_t)(row + q) * 2096 + col + 16] = v1[q];
      }
    });
}

NOINL void ph_gemm_f32out(const P& p, const bf16_t* A, int lda, const bf16_t* B, int ldb, int K, float* C, int N) {
  const int nN = N / 128;
  gemm_stream(64 * nN, lda, ldb, K, g_smem,
    [=](int t) {
      TileInfo r;
      int m, n; tile_mn(t, 64, nN, m, n);
      r.m0 = m * 128; r.n0 = n * 128; r.ctx = 0;
      r.a = A + (size_t)r.m0 * lda; r.b = B + (size_t)r.n0 * ldb;
      return r;
    },
    [&](int ctx, int row, int col, f32x4 v0, f32x4 v1) {
#pragma unroll
      for (int q = 0; q < 4; ++q) {
        C[(size_t)(row + q) * N + col] = v0[q];
        C[(size_t)(row + q) * N + col + 16] = v1[q];
      }
    });
}

NOINL void ph_gemm_q(const P& p) {
  bf16_t* qo = WSB(OFF_Q);
  const bf16_t* A = WSB(OFF_CQN);
  const bf16_t* B = WSB(OFF_WUQ);
  gemm_stream(64 * 6, 256, 256, 256, g_smem,
    [=](int t) {
      TileInfo r;
      int m, n; tile_mn(t, 64, 6, m, n);
      r.m0 = m * 128; r.n0 = n * 128; r.ctx = 0;
      r.a = A + (size_t)r.m0 * 256; r.b = B + (size_t)r.n0 * 256;
      return r;
    },
    [&](int ctx, int row, int col, f32x4 v0, f32x4 v1) {
      const float scl = 0.10206207261596575f;
      const int tn = col >> 4;
      const bool rope = ((tn % 6) == 4) && (row >= 4096);
      const int ii = col & 15;
      const float fr = rope_freq(ii & 7);
#pragma unroll
      for (int q = 0; q < 4; ++q) {
        float a = v0[q], b = v1[q];
        if (rope) {
          const int tt = (row + q - 4096) & 2047;
          const float pos = (ii < 8) ? (float)(tt >> 6) : (float)(tt & 63);
          const float ang = pos * fr;
          float cs, sn;
          fast_sincos(ang, sn, cs);
          const float x1 = a, x2 = b;
          a = x1 * cs - x2 * sn;
          b = x1 * sn + x2 * cs;
        }
        qo[(size_t)(row + q) * 768 + col] = f2bf(a * scl);
        qo[(size_t)(row + q) * 768 + col + 16] = f2bf(b * scl);
      }
    });
}

NOINL void ph_gemm_kv(const P& p) {
  bf16_t* kn = WSB(OFF_KN);
  bf16_t* vt = WSB(OFF_VT);
  const bf16_t* A = WSB(OFF_CKV);
  const bf16_t* B = WSB(OFF_WUKV);
  gemm_stream(68 * 8, 256, 256, 256, g_smem,
    [=](int t) {
      TileInfo r;
      int m, n; tile_mn(t, 68, 8, m, n);
      r.m0 = m * 128; r.n0 = n * 128; r.ctx = 0;
      r.a = A + (size_t)r.m0 * 256; r.b = B + (size_t)r.n0 * 256;
      return r;
    },
    [&](int ctx, int row, int col, f32x4 v0, f32x4 v1) {
      const int hh = col >> 7, j = col & 127;
      if (j < 64) {
#pragma unroll
        for (int q = 0; q < 4; ++q) {
          kn[(size_t)(row + q) * 512 + hh * 64 + j] = f2bf(v0[q]);
          kn[(size_t)(row + q) * 512 + hh * 64 + j + 16] = f2bf(v1[q]);
        }
      } else {
        uint2 o0, o1;
        o0.x = pack2(v0[0], v0[1]); o0.y = pack2(v0[2], v0[3]);
        o1.x = pack2(v1[0], v1[1]); o1.y = pack2(v1[2], v1[3]);
        *(uint2*)(vt + (size_t)(hh * 64 + j - 64) * 8704 + row) = o0;
        *(uint2*)(vt + (size_t)(hh * 64 + j - 64 + 16) * 8704 + row) = o1;
      }
    });
}

NOINL void ph_gemm_ffn_up(const P& p, int layer) {
  bf16_t* gu = WSB(OFF_R1);
  const bf16_t* A = WSB(OFF_H);
  const bf16_t* B = WSB(OFF_WGU) + (size_t)layer * 5632 * 1024;
  gemm_stream(64 * 44, 1024, 1024, 1024, g_smem,
    [=](int t) {
      TileInfo r;
      int m, n; tile_mn(t, 64, 44, m, n);
      r.m0 = m * 128; r.n0 = n * 128; r.ctx = 0;
      r.a = A + (size_t)r.m0 * 1024; r.b = B + (size_t)r.n0 * 1024;
      return r;
    },
    [&](int ctx, int row, int col, f32x4 v0, f32x4 v1) {
      const int oc = (col >> 5) * 16 + (col & 15);
#pragma unroll
      for (int q = 0; q < 4; ++q) gu[(size_t)(row + q) * 2816 + oc] = f2bf(silu(v0[q]) * v1[q]);
    });
}

NOINL void ph_gemm_pool(const P& p) {
  float* mix = WSF(OFF_R1);
  const bf16_t* A = WSB(OFF_CAT);
  const bf16_t* B = WSB(OFF_WPOOL);
  gemm_stream(512, 1024, 256, 256, g_smem,
    [=](int t) {
      TileInfo r;
      const int id = swz_tile(t, 512);
      const int g = id >> 7, rem = id & 127;
      r.m0 = (rem >> 1) * 128; r.n0 = (rem & 1) * 128; r.ctx = g;
      r.a = A + (size_t)r.m0 * 1024 + g * 256; r.b = B + (size_t)g * 65536 + (size_t)r.n0 * 256;
      return r;
    },
    [&](int g, int row, int col, f32x4 v0, f32x4 v1) {
      const int c0 = g * 256 + col;
      const float s0 = p.pool_scale[c0], s1 = p.pool_scale[c0 + 16];
#pragma unroll
      for (int q = 0; q < 4; ++q) {
        mix[(size_t)(row + q) * 1024 + c0] = v0[q] * s0;
        mix[(size_t)(row + q) * 1024 + c0 + 16] = v1[q] * s1;
      }
    });
}


#define XB_TMO      128
#define XB_XCNT(j)  (256  + 64 * (j))
#define XB_XSUB(j)  (1280 + 64 * (j))
#define XB_XGEN(j)  (2304 + 64 * (j))
#define XB_TOP      3328
#define XB_TOPGEN   3392
#define XCD_BAR_WORDS 3456
#define XB_SPIN_CAP (1u << 22)
#define LAS __attribute__((address_space(3)))
DEVI unsigned xb_ld(unsigned* p) { return __hip_atomic_load(p, __ATOMIC_RELAXED, __HIP_MEMORY_SCOPE_AGENT); }
DEVI unsigned xb_add(unsigned* p, unsigned v) { return __hip_atomic_fetch_add(p, v, __ATOMIC_RELAXED, __HIP_MEMORY_SCOPE_AGENT); }
DEVI unsigned xb_xcc_id() { return (unsigned)__builtin_amdgcn_s_getreg((3 << 11) | 20) & 0xFu; }
#define XB_SPIN(cond, bar) do { unsigned _sp = 0; while (cond) { __builtin_amdgcn_s_sleep(1); \
    if ((++_sp & 255u) == 0u) { if (xb_ld(&(bar)[XB_TMO])) break; if (_sp > XB_SPIN_CAP) { atomicAdd(&(bar)[XB_TMO], 1u); break; } } } } while (0)
struct XcdBarrier { unsigned* bar; unsigned x; volatile LAS unsigned* st; };
DEVI XcdBarrier xcd_barrier_post(unsigned* bar, volatile LAS unsigned* st) {
  XcdBarrier b; b.bar = bar; b.x = xb_xcc_id(); b.st = st;
  if (threadIdx.x == 0) (void)xb_add(&bar[XB_XCNT(b.x)], 1u);
  return b;
}
DEVI void xcd_barrier_complete(unsigned* bar, unsigned x, unsigned& nloc, unsigned& nx) {
  const unsigned G = gridDim.x * gridDim.y * gridDim.z;
  unsigned sum, cnt, mine, sp = 0u;
  for (;;) {
    sum = 0u; cnt = 0u; mine = 0u;
#pragma unroll
    for (unsigned j = 0; j < 16; ++j) { const unsigned c = xb_ld(&bar[XB_XCNT(j)]); sum += c; cnt += (c > 0u) ? 1u : 0u; mine = (j == x) ? c : mine; }
    if (sum == G) break;
    __builtin_amdgcn_s_sleep(1);
    if ((++sp & 255u) == 0u) { if (xb_ld(&bar[XB_TMO])) break; if (sp > XB_SPIN_CAP) { atomicAdd(&bar[XB_TMO], 1u); break; } }
  }
  nloc = mine > 0u ? mine : 1u; nx = cnt > 0u ? cnt : 1u;
}
DEVI void xcd_barrier(const XcdBarrier& b) {
  asm volatile("s_waitcnt vmcnt(0)" ::: "memory");
  __syncthreads();
  if (threadIdx.x == 0) {
    unsigned* bar = b.bar;
    __builtin_amdgcn_s_waitcnt(0);
    unsigned nloc = b.st[0], nx = b.st[1];
    if (nloc == 0u) { xcd_barrier_complete(bar, b.x, nloc, nx); b.st[0] = nloc; b.st[1] = nx; }
    const unsigned old = xb_add(&bar[XB_XSUB(b.x)], 1u);
    const unsigned gen = old / nloc;
    if (old + 1u == (gen + 1u) * nloc) {
      __builtin_amdgcn_fence(__ATOMIC_RELEASE, "agent");
      asm volatile("s_waitcnt vmcnt(0)" ::: "memory");
      const unsigned og = xb_add(&bar[XB_TOP], 1u);
      const unsigned tg = og / nx;
      if (og + 1u == (tg + 1u) * nx) xb_add(&bar[XB_TOPGEN], 1u);
      else XB_SPIN(xb_ld(&bar[XB_TOPGEN]) == tg, bar);
      __builtin_amdgcn_fence(__ATOMIC_ACQUIRE, "agent");
      xb_add(&bar[XB_XGEN(b.x)], 1u);
      asm volatile("s_waitcnt vmcnt(0)" ::: "memory");
    } else {
      XB_SPIN(xb_ld(&bar[XB_XGEN(b.x)]) == gen, bar);
      __builtin_amdgcn_fence(__ATOMIC_ACQUIRE, "agent");
      asm volatile("s_waitcnt vmcnt(0)" ::: "memory");
    }
  }
  __syncthreads();
}

constexpr int NPHASE = 18;
#ifndef REPMASK
#define REPMASK 0
#endif
#ifndef PHMASK
#define PHMASK 0x3ffff
#endif
#define PH(n) if constexpr ((PHMASK >> (n)) & 1)

__global__ void __launch_bounds__(256, 2) mega(P p, int lo, int hi) {
  __shared__ uint4 xb_words;
  if (threadIdx.x == 0) xb_words = make_uint4(0u, 0u, 0u, 0u);
  __syncthreads();
  XcdBarrier xb = xcd_barrier_post((unsigned*)(p.ws + OFF_BAR), (volatile LAS unsigned*)&xb_words);
  if (lo < 0) cg::this_grid().sync();
  PH(0) if (lo <= 0 && 0 < hi) {
        for (int t = blockIdx.x; t < 384 + 5200; t += gridDim.x) {
          if (t < 384) gemv_tile(p, t); else transpose_tile(p, t - 384);
        }
#if (REPMASK >> 0) & 1
    xcd_barrier(xb);
        for (int t = blockIdx.x; t < 384 + 5200; t += gridDim.x) {
          if (t < 384) gemv_tile(p, t); else transpose_tile(p, t - 384);
        }
#endif
  }
  if (lo <= 0 && 0 + 1 < hi) xcd_barrier(xb);
  PH(1) if (lo <= 1 && 1 < hi) {
        rowop<false, true, true>(p, nullptr, nullptr, 0, p.n_pre_mix, 0, 1, 0, 0);
#if (REPMASK >> 1) & 1
    xcd_barrier(xb);
        rowop<false, true, true>(p, nullptr, nullptr, 0, p.n_pre_mix, 0, 1, 0, 0);
#endif
  }
  if (lo <= 1 && 1 + 1 < hi) xcd_barrier(xb);
  PH(2) if (lo <= 2 && 2 < hi) {
        ph_gemm_proj(p);
#if (REPMASK >> 2) & 1
    xcd_barrier(xb);
        ph_gemm_proj(p);
#endif
  }
  if (lo <= 2 && 2 + 1 < hi) xcd_barrier(xb);
  PH(3) if (lo <= 3 && 3 < hi) {
        prep_rows(p);
        prep_cache(p);
        for (int t = blockIdx.x; t < 2048; t += gridDim.x) conv_tile(p, t);
#if (REPMASK >> 3) & 1
    xcd_barrier(xb);
        prep_rows(p);
        prep_cache(p);
        for (int t = blockIdx.x; t < 2048; t += gridDim.x) conv_tile(p, t);
#endif
  }
  if (lo <= 3 && 3 + 1 < hi) xcd_barrier(xb);
  PH(4) if (lo <= 4 && 4 < hi) {
        ph_gemm_q(p);
        ph_gemm_kv(p);
        for (int t = blockIdx.x; t < 512; t += gridDim.x) chunk_state_item(p, t);
#if (REPMASK >> 4) & 1
    xcd_barrier(xb);
        ph_gemm_q(p);
        ph_gemm_kv(p);
        for (int t = blockIdx.x; t < 512; t += gridDim.x) chunk_state_item(p, t);
#endif
  }
  if (lo <= 4 && 4 + 1 < hi) xcd_barrier(xb);
  PH(5) if (lo <= 5 && 5 < hi) {
        scan_states(p);
#if (REPMASK >> 5) & 1
    xcd_barrier(xb);
        scan_states(p);
#endif
  }
  if (lo <= 5 && 5 + 1 < hi) xcd_barrier(xb);
  PH(6) if (lo <= 6 && 6 < hi) {
        for (int t = blockIdx.x; t < 1024 + 256; t += gridDim.x) {
#ifndef P6SEL
#define P6SEL 3
#endif
          if (t < 1024) { if constexpr (P6SEL & 1) attn_item(p, t); } else { if constexpr (P6SEL & 2) ssd_y_item(p, t - 1024); }
        }
#if (REPMASK >> 6) & 1
    xcd_barrier(xb);
        for (int t = blockIdx.x; t < 1024 + 256; t += gridDim.x) {
#ifndef P6SEL
#define P6SEL 3
#endif
          if (t < 1024) { if constexpr (P6SEL & 1) attn_item(p, t); } else { if constexpr (P6SEL & 2) ssd_y_item(p, t - 1024); }
        }
#endif
  }
  if (lo <= 6 && 6 + 1 < hi) xcd_barrier(xb);
  PH(7) if (lo <= 7 && 7 < hi) {
        ph_gemm_f32out(p, WSB(OFF_CAT), 1024, WSB(OFF_WOUT), 1024, 1024, WSF(OFF_R1), 1024);
#if (REPMASK >> 7) & 1
    xcd_barrier(xb);
        ph_gemm_f32out(p, WSB(OFF_CAT), 1024, WSB(OFF_WOUT), 1024, 1024, WSF(OFF_R1), 1024);
#endif
  }
  if (lo <= 7 && 7 + 1 < hi) xcd_barrier(xb);
  PH(8) if (lo <= 8 && 8 < hi) {
        rowop<true, true, true>(p, WSF(OFF_R1), p.n_post_mix, 2, p.n_pre_ffn, 3, 4, 0, 0);
#if (REPMASK >> 8) & 1
    xcd_barrier(xb);
        rowop<true, true, true>(p, WSF(OFF_R1), p.n_post_mix, 2, p.n_pre_ffn, 3, 4, 0, 0);
#endif
  }
  if (lo <= 8 && 8 + 1 < hi) xcd_barrier(xb);
  PH(9) if (lo <= 9 && 9 < hi) {
        ph_gemm_ffn_up(p, 0);
#if (REPMASK >> 9) & 1
    xcd_barrier(xb);
        ph_gemm_ffn_up(p, 0);
#endif
  }
  if (lo <= 9 && 9 + 1 < hi) xcd_barrier(xb);
  PH(10) if (lo <= 10 && 10 < hi) {
        ph_gemm_f32out(p, WSB(OFF_R1), 2816, WSB(OFF_WDN), 2816, 2816, WSF(OFF_R2), 1024);
#if (REPMASK >> 10) & 1
    xcd_barrier(xb);
        ph_gemm_f32out(p, WSB(OFF_R1), 2816, WSB(OFF_WDN), 2816, 2816, WSF(OFF_R2), 1024);
#endif
  }
  if (lo <= 10 && 10 + 1 < hi) xcd_barrier(xb);
  PH(11) if (lo <= 11 && 11 < hi) {
        rowop<true, true, false>(p, WSF(OFF_R2), p.n_post_ffn, 5, p.n_pre_mix + 1024, 0, 1, 0, 1);
#if (REPMASK >> 11) & 1
    xcd_barrier(xb);
        rowop<true, true, false>(p, WSF(OFF_R2), p.n_post_ffn, 5, p.n_pre_mix + 1024, 0, 1, 0, 1);
#endif
  }
  if (lo <= 11 && 11 + 1 < hi) xcd_barrier(xb);
  PH(12) if (lo <= 12 && 12 < hi) {
        pool_phase(p);
#if (REPMASK >> 12) & 1
    xcd_barrier(xb);
        pool_phase(p);
#endif
  }
  if (lo <= 12 && 12 + 1 < hi) xcd_barrier(xb);
  PH(13) if (lo <= 13 && 13 < hi) {
        ph_gemm_pool(p);
#if (REPMASK >> 13) & 1
    xcd_barrier(xb);
        ph_gemm_pool(p);
#endif
  }
  if (lo <= 13 && 13 + 1 < hi) xcd_barrier(xb);
  PH(14) if (lo <= 14 && 14 < hi) {
        rowop<true, true, false>(p, WSF(OFF_R1), p.n_post_mix + 1024, 2, p.n_pre_ffn + 1024, 3, 4, 1, 1);
#if (REPMASK >> 14) & 1
    xcd_barrier(xb);
        rowop<true, true, false>(p, WSF(OFF_R1), p.n_post_mix + 1024, 2, p.n_pre_ffn + 1024, 3, 4, 1, 1);
#endif
  }
  if (lo <= 14 && 14 + 1 < hi) xcd_barrier(xb);
  PH(15) if (lo <= 15 && 15 < hi) {
        ph_gemm_ffn_up(p, 1);
#if (REPMASK >> 15) & 1
    xcd_barrier(xb);
        ph_gemm_ffn_up(p, 1);
#endif
  }
  if (lo <= 15 && 15 + 1 < hi) xcd_barrier(xb);
  PH(16) if (lo <= 16 && 16 < hi) {
        ph_gemm_f32out(p, WSB(OFF_R1), 2816, WSB(OFF_WDN) + (size_t)1024 * 2816, 2816, 2816, WSF(OFF_R2), 1024);
#if (REPMASK >> 16) & 1
    xcd_barrier(xb);
        ph_gemm_f32out(p, WSB(OFF_R1), 2816, WSB(OFF_WDN) + (size_t)1024 * 2816, 2816, 2816, WSF(OFF_R2), 1024);
#endif
  }
  if (lo <= 16 && 16 + 1 < hi) xcd_barrier(xb);
  PH(17) if (lo <= 17 && 17 < hi) {
        rowop<true, false, false>(p, WSF(OFF_R2), p.n_post_ffn + 1024, 5, nullptr, 0, 0, 1, 1);
#if (REPMASK >> 17) & 1
    xcd_barrier(xb);
        rowop<true, false, false>(p, WSF(OFF_R2), p.n_post_ffn + 1024, 5, nullptr, 0, 0, 1, 1);
#endif
  }
}

extern "C" void kernel_launch(void* const* d_in, const int* in_sizes, int n_in, void* d_out, int out_size, void* d_ws,
                              size_t ws_size, hipStream_t stream) {
  P p{};
  const float** f = (const float**)&p;
  for (int i = 0; i < 33; ++i) f[i] = (const float*)d_in[i];
  p.out = (float*)d_out;
  p.ws = (char*)d_ws;
  static int grid_blocks = 0;
  if (!grid_blocks) {
    int dev = 0, cus = 0, per_cu = 0;
    hipGetDevice(&dev);
    hipDeviceGetAttribute(&cus, hipDeviceAttributeMultiprocessorCount, dev);
    hipOccupancyMaxActiveBlocksPerMultiprocessor(&per_cu, mega, 256, 0);
    if (per_cu > 2) per_cu = 2;
    if (per_cu < 1) per_cu = 1;
    grid_blocks = cus * per_cu;
  }
  hipMemsetAsync((char*)d_ws + OFF_BAR, 0, XCD_BAR_WORDS * 4, stream);
#if SINGLE_LAUNCH
  int lo = 0, hi = NPHASE;
  void* args[] = {&p, &lo, &hi};
  hipError_t e = hipLaunchCooperativeKernel((void*)mega, dim3(grid_blocks), dim3(256), args, 0, stream);
  if (e != hipSuccess) fprintf(stderr, "cooperative launch failed: %s (grid %d)\n", hipGetErrorString(e), grid_blocks);
#else
  for (int ph = 0; ph < NPHASE; ++ph) mega<<<grid_blocks, 256, 0, stream>>>(p, ph, ph + 1);
#endif
}
```

```cpp
#include <hip/hip_runtime.h>
#include <hip/hip_cooperative_groups.h>
#include <stdint.h>
#include <stdio.h>
namespace cg = cooperative_groups;

#ifndef SINGLE_LAUNCH
#define SINGLE_LAUNCH 1
#endif

typedef __attribute__((ext_vector_type(8))) short bf16x8;
typedef __attribute__((ext_vector_type(4))) float f32x4;
typedef unsigned short bf16_t;

#define DEVI __device__ __forceinline__

constexpr size_t OFF_WIN   = 0;
constexpr size_t OFF_WUQ   = OFF_WIN   + (size_t)2176*1024*2;
constexpr size_t OFF_WUKV  = OFF_WUQ   + (size_t)768*256*2;
constexpr size_t OFF_WOUT  = OFF_WUKV  + (size_t)1024*256*2;
constexpr size_t OFF_WPOOL = OFF_WOUT  + (size_t)1024*1024*2;
constexpr size_t OFF_WGU   = OFF_WPOOL + (size_t)4*256*256*2;
constexpr size_t OFF_WDN   = OFF_WGU   + (size_t)2*5632*1024*2;
constexpr size_t OFF_MOD   = OFF_WDN   + (size_t)2*1024*2816*2;
constexpr size_t OFF_R1    = OFF_MOD   + (size_t)2*3*6144*4;
constexpr size_t OFF_R2    = OFF_R1    + (size_t)8192*2096*4;
constexpr size_t OFF_H     = OFF_R2    + (size_t)8192*1024*4;
constexpr size_t OFF_CAT   = OFF_H     + (size_t)8192*1024*2;
constexpr size_t OFF_Q     = OFF_CAT   + (size_t)8192*1024*2;
constexpr size_t OFF_KN    = OFF_Q     + (size_t)8192*768*2;
constexpr size_t OFF_VT    = OFF_KN    + (size_t)8704*512*2;
constexpr size_t OFF_CQN   = OFF_VT    + (size_t)8704*512*2;
constexpr size_t OFF_CKV   = OFF_CQN   + (size_t)8192*256*2;
constexpr size_t OFF_KPE   = OFF_CKV   + (size_t)8704*256*2;
constexpr size_t OFF_XS    = OFF_KPE   + (size_t)8704*32*2;
constexpr size_t OFF_XST   = OFF_XS    + (size_t)8192*512*2;
constexpr size_t OFF_BM    = OFF_XST   + (size_t)8192*512*2;
constexpr size_t OFF_BT    = OFF_BM    + (size_t)8192*256*2;
constexpr size_t OFF_CM    = OFF_BT    + (size_t)8192*256*2;
constexpr size_t OFF_DTV   = OFF_CM    + (size_t)8192*256*2;
constexpr size_t OFF_CUM   = OFF_DTV   + (size_t)2*8192*8*4;
constexpr size_t OFF_TOT   = OFF_CUM   + (size_t)2*8192*8*4;
constexpr size_t OFF_BAR   = OFF_TOT   + 4096;
constexpr size_t OFF_END   = OFF_BAR   + 16384;

constexpr size_t OUT_CKV = 8388608, OUT_KR = 9437184, OUT_SF = 9568256, OUT_SB = 10616832;

struct P {
  const float *x_prompt, *x_sample, *c, *cache_ckv, *cache_kr, *st_f, *st_b, *c_ctx;
  const float *w_mod, *b_mod, *n_pre_mix, *n_post_mix, *n_pre_ffn, *n_post_ffn;
  const float *w_in, *q_norm, *w_uq, *kv_norm, *w_ukv, *conv_w, *conv_b, *dtb_f, *dtb_b, *alog_f, *alog_b;
  const float *ssd_d, *ssd_norm, *w_out, *pool_w, *pool_scale, *w_gate, *w_up, *w_down;
  float* out;
  char* ws;
};

#define WSB(off) ((bf16_t*)(p.ws + (off)))
#define WSF(off) ((float*)(p.ws + (off)))

DEVI bf16_t f2bf(float f) {
  unsigned u = __float_as_uint(f);
  u += 0x7fffu + ((u >> 16) & 1u);
  return (bf16_t)(u >> 16);
}
DEVI float bf2f(bf16_t b) { return __uint_as_float(((unsigned)b) << 16); }
DEVI unsigned pack2(float a, float b) { return (unsigned)f2bf(a) | ((unsigned)f2bf(b) << 16); }
DEVI float silu(float x) { return x / (1.f + __expf(-x)); }
DEVI float wave_sum(float v) {
#pragma unroll
  for (int o = 32; o > 0; o >>= 1) v += __shfl_xor(v, o, 64);
  return v;
}
DEVI f32x4 mfma16(bf16x8 a, bf16x8 b, f32x4 c) { return __builtin_amdgcn_mfma_f32_16x16x32_bf16(a, b, c, 0, 0, 0); }

DEVI float rope_freq(int m) { return exp2f(-(float)m * 1.6609640474436813f); }
DEVI void fast_sincos(float ang, float& sn, float& cs) {
  float rev = ang * 0.15915494309189535f;
  rev -= rintf(rev);
  sn = __builtin_amdgcn_sinf(rev);
  cs = __builtin_amdgcn_cosf(rev);
}
DEVI int opaque_tid() { int t = threadIdx.x; asm volatile("" : "+v"(t)); return t; }
DEVI int swz_tile(int t, int T) {
  int q = T >> 3, r = T & 7, x = t & 7, off = t >> 3;
  return (x < r ? x * (q + 1) : r * (q + 1) + (x - r) * q) + off;
}

__shared__ __attribute__((aligned(16))) char g_smem[73728];
#define NOINL __device__ __forceinline__

constexpr int LDT = 72;
constexpr int TILE_E = 128 * LDT;

template <class Epi>
DEVI void gemm_tile(const bf16_t* __restrict__ A, int lda, const bf16_t* __restrict__ B, int ldb, int K,
                    int m0, int n0, char* smem, Epi epi) {
  const int tid = threadIdx.x, lane = tid & 63, wave = tid >> 6, wm = wave >> 1, wn = wave & 1;
  const int lr = lane & 15, lg = lane >> 4;
  bf16_t* sA = (bf16_t*)smem;
  bf16_t* sB = sA + 2 * TILE_E;
  f32x4 acc[4][4];
#pragma unroll
  for (int i = 0; i < 4; ++i)
#pragma unroll
    for (int j = 0; j < 4; ++j) acc[i][j] = (f32x4){0.f, 0.f, 0.f, 0.f};
  const int lrow = tid >> 3, lkc = (tid & 7) * 8;
  const bf16_t* gA = A + (size_t)(m0 + lrow) * lda + lkc;
  const bf16_t* gB = B + (size_t)(n0 + lrow) * ldb + lkc;
  uint4 ra[4], rb[4];
#pragma unroll
  for (int i = 0; i < 4; ++i) {
    ra[i] = *(const uint4*)(gA + (size_t)(32 * i) * lda);
    rb[i] = *(const uint4*)(gB + (size_t)(32 * i) * ldb);
  }
#pragma unroll
  for (int i = 0; i < 4; ++i) {
    *(uint4*)(sA + (lrow + 32 * i) * LDT + lkc) = ra[i];
    *(uint4*)(sB + (lrow + 32 * i) * LDT + lkc) = rb[i];
  }
  __syncthreads();
  const int nk = K >> 6;
  for (int kt = 0; kt < nk; ++kt) {
    const int cur = kt & 1;
    if (kt + 1 < nk) {
      const int k0 = (kt + 1) << 6;
#pragma unroll
      for (int i = 0; i < 4; ++i) {
        ra[i] = *(const uint4*)(gA + (size_t)(32 * i) * lda + k0);
        rb[i] = *(const uint4*)(gB + (size_t)(32 * i) * ldb + k0);
      }
    }
    const bf16_t* cA = sA + cur * TILE_E + (wm * 64 + lr) * LDT + lg * 8;
    const bf16_t* cB = sB + cur * TILE_E + (wn * 64 + lr) * LDT + lg * 8;
#pragma unroll
    for (int ks = 0; ks < 2; ++ks) {
      bf16x8 af[4], bfr[4];
#pragma unroll
      for (int i = 0; i < 4; ++i) {
        af[i] = *(const bf16x8*)(cA + i * 16 * LDT + ks * 32);
        bfr[i] = *(const bf16x8*)(cB + i * 16 * LDT + ks * 32);
      }
#pragma unroll
      for (int i = 0; i < 4; ++i)
#pragma unroll
        for (int j = 0; j < 4; ++j) acc[i][j] = mfma16(af[i], bfr[j], acc[i][j]);
    }
    if (kt + 1 < nk) {
      const int nx = cur ^ 1;
#pragma unroll
      for (int i = 0; i < 4; ++i) {
        *(uint4*)(sA + nx * TILE_E + (lrow + 32 * i) * LDT + lkc) = ra[i];
        *(uint4*)(sB + nx * TILE_E + (lrow + 32 * i) * LDT + lkc) = rb[i];
      }
    }
    __syncthreads();
  }
#pragma unroll
  for (int i = 0; i < 4; ++i)
#pragma unroll
    for (int j = 0; j < 4; j += 2)
      epi(m0 + wm * 64 + i * 16 + lg * 4, n0 + wn * 64 + j * 16 + lr, acc[i][j], acc[i][j + 1]);
}

struct TileInfo { const bf16_t* a; const bf16_t* b; int m0, n0, ctx; };
template <class TileFn, class Epi>
DEVI void gemm_stream(int T, int lda, int ldb, int K, char* smem, TileFn tf, Epi epi) {
  int t = blockIdx.x;
  if (t >= T) return;
  const int tid = opaque_tid(), lane = tid & 63, wave = tid >> 6, wm = wave >> 1, wn = wave & 1;
  const int lr = lane & 15, lg = lane >> 4;
  bf16_t* sA = (bf16_t*)smem;
  bf16_t* sB = sA + 2 * TILE_E;
  const int lrow = tid >> 3, lkc = (tid & 7) * 8;
  TileInfo ti = tf(t);
  const bf16_t* gA = ti.a + (size_t)lrow * lda + lkc;
  const bf16_t* gB = ti.b + (size_t)lrow * ldb + lkc;
  int m0 = ti.m0, n0 = ti.n0, ctx = ti.ctx;
  uint4 ra0, ra1, ra2, ra3, rb0, rb1, rb2, rb3;
  uint4 rc0, rc1, rc2, rc3, rd0, rd1, rd2, rd3;
#define GS_LOAD0(pa, pb) \
  ra0 = *(const uint4*)((pa)); ra1 = *(const uint4*)((pa) + (size_t)32 * lda); \
  ra2 = *(const uint4*)((pa) + (size_t)64 * lda); ra3 = *(const uint4*)((pa) + (size_t)96 * lda); \
  rb0 = *(const uint4*)((pb)); rb1 = *(const uint4*)((pb) + (size_t)32 * ldb); \
  rb2 = *(const uint4*)((pb) + (size_t)64 * ldb); rb3 = *(const uint4*)((pb) + (size_t)96 * ldb);
#define GS_LOAD1(pa, pb) \
  rc0 = *(const uint4*)((pa)); rc1 = *(const uint4*)((pa) + (size_t)32 * lda); \
  rc2 = *(const uint4*)((pa) + (size_t)64 * lda); rc3 = *(const uint4*)((pa) + (size_t)96 * lda); \
  rd0 = *(const uint4*)((pb)); rd1 = *(const uint4*)((pb) + (size_t)32 * ldb); \
  rd2 = *(const uint4*)((pb) + (size_t)64 * ldb); rd3 = *(const uint4*)((pb) + (size_t)96 * ldb);
#define GS_WRITE0(buf) { \
  bf16_t* wa = sA + (buf) * TILE_E + lrow * LDT + lkc; bf16_t* wb = sB + (buf) * TILE_E + lrow * LDT + lkc; \
  *(uint4*)(wa) = ra0; *(uint4*)(wa + 32 * LDT) = ra1; *(uint4*)(wa + 64 * LDT) = ra2; *(uint4*)(wa + 96 * LDT) = ra3; \
  *(uint4*)(wb) = rb0; *(uint4*)(wb + 32 * LDT) = rb1; *(uint4*)(wb + 64 * LDT) = rb2; *(uint4*)(wb + 96 * LDT) = rb3; }
#define GS_WRITE1(buf) { \
  bf16_t* wa = sA + (buf) * TILE_E + lrow * LDT + lkc; bf16_t* wb = sB + (buf) * TILE_E + lrow * LDT + lkc; \
  *(uint4*)(wa) = rc0; *(uint4*)(wa + 32 * LDT) = rc1; *(uint4*)(wa + 64 * LDT) = rc2; *(uint4*)(wa + 96 * LDT) = rc3; \
  *(uint4*)(wb) = rd0; *(uint4*)(wb + 32 * LDT) = rd1; *(uint4*)(wb + 64 * LDT) = rd2; *(uint4*)(wb + 96 * LDT) = rd3; }
#define GS_COMPUTE(buf) { \
    const bf16_t* cA = sA + (buf) * TILE_E + (wm * 64 + lr) * LDT + lg * 8; \
    const bf16_t* cB = sB + (buf) * TILE_E + (wn * 64 + lr) * LDT + lg * 8; \
    _Pragma("unroll") for (int ks = 0; ks < 2; ++ks) { \
      bf16x8 af[4], bfr[4]; \
      _Pragma("unroll") for (int i = 0; i < 4; ++i) { \
        af[i] = *(const bf16x8*)(cA + i * 16 * LDT + ks * 32); \
        bfr[i] = *(const bf16x8*)(cB + i * 16 * LDT + ks * 32); \
      } \
      __builtin_amdgcn_s_setprio(1); \
      _Pragma("unroll") for (int i = 0; i < 4; ++i) \
        _Pragma("unroll") for (int j = 0; j < 4; ++j) acc[i][j] = mfma16(af[i], bfr[j], acc[i][j]); \
      __builtin_amdgcn_s_setprio(0); \
    } }
  GS_LOAD0(gA, gB)
  GS_WRITE0(0)
  GS_LOAD1(gA + 64, gB + 64)
  __syncthreads();
  const int nk = K >> 6;
  for (;;) {
    f32x4 acc[4][4];
#pragma unroll
    for (int i = 0; i < 4; ++i)
#pragma unroll
      for (int j = 0; j < 4; ++j) acc[i][j] = (f32x4){0.f, 0.f, 0.f, 0.f};
    const int tn = t + gridDim.x;
    const bool have_next = tn < T;
    const bf16_t *nA = gA, *nB = gB;
    int nm0 = 0, nn0 = 0, nctx = 0;
    if (have_next) {
      const TileInfo tj = tf(tn);
      nA = tj.a + (size_t)lrow * lda + lkc;
      nB = tj.b + (size_t)lrow * ldb + lkc;
      nm0 = tj.m0; nn0 = tj.n0; nctx = tj.ctx;
    }
    for (int kt = 0; kt < nk; kt += 2) {
      {
        const bool wrap = (kt + 2 >= nk);
        const bf16_t* pa = wrap ? nA : gA + ((kt + 2) << 6);
        const bf16_t* pb = wrap ? nB : gB + ((kt + 2) << 6);
        GS_LOAD0(pa, pb)
        GS_COMPUTE(0)
        GS_WRITE1(1)
        __syncthreads();
      }
      {
        const bool wrap = (kt + 3 >= nk);
        const bf16_t* pa = wrap ? nA + 64 : gA + ((kt + 3) << 6);
        const bf16_t* pb = wrap ? nB + 64 : gB + ((kt + 3) << 6);
        GS_LOAD1(pa, pb)
        GS_COMPUTE(1)
        GS_WRITE0(0)
        __syncthreads();
      }
    }
#pragma unroll
    for (int i = 0; i < 4; ++i)
#pragma unroll
      for (int j = 0; j < 4; j += 2)
        epi(ctx, m0 + wm * 64 + i * 16 + lg * 4, n0 + wn * 64 + j * 16 + lr, acc[i][j], acc[i][j + 1]);
    if (!have_next) break;
    t = tn; gA = nA; gB = nB; m0 = nm0; n0 = nn0; ctx = nctx;
  }
}

DEVI void tile_mn(int t, int nM, int nN, int& m, int& n) {
  int id = swz_tile(t, nM * nN);
  int per = 8 * nN;
  int gq = id / per, rem = id - gq * per;
  int gsz = min(8, nM - gq * 8);
  m = gq * 8 + rem % gsz;
  n = rem / gsz;
}

NOINL void gemv_tile(const P& p, int t) {
  char* smem = g_smem;
  const int tid = opaque_tid();
  float* sv = (float*)smem;
  float* red = sv + 3072;
  const int l = t / 192, n0 = (t % 192) * 32;
  for (int i = tid; i < 3072; i += 256) {
    int v = i >> 10, k = i & 1023;
    float cv = (v == 0) ? p.c_ctx[k] : p.c[(v - 1) * 1024 + k];
    sv[i] = cv / (1.f + expf(-cv));
  }
  __syncthreads();
  const int cgp = tid & 7, ks = tid >> 3;
  const float* w = p.w_mod + (size_t)l * 1024 * 6144 + n0 + cgp * 4;
  float a0[4] = {0, 0, 0, 0}, a1[4] = {0, 0, 0, 0}, a2[4] = {0, 0, 0, 0};
#pragma unroll 8
  for (int kk = 0; kk < 32; ++kk) {
    const int k = ks * 32 + kk;
    const float4 wv = *(const float4*)(w + (size_t)k * 6144);
    const float s0 = sv[k], s1 = sv[1024 + k], s2 = sv[2048 + k];
    a0[0] += s0 * wv.x; a0[1] += s0 * wv.y; a0[2] += s0 * wv.z; a0[3] += s0 * wv.w;
    a1[0] += s1 * wv.x; a1[1] += s1 * wv.y; a1[2] += s1 * wv.z; a1[3] += s1 * wv.w;
    a2[0] += s2 * wv.x; a2[1] += s2 * wv.y; a2[2] += s2 * wv.z; a2[3] += s2 * wv.w;
  }
#pragma unroll
  for (int j = 0; j < 4; ++j) {
    red[(ks * 3 + 0) * 32 + cgp * 4 + j] = a0[j];
    red[(ks * 3 + 1) * 32 + cgp * 4 + j] = a1[j];
    red[(ks * 3 + 2) * 32 + cgp * 4 + j] = a2[j];
  }
  __syncthreads();
  if (tid < 96) {
    const int v = tid >> 5, col = tid & 31;
    float s = 0.f;
    for (int q = 0; q < 32; ++q) s += red[(q * 3 + v) * 32 + col];
    s += p.b_mod[l * 6144 + n0 + col];
    WSF(OFF_MOD)[(l * 3 + v) * 6144 + n0 + col] = s;
  }
  __syncthreads();
}

NOINL void transpose_tile(const P& p, int t) {
  char* smem = g_smem;
  const int tid = opaque_tid();
  const float* src; bf16_t* dst; int K, N, ntn, mode = 0;
  if (t < 544) { src = p.w_in; dst = WSB(OFF_WIN); K = 1024; N = 2096; ntn = 34; }
  else if ((t -= 544) < 48) { src = p.w_uq; dst = WSB(OFF_WUQ); K = 256; N = 768; ntn = 12; }
  else if ((t -= 48) < 64) { src = p.w_ukv; dst = WSB(OFF_WUKV); K = 256; N = 1024; ntn = 16; }
  else if ((t -= 64) < 256) { src = p.w_out; dst = WSB(OFF_WOUT); K = 1024; N = 1024; ntn = 16; }
  else if ((t -= 256) < 64) { int g = t >> 4; t &= 15; src = p.pool_w + (size_t)g * 65536; dst = WSB(OFF_WPOOL) + (size_t)g * 65536; K = 256; N = 256; ntn = 4; }
  else if ((t -= 64) < 1408) { int l = t / 704; t -= l * 704; src = p.w_gate + (size_t)l * 1024 * 2816; dst = WSB(OFF_WGU) + (size_t)l * 5632 * 1024; K = 1024; N = 2816; ntn = 44; mode = 1; }
  else if ((t -= 1408) < 1408) { int l = t / 704; t -= l * 704; src = p.w_up + (size_t)l * 1024 * 2816; dst = WSB(OFF_WGU) + (size_t)l * 5632 * 1024; K = 1024; N = 2816; ntn = 44; mode = 2; }
  else { t -= 1408; int l = t / 704; t -= l * 704; src = p.w_down + (size_t)l * 2816 * 1024; dst = WSB(OFF_WDN) + (size_t)l * 1024 * 2816; K = 2816; N = 1024; ntn = 16; }
  const int kt = t / ntn, nt_ = t - kt * ntn;
  const int k0 = kt * 64, n0 = nt_ * 64;
  float* tile = (float*)smem;
  {
    const int nn = tid & 63, kk0 = tid >> 6;
    const int n = n0 + nn;
#pragma unroll 4
    for (int i = 0; i < 16; ++i) {
      const int kk = kk0 + 4 * i;
      tile[kk * 65 + nn] = (n < N) ? src[(size_t)(k0 + kk) * N + n] : 0.f;
    }
  }
  __syncthreads();
#pragma unroll
  for (int i = 0; i < 2; ++i) {
    const int id = tid + 256 * i;
    const int nn = id >> 3, kc = id & 7;
    const int n = n0 + nn;
    uint4 pk;
    pk.x = pack2(tile[(kc * 8 + 0) * 65 + nn], tile[(kc * 8 + 1) * 65 + nn]);
    pk.y = pack2(tile[(kc * 8 + 2) * 65 + nn], tile[(kc * 8 + 3) * 65 + nn]);
    pk.z = pack2(tile[(kc * 8 + 4) * 65 + nn], tile[(kc * 8 + 5) * 65 + nn]);
    pk.w = pack2(tile[(kc * 8 + 6) * 65 + nn], tile[(kc * 8 + 7) * 65 + nn]);
    int drow = n;
    if (mode == 1) drow = (n >> 4) * 32 + (n & 15);
    else if (mode == 2) drow = (n >> 4) * 32 + 16 + (n & 15);
    *(uint4*)(dst + (size_t)drow * K + k0 + kc * 8) = pk;
  }
  __syncthreads();
}

template <bool UPD, bool MOD, bool FIRST>
DEVI void rowop(const P& p, const float* msrc, const float* wpost, int gate_idx, const float* wpre, int shift_idx,
                int scale_idx, int layer_g, int layer_m) {
  const int lane = threadIdx.x & 63, wave = threadIdx.x >> 6;
  const float* modg = WSF(OFF_MOD) + (size_t)layer_g * 3 * 6144;
  const float* modm = WSF(OFF_MOD) + (size_t)layer_m * 3 * 6144;
  bf16_t* hbuf = WSB(OFF_H);
  for (int r = blockIdx.x * 4 + wave; r < 8192; r += gridDim.x * 4) {
    const int v = r < 4096 ? 0 : 1 + ((r - 4096) >> 11);
    const float* mvg = modg + v * 6144;
    const float* mvm = modm + v * 6144;
    const float* xin = FIRST ? (r < 4096 ? p.x_prompt + (size_t)r * 1024 : p.x_sample + (size_t)(r - 4096) * 1024)
                             : p.out + (size_t)r * 1024;
    float4 x[4];
#pragma unroll
    for (int i = 0; i < 4; ++i) x[i] = *(const float4*)(xin + lane * 4 + 256 * i);
    if (UPD) {
      float4 m[4];
      float ss = 0.f;
#pragma unroll
      for (int i = 0; i < 4; ++i) {
        m[i] = *(const float4*)(msrc + (size_t)r * 1024 + lane * 4 + 256 * i);
        ss += m[i].x * m[i].x + m[i].y * m[i].y + m[i].z * m[i].z + m[i].w * m[i].w;
      }
      ss = wave_sum(ss);
      const float rs = rsqrtf(ss * (1.f / 1024.f) + 1e-6f);
#pragma unroll
      for (int i = 0; i < 4; ++i) {
        const int col = lane * 4 + 256 * i;
        const float4 wp = *(const float4*)(wpost + col);
        const float4 g = *(const float4*)(mvg + gate_idx * 1024 + col);
        x[i].x += g.x * (m[i].x * rs * wp.x);
        x[i].y += g.y * (m[i].y * rs * wp.y);
        x[i].z += g.z * (m[i].z * rs * wp.z);
        x[i].w += g.w * (m[i].w * rs * wp.w);
        *(float4*)(p.out + (size_t)r * 1024 + col) = x[i];
      }
    }
    if (MOD) {
      float ss = 0.f;
#pragma unroll
      for (int i = 0; i < 4; ++i) ss += x[i].x * x[i].x + x[i].y * x[i].y + x[i].z * x[i].z + x[i].w * x[i].w;
      ss = wave_sum(ss);
      const float rs = rsqrtf(ss * (1.f / 1024.f) + 1e-6f);
#pragma unroll
      for (int i = 0; i < 4; ++i) {
        const int col = lane * 4 + 256 * i;
        const float4 wp = *(const float4*)(wpre + col);
        const float4 sh = *(const float4*)(mvm + shift_idx * 1024 + col);
        const float4 sc = *(const float4*)(mvm + scale_idx * 1024 + col);
        uint2 o;
        o.x = pack2(x[i].x * rs * wp.x * (1.f + sc.x) + sh.x, x[i].y * rs * wp.y * (1.f + sc.y) + sh.y);
        o.y = pack2(x[i].z * rs * wp.z * (1.f + sc.z) + sh.z, x[i].w * rs * wp.w * (1.f + sc.w) + sh.w);
        *(uint2*)(hbuf + (size_t)r * 1024 + col) = o;
      }
    }
  }
}

NOINL void prep_rows(const P& p) {
  const int lane = threadIdx.x & 63, wave = threadIdx.x >> 6;
  const float* proj = WSF(OFF_R1);
  for (int r = blockIdx.x * 4 + wave; r < 8192; r += gridDim.x * 4) {
    const float* pr = proj + (size_t)r * 2096;
    const int kvrow = r < 4096 ? r : 4096 + ((r - 4096) >> 11) * 2304 + 256 + ((r - 4096) & 2047);
    {
      const float4 a = *(const float4*)(pr + lane * 4);
      float ss = wave_sum(a.x * a.x + a.y * a.y + a.z * a.z + a.w * a.w);
      const float rs = rsqrtf(ss * (1.f / 256.f) + 1e-6f);
      const float4 g = *(const float4*)(p.q_norm + lane * 4);
      uint2 o;
      o.x = pack2(a.x * rs * g.x, a.y * rs * g.y);
      o.y = pack2(a.z * rs * g.z, a.w * rs * g.w);
      *(uint2*)(WSB(OFF_CQN) + (size_t)r * 256 + lane * 4) = o;
    }
    {
      const float4 a = *(const float4*)(pr + 256 + lane * 4);
      float ss = wave_sum(a.x * a.x + a.y * a.y + a.z * a.z + a.w * a.w);
      const float rs = rsqrtf(ss * (1.f / 256.f) + 1e-6f);
      const float4 g = *(const float4*)(p.kv_norm + lane * 4);
      float4 vv;
      vv.x = a.x * rs * g.x; vv.y = a.y * rs * g.y; vv.z = a.z * rs * g.z; vv.w = a.w * rs * g.w;
      if (r < 4096) *(float4*)(p.out + OUT_CKV + (size_t)r * 256 + lane * 4) = vv;
      uint2 o;
      o.x = pack2(vv.x, vv.y);
      o.y = pack2(vv.z, vv.w);
      *(uint2*)(WSB(OFF_CKV) + (size_t)kvrow * 256 + lane * 4) = o;
    }
    {
      const float kv = (lane < 32) ? pr[512 + lane] : 0.f;
      const float partner = __shfl_xor(kv, 16, 64);
      if (r < 4096) {
        if (lane < 32) {
          p.out[OUT_KR + (size_t)r * 32 + lane] = kv;
          WSB(OFF_KPE)[(size_t)kvrow * 32 + lane] = f2bf(kv);
        }
      } else {
        const int t = (r - 4096) & 2047;
        const int ii = lane & 15;
        const float pos = (ii < 8) ? (float)(t >> 6) : (float)(t & 63);
        const float fr = rope_freq(ii & 7);
        const float ang = pos * fr;
        float cs, sn;
        fast_sincos(ang, sn, cs);
        const float o = (lane < 16) ? (kv * cs - partner * sn) : (partner * sn + kv * cs);
        if (lane < 32) WSB(OFF_KPE)[(size_t)kvrow * 32 + lane] = f2bf(o);
      }
    }
    if (lane < 16) {
      const int dir = lane >> 3, hh = lane & 7;
      const float raw = pr[2080 + lane] + (dir ? p.dtb_b[hh] : p.dtb_f[hh]);
      const float sp = raw > 20.f ? raw : log1pf(expf(raw));
      WSF(OFF_DTV)[((size_t)dir * 8192 + r) * 8 + hh] = sp;
    }
  }
}

NOINL void prep_cache(const P& p) {
  const int gt = blockIdx.x * 256 + threadIdx.x, gs = gridDim.x * 256;
  for (int i = gt; i < 2 * 256 * 256; i += gs) {
    int b = i >> 16, rem = i & 65535;
    WSB(OFF_CKV)[(size_t)(4096 + b * 2304) * 256 + rem] = f2bf(p.cache_ckv[i]);
  }
  for (int i = gt; i < 2 * 256 * 32; i += gs) {
    int b = i >> 13, rem = i & 8191;
    WSB(OFF_KPE)[(size_t)(4096 + b * 2304) * 32 + rem] = f2bf(p.cache_kr[i]);
  }
}

NOINL void conv_tile(const P& p, int t) {
  char* smem = g_smem;
  const int tid = opaque_tid();
  float* sin_ = (float*)smem;
  float* sout = sin_ + 68 * 64;
  const int tt_ = t >> 4, ct = t & 15;
  const int r0 = tt_ * 64, c0 = ct * 64;
  int s0, s1;
  if (r0 < 4096) { s0 = r0 & ~255; s1 = s0 + 256; } else { s0 = 4096 + ((r0 - 4096) & ~2047); s1 = s0 + 2048; }
  const float* proj = WSF(OFF_R1);
  for (int i = tid; i < 68 * 64; i += 256) {
    const int rr = i >> 6, cc = i & 63;
    const int r = r0 - 2 + rr;
    float v = 0.f;
    if (r >= s0 && r < s1) v = proj[(size_t)r * 2096 + 1056 + c0 + cc];
    sin_[i] = v;
  }
  __syncthreads();
  {
    const int cc = tid & 63, tq = tid >> 6;
    const int c = c0 + cc;
    const float w0 = p.conv_w[c], w1 = p.conv_w[1024 + c], w2 = p.conv_w[2048 + c], w3 = p.conv_w[3072 + c],
                w4 = p.conv_w[4096 + c], bias = p.conv_b[c];
#pragma unroll 4
    for (int i = 0; i < 16; ++i) {
      const int tt = tq * 16 + i;
      float y = bias + w0 * sin_[tt * 64 + cc] + w1 * sin_[(tt + 1) * 64 + cc] + w2 * sin_[(tt + 2) * 64 + cc] +
                w3 * sin_[(tt + 3) * 64 + cc] + w4 * sin_[(tt + 4) * 64 + cc];
      y = y / (1.f + __expf(-y));
      sout[tt * 65 + cc] = y;
      const bf16_t b = f2bf(y);
      const size_t r = r0 + tt;
      if (c < 512) WSB(OFF_XS)[r * 512 + c] = b;
      else if (c < 768) WSB(OFF_BM)[r * 256 + (c - 512)] = b;
      else WSB(OFF_CM)[r * 256 + (c - 768)] = b;
    }
  }
  __syncthreads();
  if (c0 < 768) {
    const int cl = tid >> 2, q4 = tid & 3;
    uint4 o0, o1;
    const float* sp = sout + (q4 * 16) * 65 + cl;
    o0.x = pack2(sp[0 * 65], sp[1 * 65]);   o0.y = pack2(sp[2 * 65], sp[3 * 65]);
    o0.z = pack2(sp[4 * 65], sp[5 * 65]);   o0.w = pack2(sp[6 * 65], sp[7 * 65]);
    o1.x = pack2(sp[8 * 65], sp[9 * 65]);   o1.y = pack2(sp[10 * 65], sp[11 * 65]);
    o1.z = pack2(sp[12 * 65], sp[13 * 65]); o1.w = pack2(sp[14 * 65], sp[15 * 65]);
    bf16_t* dst = (c0 < 512) ? WSB(OFF_XST) + (size_t)(c0 + cl) * 8192 : WSB(OFF_BT) + (size_t)(c0 - 512 + cl) * 8192;
    dst += r0 + q4 * 16;
    *(uint4*)(dst) = o0;
    *(uint4*)(dst + 8) = o1;
  }
  __syncthreads();
}

NOINL void chunk_state_item(const P& p, int item) {
  char* smem = g_smem;
  const int tid = opaque_tid(), lane = tid & 63, wave = tid >> 6, lr = lane & 15, lg = lane >> 4;
  const int cidx = item >> 3, hh = item & 7, g = hh >> 2;
  const int r0 = cidx * 128;
  constexpr int LDS_ = 136;
  bf16_t* sAs = (bf16_t*)smem;
  bf16_t* sBs = sAs + 2 * 64 * LDS_;
  float* fa = (float*)(sBs + 128 * LDS_);
  float* fcum = fa + 256;
  float* fw = fa + 512;
  float* fdt = fa + 768;
  {
    const int dir = tid >> 7, j = tid & 127;
    const float dt = WSF(OFF_DTV)[((size_t)dir * 8192 + r0 + j) * 8 + hh];
    const float Aco = -expf(dir ? p.alog_b[hh] : p.alog_f[hh]);
    fa[tid] = dt * Aco;
    fdt[tid] = dt;
  }
  __syncthreads();
  {
    const int dir = tid >> 7, j = tid & 127;
    float s = 0.f;
    if (dir == 0) { for (int k = 0; k <= j; ++k) s += fa[k]; }
    else { for (int k = 127; k >= j; --k) s += fa[128 + k]; }
    fcum[tid] = s;
    WSF(OFF_CUM)[((size_t)dir * 8192 + r0 + j) * 8 + hh] = s;
  }
  __syncthreads();
  {
    const int dir = tid >> 7;
    const float ce = dir ? fcum[128] : fcum[127];
    fw[tid] = __expf(ce - fcum[tid]) * fdt[tid];
    if ((tid & 127) == 0) WSF(OFF_TOT)[(dir * 64 + cidx) * 8 + hh] = __expf(ce);
  }
  __syncthreads();
#pragma unroll
  for (int i = 0; i < 4; ++i) {
    const int id = tid + 256 * i;
    const int pp = id >> 4, jc = (id & 15) * 8;
    const uint4 raw = *(const uint4*)(WSB(OFF_XST) + (size_t)(hh * 64 + pp) * 8192 + r0 + jc);
    const unsigned rw[4] = {raw.x, raw.y, raw.z, raw.w};
    unsigned of[4], ob[4];
#pragma unroll
    for (int q = 0; q < 4; ++q) {
      const float x0 = __uint_as_float(rw[q] << 16), x1 = __uint_as_float(rw[q] & 0xffff0000u);
      of[q] = pack2(x0 * fw[jc + 2 * q], x1 * fw[jc + 2 * q + 1]);
      ob[q] = pack2(x0 * fw[128 + jc + 2 * q], x1 * fw[128 + jc + 2 * q + 1]);
    }
    *(uint4*)(sAs + pp * LDS_ + jc) = make_uint4(of[0], of[1], of[2], of[3]);
    *(uint4*)(sAs + 64 * LDS_ + pp * LDS_ + jc) = make_uint4(ob[0], ob[1], ob[2], ob[3]);
  }
#pragma unroll
  for (int i = 0; i < 8; ++i) {
    const int id = tid + 256 * i;
    const int nn = id >> 4, jc = (id & 15) * 8;
    *(uint4*)(sBs + nn * LDS_ + jc) = *(const uint4*)(WSB(OFF_BT) + (size_t)(g * 128 + nn) * 8192 + r0 + jc);
  }
  __syncthreads();
  {
    const int dir = wave >> 1, nh = wave & 1;
    f32x4 acc[4][4];
#pragma unroll
    for (int i = 0; i < 4; ++i)
#pragma unroll
      for (int j = 0; j < 4; ++j) acc[i][j] = (f32x4){0.f, 0.f, 0.f, 0.f};
    const bf16_t* cA = sAs + dir * 64 * LDS_ + lr * LDS_ + lg * 8;
    const bf16_t* cB = sBs + (nh * 64 + lr) * LDS_ + lg * 8;
#pragma unroll 1
    for (int ks = 0; ks < 4; ++ks) {
      bf16x8 af[4], bfr[4];
#pragma unroll
      for (int i = 0; i < 4; ++i) {
        af[i] = *(const bf16x8*)(cA + i * 16 * LDS_ + ks * 32);
        bfr[i] = *(const bf16x8*)(cB + i * 16 * LDS_ + ks * 32);
      }
#pragma unroll
      for (int i = 0; i < 4; ++i)
#pragma unroll
        for (int j = 0; j < 4; ++j) acc[i][j] = mfma16(af[i], bfr[j], acc[i][j]);
    }
    float* S = WSF(OFF_R2) + ((size_t)(dir * 64 + cidx) * 8 + hh) * 8192 + (lg * 4) * 128 + nh * 64 + lr;
#pragma unroll
    for (int i = 0; i < 4; ++i) {
#pragma unroll
      for (int q = 0; q < 4; ++q) {
#pragma unroll
        for (int j = 0; j < 4; ++j) S[j * 16] = acc[i][j][q];
        S += 128;
      }
      S += 12 * 128;
      __builtin_amdgcn_sched_barrier(0);
    }
  }
  __syncthreads();
}

NOINL void scan_states(const P& p) {
  const int total = 2 * 18 * 8 * 64 * 32;
  for (int idx = blockIdx.x * 256 + threadIdx.x; idx < total; idx += gridDim.x * 256) {
    const int n4 = idx & 31, pp = (idx >> 5) & 63, hh = (idx >> 11) & 7;
    const int sd = idx >> 14;
    const int s = sd % 18, dir = sd / 18;
    const int nc = s < 16 ? 2 : 16;
    const int cb = s < 16 ? s * 2 : 32 + (s - 16) * 16;
    float4 h = make_float4(0.f, 0.f, 0.f, 0.f);
    if (s >= 16) {
      const float* st = (dir ? p.st_b : p.st_f) + ((size_t)((s - 16) * 8 + hh) * 64 + pp) * 128 + n4 * 4;
      h = *(const float4*)st;
    }
    const size_t eoff = (size_t)pp * 128 + n4 * 4;
    for (int c = 0; c < nc; ++c) {
      const int cidx = cb + (dir ? nc - 1 - c : c);
      const size_t base = ((size_t)(dir * 64 + cidx) * 8 + hh) * 8192 + eoff;
      uint2 o;
      o.x = pack2(h.x, h.y);
      o.y = pack2(h.z, h.w);
      *(uint2*)(WSB(OFF_H) + base) = o;
      const float d = WSF(OFF_TOT)[(dir * 64 + cidx) * 8 + hh];
      const float4 sv = *(const float4*)(WSF(OFF_R2) + base);
      h.x = d * h.x + sv.x; h.y = d * h.y + sv.y; h.z = d * h.z + sv.z; h.w = d * h.w + sv.w;
    }
    if (s < 16) {
      float* o = p.out + (dir ? OUT_SB : OUT_SF) + ((size_t)(s * 8 + hh) * 64 + pp) * 128 + n4 * 4;
      *(float4*)o = h;
    }
  }
}

NOINL void attn_item(const P& p, int id) {
  char* smem = g_smem;
  const int tid = opaque_tid(), lane = tid & 63, wave = tid >> 6, lr = lane & 15, lg = lane >> 4;
  int row0, kvbase, Lk, hh;
  if (id < 512) { const int b = id >> 8; hh = (id >> 5) & 7; const int qb = id & 31; row0 = 4096 + b * 2048 + qb * 64; kvbase = 4096 + b * 2304; Lk = 2304; }
  else { const int i2 = id - 512; const int b = i2 >> 5; hh = (i2 >> 2) & 7; const int qb = i2 & 3; row0 = b * 256 + qb * 64; kvbase = b * 256; Lk = 256; }
  constexpr int LDK = 104, LDV = 72;
  constexpr int KVBUF = 64 * LDK + 64 * LDV;
  bf16_t* sKV = (bf16_t*)smem;
  const int qrow = row0 + wave * 16 + lr;
  bf16x8 qf[3];
#pragma unroll
  for (int ks = 0; ks < 3; ++ks) qf[ks] = *(const bf16x8*)(WSB(OFF_Q) + (size_t)qrow * 768 + hh * 96 + ks * 32 + lg * 8);
  f32x4 oacc[4];
#pragma unroll
  for (int i = 0; i < 4; ++i) oacc[i] = (f32x4){0.f, 0.f, 0.f, 0.f};
  float mrun = -1e30f, lrun = 0.f;
  const int nkt = Lk >> 6;
  const int kkey0 = tid / 12, kcc0 = tid - kkey0 * 12;
  const int c1 = tid + 256, kkey1 = c1 / 12, kcc1 = c1 - kkey1 * 12;
  const int c2 = tid + 512, kkey2 = c2 / 12, kcc2 = c2 - kkey2 * 12;
  const bf16_t* kn = WSB(OFF_KN);
  const bf16_t* kp = WSB(OFF_KPE);
  const bf16_t* ksrc0 = (kcc0 < 8) ? kn + (size_t)(kvbase + kkey0) * 512 + hh * 64 + kcc0 * 8 : kp + (size_t)(kvbase + kkey0) * 32 + (kcc0 - 8) * 8;
  const bf16_t* ksrc1 = (kcc1 < 8) ? kn + (size_t)(kvbase + kkey1) * 512 + hh * 64 + kcc1 * 8 : kp + (size_t)(kvbase + kkey1) * 32 + (kcc1 - 8) * 8;
  const bf16_t* ksrc2 = (kcc2 < 8) ? kn + (size_t)(kvbase + kkey2) * 512 + hh * 64 + kcc2 * 8 : kp + (size_t)(kvbase + kkey2) * 32 + (kcc2 - 8) * 8;
  const int kst0 = (kcc0 < 8) ? 512 * 64 : 32 * 64, kst1 = (kcc1 < 8) ? 512 * 64 : 32 * 64, kst2 = (kcc2 < 8) ? 512 * 64 : 32 * 64;
  const int vd0 = tid >> 3, vcc = tid & 7;
  const bf16_t* vsrc0 = WSB(OFF_VT) + (size_t)(hh * 64 + vd0) * 8704 + kvbase + vcc * 8;
  const bf16_t* vsrc1 = vsrc0 + (size_t)32 * 8704;
  uint4 rk0, rk1, rk2, rv0, rv1;
#define AT_LOAD(kt) { const int _k = (kt); \
    rk0 = *(const uint4*)(ksrc0 + (size_t)_k * kst0); rk1 = *(const uint4*)(ksrc1 + (size_t)_k * kst1); \
    rk2 = *(const uint4*)(ksrc2 + (size_t)_k * kst2); \
    rv0 = *(const uint4*)(vsrc0 + _k * 64); rv1 = *(const uint4*)(vsrc1 + _k * 64); }
#define AT_WRITE(buf) { bf16_t* _b = sKV + (buf) * KVBUF; \
    *(uint4*)(_b + kkey0 * LDK + kcc0 * 8) = rk0; *(uint4*)(_b + kkey1 * LDK + kcc1 * 8) = rk1; \
    *(uint4*)(_b + kkey2 * LDK + kcc2 * 8) = rk2; \
    *(uint4*)(_b + 64 * LDK + vd0 * LDV + vcc * 8) = rv0; *(uint4*)(_b + 64 * LDK + (vd0 + 32) * LDV + vcc * 8) = rv1; }
  AT_LOAD(0)
  AT_WRITE(0)
  __syncthreads();
  for (int kt = 0; kt < nkt; ++kt) {
    const int ktn = min(kt + 1, nkt - 1);
    AT_LOAD(ktn)
    const bf16_t* sK = sKV + (kt & 1) * KVBUF;
    const bf16_t* sV = sK + 64 * LDK;
    f32x4 sacc[4];
#pragma unroll
    for (int n = 0; n < 4; ++n) sacc[n] = (f32x4){0.f, 0.f, 0.f, 0.f};
#pragma unroll
    for (int ks = 0; ks < 3; ++ks)
#pragma unroll
      for (int n = 0; n < 4; ++n) {
        const bf16x8 a = *(const bf16x8*)(sK + (n * 16 + lr) * LDK + ks * 32 + lg * 8);
        sacc[n] = mfma16(a, qf[ks], sacc[n]);
      }
    float mx = sacc[0][0];
#pragma unroll
    for (int n = 0; n < 4; ++n)
#pragma unroll
      for (int q = 0; q < 4; ++q) mx = fmaxf(mx, sacc[n][q]);
    mx = fmaxf(mx, __shfl_xor(mx, 16, 64));
    mx = fmaxf(mx, __shfl_xor(mx, 32, 64));
    const float mnew = fmaxf(mrun, mx);
    const float alpha = __expf(mrun - mnew);
    mrun = mnew;
    float ps = 0.f;
#pragma unroll
    for (int n = 0; n < 4; ++n)
#pragma unroll
      for (int q = 0; q < 4; ++q) { const float e = __expf(sacc[n][q] - mnew); sacc[n][q] = e; ps += e; }
    lrun = lrun * alpha + ps;
#pragma unroll
    for (int i = 0; i < 4; ++i)
#pragma unroll
      for (int q = 0; q < 4; ++q) oacc[i][q] *= alpha;
#pragma unroll
    for (int ks = 0; ks < 2; ++ks) {
      union { bf16x8 v; unsigned u[4]; } pf;
      pf.u[0] = pack2(sacc[2 * ks][0], sacc[2 * ks][1]);
      pf.u[1] = pack2(sacc[2 * ks][2], sacc[2 * ks][3]);
      pf.u[2] = pack2(sacc[2 * ks + 1][0], sacc[2 * ks + 1][1]);
      pf.u[3] = pack2(sacc[2 * ks + 1][2], sacc[2 * ks + 1][3]);
#pragma unroll
      for (int m = 0; m < 4; ++m) {
        union { bf16x8 v; uint2 h[2]; } av;
        const bf16_t* vp = sV + (m * 16 + lr) * LDV + ks * 32 + lg * 4;
        av.h[0] = *(const uint2*)(vp);
        av.h[1] = *(const uint2*)(vp + 16);
        oacc[m] = mfma16(av.v, pf.v, oacc[m]);
      }
    }
    AT_WRITE((kt + 1) & 1)
    __syncthreads();
  }
  lrun += __shfl_xor(lrun, 16, 64);
  lrun += __shfl_xor(lrun, 32, 64);
  const float inv = 1.f / lrun;
#pragma unroll
  for (int m = 0; m < 4; ++m) {
    uint2 o;
    o.x = pack2(oacc[m][0] * inv, oacc[m][1] * inv);
    o.y = pack2(oacc[m][2] * inv, oacc[m][3] * inv);
    *(uint2*)(WSB(OFF_CAT) + (size_t)qrow * 1024 + hh * 64 + m * 16 + lg * 4) = o;
  }
}

NOINL void ssd_y_item(const P& p, int item) {
  char* smem = g_smem;
  const int tid = opaque_tid(), lane = tid & 63, wave = tid >> 6, lr = lane & 15, lg = lane >> 4;
  const int cidx = item >> 2, half = (item >> 1) & 1, g = item & 1;
  const int r0 = cidx * 128;
  const int hh = g * 4 + wave;
  constexpr int LDC = 136, LDM = 72;
  bf16_t* sC = (bf16_t*)smem;
  bf16_t* sB = sC + 64 * LDC;
  bf16_t* sM = sB + 64 * LDC + wave * 64 * LDM;
  float* rowss = (float*)((bf16_t*)smem + 2 * 64 * LDC + 4 * 64 * LDM);
  const float* cum = WSF(OFF_CUM);
  const float* dtv = WSF(OFF_DTV);
#pragma unroll
  for (int i = 0; i < 4; ++i) {
    const int id = tid + 256 * i;
    const int rr = id >> 4, nc = (id & 15) * 8;
    *(uint4*)(sC + rr * LDC + nc) = *(const uint4*)(WSB(OFF_CM) + (size_t)(r0 + half * 64 + rr) * 256 + g * 128 + nc);
  }
  f32x4 Y[4][4];
#pragma unroll
  for (int i = 0; i < 4; ++i)
#pragma unroll
    for (int j = 0; j < 4; ++j) Y[i][j] = (f32x4){0.f, 0.f, 0.f, 0.f};
#pragma unroll 1
  for (int jh = 0; jh < 2; ++jh) {
    __syncthreads();
#pragma unroll
    for (int i = 0; i < 4; ++i) {
      const int id = tid + 256 * i;
      const int rr = id >> 4, nc = (id & 15) * 8;
      *(uint4*)(sB + rr * LDC + nc) = *(const uint4*)(WSB(OFF_BM) + (size_t)(r0 + jh * 64 + rr) * 256 + g * 128 + nc);
    }
    __syncthreads();
#pragma unroll 1
    for (int dir = 0; dir < 2; ++dir) {
      const bool use = dir == 0 ? (jh <= half) : (jh >= half);
      if (!use) continue;
      float cj[4], dj[4];
#pragma unroll
      for (int j = 0; j < 4; ++j) {
        const size_t tj = (size_t)dir * 8192 + r0 + jh * 64 + j * 16 + lr;
        cj[j] = cum[tj * 8 + hh];
        dj[j] = dtv[tj * 8 + hh];
      }
#pragma unroll
      for (int i = 0; i < 4; ++i) {
        f32x4 cb[4];
#pragma unroll
        for (int j = 0; j < 4; ++j) cb[j] = (f32x4){0.f, 0.f, 0.f, 0.f};
#pragma unroll 1
        for (int ks = 0; ks < 4; ++ks) {
          const bf16x8 a = *(const bf16x8*)(sC + (i * 16 + lr) * LDC + ks * 32 + lg * 8);
#pragma unroll
          for (int j = 0; j < 4; ++j) {
            const bf16x8 b = *(const bf16x8*)(sB + (j * 16 + lr) * LDC + ks * 32 + lg * 8);
            cb[j] = mfma16(a, b, cb[j]);
          }
        }
#pragma unroll
        for (int q = 0; q < 4; ++q) {
          const int il = i * 16 + lg * 4 + q;
          const int ti = half * 64 + il;
          const float ci = cum[((size_t)dir * 8192 + r0 + ti) * 8 + hh];
#pragma unroll
          for (int j = 0; j < 4; ++j) {
            const int tj = jh * 64 + j * 16 + lr;
            const bool ok = dir == 0 ? (tj <= ti) : (tj >= ti);
            const float val = ok ? cb[j][q] * __expf(ci - cj[j]) * dj[j] : 0.f;
            sM[il * LDM + j * 16 + lr] = f2bf(val);
          }
        }
        __builtin_amdgcn_sched_barrier(0);
      }
      __syncthreads();
#pragma unroll 1
      for (int ks = 0; ks < 2; ++ks) {
        bf16x8 af[4], bfr[4];
#pragma unroll
        for (int i = 0; i < 4; ++i) {
          af[i] = *(const bf16x8*)(sM + (i * 16 + lr) * LDM + ks * 32 + lg * 8);
          bfr[i] = *(const bf16x8*)(WSB(OFF_XST) + (size_t)(hh * 64 + i * 16 + lr) * 8192 + r0 + jh * 64 + ks * 32 + lg * 8);
        }
#pragma unroll
        for (int i = 0; i < 4; ++i)
#pragma unroll
          for (int j = 0; j < 4; ++j) Y[i][j] = mfma16(af[i], bfr[j], Y[i][j]);
      }
      __syncthreads();
    }
  }
#pragma unroll 1
  for (int dir = 0; dir < 2; ++dir) {
    const bf16_t* hp = WSB(OFF_H) + ((size_t)(dir * 64 + cidx) * 8 + hh) * 8192;
#pragma unroll
    for (int i = 0; i < 4; ++i) {
      f32x4 T[4];
#pragma unroll
      for (int j = 0; j < 4; ++j) T[j] = (f32x4){0.f, 0.f, 0.f, 0.f};
#pragma unroll 1
      for (int ks = 0; ks < 4; ++ks) {
        const bf16x8 a = *(const bf16x8*)(sC + (i * 16 + lr) * LDC + ks * 32 + lg * 8);
#pragma unroll
        for (int j = 0; j < 4; ++j) {
          const bf16x8 b = *(const bf16x8*)(hp + (size_t)(j * 16 + lr) * 128 + ks * 32 + lg * 8);
          T[j] = mfma16(a, b, T[j]);
        }
      }
#pragma unroll
      for (int q = 0; q < 4; ++q) {
        const int ti = half * 64 + i * 16 + lg * 4 + q;
        const float e = __expf(cum[((size_t)dir * 8192 + r0 + ti) * 8 + hh]);
#pragma unroll
        for (int j = 0; j < 4; ++j) Y[i][j][q] += e * T[j][q];
      }
      __builtin_amdgcn_sched_barrier(0);
    }
  }
  const float dsk = p.ssd_d[hh];
  const float* proj = WSF(OFF_R1);
#pragma unroll
  for (int i = 0; i < 4; ++i)
#pragma unroll
    for (int q = 0; q < 4; ++q) {
      const int il = i * 16 + lg * 4 + q;
      const size_t r = (size_t)r0 + half * 64 + il;
      float ss = 0.f;
#pragma unroll
      for (int j = 0; j < 4; ++j) {
        const int ch = hh * 64 + j * 16 + lr;
        const float xs = bf2f(WSB(OFF_XS)[r * 512 + ch]);
        const float z = proj[r * 2096 + 544 + ch];
        const float y = (Y[i][j][q] + dsk * xs) * silu(z);
        Y[i][j][q] = y;
        ss += y * y;
      }
      ss += __shfl_xor(ss, 1, 64);
      ss += __shfl_xor(ss, 2, 64);
      ss += __shfl_xor(ss, 4, 64);
      ss += __shfl_xor(ss, 8, 64);
      if (lr == 0) rowss[wave * 64 + il] = ss;
      __builtin_amdgcn_sched_barrier(0);
    }
  __syncthreads();
#pragma unroll
  for (int i = 0; i < 4; ++i)
#pragma unroll
    for (int q = 0; q < 4; ++q) {
      const int il = i * 16 + lg * 4 + q;
      const size_t r = (size_t)r0 + half * 64 + il;
      const float tot = rowss[il] + rowss[64 + il] + rowss[128 + il] + rowss[192 + il];
      const float rs = rsqrtf(tot * (1.f / 256.f) + 1e-6f);
#pragma unroll
      for (int j = 0; j < 4; ++j) {
        const int ch = hh * 64 + j * 16 + lr;
        WSB(OFF_CAT)[r * 1024 + 512 + ch] = f2bf(Y[i][j][q] * rs * p.ssd_norm[ch]);
      }
    }
  __syncthreads();
}

NOINL void pool_phase(const P& p) {
  const bf16_t* h = WSB(OFF_H);
  bf16_t* dst = WSB(OFF_CAT);
  const int total = 8192 * 128;
  for (int idx = blockIdx.x * 256 + threadIdx.x; idx < total; idx += gridDim.x * 256) {
    const int r = idx >> 7, cc = (idx & 127) * 8;
    int s0, L;
    if (r < 4096) { s0 = r & ~255; L = 256; } else { s0 = 4096 + ((r - 4096) & ~2047); L = 2048; }
    const int t = r - s0;
    const int w2 = 1 << (cc >> 8);
    const int lo = max(t - w2, 0), hi = min(t + w2, L);
    float acc[8] = {0, 0, 0, 0, 0, 0, 0, 0};
    for (int u = lo; u < hi; ++u) {
      const uint4 v = *(const uint4*)(h + (size_t)(s0 + u) * 1024 + cc);
      acc[0] += __uint_as_float(v.x << 16); acc[1] += __uint_as_float(v.x & 0xffff0000u);
      acc[2] += __uint_as_float(v.y << 16); acc[3] += __uint_as_float(v.y & 0xffff0000u);
      acc[4] += __uint_as_float(v.z << 16); acc[5] += __uint_as_float(v.z & 0xffff0000u);
      acc[6] += __uint_as_float(v.w << 16); acc[7] += __uint_as_float(v.w & 0xffff0000u);
    }
    const float inv = 1.f / (float)(hi - lo);
    const uint4 v = *(const uint4*)(h + (size_t)r * 1024 + cc);
    uint4 o;
    o.x = pack2(acc[0] * inv - __uint_as_float(v.x << 16), acc[1] * inv - __uint_as_float(v.x & 0xffff0000u));
    o.y = pack2(acc[2] * inv - __uint_as_float(v.y << 16), acc[3] * inv - __uint_as_float(v.y & 0xffff0000u));
    o.z = pack2(acc[4] * inv - __uint_as_float(v.z << 16), acc[5] * inv - __uint_as_float(v.z & 0xffff0000u));
    o.w = pack2(acc[6] * inv - __uint_as_float(v.w << 16), acc[7] * inv - __uint_as_float(v.w & 0xffff0000u));
    *(uint4*)(dst + (size_t)r * 1024 + cc) = o;
  }
}

NOINL void ph_gemm_proj(const P& p) {
  float* proj = WSF(OFF_R1);
  const bf16_t* A = WSB(OFF_H);
  const bf16_t* B = WSB(OFF_WIN);
  gemm_stream(64 * 17, 1024, 1024, 1024, g_smem,
    [=](int t) {
      TileInfo r;
      int m, n; tile_mn(t, 64, 17, m, n);
      r.m0 = m * 128; r.n0 = n * 128; r.ctx = 0;
      r.a = A + (size_t)r.m0 * 1024; r.b = B + (size_t)r.n0 * 1024;
      return r;
    },
    [&](int ctx, int row, int col, f32x4 v0, f32x4 v1) {
#pragma unroll
      for (int q = 0; q < 4; ++q) {
        if (col < 2096) proj[(size_t)(row + q) * 2096 + col] = v0[q];
        if (col + 16 < 2096) proj[(size_t)(row + q) * 2096 + col + 16] = v1[q];
      }
    });
}

NOINL void ph_gemm_f32out(const P& p, const bf16_t* A, int lda, const bf16_t* B, int ldb, int K, float* C, int N) {
  const int nN = N / 128;
  gemm_stream(64 * nN, lda, ldb, K, g_smem,
    [=](int t) {
      TileInfo r;
      int m, n; tile_mn(t, 64, nN, m, n);
      r.m0 = m * 128; r.n0 = n * 128; r.ctx = 0;
      r.a = A + (size_t)r.m0 * lda; r.b = B + (size_t)r.n0 * ldb;
      return r;
    },
    [&](int ctx, int row, int col, f32x4 v0, f32x4 v1) {
#pragma unroll
      for (int q = 0; q < 4; ++q) {
        C[(size_t)(row + q) * N + col] = v0[q];
        C[(size_t)(row + q) * N + col + 16] = v1[q];
      }
    });
}

NOINL void ph_gemm_q(const P& p) {
  bf16_t* qo = WSB(OFF_Q);
  const bf16_t* A = WSB(OFF_CQN);
  const bf16_t* B = WSB(OFF_WUQ);
  gemm_stream(64 * 6, 256, 256, 256, g_smem,
    [=](int t) {
      TileInfo r;
      int m, n; tile_mn(t, 64, 6, m, n);
      r.m0 = m * 128; r.n0 = n * 128; r.ctx = 0;
      r.a = A + (size_t)r.m0 * 256; r.b = B + (size_t)r.n0 * 256;
      return r;
    },
    [&](int ctx, int row, int col, f32x4 v0, f32x4 v1) {
      const float scl = 0.10206207261596575f;
      const int tn = col >> 4;
      const bool rope = ((tn % 6) == 4) && (row >= 4096);
      const int ii = col & 15;
      const float fr = rope_freq(ii & 7);
#pragma unroll
      for (int q = 0; q < 4; ++q) {
        float a = v0[q], b = v1[q];
        if (rope) {
          const int tt = (row + q - 4096) & 2047;
          const float pos = (ii < 8) ? (float)(tt >> 6) : (float)(tt & 63);
          const float ang = pos * fr;
          float cs, sn;
          fast_sincos(ang, sn, cs);
          const float x1 = a, x2 = b;
          a = x1 * cs - x2 * sn;
          b = x1 * sn + x2 * cs;
        }
        qo[(size_t)(row + q) * 768 + col] = f2bf(a * scl);
        qo[(size_t)(row + q) * 768 + col + 16] = f2bf(b * scl);
      }
    });
}

NOINL void ph_gemm_kv(const P& p) {
  bf16_t* kn = WSB(OFF_KN);
  bf16_t* vt = WSB(OFF_VT);
  const bf16_t* A = WSB(OFF_CKV);
  const bf16_t* B = WSB(OFF_WUKV);
  gemm_stream(68 * 8, 256, 256, 256, g_smem,
    [=](int t) {
      TileInfo r;
      int m, n; tile_mn(t, 68, 8, m, n);
      r.m0 = m * 128; r.n0 = n * 128; r.ctx = 0;
      r.a = A + (size_t)r.m0 * 256; r.b = B + (size_t)r.n0 * 256;
      return r;
    },
    [&](int ctx, int row, int col, f32x4 v0, f32x4 v1) {
      const int hh = col >> 7, j = col & 127;
      if (j < 64) {
#pragma unroll
        for (int q = 0; q < 4; ++q) {
          kn[(size_t)(row + q) * 512 + hh * 64 + j] = f2bf(v0[q]);
          kn[(size_t)(row + q) * 512 + hh * 64 + j + 16] = f2bf(v1[q]);
        }
      } else {
        uint2 o0, o1;
        o0.x = pack2(v0[0], v0[1]); o0.y = pack2(v0[2], v0[3]);
        o1.x = pack2(v1[0], v1[1]); o1.y = pack2(v1[2], v1[3]);
        *(uint2*)(vt + (size_t)(hh * 64 + j - 64) * 8704 + row) = o0;
        *(uint2*)(vt + (size_t)(hh * 64 + j - 64 + 16) * 8704 + row) = o1;
      }
    });
}

NOINL void ph_gemm_ffn_up(const P& p, int layer) {
  bf16_t* gu = WSB(OFF_R1);
  const bf16_t* A = WSB(OFF_H);
  const bf16_t* B = WSB(OFF_WGU) + (size_t)layer * 5632 * 1024;
  gemm_stream(64 * 44, 1024, 1024, 1024, g_smem,
    [=](int t) {
      TileInfo r;
      int m, n; tile_mn(t, 64, 44, m, n);
      r.m0 = m * 128; r.n0 = n * 128; r.ctx = 0;
      r.a = A + (size_t)r.m0 * 1024; r.b = B + (size_t)r.n0 * 1024;
      return r;
    },
    [&](int ctx, int row, int col, f32x4 v0, f32x4 v1) {
      const int oc = (col >> 5) * 16 + (col & 15);
#pragma unroll
      for (int q = 0; q < 4; ++q) gu[(size_t)(row + q) * 2816 + oc] = f2bf(silu(v0[q]) * v1[q]);
    });
}

NOINL void ph_gemm_pool(const P& p) {
  float* mix = WSF(OFF_R1);
  const bf16_t* A = WSB(OFF_CAT);
  const bf16_t* B = WSB(OFF_WPOOL);
  gemm_stream(512, 1024, 256, 256, g_smem,
    [=](int t) {
      TileInfo r;
      const int id = swz_tile(t, 512);
      const int g = id >> 7, rem = id & 127;
      r.m0 = (rem >> 1) * 128; r.n0 = (rem & 1) * 128; r.ctx = g;
      r.a = A + (size_t)r.m0 * 1024 + g * 256; r.b = B + (size_t)g * 65536 + (size_t)r.n0 * 256;
      return r;
    },
    [&](int g, int row, int col, f32x4 v0, f32x4 v1) {
      const int c0 = g * 256 + col;
      const float s0 = p.pool_scale[c0], s1 = p.pool_scale[c0 + 16];
#pragma unroll
      for (int q = 0; q < 4; ++q) {
        mix[(size_t)(row + q) * 1024 + c0] = v0[q] * s0;
        mix[(size_t)(row + q) * 1024 + c0 + 16] = v1[q] * s1;
      }
    });
}


#define XB_TMO      128
#define XB_XCNT(j)  (256  + 64 * (j))
#define XB_XSUB(j)  (1280 + 64 * (j))
#define XB_XGEN(j)  (2304 + 64 * (j))
#define XB_TOP      3328
#define XB_TOPGEN   3392
#define XCD_BAR_WORDS 3456
#define XB_SPIN_CAP (1u << 22)
#define LAS __attribute__((address_space(3)))
DEVI unsigned xb_ld(unsigned* p) { return __hip_atomic_load(p, __ATOMIC_RELAXED, __HIP_MEMORY_SCOPE_AGENT); }
DEVI unsigned xb_add(unsigned* p, unsigned v) { return __hip_atomic_fetch_add(p, v, __ATOMIC_RELAXED, __HIP_MEMORY_SCOPE_AGENT); }
DEVI unsigned xb_xcc_id() { return (unsigned)__builtin_amdgcn_s_getreg((3 << 11) | 20) & 0xFu; }
#define XB_SPIN(cond, bar) do { unsigned _sp = 0; while (cond) { __builtin_amdgcn_s_sleep(1); \
    if ((++_sp & 255u) == 0u) { if (xb_ld(&(bar)[XB_TMO])) break; if (_sp > XB_SPIN_CAP) { atomicAdd(&(bar)[XB_TMO], 1u); break; } } } } while (0)
struct XcdBarrier { unsigned* bar; unsigned x; volatile LAS unsigned* st; };
DEVI XcdBarrier xcd_barrier_post(unsigned* bar, volatile LAS unsigned* st) {
  XcdBarrier b; b.bar = bar; b.x = xb_xcc_id(); b.st = st;
  if (threadIdx.x == 0) (void)xb_add(&bar[XB_XCNT(b.x)], 1u);
  return b;
}
DEVI void xcd_barrier_complete(unsigned* bar, unsigned x, unsigned& nloc, unsigned& nx) {
  const unsigned G = gridDim.x * gridDim.y * gridDim.z;
  unsigned sum, cnt, mine, sp = 0u;
  for (;;) {
    sum = 0u; cnt = 0u; mine = 0u;
#pragma unroll
    for (unsigned j = 0; j < 16; ++j) { const unsigned c = xb_ld(&bar[XB_XCNT(j)]); sum += c; cnt += (c > 0u) ? 1u : 0u; mine = (j == x) ? c : mine; }
    if (sum == G) break;
    __builtin_amdgcn_s_sleep(1);
    if ((++sp & 255u) == 0u) { if (xb_ld(&bar[XB_TMO])) break; if (sp > XB_SPIN_CAP) { atomicAdd(&bar[XB_TMO], 1u); break; } }
  }
  nloc = mine > 0u ? mine : 1u; nx = cnt > 0u ? cnt : 1u;
}
DEVI void xcd_barrier(const XcdBarrier& b) {
  asm volatile("s_waitcnt vmcnt(0)" ::: "memory");
  __syncthreads();
  if (threadIdx.x == 0) {
    unsigned* bar = b.bar;
    __builtin_amdgcn_s_waitcnt(0);
    unsigned nloc = b.st[0], nx = b.st[1];
    if (nloc == 0u) { xcd_barrier_complete(bar, b.x, nloc, nx); b.st[0] = nloc; b.st[1] = nx; }
    const unsigned old = xb_add(&bar[XB_XSUB(b.x)], 1u);
    const unsigned gen = old / nloc;
    if (old + 1u == (gen + 1u) * nloc) {
      __builtin_amdgcn_fence(__ATOMIC_RELEASE, "agent");
      asm volatile("s_waitcnt vmcnt(0)" ::: "memory");
      const unsigned og = xb_add(&bar[XB_TOP], 1u);
      const unsigned tg = og / nx;
      if (og + 1u == (tg + 1u) * nx) xb_add(&bar[XB_TOPGEN], 1u);
      else XB_SPIN(xb_ld(&bar[XB_TOPGEN]) == tg, bar);
      __builtin_amdgcn_fence(__ATOMIC_ACQUIRE, "agent");
      xb_add(&bar[XB_XGEN(b.x)], 1u);
      asm volatile("s_waitcnt vmcnt(0)" ::: "memory");
    } else {
      XB_SPIN(xb_ld(&bar[XB_XGEN(b.x)]) == gen, bar);
      __builtin_amdgcn_fence(__ATOMIC_ACQUIRE, "agent");
      asm volatile("s_waitcnt vmcnt(0)" ::: "memory");
    }
  }
  __syncthreads();
}

constexpr int NPHASE = 18;
#ifndef REPMASK
#define REPMASK 0
#endif
#ifndef PHMASK
#define PHMASK 0x3ffff
#endif
#define PH(n) if constexpr ((PHMASK >> (n)) & 1)

__global__ void __launch_bounds__(256, 2) mega(P p, int lo, int hi) {
  __shared__ uint4 xb_words;
  if (threadIdx.x == 0) xb_words = make_uint4(0u, 0u, 0u, 0u);
  __syncthreads();
  XcdBarrier xb = xcd_barrier_post((unsigned*)(p.ws + OFF_BAR), (volatile LAS unsigned*)&xb_words);
  if (lo < 0) cg::this_grid().sync();
  PH(0) if (lo <= 0 && 0 < hi) {
        for (int t = blockIdx.x; t < 384 + 5200; t += gridDim.x) {
          if (t < 384) gemv_tile(p, t); else transpose_tile(p, t - 384);
        }
#if (REPMASK >> 0) & 1
    xcd_barrier(xb);
        for (int t = blockIdx.x; t < 384 + 5200; t += gridDim.x) {
          if (t < 384) gemv_tile(p, t); else transpose_tile(p, t - 384);
        }
#endif
  }
  if (lo <= 0 && 0 + 1 < hi) xcd_barrier(xb);
  PH(1) if (lo <= 1 && 1 < hi) {
        rowop<false, true, true>(p, nullptr, nullptr, 0, p.n_pre_mix, 0, 1, 0, 0);
#if (REPMASK >> 1) & 1
    xcd_barrier(xb);
        rowop<false, true, true>(p, nullptr, nullptr, 0, p.n_pre_mix, 0, 1, 0, 0);
#endif
  }
  if (lo <= 1 && 1 + 1 < hi) xcd_barrier(xb);
  PH(2) if (lo <= 2 && 2 < hi) {
        ph_gemm_proj(p);
#if (REPMASK >> 2) & 1
    xcd_barrier(xb);
        ph_gemm_proj(p);
#endif
  }
  if (lo <= 2 && 2 + 1 < hi) xcd_barrier(xb);
  PH(3) if (lo <= 3 && 3 < hi) {
        prep_rows(p);
        prep_cache(p);
        for (int t = blockIdx.x; t < 2048; t += gridDim.x) conv_tile(p, t);
#if (REPMASK >> 3) & 1
    xcd_barrier(xb);
        prep_rows(p);
        prep_cache(p);
        for (int t = blockIdx.x; t < 2048; t += gridDim.x) conv_tile(p, t);
#endif
  }
  if (lo <= 3 && 3 + 1 < hi) xcd_barrier(xb);
  PH(4) if (lo <= 4 && 4 < hi) {
        ph_gemm_q(p);
        ph_gemm_kv(p);
        for (int t = blockIdx.x; t < 512; t += gridDim.x) chunk_state_item(p, t);
#if (REPMASK >> 4) & 1
    xcd_barrier(xb);
        ph_gemm_q(p);
        ph_gemm_kv(p);
        for (int t = blockIdx.x; t < 512; t += gridDim.x) chunk_state_item(p, t);
#endif
  }
  if (lo <= 4 && 4 + 1 < hi) xcd_barrier(xb);
  PH(5) if (lo <= 5 && 5 < hi) {
        scan_states(p);
#if (REPMASK >> 5) & 1
    xcd_barrier(xb);
        scan_states(p);
#endif
  }
  if (lo <= 5 && 5 + 1 < hi) xcd_barrier(xb);
  PH(6) if (lo <= 6 && 6 < hi) {
        for (int t = blockIdx.x; t < 1024; t += gridDim.x) {
          if (t >= 512 && t < 768) ssd_y_item(p, t - 512);
          else {
            const int first = t < 512 ? t : 512 + 2 * (t - 768);
            const int cnt = t < 512 ? 1 : 2;
            for (int k = 0; k < cnt; ++k) attn_item(p, first + k);
          }
        }
#if (REPMASK >> 6) & 1
    xcd_barrier(xb);
        for (int t = blockIdx.x; t < 1024; t += gridDim.x) {
          if (t >= 512 && t < 768) ssd_y_item(p, t - 512);
          else {
            const int first = t < 512 ? t : 512 + 2 * (t - 768);
            const int cnt = t < 512 ? 1 : 2;
            for (int k = 0; k < cnt; ++k) attn_item(p, first + k);
          }
        }
#endif
  }
  if (lo <= 6 && 6 + 1 < hi) xcd_barrier(xb);
  PH(7) if (lo <= 7 && 7 < hi) {
        ph_gemm_f32out(p, WSB(OFF_CAT), 1024, WSB(OFF_WOUT), 1024, 1024, WSF(OFF_R1), 1024);
#if (REPMASK >> 7) & 1
    xcd_barrier(xb);
        ph_gemm_f32out(p, WSB(OFF_CAT), 1024, WSB(OFF_WOUT), 1024, 1024, WSF(OFF_R1), 1024);
#endif
  }
  if (lo <= 7 && 7 + 1 < hi) xcd_barrier(xb);
  PH(8) if (lo <= 8 && 8 < hi) {
        rowop<true, true, true>(p, WSF(OFF_R1), p.n_post_mix, 2, p.n_pre_ffn, 3, 4, 0, 0);
#if (REPMASK >> 8) & 1
    xcd_barrier(xb);
        rowop<true, true, true>(p, WSF(OFF_R1), p.n_post_mix, 2, p.n_pre_ffn, 3, 4, 0, 0);
#endif
  }
  if (lo <= 8 && 8 + 1 < hi) xcd_barrier(xb);
  PH(9) if (lo <= 9 && 9 < hi) {
        ph_gemm_ffn_up(p, 0);
#if (REPMASK >> 9) & 1
    xcd_barrier(xb);
        ph_gemm_ffn_up(p, 0);
#endif
  }
  if (lo <= 9 && 9 + 1 < hi) xcd_barrier(xb);
  PH(10) if (lo <= 10 && 10 < hi) {
        ph_gemm_f32out(p, WSB(OFF_R1), 2816, WSB(OFF_WDN), 2816, 2816, WSF(OFF_R2), 1024);
#if (REPMASK >> 10) & 1
    xcd_barrier(xb);
        ph_gemm_f32out(p, WSB(OFF_R1), 2816, WSB(OFF_WDN), 2816, 2816, WSF(OFF_R2), 1024);
#endif
  }
  if (lo <= 10 && 10 + 1 < hi) xcd_barrier(xb);
  PH(11) if (lo <= 11 && 11 < hi) {
        rowop<true, true, false>(p, WSF(OFF_R2), p.n_post_ffn, 5, p.n_pre_mix + 1024, 0, 1, 0, 1);
#if (REPMASK >> 11) & 1
    xcd_barrier(xb);
        rowop<true, true, false>(p, WSF(OFF_R2), p.n_post_ffn, 5, p.n_pre_mix + 1024, 0, 1, 0, 1);
#endif
  }
  if (lo <= 11 && 11 + 1 < hi) xcd_barrier(xb);
  PH(12) if (lo <= 12 && 12 < hi) {
        pool_phase(p);
#if (REPMASK >> 12) & 1
    xcd_barrier(xb);
        pool_phase(p);
#endif
  }
  if (lo <= 12 && 12 + 1 < hi) xcd_barrier(xb);
  PH(13) if (lo <= 13 && 13 < hi) {
        ph_gemm_pool(p);
#if (REPMASK >> 13) & 1
    xcd_barrier(xb);
        ph_gemm_pool(p);
#endif
  }
  if (lo <= 13 && 13 + 1 < hi) xcd_barrier(xb);
  PH(14) if (lo <= 14 && 14 < hi) {
        rowop<true, true, false>(p, WSF(OFF_R1), p.n_post_mix + 1024, 2, p.n_pre_ffn + 1024, 3, 4, 1, 1);
#if (REPMASK >> 14) & 1
    xcd_barrier(xb);
        rowop<true, true, false>(p, WSF(OFF_R1), p.n_post_mix + 1024, 2, p.n_pre_ffn + 1024, 3, 4, 1, 1);
#endif
  }
  if (lo <= 14 && 14 + 1 < hi) xcd_barrier(xb);
  PH(15) if (lo <= 15 && 15 < hi) {
        ph_gemm_ffn_up(p, 1);
#if (REPMASK >> 15) & 1
    xcd_barrier(xb);
        ph_gemm_ffn_up(p, 1);
#endif
  }
  if (lo <= 15 && 15 + 1 < hi) xcd_barrier(xb);
  PH(16) if (lo <= 16 && 16 < hi) {
        ph_gemm_f32out(p, WSB(OFF_R1), 2816, WSB(OFF_WDN) + (size_t)1024 * 2816, 2816, 2816, WSF(OFF_R2), 1024);
#if (REPMASK >> 16) & 1
    xcd_barrier(xb);
        ph_gemm_f32out(p, WSB(OFF_R1), 2816, WSB(OFF_WDN) + (size_t)1024 * 2816, 2816, 2816, WSF(OFF_R2), 1024);
#endif
  }
  if (lo <= 16 && 16 + 1 < hi) xcd_barrier(xb);
  PH(17) if (lo <= 17 && 17 < hi) {
        rowop<true, false, false>(p, WSF(OFF_R2), p.n_post_ffn + 1024, 5, nullptr, 0, 0, 1, 1);
#if (REPMASK >> 17) & 1
    xcd_barrier(xb);
        rowop<true, false, false>(p, WSF(OFF_R2), p.n_post_ffn + 1024, 5, nullptr, 0, 0, 1, 1);
#endif
  }
}

extern "C" void kernel_launch(void* const* d_in, const int* in_sizes, int n_in, void* d_out, int out_size, void* d_ws,
                              size_t ws_size, hipStream_t stream) {
  P p{};
  const float** f = (const float**)&p;
  for (int i = 0; i < 33; ++i) f[i] = (const float*)d_in[i];
  p.out = (float*)d_out;
  p.ws = (char*)d_ws;
  static int grid_blocks = 0;
  if (!grid_blocks) {
    int dev = 0, cus = 0, per_cu = 0;
    hipGetDevice(&dev);
    hipDeviceGetAttribute(&cus, hipDeviceAttributeMultiprocessorCount, dev);
    hipOccupancyMaxActiveBlocksPerMultiprocessor(&per_cu, mega, 256, 0);
    if (per_cu > 2) per_cu = 2;
    if (per_cu < 1) per_cu = 1;
    grid_blocks = cus * per_cu;
  }
  hipMemsetAsync((char*)d_ws + OFF_BAR, 0, XCD_BAR_WORDS * 4, stream);
#if SINGLE_LAUNCH
  int lo = 0, hi = NPHASE;
  void* args[] = {&p, &lo, &hi};
  hipError_t e = hipLaunchCooperativeKernel((void*)mega, dim3(grid_blocks), dim3(256), args, 0, stream);
  if (e != hipSuccess) fprintf(stderr, "cooperative launch failed: %s (grid %d)\n", hipGetErrorString(e), grid_blocks);
#else
  for (int ph = 0; ph < NPHASE; ++ph) mega<<<grid_blocks, 256, 0, stream>>>(p, ph, ph + 1);
#endif
}
```

```cpp
#include <hip/hip_runtime.h>
#include <hip/hip_cooperative_groups.h>
#include <stdint.h>
#include <stdio.h>
namespace cg = cooperative_groups;

#ifndef SINGLE_LAUNCH
#define SINGLE_LAUNCH 1
#endif

typedef __attribute__((ext_vector_type(8))) short bf16x8;
typedef __attribute__((ext_vector_type(4))) float f32x4;
typedef unsigned short bf16_t;

#define DEVI __device__ __forceinline__

constexpr size_t OFF_WIN   = 0;
constexpr size_t OFF_WUQ   = OFF_WIN   + (size_t)2176*1024*2;
constexpr size_t OFF_WUKV  = OFF_WUQ   + (size_t)768*256*2;
constexpr size_t OFF_WOUT  = OFF_WUKV  + (size_t)1024*256*2;
constexpr size_t OFF_WPOOL = OFF_WOUT  + (size_t)1024*1024*2;
constexpr size_t OFF_WGU   = OFF_WPOOL + (size_t)4*256*256*2;
constexpr size_t OFF_WDN   = OFF_WGU   + (size_t)2*5632*1024*2;
constexpr size_t OFF_MOD   = OFF_WDN   + (size_t)2*1024*2816*2;
constexpr size_t OFF_R1    = OFF_MOD   + (size_t)2*3*6144*4;
constexpr size_t OFF_R2    = OFF_R1    + (size_t)8192*2096*4;
constexpr size_t OFF_H     = OFF_R2    + (size_t)8192*1024*4;
constexpr size_t OFF_CAT   = OFF_H     + (size_t)8192*1024*2;
constexpr size_t OFF_Q     = OFF_CAT   + (size_t)8192*1024*2;
constexpr size_t OFF_KN    = OFF_Q     + (size_t)8192*768*2;
constexpr size_t OFF_VT    = OFF_KN    + (size_t)8704*512*2;
constexpr size_t OFF_CQN   = OFF_VT    + (size_t)8704*512*2;
constexpr size_t OFF_CKV   = OFF_CQN   + (size_t)8192*256*2;
constexpr size_t OFF_KPE   = OFF_CKV   + (size_t)8704*256*2;
constexpr size_t OFF_XS    = OFF_KPE   + (size_t)8704*32*2;
constexpr size_t OFF_XST   = OFF_XS    + (size_t)8192*512*2;
constexpr size_t OFF_BM    = OFF_XST   + (size_t)8192*512*2;
constexpr size_t OFF_BT    = OFF_BM    + (size_t)8192*256*2;
constexpr size_t OFF_CM    = OFF_BT    + (size_t)8192*256*2;
constexpr size_t OFF_DTV   = OFF_CM    + (size_t)8192*256*2;
constexpr size_t OFF_CUM   = OFF_DTV   + (size_t)2*8192*8*4;
constexpr size_t OFF_TOT   = OFF_CUM   + (size_t)2*8192*8*4;
constexpr size_t OFF_BAR   = OFF_TOT   + 4096;
constexpr size_t OFF_END   = OFF_BAR   + 16384;

constexpr size_t OUT_CKV = 8388608, OUT_KR = 9437184, OUT_SF = 9568256, OUT_SB = 10616832;

struct P {
  const float *x_prompt, *x_sample, *c, *cache_ckv, *cache_kr, *st_f, *st_b, *c_ctx;
  const float *w_mod, *b_mod, *n_pre_mix, *n_post_mix, *n_pre_ffn, *n_post_ffn;
  const float *w_in, *q_norm, *w_uq, *kv_norm, *w_ukv, *conv_w, *conv_b, *dtb_f, *dtb_b, *alog_f, *alog_b;
  const float *ssd_d, *ssd_norm, *w_out, *pool_w, *pool_scale, *w_gate, *w_up, *w_down;
  float* out;
  char* ws;
};

#define WSB(off) ((bf16_t*)(p.ws + (off)))
#define WSF(off) ((float*)(p.ws + (off)))

DEVI bf16_t f2bf(float f) {
  unsigned u = __float_as_uint(f);
  u += 0x7fffu + ((u >> 16) & 1u);
  return (bf16_t)(u >> 16);
}
DEVI float bf2f(bf16_t b) { return __uint_as_float(((unsigned)b) << 16); }
DEVI unsigned pack2(float a, float b) { return (unsigned)f2bf(a) | ((unsigned)f2bf(b) << 16); }
DEVI float silu(float x) { return x / (1.f + __expf(-x)); }
DEVI float wave_sum(float v) {
#pragma unroll
  for (int o = 32; o > 0; o >>= 1) v += __shfl_xor(v, o, 64);
  return v;
}
DEVI f32x4 mfma16(bf16x8 a, bf16x8 b, f32x4 c) { return __builtin_amdgcn_mfma_f32_16x16x32_bf16(a, b, c, 0, 0, 0); }

DEVI float rope_freq(int m) { return exp2f(-(float)m * 1.6609640474436813f); }
DEVI void fast_sincos(float ang, float& sn, float& cs) {
  float rev = ang * 0.15915494309189535f;
  rev -= rintf(rev);
  sn = __builtin_amdgcn_sinf(rev);
  cs = __builtin_amdgcn_cosf(rev);
}
DEVI int opaque_tid() { int t = threadIdx.x; asm volatile("" : "+v"(t)); return t; }
DEVI int swz_tile(int t, int T) {
  int q = T >> 3, r = T & 7, x = t & 7, off = t >> 3;
  return (x < r ? x * (q + 1) : r * (q + 1) + (x - r) * q) + off;
}

__shared__ __attribute__((aligned(16))) char g_smem[73728];
#define NOINL __device__ __forceinline__

constexpr int LDT = 72;
constexpr int TILE_E = 128 * LDT;

template <class Epi>
DEVI void gemm_tile(const bf16_t* __restrict__ A, int lda, const bf16_t* __restrict__ B, int ldb, int K,
                    int m0, int n0, char* smem, Epi epi) {
  const int tid = threadIdx.x, lane = tid & 63, wave = tid >> 6, wm = wave >> 1, wn = wave & 1;
  const int lr = lane & 15, lg = lane >> 4;
  bf16_t* sA = (bf16_t*)smem;
  bf16_t* sB = sA + 2 * TILE_E;
  f32x4 acc[4][4];
#pragma unroll
  for (int i = 0; i < 4; ++i)
#pragma unroll
    for (int j = 0; j < 4; ++j) acc[i][j] = (f32x4){0.f, 0.f, 0.f, 0.f};
  const int lrow = tid >> 3, lkc = (tid & 7) * 8;
  const bf16_t* gA = A + (size_t)(m0 + lrow) * lda + lkc;
  const bf16_t* gB = B + (size_t)(n0 + lrow) * ldb + lkc;
  uint4 ra[4], rb[4];
#pragma unroll
  for (int i = 0; i < 4; ++i) {
    ra[i] = *(const uint4*)(gA + (size_t)(32 * i) * lda);
    rb[i] = *(const uint4*)(gB + (size_t)(32 * i) * ldb);
  }
#pragma unroll
  for (int i = 0; i < 4; ++i) {
    *(uint4*)(sA + (lrow + 32 * i) * LDT + lkc) = ra[i];
    *(uint4*)(sB + (lrow + 32 * i) * LDT + lkc) = rb[i];
  }
  __syncthreads();
  const int nk = K >> 6;
  for (int kt = 0; kt < nk; ++kt) {
    const int cur = kt & 1;
    if (kt + 1 < nk) {
      const int k0 = (kt + 1) << 6;
#pragma unroll
      for (int i = 0; i < 4; ++i) {
        ra[i] = *(const uint4*)(gA + (size_t)(32 * i) * lda + k0);
        rb[i] = *(const uint4*)(gB + (size_t)(32 * i) * ldb + k0);
      }
    }
    const bf16_t* cA = sA + cur * TILE_E + (wm * 64 + lr) * LDT + lg * 8;
    const bf16_t* cB = sB + cur * TILE_E + (wn * 64 + lr) * LDT + lg * 8;
#pragma unroll
    for (int ks = 0; ks < 2; ++ks) {
      bf16x8 af[4], bfr[4];
#pragma unroll
      for (int i = 0; i < 4; ++i) {
        af[i] = *(const bf16x8*)(cA + i * 16 * LDT + ks * 32);
        bfr[i] = *(const bf16x8*)(cB + i * 16 * LDT + ks * 32);
      }
#pragma unroll
      for (int i = 0; i < 4; ++i)
#pragma unroll
        for (int j = 0; j < 4; ++j) acc[i][j] = mfma16(af[i], bfr[j], acc[i][j]);
    }
    if (kt + 1 < nk) {
      const int nx = cur ^ 1;
#pragma unroll
      for (int i = 0; i < 4; ++i) {
        *(uint4*)(sA + nx * TILE_E + (lrow + 32 * i) * LDT + lkc) = ra[i];
        *(uint4*)(sB + nx * TILE_E + (lrow + 32 * i) * LDT + lkc) = rb[i];
      }
    }
    __syncthreads();
  }
#pragma unroll
  for (int i = 0; i < 4; ++i)
#pragma unroll
    for (int j = 0; j < 4; j += 2)
      epi(m0 + wm * 64 + i * 16 + lg * 4, n0 + wn * 64 + j * 16 + lr, acc[i][j], acc[i][j + 1]);
}

struct TileInfo { const bf16_t* a; const bf16_t* b; int m0, n0, ctx; };
template <class TileFn, class Epi>
DEVI void gemm_stream(int T, int lda, int ldb, int K, char* smem, TileFn tf, Epi epi) {
  int t = blockIdx.x;
  if (t >= T) return;
  const int tid = opaque_tid(), lane = tid & 63, wave = tid >> 6, wm = wave >> 1, wn = wave & 1;
  const int lr = lane & 15, lg = lane >> 4;
  bf16_t* sA = (bf16_t*)smem;
  bf16_t* sB = sA + 2 * TILE_E;
  const int lrow = tid >> 3, lkc = (tid & 7) * 8;
  TileInfo ti = tf(t);
  const bf16_t* gA = ti.a + (size_t)lrow * lda + lkc;
  const bf16_t* gB = ti.b + (size_t)lrow * ldb + lkc;
  int m0 = ti.m0, n0 = ti.n0, ctx = ti.ctx;
  uint4 ra0, ra1, ra2, ra3, rb0, rb1, rb2, rb3;
  uint4 rc0, rc1, rc2, rc3, rd0, rd1, rd2, rd3;
#define GS_LOAD0(pa, pb) \
  ra0 = *(const uint4*)((pa)); ra1 = *(const uint4*)((pa) + (size_t)32 * lda); \
  ra2 = *(const uint4*)((pa) + (size_t)64 * lda); ra3 = *(const uint4*)((pa) + (size_t)96 * lda); \
  rb0 = *(const uint4*)((pb)); rb1 = *(const uint4*)((pb) + (size_t)32 * ldb); \
  rb2 = *(const uint4*)((pb) + (size_t)64 * ldb); rb3 = *(const uint4*)((pb) + (size_t)96 * ldb);
#define GS_LOAD1(pa, pb) \
  rc0 = *(const uint4*)((pa)); rc1 = *(const uint4*)((pa) + (size_t)32 * lda); \
  rc2 = *(const uint4*)((pa) + (size_t)64 * lda); rc3 = *(const uint4*)((pa) + (size_t)96 * lda); \
  rd0 = *(const uint4*)((pb)); rd1 = *(const uint4*)((pb) + (size_t)32 * ldb); \
  rd2 = *(const uint4*)((pb) + (size_t)64 * ldb); rd3 = *(const uint4*)((pb) + (size_t)96 * ldb);
#define GS_WRITE0(buf) { \
  bf16_t* wa = sA + (buf) * TILE_E + lrow * LDT + lkc; bf16_t* wb = sB + (buf) * TILE_E + lrow * LDT + lkc; \
  *(uint4*)(wa) = ra0; *(uint4*)(wa + 32 * LDT) = ra1; *(uint4*)(wa + 64 * LDT) = ra2; *(uint4*)(wa + 96 * LDT) = ra3; \
  *(uint4*)(wb) = rb0; *(uint4*)(wb + 32 * LDT) = rb1; *(uint4*)(wb + 64 * LDT) = rb2; *(uint4*)(wb + 96 * LDT) = rb3; }
#define GS_WRITE1(buf) { \
  bf16_t* wa = sA + (buf) * TILE_E + lrow * LDT + lkc; bf16_t* wb = sB + (buf) * TILE_E + lrow * LDT + lkc; \
  *(uint4*)(wa) = rc0; *(uint4*)(wa + 32 * LDT) = rc1; *(uint4*)(wa + 64 * LDT) = rc2; *(uint4*)(wa + 96 * LDT) = rc3; \
  *(uint4*)(wb) = rd0; *(uint4*)(wb + 32 * LDT) = rd1; *(uint4*)(wb + 64 * LDT) = rd2; *(uint4*)(wb + 96 * LDT) = rd3; }
#define GS_COMPUTE(buf) { \
    const bf16_t* cA = sA + (buf) * TILE_E + (wm * 64 + lr) * LDT + lg * 8; \
    const bf16_t* cB = sB + (buf) * TILE_E + (wn * 64 + lr) * LDT + lg * 8; \
    _Pragma("unroll") for (int ks = 0; ks < 2; ++ks) { \
      bf16x8 af[4], bfr[4]; \
      _Pragma("unroll") for (int i = 0; i < 4; ++i) { \
        af[i] = *(const bf16x8*)(cA + i * 16 * LDT + ks * 32); \
        bfr[i] = *(const bf16x8*)(cB + i * 16 * LDT + ks * 32); \
      } \
      __builtin_amdgcn_s_setprio(1); \
      _Pragma("unroll") for (int i = 0; i < 4; ++i) \
        _Pragma("unroll") for (int j = 0; j < 4; ++j) acc[i][j] = mfma16(af[i], bfr[j], acc[i][j]); \
      __builtin_amdgcn_s_setprio(0); \
    } }
  GS_LOAD0(gA, gB)
  GS_WRITE0(0)
  GS_LOAD1(gA + 64, gB + 64)
  __syncthreads();
  const int nk = K >> 6;
  for (;;) {
    f32x4 acc[4][4];
#pragma unroll
    for (int i = 0; i < 4; ++i)
#pragma unroll
      for (int j = 0; j < 4; ++j) acc[i][j] = (f32x4){0.f, 0.f, 0.f, 0.f};
    const int tn = t + gridDim.x;
    const bool have_next = tn < T;
    const bf16_t *nA = gA, *nB = gB;
    int nm0 = 0, nn0 = 0, nctx = 0;
    if (have_next) {
      const TileInfo tj = tf(tn);
      nA = tj.a + (size_t)lrow * lda + lkc;
      nB = tj.b + (size_t)lrow * ldb + lkc;
      nm0 = tj.m0; nn0 = tj.n0; nctx = tj.ctx;
    }
    for (int kt = 0; kt < nk; kt += 2) {
      {
        const bool wrap = (kt + 2 >= nk);
        const bf16_t* pa = wrap ? nA : gA + ((kt + 2) << 6);
        const bf16_t* pb = wrap ? nB : gB + ((kt + 2) << 6);
        GS_LOAD0(pa, pb)
        GS_COMPUTE(0)
        GS_WRITE1(1)
        __syncthreads();
      }
      {
        const bool wrap = (kt + 3 >= nk);
        const bf16_t* pa = wrap ? nA + 64 : gA + ((kt + 3) << 6);
        const bf16_t* pb = wrap ? nB + 64 : gB + ((kt + 3) << 6);
        GS_LOAD1(pa, pb)
        GS_COMPUTE(1)
        GS_WRITE0(0)
        __syncthreads();
      }
    }
#pragma unroll
    for (int i = 0; i < 4; ++i)
#pragma unroll
      for (int j = 0; j < 4; j += 2)
        epi(ctx, m0 + wm * 64 + i * 16 + lg * 4, n0 + wn * 64 + j * 16 + lr, acc[i][j], acc[i][j + 1]);
    if (!have_next) break;
    t = tn; gA = nA; gB = nB; m0 = nm0; n0 = nn0; ctx = nctx;
  }
}

DEVI void tile_mn(int t, int nM, int nN, int& m, int& n) {
  int id = swz_tile(t, nM * nN);
  int per = 8 * nN;
  int gq = id / per, rem = id - gq * per;
  int gsz = min(8, nM - gq * 8);
  m = gq * 8 + rem % gsz;
  n = rem / gsz;
}

NOINL void gemv_tile(const P& p, int t) {
  char* smem = g_smem;
  const int tid = opaque_tid();
  float* sv = (float*)smem;
  float* red = sv + 3072;
  const int l = t / 192, n0 = (t % 192) * 32;
  for (int i = tid; i < 3072; i += 256) {
    int v = i >> 10, k = i & 1023;
    float cv = (v == 0) ? p.c_ctx[k] : p.c[(v - 1) * 1024 + k];
    sv[i] = cv / (1.f + expf(-cv));
  }
  __syncthreads();
  const int cgp = tid & 7, ks = tid >> 3;
  const float* w = p.w_mod + (size_t)l * 1024 * 6144 + n0 + cgp * 4;
  float a0[4] = {0, 0, 0, 0}, a1[4] = {0, 0, 0, 0}, a2[4] = {0, 0, 0, 0};
#pragma unroll 16
  for (int kk = 0; kk < 32; ++kk) {
    const int k = ks * 32 + kk;
    const float4 wv = *(const float4*)(w + (size_t)k * 6144);
    const float s0 = sv[k], s1 = sv[1024 + k], s2 = sv[2048 + k];
    a0[0] += s0 * wv.x; a0[1] += s0 * wv.y; a0[2] += s0 * wv.z; a0[3] += s0 * wv.w;
    a1[0] += s1 * wv.x; a1[1] += s1 * wv.y; a1[2] += s1 * wv.z; a1[3] += s1 * wv.w;
    a2[0] += s2 * wv.x; a2[1] += s2 * wv.y; a2[2] += s2 * wv.z; a2[3] += s2 * wv.w;
  }
#pragma unroll
  for (int j = 0; j < 4; ++j) {
    red[(ks * 3 + 0) * 32 + cgp * 4 + j] = a0[j];
    red[(ks * 3 + 1) * 32 + cgp * 4 + j] = a1[j];
    red[(ks * 3 + 2) * 32 + cgp * 4 + j] = a2[j];
  }
  __syncthreads();
  if (tid < 96) {
    const int v = tid >> 5, col = tid & 31;
    float s = 0.f;
    for (int q = 0; q < 32; ++q) s += red[(q * 3 + v) * 32 + col];
    s += p.b_mod[l * 6144 + n0 + col];
    WSF(OFF_MOD)[(l * 3 + v) * 6144 + n0 + col] = s;
  }
  __syncthreads();
}

NOINL void transpose_tile(const P& p, int t) {
  char* smem = g_smem;
  const int tid = opaque_tid();
  const float* src; bf16_t* dst; int K, N, ntn, mode = 0;
  if (t < 544) { src = p.w_in; dst = WSB(OFF_WIN); K = 1024; N = 2096; ntn = 34; }
  else if ((t -= 544) < 48) { src = p.w_uq; dst = WSB(OFF_WUQ); K = 256; N = 768; ntn = 12; }
  else if ((t -= 48) < 64) { src = p.w_ukv; dst = WSB(OFF_WUKV); K = 256; N = 1024; ntn = 16; }
  else if ((t -= 64) < 256) { src = p.w_out; dst = WSB(OFF_WOUT); K = 1024; N = 1024; ntn = 16; }
  else if ((t -= 256) < 64) { int g = t >> 4; t &= 15; src = p.pool_w + (size_t)g * 65536; dst = WSB(OFF_WPOOL) + (size_t)g * 65536; K = 256; N = 256; ntn = 4; }
  else if ((t -= 64) < 1408) { int l = t / 704; t -= l * 704; src = p.w_gate + (size_t)l * 1024 * 2816; dst = WSB(OFF_WGU) + (size_t)l * 5632 * 1024; K = 1024; N = 2816; ntn = 44; mode = 1; }
  else if ((t -= 1408) < 1408) { int l = t / 704; t -= l * 704; src = p.w_up + (size_t)l * 1024 * 2816; dst = WSB(OFF_WGU) + (size_t)l * 5632 * 1024; K = 1024; N = 2816; ntn = 44; mode = 2; }
  else { t -= 1408; int l = t / 704; t -= l * 704; src = p.w_down + (size_t)l * 2816 * 1024; dst = WSB(OFF_WDN) + (size_t)l * 1024 * 2816; K = 2816; N = 1024; ntn = 16; }
  const int kt = t / ntn, nt_ = t - kt * ntn;
  const int k0 = kt * 64, n0 = nt_ * 64;
  float* tile = (float*)smem;
  {
    const int nn = tid & 63, kk0 = tid >> 6;
    const int n = n0 + nn;
    const int nc = n < N ? n : N - 1;
    float v[16];
#pragma unroll
    for (int i = 0; i < 16; ++i) v[i] = src[(size_t)(k0 + kk0 + 4 * i) * N + nc];
#pragma unroll
    for (int i = 0; i < 16; ++i) tile[(kk0 + 4 * i) * 65 + nn] = (n < N) ? v[i] : 0.f;
  }
  __syncthreads();
#pragma unroll
  for (int i = 0; i < 2; ++i) {
    const int id = tid + 256 * i;
    const int nn = id >> 3, kc = id & 7;
    const int n = n0 + nn;
    uint4 pk;
    pk.x = pack2(tile[(kc * 8 + 0) * 65 + nn], tile[(kc * 8 + 1) * 65 + nn]);
    pk.y = pack2(tile[(kc * 8 + 2) * 65 + nn], tile[(kc * 8 + 3) * 65 + nn]);
    pk.z = pack2(tile[(kc * 8 + 4) * 65 + nn], tile[(kc * 8 + 5) * 65 + nn]);
    pk.w = pack2(tile[(kc * 8 + 6) * 65 + nn], tile[(kc * 8 + 7) * 65 + nn]);
    int drow = n;
    if (mode == 1) drow = (n >> 4) * 32 + (n & 15);
    else if (mode == 2) drow = (n >> 4) * 32 + 16 + (n & 15);
    *(uint4*)(dst + (size_t)drow * K + k0 + kc * 8) = pk;
  }
  __syncthreads();
}

template <bool UPD, bool MOD, bool FIRST>
DEVI void rowop(const P& p, const float* msrc, const float* wpost, int gate_idx, const float* wpre, int shift_idx,
                int scale_idx, int layer_g, int layer_m) {
  const int lane = threadIdx.x & 63, wave = threadIdx.x >> 6;
  const float* modg = WSF(OFF_MOD) + (size_t)layer_g * 3 * 6144;
  const float* modm = WSF(OFF_MOD) + (size_t)layer_m * 3 * 6144;
  bf16_t* hbuf = WSB(OFF_H);
  for (int r = blockIdx.x * 4 + wave; r < 8192; r += gridDim.x * 4) {
    const int v = r < 4096 ? 0 : 1 + ((r - 4096) >> 11);
    const float* mvg = modg + v * 6144;
    const float* mvm = modm + v * 6144;
    const float* xin = FIRST ? (r < 4096 ? p.x_prompt + (size_t)r * 1024 : p.x_sample + (size_t)(r - 4096) * 1024)
                             : p.out + (size_t)r * 1024;
    float4 x[4];
#pragma unroll
    for (int i = 0; i < 4; ++i) x[i] = *(const float4*)(xin + lane * 4 + 256 * i);
    if (UPD) {
      float4 m[4];
      float ss = 0.f;
#pragma unroll
      for (int i = 0; i < 4; ++i) {
        m[i] = *(const float4*)(msrc + (size_t)r * 1024 + lane * 4 + 256 * i);
        ss += m[i].x * m[i].x + m[i].y * m[i].y + m[i].z * m[i].z + m[i].w * m[i].w;
      }
      ss = wave_sum(ss);
      const float rs = rsqrtf(ss * (1.f / 1024.f) + 1e-6f);
#pragma unroll
      for (int i = 0; i < 4; ++i) {
        const int col = lane * 4 + 256 * i;
        const float4 wp = *(const float4*)(wpost + col);
        const float4 g = *(const float4*)(mvg + gate_idx * 1024 + col);
        x[i].x += g.x * (m[i].x * rs * wp.x);
        x[i].y += g.y * (m[i].y * rs * wp.y);
        x[i].z += g.z * (m[i].z * rs * wp.z);
        x[i].w += g.w * (m[i].w * rs * wp.w);
        *(float4*)(p.out + (size_t)r * 1024 + col) = x[i];
      }
    }
    if (MOD) {
      float ss = 0.f;
#pragma unroll
      for (int i = 0; i < 4; ++i) ss += x[i].x * x[i].x + x[i].y * x[i].y + x[i].z * x[i].z + x[i].w * x[i].w;
      ss = wave_sum(ss);
      const float rs = rsqrtf(ss * (1.f / 1024.f) + 1e-6f);
#pragma unroll
      for (int i = 0; i < 4; ++i) {
        const int col = lane * 4 + 256 * i;
        const float4 wp = *(const float4*)(wpre + col);
        const float4 sh = *(const float4*)(mvm + shift_idx * 1024 + col);
        const float4 sc = *(const float4*)(mvm + scale_idx * 1024 + col);
        uint2 o;
        o.x = pack2(x[i].x * rs * wp.x * (1.f + sc.x) + sh.x, x[i].y * rs * wp.y * (1.f + sc.y) + sh.y);
        o.y = pack2(x[i].z * rs * wp.z * (1.f + sc.z) + sh.z, x[i].w * rs * wp.w * (1.f + sc.w) + sh.w);
        *(uint2*)(hbuf + (size_t)r * 1024 + col) = o;
      }
    }
  }
}

NOINL void prep_rows(const P& p) {
  const int lane = threadIdx.x & 63, wave = threadIdx.x >> 6;
  const float* proj = WSF(OFF_R1);
  for (int r = blockIdx.x * 4 + wave; r < 8192; r += gridDim.x * 4) {
    const float* pr = proj + (size_t)r * 2096;
    const int kvrow = r < 4096 ? r : 4096 + ((r - 4096) >> 11) * 2304 + 256 + ((r - 4096) & 2047);
    {
      const float4 a = *(const float4*)(pr + lane * 4);
      float ss = wave_sum(a.x * a.x + a.y * a.y + a.z * a.z + a.w * a.w);
      const float rs = rsqrtf(ss * (1.f / 256.f) + 1e-6f);
      const float4 g = *(const float4*)(p.q_norm + lane * 4);
      uint2 o;
      o.x = pack2(a.x * rs * g.x, a.y * rs * g.y);
      o.y = pack2(a.z * rs * g.z, a.w * rs * g.w);
      *(uint2*)(WSB(OFF_CQN) + (size_t)r * 256 + lane * 4) = o;
    }
    {
      const float4 a = *(const float4*)(pr + 256 + lane * 4);
      float ss = wave_sum(a.x * a.x + a.y * a.y + a.z * a.z + a.w * a.w);
      const float rs = rsqrtf(ss * (1.f / 256.f) + 1e-6f);
      const float4 g = *(const float4*)(p.kv_norm + lane * 4);
      float4 vv;
      vv.x = a.x * rs * g.x; vv.y = a.y * rs * g.y; vv.z = a.z * rs * g.z; vv.w = a.w * rs * g.w;
      if (r < 4096) *(float4*)(p.out + OUT_CKV + (size_t)r * 256 + lane * 4) = vv;
      uint2 o;
      o.x = pack2(vv.x, vv.y);
      o.y = pack2(vv.z, vv.w);
      *(uint2*)(WSB(OFF_CKV) + (size_t)kvrow * 256 + lane * 4) = o;
    }
    {
      const float kv = (lane < 32) ? pr[512 + lane] : 0.f;
      const float partner = __shfl_xor(kv, 16, 64);
      if (r < 4096) {
        if (lane < 32) {
          p.out[OUT_KR + (size_t)r * 32 + lane] = kv;
          WSB(OFF_KPE)[(size_t)kvrow * 32 + lane] = f2bf(kv);
        }
      } else {
        const int t = (r - 4096) & 2047;
        const int ii = lane & 15;
        const float pos = (ii < 8) ? (float)(t >> 6) : (float)(t & 63);
        const float fr = rope_freq(ii & 7);
        const float ang = pos * fr;
        float cs, sn;
        fast_sincos(ang, sn, cs);
        const float o = (lane < 16) ? (kv * cs - partner * sn) : (partner * sn + kv * cs);
        if (lane < 32) WSB(OFF_KPE)[(size_t)kvrow * 32 + lane] = f2bf(o);
      }
    }
    if (lane < 16) {
      const int dir = lane >> 3, hh = lane & 7;
      const float raw = pr[2080 + lane] + (dir ? p.dtb_b[hh] : p.dtb_f[hh]);
      const float sp = raw > 20.f ? raw : log1pf(expf(raw));
      WSF(OFF_DTV)[((size_t)dir * 8192 + r) * 8 + hh] = sp;
    }
  }
}

NOINL void prep_cache(const P& p) {
  const int gt = blockIdx.x * 256 + threadIdx.x, gs = gridDim.x * 256;
  for (int i = gt; i < 2 * 256 * 256; i += gs) {
    int b = i >> 16, rem = i & 65535;
    WSB(OFF_CKV)[(size_t)(4096 + b * 2304) * 256 + rem] = f2bf(p.cache_ckv[i]);
  }
  for (int i = gt; i < 2 * 256 * 32; i += gs) {
    int b = i >> 13, rem = i & 8191;
    WSB(OFF_KPE)[(size_t)(4096 + b * 2304) * 32 + rem] = f2bf(p.cache_kr[i]);
  }
}

NOINL void conv_tile(const P& p, int t) {
  char* smem = g_smem;
  const int tid = opaque_tid();
  float* sin_ = (float*)smem;
  float* sout = sin_ + 68 * 64;
  const int tt_ = t >> 4, ct = t & 15;
  const int r0 = tt_ * 64, c0 = ct * 64;
  int s0, s1;
  if (r0 < 4096) { s0 = r0 & ~255; s1 = s0 + 256; } else { s0 = 4096 + ((r0 - 4096) & ~2047); s1 = s0 + 2048; }
  const float* proj = WSF(OFF_R1);
  for (int i = tid; i < 68 * 64; i += 256) {
    const int rr = i >> 6, cc = i & 63;
    const int r = r0 - 2 + rr;
    float v = 0.f;
    if (r >= s0 && r < s1) v = proj[(size_t)r * 2096 + 1056 + c0 + cc];
    sin_[i] = v;
  }
  __syncthreads();
  {
    const int cc = tid & 63, tq = tid >> 6;
    const int c = c0 + cc;
    const float w0 = p.conv_w[c], w1 = p.conv_w[1024 + c], w2 = p.conv_w[2048 + c], w3 = p.conv_w[3072 + c],
                w4 = p.conv_w[4096 + c], bias = p.conv_b[c];
#pragma unroll 4
    for (int i = 0; i < 16; ++i) {
      const int tt = tq * 16 + i;
      float y = bias + w0 * sin_[tt * 64 + cc] + w1 * sin_[(tt + 1) * 64 + cc] + w2 * sin_[(tt + 2) * 64 + cc] +
                w3 * sin_[(tt + 3) * 64 + cc] + w4 * sin_[(tt + 4) * 64 + cc];
      y = y / (1.f + __expf(-y));
      sout[tt * 65 + cc] = y;
      const bf16_t b = f2bf(y);
      const size_t r = r0 + tt;
      if (c < 512) WSB(OFF_XS)[r * 512 + c] = b;
      else if (c < 768) WSB(OFF_BM)[r * 256 + (c - 512)] = b;
      else WSB(OFF_CM)[r * 256 + (c - 768)] = b;
    }
  }
  __syncthreads();
  if (c0 < 768) {
    const int cl = tid >> 2, q4 = tid & 3;
    uint4 o0, o1;
    const float* sp = sout + (q4 * 16) * 65 + cl;
    o0.x = pack2(sp[0 * 65], sp[1 * 65]);   o0.y = pack2(sp[2 * 65], sp[3 * 65]);
    o0.z = pack2(sp[4 * 65], sp[5 * 65]);   o0.w = pack2(sp[6 * 65], sp[7 * 65]);
    o1.x = pack2(sp[8 * 65], sp[9 * 65]);   o1.y = pack2(sp[10 * 65], sp[11 * 65]);
    o1.z = pack2(sp[12 * 65], sp[13 * 65]); o1.w = pack2(sp[14 * 65], sp[15 * 65]);
    bf16_t* dst = (c0 < 512) ? WSB(OFF_XST) + (size_t)(c0 + cl) * 8192 : WSB(OFF_BT) + (size_t)(c0 - 512 + cl) * 8192;
    dst += r0 + q4 * 16;
    *(uint4*)(dst) = o0;
    *(uint4*)(dst + 8) = o1;
  }
  __syncthreads();
}

NOINL void chunk_state_item(const P& p, int item) {
  char* smem = g_smem;
  const int tid = opaque_tid(), lane = tid & 63, wave = tid >> 6, lr = lane & 15, lg = lane >> 4;
  const int cidx = item >> 3, hh = item & 7, g = hh >> 2;
  const int r0 = cidx * 128;
  constexpr int LDS_ = 136;
  bf16_t* sAs = (bf16_t*)smem;
  bf16_t* sBs = sAs + 2 * 64 * LDS_;
  float* fa = (float*)(sBs + 128 * LDS_);
  float* fcum = fa + 256;
  float* fw = fa + 512;
  float* fdt = fa + 768;
  {
    const int dir = tid >> 7, j = tid & 127;
    const float dt = WSF(OFF_DTV)[((size_t)dir * 8192 + r0 + j) * 8 + hh];
    const float Aco = -expf(dir ? p.alog_b[hh] : p.alog_f[hh]);
    fa[tid] = dt * Aco;
    fdt[tid] = dt;
  }
  __syncthreads();
  {
    const int dir = tid >> 7, j = tid & 127;
    float s = 0.f;
    if (dir == 0) { for (int k = 0; k <= j; ++k) s += fa[k]; }
    else { for (int k = 127; k >= j; --k) s += fa[128 + k]; }
    fcum[tid] = s;
    WSF(OFF_CUM)[((size_t)dir * 8192 + r0 + j) * 8 + hh] = s;
  }
  __syncthreads();
  {
    const int dir = tid >> 7;
    const float ce = dir ? fcum[128] : fcum[127];
    fw[tid] = __expf(ce - fcum[tid]) * fdt[tid];
    if ((tid & 127) == 0) WSF(OFF_TOT)[(dir * 64 + cidx) * 8 + hh] = __expf(ce);
  }
  __syncthreads();
#pragma unroll
  for (int i = 0; i < 4; ++i) {
    const int id = tid + 256 * i;
    const int pp = id >> 4, jc = (id & 15) * 8;
    const uint4 raw = *(const uint4*)(WSB(OFF_XST) + (size_t)(hh * 64 + pp) * 8192 + r0 + jc);
    const unsigned rw[4] = {raw.x, raw.y, raw.z, raw.w};
    unsigned of[4], ob[4];
#pragma unroll
    for (int q = 0; q < 4; ++q) {
      const float x0 = __uint_as_float(rw[q] << 16), x1 = __uint_as_float(rw[q] & 0xffff0000u);
      of[q] = pack2(x0 * fw[jc + 2 * q], x1 * fw[jc + 2 * q + 1]);
      ob[q] = pack2(x0 * fw[128 + jc + 2 * q], x1 * fw[128 + jc + 2 * q + 1]);
    }
    *(uint4*)(sAs + pp * LDS_ + jc) = make_uint4(of[0], of[1], of[2], of[3]);
    *(uint4*)(sAs + 64 * LDS_ + pp * LDS_ + jc) = make_uint4(ob[0], ob[1], ob[2], ob[3]);
  }
#pragma unroll
  for (int i = 0; i < 8; ++i) {
    const int id = tid + 256 * i;
    const int nn = id >> 4, jc = (id & 15) * 8;
    *(uint4*)(sBs + nn * LDS_ + jc) = *(const uint4*)(WSB(OFF_BT) + (size_t)(g * 128 + nn) * 8192 + r0 + jc);
  }
  __syncthreads();
  {
    const int dir = wave >> 1, nh = wave & 1;
    f32x4 acc[4][4];
#pragma unroll
    for (int i = 0; i < 4; ++i)
#pragma unroll
      for (int j = 0; j < 4; ++j) acc[i][j] = (f32x4){0.f, 0.f, 0.f, 0.f};
    const bf16_t* cA = sAs + dir * 64 * LDS_ + lr * LDS_ + lg * 8;
    const bf16_t* cB = sBs + (nh * 64 + lr) * LDS_ + lg * 8;
#pragma unroll 1
    for (int ks = 0; ks < 4; ++ks) {
      bf16x8 af[4], bfr[4];
#pragma unroll
      for (int i = 0; i < 4; ++i) {
        af[i] = *(const bf16x8*)(cA + i * 16 * LDS_ + ks * 32);
        bfr[i] = *(const bf16x8*)(cB + i * 16 * LDS_ + ks * 32);
      }
#pragma unroll
      for (int i = 0; i < 4; ++i)
#pragma unroll
        for (int j = 0; j < 4; ++j) acc[i][j] = mfma16(af[i], bfr[j], acc[i][j]);
    }
    float* S = WSF(OFF_R2) + ((size_t)(dir * 64 + cidx) * 8 + hh) * 8192 + (lg * 4) * 128 + nh * 64 + lr;
#pragma unroll
    for (int i = 0; i < 4; ++i) {
#pragma unroll
      for (int q = 0; q < 4; ++q) {
#pragma unroll
        for (int j = 0; j < 4; ++j) S[j * 16] = acc[i][j][q];
        S += 128;
      }
      S += 12 * 128;
      __builtin_amdgcn_sched_barrier(0);
    }
  }
  __syncthreads();
}

NOINL void scan_states(const P& p) {
  const int total = 2 * 18 * 8 * 64 * 32;
  for (int idx = blockIdx.x * 256 + threadIdx.x; idx < total; idx += gridDim.x * 256) {
    const int n4 = idx & 31, pp = (idx >> 5) & 63, hh = (idx >> 11) & 7;
    const int sd = idx >> 14;
    const int s = sd % 18, dir = sd / 18;
    const int nc = s < 16 ? 2 : 16;
    const int cb = s < 16 ? s * 2 : 32 + (s - 16) * 16;
    float4 h = make_float4(0.f, 0.f, 0.f, 0.f);
    if (s >= 16) {
      const float* st = (dir ? p.st_b : p.st_f) + ((size_t)((s - 16) * 8 + hh) * 64 + pp) * 128 + n4 * 4;
      h = *(const float4*)st;
    }
    const size_t eoff = (size_t)pp * 128 + n4 * 4;
    for (int c = 0; c < nc; ++c) {
      const int cidx = cb + (dir ? nc - 1 - c : c);
      const size_t base = ((size_t)(dir * 64 + cidx) * 8 + hh) * 8192 + eoff;
      uint2 o;
      o.x = pack2(h.x, h.y);
      o.y = pack2(h.z, h.w);
      *(uint2*)(WSB(OFF_H) + base) = o;
      const float d = WSF(OFF_TOT)[(dir * 64 + cidx) * 8 + hh];
      const float4 sv = *(const float4*)(WSF(OFF_R2) + base);
      h.x = d * h.x + sv.x; h.y = d * h.y + sv.y; h.z = d * h.z + sv.z; h.w = d * h.w + sv.w;
    }
    if (s < 16) {
      float* o = p.out + (dir ? OUT_SB : OUT_SF) + ((size_t)(s * 8 + hh) * 64 + pp) * 128 + n4 * 4;
      *(float4*)o = h;
    }
  }
}

NOINL void attn_item(const P& p, int id) {
  char* smem = g_smem;
  const int tid = opaque_tid(), lane = tid & 63, wave = tid >> 6, lr = lane & 15, lg = lane >> 4;
  int row0, kvbase, Lk, hh;
  if (id < 512) { const int b = id >> 8; hh = (id >> 5) & 7; const int qb = id & 31; row0 = 4096 + b * 2048 + qb * 64; kvbase = 4096 + b * 2304; Lk = 2304; }
  else { const int i2 = id - 512; const int b = i2 >> 5; hh = (i2 >> 2) & 7; const int qb = i2 & 3; row0 = b * 256 + qb * 64; kvbase = b * 256; Lk = 256; }
  constexpr int LDK = 104, LDV = 72;
  constexpr int KVBUF = 64 * LDK + 64 * LDV;
  bf16_t* sKV = (bf16_t*)smem;
  const int qrow = row0 + wave * 16 + lr;
  bf16x8 qf[3];
#pragma unroll
  for (int ks = 0; ks < 3; ++ks) qf[ks] = *(const bf16x8*)(WSB(OFF_Q) + (size_t)qrow * 768 + hh * 96 + ks * 32 + lg * 8);
  f32x4 oacc[4];
#pragma unroll
  for (int i = 0; i < 4; ++i) oacc[i] = (f32x4){0.f, 0.f, 0.f, 0.f};
  float mrun = -1e30f, lrun = 0.f;
  const int nkt = Lk >> 6;
  const int kkey0 = tid / 12, kcc0 = tid - kkey0 * 12;
  const int c1 = tid + 256, kkey1 = c1 / 12, kcc1 = c1 - kkey1 * 12;
  const int c2 = tid + 512, kkey2 = c2 / 12, kcc2 = c2 - kkey2 * 12;
  const bf16_t* kn = WSB(OFF_KN);
  const bf16_t* kp = WSB(OFF_KPE);
  const bf16_t* ksrc0 = (kcc0 < 8) ? kn + (size_t)(kvbase + kkey0) * 512 + hh * 64 + kcc0 * 8 : kp + (size_t)(kvbase + kkey0) * 32 + (kcc0 - 8) * 8;
  const bf16_t* ksrc1 = (kcc1 < 8) ? kn + (size_t)(kvbase + kkey1) * 512 + hh * 64 + kcc1 * 8 : kp + (size_t)(kvbase + kkey1) * 32 + (kcc1 - 8) * 8;
  const bf16_t* ksrc2 = (kcc2 < 8) ? kn + (size_t)(kvbase + kkey2) * 512 + hh * 64 + kcc2 * 8 : kp + (size_t)(kvbase + kkey2) * 32 + (kcc2 - 8) * 8;
  const int kst0 = (kcc0 < 8) ? 512 * 64 : 32 * 64, kst1 = (kcc1 < 8) ? 512 * 64 : 32 * 64, kst2 = (kcc2 < 8) ? 512 * 64 : 32 * 64;
  const int vd0 = tid >> 3, vcc = tid & 7;
  const bf16_t* vsrc0 = WSB(OFF_VT) + (size_t)(hh * 64 + vd0) * 8704 + kvbase + vcc * 8;
  const bf16_t* vsrc1 = vsrc0 + (size_t)32 * 8704;
  uint4 rk0, rk1, rk2, rv0, rv1;
#define AT_LOAD(kt) { const int _k = (kt); \
    rk0 = *(const uint4*)(ksrc0 + (size_t)_k * kst0); rk1 = *(const uint4*)(ksrc1 + (size_t)_k * kst1); \
    rk2 = *(const uint4*)(ksrc2 + (size_t)_k * kst2); \
    rv0 = *(const uint4*)(vsrc0 + _k * 64); rv1 = *(const uint4*)(vsrc1 + _k * 64); }
#define AT_WRITE(buf) { bf16_t* _b = sKV + (buf) * KVBUF; \
    *(uint4*)(_b + kkey0 * LDK + kcc0 * 8) = rk0; *(uint4*)(_b + kkey1 * LDK + kcc1 * 8) = rk1; \
    *(uint4*)(_b + kkey2 * LDK + kcc2 * 8) = rk2; \
    *(uint4*)(_b + 64 * LDK + vd0 * LDV + vcc * 8) = rv0; *(uint4*)(_b + 64 * LDK + (vd0 + 32) * LDV + vcc * 8) = rv1; }
  AT_LOAD(0)
  AT_WRITE(0)
  __syncthreads();
  for (int kt = 0; kt < nkt; ++kt) {
    const int ktn = min(kt + 1, nkt - 1);
    AT_LOAD(ktn)
    const bf16_t* sK = sKV + (kt & 1) * KVBUF;
    const bf16_t* sV = sK + 64 * LDK;
    f32x4 sacc[4];
#pragma unroll
    for (int n = 0; n < 4; ++n) sacc[n] = (f32x4){0.f, 0.f, 0.f, 0.f};
#pragma unroll
    for (int ks = 0; ks < 3; ++ks)
#pragma unroll
      for (int n = 0; n < 4; ++n) {
        const bf16x8 a = *(const bf16x8*)(sK + (n * 16 + lr) * LDK + ks * 32 + lg * 8);
        sacc[n] = mfma16(a, qf[ks], sacc[n]);
      }
    float mx = sacc[0][0];
#pragma unroll
    for (int n = 0; n < 4; ++n)
#pragma unroll
      for (int q = 0; q < 4; ++q) mx = fmaxf(mx, sacc[n][q]);
    mx = fmaxf(mx, __shfl_xor(mx, 16, 64));
    mx = fmaxf(mx, __shfl_xor(mx, 32, 64));
    const float mnew = fmaxf(mrun, mx);
    const float alpha = __expf(mrun - mnew);
    mrun = mnew;
    float ps = 0.f;
#pragma unroll
    for (int n = 0; n < 4; ++n)
#pragma unroll
      for (int q = 0; q < 4; ++q) { const float e = __expf(sacc[n][q] - mnew); sacc[n][q] = e; ps += e; }
    lrun = lrun * alpha + ps;
#pragma unroll
    for (int i = 0; i < 4; ++i)
#pragma unroll
      for (int q = 0; q < 4; ++q) oacc[i][q] *= alpha;
#pragma unroll
    for (int ks = 0; ks < 2; ++ks) {
      union { bf16x8 v; unsigned u[4]; } pf;
      pf.u[0] = pack2(sacc[2 * ks][0], sacc[2 * ks][1]);
      pf.u[1] = pack2(sacc[2 * ks][2], sacc[2 * ks][3]);
      pf.u[2] = pack2(sacc[2 * ks + 1][0], sacc[2 * ks + 1][1]);
      pf.u[3] = pack2(sacc[2 * ks + 1][2], sacc[2 * ks + 1][3]);
#pragma unroll
      for (int m = 0; m < 4; ++m) {
        union { bf16x8 v; uint2 h[2]; } av;
        const bf16_t* vp = sV + (m * 16 + lr) * LDV + ks * 32 + lg * 4;
        av.h[0] = *(const uint2*)(vp);
        av.h[1] = *(const uint2*)(vp + 16);
        oacc[m] = mfma16(av.v, pf.v, oacc[m]);
      }
    }
    AT_WRITE((kt + 1) & 1)
    __syncthreads();
  }
  lrun += __shfl_xor(lrun, 16, 64);
  lrun += __shfl_xor(lrun, 32, 64);
  const float inv = 1.f / lrun;
#pragma unroll
  for (int m = 0; m < 4; ++m) {
    uint2 o;
    o.x = pack2(oacc[m][0] * inv, oacc[m][1] * inv);
    o.y = pack2(oacc[m][2] * inv, oacc[m][3] * inv);
    *(uint2*)(WSB(OFF_CAT) + (size_t)qrow * 1024 + hh * 64 + m * 16 + lg * 4) = o;
  }
}

NOINL void ssd_y_item(const P& p, int item) {
  char* smem = g_smem;
  const int tid = opaque_tid(), lane = tid & 63, wave = tid >> 6, lr = lane & 15, lg = lane >> 4;
  const int cidx = item >> 2, half = (item >> 1) & 1, g = item & 1;
  const int r0 = cidx * 128;
  const int hh = g * 4 + wave;
  constexpr int LDC = 136, LDM = 72;
  bf16_t* sC = (bf16_t*)smem;
  bf16_t* sB = sC + 64 * LDC;
  bf16_t* sM = sB + 64 * LDC + wave * 64 * LDM;
  float* rowss = (float*)((bf16_t*)smem + 2 * 64 * LDC + 4 * 64 * LDM);
  const float* cum = WSF(OFF_CUM);
  const float* dtv = WSF(OFF_DTV);
  const int srow = tid >> 4, scol = (tid & 15) * 8;
  uint4 pb0, pb1, pb2, pb3;
  {
    const bf16_t* cs = WSB(OFF_CM) + (size_t)(r0 + half * 64 + srow) * 256 + g * 128 + scol;
    const bf16_t* bs = WSB(OFF_BM) + (size_t)(r0 + srow) * 256 + g * 128 + scol;
    const uint4 c0 = *(const uint4*)(cs), c1 = *(const uint4*)(cs + 16 * 256), c2 = *(const uint4*)(cs + 32 * 256), c3 = *(const uint4*)(cs + 48 * 256);
    const uint4 b0 = *(const uint4*)(bs), b1 = *(const uint4*)(bs + 16 * 256), b2 = *(const uint4*)(bs + 32 * 256), b3 = *(const uint4*)(bs + 48 * 256);
    pb0 = *(const uint4*)(bs + 64 * 256); pb1 = *(const uint4*)(bs + 80 * 256); pb2 = *(const uint4*)(bs + 96 * 256); pb3 = *(const uint4*)(bs + 112 * 256);
    bf16_t* wc = sC + srow * LDC + scol;
    bf16_t* wb = sB + srow * LDC + scol;
    *(uint4*)(wc) = c0; *(uint4*)(wc + 16 * LDC) = c1; *(uint4*)(wc + 32 * LDC) = c2; *(uint4*)(wc + 48 * LDC) = c3;
    *(uint4*)(wb) = b0; *(uint4*)(wb + 16 * LDC) = b1; *(uint4*)(wb + 32 * LDC) = b2; *(uint4*)(wb + 48 * LDC) = b3;
  }
  __syncthreads();
  f32x4 Y[4][4];
#pragma unroll
  for (int i = 0; i < 4; ++i)
#pragma unroll
    for (int j = 0; j < 4; ++j) Y[i][j] = (f32x4){0.f, 0.f, 0.f, 0.f};
#pragma unroll 1
  for (int jh = 0; jh < 2; ++jh) {
    if (jh == 1) {
      __syncthreads();
      bf16_t* wb = sB + srow * LDC + scol;
      *(uint4*)(wb) = pb0; *(uint4*)(wb + 16 * LDC) = pb1; *(uint4*)(wb + 32 * LDC) = pb2; *(uint4*)(wb + 48 * LDC) = pb3;
      __syncthreads();
    }
#pragma unroll 1
    for (int dir = 0; dir < 2; ++dir) {
      const bool use = dir == 0 ? (jh <= half) : (jh >= half);
      if (!use) continue;
      bf16x8 xf[2][4];
#pragma unroll
      for (int ks = 0; ks < 2; ++ks)
#pragma unroll
        for (int pt = 0; pt < 4; ++pt)
          xf[ks][pt] = *(const bf16x8*)(WSB(OFF_XST) + (size_t)(hh * 64 + pt * 16 + lr) * 8192 + r0 + jh * 64 + ks * 32 + lg * 8);
      float ci[4], cj[4][4], dj[4][4];
#pragma unroll
      for (int it = 0; it < 4; ++it) ci[it] = cum[((size_t)dir * 8192 + r0 + half * 64 + it * 16 + lr) * 8 + hh];
#pragma unroll
      for (int jt = 0; jt < 4; ++jt)
#pragma unroll
        for (int q = 0; q < 4; ++q) {
          const size_t tj = (size_t)dir * 8192 + r0 + jh * 64 + jt * 16 + lg * 4 + q;
          cj[jt][q] = cum[tj * 8 + hh];
          dj[jt][q] = dtv[tj * 8 + hh];
        }
#pragma unroll
      for (int it = 0; it < 4; ++it) {
        f32x4 cb[4];
#pragma unroll
        for (int jt = 0; jt < 4; ++jt) cb[jt] = (f32x4){0.f, 0.f, 0.f, 0.f};
#pragma unroll
        for (int ks = 0; ks < 4; ++ks) {
          const bf16x8 b = *(const bf16x8*)(sC + (it * 16 + lr) * LDC + ks * 32 + lg * 8);
#pragma unroll
          for (int jt = 0; jt < 4; ++jt) {
            const bf16x8 a = *(const bf16x8*)(sB + (jt * 16 + lr) * LDC + ks * 32 + lg * 8);
            cb[jt] = mfma16(a, b, cb[jt]);
          }
        }
        const int ti = half * 64 + it * 16 + lr;
#pragma unroll
        for (int jt = 0; jt < 4; ++jt) {
          float v[4];
#pragma unroll
          for (int q = 0; q < 4; ++q) {
            const int tj = jh * 64 + jt * 16 + lg * 4 + q;
            const bool ok = dir == 0 ? (tj <= ti) : (tj >= ti);
            v[q] = ok ? cb[jt][q] * __expf(ci[it] - cj[jt][q]) * dj[jt][q] : 0.f;
          }
          uint2 o;
          o.x = pack2(v[0], v[1]);
          o.y = pack2(v[2], v[3]);
          *(uint2*)(sM + (it * 16 + lr) * LDM + jt * 16 + lg * 4) = o;
        }
        __builtin_amdgcn_sched_barrier(0);
      }
      asm volatile("s_waitcnt lgkmcnt(0)" ::: "memory");
#pragma unroll
      for (int ks = 0; ks < 2; ++ks) {
        bf16x8 af[4];
#pragma unroll
        for (int it = 0; it < 4; ++it) af[it] = *(const bf16x8*)(sM + (it * 16 + lr) * LDM + ks * 32 + lg * 8);
#pragma unroll
        for (int it = 0; it < 4; ++it)
#pragma unroll
          for (int pt = 0; pt < 4; ++pt) Y[it][pt] = mfma16(af[it], xf[ks][pt], Y[it][pt]);
      }
      asm volatile("s_waitcnt lgkmcnt(0)" ::: "memory");
      __builtin_amdgcn_sched_barrier(0);
    }
  }
#pragma unroll 1
  for (int dir = 0; dir < 2; ++dir) {
    const bf16_t* hp = WSB(OFF_H) + ((size_t)(dir * 64 + cidx) * 8 + hh) * 8192;
    float ei[4][4];
#pragma unroll
    for (int it = 0; it < 4; ++it)
#pragma unroll
      for (int q = 0; q < 4; ++q)
        ei[it][q] = __expf(cum[((size_t)dir * 8192 + r0 + half * 64 + it * 16 + lg * 4 + q) * 8 + hh]);
#pragma unroll
    for (int pt = 0; pt < 4; ++pt) {
      bf16x8 bfr[4];
#pragma unroll
      for (int ks = 0; ks < 4; ++ks) bfr[ks] = *(const bf16x8*)(hp + (size_t)(pt * 16 + lr) * 128 + ks * 32 + lg * 8);
      f32x4 T[4];
#pragma unroll
      for (int it = 0; it < 4; ++it) T[it] = (f32x4){0.f, 0.f, 0.f, 0.f};
#pragma unroll
      for (int ks = 0; ks < 4; ++ks)
#pragma unroll
        for (int it = 0; it < 4; ++it) {
          const bf16x8 a = *(const bf16x8*)(sC + (it * 16 + lr) * LDC + ks * 32 + lg * 8);
          T[it] = mfma16(a, bfr[ks], T[it]);
        }
#pragma unroll
      for (int it = 0; it < 4; ++it)
#pragma unroll
        for (int q = 0; q < 4; ++q) Y[it][pt][q] += ei[it][q] * T[it][q];
    }
    __builtin_amdgcn_sched_barrier(0);
  }
  const float dsk = p.ssd_d[hh];
  const float* proj = WSF(OFF_R1);
#pragma unroll
  for (int i = 0; i < 4; ++i) {
#pragma unroll
    for (int q = 0; q < 4; ++q) {
      const int il = i * 16 + lg * 4 + q;
      const size_t r = (size_t)r0 + half * 64 + il;
      float ss = 0.f;
#pragma unroll
      for (int j = 0; j < 4; ++j) {
        const int ch = hh * 64 + j * 16 + lr;
        const float xs = bf2f(WSB(OFF_XS)[r * 512 + ch]);
        const float z = proj[r * 2096 + 544 + ch];
        const float y = (Y[i][j][q] + dsk * xs) * silu(z);
        Y[i][j][q] = y;
        ss += y * y;
      }
      ss += __shfl_xor(ss, 1, 64);
      ss += __shfl_xor(ss, 2, 64);
      ss += __shfl_xor(ss, 4, 64);
      ss += __shfl_xor(ss, 8, 64);
      if (lr == 0) rowss[wave * 64 + il] = ss;
    }
    __builtin_amdgcn_sched_barrier(0);
  }
  __syncthreads();
#pragma unroll
  for (int i = 0; i < 4; ++i) {
#pragma unroll
    for (int q = 0; q < 4; ++q) {
      const int il = i * 16 + lg * 4 + q;
      const size_t r = (size_t)r0 + half * 64 + il;
      const float tot = rowss[il] + rowss[64 + il] + rowss[128 + il] + rowss[192 + il];
      const float rs = rsqrtf(tot * (1.f / 256.f) + 1e-6f);
#pragma unroll
      for (int j = 0; j < 4; ++j) {
        const int ch = hh * 64 + j * 16 + lr;
        WSB(OFF_CAT)[r * 1024 + 512 + ch] = f2bf(Y[i][j][q] * rs * p.ssd_norm[ch]);
      }
    }
    __builtin_amdgcn_sched_barrier(0);
  }
  __syncthreads();
}

NOINL void pool_phase(const P& p) {
  const bf16_t* h = WSB(OFF_H);
  bf16_t* dst = WSB(OFF_CAT);
  const int total = 8192 * 128;
  for (int idx = blockIdx.x * 256 + threadIdx.x; idx < total; idx += gridDim.x * 256) {
    const int r = idx >> 7, cc = (idx & 127) * 8;
    int s0, L;
    if (r < 4096) { s0 = r & ~255; L = 256; } else { s0 = 4096 + ((r - 4096) & ~2047); L = 2048; }
    const int t = r - s0;
    const int w2 = 1 << (cc >> 8);
    const int lo = max(t - w2, 0), hi = min(t + w2, L);
    float acc[8] = {0, 0, 0, 0, 0, 0, 0, 0};
    for (int u = lo; u < hi; ++u) {
      const uint4 v = *(const uint4*)(h + (size_t)(s0 + u) * 1024 + cc);
      acc[0] += __uint_as_float(v.x << 16); acc[1] += __uint_as_float(v.x & 0xffff0000u);
      acc[2] += __uint_as_float(v.y << 16); acc[3] += __uint_as_float(v.y & 0xffff0000u);
      acc[4] += __uint_as_float(v.z << 16); acc[5] += __uint_as_float(v.z & 0xffff0000u);
      acc[6] += __uint_as_float(v.w << 16); acc[7] += __uint_as_float(v.w & 0xffff0000u);
    }
    const float inv = 1.f / (float)(hi - lo);
    const uint4 v = *(const uint4*)(h + (size_t)r * 1024 + cc);
    uint4 o;
    o.x = pack2(acc[0] * inv - __uint_as_float(v.x << 16), acc[1] * inv - __uint_as_float(v.x & 0xffff0000u));
    o.y = pack2(acc[2] * inv - __uint_as_float(v.y << 16), acc[3] * inv - __uint_as_float(v.y & 0xffff0000u));
    o.z = pack2(acc[4] * inv - __uint_as_float(v.z << 16), acc[5] * inv - __uint_as_float(v.z & 0xffff0000u));
    o.w = pack2(acc[6] * inv - __uint_as_float(v.w << 16), acc[7] * inv - __uint_as_float(v.w & 0xffff0000u));
    *(uint4*)(dst + (size_t)r * 1024 + cc) = o;
  }
}

NOINL void ph_gemm_proj(const P& p) {
  float* proj = WSF(OFF_R1);
  const bf16_t* A = WSB(OFF_H);
  const bf16_t* B = WSB(OFF_WIN);
  gemm_stream(64 * 17, 1024, 1024, 1024, g_smem,
    [=](int t) {
      TileInfo r;
      int m, n; tile_mn(t, 64, 17, m, n);
      r.m0 = m * 128; r.n0 = n * 128; r.ctx = 0;
      r.a = A + (size_t)r.m0 * 1024; r.b = B + (size_t)r.n0 * 1024;
      return r;
    },
    [&](int ctx, int row, int col, f32x4 v0, f32x4 v1) {
#pragma unroll
      for (int q = 0; q < 4; ++q) {
        if (col < 2096) proj[(size_t)(row + q) * 2096 + col] = v0[q];
        if (col + 16 < 2096) proj[(size_t)(row + q) * 2096 + col + 16] = v1[q];
      }
    });
}

NOINL void ph_gemm_f32out(const P& p, const bf16_t* A, int lda, const bf16_t* B, int ldb, int K, float* C, int N) {
  const int nN = N / 128;
  gemm_stream(64 * nN, lda, ldb, K, g_smem,
    [=](int t) {
      TileInfo r;
      int m, n; tile_mn(t, 64, nN, m, n);
      r.m0 = m * 128; r.n0 = n * 128; r.ctx = 0;
      r.a = A + (size_t)r.m0 * lda; r.b = B + (size_t)r.n0 * ldb;
      return r;
    },
    [&](int ctx, int row, int col, f32x4 v0, f32x4 v1) {
#pragma unroll
      for (int q = 0; q < 4; ++q) {
        C[(size_t)(row + q) * N + col] = v0[q];
        C[(size_t)(row + q) * N + col + 16] = v1[q];
      }
    });
}

NOINL void ph_gemm_q(const P& p) {
  bf16_t* qo = WSB(OFF_Q);
  const bf16_t* A = WSB(OFF_CQN);
  const bf16_t* B = WSB(OFF_WUQ);
  gemm_stream(64 * 6, 256, 256, 256, g_smem,
    [=](int t) {
      TileInfo r;
      int m, n; tile_mn(t, 64, 6, m, n);
      r.m0 = m * 128; r.n0 = n * 128; r.ctx = 0;
      r.a = A + (size_t)r.m0 * 256; r.b = B + (size_t)r.n0 * 256;
      return r;
    },
    [&](int ctx, int row, int col, f32x4 v0, f32x4 v1) {
      const float scl = 0.10206207261596575f;
      const int tn = col >> 4;
      const bool rope = ((tn % 6) == 4) && (row >= 4096);
      const int ii = col & 15;
      const float fr = rope_freq(ii & 7);
#pragma unroll
      for (int q = 0; q < 4; ++q) {
        float a = v0[q], b = v1[q];
        if (rope) {
          const int tt = (row + q - 4096) & 2047;
          const float pos = (ii < 8) ? (float)(tt >> 6) : (float)(tt & 63);
          const float ang = pos * fr;
          float cs, sn;
          fast_sincos(ang, sn, cs);
          const float x1 = a, x2 = b;
          a = x1 * cs - x2 * sn;
          b = x1 * sn + x2 * cs;
        }
        qo[(size_t)(row + q) * 768 + col] = f2bf(a * scl);
        qo[(size_t)(row + q) * 768 + col + 16] = f2bf(b * scl);
      }
    });
}

NOINL void ph_gemm_kv(const P& p) {
  bf16_t* kn = WSB(OFF_KN);
  bf16_t* vt = WSB(OFF_VT);
  const bf16_t* A = WSB(OFF_CKV);
  const bf16_t* B = WSB(OFF_WUKV);
  gemm_stream(68 * 8, 256, 256, 256, g_smem,
    [=](int t) {
      TileInfo r;
      int m, n; tile_mn(t, 68, 8, m, n);
      r.m0 = m * 128; r.n0 = n * 128; r.ctx = 0;
      r.a = A + (size_t)r.m0 * 256; r.b = B + (size_t)r.n0 * 256;
      return r;
    },
    [&](int ctx, int row, int col, f32x4 v0, f32x4 v1) {
      const int hh = col >> 7, j = col & 127;
      if (j < 64) {
#pragma unroll
        for (int q = 0; q < 4; ++q) {
          kn[(size_t)(row + q) * 512 + hh * 64 + j] = f2bf(v0[q]);
          kn[(size_t)(row + q) * 512 + hh * 64 + j + 16] = f2bf(v1[q]);
        }
      } else {
        uint2 o0, o1;
        o0.x = pack2(v0[0], v0[1]); o0.y = pack2(v0[2], v0[3]);
        o1.x = pack2(v1[0], v1[1]); o1.y = pack2(v1[2], v1[3]);
        *(uint2*)(vt + (size_t)(hh * 64 + j - 64) * 8704 + row) = o0;
        *(uint2*)(vt + (size_t)(hh * 64 + j - 64 + 16) * 8704 + row) = o1;
      }
    });
}

NOINL void ph_gemm_ffn_up(const P& p, int layer) {
  bf16_t* gu = WSB(OFF_R1);
  const bf16_t* A = WSB(OFF_H);
  const bf16_t* B = WSB(OFF_WGU) + (size_t)layer * 5632 * 1024;
  gemm_stream(64 * 44, 1024, 1024, 1024, g_smem,
    [=](int t) {
      TileInfo r;
      int m, n; tile_mn(t, 64, 44, m, n);
      r.m0 = m * 128; r.n0 = n * 128; r.ctx = 0;
      r.a = A + (size_t)r.m0 * 1024; r.b = B + (size_t)r.n0 * 1024;
      return r;
    },
    [&](int ctx, int row, int col, f32x4 v0, f32x4 v1) {
      const int oc = (col >> 5) * 16 + (col & 15);
#pragma unroll
      for (int q = 0; q < 4; ++q) gu[(size_t)(row + q) * 2816 + oc] = f2bf(silu(v0[q]) * v1[q]);
    });
}

NOINL void ph_gemm_pool(const P& p) {
  float* mix = WSF(OFF_R1);
  const bf16_t* A = WSB(OFF_CAT);
  const bf16_t* B = WSB(OFF_WPOOL);
  gemm_stream(512, 1024, 256, 256, g_smem,
    [=](int t) {
      TileInfo r;
      const int id = swz_tile(t, 512);
      const int g = id >> 7, rem = id & 127;
      r.m0 = (rem >> 1) * 128; r.n0 = (rem & 1) * 128; r.ctx = g;
      r.a = A + (size_t)r.m0 * 1024 + g * 256; r.b = B + (size_t)g * 65536 + (size_t)r.n0 * 256;
      return r;
    },
    [&](int g, int row, int col, f32x4 v0, f32x4 v1) {
      const int c0 = g * 256 + col;
      const float s0 = p.pool_scale[c0], s1 = p.pool_scale[c0 + 16];
#pragma unroll
      for (int q = 0; q < 4; ++q) {
        mix[(size_t)(row + q) * 1024 + c0] = v0[q] * s0;
        mix[(size_t)(row + q) * 1024 + c0 + 16] = v1[q] * s1;
      }
    });
}


#define XB_TMO      128
#define XB_XCNT(j)  (256  + 64 * (j))
#define XB_XSUB(j)  (1280 + 64 * (j))
#define XB_XGEN(j)  (2304 + 64 * (j))
#define XB_TOP      3328
#define XB_TOPGEN   3392
#define XCD_BAR_WORDS 3456
#define XB_SPIN_CAP (1u << 22)
#define LAS __attribute__((address_space(3)))
DEVI unsigned xb_ld(unsigned* p) { return __hip_atomic_load(p, __ATOMIC_RELAXED, __HIP_MEMORY_SCOPE_AGENT); }
DEVI unsigned xb_add(unsigned* p, unsigned v) { return __hip_atomic_fetch_add(p, v, __ATOMIC_RELAXED, __HIP_MEMORY_SCOPE_AGENT); }
DEVI unsigned xb_xcc_id() { return (unsigned)__builtin_amdgcn_s_getreg((3 << 11) | 20) & 0xFu; }
#define XB_SPIN(cond, bar) do { unsigned _sp = 0; while (cond) { __builtin_amdgcn_s_sleep(1); \
    if ((++_sp & 255u) == 0u) { if (xb_ld(&(bar)[XB_TMO])) break; if (_sp > XB_SPIN_CAP) { atomicAdd(&(bar)[XB_TMO], 1u); break; } } } } while (0)
struct XcdBarrier { unsigned* bar; unsigned x; volatile LAS unsigned* st; };
DEVI XcdBarrier xcd_barrier_post(unsigned* bar, volatile LAS unsigned* st) {
  XcdBarrier b; b.bar = bar; b.x = xb_xcc_id(); b.st = st;
  if (threadIdx.x == 0) (void)xb_add(&bar[XB_XCNT(b.x)], 1u);
  return b;
}
DEVI void xcd_barrier_complete(unsigned* bar, unsigned x, unsigned& nloc, unsigned& nx) {
  const unsigned G = gridDim.x * gridDim.y * gridDim.z;
  unsigned sum, cnt, mine, sp = 0u;
  for (;;) {
    sum = 0u; cnt = 0u; mine = 0u;
#pragma unroll
    for (unsigned j = 0; j < 16; ++j) { const unsigned c = xb_ld(&bar[XB_XCNT(j)]); sum += c; cnt += (c > 0u) ? 1u : 0u; mine = (j == x) ? c : mine; }
    if (sum == G) break;
    __builtin_amdgcn_s_sleep(1);
    if ((++sp & 255u) == 0u) { if (xb_ld(&bar[XB_TMO])) break; if (sp > XB_SPIN_CAP) { atomicAdd(&bar[XB_TMO], 1u); break; } }
  }
  nloc = mine > 0u ? mine : 1u; nx = cnt > 0u ? cnt : 1u;
}
DEVI void xcd_barrier(const XcdBarrier& b) {
  asm volatile("s_waitcnt vmcnt(0)" ::: "memory");
  __syncthreads();
  if (threadIdx.x == 0) {
    unsigned* bar = b.bar;
    __builtin_amdgcn_s_waitcnt(0);
    unsigned nloc = b.st[0], nx = b.st[1];
    if (nloc == 0u) { xcd_barrier_complete(bar, b.x, nloc, nx); b.st[0] = nloc; b.st[1] = nx; }
    const unsigned old = xb_add(&bar[XB_XSUB(b.x)], 1u);
    const unsigned gen = old / nloc;
    if (old + 1u == (gen + 1u) * nloc) {
      __builtin_amdgcn_fence(__ATOMIC_RELEASE, "agent");
      asm volatile("s_waitcnt vmcnt(0)" ::: "memory");
      const unsigned og = xb_add(&bar[XB_TOP], 1u);
      const unsigned tg = og / nx;
      if (og + 1u == (tg + 1u) * nx) xb_add(&bar[XB_TOPGEN], 1u);
      else XB_SPIN(xb_ld(&bar[XB_TOPGEN]) == tg, bar);
      __builtin_amdgcn_fence(__ATOMIC_ACQUIRE, "agent");
      xb_add(&bar[XB_XGEN(b.x)], 1u);
      asm volatile("s_waitcnt vmcnt(0)" ::: "memory");
    } else {
      XB_SPIN(xb_ld(&bar[XB_XGEN(b.x)]) == gen, bar);
      __builtin_amdgcn_fence(__ATOMIC_ACQUIRE, "agent");
      asm volatile("s_waitcnt vmcnt(0)" ::: "memory");
    }
  }
  __syncthreads();
}

constexpr int NPHASE = 18;
#ifndef REPMASK
#define REPMASK 0
#endif
#ifndef PHMASK
#define PHMASK 0x3ffff
#endif
#define PH(n) if constexpr ((PHMASK >> (n)) & 1)

__global__ void __launch_bounds__(256, 2) mega(P p, int lo, int hi) {
  __shared__ uint4 xb_words;
  if (threadIdx.x == 0) xb_words = make_uint4(0u, 0u, 0u, 0u);
  __syncthreads();
  XcdBarrier xb = xcd_barrier_post((unsigned*)(p.ws + OFF_BAR), (volatile LAS unsigned*)&xb_words);
  if (lo < 0) cg::this_grid().sync();
  PH(0) if (lo <= 0 && 0 < hi) {
        for (int t = blockIdx.x; t < 384 + 5200; t += gridDim.x) {
          if (t < 384) gemv_tile(p, t); else transpose_tile(p, t - 384);
        }
#if (REPMASK >> 0) & 1
    xcd_barrier(xb);
        for (int t = blockIdx.x; t < 384 + 5200; t += gridDim.x) {
          if (t < 384) gemv_tile(p, t); else transpose_tile(p, t - 384);
        }
#endif
  }
  if (lo <= 0 && 0 + 1 < hi) xcd_barrier(xb);
  PH(1) if (lo <= 1 && 1 < hi) {
        rowop<false, true, true>(p, nullptr, nullptr, 0, p.n_pre_mix, 0, 1, 0, 0);
#if (REPMASK >> 1) & 1
    xcd_barrier(xb);
        rowop<false, true, true>(p, nullptr, nullptr, 0, p.n_pre_mix, 0, 1, 0, 0);
#endif
  }
  if (lo <= 1 && 1 + 1 < hi) xcd_barrier(xb);
  PH(2) if (lo <= 2 && 2 < hi) {
        ph_gemm_proj(p);
#if (REPMASK >> 2) & 1
    xcd_barrier(xb);
        ph_gemm_proj(p);
#endif
  }
  if (lo <= 2 && 2 + 1 < hi) xcd_barrier(xb);
  PH(3) if (lo <= 3 && 3 < hi) {
        prep_rows(p);
        prep_cache(p);
        for (int t = blockIdx.x; t < 2048; t += gridDim.x) conv_tile(p, t);
#if (REPMASK >> 3) & 1
    xcd_barrier(xb);
        prep_rows(p);
        prep_cache(p);
        for (int t = blockIdx.x; t < 2048; t += gridDim.x) conv_tile(p, t);
#endif
  }
  if (lo <= 3 && 3 + 1 < hi) xcd_barrier(xb);
  PH(4) if (lo <= 4 && 4 < hi) {
        ph_gemm_q(p);
        ph_gemm_kv(p);
        for (int t = blockIdx.x; t < 512; t += gridDim.x) chunk_state_item(p, t);
#if (REPMASK >> 4) & 1
    xcd_barrier(xb);
        ph_gemm_q(p);
        ph_gemm_kv(p);
        for (int t = blockIdx.x; t < 512; t += gridDim.x) chunk_state_item(p, t);
#endif
  }
  if (lo <= 4 && 4 + 1 < hi) xcd_barrier(xb);
  PH(5) if (lo <= 5 && 5 < hi) {
        scan_states(p);
#if (REPMASK >> 5) & 1
    xcd_barrier(xb);
        scan_states(p);
#endif
  }
  if (lo <= 5 && 5 + 1 < hi) xcd_barrier(xb);
  PH(6) if (lo <= 6 && 6 < hi) {
        for (int t = blockIdx.x; t < 1024; t += gridDim.x) {
          if (t >= 512 && t < 768) ssd_y_item(p, t - 512);
          else {
            const int first = t < 512 ? t : 512 + 2 * (t - 768);
            const int cnt = t < 512 ? 1 : 2;
            for (int k = 0; k < cnt; ++k) attn_item(p, first + k);
          }
        }
#if (REPMASK >> 6) & 1
    xcd_barrier(xb);
        for (int t = blockIdx.x; t < 1024; t += gridDim.x) {
          if (t >= 512 && t < 768) ssd_y_item(p, t - 512);
          else {
            const int first = t < 512 ? t : 512 + 2 * (t - 768);
            const int cnt = t < 512 ? 1 : 2;
            for (int k = 0; k < cnt; ++k) attn_item(p, first + k);
          }
        }
#endif
  }
  if (lo <= 6 && 6 + 1 < hi) xcd_barrier(xb);
  PH(7) if (lo <= 7 && 7 < hi) {
        ph_gemm_f32out(p, WSB(OFF_CAT), 1024, WSB(OFF_WOUT), 1024, 1024, WSF(OFF_R1), 1024);
#if (REPMASK >> 7) & 1
    xcd_barrier(xb);
        ph_gemm_f32out(p, WSB(OFF_CAT), 1024, WSB(OFF_WOUT), 1024, 1024, WSF(OFF_R1), 1024);
#endif
  }
  if (lo <= 7 && 7 + 1 < hi) xcd_barrier(xb);
  PH(8) if (lo <= 8 && 8 < hi) {
        rowop<true, true, true>(p, WSF(OFF_R1), p.n_post_mix, 2, p.n_pre_ffn, 3, 4, 0, 0);
#if (REPMASK >> 8) & 1
    xcd_barrier(xb);
        rowop<true, true, true>(p, WSF(OFF_R1), p.n_post_mix, 2, p.n_pre_ffn, 3, 4, 0, 0);
#endif
  }
  if (lo <= 8 && 8 + 1 < hi) xcd_barrier(xb);
  PH(9) if (lo <= 9 && 9 < hi) {
        ph_gemm_ffn_up(p, 0);
#if (REPMASK >> 9) & 1
    xcd_barrier(xb);
        ph_gemm_ffn_up(p, 0);
#endif
  }
  if (lo <= 9 && 9 + 1 < hi) xcd_barrier(xb);
  PH(10) if (lo <= 10 && 10 < hi) {
        ph_gemm_f32out(p, WSB(OFF_R1), 2816, WSB(OFF_WDN), 2816, 2816, WSF(OFF_R2), 1024);
#if (REPMASK >> 10) & 1
    xcd_barrier(xb);
        ph_gemm_f32out(p, WSB(OFF_R1), 2816, WSB(OFF_WDN), 2816, 2816, WSF(OFF_R2), 1024);
#endif
  }
  if (lo <= 10 && 10 + 1 < hi) xcd_barrier(xb);
  PH(11) if (lo <= 11 && 11 < hi) {
        rowop<true, true, false>(p, WSF(OFF_R2), p.n_post_ffn, 5, p.n_pre_mix + 1024, 0, 1, 0, 1);
#if (REPMASK >> 11) & 1
    xcd_barrier(xb);
        rowop<true, true, false>(p, WSF(OFF_R2), p.n_post_ffn, 5, p.n_pre_mix + 1024, 0, 1, 0, 1);
#endif
  }
  if (lo <= 11 && 11 + 1 < hi) xcd_barrier(xb);
  PH(12) if (lo <= 12 && 12 < hi) {
        pool_phase(p);
#if (REPMASK >> 12) & 1
    xcd_barrier(xb);
        pool_phase(p);
#endif
  }
  if (lo <= 12 && 12 + 1 < hi) xcd_barrier(xb);
  PH(13) if (lo <= 13 && 13 < hi) {
        ph_gemm_pool(p);
#if (REPMASK >> 13) & 1
    xcd_barrier(xb);
        ph_gemm_pool(p);
#endif
  }
  if (lo <= 13 && 13 + 1 < hi) xcd_barrier(xb);
  PH(14) if (lo <= 14 && 14 < hi) {
        rowop<true, true, false>(p, WSF(OFF_R1), p.n_post_mix + 1024, 2, p.n_pre_ffn + 1024, 3, 4, 1, 1);
#if (REPMASK >> 14) & 1
    xcd_barrier(xb);
        rowop<true, true, false>(p, WSF(OFF_R1), p.n_post_mix + 1024, 2, p.n_pre_ffn + 1024, 3, 4, 1, 1);
#endif
  }
  if (lo <= 14 && 14 + 1 < hi) xcd_barrier(xb);
  PH(15) if (lo <= 15 && 15 < hi) {
        ph_gemm_ffn_up(p, 1);
#if (REPMASK >> 15) & 1
    xcd_barrier(xb);
        ph_gemm_ffn_up(p, 1);
#endif
  }
  if (lo <= 15 && 15 + 1 < hi) xcd_barrier(xb);
  PH(16) if (lo <= 16 && 16 < hi) {
        ph_gemm_f32out(p, WSB(OFF_R1), 2816, WSB(OFF_WDN) + (size_t)1024 * 2816, 2816, 2816, WSF(OFF_R2), 1024);
#if (REPMASK >> 16) & 1
    xcd_barrier(xb);
        ph_gemm_f32out(p, WSB(OFF_R1), 2816, WSB(OFF_WDN) + (size_t)1024 * 2816, 2816, 2816, WSF(OFF_R2), 1024);
#endif
  }
  if (lo <= 16 && 16 + 1 < hi) xcd_barrier(xb);
  PH(17) if (lo <= 17 && 17 < hi) {
        rowop<true, false, false>(p, WSF(OFF_R2), p.n_post_ffn + 1024, 5, nullptr, 0, 0, 1, 1);
#if (REPMASK >> 17) & 1
    xcd_barrier(xb);
        rowop<true, false, false>(p, WSF(OFF_R2), p.n_post_ffn + 1024, 5, nullptr, 0, 0, 1, 1);
#endif
  }
}

extern "C" void kernel_launch(void* const* d_in, const int* in_sizes, int n_in, void* d_out, int out_size, void* d_ws,
                              size_t ws_size, hipStream_t stream) {
  P p{};
  const float** f = (const float**)&p;
  for (int i = 0; i < 33; ++i) f[i] = (const float*)d_in[i];
  p.out = (float*)d_out;
  p.ws = (char*)d_ws;
  static int grid_blocks = 0;
  if (!grid_blocks) {
    int dev = 0, cus = 0, per_cu = 0;
    hipGetDevice(&dev);
    hipDeviceGetAttribute(&cus, hipDeviceAttributeMultiprocessorCount, dev);
    hipOccupancyMaxActiveBlocksPerMultiprocessor(&per_cu, mega, 256, 0);
    if (per_cu > 2) per_cu = 2;
    if (per_cu < 1) per_cu = 1;
    grid_blocks = cus * per_cu;
  }
  hipMemsetAsync((char*)d_ws + OFF_BAR, 0, XCD_BAR_WORDS * 4, stream);
#if SINGLE_LAUNCH
  int lo = 0, hi = NPHASE;
  void* args[] = {&p, &lo, &hi};
  hipError_t e = hipLaunchCooperativeKernel((void*)mega, dim3(grid_blocks), dim3(256), args, 0, stream);
  if (e != hipSuccess) fprintf(stderr, "cooperative launch failed: %s (grid %d)\n", hipGetErrorString(e), grid_blocks);
#else
  for (int ph = 0; ph < NPHASE; ++ph) mega<<<grid_blocks, 256, 0, stream>>>(p, ph, ph + 1);
#endif
}
```

```cpp
#include <hip/hip_runtime.h>
#include <hip/hip_cooperative_groups.h>
#include <stdint.h>
#include <stdio.h>
namespace cg = cooperative_groups;

#ifndef SINGLE_LAUNCH
#define SINGLE_LAUNCH 1
#endif

typedef __attribute__((ext_vector_type(8))) short bf16x8;
typedef __attribute__((ext_vector_type(4))) float f32x4;
typedef unsigned short bf16_t;

#define DEVI __device__ __forceinline__

constexpr size_t OFF_WIN   = 0;
constexpr size_t OFF_WUQ   = OFF_WIN   + (size_t)2176*1024*2;
constexpr size_t OFF_WUKV  = OFF_WUQ   + (size_t)768*256*2;
constexpr size_t OFF_WOUT  = OFF_WUKV  + (size_t)1024*256*2;
constexpr size_t OFF_WPOOL = OFF_WOUT  + (size_t)1024*1024*2;
constexpr size_t OFF_WGU   = OFF_WPOOL + (size_t)4*256*256*2;
constexpr size_t OFF_WDN   = OFF_WGU   + (size_t)2*5632*1024*2;
constexpr size_t OFF_MOD   = OFF_WDN   + (size_t)2*1024*2816*2;
constexpr size_t OFF_R1    = OFF_MOD   + (size_t)2*3*6144*4;
constexpr size_t OFF_R2    = OFF_R1    + (size_t)8192*2096*4;
constexpr size_t OFF_H     = OFF_R2    + (size_t)8192*1024*4;
constexpr size_t OFF_CAT   = OFF_H     + (size_t)8192*1024*2;
constexpr size_t OFF_Q     = OFF_CAT   + (size_t)8192*1024*2;
constexpr size_t OFF_KN    = OFF_Q     + (size_t)8192*768*2;
constexpr size_t OFF_VT    = OFF_KN    + (size_t)8704*512*2;
constexpr size_t OFF_CQN   = OFF_VT    + (size_t)8704*512*2;
constexpr size_t OFF_CKV   = OFF_CQN   + (size_t)8192*256*2;
constexpr size_t OFF_KPE   = OFF_CKV   + (size_t)8704*256*2;
constexpr size_t OFF_XS    = OFF_KPE   + (size_t)8704*32*2;
constexpr size_t OFF_XST   = OFF_XS    + (size_t)8192*512*2;
constexpr size_t OFF_BM    = OFF_XST   + (size_t)8192*512*2;
constexpr size_t OFF_BT    = OFF_BM    + (size_t)8192*256*2;
constexpr size_t OFF_CM    = OFF_BT    + (size_t)8192*256*2;
constexpr size_t OFF_DTV   = OFF_CM    + (size_t)8192*256*2;
constexpr size_t OFF_CUM   = OFF_DTV   + (size_t)2*8192*8*4;
constexpr size_t OFF_TOT   = OFF_CUM   + (size_t)2*8192*8*4;
constexpr size_t OFF_BAR   = OFF_TOT   + 4096;
constexpr size_t OFF_END   = OFF_BAR   + 16384;

constexpr size_t OUT_CKV = 8388608, OUT_KR = 9437184, OUT_SF = 9568256, OUT_SB = 10616832;

struct P {
  const float *x_prompt, *x_sample, *c, *cache_ckv, *cache_kr, *st_f, *st_b, *c_ctx;
  const float *w_mod, *b_mod, *n_pre_mix, *n_post_mix, *n_pre_ffn, *n_post_ffn;
  const float *w_in, *q_norm, *w_uq, *kv_norm, *w_ukv, *conv_w, *conv_b, *dtb_f, *dtb_b, *alog_f, *alog_b;
  const float *ssd_d, *ssd_norm, *w_out, *pool_w, *pool_scale, *w_gate, *w_up, *w_down;
  float* out;
  char* ws;
};

#define WSB(off) ((bf16_t*)(p.ws + (off)))
#define WSF(off) ((float*)(p.ws + (off)))

typedef __bf16 hwbf16x2 __attribute__((ext_vector_type(2)));
typedef float hwf32x2 __attribute__((ext_vector_type(2)));
DEVI bf16_t f2bf(float f) {
  __bf16 r = (__bf16)f;
  return __builtin_bit_cast(bf16_t, r);
}
DEVI float bf2f(bf16_t b) { return __uint_as_float(((unsigned)b) << 16); }
DEVI unsigned pack2(float a, float b) {
  hwf32x2 v = {a, b};
  hwbf16x2 r = __builtin_convertvector(v, hwbf16x2);
  return __builtin_bit_cast(unsigned, r);
}
DEVI float silu(float x) { return x / (1.f + __expf(-x)); }
DEVI float wave_sum(float v) {
#pragma unroll
  for (int o = 32; o > 0; o >>= 1) v += __shfl_xor(v, o, 64);
  return v;
}
DEVI f32x4 mfma16(bf16x8 a, bf16x8 b, f32x4 c) { return __builtin_amdgcn_mfma_f32_16x16x32_bf16(a, b, c, 0, 0, 0); }

DEVI float rope_freq(int m) { return exp2f(-(float)m * 1.6609640474436813f); }
DEVI void fast_sincos(float ang, float& sn, float& cs) {
  float rev = ang * 0.15915494309189535f;
  rev -= rintf(rev);
  sn = __builtin_amdgcn_sinf(rev);
  cs = __builtin_amdgcn_cosf(rev);
}
DEVI int opaque_tid() { int t = threadIdx.x; asm volatile("" : "+v"(t)); return t; }
DEVI int swz_tile(int t, int T) {
  int q = T >> 3, r = T & 7, x = t & 7, off = t >> 3;
  return (x < r ? x * (q + 1) : r * (q + 1) + (x - r) * q) + off;
}

__shared__ __attribute__((aligned(16))) char g_smem[73728];
#define NOINL __device__ __forceinline__

constexpr int LDT = 72;
constexpr int TILE_E = 128 * LDT;

template <class Epi>
DEVI void gemm_tile(const bf16_t* __restrict__ A, int lda, const bf16_t* __restrict__ B, int ldb, int K,
                    int m0, int n0, char* smem, Epi epi) {
  const int tid = threadIdx.x, lane = tid & 63, wave = tid >> 6, wm = wave >> 1, wn = wave & 1;
  const int lr = lane & 15, lg = lane >> 4;
  bf16_t* sA = (bf16_t*)smem;
  bf16_t* sB = sA + 2 * TILE_E;
  f32x4 acc[4][4];
#pragma unroll
  for (int i = 0; i < 4; ++i)
#pragma unroll
    for (int j = 0; j < 4; ++j) acc[i][j] = (f32x4){0.f, 0.f, 0.f, 0.f};
  const int lrow = tid >> 3, lkc = (tid & 7) * 8;
  const bf16_t* gA = A + (size_t)(m0 + lrow) * lda + lkc;
  const bf16_t* gB = B + (size_t)(n0 + lrow) * ldb + lkc;
  uint4 ra[4], rb[4];
#pragma unroll
  for (int i = 0; i < 4; ++i) {
    ra[i] = *(const uint4*)(gA + (size_t)(32 * i) * lda);
    rb[i] = *(const uint4*)(gB + (size_t)(32 * i) * ldb);
  }
#pragma unroll
  for (int i = 0; i < 4; ++i) {
    *(uint4*)(sA + (lrow + 32 * i) * LDT + lkc) = ra[i];
    *(uint4*)(sB + (lrow + 32 * i) * LDT + lkc) = rb[i];
  }
  __syncthreads();
  const int nk = K >> 6;
  for (int kt = 0; kt < nk; ++kt) {
    const int cur = kt & 1;
    if (kt + 1 < nk) {
      const int k0 = (kt + 1) << 6;
#pragma unroll
      for (int i = 0; i < 4; ++i) {
        ra[i] = *(const uint4*)(gA + (size_t)(32 * i) * lda + k0);
        rb[i] = *(const uint4*)(gB + (size_t)(32 * i) * ldb + k0);
      }
    }
    const bf16_t* cA = sA + cur * TILE_E + (wm * 64 + lr) * LDT + lg * 8;
    const bf16_t* cB = sB + cur * TILE_E + (wn * 64 + lr) * LDT + lg * 8;
#pragma unroll
    for (int ks = 0; ks < 2; ++ks) {
      bf16x8 af[4], bfr[4];
#pragma unroll
      for (int i = 0; i < 4; ++i) {
        af[i] = *(const bf16x8*)(cA + i * 16 * LDT + ks * 32);
        bfr[i] = *(const bf16x8*)(cB + i * 16 * LDT + ks * 32);
      }
#pragma unroll
      for (int i = 0; i < 4; ++i)
#pragma unroll
        for (int j = 0; j < 4; ++j) acc[i][j] = mfma16(af[i], bfr[j], acc[i][j]);
    }
    if (kt + 1 < nk) {
      const int nx = cur ^ 1;
#pragma unroll
      for (int i = 0; i < 4; ++i) {
        *(uint4*)(sA + nx * TILE_E + (lrow + 32 * i) * LDT + lkc) = ra[i];
        *(uint4*)(sB + nx * TILE_E + (lrow + 32 * i) * LDT + lkc) = rb[i];
      }
    }
    __syncthreads();
  }
#pragma unroll
  for (int i = 0; i < 4; ++i)
#pragma unroll
    for (int j = 0; j < 4; j += 2)
      epi(m0 + wm * 64 + i * 16 + lg * 4, n0 + wn * 64 + j * 16 + lr, acc[i][j], acc[i][j + 1]);
}

struct TileInfo { const bf16_t* a; const bf16_t* b; int m0, n0, ctx; };
template <class TileFn, class Epi>
DEVI void gemm_stream(int T, int lda, int ldb, int K, char* smem, TileFn tf, Epi epi) {
  int t = blockIdx.x;
  if (t >= T) return;
  const int tid = opaque_tid(), lane = tid & 63, wave = tid >> 6, wm = wave >> 1, wn = wave & 1;
  const int lr = lane & 15, lg = lane >> 4;
  bf16_t* sA = (bf16_t*)smem;
  bf16_t* sB = sA + 2 * TILE_E;
  const int lrow = tid >> 3, lkc = (tid & 7) * 8;
  TileInfo ti = tf(t);
  const bf16_t* gA = ti.a + (size_t)lrow * lda + lkc;
  const bf16_t* gB = ti.b + (size_t)lrow * ldb + lkc;
  int m0 = ti.m0, n0 = ti.n0, ctx = ti.ctx;
  uint4 ra0, ra1, ra2, ra3, rb0, rb1, rb2, rb3;
  uint4 rc0, rc1, rc2, rc3, rd0, rd1, rd2, rd3;
#define GS_LOAD0(pa, pb) \
  ra0 = *(const uint4*)((pa)); ra1 = *(const uint4*)((pa) + (size_t)32 * lda); \
  ra2 = *(const uint4*)((pa) + (size_t)64 * lda); ra3 = *(const uint4*)((pa) + (size_t)96 * lda); \
  rb0 = *(const uint4*)((pb)); rb1 = *(const uint4*)((pb) + (size_t)32 * ldb); \
  rb2 = *(const uint4*)((pb) + (size_t)64 * ldb); rb3 = *(const uint4*)((pb) + (size_t)96 * ldb);
#define GS_LOAD1(pa, pb) \
  rc0 = *(const uint4*)((pa)); rc1 = *(const uint4*)((pa) + (size_t)32 * lda); \
  rc2 = *(const uint4*)((pa) + (size_t)64 * lda); rc3 = *(const uint4*)((pa) + (size_t)96 * lda); \
  rd0 = *(const uint4*)((pb)); rd1 = *(const uint4*)((pb) + (size_t)32 * ldb); \
  rd2 = *(const uint4*)((pb) + (size_t)64 * ldb); rd3 = *(const uint4*)((pb) + (size_t)96 * ldb);
#define GS_WRITE0(buf) { \
  bf16_t* wa = sA + (buf) * TILE_E + lrow * LDT + lkc; bf16_t* wb = sB + (buf) * TILE_E + lrow * LDT + lkc; \
  *(uint4*)(wa) = ra0; *(uint4*)(wa + 32 * LDT) = ra1; *(uint4*)(wa + 64 * LDT) = ra2; *(uint4*)(wa + 96 * LDT) = ra3; \
  *(uint4*)(wb) = rb0; *(uint4*)(wb + 32 * LDT) = rb1; *(uint4*)(wb + 64 * LDT) = rb2; *(uint4*)(wb + 96 * LDT) = rb3; }
#define GS_WRITE1(buf) { \
  bf16_t* wa = sA + (buf) * TILE_E + lrow * LDT + lkc; bf16_t* wb = sB + (buf) * TILE_E + lrow * LDT + lkc; \
  *(uint4*)(wa) = rc0; *(uint4*)(wa + 32 * LDT) = rc1; *(uint4*)(wa + 64 * LDT) = rc2; *(uint4*)(wa + 96 * LDT) = rc3; \
  *(uint4*)(wb) = rd0; *(uint4*)(wb + 32 * LDT) = rd1; *(uint4*)(wb + 64 * LDT) = rd2; *(uint4*)(wb + 96 * LDT) = rd3; }
#define GS_COMPUTE(buf) { \
    const bf16_t* cA = sA + (buf) * TILE_E + (wm * 64 + lr) * LDT + lg * 8; \
    const bf16_t* cB = sB + (buf) * TILE_E + (wn * 64 + lr) * LDT + lg * 8; \
    _Pragma("unroll") for (int ks = 0; ks < 2; ++ks) { \
      bf16x8 af[4], bfr[4]; \
      _Pragma("unroll") for (int i = 0; i < 4; ++i) { \
        af[i] = *(const bf16x8*)(cA + i * 16 * LDT + ks * 32); \
        bfr[i] = *(const bf16x8*)(cB + i * 16 * LDT + ks * 32); \
      } \
      __builtin_amdgcn_s_setprio(1); \
      _Pragma("unroll") for (int i = 0; i < 4; ++i) \
        _Pragma("unroll") for (int j = 0; j < 4; ++j) acc[i][j] = mfma16(af[i], bfr[j], acc[i][j]); \
      __builtin_amdgcn_s_setprio(0); \
    } }
  GS_LOAD0(gA, gB)
  GS_WRITE0(0)
  GS_LOAD1(gA + 64, gB + 64)
  __syncthreads();
  const int nk = K >> 6;
  for (;;) {
    f32x4 acc[4][4];
#pragma unroll
    for (int i = 0; i < 4; ++i)
#pragma unroll
      for (int j = 0; j < 4; ++j) acc[i][j] = (f32x4){0.f, 0.f, 0.f, 0.f};
    const int tn = t + gridDim.x;
    const bool have_next = tn < T;
    const bf16_t *nA = gA, *nB = gB;
    int nm0 = 0, nn0 = 0, nctx = 0;
    if (have_next) {
      const TileInfo tj = tf(tn);
      nA = tj.a + (size_t)lrow * lda + lkc;
      nB = tj.b + (size_t)lrow * ldb + lkc;
      nm0 = tj.m0; nn0 = tj.n0; nctx = tj.ctx;
    }
    for (int kt = 0; kt < nk; kt += 2) {
      {
        const bool wrap = (kt + 2 >= nk);
        const bf16_t* pa = wrap ? nA : gA + ((kt + 2) << 6);
        const bf16_t* pb = wrap ? nB : gB + ((kt + 2) << 6);
        GS_LOAD0(pa, pb)
        GS_COMPUTE(0)
        GS_WRITE1(1)
        __syncthreads();
      }
      {
        const bool wrap = (kt + 3 >= nk);
        const bf16_t* pa = wrap ? nA + 64 : gA + ((kt + 3) << 6);
        const bf16_t* pb = wrap ? nB + 64 : gB + ((kt + 3) << 6);
        GS_LOAD1(pa, pb)
        GS_COMPUTE(1)
        GS_WRITE0(0)
        __syncthreads();
      }
    }
#pragma unroll
    for (int i = 0; i < 4; ++i)
#pragma unroll
      for (int j = 0; j < 4; j += 2)
        epi(ctx, m0 + wm * 64 + i * 16 + lg * 4, n0 + wn * 64 + j * 16 + lr, acc[i][j], acc[i][j + 1]);
    if (!have_next) break;
    t = tn; gA = nA; gB = nB; m0 = nm0; n0 = nn0; ctx = nctx;
  }
}

DEVI void tile_mn(int t, int nM, int nN, int& m, int& n) {
  int id = swz_tile(t, nM * nN);
  int per = 8 * nN;
  int gq = id / per, rem = id - gq * per;
  int gsz = min(8, nM - gq * 8);
  m = gq * 8 + rem % gsz;
  n = rem / gsz;
}

NOINL void gemv_tile(const P& p, int t) {
  char* smem = g_smem;
  const int tid = opaque_tid();
  float* sv = (float*)smem;
  float* red = sv + 3072;
  const int l = t / 192, n0 = (t % 192) * 32;
  for (int i = tid; i < 3072; i += 256) {
    int v = i >> 10, k = i & 1023;
    float cv = (v == 0) ? p.c_ctx[k] : p.c[(v - 1) * 1024 + k];
    sv[i] = cv / (1.f + expf(-cv));
  }
  __syncthreads();
  const int cgp = tid & 7, ks = tid >> 3;
  const float* w = p.w_mod + (size_t)l * 1024 * 6144 + n0 + cgp * 4;
  float a0[4] = {0, 0, 0, 0}, a1[4] = {0, 0, 0, 0}, a2[4] = {0, 0, 0, 0};
#pragma unroll 16
  for (int kk = 0; kk < 32; ++kk) {
    const int k = ks * 32 + kk;
    const float4 wv = *(const float4*)(w + (size_t)k * 6144);
    const float s0 = sv[k], s1 = sv[1024 + k], s2 = sv[2048 + k];
    a0[0] += s0 * wv.x; a0[1] += s0 * wv.y; a0[2] += s0 * wv.z; a0[3] += s0 * wv.w;
    a1[0] += s1 * wv.x; a1[1] += s1 * wv.y; a1[2] += s1 * wv.z; a1[3] += s1 * wv.w;
    a2[0] += s2 * wv.x; a2[1] += s2 * wv.y; a2[2] += s2 * wv.z; a2[3] += s2 * wv.w;
  }
#pragma unroll
  for (int j = 0; j < 4; ++j) {
    red[(ks * 3 + 0) * 32 + cgp * 4 + j] = a0[j];
    red[(ks * 3 + 1) * 32 + cgp * 4 + j] = a1[j];
    red[(ks * 3 + 2) * 32 + cgp * 4 + j] = a2[j];
  }
  __syncthreads();
  if (tid < 96) {
    const int v = tid >> 5, col = tid & 31;
    float s = 0.f;
    for (int q = 0; q < 32; ++q) s += red[(q * 3 + v) * 32 + col];
    s += p.b_mod[l * 6144 + n0 + col];
    WSF(OFF_MOD)[(l * 3 + v) * 6144 + n0 + col] = s;
  }
  __syncthreads();
}

NOINL void transpose_tile(const P& p, int t) {
  char* smem = g_smem;
  const int tid = opaque_tid();
  const float* src; bf16_t* dst; int K, N, ntn, mode = 0;
  if (t < 544) { src = p.w_in; dst = WSB(OFF_WIN); K = 1024; N = 2096; ntn = 34; }
  else if ((t -= 544) < 48) { src = p.w_uq; dst = WSB(OFF_WUQ); K = 256; N = 768; ntn = 12; }
  else if ((t -= 48) < 64) { src = p.w_ukv; dst = WSB(OFF_WUKV); K = 256; N = 1024; ntn = 16; }
  else if ((t -= 64) < 256) { src = p.w_out; dst = WSB(OFF_WOUT); K = 1024; N = 1024; ntn = 16; }
  else if ((t -= 256) < 64) { int g = t >> 4; t &= 15; src = p.pool_w + (size_t)g * 65536; dst = WSB(OFF_WPOOL) + (size_t)g * 65536; K = 256; N = 256; ntn = 4; }
  else if ((t -= 64) < 1408) { int l = t / 704; t -= l * 704; src = p.w_gate + (size_t)l * 1024 * 2816; dst = WSB(OFF_WGU) + (size_t)l * 5632 * 1024; K = 1024; N = 2816; ntn = 44; mode = 1; }
  else if ((t -= 1408) < 1408) { int l = t / 704; t -= l * 704; src = p.w_up + (size_t)l * 1024 * 2816; dst = WSB(OFF_WGU) + (size_t)l * 5632 * 1024; K = 1024; N = 2816; ntn = 44; mode = 2; }
  else { t -= 1408; int l = t / 704; t -= l * 704; src = p.w_down + (size_t)l * 2816 * 1024; dst = WSB(OFF_WDN) + (size_t)l * 1024 * 2816; K = 2816; N = 1024; ntn = 16; }
  const int kt = t / ntn, nt_ = t - kt * ntn;
  const int k0 = kt * 64, n0 = nt_ * 64;
  float* tile = (float*)smem;
  {
    const int nn = tid & 63, kk0 = tid >> 6;
    const int n = n0 + nn;
    const int nc = n < N ? n : N - 1;
    float v[16];
#pragma unroll
    for (int i = 0; i < 16; ++i) v[i] = src[(size_t)(k0 + kk0 + 4 * i) * N + nc];
#pragma unroll
    for (int i = 0; i < 16; ++i) tile[(kk0 + 4 * i) * 65 + nn] = (n < N) ? v[i] : 0.f;
  }
  __syncthreads();
#pragma unroll
  for (int i = 0; i < 2; ++i) {
    const int id = tid + 256 * i;
    const int nn = id >> 3, kc = id & 7;
    const int n = n0 + nn;
    uint4 pk;
    pk.x = pack2(tile[(kc * 8 + 0) * 65 + nn], tile[(kc * 8 + 1) * 65 + nn]);
    pk.y = pack2(tile[(kc * 8 + 2) * 65 + nn], tile[(kc * 8 + 3) * 65 + nn]);
    pk.z = pack2(tile[(kc * 8 + 4) * 65 + nn], tile[(kc * 8 + 5) * 65 + nn]);
    pk.w = pack2(tile[(kc * 8 + 6) * 65 + nn], tile[(kc * 8 + 7) * 65 + nn]);
    int drow = n;
    if (mode == 1) drow = (n >> 4) * 32 + (n & 15);
    else if (mode == 2) drow = (n >> 4) * 32 + 16 + (n & 15);
    *(uint4*)(dst + (size_t)drow * K + k0 + kc * 8) = pk;
  }
  __syncthreads();
}

template <bool UPD, bool MOD, bool FIRST>
DEVI void rowop(const P& p, const float* msrc, const float* wpost, int gate_idx, const float* wpre, int shift_idx,
                int scale_idx, int layer_g, int layer_m) {
  const int lane = threadIdx.x & 63, wave = threadIdx.x >> 6;
  const float* modg = WSF(OFF_MOD) + (size_t)layer_g * 3 * 6144;
  const float* modm = WSF(OFF_MOD) + (size_t)layer_m * 3 * 6144;
  bf16_t* hbuf = WSB(OFF_H);
  for (int r = blockIdx.x * 4 + wave; r < 8192; r += gridDim.x * 4) {
    const int v = r < 4096 ? 0 : 1 + ((r - 4096) >> 11);
    const float* mvg = modg + v * 6144;
    const float* mvm = modm + v * 6144;
    const float* xin = FIRST ? (r < 4096 ? p.x_prompt + (size_t)r * 1024 : p.x_sample + (size_t)(r - 4096) * 1024)
                             : p.out + (size_t)r * 1024;
    float4 x[4];
#pragma unroll
    for (int i = 0; i < 4; ++i) x[i] = *(const float4*)(xin + lane * 4 + 256 * i);
    if (UPD) {
      float4 m[4];
      float ss = 0.f;
#pragma unroll
      for (int i = 0; i < 4; ++i) {
        m[i] = *(const float4*)(msrc + (size_t)r * 1024 + lane * 4 + 256 * i);
        ss += m[i].x * m[i].x + m[i].y * m[i].y + m[i].z * m[i].z + m[i].w * m[i].w;
      }
      ss = wave_sum(ss);
      const float rs = rsqrtf(ss * (1.f / 1024.f) + 1e-6f);
#pragma unroll
      for (int i = 0; i < 4; ++i) {
        const int col = lane * 4 + 256 * i;
        const float4 wp = *(const float4*)(wpost + col);
        const float4 g = *(const float4*)(mvg + gate_idx * 1024 + col);
        x[i].x += g.x * (m[i].x * rs * wp.x);
        x[i].y += g.y * (m[i].y * rs * wp.y);
        x[i].z += g.z * (m[i].z * rs * wp.z);
        x[i].w += g.w * (m[i].w * rs * wp.w);
        *(float4*)(p.out + (size_t)r * 1024 + col) = x[i];
      }
    }
    if (MOD) {
      float ss = 0.f;
#pragma unroll
      for (int i = 0; i < 4; ++i) ss += x[i].x * x[i].x + x[i].y * x[i].y + x[i].z * x[i].z + x[i].w * x[i].w;
      ss = wave_sum(ss);
      const float rs = rsqrtf(ss * (1.f / 1024.f) + 1e-6f);
#pragma unroll
      for (int i = 0; i < 4; ++i) {
        const int col = lane * 4 + 256 * i;
        const float4 wp = *(const float4*)(wpre + col);
        const float4 sh = *(const float4*)(mvm + shift_idx * 1024 + col);
        const float4 sc = *(const float4*)(mvm + scale_idx * 1024 + col);
        uint2 o;
        o.x = pack2(x[i].x * rs * wp.x * (1.f + sc.x) + sh.x, x[i].y * rs * wp.y * (1.f + sc.y) + sh.y);
        o.y = pack2(x[i].z * rs * wp.z * (1.f + sc.z) + sh.z, x[i].w * rs * wp.w * (1.f + sc.w) + sh.w);
        *(uint2*)(hbuf + (size_t)r * 1024 + col) = o;
      }
    }
  }
}

NOINL void prep_rows(const P& p) {
  const int lane = threadIdx.x & 63, wave = threadIdx.x >> 6;
  const float* proj = WSF(OFF_R1);
  for (int r = blockIdx.x * 4 + wave; r < 8192; r += gridDim.x * 4) {
    const float* pr = proj + (size_t)r * 2096;
    const int kvrow = r < 4096 ? r : 4096 + ((r - 4096) >> 11) * 2304 + 256 + ((r - 4096) & 2047);
    const float4 ld_cq = *(const float4*)(pr + lane * 4);
    const float4 ld_ckv = *(const float4*)(pr + 256 + lane * 4);
    const float ld_kpe = pr[512 + (lane & 31)];
    const float ld_dt = pr[2080 + (lane & 15)];
    {
      const float4 a = ld_cq;
      float ss = wave_sum(a.x * a.x + a.y * a.y + a.z * a.z + a.w * a.w);
      const float rs = rsqrtf(ss * (1.f / 256.f) + 1e-6f);
      const float4 g = *(const float4*)(p.q_norm + lane * 4);
      uint2 o;
      o.x = pack2(a.x * rs * g.x, a.y * rs * g.y);
      o.y = pack2(a.z * rs * g.z, a.w * rs * g.w);
      *(uint2*)(WSB(OFF_CQN) + (size_t)r * 256 + lane * 4) = o;
    }
    {
      const float4 a = ld_ckv;
      float ss = wave_sum(a.x * a.x + a.y * a.y + a.z * a.z + a.w * a.w);
      const float rs = rsqrtf(ss * (1.f / 256.f) + 1e-6f);
      const float4 g = *(const float4*)(p.kv_norm + lane * 4);
      float4 vv;
      vv.x = a.x * rs * g.x; vv.y = a.y * rs * g.y; vv.z = a.z * rs * g.z; vv.w = a.w * rs * g.w;
      if (r < 4096) *(float4*)(p.out + OUT_CKV + (size_t)r * 256 + lane * 4) = vv;
      uint2 o;
      o.x = pack2(vv.x, vv.y);
      o.y = pack2(vv.z, vv.w);
      *(uint2*)(WSB(OFF_CKV) + (size_t)kvrow * 256 + lane * 4) = o;
    }
    {
      const float kv = (lane < 32) ? ld_kpe : 0.f;
      const float partner = __shfl_xor(kv, 16, 64);
      if (r < 4096) {
        if (lane < 32) {
          p.out[OUT_KR + (size_t)r * 32 + lane] = kv;
          WSB(OFF_KPE)[(size_t)kvrow * 32 + lane] = f2bf(kv);
        }
      } else {
        const int t = (r - 4096) & 2047;
        const int ii = lane & 15;
        const float pos = (ii < 8) ? (float)(t >> 6) : (float)(t & 63);
        const float fr = rope_freq(ii & 7);
        const float ang = pos * fr;
        float cs, sn;
        fast_sincos(ang, sn, cs);
        const float o = (lane < 16) ? (kv * cs - partner * sn) : (partner * sn + kv * cs);
        if (lane < 32) WSB(OFF_KPE)[(size_t)kvrow * 32 + lane] = f2bf(o);
      }
    }
    if (lane < 16) {
      const int dir = lane >> 3, hh = lane & 7;
      const float raw = ld_dt + (dir ? p.dtb_b[hh] : p.dtb_f[hh]);
      const float sp = raw > 20.f ? raw : log1pf(expf(raw));
      WSF(OFF_DTV)[((size_t)dir * 8192 + r) * 8 + hh] = sp;
    }
  }
}

NOINL void prep_cache(const P& p) {
  const int gt = blockIdx.x * 256 + threadIdx.x, gs = gridDim.x * 256;
  for (int i = gt; i < 2 * 256 * 256; i += gs) {
    int b = i >> 16, rem = i & 65535;
    WSB(OFF_CKV)[(size_t)(4096 + b * 2304) * 256 + rem] = f2bf(p.cache_ckv[i]);
  }
  for (int i = gt; i < 2 * 256 * 32; i += gs) {
    int b = i >> 13, rem = i & 8191;
    WSB(OFF_KPE)[(size_t)(4096 + b * 2304) * 32 + rem] = f2bf(p.cache_kr[i]);
  }
}

NOINL void conv_tile(const P& p, int t) {
  char* smem = g_smem;
  const int tid = opaque_tid();
  float* sin_ = (float*)smem;
  float* sout = sin_ + 68 * 64;
  const int tt_ = t >> 4, ct = t & 15;
  const int r0 = tt_ * 64, c0 = ct * 64;
  int s0, s1;
  if (r0 < 4096) { s0 = r0 & ~255; s1 = s0 + 256; } else { s0 = 4096 + ((r0 - 4096) & ~2047); s1 = s0 + 2048; }
  const float* proj = WSF(OFF_R1);
  {
    const int rr0 = tid >> 6, cc = tid & 63;
    float v[17];
#pragma unroll
    for (int k = 0; k < 17; ++k) {
      const int r = r0 - 2 + rr0 + 4 * k;
      const int rc = r < s0 ? s0 : (r >= s1 ? s1 - 1 : r);
      v[k] = proj[(size_t)rc * 2096 + 1056 + c0 + cc];
    }
#pragma unroll
    for (int k = 0; k < 17; ++k) {
      const int r = r0 - 2 + rr0 + 4 * k;
      sin_[(rr0 + 4 * k) * 64 + cc] = (r >= s0 && r < s1) ? v[k] : 0.f;
    }
  }
  __syncthreads();
  {
    const int cc = tid & 63, tq = tid >> 6;
    const int c = c0 + cc;
    const float w0 = p.conv_w[c], w1 = p.conv_w[1024 + c], w2 = p.conv_w[2048 + c], w3 = p.conv_w[3072 + c],
                w4 = p.conv_w[4096 + c], bias = p.conv_b[c];
#pragma unroll 4
    for (int i = 0; i < 16; ++i) {
      const int tt = tq * 16 + i;
      float y = bias + w0 * sin_[tt * 64 + cc] + w1 * sin_[(tt + 1) * 64 + cc] + w2 * sin_[(tt + 2) * 64 + cc] +
                w3 * sin_[(tt + 3) * 64 + cc] + w4 * sin_[(tt + 4) * 64 + cc];
      y = y / (1.f + __expf(-y));
      sout[tt * 65 + cc] = y;
      const bf16_t b = f2bf(y);
      const size_t r = r0 + tt;
      if (c < 512) WSB(OFF_XS)[r * 512 + c] = b;
      else if (c < 768) WSB(OFF_BM)[r * 256 + (c - 512)] = b;
      else WSB(OFF_CM)[r * 256 + (c - 768)] = b;
    }
  }
  __syncthreads();
  if (c0 < 768) {
    const int cl = tid >> 2, q4 = tid & 3;
    uint4 o0, o1;
    const float* sp = sout + (q4 * 16) * 65 + cl;
    o0.x = pack2(sp[0 * 65], sp[1 * 65]);   o0.y = pack2(sp[2 * 65], sp[3 * 65]);
    o0.z = pack2(sp[4 * 65], sp[5 * 65]);   o0.w = pack2(sp[6 * 65], sp[7 * 65]);
    o1.x = pack2(sp[8 * 65], sp[9 * 65]);   o1.y = pack2(sp[10 * 65], sp[11 * 65]);
    o1.z = pack2(sp[12 * 65], sp[13 * 65]); o1.w = pack2(sp[14 * 65], sp[15 * 65]);
    bf16_t* dst = (c0 < 512) ? WSB(OFF_XST) + (size_t)(c0 + cl) * 8192 : WSB(OFF_BT) + (size_t)(c0 - 512 + cl) * 8192;
    dst += r0 + q4 * 16;
    *(uint4*)(dst) = o0;
    *(uint4*)(dst + 8) = o1;
  }
  __syncthreads();
}

NOINL void chunk_state_item(const P& p, int item) {
  char* smem = g_smem;
  const int tid = opaque_tid(), lane = tid & 63, wave = tid >> 6, lr = lane & 15, lg = lane >> 4;
  const int cidx = item >> 3, hh = item & 7, g = hh >> 2;
  const int r0 = cidx * 128;
  constexpr int LDS_ = 136;
  bf16_t* sAs = (bf16_t*)smem;
  bf16_t* sBs = sAs + 2 * 64 * LDS_;
  float* fa = (float*)(sBs + 128 * LDS_);
  float* fcum = fa + 256;
  float* fw = fa + 512;
  float* fdt = fa + 768;
  {
    const int dir = tid >> 7, j = tid & 127;
    const float dt = WSF(OFF_DTV)[((size_t)dir * 8192 + r0 + j) * 8 + hh];
    const float Aco = -expf(dir ? p.alog_b[hh] : p.alog_f[hh]);
    fa[tid] = dt * Aco;
    fdt[tid] = dt;
  }
  __syncthreads();
  {
    const int dir = tid >> 7, j = tid & 127;
    float s = 0.f;
    if (dir == 0) { for (int k = 0; k <= j; ++k) s += fa[k]; }
    else { for (int k = 127; k >= j; --k) s += fa[128 + k]; }
    fcum[tid] = s;
    WSF(OFF_CUM)[((size_t)dir * 8192 + r0 + j) * 8 + hh] = s;
  }
  __syncthreads();
  {
    const int dir = tid >> 7;
    const float ce = dir ? fcum[128] : fcum[127];
    fw[tid] = __expf(ce - fcum[tid]) * fdt[tid];
    if ((tid & 127) == 0) WSF(OFF_TOT)[(dir * 64 + cidx) * 8 + hh] = __expf(ce);
  }
  __syncthreads();
#pragma unroll
  for (int i = 0; i < 4; ++i) {
    const int id = tid + 256 * i;
    const int pp = id >> 4, jc = (id & 15) * 8;
    const uint4 raw = *(const uint4*)(WSB(OFF_XST) + (size_t)(hh * 64 + pp) * 8192 + r0 + jc);
    const unsigned rw[4] = {raw.x, raw.y, raw.z, raw.w};
    unsigned of[4], ob[4];
#pragma unroll
    for (int q = 0; q < 4; ++q) {
      const float x0 = __uint_as_float(rw[q] << 16), x1 = __uint_as_float(rw[q] & 0xffff0000u);
      of[q] = pack2(x0 * fw[jc + 2 * q], x1 * fw[jc + 2 * q + 1]);
      ob[q] = pack2(x0 * fw[128 + jc + 2 * q], x1 * fw[128 + jc + 2 * q + 1]);
    }
    *(uint4*)(sAs + pp * LDS_ + jc) = make_uint4(of[0], of[1], of[2], of[3]);
    *(uint4*)(sAs + 64 * LDS_ + pp * LDS_ + jc) = make_uint4(ob[0], ob[1], ob[2], ob[3]);
  }
#pragma unroll
  for (int i = 0; i < 8; ++i) {
    const int id = tid + 256 * i;
    const int nn = id >> 4, jc = (id & 15) * 8;
    *(uint4*)(sBs + nn * LDS_ + jc) = *(const uint4*)(WSB(OFF_BT) + (size_t)(g * 128 + nn) * 8192 + r0 + jc);
  }
  __syncthreads();
  {
    const int dir = wave >> 1, nh = wave & 1;
    f32x4 acc[4][4];
#pragma unroll
    for (int i = 0; i < 4; ++i)
#pragma unroll
      for (int j = 0; j < 4; ++j) acc[i][j] = (f32x4){0.f, 0.f, 0.f, 0.f};
    const bf16_t* cA = sAs + dir * 64 * LDS_ + lr * LDS_ + lg * 8;
    const bf16_t* cB = sBs + (nh * 64 + lr) * LDS_ + lg * 8;
#pragma unroll 1
    for (int ks = 0; ks < 4; ++ks) {
      bf16x8 af[4], bfr[4];
#pragma unroll
      for (int i = 0; i < 4; ++i) {
        af[i] = *(const bf16x8*)(cA + i * 16 * LDS_ + ks * 32);
        bfr[i] = *(const bf16x8*)(cB + i * 16 * LDS_ + ks * 32);
      }
#pragma unroll
      for (int i = 0; i < 4; ++i)
#pragma unroll
        for (int j = 0; j < 4; ++j) acc[i][j] = mfma16(af[i], bfr[j], acc[i][j]);
    }
    float* S = WSF(OFF_R2) + ((size_t)(dir * 64 + cidx) * 8 + hh) * 8192 + (lg * 4) * 128 + nh * 64 + lr;
#pragma unroll
    for (int i = 0; i < 4; ++i) {
#pragma unroll
      for (int q = 0; q < 4; ++q) {
#pragma unroll
        for (int j = 0; j < 4; ++j) S[j * 16] = acc[i][j][q];
        S += 128;
      }
      S += 12 * 128;
      __builtin_amdgcn_sched_barrier(0);
    }
  }
  __syncthreads();
}

template <int NB>
DEVI void scan_group(const P& p, float4& h, int dir, int cb, int nc, int c0, int hh, size_t eoff) {
  float4 sv[NB];
  float d[NB];
  size_t base[NB];
#pragma unroll
  for (int k = 0; k < NB; ++k) {
    const int c = c0 + k;
    const int cidx = cb + (dir ? nc - 1 - c : c);
    base[k] = ((size_t)(dir * 64 + cidx) * 8 + hh) * 8192 + eoff;
    d[k] = WSF(OFF_TOT)[(dir * 64 + cidx) * 8 + hh];
    sv[k] = *(const float4*)(WSF(OFF_R2) + base[k]);
  }
#pragma unroll
  for (int k = 0; k < NB; ++k) {
    uint2 o;
    o.x = pack2(h.x, h.y);
    o.y = pack2(h.z, h.w);
    *(uint2*)(WSB(OFF_H) + base[k]) = o;
    h.x = d[k] * h.x + sv[k].x; h.y = d[k] * h.y + sv[k].y; h.z = d[k] * h.z + sv[k].z; h.w = d[k] * h.w + sv[k].w;
  }
}

NOINL void scan_states(const P& p) {
  const int total = 2 * 18 * 8 * 64 * 32;
  for (int idx = blockIdx.x * 256 + threadIdx.x; idx < total; idx += gridDim.x * 256) {
    const int n4 = idx & 31, pp = (idx >> 5) & 63, hh = (idx >> 11) & 7;
    const int sd = idx >> 14;
    const int s = sd % 18, dir = sd / 18;
    const int nc = s < 16 ? 2 : 16;
    const int cb = s < 16 ? s * 2 : 32 + (s - 16) * 16;
    float4 h = make_float4(0.f, 0.f, 0.f, 0.f);
    const size_t eoff = (size_t)pp * 128 + n4 * 4;
    if (s >= 16) {
      const float* st = (dir ? p.st_b : p.st_f) + ((size_t)((s - 16) * 8 + hh) * 64 + pp) * 128 + n4 * 4;
      h = *(const float4*)st;
      scan_group<8>(p, h, dir, cb, nc, 0, hh, eoff);
      scan_group<8>(p, h, dir, cb, nc, 8, hh, eoff);
    } else {
      scan_group<2>(p, h, dir, cb, nc, 0, hh, eoff);
      float* o = p.out + (dir ? OUT_SB : OUT_SF) + ((size_t)(s * 8 + hh) * 64 + pp) * 128 + n4 * 4;
      *(float4*)o = h;
    }
  }
}

NOINL void attn_item(const P& p, int id) {
  char* smem = g_smem;
  const int tid = opaque_tid(), lane = tid & 63, wave = tid >> 6, lr = lane & 15, lg = lane >> 4;
  int row0, kvbase, Lk, hh;
  if (id < 512) { hh = id & 7; const int b = (id >> 3) & 1; const int qb = id >> 4; row0 = 4096 + b * 2048 + qb * 64; kvbase = 4096 + b * 2304; Lk = 2304; }
  else { const int i2 = id - 512; hh = i2 & 7; const int rest = i2 >> 3; const int b = rest >> 2; const int qb = rest & 3; row0 = b * 256 + qb * 64; kvbase = b * 256; Lk = 256; }
  constexpr int LDK = 104, LDV = 72;
  constexpr int KVBUF = 64 * LDK + 64 * LDV;
  bf16_t* sKV = (bf16_t*)smem;
  const int qrow = row0 + wave * 16 + lr;
  bf16x8 qf[3];
#pragma unroll
  for (int ks = 0; ks < 3; ++ks) qf[ks] = *(const bf16x8*)(WSB(OFF_Q) + (size_t)qrow * 768 + hh * 96 + ks * 32 + lg * 8);
  f32x4 oacc[4];
#pragma unroll
  for (int i = 0; i < 4; ++i) oacc[i] = (f32x4){0.f, 0.f, 0.f, 0.f};
  float mrun = -1e30f, lrun = 0.f;
  const int nkt = Lk >> 6;
  const int kkey0 = tid / 12, kcc0 = tid - kkey0 * 12;
  const int c1 = tid + 256, kkey1 = c1 / 12, kcc1 = c1 - kkey1 * 12;
  const int c2 = tid + 512, kkey2 = c2 / 12, kcc2 = c2 - kkey2 * 12;
  const bf16_t* kn = WSB(OFF_KN);
  const bf16_t* kp = WSB(OFF_KPE);
  const bf16_t* ksrc0 = (kcc0 < 8) ? kn + (size_t)(kvbase + kkey0) * 512 + hh * 64 + kcc0 * 8 : kp + (size_t)(kvbase + kkey0) * 32 + (kcc0 - 8) * 8;
  const bf16_t* ksrc1 = (kcc1 < 8) ? kn + (size_t)(kvbase + kkey1) * 512 + hh * 64 + kcc1 * 8 : kp + (size_t)(kvbase + kkey1) * 32 + (kcc1 - 8) * 8;
  const bf16_t* ksrc2 = (kcc2 < 8) ? kn + (size_t)(kvbase + kkey2) * 512 + hh * 64 + kcc2 * 8 : kp + (size_t)(kvbase + kkey2) * 32 + (kcc2 - 8) * 8;
  const int kst0 = (kcc0 < 8) ? 512 * 64 : 32 * 64, kst1 = (kcc1 < 8) ? 512 * 64 : 32 * 64, kst2 = (kcc2 < 8) ? 512 * 64 : 32 * 64;
  const int vd0 = tid >> 3, vcc = tid & 7;
  const bf16_t* vsrc0 = WSB(OFF_VT) + (size_t)(hh * 64 + vd0) * 8704 + kvbase + vcc * 8;
  const bf16_t* vsrc1 = vsrc0 + (size_t)32 * 8704;
  uint4 rk0, rk1, rk2, rv0, rv1;
#define AT_LOAD(kt) { const int _k = (kt); \
    rk0 = *(const uint4*)(ksrc0 + (size_t)_k * kst0); rk1 = *(const uint4*)(ksrc1 + (size_t)_k * kst1); \
    rk2 = *(const uint4*)(ksrc2 + (size_t)_k * kst2); \
    rv0 = *(const uint4*)(vsrc0 + _k * 64); rv1 = *(const uint4*)(vsrc1 + _k * 64); }
#define AT_WRITE(buf) { bf16_t* _b = sKV + (buf) * KVBUF; \
    *(uint4*)(_b + kkey0 * LDK + kcc0 * 8) = rk0; *(uint4*)(_b + kkey1 * LDK + kcc1 * 8) = rk1; \
    *(uint4*)(_b + kkey2 * LDK + kcc2 * 8) = rk2; \
    *(uint4*)(_b + 64 * LDK + vd0 * LDV + vcc * 8) = rv0; *(uint4*)(_b + 64 * LDK + (vd0 + 32) * LDV + vcc * 8) = rv1; }
  AT_LOAD(0)
  AT_WRITE(0)
  __syncthreads();
  for (int kt = 0; kt < nkt; ++kt) {
    const int ktn = min(kt + 1, nkt - 1);
    AT_LOAD(ktn)
    const bf16_t* sK = sKV + (kt & 1) * KVBUF;
    const bf16_t* sV = sK + 64 * LDK;
    f32x4 sacc[4];
#pragma unroll
    for (int n = 0; n < 4; ++n) sacc[n] = (f32x4){0.f, 0.f, 0.f, 0.f};
#pragma unroll
    for (int ks = 0; ks < 3; ++ks)
#pragma unroll
      for (int n = 0; n < 4; ++n) {
        const bf16x8 a = *(const bf16x8*)(sK + (n * 16 + lr) * LDK + ks * 32 + lg * 8);
        sacc[n] = mfma16(a, qf[ks], sacc[n]);
      }
    float mx = sacc[0][0];
#pragma unroll
    for (int n = 0; n < 4; ++n)
#pragma unroll
      for (int q = 0; q < 4; ++q) mx = fmaxf(mx, sacc[n][q]);
    mx = fmaxf(mx, __shfl_xor(mx, 16, 64));
    mx = fmaxf(mx, __shfl_xor(mx, 32, 64));
    const float mnew = fmaxf(mrun, mx);
    const float alpha = __builtin_amdgcn_exp2f(mrun - mnew);
    mrun = mnew;
    float ps = 0.f;
#pragma unroll
    for (int n = 0; n < 4; ++n)
#pragma unroll
      for (int q = 0; q < 4; ++q) { const float e = __builtin_amdgcn_exp2f(sacc[n][q] - mnew); sacc[n][q] = e; ps += e; }
    lrun = lrun * alpha + ps;
#pragma unroll
    for (int i = 0; i < 4; ++i)
#pragma unroll
      for (int q = 0; q < 4; ++q) oacc[i][q] *= alpha;
#pragma unroll
    for (int ks = 0; ks < 2; ++ks) {
      union { bf16x8 v; unsigned u[4]; } pf;
      pf.u[0] = pack2(sacc[2 * ks][0], sacc[2 * ks][1]);
      pf.u[1] = pack2(sacc[2 * ks][2], sacc[2 * ks][3]);
      pf.u[2] = pack2(sacc[2 * ks + 1][0], sacc[2 * ks + 1][1]);
      pf.u[3] = pack2(sacc[2 * ks + 1][2], sacc[2 * ks + 1][3]);
#pragma unroll
      for (int m = 0; m < 4; ++m) {
        union { bf16x8 v; uint2 h[2]; } av;
        const bf16_t* vp = sV + (m * 16 + lr) * LDV + ks * 32 + lg * 4;
        av.h[0] = *(const uint2*)(vp);
        av.h[1] = *(const uint2*)(vp + 16);
        oacc[m] = mfma16(av.v, pf.v, oacc[m]);
      }
    }
    __builtin_amdgcn_sched_barrier(0);
    AT_WRITE((kt + 1) & 1)
    __syncthreads();
  }
  lrun += __shfl_xor(lrun, 16, 64);
  lrun += __shfl_xor(lrun, 32, 64);
  const float inv = 1.f / lrun;
#pragma unroll
  for (int m = 0; m < 4; ++m) {
    uint2 o;
    o.x = pack2(oacc[m][0] * inv, oacc[m][1] * inv);
    o.y = pack2(oacc[m][2] * inv, oacc[m][3] * inv);
    *(uint2*)(WSB(OFF_CAT) + (size_t)qrow * 1024 + hh * 64 + m * 16 + lg * 4) = o;
  }
}

NOINL void ssd_y_item(const P& p, int item) {
  char* smem = g_smem;
  const int tid = opaque_tid(), lane = tid & 63, wave = tid >> 6, lr = lane & 15, lg = lane >> 4;
  const int cidx = item >> 2, half = (item >> 1) & 1, g = item & 1;
  const int r0 = cidx * 128;
  const int hh = g * 4 + wave;
  constexpr int LDC = 136, LDM = 72;
  bf16_t* sC = (bf16_t*)smem;
  bf16_t* sB = sC + 64 * LDC;
  bf16_t* sM = sB + 64 * LDC + wave * 64 * LDM;
  float* rowss = (float*)((bf16_t*)smem + 2 * 64 * LDC + 4 * 64 * LDM);
  const float* cum = WSF(OFF_CUM);
  const float* dtv = WSF(OFF_DTV);
  const int srow = tid >> 4, scol = (tid & 15) * 8;
  uint4 pb0, pb1, pb2, pb3;
  {
    const bf16_t* cs = WSB(OFF_CM) + (size_t)(r0 + half * 64 + srow) * 256 + g * 128 + scol;
    const bf16_t* bs = WSB(OFF_BM) + (size_t)(r0 + srow) * 256 + g * 128 + scol;
    const uint4 c0 = *(const uint4*)(cs), c1 = *(const uint4*)(cs + 16 * 256), c2 = *(const uint4*)(cs + 32 * 256), c3 = *(const uint4*)(cs + 48 * 256);
    const uint4 b0 = *(const uint4*)(bs), b1 = *(const uint4*)(bs + 16 * 256), b2 = *(const uint4*)(bs + 32 * 256), b3 = *(const uint4*)(bs + 48 * 256);
    pb0 = *(const uint4*)(bs + 64 * 256); pb1 = *(const uint4*)(bs + 80 * 256); pb2 = *(const uint4*)(bs + 96 * 256); pb3 = *(const uint4*)(bs + 112 * 256);
    bf16_t* wc = sC + srow * LDC + scol;
    bf16_t* wb = sB + srow * LDC + scol;
    *(uint4*)(wc) = c0; *(uint4*)(wc + 16 * LDC) = c1; *(uint4*)(wc + 32 * LDC) = c2; *(uint4*)(wc + 48 * LDC) = c3;
    *(uint4*)(wb) = b0; *(uint4*)(wb + 16 * LDC) = b1; *(uint4*)(wb + 32 * LDC) = b2; *(uint4*)(wb + 48 * LDC) = b3;
  }
  __syncthreads();
  f32x4 Y[4][4];
#pragma unroll
  for (int i = 0; i < 4; ++i)
#pragma unroll
    for (int j = 0; j < 4; ++j) Y[i][j] = (f32x4){0.f, 0.f, 0.f, 0.f};
#pragma unroll 1
  for (int jh = 0; jh < 2; ++jh) {
    if (jh == 1) {
      __syncthreads();
      bf16_t* wb = sB + srow * LDC + scol;
      *(uint4*)(wb) = pb0; *(uint4*)(wb + 16 * LDC) = pb1; *(uint4*)(wb + 32 * LDC) = pb2; *(uint4*)(wb + 48 * LDC) = pb3;
      __syncthreads();
    }
#pragma unroll 1
    for (int dir = 0; dir < 2; ++dir) {
      const bool use = dir == 0 ? (jh <= half) : (jh >= half);
      if (!use) continue;
      bf16x8 xf[2][4];
#pragma unroll
      for (int ks = 0; ks < 2; ++ks)
#pragma unroll
        for (int pt = 0; pt < 4; ++pt)
          xf[ks][pt] = *(const bf16x8*)(WSB(OFF_XST) + (size_t)(hh * 64 + pt * 16 + lr) * 8192 + r0 + jh * 64 + ks * 32 + lg * 8);
      float ci[4], cj[4][4], dj[4][4];
#pragma unroll
      for (int it = 0; it < 4; ++it) ci[it] = cum[((size_t)dir * 8192 + r0 + half * 64 + it * 16 + lr) * 8 + hh];
#pragma unroll
      for (int jt = 0; jt < 4; ++jt)
#pragma unroll
        for (int q = 0; q < 4; ++q) {
          const size_t tj = (size_t)dir * 8192 + r0 + jh * 64 + jt * 16 + lg * 4 + q;
          cj[jt][q] = cum[tj * 8 + hh];
          dj[jt][q] = dtv[tj * 8 + hh];
        }
#pragma unroll
      for (int it = 0; it < 4; ++it) {
        f32x4 cb[4];
#pragma unroll
        for (int jt = 0; jt < 4; ++jt) cb[jt] = (f32x4){0.f, 0.f, 0.f, 0.f};
#pragma unroll
        for (int ks = 0; ks < 4; ++ks) {
          const bf16x8 b = *(const bf16x8*)(sC + (it * 16 + lr) * LDC + ks * 32 + lg * 8);
#pragma unroll
          for (int jt = 0; jt < 4; ++jt) {
            const bf16x8 a = *(const bf16x8*)(sB + (jt * 16 + lr) * LDC + ks * 32 + lg * 8);
            cb[jt] = mfma16(a, b, cb[jt]);
          }
        }
        const int ti = half * 64 + it * 16 + lr;
#pragma unroll
        for (int jt = 0; jt < 4; ++jt) {
          float v[4];
#pragma unroll
          for (int q = 0; q < 4; ++q) {
            const int tj = jh * 64 + jt * 16 + lg * 4 + q;
            const bool ok = dir == 0 ? (tj <= ti) : (tj >= ti);
            v[q] = ok ? cb[jt][q] * __expf(ci[it] - cj[jt][q]) * dj[jt][q] : 0.f;
          }
          uint2 o;
          o.x = pack2(v[0], v[1]);
          o.y = pack2(v[2], v[3]);
          *(uint2*)(sM + (it * 16 + lr) * LDM + jt * 16 + lg * 4) = o;
        }
        __builtin_amdgcn_sched_barrier(0);
      }
      asm volatile("s_waitcnt lgkmcnt(0)" ::: "memory");
#pragma unroll
      for (int ks = 0; ks < 2; ++ks) {
        bf16x8 af[4];
#pragma unroll
        for (int it = 0; it < 4; ++it) af[it] = *(const bf16x8*)(sM + (it * 16 + lr) * LDM + ks * 32 + lg * 8);
#pragma unroll
        for (int it = 0; it < 4; ++it)
#pragma unroll
          for (int pt = 0; pt < 4; ++pt) Y[it][pt] = mfma16(af[it], xf[ks][pt], Y[it][pt]);
      }
      asm volatile("s_waitcnt lgkmcnt(0)" ::: "memory");
      __builtin_amdgcn_sched_barrier(0);
    }
  }
#pragma unroll 1
  for (int dir = 0; dir < 2; ++dir) {
    const bf16_t* hp = WSB(OFF_H) + ((size_t)(dir * 64 + cidx) * 8 + hh) * 8192;
    float ei[4][4];
#pragma unroll
    for (int it = 0; it < 4; ++it)
#pragma unroll
      for (int q = 0; q < 4; ++q)
        ei[it][q] = __expf(cum[((size_t)dir * 8192 + r0 + half * 64 + it * 16 + lg * 4 + q) * 8 + hh]);
#pragma unroll
    for (int pt = 0; pt < 4; ++pt) {
      bf16x8 bfr[4];
#pragma unroll
      for (int ks = 0; ks < 4; ++ks) bfr[ks] = *(const bf16x8*)(hp + (size_t)(pt * 16 + lr) * 128 + ks * 32 + lg * 8);
      f32x4 T[4];
#pragma unroll
      for (int it = 0; it < 4; ++it) T[it] = (f32x4){0.f, 0.f, 0.f, 0.f};
#pragma unroll
      for (int ks = 0; ks < 4; ++ks)
#pragma unroll
        for (int it = 0; it < 4; ++it) {
          const bf16x8 a = *(const bf16x8*)(sC + (it * 16 + lr) * LDC + ks * 32 + lg * 8);
          T[it] = mfma16(a, bfr[ks], T[it]);
        }
#pragma unroll
      for (int it = 0; it < 4; ++it)
#pragma unroll
        for (int q = 0; q < 4; ++q) Y[it][pt][q] += ei[it][q] * T[it][q];
    }
    __builtin_amdgcn_sched_barrier(0);
  }
  const float dsk = p.ssd_d[hh];
  const float* proj = WSF(OFF_R1);
#pragma unroll
  for (int i = 0; i < 4; ++i) {
#pragma unroll
    for (int q = 0; q < 4; ++q) {
      const int il = i * 16 + lg * 4 + q;
      const size_t r = (size_t)r0 + half * 64 + il;
      float ss = 0.f;
#pragma unroll
      for (int j = 0; j < 4; ++j) {
        const int ch = hh * 64 + j * 16 + lr;
        const float xs = bf2f(WSB(OFF_XS)[r * 512 + ch]);
        const float z = proj[r * 2096 + 544 + ch];
        const float y = (Y[i][j][q] + dsk * xs) * silu(z);
        Y[i][j][q] = y;
        ss += y * y;
      }
      ss += __shfl_xor(ss, 1, 64);
      ss += __shfl_xor(ss, 2, 64);
      ss += __shfl_xor(ss, 4, 64);
      ss += __shfl_xor(ss, 8, 64);
      if (lr == 0) rowss[wave * 64 + il] = ss;
    }
    __builtin_amdgcn_sched_barrier(0);
  }
  __syncthreads();
#pragma unroll
  for (int i = 0; i < 4; ++i) {
#pragma unroll
    for (int q = 0; q < 4; ++q) {
      const int il = i * 16 + lg * 4 + q;
      const size_t r = (size_t)r0 + half * 64 + il;
      const float tot = rowss[il] + rowss[64 + il] + rowss[128 + il] + rowss[192 + il];
      const float rs = rsqrtf(tot * (1.f / 256.f) + 1e-6f);
#pragma unroll
      for (int j = 0; j < 4; ++j) {
        const int ch = hh * 64 + j * 16 + lr;
        WSB(OFF_CAT)[r * 1024 + 512 + ch] = f2bf(Y[i][j][q] * rs * p.ssd_norm[ch]);
      }
    }
    __builtin_amdgcn_sched_barrier(0);
  }
  __syncthreads();
}

template <int W2>
DEVI void pool_item(const bf16_t* __restrict__ h, bf16_t* __restrict__ dst, int r, int cc) {
  int s0, L;
  if (r < 4096) { s0 = r & ~255; L = 256; } else { s0 = 4096 + ((r - 4096) & ~2047); L = 2048; }
  const int t = r - s0;
  const int lo = max(t - W2, 0), hi = min(t + W2, L);
  uint4 v[2 * W2];
#pragma unroll
  for (int k = 0; k < 2 * W2; ++k) {
    const int u = min(max(t - W2 + k, 0), L - 1);
    v[k] = *(const uint4*)(h + (size_t)(s0 + u) * 1024 + cc);
  }
  float acc[8] = {0, 0, 0, 0, 0, 0, 0, 0};
#pragma unroll
  for (int k = 0; k < 2 * W2; ++k) {
    const int u = t - W2 + k;
    const float m = (u >= 0 && u < L) ? 1.f : 0.f;
    acc[0] += m * __uint_as_float(v[k].x << 16); acc[1] += m * __uint_as_float(v[k].x & 0xffff0000u);
    acc[2] += m * __uint_as_float(v[k].y << 16); acc[3] += m * __uint_as_float(v[k].y & 0xffff0000u);
    acc[4] += m * __uint_as_float(v[k].z << 16); acc[5] += m * __uint_as_float(v[k].z & 0xffff0000u);
    acc[6] += m * __uint_as_float(v[k].w << 16); acc[7] += m * __uint_as_float(v[k].w & 0xffff0000u);
  }
  const float inv = 1.f / (float)(hi - lo);
  const uint4 c = v[W2];
  uint4 o;
  o.x = pack2(acc[0] * inv - __uint_as_float(c.x << 16), acc[1] * inv - __uint_as_float(c.x & 0xffff0000u));
  o.y = pack2(acc[2] * inv - __uint_as_float(c.y << 16), acc[3] * inv - __uint_as_float(c.y & 0xffff0000u));
  o.z = pack2(acc[4] * inv - __uint_as_float(c.z << 16), acc[5] * inv - __uint_as_float(c.z & 0xffff0000u));
  o.w = pack2(acc[6] * inv - __uint_as_float(c.w << 16), acc[7] * inv - __uint_as_float(c.w & 0xffff0000u));
  *(uint4*)(dst + (size_t)r * 1024 + cc) = o;
}

NOINL void pool_phase(const P& p) {
  const bf16_t* h = WSB(OFF_H);
  bf16_t* dst = WSB(OFF_CAT);
  const int total = 8192 * 128;
  for (int idx = blockIdx.x * 256 + threadIdx.x; idx < total; idx += gridDim.x * 256) {
    const int c32 = idx & 31, rlo = (idx >> 5) & 1, gi = (idx >> 6) & 3, rhi = idx >> 8;
    const int r = rhi * 2 + rlo, cc = gi * 256 + c32 * 8;
    if (gi == 0) pool_item<1>(h, dst, r, cc);
    else if (gi == 1) pool_item<2>(h, dst, r, cc);
    else if (gi == 2) pool_item<4>(h, dst, r, cc);
    else pool_item<8>(h, dst, r, cc);
  }
}

NOINL void ph_gemm_proj(const P& p) {
  float* proj = WSF(OFF_R1);
  const bf16_t* A = WSB(OFF_H);
  const bf16_t* B = WSB(OFF_WIN);
  gemm_stream(64 * 17, 1024, 1024, 1024, g_smem,
    [=](int t) {
      TileInfo r;
      int m, n; tile_mn(t, 64, 17, m, n);
      r.m0 = m * 128; r.n0 = n * 128; r.ctx = 0;
      r.a = A + (size_t)r.m0 * 1024; r.b = B + (size_t)r.n0 * 1024;
      return r;
    },
    [&](int ctx, int row, int col, f32x4 v0, f32x4 v1) {
#pragma unroll
      for (int q = 0; q < 4; ++q) {
        if (col < 2096) proj[(size_t)(row + q) * 2096 + col] = v0[q];
        if (col + 16 < 2096) proj[(size_t)(row + q) * 2096 + col + 16] = v1[q];
      }
    });
}

NOINL void ph_gemm_f32out(const P& p, const bf16_t* A, int lda, const bf16_t* B, int ldb, int K, float* C, int N) {
  const int nN = N / 128;
  gemm_stream(64 * nN, lda, ldb, K, g_smem,
    [=](int t) {
      TileInfo r;
      int m, n; tile_mn(t, 64, nN, m, n);
      r.m0 = m * 128; r.n0 = n * 128; r.ctx = 0;
      r.a = A + (size_t)r.m0 * lda; r.b = B + (size_t)r.n0 * ldb;
      return r;
    },
    [&](int ctx, int row, int col, f32x4 v0, f32x4 v1) {
#pragma unroll
      for (int q = 0; q < 4; ++q) {
        C[(size_t)(row + q) * N + col] = v0[q];
        C[(size_t)(row + q) * N + col + 16] = v1[q];
      }
    });
}

NOINL void ph_gemm_q(const P& p) {
  bf16_t* qo = WSB(OFF_Q);
  const bf16_t* A = WSB(OFF_CQN);
  const bf16_t* B = WSB(OFF_WUQ);
  gemm_stream(64 * 6, 256, 256, 256, g_smem,
    [=](int t) {
      TileInfo r;
      int m, n; tile_mn(t, 64, 6, m, n);
      r.m0 = m * 128; r.n0 = n * 128; r.ctx = 0;
      r.a = A + (size_t)r.m0 * 256; r.b = B + (size_t)r.n0 * 256;
      return r;
    },
    [&](int ctx, int row, int col, f32x4 v0, f32x4 v1) {
      const float scl = 0.10206207261596575f * 1.4426950408889634f;
      const int tn = col >> 4;
      const bool rope = ((tn % 6) == 4) && (row >= 4096);
      const int ii = col & 15;
      const float fr = rope_freq(ii & 7);
#pragma unroll
      for (int q = 0; q < 4; ++q) {
        float a = v0[q], b = v1[q];
        if (rope) {
          const int tt = (row + q - 4096) & 2047;
          const float pos = (ii < 8) ? (float)(tt >> 6) : (float)(tt & 63);
          const float ang = pos * fr;
          float cs, sn;
          fast_sincos(ang, sn, cs);
          const float x1 = a, x2 = b;
          a = x1 * cs - x2 * sn;
          b = x1 * sn + x2 * cs;
        }
        qo[(size_t)(row + q) * 768 + col] = f2bf(a * scl);
        qo[(size_t)(row + q) * 768 + col + 16] = f2bf(b * scl);
      }
    });
}

NOINL void ph_gemm_kv(const P& p) {
  bf16_t* kn = WSB(OFF_KN);
  bf16_t* vt = WSB(OFF_VT);
  const bf16_t* A = WSB(OFF_CKV);
  const bf16_t* B = WSB(OFF_WUKV);
  gemm_stream(68 * 8, 256, 256, 256, g_smem,
    [=](int t) {
      TileInfo r;
      int m, n; tile_mn(t, 68, 8, m, n);
      r.m0 = m * 128; r.n0 = n * 128; r.ctx = 0;
      r.a = A + (size_t)r.m0 * 256; r.b = B + (size_t)r.n0 * 256;
      return r;
    },
    [&](int ctx, int row, int col, f32x4 v0, f32x4 v1) {
      const int hh = col >> 7, j = col & 127;
      if (j < 64) {
#pragma unroll
        for (int q = 0; q < 4; ++q) {
          kn[(size_t)(row + q) * 512 + hh * 64 + j] = f2bf(v0[q]);
          kn[(size_t)(row + q) * 512 + hh * 64 + j + 16] = f2bf(v1[q]);
        }
      } else {
        uint2 o0, o1;
        o0.x = pack2(v0[0], v0[1]); o0.y = pack2(v0[2], v0[3]);
        o1.x = pack2(v1[0], v1[1]); o1.y = pack2(v1[2], v1[3]);
        *(uint2*)(vt + (size_t)(hh * 64 + j - 64) * 8704 + row) = o0;
        *(uint2*)(vt + (size_t)(hh * 64 + j - 64 + 16) * 8704 + row) = o1;
      }
    });
}

NOINL void ph_gemm_ffn_up(const P& p, int layer) {
  bf16_t* gu = WSB(OFF_R1);
  const bf16_t* A = WSB(OFF_H);
  const bf16_t* B = WSB(OFF_WGU) + (size_t)layer * 5632 * 1024;
  gemm_stream(64 * 44, 1024, 1024, 1024, g_smem,
    [=](int t) {
      TileInfo r;
      int m, n; tile_mn(t, 64, 44, m, n);
      r.m0 = m * 128; r.n0 = n * 128; r.ctx = 0;
      r.a = A + (size_t)r.m0 * 1024; r.b = B + (size_t)r.n0 * 1024;
      return r;
    },
    [&](int ctx, int row, int col, f32x4 v0, f32x4 v1) {
      const int oc = (col >> 5) * 16 + (col & 15);
#pragma unroll
      for (int q = 0; q < 4; ++q) gu[(size_t)(row + q) * 2816 + oc] = f2bf(silu(v0[q]) * v1[q]);
    });
}

NOINL void ph_gemm_pool(const P& p) {
  float* mix = WSF(OFF_R1);
  const bf16_t* A = WSB(OFF_CAT);
  const bf16_t* B = WSB(OFF_WPOOL);
  gemm_stream(512, 1024, 256, 256, g_smem,
    [=](int t) {
      TileInfo r;
      const int id = swz_tile(t, 512);
      const int g = id >> 7, rem = id & 127;
      r.m0 = (rem >> 1) * 128; r.n0 = (rem & 1) * 128; r.ctx = g;
      r.a = A + (size_t)r.m0 * 1024 + g * 256; r.b = B + (size_t)g * 65536 + (size_t)r.n0 * 256;
      return r;
    },
    [&](int g, int row, int col, f32x4 v0, f32x4 v1) {
      const int c0 = g * 256 + col;
      const float s0 = p.pool_scale[c0], s1 = p.pool_scale[c0 + 16];
#pragma unroll
      for (int q = 0; q < 4; ++q) {
        mix[(size_t)(row + q) * 1024 + c0] = v0[q] * s0;
        mix[(size_t)(row + q) * 1024 + c0 + 16] = v1[q] * s1;
      }
    });
}


#define XB_TMO      128
#define XB_XCNT(j)  (256  + 64 * (j))
#define XB_XSUB(j)  (1280 + 64 * (j))
#define XB_XGEN(j)  (2304 + 64 * (j))
#define XB_TOP      3328
#define XB_TOPGEN   3392
#define XCD_BAR_WORDS 3456
#define XB_SPIN_CAP (1u << 22)
#define LAS __attribute__((address_space(3)))
DEVI unsigned xb_ld(unsigned* p) { return __hip_atomic_load(p, __ATOMIC_RELAXED, __HIP_MEMORY_SCOPE_AGENT); }
DEVI unsigned xb_add(unsigned* p, unsigned v) { return __hip_atomic_fetch_add(p, v, __ATOMIC_RELAXED, __HIP_MEMORY_SCOPE_AGENT); }
DEVI unsigned xb_xcc_id() { return (unsigned)__builtin_amdgcn_s_getreg((3 << 11) | 20) & 0xFu; }
#define XB_SPIN(cond, bar) do { unsigned _sp = 0; while (cond) { __builtin_amdgcn_s_sleep(1); \
    if ((++_sp & 255u) == 0u) { if (xb_ld(&(bar)[XB_TMO])) break; if (_sp > XB_SPIN_CAP) { atomicAdd(&(bar)[XB_TMO], 1u); break; } } } } while (0)
struct XcdBarrier { unsigned* bar; unsigned x; volatile LAS unsigned* st; };
DEVI XcdBarrier xcd_barrier_post(unsigned* bar, volatile LAS unsigned* st) {
  XcdBarrier b; b.bar = bar; b.x = xb_xcc_id(); b.st = st;
  if (threadIdx.x == 0) (void)xb_add(&bar[XB_XCNT(b.x)], 1u);
  return b;
}
DEVI void xcd_barrier_complete(unsigned* bar, unsigned x, unsigned& nloc, unsigned& nx) {
  const unsigned G = gridDim.x * gridDim.y * gridDim.z;
  unsigned sum, cnt, mine, sp = 0u;
  for (;;) {
    sum = 0u; cnt = 0u; mine = 0u;
#pragma unroll
    for (unsigned j = 0; j < 16; ++j) { const unsigned c = xb_ld(&bar[XB_XCNT(j)]); sum += c; cnt += (c > 0u) ? 1u : 0u; mine = (j == x) ? c : mine; }
    if (sum == G) break;
    __builtin_amdgcn_s_sleep(1);
    if ((++sp & 255u) == 0u) { if (xb_ld(&bar[XB_TMO])) break; if (sp > XB_SPIN_CAP) { atomicAdd(&bar[XB_TMO], 1u); break; } }
  }
  nloc = mine > 0u ? mine : 1u; nx = cnt > 0u ? cnt : 1u;
}
DEVI void xcd_barrier(const XcdBarrier& b) {
  asm volatile("s_waitcnt vmcnt(0)" ::: "memory");
  __syncthreads();
  if (threadIdx.x == 0) {
    unsigned* bar = b.bar;
    __builtin_amdgcn_s_waitcnt(0);
    unsigned nloc = b.st[0], nx = b.st[1];
    if (nloc == 0u) { xcd_barrier_complete(bar, b.x, nloc, nx); b.st[0] = nloc; b.st[1] = nx; }
    const unsigned old = xb_add(&bar[XB_XSUB(b.x)], 1u);
    const unsigned gen = old / nloc;
    if (old + 1u == (gen + 1u) * nloc) {
      __builtin_amdgcn_fence(__ATOMIC_RELEASE, "agent");
      asm volatile("s_waitcnt vmcnt(0)" ::: "memory");
      const unsigned og = xb_add(&bar[XB_TOP], 1u);
      const unsigned tg = og / nx;
      if (og + 1u == (tg + 1u) * nx) xb_add(&bar[XB_TOPGEN], 1u);
      else XB_SPIN(xb_ld(&bar[XB_TOPGEN]) == tg, bar);
      __builtin_amdgcn_fence(__ATOMIC_ACQUIRE, "agent");
      xb_add(&bar[XB_XGEN(b.x)], 1u);
      asm volatile("s_waitcnt vmcnt(0)" ::: "memory");
    } else {
      XB_SPIN(xb_ld(&bar[XB_XGEN(b.x)]) == gen, bar);
      __builtin_amdgcn_fence(__ATOMIC_ACQUIRE, "agent");
      asm volatile("s_waitcnt vmcnt(0)" ::: "memory");
    }
  }
  __syncthreads();
}

constexpr int NPHASE = 18;
#ifndef REPMASK
#define REPMASK 0
#endif
#ifndef P6PROBE
#define P6PROBE 1
#endif
#ifndef PHMASK
#define PHMASK 0x3ffff
#endif
#define PH(n) if constexpr ((PHMASK >> (n)) & 1)

__global__ void __launch_bounds__(256, 2) mega(P p, int lo, int hi) {
  __shared__ uint4 xb_words;
  if (threadIdx.x == 0) xb_words = make_uint4(0u, 0u, 0u, 0u);
  __syncthreads();
  XcdBarrier xb = xcd_barrier_post((unsigned*)(p.ws + OFF_BAR), (volatile LAS unsigned*)&xb_words);
  if (lo < 0) cg::this_grid().sync();
  PH(0) if (lo <= 0 && 0 < hi) {
#if (REPMASK >> 0) & 1
    int nrep = 2; asm volatile("" : "+s"(nrep));
    for (int rep = 0; rep < nrep; ++rep) {
      if (rep) xcd_barrier(xb);
#else
    {
#endif
        for (int t = blockIdx.x; t < 384 + 5200; t += gridDim.x) {
          if (t < 384) gemv_tile(p, t); else transpose_tile(p, t - 384);
        }
    }
  }
  if (lo <= 0 && 0 + 1 < hi) xcd_barrier(xb);
  PH(1) if (lo <= 1 && 1 < hi) {
#if (REPMASK >> 1) & 1
    int nrep = 2; asm volatile("" : "+s"(nrep));
    for (int rep = 0; rep < nrep; ++rep) {
      if (rep) xcd_barrier(xb);
#else
    {
#endif
        rowop<false, true, true>(p, nullptr, nullptr, 0, p.n_pre_mix, 0, 1, 0, 0);
    }
  }
  if (lo <= 1 && 1 + 1 < hi) xcd_barrier(xb);
  PH(2) if (lo <= 2 && 2 < hi) {
#if (REPMASK >> 2) & 1
    int nrep = 2; asm volatile("" : "+s"(nrep));
    for (int rep = 0; rep < nrep; ++rep) {
      if (rep) xcd_barrier(xb);
#else
    {
#endif
        ph_gemm_proj(p);
    }
  }
  if (lo <= 2 && 2 + 1 < hi) xcd_barrier(xb);
  PH(3) if (lo <= 3 && 3 < hi) {
#if (REPMASK >> 3) & 1
    int nrep = 2; asm volatile("" : "+s"(nrep));
    for (int rep = 0; rep < nrep; ++rep) {
      if (rep) xcd_barrier(xb);
#else
    {
#endif
        prep_rows(p);
        prep_cache(p);
        for (int t = blockIdx.x; t < 2048; t += gridDim.x) conv_tile(p, t);
    }
  }
  if (lo <= 3 && 3 + 1 < hi) xcd_barrier(xb);
  PH(4) if (lo <= 4 && 4 < hi) {
#if (REPMASK >> 4) & 1
    int nrep = 2; asm volatile("" : "+s"(nrep));
    for (int rep = 0; rep < nrep; ++rep) {
      if (rep) xcd_barrier(xb);
#else
    {
#endif
        ph_gemm_q(p);
        ph_gemm_kv(p);
        for (int t = blockIdx.x; t < 512; t += gridDim.x) chunk_state_item(p, t);
    }
  }
  if (lo <= 4 && 4 + 1 < hi) xcd_barrier(xb);
  PH(5) if (lo <= 5 && 5 < hi) {
#if (REPMASK >> 5) & 1
    int nrep = 2; asm volatile("" : "+s"(nrep));
    for (int rep = 0; rep < nrep; ++rep) {
      if (rep) xcd_barrier(xb);
#else
    {
#endif
        scan_states(p);
    }
  }
  if (lo <= 5 && 5 + 1 < hi) xcd_barrier(xb);
  PH(6) if (lo <= 6 && 6 < hi) {
#if (REPMASK >> 6) & 1
    int nrep = 2; asm volatile("" : "+s"(nrep));
    for (int rep = 0; rep < nrep; ++rep) {
      if (rep) xcd_barrier(xb);
#else
    {
#endif
        for (int t = blockIdx.x; t < 1024; t += gridDim.x) {
#if (REPMASK >> 6) & 1
          if (rep && ((P6PROBE == 1) == (t >= 512 && t < 768))) continue;
#endif
          if (t >= 512 && t < 768) ssd_y_item(p, t - 512);
          else {
            const int first = t < 512 ? t : 512 + (t - 768);
            const int cnt = t < 512 ? 1 : 2;
            for (int k = 0; k < cnt; ++k) attn_item(p, first + k * 256);
          }
        }
    }
  }
  if (lo <= 6 && 6 + 1 < hi) xcd_barrier(xb);
  PH(7) if (lo <= 7 && 7 < hi) {
#if (REPMASK >> 7) & 1
    int nrep = 2; asm volatile("" : "+s"(nrep));
    for (int rep = 0; rep < nrep; ++rep) {
      if (rep) xcd_barrier(xb);
#else
    {
#endif
        ph_gemm_f32out(p, WSB(OFF_CAT), 1024, WSB(OFF_WOUT), 1024, 1024, WSF(OFF_R1), 1024);
    }
  }
  if (lo <= 7 && 7 + 1 < hi) xcd_barrier(xb);
  PH(8) if (lo <= 8 && 8 < hi) {
#if (REPMASK >> 8) & 1
    int nrep = 2; asm volatile("" : "+s"(nrep));
    for (int rep = 0; rep < nrep; ++rep) {
      if (rep) xcd_barrier(xb);
#else
    {
#endif
        rowop<true, true, true>(p, WSF(OFF_R1), p.n_post_mix, 2, p.n_pre_ffn, 3, 4, 0, 0);
    }
  }
  if (lo <= 8 && 8 + 1 < hi) xcd_barrier(xb);
  PH(9) if (lo <= 9 && 9 < hi) {
#if (REPMASK >> 9) & 1
    int nrep = 2; asm volatile("" : "+s"(nrep));
    for (int rep = 0; rep < nrep; ++rep) {
      if (rep) xcd_barrier(xb);
#else
    {
#endif
        ph_gemm_ffn_up(p, 0);
    }
  }
  if (lo <= 9 && 9 + 1 < hi) xcd_barrier(xb);
  PH(10) if (lo <= 10 && 10 < hi) {
#if (REPMASK >> 10) & 1
    int nrep = 2; asm volatile("" : "+s"(nrep));
    for (int rep = 0; rep < nrep; ++rep) {
      if (rep) xcd_barrier(xb);
#else
    {
#endif
        ph_gemm_f32out(p, WSB(OFF_R1), 2816, WSB(OFF_WDN), 2816, 2816, WSF(OFF_R2), 1024);
    }
  }
  if (lo <= 10 && 10 + 1 < hi) xcd_barrier(xb);
  PH(11) if (lo <= 11 && 11 < hi) {
#if (REPMASK >> 11) & 1
    int nrep = 2; asm volatile("" : "+s"(nrep));
    for (int rep = 0; rep < nrep; ++rep) {
      if (rep) xcd_barrier(xb);
#else
    {
#endif
        rowop<true, true, false>(p, WSF(OFF_R2), p.n_post_ffn, 5, p.n_pre_mix + 1024, 0, 1, 0, 1);
    }
  }
  if (lo <= 11 && 11 + 1 < hi) xcd_barrier(xb);
  PH(12) if (lo <= 12 && 12 < hi) {
#if (REPMASK >> 12) & 1
    int nrep = 2; asm volatile("" : "+s"(nrep));
    for (int rep = 0; rep < nrep; ++rep) {
      if (rep) xcd_barrier(xb);
#else
    {
#endif
        pool_phase(p);
    }
  }
  if (lo <= 12 && 12 + 1 < hi) xcd_barrier(xb);
  PH(13) if (lo <= 13 && 13 < hi) {
#if (REPMASK >> 13) & 1
    int nrep = 2; asm volatile("" : "+s"(nrep));
    for (int rep = 0; rep < nrep; ++rep) {
      if (rep) xcd_barrier(xb);
#else
    {
#endif
        ph_gemm_pool(p);
    }
  }
  if (lo <= 13 && 13 + 1 < hi) xcd_barrier(xb);
  PH(14) if (lo <= 14 && 14 < hi) {
#if (REPMASK >> 14) & 1
    int nrep = 2; asm volatile("" : "+s"(nrep));
    for (int rep = 0; rep < nrep; ++rep) {
      if (rep) xcd_barrier(xb);
#else
    {
#endif
        rowop<true, true, false>(p, WSF(OFF_R1), p.n_post_mix + 1024, 2, p.n_pre_ffn + 1024, 3, 4, 1, 1);
    }
  }
  if (lo <= 14 && 14 + 1 < hi) xcd_barrier(xb);
  PH(15) if (lo <= 15 && 15 < hi) {
#if (REPMASK >> 15) & 1
    int nrep = 2; asm volatile("" : "+s"(nrep));
    for (int rep = 0; rep < nrep; ++rep) {
      if (rep) xcd_barrier(xb);
#else
    {
#endif
        ph_gemm_ffn_up(p, 1);
    }
  }
  if (lo <= 15 && 15 + 1 < hi) xcd_barrier(xb);
  PH(16) if (lo <= 16 && 16 < hi) {
#if (REPMASK >> 16) & 1
    int nrep = 2; asm volatile("" : "+s"(nrep));
    for (int rep = 0; rep < nrep; ++rep) {
      if (rep) xcd_barrier(xb);
#else
    {
#endif
        ph_gemm_f32out(p, WSB(OFF_R1), 2816, WSB(OFF_WDN) + (size_t)1024 * 2816, 2816, 2816, WSF(OFF_R2), 1024);
    }
  }
  if (lo <= 16 && 16 + 1 < hi) xcd_barrier(xb);
  PH(17) if (lo <= 17 && 17 < hi) {
#if (REPMASK >> 17) & 1
    int nrep = 2; asm volatile("" : "+s"(nrep));
    for (int rep = 0; rep < nrep; ++rep) {
      if (rep) xcd_barrier(xb);
#else
    {
#endif
        rowop<true, false, false>(p, WSF(OFF_R2), p.n_post_ffn + 1024, 5, nullptr, 0, 0, 1, 1);
    }
  }
}

extern "C" void kernel_launch(void* const* d_in, const int* in_sizes, int n_in, void* d_out, int out_size, void* d_ws,
                              size_t ws_size, hipStream_t stream) {
  P p{};
  const float** f = (const float**)&p;
  for (int i = 0; i < 33; ++i) f[i] = (const float*)d_in[i];
  p.out = (float*)d_out;
  p.ws = (char*)d_ws;
  static int grid_blocks = 0;
  if (!grid_blocks) {
    int dev = 0, cus = 0, per_cu = 0;
    hipGetDevice(&dev);
    hipDeviceGetAttribute(&cus, hipDeviceAttributeMultiprocessorCount, dev);
    hipOccupancyMaxActiveBlocksPerMultiprocessor(&per_cu, mega, 256, 0);
    if (per_cu > 2) per_cu = 2;
    if (per_cu < 1) per_cu = 1;
    grid_blocks = cus * per_cu;
  }
  hipMemsetAsync((char*)d_ws + OFF_BAR, 0, XCD_BAR_WORDS * 4, stream);
#if SINGLE_LAUNCH
  int lo = 0, hi = NPHASE;
  void* args[] = {&p, &lo, &hi};
  hipError_t e = hipLaunchCooperativeKernel((void*)mega, dim3(grid_blocks), dim3(256), args, 0, stream);
  if (e != hipSuccess) fprintf(stderr, "cooperative launch failed: %s (grid %d)\n", hipGetErrorString(e), grid_blocks);
#else
  for (int ph = 0; ph < NPHASE; ++ph) mega<<<grid_blocks, 256, 0, stream>>>(p, ph, ph + 1);
#endif
}
```

```cpp
#include <hip/hip_runtime.h>
#include <hip/hip_cooperative_groups.h>
#include <stdint.h>
#include <stdio.h>
namespace cg = cooperative_groups;

#ifndef SINGLE_LAUNCH
#define SINGLE_LAUNCH 1
#endif

typedef __attribute__((ext_vector_type(8))) short bf16x8;
typedef __attribute__((ext_vector_type(4))) float f32x4;
typedef unsigned short bf16_t;

#define DEVI __device__ __forceinline__

constexpr size_t OFF_WIN   = 0;
constexpr size_t OFF_WUQ   = OFF_WIN   + (size_t)2176*1024*2;
constexpr size_t OFF_WUKV  = OFF_WUQ   + (size_t)768*256*2;
constexpr size_t OFF_WOUT  = OFF_WUKV  + (size_t)1024*256*2;
constexpr size_t OFF_WPOOL = OFF_WOUT  + (size_t)1024*1024*2;
constexpr size_t OFF_WGU   = OFF_WPOOL + (size_t)4*256*256*2;
constexpr size_t OFF_WDN   = OFF_WGU   + (size_t)2*5632*1024*2;
constexpr size_t OFF_MOD   = OFF_WDN   + (size_t)2*1024*2816*2;
constexpr size_t OFF_R1    = OFF_MOD   + (size_t)2*3*6144*4;
constexpr size_t OFF_R2    = OFF_R1    + (size_t)8192*2096*4;
constexpr size_t OFF_H     = OFF_R2    + (size_t)8192*1024*4;
constexpr size_t OFF_CAT   = OFF_H     + (size_t)8192*1024*2;
constexpr size_t OFF_Q     = OFF_CAT   + (size_t)8192*1024*2;
constexpr size_t OFF_KN    = OFF_Q     + (size_t)8192*768*2;
constexpr size_t OFF_VT    = OFF_KN    + (size_t)8704*512*2;
constexpr size_t OFF_CQN   = OFF_VT    + (size_t)8704*512*2;
constexpr size_t OFF_CKV   = OFF_CQN   + (size_t)8192*256*2;
constexpr size_t OFF_KPE   = OFF_CKV   + (size_t)8704*256*2;
constexpr size_t OFF_XS    = OFF_KPE   + (size_t)8704*32*2;
constexpr size_t OFF_XST   = OFF_XS    + (size_t)8192*512*2;
constexpr size_t OFF_BM    = OFF_XST   + (size_t)8192*512*2;
constexpr size_t OFF_BT    = OFF_BM    + (size_t)8192*256*2;
constexpr size_t OFF_CM    = OFF_BT    + (size_t)8192*256*2;
constexpr size_t OFF_DTV   = OFF_CM    + (size_t)8192*256*2;
constexpr size_t OFF_CUM   = OFF_DTV   + (size_t)2*8192*8*4;
constexpr size_t OFF_TOT   = OFF_CUM   + (size_t)2*8192*8*4;
constexpr size_t OFF_BAR   = OFF_TOT   + 4096;
constexpr size_t OFF_XR    = OFF_BAR   + 16384;
constexpr size_t OFF_END   = OFF_XR    + (size_t)8192*1024*2;
static_assert(OFF_END <= ((size_t)256 << 20), "workspace map exceeds 256 MiB");

constexpr size_t OUT_CKV = 8388608, OUT_KR = 9437184, OUT_SF = 9568256, OUT_SB = 10616832;

struct P {
  const float *x_prompt, *x_sample, *c, *cache_ckv, *cache_kr, *st_f, *st_b, *c_ctx;
  const float *w_mod, *b_mod, *n_pre_mix, *n_post_mix, *n_pre_ffn, *n_post_ffn;
  const float *w_in, *q_norm, *w_uq, *kv_norm, *w_ukv, *conv_w, *conv_b, *dtb_f, *dtb_b, *alog_f, *alog_b;
  const float *ssd_d, *ssd_norm, *w_out, *pool_w, *pool_scale, *w_gate, *w_up, *w_down;
  float* out;
  char* ws;
};

#define WSB(off) ((bf16_t*)(p.ws + (off)))
#define WSF(off) ((float*)(p.ws + (off)))

typedef __bf16 hwbf16x2 __attribute__((ext_vector_type(2)));
typedef float hwf32x2 __attribute__((ext_vector_type(2)));
DEVI bf16_t f2bf(float f) {
  __bf16 r = (__bf16)f;
  return __builtin_bit_cast(bf16_t, r);
}
DEVI float bf2f(bf16_t b) { return __uint_as_float(((unsigned)b) << 16); }
DEVI unsigned pack2(float a, float b) {
  hwf32x2 v = {a, b};
  hwbf16x2 r = __builtin_convertvector(v, hwbf16x2);
  return __builtin_bit_cast(unsigned, r);
}
DEVI float silu(float x) { return x / (1.f + __expf(-x)); }
DEVI float wave_sum(float v) {
#pragma unroll
  for (int o = 32; o > 0; o >>= 1) v += __shfl_xor(v, o, 64);
  return v;
}
DEVI f32x4 mfma16(bf16x8 a, bf16x8 b, f32x4 c) { return __builtin_amdgcn_mfma_f32_16x16x32_bf16(a, b, c, 0, 0, 0); }

DEVI float rope_freq(int m) { return exp2f(-(float)m * 1.6609640474436813f); }
DEVI void fast_sincos(float ang, float& sn, float& cs) {
  float rev = ang * 0.15915494309189535f;
  rev -= rintf(rev);
  sn = __builtin_amdgcn_sinf(rev);
  cs = __builtin_amdgcn_cosf(rev);
}
typedef unsigned hwu32x2 __attribute__((ext_vector_type(2)));
DEVI float quad_max(float x) {
  hwu32x2 r = __builtin_amdgcn_permlane16_swap(__float_as_uint(x), __float_as_uint(x), false, false);
  x = fmaxf(__uint_as_float(r[0]), __uint_as_float(r[1]));
  r = __builtin_amdgcn_permlane32_swap(__float_as_uint(x), __float_as_uint(x), false, false);
  return fmaxf(__uint_as_float(r[0]), __uint_as_float(r[1]));
}
DEVI float quad_sum(float x) {
  hwu32x2 r = __builtin_amdgcn_permlane16_swap(__float_as_uint(x), __float_as_uint(x), false, false);
  x = __uint_as_float(r[0]) + __uint_as_float(r[1]);
  r = __builtin_amdgcn_permlane32_swap(__float_as_uint(x), __float_as_uint(x), false, false);
  return __uint_as_float(r[0]) + __uint_as_float(r[1]);
}
DEVI int opaque_tid() { int t = threadIdx.x; asm volatile("" : "+v"(t)); return t; }
DEVI int swz_tile(int t, int T) {
  int q = T >> 3, r = T & 7, x = t & 7, off = t >> 3;
  return (x < r ? x * (q + 1) : r * (q + 1) + (x - r) * q) + off;
}

__shared__ __attribute__((aligned(16))) char g_smem[73728];
#define NOINL __device__ __forceinline__

constexpr int LDT = 72;
constexpr int TILE_E = 128 * LDT;

template <class Epi>
DEVI void gemm_tile(const bf16_t* __restrict__ A, int lda, const bf16_t* __restrict__ B, int ldb, int K,
                    int m0, int n0, char* smem, Epi epi) {
  const int tid = threadIdx.x, lane = tid & 63, wave = tid >> 6, wm = wave >> 1, wn = wave & 1;
  const int lr = lane & 15, lg = lane >> 4;
  bf16_t* sA = (bf16_t*)smem;
  bf16_t* sB = sA + 2 * TILE_E;
  f32x4 acc[4][4];
#pragma unroll
  for (int i = 0; i < 4; ++i)
#pragma unroll
    for (int j = 0; j < 4; ++j) acc[i][j] = (f32x4){0.f, 0.f, 0.f, 0.f};
  const int lrow = tid >> 3, lkc = (tid & 7) * 8;
  const bf16_t* gA = A + (size_t)(m0 + lrow) * lda + lkc;
  const bf16_t* gB = B + (size_t)(n0 + lrow) * ldb + lkc;
  uint4 ra[4], rb[4];
#pragma unroll
  for (int i = 0; i < 4; ++i) {
    ra[i] = *(const uint4*)(gA + (size_t)(32 * i) * lda);
    rb[i] = *(const uint4*)(gB + (size_t)(32 * i) * ldb);
  }
#pragma unroll
  for (int i = 0; i < 4; ++i) {
    *(uint4*)(sA + (lrow + 32 * i) * LDT + lkc) = ra[i];
    *(uint4*)(sB + (lrow + 32 * i) * LDT + lkc) = rb[i];
  }
  __syncthreads();
  const int nk = K >> 6;
  for (int kt = 0; kt < nk; ++kt) {
    const int cur = kt & 1;
    if (kt + 1 < nk) {
      const int k0 = (kt + 1) << 6;
#pragma unroll
      for (int i = 0; i < 4; ++i) {
        ra[i] = *(const uint4*)(gA + (size_t)(32 * i) * lda + k0);
        rb[i] = *(const uint4*)(gB + (size_t)(32 * i) * ldb + k0);
      }
    }
    const bf16_t* cA = sA + cur * TILE_E + (wm * 64 + lr) * LDT + lg * 8;
    const bf16_t* cB = sB + cur * TILE_E + (wn * 64 + lr) * LDT + lg * 8;
#pragma unroll
    for (int ks = 0; ks < 2; ++ks) {
      bf16x8 af[4], bfr[4];
#pragma unroll
      for (int i = 0; i < 4; ++i) {
        af[i] = *(const bf16x8*)(cA + i * 16 * LDT + ks * 32);
        bfr[i] = *(const bf16x8*)(cB + i * 16 * LDT + ks * 32);
      }
#pragma unroll
      for (int i = 0; i < 4; ++i)
#pragma unroll
        for (int j = 0; j < 4; ++j) acc[i][j] = mfma16(af[i], bfr[j], acc[i][j]);
    }
    if (kt + 1 < nk) {
      const int nx = cur ^ 1;
#pragma unroll
      for (int i = 0; i < 4; ++i) {
        *(uint4*)(sA + nx * TILE_E + (lrow + 32 * i) * LDT + lkc) = ra[i];
        *(uint4*)(sB + nx * TILE_E + (lrow + 32 * i) * LDT + lkc) = rb[i];
      }
    }
    __syncthreads();
  }
#pragma unroll
  for (int i = 0; i < 4; ++i)
#pragma unroll
    for (int j = 0; j < 4; j += 2)
      epi(m0 + wm * 64 + i * 16 + lg * 4, n0 + wn * 64 + j * 16 + lr, acc[i][j], acc[i][j + 1]);
}

struct TileInfo { const bf16_t* a; const bf16_t* b; int m0, n0, ctx; };
template <class TileFn, class Epi>
DEVI void gemm_stream(int T, int lda, int ldb, int K, char* smem, TileFn tf, Epi epi) {
  int t = blockIdx.x;
  if (t >= T) return;
  const int tid = opaque_tid(), lane = tid & 63, wave = tid >> 6, wm = wave >> 1, wn = wave & 1;
  const int lr = lane & 15, lg = lane >> 4;
  bf16_t* sA = (bf16_t*)smem;
  bf16_t* sB = sA + 2 * TILE_E;
  const int lrow = tid >> 3, lkc = (tid & 7) * 8;
  TileInfo ti = tf(t);
  const bf16_t* gA = ti.a + (size_t)lrow * lda + lkc;
  const bf16_t* gB = ti.b + (size_t)lrow * ldb + lkc;
  int m0 = ti.m0, n0 = ti.n0, ctx = ti.ctx;
  uint4 ra0, ra1, ra2, ra3, rb0, rb1, rb2, rb3;
  uint4 rc0, rc1, rc2, rc3, rd0, rd1, rd2, rd3;
#define GS_LOAD0(pa, pb) \
  ra0 = *(const uint4*)((pa)); ra1 = *(const uint4*)((pa) + (size_t)32 * lda); \
  ra2 = *(const uint4*)((pa) + (size_t)64 * lda); ra3 = *(const uint4*)((pa) + (size_t)96 * lda); \
  rb0 = *(const uint4*)((pb)); rb1 = *(const uint4*)((pb) + (size_t)32 * ldb); \
  rb2 = *(const uint4*)((pb) + (size_t)64 * ldb); rb3 = *(const uint4*)((pb) + (size_t)96 * ldb);
#define GS_LOAD1(pa, pb) \
  rc0 = *(const uint4*)((pa)); rc1 = *(const uint4*)((pa) + (size_t)32 * lda); \
  rc2 = *(const uint4*)((pa) + (size_t)64 * lda); rc3 = *(const uint4*)((pa) + (size_t)96 * lda); \
  rd0 = *(const uint4*)((pb)); rd1 = *(const uint4*)((pb) + (size_t)32 * ldb); \
  rd2 = *(const uint4*)((pb) + (size_t)64 * ldb); rd3 = *(const uint4*)((pb) + (size_t)96 * ldb);
#define GS_WRITE0(buf) { \
  bf16_t* wa = sA + (buf) * TILE_E + lrow * LDT + lkc; bf16_t* wb = sB + (buf) * TILE_E + lrow * LDT + lkc; \
  *(uint4*)(wa) = ra0; *(uint4*)(wa + 32 * LDT) = ra1; *(uint4*)(wa + 64 * LDT) = ra2; *(uint4*)(wa + 96 * LDT) = ra3; \
  *(uint4*)(wb) = rb0; *(uint4*)(wb + 32 * LDT) = rb1; *(uint4*)(wb + 64 * LDT) = rb2; *(uint4*)(wb + 96 * LDT) = rb3; }
#define GS_WRITE1(buf) { \
  bf16_t* wa = sA + (buf) * TILE_E + lrow * LDT + lkc; bf16_t* wb = sB + (buf) * TILE_E + lrow * LDT + lkc; \
  *(uint4*)(wa) = rc0; *(uint4*)(wa + 32 * LDT) = rc1; *(uint4*)(wa + 64 * LDT) = rc2; *(uint4*)(wa + 96 * LDT) = rc3; \
  *(uint4*)(wb) = rd0; *(uint4*)(wb + 32 * LDT) = rd1; *(uint4*)(wb + 64 * LDT) = rd2; *(uint4*)(wb + 96 * LDT) = rd3; }
#define GS_COMPUTE(buf) { \
    const bf16_t* cA = sA + (buf) * TILE_E + (wm * 64 + lr) * LDT + lg * 8; \
    const bf16_t* cB = sB + (buf) * TILE_E + (wn * 64 + lr) * LDT + lg * 8; \
    _Pragma("unroll") for (int ks = 0; ks < 2; ++ks) { \
      bf16x8 af[4], bfr[4]; \
      _Pragma("unroll") for (int i = 0; i < 4; ++i) { \
        af[i] = *(const bf16x8*)(cA + i * 16 * LDT + ks * 32); \
        bfr[i] = *(const bf16x8*)(cB + i * 16 * LDT + ks * 32); \
      } \
      __builtin_amdgcn_s_setprio(1); \
      _Pragma("unroll") for (int i = 0; i < 4; ++i) \
        _Pragma("unroll") for (int j = 0; j < 4; ++j) acc[i][j] = mfma16(af[i], bfr[j], acc[i][j]); \
      __builtin_amdgcn_s_setprio(0); \
    } }
  GS_LOAD0(gA, gB)
  GS_WRITE0(0)
  GS_LOAD1(gA + 64, gB + 64)
  __syncthreads();
  const int nk = K >> 6;
  for (;;) {
    f32x4 acc[4][4];
#pragma unroll
    for (int i = 0; i < 4; ++i)
#pragma unroll
      for (int j = 0; j < 4; ++j) acc[i][j] = (f32x4){0.f, 0.f, 0.f, 0.f};
    const int tn = t + gridDim.x;
    const bool have_next = tn < T;
    const bf16_t *nA = gA, *nB = gB;
    int nm0 = 0, nn0 = 0, nctx = 0;
    if (have_next) {
      const TileInfo tj = tf(tn);
      nA = tj.a + (size_t)lrow * lda + lkc;
      nB = tj.b + (size_t)lrow * ldb + lkc;
      nm0 = tj.m0; nn0 = tj.n0; nctx = tj.ctx;
    }
    for (int kt = 0; kt < nk; kt += 2) {
      {
        const bool wrap = (kt + 2 >= nk);
        const bf16_t* pa = wrap ? nA : gA + ((kt + 2) << 6);
        const bf16_t* pb = wrap ? nB : gB + ((kt + 2) << 6);
        GS_LOAD0(pa, pb)
        GS_COMPUTE(0)
        GS_WRITE1(1)
        __syncthreads();
      }
      {
        const bool wrap = (kt + 3 >= nk);
        const bf16_t* pa = wrap ? nA + 64 : gA + ((kt + 3) << 6);
        const bf16_t* pb = wrap ? nB + 64 : gB + ((kt + 3) << 6);
        GS_LOAD1(pa, pb)
        GS_COMPUTE(1)
        GS_WRITE0(0)
        __syncthreads();
      }
    }
#pragma unroll
    for (int i = 0; i < 4; ++i)
#pragma unroll
      for (int j = 0; j < 4; j += 2)
        epi(ctx, m0 + wm * 64 + i * 16 + lg * 4, n0 + wn * 64 + j * 16 + lr, acc[i][j], acc[i][j + 1]);
    if (!have_next) break;
    t = tn; gA = nA; gB = nB; m0 = nm0; n0 = nn0; ctx = nctx;
  }
}

DEVI void tile_mn(int t, int nM, int nN, int& m, int& n) {
  int id = swz_tile(t, nM * nN);
  int per = 8 * nN;
  int gq = id / per, rem = id - gq * per;
  int gsz = min(8, nM - gq * 8);
  m = gq * 8 + rem % gsz;
  n = rem / gsz;
}

NOINL void gemv_tile(const P& p, int t) {
  char* smem = g_smem;
  const int tid = opaque_tid();
  float* sv = (float*)smem;
  float* red = sv + 3072;
  const int l = t / 192, n0 = (t % 192) * 32;
  for (int i = tid; i < 3072; i += 256) {
    int v = i >> 10, k = i & 1023;
    float cv = (v == 0) ? p.c_ctx[k] : p.c[(v - 1) * 1024 + k];
    sv[i] = cv / (1.f + expf(-cv));
  }
  __syncthreads();
  const int cgp = tid & 7, ks = tid >> 3;
  const float* w = p.w_mod + (size_t)l * 1024 * 6144 + n0 + cgp * 4;
  float a0[4] = {0, 0, 0, 0}, a1[4] = {0, 0, 0, 0}, a2[4] = {0, 0, 0, 0};
#pragma unroll 16
  for (int kk = 0; kk < 32; ++kk) {
    const int k = ks * 32 + kk;
    const float4 wv = *(const float4*)(w + (size_t)k * 6144);
    const float s0 = sv[k], s1 = sv[1024 + k], s2 = sv[2048 + k];
    a0[0] += s0 * wv.x; a0[1] += s0 * wv.y; a0[2] += s0 * wv.z; a0[3] += s0 * wv.w;
    a1[0] += s1 * wv.x; a1[1] += s1 * wv.y; a1[2] += s1 * wv.z; a1[3] += s1 * wv.w;
    a2[0] += s2 * wv.x; a2[1] += s2 * wv.y; a2[2] += s2 * wv.z; a2[3] += s2 * wv.w;
  }
#pragma unroll
  for (int j = 0; j < 4; ++j) {
    red[(ks * 3 + 0) * 32 + cgp * 4 + j] = a0[j];
    red[(ks * 3 + 1) * 32 + cgp * 4 + j] = a1[j];
    red[(ks * 3 + 2) * 32 + cgp * 4 + j] = a2[j];
  }
  __syncthreads();
  if (tid < 96) {
    const int v = tid >> 5, col = tid & 31;
    float s = 0.f;
    for (int q = 0; q < 32; ++q) s += red[(q * 3 + v) * 32 + col];
    s += p.b_mod[l * 6144 + n0 + col];
    WSF(OFF_MOD)[(l * 3 + v) * 6144 + n0 + col] = s;
  }
  __syncthreads();
}

NOINL void transpose_tile(const P& p, int t) {
  char* smem = g_smem;
  const int tid = opaque_tid();
  const float* src; bf16_t* dst; int K, N, ntn, mode = 0;
  if (t < 544) { src = p.w_in; dst = WSB(OFF_WIN); K = 1024; N = 2096; ntn = 34; }
  else if ((t -= 544) < 48) { src = p.w_uq; dst = WSB(OFF_WUQ); K = 256; N = 768; ntn = 12; }
  else if ((t -= 48) < 64) { src = p.w_ukv; dst = WSB(OFF_WUKV); K = 256; N = 1024; ntn = 16; }
  else if ((t -= 64) < 256) { src = p.w_out; dst = WSB(OFF_WOUT); K = 1024; N = 1024; ntn = 16; }
  else if ((t -= 256) < 64) { int g = t >> 4; t &= 15; src = p.pool_w + (size_t)g * 65536; dst = WSB(OFF_WPOOL) + (size_t)g * 65536; K = 256; N = 256; ntn = 4; }
  else if ((t -= 64) < 1408) { int l = t / 704; t -= l * 704; src = p.w_gate + (size_t)l * 1024 * 2816; dst = WSB(OFF_WGU) + (size_t)l * 5632 * 1024; K = 1024; N = 2816; ntn = 44; mode = 1; }
  else if ((t -= 1408) < 1408) { int l = t / 704; t -= l * 704; src = p.w_up + (size_t)l * 1024 * 2816; dst = WSB(OFF_WGU) + (size_t)l * 5632 * 1024; K = 1024; N = 2816; ntn = 44; mode = 2; }
  else { t -= 1408; int l = t / 704; t -= l * 704; src = p.w_down + (size_t)l * 2816 * 1024; dst = WSB(OFF_WDN) + (size_t)l * 1024 * 2816; K = 2816; N = 1024; ntn = 16; }
  const int kt = t / ntn, nt_ = t - kt * ntn;
  const int k0 = kt * 64, n0 = nt_ * 64;
  float* tile = (float*)smem;
  {
    const int nn = tid & 63, kk0 = tid >> 6;
    const int n = n0 + nn;
    const int nc = n < N ? n : N - 1;
    float v[16];
#pragma unroll
    for (int i = 0; i < 16; ++i) v[i] = src[(size_t)(k0 + kk0 + 4 * i) * N + nc];
#pragma unroll
    for (int i = 0; i < 16; ++i) tile[(kk0 + 4 * i) * 65 + nn] = (n < N) ? v[i] : 0.f;
  }
  __syncthreads();
#pragma unroll
  for (int i = 0; i < 2; ++i) {
    const int id = tid + 256 * i;
    const int nn = id >> 3, kc = id & 7;
    const int n = n0 + nn;
    uint4 pk;
    pk.x = pack2(tile[(kc * 8 + 0) * 65 + nn], tile[(kc * 8 + 1) * 65 + nn]);
    pk.y = pack2(tile[(kc * 8 + 2) * 65 + nn], tile[(kc * 8 + 3) * 65 + nn]);
    pk.z = pack2(tile[(kc * 8 + 4) * 65 + nn], tile[(kc * 8 + 5) * 65 + nn]);
    pk.w = pack2(tile[(kc * 8 + 6) * 65 + nn], tile[(kc * 8 + 7) * 65 + nn]);
    int drow = n;
    if (mode == 1) drow = (n >> 4) * 32 + (n & 15);
    else if (mode == 2) drow = (n >> 4) * 32 + 16 + (n & 15);
    *(uint4*)(dst + (size_t)drow * K + k0 + kc * 8) = pk;
  }
  __syncthreads();
}

template <bool UPD, bool MOD, bool FIRST, bool LASTW>
DEVI void rowop(const P& p, const bf16_t* msrc, const float* wpost, int gate_idx, const float* wpre, int shift_idx,
                int scale_idx, int layer_g, int layer_m) {
  const int lane = threadIdx.x & 63, wave = threadIdx.x >> 6;
  const float* modg = WSF(OFF_MOD) + (size_t)layer_g * 3 * 6144;
  const float* modm = WSF(OFF_MOD) + (size_t)layer_m * 3 * 6144;
  bf16_t* hbuf = WSB(OFF_H);
  for (int r = blockIdx.x * 4 + wave; r < 8192; r += gridDim.x * 4) {
    const int v = r < 4096 ? 0 : 1 + ((r - 4096) >> 11);
    const float* mvg = modg + v * 6144;
    const float* mvm = modm + v * 6144;
    float4 x[4];
    if (FIRST) {
      const float* xin = r < 4096 ? p.x_prompt + (size_t)r * 1024 : p.x_sample + (size_t)(r - 4096) * 1024;
#pragma unroll
      for (int i = 0; i < 4; ++i) x[i] = *(const float4*)(xin + lane * 4 + 256 * i);
    } else {
#pragma unroll
      for (int i = 0; i < 4; ++i) {
        const uint2 xb = *(const uint2*)(WSB(OFF_XR) + (size_t)r * 1024 + lane * 4 + 256 * i);
        x[i].x = __uint_as_float(xb.x << 16); x[i].y = __uint_as_float(xb.x & 0xffff0000u);
        x[i].z = __uint_as_float(xb.y << 16); x[i].w = __uint_as_float(xb.y & 0xffff0000u);
      }
    }
    if (UPD) {
      float4 m[4];
      float ss = 0.f;
#pragma unroll
      for (int i = 0; i < 4; ++i) {
        const uint2 mb = *(const uint2*)(msrc + (size_t)r * 1024 + lane * 4 + 256 * i);
        m[i].x = __uint_as_float(mb.x << 16); m[i].y = __uint_as_float(mb.x & 0xffff0000u);
        m[i].z = __uint_as_float(mb.y << 16); m[i].w = __uint_as_float(mb.y & 0xffff0000u);
        ss += m[i].x * m[i].x + m[i].y * m[i].y + m[i].z * m[i].z + m[i].w * m[i].w;
      }
      ss = wave_sum(ss);
      const float rs = rsqrtf(ss * (1.f / 1024.f) + 1e-6f);
#pragma unroll
      for (int i = 0; i < 4; ++i) {
        const int col = lane * 4 + 256 * i;
        const float4 wp = *(const float4*)(wpost + col);
        const float4 g = *(const float4*)(mvg + gate_idx * 1024 + col);
        x[i].x += g.x * (m[i].x * rs * wp.x);
        x[i].y += g.y * (m[i].y * rs * wp.y);
        x[i].z += g.z * (m[i].z * rs * wp.z);
        x[i].w += g.w * (m[i].w * rs * wp.w);
        if (LASTW) *(float4*)(p.out + (size_t)r * 1024 + col) = x[i];
        else {
          uint2 xo;
          xo.x = pack2(x[i].x, x[i].y);
          xo.y = pack2(x[i].z, x[i].w);
          *(uint2*)(WSB(OFF_XR) + (size_t)r * 1024 + col) = xo;
        }
      }
    }
    if (MOD) {
      float ss = 0.f;
#pragma unroll
      for (int i = 0; i < 4; ++i) ss += x[i].x * x[i].x + x[i].y * x[i].y + x[i].z * x[i].z + x[i].w * x[i].w;
      ss = wave_sum(ss);
      const float rs = rsqrtf(ss * (1.f / 1024.f) + 1e-6f);
#pragma unroll
      for (int i = 0; i < 4; ++i) {
        const int col = lane * 4 + 256 * i;
        const float4 wp = *(const float4*)(wpre + col);
        const float4 sh = *(const float4*)(mvm + shift_idx * 1024 + col);
        const float4 sc = *(const float4*)(mvm + scale_idx * 1024 + col);
        uint2 o;
        o.x = pack2(x[i].x * rs * wp.x * (1.f + sc.x) + sh.x, x[i].y * rs * wp.y * (1.f + sc.y) + sh.y);
        o.y = pack2(x[i].z * rs * wp.z * (1.f + sc.z) + sh.z, x[i].w * rs * wp.w * (1.f + sc.w) + sh.w);
        *(uint2*)(hbuf + (size_t)r * 1024 + col) = o;
      }
    }
  }
}

NOINL void prep_rows(const P& p) {
  const int lane = threadIdx.x & 63, wave = threadIdx.x >> 6;
  const float* proj = WSF(OFF_R1);
  for (int r = blockIdx.x * 4 + wave; r < 8192; r += gridDim.x * 4) {
    const float* pr = proj + (size_t)r * 2096;
    const int kvrow = r < 4096 ? r : 4096 + ((r - 4096) >> 11) * 2304 + 256 + ((r - 4096) & 2047);
    const float4 ld_cq = *(const float4*)(pr + lane * 4);
    const float4 ld_ckv = *(const float4*)(pr + 256 + lane * 4);
    const float ld_kpe = pr[512 + (lane & 31)];
    const float ld_dt = pr[2080 + (lane & 15)];
    {
      const float4 a = ld_cq;
      float ss = wave_sum(a.x * a.x + a.y * a.y + a.z * a.z + a.w * a.w);
      const float rs = rsqrtf(ss * (1.f / 256.f) + 1e-6f);
      const float4 g = *(const float4*)(p.q_norm + lane * 4);
      uint2 o;
      o.x = pack2(a.x * rs * g.x, a.y * rs * g.y);
      o.y = pack2(a.z * rs * g.z, a.w * rs * g.w);
      *(uint2*)(WSB(OFF_CQN) + (size_t)r * 256 + lane * 4) = o;
    }
    {
      const float4 a = ld_ckv;
      float ss = wave_sum(a.x * a.x + a.y * a.y + a.z * a.z + a.w * a.w);
      const float rs = rsqrtf(ss * (1.f / 256.f) + 1e-6f);
      const float4 g = *(const float4*)(p.kv_norm + lane * 4);
      float4 vv;
      vv.x = a.x * rs * g.x; vv.y = a.y * rs * g.y; vv.z = a.z * rs * g.z; vv.w = a.w * rs * g.w;
      if (r < 4096) *(float4*)(p.out + OUT_CKV + (size_t)r * 256 + lane * 4) = vv;
      uint2 o;
      o.x = pack2(vv.x, vv.y);
      o.y = pack2(vv.z, vv.w);
      *(uint2*)(WSB(OFF_CKV) + (size_t)kvrow * 256 + lane * 4) = o;
    }
    {
      const float kv = (lane < 32) ? ld_kpe : 0.f;
      const float partner = __shfl_xor(kv, 16, 64);
      if (r < 4096) {
        if (lane < 32) {
          p.out[OUT_KR + (size_t)r * 32 + lane] = kv;
          WSB(OFF_KPE)[(size_t)kvrow * 32 + lane] = f2bf(kv);
        }
      } else {
        const int t = (r - 4096) & 2047;
        const int ii = lane & 15;
        const float pos = (ii < 8) ? (float)(t >> 6) : (float)(t & 63);
        const float fr = rope_freq(ii & 7);
        const float ang = pos * fr;
        float cs, sn;
        fast_sincos(ang, sn, cs);
        const float o = (lane < 16) ? (kv * cs - partner * sn) : (partner * sn + kv * cs);
        if (lane < 32) WSB(OFF_KPE)[(size_t)kvrow * 32 + lane] = f2bf(o);
      }
    }
    if (lane < 16) {
      const int dir = lane >> 3, hh = lane & 7;
      const float raw = ld_dt + (dir ? p.dtb_b[hh] : p.dtb_f[hh]);
      const float sp = raw > 20.f ? raw : log1pf(expf(raw));
      WSF(OFF_DTV)[((size_t)dir * 8192 + r) * 8 + hh] = sp;
    }
  }
}

NOINL void prep_cache(const P& p) {
  const int gt = blockIdx.x * 256 + threadIdx.x, gs = gridDim.x * 256;
  for (int i = gt; i < 2 * 256 * 256; i += gs) {
    int b = i >> 16, rem = i & 65535;
    WSB(OFF_CKV)[(size_t)(4096 + b * 2304) * 256 + rem] = f2bf(p.cache_ckv[i]);
  }
  for (int i = gt; i < 2 * 256 * 32; i += gs) {
    int b = i >> 13, rem = i & 8191;
    WSB(OFF_KPE)[(size_t)(4096 + b * 2304) * 32 + rem] = f2bf(p.cache_kr[i]);
  }
}

NOINL void conv_tile(const P& p, int t) {
  char* smem = g_smem;
  const int tid = opaque_tid();
  float* sin_ = (float*)smem;
  float* sout = sin_ + 68 * 64;
  const int tt_ = t >> 4, ct = t & 15;
  const int r0 = tt_ * 64, c0 = ct * 64;
  int s0, s1;
  if (r0 < 4096) { s0 = r0 & ~255; s1 = s0 + 256; } else { s0 = 4096 + ((r0 - 4096) & ~2047); s1 = s0 + 2048; }
  const float* proj = WSF(OFF_R1);
  {
    const int rr0 = tid >> 6, cc = tid & 63;
    float v[17];
#pragma unroll
    for (int k = 0; k < 17; ++k) {
      const int r = r0 - 2 + rr0 + 4 * k;
      const int rc = r < s0 ? s0 : (r >= s1 ? s1 - 1 : r);
      v[k] = proj[(size_t)rc * 2096 + 1056 + c0 + cc];
    }
#pragma unroll
    for (int k = 0; k < 17; ++k) {
      const int r = r0 - 2 + rr0 + 4 * k;
      sin_[(rr0 + 4 * k) * 64 + cc] = (r >= s0 && r < s1) ? v[k] : 0.f;
    }
  }
  __syncthreads();
  {
    const int cc = tid & 63, tq = tid >> 6;
    const int c = c0 + cc;
    const float w0 = p.conv_w[c], w1 = p.conv_w[1024 + c], w2 = p.conv_w[2048 + c], w3 = p.conv_w[3072 + c],
                w4 = p.conv_w[4096 + c], bias = p.conv_b[c];
#pragma unroll 4
    for (int i = 0; i < 16; ++i) {
      const int tt = tq * 16 + i;
      float y = bias + w0 * sin_[tt * 64 + cc] + w1 * sin_[(tt + 1) * 64 + cc] + w2 * sin_[(tt + 2) * 64 + cc] +
                w3 * sin_[(tt + 3) * 64 + cc] + w4 * sin_[(tt + 4) * 64 + cc];
      y = y / (1.f + __expf(-y));
      sout[tt * 65 + cc] = y;
      const bf16_t b = f2bf(y);
      const size_t r = r0 + tt;
      if (c < 512) WSB(OFF_XS)[r * 512 + c] = b;
      else if (c < 768) WSB(OFF_BM)[r * 256 + (c - 512)] = b;
      else WSB(OFF_CM)[r * 256 + (c - 768)] = b;
    }
  }
  __syncthreads();
  if (c0 < 768) {
    const int cl = tid >> 2, q4 = tid & 3;
    uint4 o0, o1;
    const float* sp = sout + (q4 * 16) * 65 + cl;
    o0.x = pack2(sp[0 * 65], sp[1 * 65]);   o0.y = pack2(sp[2 * 65], sp[3 * 65]);
    o0.z = pack2(sp[4 * 65], sp[5 * 65]);   o0.w = pack2(sp[6 * 65], sp[7 * 65]);
    o1.x = pack2(sp[8 * 65], sp[9 * 65]);   o1.y = pack2(sp[10 * 65], sp[11 * 65]);
    o1.z = pack2(sp[12 * 65], sp[13 * 65]); o1.w = pack2(sp[14 * 65], sp[15 * 65]);
    bf16_t* dst = (c0 < 512) ? WSB(OFF_XST) + (size_t)(c0 + cl) * 8192 : WSB(OFF_BT) + (size_t)(c0 - 512 + cl) * 8192;
    dst += r0 + q4 * 16;
    *(uint4*)(dst) = o0;
    *(uint4*)(dst + 8) = o1;
  }
  __syncthreads();
}

NOINL void chunk_state_item(const P& p, int item) {
  char* smem = g_smem;
  const int tid = opaque_tid(), lane = tid & 63, wave = tid >> 6, lr = lane & 15, lg = lane >> 4;
  const int cidx = item >> 3, hh = item & 7, g = hh >> 2;
  const int r0 = cidx * 128;
  constexpr int LDS_ = 136;
  bf16_t* sAs = (bf16_t*)smem;
  bf16_t* sBs = sAs + 2 * 64 * LDS_;
  float* fa = (float*)(sBs + 128 * LDS_);
  float* fcum = fa + 256;
  float* fw = fa + 512;
  float* fdt = fa + 768;
  {
    const int dir = tid >> 7, j = tid & 127;
    const float dt = WSF(OFF_DTV)[((size_t)dir * 8192 + r0 + j) * 8 + hh];
    const float Aco = -expf(dir ? p.alog_b[hh] : p.alog_f[hh]);
    fa[tid] = dt * Aco;
    fdt[tid] = dt;
  }
  __syncthreads();
  {
    const int dir = tid >> 7, j = tid & 127;
    float s = 0.f;
    if (dir == 0) { for (int k = 0; k <= j; ++k) s += fa[k]; }
    else { for (int k = 127; k >= j; --k) s += fa[128 + k]; }
    fcum[tid] = s;
    WSF(OFF_CUM)[((size_t)dir * 8192 + r0 + j) * 8 + hh] = s;
  }
  __syncthreads();
  {
    const int dir = tid >> 7;
    const float ce = dir ? fcum[128] : fcum[127];
    fw[tid] = __expf(ce - fcum[tid]) * fdt[tid];
    if ((tid & 127) == 0) WSF(OFF_TOT)[(dir * 64 + cidx) * 8 + hh] = __expf(ce);
  }
  __syncthreads();
#pragma unroll
  for (int i = 0; i < 4; ++i) {
    const int id = tid + 256 * i;
    const int pp = id >> 4, jc = (id & 15) * 8;
    const uint4 raw = *(const uint4*)(WSB(OFF_XST) + (size_t)(hh * 64 + pp) * 8192 + r0 + jc);
    const unsigned rw[4] = {raw.x, raw.y, raw.z, raw.w};
    unsigned of[4], ob[4];
#pragma unroll
    for (int q = 0; q < 4; ++q) {
      const float x0 = __uint_as_float(rw[q] << 16), x1 = __uint_as_float(rw[q] & 0xffff0000u);
      of[q] = pack2(x0 * fw[jc + 2 * q], x1 * fw[jc + 2 * q + 1]);
      ob[q] = pack2(x0 * fw[128 + jc + 2 * q], x1 * fw[128 + jc + 2 * q + 1]);
    }
    *(uint4*)(sAs + pp * LDS_ + jc) = make_uint4(of[0], of[1], of[2], of[3]);
    *(uint4*)(sAs + 64 * LDS_ + pp * LDS_ + jc) = make_uint4(ob[0], ob[1], ob[2], ob[3]);
  }
#pragma unroll
  for (int i = 0; i < 8; ++i) {
    const int id = tid + 256 * i;
    const int nn = id >> 4, jc = (id & 15) * 8;
    *(uint4*)(sBs + nn * LDS_ + jc) = *(const uint4*)(WSB(OFF_BT) + (size_t)(g * 128 + nn) * 8192 + r0 + jc);
  }
  __syncthreads();
  {
    const int dir = wave >> 1, nh = wave & 1;
    f32x4 acc[4][4];
#pragma unroll
    for (int i = 0; i < 4; ++i)
#pragma unroll
      for (int j = 0; j < 4; ++j) acc[i][j] = (f32x4){0.f, 0.f, 0.f, 0.f};
    const bf16_t* cA = sAs + dir * 64 * LDS_ + lr * LDS_ + lg * 8;
    const bf16_t* cB = sBs + (nh * 64 + lr) * LDS_ + lg * 8;
#pragma unroll 1
    for (int ks = 0; ks < 4; ++ks) {
      bf16x8 af[4], bfr[4];
#pragma unroll
      for (int i = 0; i < 4; ++i) {
        af[i] = *(const bf16x8*)(cA + i * 16 * LDS_ + ks * 32);
        bfr[i] = *(const bf16x8*)(cB + i * 16 * LDS_ + ks * 32);
      }
#pragma unroll
      for (int i = 0; i < 4; ++i)
#pragma unroll
        for (int j = 0; j < 4; ++j) acc[i][j] = mfma16(af[i], bfr[j], acc[i][j]);
    }
    float* S = WSF(OFF_R2) + ((size_t)(dir * 64 + cidx) * 8 + hh) * 8192 + (lg * 4) * 128 + nh * 64 + lr;
#pragma unroll
    for (int i = 0; i < 4; ++i) {
#pragma unroll
      for (int q = 0; q < 4; ++q) {
#pragma unroll
        for (int j = 0; j < 4; ++j) S[j * 16] = acc[i][j][q];
        S += 128;
      }
      S += 12 * 128;
      __builtin_amdgcn_sched_barrier(0);
    }
  }
  __syncthreads();
}

template <int NB>
DEVI void scan_group(const P& p, float4& h, int dir, int cb, int nc, int c0, int hh, size_t eoff) {
  float4 sv[NB];
  float d[NB];
  size_t base[NB];
#pragma unroll
  for (int k = 0; k < NB; ++k) {
    const int c = c0 + k;
    const int cidx = cb + (dir ? nc - 1 - c : c);
    base[k] = ((size_t)(dir * 64 + cidx) * 8 + hh) * 8192 + eoff;
    d[k] = WSF(OFF_TOT)[(dir * 64 + cidx) * 8 + hh];
    sv[k] = *(const float4*)(WSF(OFF_R2) + base[k]);
  }
#pragma unroll
  for (int k = 0; k < NB; ++k) {
    uint2 o;
    o.x = pack2(h.x, h.y);
    o.y = pack2(h.z, h.w);
    *(uint2*)(WSB(OFF_H) + base[k]) = o;
    h.x = d[k] * h.x + sv[k].x; h.y = d[k] * h.y + sv[k].y; h.z = d[k] * h.z + sv[k].z; h.w = d[k] * h.w + sv[k].w;
  }
}

NOINL void scan_states(const P& p) {
  const int total = 2 * 18 * 8 * 64 * 32;
  for (int idx = blockIdx.x * 256 + threadIdx.x; idx < total; idx += gridDim.x * 256) {
    const int n4 = idx & 31, pp = (idx >> 5) & 63, hh = (idx >> 11) & 7;
    const int sd = idx >> 14;
    const int s = sd % 18, dir = sd / 18;
    const int nc = s < 16 ? 2 : 16;
    const int cb = s < 16 ? s * 2 : 32 + (s - 16) * 16;
    float4 h = make_float4(0.f, 0.f, 0.f, 0.f);
    const size_t eoff = (size_t)pp * 128 + n4 * 4;
    if (s >= 16) {
      const float* st = (dir ? p.st_b : p.st_f) + ((size_t)((s - 16) * 8 + hh) * 64 + pp) * 128 + n4 * 4;
      h = *(const float4*)st;
      scan_group<8>(p, h, dir, cb, nc, 0, hh, eoff);
      scan_group<8>(p, h, dir, cb, nc, 8, hh, eoff);
    } else {
      scan_group<2>(p, h, dir, cb, nc, 0, hh, eoff);
      float* o = p.out + (dir ? OUT_SB : OUT_SF) + ((size_t)(s * 8 + hh) * 64 + pp) * 128 + n4 * 4;
      *(float4*)o = h;
    }
  }
}

NOINL void attn_item(const P& p, int id) {
  char* smem = g_smem;
  const int tid = opaque_tid(), lane = tid & 63, wave = tid >> 6, lr = lane & 15, lg = lane >> 4;
  int row0, kvbase, Lk, hh;
  if (id < 512) { hh = id & 7; const int b = (id >> 3) & 1; const int qb = id >> 4; row0 = 4096 + b * 2048 + qb * 64; kvbase = 4096 + b * 2304; Lk = 2304; }
  else { const int i2 = id - 512; hh = i2 & 7; const int rest = i2 >> 3; const int b = rest >> 2; const int qb = rest & 3; row0 = b * 256 + qb * 64; kvbase = b * 256; Lk = 256; }
  constexpr int LDK = 104, LDV = 72;
  constexpr int KVBUF = 64 * LDK + 64 * LDV;
  bf16_t* sKV = (bf16_t*)smem;
  const int qrow = row0 + wave * 16 + lr;
  bf16x8 qf[3];
#pragma unroll
  for (int ks = 0; ks < 3; ++ks) qf[ks] = *(const bf16x8*)(WSB(OFF_Q) + (size_t)qrow * 768 + hh * 96 + ks * 32 + lg * 8);
  f32x4 oacc[4];
#pragma unroll
  for (int i = 0; i < 4; ++i) oacc[i] = (f32x4){0.f, 0.f, 0.f, 0.f};
  float mrun = -1e30f, lrun = 0.f;
  const int nkt = Lk >> 6;
  const int kkey0 = tid / 12, kcc0 = tid - kkey0 * 12;
  const int c1 = tid + 256, kkey1 = c1 / 12, kcc1 = c1 - kkey1 * 12;
  const int c2 = tid + 512, kkey2 = c2 / 12, kcc2 = c2 - kkey2 * 12;
  const bf16_t* kn = WSB(OFF_KN);
  const bf16_t* kp = WSB(OFF_KPE);
  const bf16_t* ksrc0 = (kcc0 < 8) ? kn + (size_t)(kvbase + kkey0) * 512 + hh * 64 + kcc0 * 8 : kp + (size_t)(kvbase + kkey0) * 32 + (kcc0 - 8) * 8;
  const bf16_t* ksrc1 = (kcc1 < 8) ? kn + (size_t)(kvbase + kkey1) * 512 + hh * 64 + kcc1 * 8 : kp + (size_t)(kvbase + kkey1) * 32 + (kcc1 - 8) * 8;
  const bf16_t* ksrc2 = (kcc2 < 8) ? kn + (size_t)(kvbase + kkey2) * 512 + hh * 64 + kcc2 * 8 : kp + (size_t)(kvbase + kkey2) * 32 + (kcc2 - 8) * 8;
  const int kst0 = (kcc0 < 8) ? 512 * 64 : 32 * 64, kst1 = (kcc1 < 8) ? 512 * 64 : 32 * 64, kst2 = (kcc2 < 8) ? 512 * 64 : 32 * 64;
  const int vd0 = tid >> 3, vcc = tid & 7;
  const bf16_t* vsrc0 = WSB(OFF_VT) + (size_t)(hh * 64 + vd0) * 8704 + kvbase + vcc * 8;
  const bf16_t* vsrc1 = vsrc0 + (size_t)32 * 8704;
  uint4 rk0, rk1, rk2, rv0, rv1;
#define AT_LOAD(kt) { const int _k = (kt); \
    rk0 = *(const uint4*)(ksrc0 + (size_t)_k * kst0); rk1 = *(const uint4*)(ksrc1 + (size_t)_k * kst1); \
    rk2 = *(const uint4*)(ksrc2 + (size_t)_k * kst2); \
    rv0 = *(const uint4*)(vsrc0 + _k * 64); rv1 = *(const uint4*)(vsrc1 + _k * 64); }
#define AT_WRITE(buf) { bf16_t* _b = sKV + (buf) * KVBUF; \
    *(uint4*)(_b + kkey0 * LDK + kcc0 * 8) = rk0; *(uint4*)(_b + kkey1 * LDK + kcc1 * 8) = rk1; \
    *(uint4*)(_b + kkey2 * LDK + kcc2 * 8) = rk2; \
    *(uint4*)(_b + 64 * LDK + vd0 * LDV + vcc * 8) = rv0; *(uint4*)(_b + 64 * LDK + (vd0 + 32) * LDV + vcc * 8) = rv1; }
  AT_LOAD(0)
  AT_WRITE(0)
  __syncthreads();
  for (int kt = 0; kt < nkt; ++kt) {
    const int ktn = min(kt + 1, nkt - 1);
    AT_LOAD(ktn)
    const bf16_t* sK = sKV + (kt & 1) * KVBUF;
    const bf16_t* sV = sK + 64 * LDK;
    f32x4 sacc[4];
#pragma unroll
    for (int n = 0; n < 4; ++n) sacc[n] = (f32x4){0.f, 0.f, 0.f, 0.f};
#pragma unroll
    for (int ks = 0; ks < 3; ++ks)
#pragma unroll
      for (int n = 0; n < 4; ++n) {
        const bf16x8 a = *(const bf16x8*)(sK + (n * 16 + lr) * LDK + ks * 32 + lg * 8);
        sacc[n] = mfma16(a, qf[ks], sacc[n]);
      }
    float mx = sacc[0][0];
#pragma unroll
    for (int n = 0; n < 4; ++n)
#pragma unroll
      for (int q = 0; q < 4; ++q) mx = fmaxf(mx, sacc[n][q]);
    mx = quad_max(mx);
    const float mnew = fmaxf(mrun, mx);
    const float alpha = __builtin_amdgcn_exp2f(mrun - mnew);
    mrun = mnew;
    float ps = 0.f;
#pragma unroll
    for (int n = 0; n < 4; ++n)
#pragma unroll
      for (int q = 0; q < 4; ++q) { const float e = __builtin_amdgcn_exp2f(sacc[n][q] - mnew); sacc[n][q] = e; ps += e; }
    lrun = lrun * alpha + ps;
#pragma unroll
    for (int i = 0; i < 4; ++i)
#pragma unroll
      for (int q = 0; q < 4; ++q) oacc[i][q] *= alpha;
#pragma unroll
    for (int ks = 0; ks < 2; ++ks) {
      union { bf16x8 v; unsigned u[4]; } pf;
      pf.u[0] = pack2(sacc[2 * ks][0], sacc[2 * ks][1]);
      pf.u[1] = pack2(sacc[2 * ks][2], sacc[2 * ks][3]);
      pf.u[2] = pack2(sacc[2 * ks + 1][0], sacc[2 * ks + 1][1]);
      pf.u[3] = pack2(sacc[2 * ks + 1][2], sacc[2 * ks + 1][3]);
#pragma unroll
      for (int m = 0; m < 4; ++m) {
        union { bf16x8 v; uint2 h[2]; } av;
        const bf16_t* vp = sV + (m * 16 + lr) * LDV + ks * 32 + lg * 4;
        av.h[0] = *(const uint2*)(vp);
        av.h[1] = *(const uint2*)(vp + 16);
        oacc[m] = mfma16(av.v, pf.v, oacc[m]);
      }
    }
    __builtin_amdgcn_sched_barrier(0);
    AT_WRITE((kt + 1) & 1)
    __syncthreads();
  }
  lrun = quad_sum(lrun);
  const float inv = 1.f / lrun;
#pragma unroll
  for (int m = 0; m < 4; ++m) {
    uint2 o;
    o.x = pack2(oacc[m][0] * inv, oacc[m][1] * inv);
    o.y = pack2(oacc[m][2] * inv, oacc[m][3] * inv);
    *(uint2*)(WSB(OFF_CAT) + (size_t)qrow * 1024 + hh * 64 + m * 16 + lg * 4) = o;
  }
}

NOINL void ssd_y_item(const P& p, int item) {
  char* smem = g_smem;
  const int tid = opaque_tid(), lane = tid & 63, wave = tid >> 6, lr = lane & 15, lg = lane >> 4;
  const int cidx = item >> 3, qt = (item >> 1) & 3, half = qt >> 1, g = item & 1;
  const int r0 = cidx * 128;
  const int hh = g * 4 + wave;
  constexpr int LDC = 136, LDM = 72;
  bf16_t* sC = (bf16_t*)smem;
  bf16_t* sB = sC + 64 * LDC;
  bf16_t* sM = sB + 64 * LDC + wave * 64 * LDM;
  float* rowss = (float*)((bf16_t*)smem + 2 * 64 * LDC + 4 * 64 * LDM);
  const float* cum = WSF(OFF_CUM);
  const float* dtv = WSF(OFF_DTV);
  const int srow = tid >> 4, scol = (tid & 15) * 8;
  uint4 pb0, pb1, pb2, pb3;
  {
    const bf16_t* cs = WSB(OFF_CM) + (size_t)(r0 + qt * 32 + srow) * 256 + g * 128 + scol;
    const bf16_t* bs = WSB(OFF_BM) + (size_t)(r0 + srow) * 256 + g * 128 + scol;
    const uint4 c0 = *(const uint4*)(cs), c1 = *(const uint4*)(cs + 16 * 256);
    const uint4 b0 = *(const uint4*)(bs), b1 = *(const uint4*)(bs + 16 * 256), b2 = *(const uint4*)(bs + 32 * 256), b3 = *(const uint4*)(bs + 48 * 256);
    pb0 = *(const uint4*)(bs + 64 * 256); pb1 = *(const uint4*)(bs + 80 * 256); pb2 = *(const uint4*)(bs + 96 * 256); pb3 = *(const uint4*)(bs + 112 * 256);
    bf16_t* wc = sC + srow * LDC + scol;
    bf16_t* wb = sB + srow * LDC + scol;
    *(uint4*)(wc) = c0; *(uint4*)(wc + 16 * LDC) = c1;
    *(uint4*)(wb) = b0; *(uint4*)(wb + 16 * LDC) = b1; *(uint4*)(wb + 32 * LDC) = b2; *(uint4*)(wb + 48 * LDC) = b3;
  }
  __syncthreads();
  f32x4 Y[2][4];
#pragma unroll
  for (int i = 0; i < 2; ++i)
#pragma unroll
    for (int j = 0; j < 4; ++j) Y[i][j] = (f32x4){0.f, 0.f, 0.f, 0.f};
#pragma unroll 1
  for (int jh = 0; jh < 2; ++jh) {
    if (jh == 1) {
      __syncthreads();
      bf16_t* wb = sB + srow * LDC + scol;
      *(uint4*)(wb) = pb0; *(uint4*)(wb + 16 * LDC) = pb1; *(uint4*)(wb + 32 * LDC) = pb2; *(uint4*)(wb + 48 * LDC) = pb3;
      __syncthreads();
    }
#pragma unroll 1
    for (int dir = 0; dir < 2; ++dir) {
      const bool use = dir == 0 ? (jh <= half) : (jh >= half);
      if (!use) continue;
      bf16x8 xf[2][4];
#pragma unroll
      for (int ks = 0; ks < 2; ++ks)
#pragma unroll
        for (int pt = 0; pt < 4; ++pt)
          xf[ks][pt] = *(const bf16x8*)(WSB(OFF_XST) + (size_t)(hh * 64 + pt * 16 + lr) * 8192 + r0 + jh * 64 + ks * 32 + lg * 8);
      float ci[2], cj[4][4], dj[4][4];
#pragma unroll
      for (int it = 0; it < 2; ++it) ci[it] = cum[((size_t)dir * 8192 + r0 + qt * 32 + it * 16 + lr) * 8 + hh];
#pragma unroll
      for (int jt = 0; jt < 4; ++jt)
#pragma unroll
        for (int q = 0; q < 4; ++q) {
          const size_t tj = (size_t)dir * 8192 + r0 + jh * 64 + jt * 16 + lg * 4 + q;
          cj[jt][q] = cum[tj * 8 + hh];
          dj[jt][q] = dtv[tj * 8 + hh];
        }
#pragma unroll
      for (int it = 0; it < 2; ++it) {
        f32x4 cb[4];
#pragma unroll
        for (int jt = 0; jt < 4; ++jt) cb[jt] = (f32x4){0.f, 0.f, 0.f, 0.f};
#pragma unroll
        for (int ks = 0; ks < 4; ++ks) {
          const bf16x8 b = *(const bf16x8*)(sC + (it * 16 + lr) * LDC + ks * 32 + lg * 8);
#pragma unroll
          for (int jt = 0; jt < 4; ++jt) {
            const bf16x8 a = *(const bf16x8*)(sB + (jt * 16 + lr) * LDC + ks * 32 + lg * 8);
            cb[jt] = mfma16(a, b, cb[jt]);
          }
        }
        const int ti = qt * 32 + it * 16 + lr;
#pragma unroll
        for (int jt = 0; jt < 4; ++jt) {
          float v[4];
#pragma unroll
          for (int q = 0; q < 4; ++q) {
            const int tj = jh * 64 + jt * 16 + lg * 4 + q;
            const bool ok = dir == 0 ? (tj <= ti) : (tj >= ti);
            v[q] = ok ? cb[jt][q] * __expf(ci[it] - cj[jt][q]) * dj[jt][q] : 0.f;
          }
          uint2 o;
          o.x = pack2(v[0], v[1]);
          o.y = pack2(v[2], v[3]);
          *(uint2*)(sM + (it * 16 + lr) * LDM + jt * 16 + lg * 4) = o;
        }
        __builtin_amdgcn_sched_barrier(0);
      }
      asm volatile("s_waitcnt lgkmcnt(0)" ::: "memory");
#pragma unroll
      for (int ks = 0; ks < 2; ++ks) {
        bf16x8 af[2];
#pragma unroll
        for (int it = 0; it < 2; ++it) af[it] = *(const bf16x8*)(sM + (it * 16 + lr) * LDM + ks * 32 + lg * 8);
#pragma unroll
        for (int it = 0; it < 2; ++it)
#pragma unroll
          for (int pt = 0; pt < 4; ++pt) Y[it][pt] = mfma16(af[it], xf[ks][pt], Y[it][pt]);
      }
      asm volatile("s_waitcnt lgkmcnt(0)" ::: "memory");
      __builtin_amdgcn_sched_barrier(0);
    }
  }
#pragma unroll 1
  for (int dir = 0; dir < 2; ++dir) {
    const bf16_t* hp = WSB(OFF_H) + ((size_t)(dir * 64 + cidx) * 8 + hh) * 8192;
    float ei[2][4];
#pragma unroll
    for (int it = 0; it < 2; ++it)
#pragma unroll
      for (int q = 0; q < 4; ++q)
        ei[it][q] = __expf(cum[((size_t)dir * 8192 + r0 + qt * 32 + it * 16 + lg * 4 + q) * 8 + hh]);
#pragma unroll
    for (int pt = 0; pt < 4; ++pt) {
      bf16x8 bfr[4];
#pragma unroll
      for (int ks = 0; ks < 4; ++ks) bfr[ks] = *(const bf16x8*)(hp + (size_t)(pt * 16 + lr) * 128 + ks * 32 + lg * 8);
      f32x4 T[2];
#pragma unroll
      for (int it = 0; it < 2; ++it) T[it] = (f32x4){0.f, 0.f, 0.f, 0.f};
#pragma unroll
      for (int ks = 0; ks < 4; ++ks)
#pragma unroll
        for (int it = 0; it < 2; ++it) {
          const bf16x8 a = *(const bf16x8*)(sC + (it * 16 + lr) * LDC + ks * 32 + lg * 8);
          T[it] = mfma16(a, bfr[ks], T[it]);
        }
#pragma unroll
      for (int it = 0; it < 2; ++it)
#pragma unroll
        for (int q = 0; q < 4; ++q) Y[it][pt][q] += ei[it][q] * T[it][q];
    }
    __builtin_amdgcn_sched_barrier(0);
  }
  const float dsk = p.ssd_d[hh];
  const float* proj = WSF(OFF_R1);
#pragma unroll
  for (int i = 0; i < 2; ++i) {
#pragma unroll
    for (int q = 0; q < 4; ++q) {
      const int il = i * 16 + lg * 4 + q;
      const size_t r = (size_t)r0 + qt * 32 + il;
      float ss = 0.f;
#pragma unroll
      for (int j = 0; j < 4; ++j) {
        const int ch = hh * 64 + j * 16 + lr;
        const float xs = bf2f(WSB(OFF_XS)[r * 512 + ch]);
        const float z = proj[r * 2096 + 544 + ch];
        const float y = (Y[i][j][q] + dsk * xs) * silu(z);
        Y[i][j][q] = y;
        ss += y * y;
      }
      ss += __shfl_xor(ss, 1, 64);
      ss += __shfl_xor(ss, 2, 64);
      ss += __shfl_xor(ss, 4, 64);
      ss += __shfl_xor(ss, 8, 64);
      if (lr == 0) rowss[wave * 64 + il] = ss;
    }
    __builtin_amdgcn_sched_barrier(0);
  }
  __syncthreads();
#pragma unroll
  for (int i = 0; i < 2; ++i) {
#pragma unroll
    for (int q = 0; q < 4; ++q) {
      const int il = i * 16 + lg * 4 + q;
      const size_t r = (size_t)r0 + qt * 32 + il;
      const float tot = rowss[il] + rowss[64 + il] + rowss[128 + il] + rowss[192 + il];
      const float rs = rsqrtf(tot * (1.f / 256.f) + 1e-6f);
#pragma unroll
      for (int j = 0; j < 4; ++j) {
        const int ch = hh * 64 + j * 16 + lr;
        WSB(OFF_CAT)[r * 1024 + 512 + ch] = f2bf(Y[i][j][q] * rs * p.ssd_norm[ch]);
      }
    }
    __builtin_amdgcn_sched_barrier(0);
  }
  __syncthreads();
}

template <int W2>
DEVI void pool_item(const bf16_t* __restrict__ h, bf16_t* __restrict__ dst, int r, int cc) {
  int s0, L;
  if (r < 4096) { s0 = r & ~255; L = 256; } else { s0 = 4096 + ((r - 4096) & ~2047); L = 2048; }
  const int t = r - s0;
  const int lo = max(t - W2, 0), hi = min(t + W2, L);
  uint4 v[2 * W2];
#pragma unroll
  for (int k = 0; k < 2 * W2; ++k) {
    const int u = min(max(t - W2 + k, 0), L - 1);
    v[k] = *(const uint4*)(h + (size_t)(s0 + u) * 1024 + cc);
  }
  float acc[8] = {0, 0, 0, 0, 0, 0, 0, 0};
#pragma unroll
  for (int k = 0; k < 2 * W2; ++k) {
    const int u = t - W2 + k;
    const float m = (u >= 0 && u < L) ? 1.f : 0.f;
    acc[0] += m * __uint_as_float(v[k].x << 16); acc[1] += m * __uint_as_float(v[k].x & 0xffff0000u);
    acc[2] += m * __uint_as_float(v[k].y << 16); acc[3] += m * __uint_as_float(v[k].y & 0xffff0000u);
    acc[4] += m * __uint_as_float(v[k].z << 16); acc[5] += m * __uint_as_float(v[k].z & 0xffff0000u);
    acc[6] += m * __uint_as_float(v[k].w << 16); acc[7] += m * __uint_as_float(v[k].w & 0xffff0000u);
  }
  const float inv = 1.f / (float)(hi - lo);
  const uint4 c = v[W2];
  uint4 o;
  o.x = pack2(acc[0] * inv - __uint_as_float(c.x << 16), acc[1] * inv - __uint_as_float(c.x & 0xffff0000u));
  o.y = pack2(acc[2] * inv - __uint_as_float(c.y << 16), acc[3] * inv - __uint_as_float(c.y & 0xffff0000u));
  o.z = pack2(acc[4] * inv - __uint_as_float(c.z << 16), acc[5] * inv - __uint_as_float(c.z & 0xffff0000u));
  o.w = pack2(acc[6] * inv - __uint_as_float(c.w << 16), acc[7] * inv - __uint_as_float(c.w & 0xffff0000u));
  *(uint4*)(dst + (size_t)r * 1024 + cc) = o;
}

NOINL void pool_phase(const P& p) {
  const bf16_t* h = WSB(OFF_H);
  bf16_t* dst = WSB(OFF_CAT);
  const int total = 8192 * 128;
  for (int idx = blockIdx.x * 256 + threadIdx.x; idx < total; idx += gridDim.x * 256) {
    const int c32 = idx & 31, rlo = (idx >> 5) & 1, gi = (idx >> 6) & 3, rhi = idx >> 8;
    const int r = rhi * 2 + rlo, cc = gi * 256 + c32 * 8;
    if (gi == 0) pool_item<1>(h, dst, r, cc);
    else if (gi == 1) pool_item<2>(h, dst, r, cc);
    else if (gi == 2) pool_item<4>(h, dst, r, cc);
    else pool_item<8>(h, dst, r, cc);
  }
}

NOINL void ph_gemm_proj(const P& p) {
  float* proj = WSF(OFF_R1);
  const bf16_t* A = WSB(OFF_H);
  const bf16_t* B = WSB(OFF_WIN);
  gemm_stream(64 * 17, 1024, 1024, 1024, g_smem,
    [=](int t) {
      TileInfo r;
      int m, n; tile_mn(t, 64, 17, m, n);
      r.m0 = m * 128; r.n0 = n * 128; r.ctx = 0;
      r.a = A + (size_t)r.m0 * 1024; r.b = B + (size_t)r.n0 * 1024;
      return r;
    },
    [&](int ctx, int row, int col, f32x4 v0, f32x4 v1) {
#pragma unroll
      for (int q = 0; q < 4; ++q) {
        if (col < 2096) proj[(size_t)(row + q) * 2096 + col] = v0[q];
        if (col + 16 < 2096) proj[(size_t)(row + q) * 2096 + col + 16] = v1[q];
      }
    });
}

NOINL void ph_gemm_f32out(const P& p, const bf16_t* A, int lda, const bf16_t* B, int ldb, int K, bf16_t* C, int N) {
  const int nN = N / 128;
  gemm_stream(64 * nN, lda, ldb, K, g_smem,
    [=](int t) {
      TileInfo r;
      int m, n; tile_mn(t, 64, nN, m, n);
      r.m0 = m * 128; r.n0 = n * 128; r.ctx = 0;
      r.a = A + (size_t)r.m0 * lda; r.b = B + (size_t)r.n0 * ldb;
      return r;
    },
    [&](int ctx, int row, int col, f32x4 v0, f32x4 v1) {
#pragma unroll
      for (int q = 0; q < 4; ++q) {
        C[(size_t)(row + q) * N + col] = f2bf(v0[q]);
        C[(size_t)(row + q) * N + col + 16] = f2bf(v1[q]);
      }
    });
}

NOINL void ph_gemm_q(const P& p) {
  bf16_t* qo = WSB(OFF_Q);
  const bf16_t* A = WSB(OFF_CQN);
  const bf16_t* B = WSB(OFF_WUQ);
  gemm_stream(64 * 6, 256, 256, 256, g_smem,
    [=](int t) {
      TileInfo r;
      int m, n; tile_mn(t, 64, 6, m, n);
      r.m0 = m * 128; r.n0 = n * 128; r.ctx = 0;
      r.a = A + (size_t)r.m0 * 256; r.b = B + (size_t)r.n0 * 256;
      return r;
    },
    [&](int ctx, int row, int col, f32x4 v0, f32x4 v1) {
      const float scl = 0.10206207261596575f * 1.4426950408889634f;
      const int tn = col >> 4;
      const bool rope = ((tn % 6) == 4) && (row >= 4096);
      const int ii = col & 15;
      const float fr = rope_freq(ii & 7);
#pragma unroll
      for (int q = 0; q < 4; ++q) {
        float a = v0[q], b = v1[q];
        if (rope) {
          const int tt = (row + q - 4096) & 2047;
          const float pos = (ii < 8) ? (float)(tt >> 6) : (float)(tt & 63);
          const float ang = pos * fr;
          float cs, sn;
          fast_sincos(ang, sn, cs);
          const float x1 = a, x2 = b;
          a = x1 * cs - x2 * sn;
          b = x1 * sn + x2 * cs;
        }
        qo[(size_t)(row + q) * 768 + col] = f2bf(a * scl);
        qo[(size_t)(row + q) * 768 + col + 16] = f2bf(b * scl);
      }
    });
}

NOINL void ph_gemm_kv(const P& p) {
  bf16_t* kn = WSB(OFF_KN);
  bf16_t* vt = WSB(OFF_VT);
  const bf16_t* A = WSB(OFF_CKV);
  const bf16_t* B = WSB(OFF_WUKV);
  gemm_stream(68 * 8, 256, 256, 256, g_smem,
    [=](int t) {
      TileInfo r;
      int m, n; tile_mn(t, 68, 8, m, n);
      r.m0 = m * 128; r.n0 = n * 128; r.ctx = 0;
      r.a = A + (size_t)r.m0 * 256; r.b = B + (size_t)r.n0 * 256;
      return r;
    },
    [&](int ctx, int row, int col, f32x4 v0, f32x4 v1) {
      const int hh = col >> 7, j = col & 127;
      if (j < 64) {
#pragma unroll
        for (int q = 0; q < 4; ++q) {
          kn[(size_t)(row + q) * 512 + hh * 64 + j] = f2bf(v0[q]);
          kn[(size_t)(row + q) * 512 + hh * 64 + j + 16] = f2bf(v1[q]);
        }
      } else {
        uint2 o0, o1;
        o0.x = pack2(v0[0], v0[1]); o0.y = pack2(v0[2], v0[3]);
        o1.x = pack2(v1[0], v1[1]); o1.y = pack2(v1[2], v1[3]);
        *(uint2*)(vt + (size_t)(hh * 64 + j - 64) * 8704 + row) = o0;
        *(uint2*)(vt + (size_t)(hh * 64 + j - 64 + 16) * 8704 + row) = o1;
      }
    });
}

NOINL void ph_gemm_ffn_up(const P& p, int layer) {
  bf16_t* gu = WSB(OFF_R1);
  const bf16_t* A = WSB(OFF_H);
  const bf16_t* B = WSB(OFF_WGU) + (size_t)layer * 5632 * 1024;
  gemm_stream(64 * 44, 1024, 1024, 1024, g_smem,
    [=](int t) {
      TileInfo r;
      int m, n; tile_mn(t, 64, 44, m, n);
      r.m0 = m * 128; r.n0 = n * 128; r.ctx = 0;
      r.a = A + (size_t)r.m0 * 1024; r.b = B + (size_t)r.n0 * 1024;
      return r;
    },
    [&](int ctx, int row, int col, f32x4 v0, f32x4 v1) {
      const int oc = (col >> 5) * 16 + (col & 15);
#pragma unroll
      for (int q = 0; q < 4; ++q) gu[(size_t)(row + q) * 2816 + oc] = f2bf(silu(v0[q]) * v1[q]);
    });
}

NOINL void ph_gemm_pool(const P& p) {
  bf16_t* mix = WSB(OFF_R1);
  const bf16_t* A = WSB(OFF_CAT);
  const bf16_t* B = WSB(OFF_WPOOL);
  gemm_stream(512, 1024, 256, 256, g_smem,
    [=](int t) {
      TileInfo r;
      const int id = swz_tile(t, 512);
      const int g = id >> 7, rem = id & 127;
      r.m0 = (rem >> 1) * 128; r.n0 = (rem & 1) * 128; r.ctx = g;
      r.a = A + (size_t)r.m0 * 1024 + g * 256; r.b = B + (size_t)g * 65536 + (size_t)r.n0 * 256;
      return r;
    },
    [&](int g, int row, int col, f32x4 v0, f32x4 v1) {
      const int c0 = g * 256 + col;
      const float s0 = p.pool_scale[c0], s1 = p.pool_scale[c0 + 16];
#pragma unroll
      for (int q = 0; q < 4; ++q) {
        mix[(size_t)(row + q) * 1024 + c0] = f2bf(v0[q] * s0);
        mix[(size_t)(row + q) * 1024 + c0 + 16] = f2bf(v1[q] * s1);
      }
    });
}


#define XB_TMO      128
#define XB_XCNT(j)  (256  + 64 * (j))
#define XB_XSUB(j)  (1280 + 64 * (j))
#define XB_XGEN(j)  (2304 + 64 * (j))
#define XB_TOP      3328
#define XB_TOPGEN   3392
#define XCD_BAR_WORDS 3456
#define XB_SPIN_CAP (1u << 22)
#define LAS __attribute__((address_space(3)))
DEVI unsigned xb_ld(unsigned* p) { return __hip_atomic_load(p, __ATOMIC_RELAXED, __HIP_MEMORY_SCOPE_AGENT); }
DEVI unsigned xb_add(unsigned* p, unsigned v) { return __hip_atomic_fetch_add(p, v, __ATOMIC_RELAXED, __HIP_MEMORY_SCOPE_AGENT); }
DEVI unsigned xb_xcc_id() { return (unsigned)__builtin_amdgcn_s_getreg((3 << 11) | 20) & 0xFu; }
#define XB_SPIN(cond, bar) do { unsigned _sp = 0; while (cond) { __builtin_amdgcn_s_sleep(1); \
    if ((++_sp & 255u) == 0u) { if (xb_ld(&(bar)[XB_TMO])) break; if (_sp > XB_SPIN_CAP) { atomicAdd(&(bar)[XB_TMO], 1u); break; } } } } while (0)
struct XcdBarrier { unsigned* bar; unsigned x; volatile LAS unsigned* st; };
DEVI XcdBarrier xcd_barrier_post(unsigned* bar, volatile LAS unsigned* st) {
  XcdBarrier b; b.bar = bar; b.x = xb_xcc_id(); b.st = st;
  if (threadIdx.x == 0) (void)xb_add(&bar[XB_XCNT(b.x)], 1u);
  return b;
}
DEVI void xcd_barrier_complete(unsigned* bar, unsigned x, unsigned& nloc, unsigned& nx) {
  const unsigned G = gridDim.x * gridDim.y * gridDim.z;
  unsigned sum, cnt, mine, sp = 0u;
  for (;;) {
    sum = 0u; cnt = 0u; mine = 0u;
#pragma unroll
    for (unsigned j = 0; j < 16; ++j) { const unsigned c = xb_ld(&bar[XB_XCNT(j)]); sum += c; cnt += (c > 0u) ? 1u : 0u; mine = (j == x) ? c : mine; }
    if (sum == G) break;
    __builtin_amdgcn_s_sleep(1);
    if ((++sp & 255u) == 0u) { if (xb_ld(&bar[XB_TMO])) break; if (sp > XB_SPIN_CAP) { atomicAdd(&bar[XB_TMO], 1u); break; } }
  }
  nloc = mine > 0u ? mine : 1u; nx = cnt > 0u ? cnt : 1u;
}
DEVI void xcd_barrier(const XcdBarrier& b) {
  asm volatile("s_waitcnt vmcnt(0)" ::: "memory");
  __syncthreads();
  if (threadIdx.x == 0) {
    unsigned* bar = b.bar;
    __builtin_amdgcn_s_waitcnt(0);
    unsigned nloc = b.st[0], nx = b.st[1];
    if (nloc == 0u) { xcd_barrier_complete(bar, b.x, nloc, nx); b.st[0] = nloc; b.st[1] = nx; }
    const unsigned old = xb_add(&bar[XB_XSUB(b.x)], 1u);
    const unsigned gen = old / nloc;
    if (old + 1u == (gen + 1u) * nloc) {
      __builtin_amdgcn_fence(__ATOMIC_RELEASE, "agent");
      asm volatile("s_waitcnt vmcnt(0)" ::: "memory");
      const unsigned og = xb_add(&bar[XB_TOP], 1u);
      const unsigned tg = og / nx;
      if (og + 1u == (tg + 1u) * nx) xb_add(&bar[XB_TOPGEN], 1u);
      else XB_SPIN(xb_ld(&bar[XB_TOPGEN]) == tg, bar);
      __builtin_amdgcn_fence(__ATOMIC_ACQUIRE, "agent");
      xb_add(&bar[XB_XGEN(b.x)], 1u);
      asm volatile("s_waitcnt vmcnt(0)" ::: "memory");
    } else {
      XB_SPIN(xb_ld(&bar[XB_XGEN(b.x)]) == gen, bar);
      __builtin_amdgcn_fence(__ATOMIC_ACQUIRE, "agent");
      asm volatile("s_waitcnt vmcnt(0)" ::: "memory");
    }
  }
  __syncthreads();
}

constexpr int NPHASE = 18;
#ifndef REPMASK
#define REPMASK 0
#endif
#ifndef P6PROBE
#define P6PROBE 1
#endif
#ifndef PHMASK
#define PHMASK 0x3ffff
#endif
#define PH(n) if constexpr ((PHMASK >> (n)) & 1)

__global__ void __launch_bounds__(256, 2) mega(P p, int lo, int hi) {
  __shared__ uint4 xb_words;
  if (threadIdx.x == 0) xb_words = make_uint4(0u, 0u, 0u, 0u);
  __syncthreads();
  XcdBarrier xb = xcd_barrier_post((unsigned*)(p.ws + OFF_BAR), (volatile LAS unsigned*)&xb_words);
  if (lo < 0) cg::this_grid().sync();
  PH(0) if (lo <= 0 && 0 < hi) {
#if (REPMASK >> 0) & 1
    int nrep = 2; asm volatile("" : "+s"(nrep));
    for (int rep = 0; rep < nrep; ++rep) {
      if (rep) xcd_barrier(xb);
#else
    {
#endif
        for (int t = blockIdx.x; t < 384 + 5200; t += gridDim.x) {
          if (t < 384) gemv_tile(p, t); else transpose_tile(p, t - 384);
        }
    }
  }
  if (lo <= 0 && 0 + 1 < hi) xcd_barrier(xb);
  PH(1) if (lo <= 1 && 1 < hi) {
#if (REPMASK >> 1) & 1
    int nrep = 2; asm volatile("" : "+s"(nrep));
    for (int rep = 0; rep < nrep; ++rep) {
      if (rep) xcd_barrier(xb);
#else
    {
#endif
        rowop<false, true, true, false>(p, nullptr, nullptr, 0, p.n_pre_mix, 0, 1, 0, 0);
    }
  }
  if (lo <= 1 && 1 + 1 < hi) xcd_barrier(xb);
  PH(2) if (lo <= 2 && 2 < hi) {
#if (REPMASK >> 2) & 1
    int nrep = 2; asm volatile("" : "+s"(nrep));
    for (int rep = 0; rep < nrep; ++rep) {
      if (rep) xcd_barrier(xb);
#else
    {
#endif
        ph_gemm_proj(p);
    }
  }
  if (lo <= 2 && 2 + 1 < hi) xcd_barrier(xb);
  PH(3) if (lo <= 3 && 3 < hi) {
#if (REPMASK >> 3) & 1
    int nrep = 2; asm volatile("" : "+s"(nrep));
    for (int rep = 0; rep < nrep; ++rep) {
      if (rep) xcd_barrier(xb);
#else
    {
#endif
        prep_rows(p);
        prep_cache(p);
        for (int t = blockIdx.x; t < 2048; t += gridDim.x) conv_tile(p, t);
    }
  }
  if (lo <= 3 && 3 + 1 < hi) xcd_barrier(xb);
  PH(4) if (lo <= 4 && 4 < hi) {
#if (REPMASK >> 4) & 1
    int nrep = 2; asm volatile("" : "+s"(nrep));
    for (int rep = 0; rep < nrep; ++rep) {
      if (rep) xcd_barrier(xb);
#else
    {
#endif
        ph_gemm_q(p);
        ph_gemm_kv(p);
        for (int t = blockIdx.x; t < 512; t += gridDim.x) chunk_state_item(p, t);
    }
  }
  if (lo <= 4 && 4 + 1 < hi) xcd_barrier(xb);
  PH(5) if (lo <= 5 && 5 < hi) {
#if (REPMASK >> 5) & 1
    int nrep = 2; asm volatile("" : "+s"(nrep));
    for (int rep = 0; rep < nrep; ++rep) {
      if (rep) xcd_barrier(xb);
#else
    {
#endif
        scan_states(p);
    }
  }
  if (lo <= 5 && 5 + 1 < hi) xcd_barrier(xb);
  PH(6) if (lo <= 6 && 6 < hi) {
#if (REPMASK >> 6) & 1
    int nrep = 2; asm volatile("" : "+s"(nrep));
    for (int rep = 0; rep < nrep; ++rep) {
      if (rep) xcd_barrier(xb);
#else
    {
#endif
        for (int t = blockIdx.x; t < 1024; t += gridDim.x) {
          if (t >= 512) ssd_y_item(p, t - 512);
          attn_item(p, t);
        }
    }
  }
  if (lo <= 6 && 6 + 1 < hi) xcd_barrier(xb);
  PH(7) if (lo <= 7 && 7 < hi) {
#if (REPMASK >> 7) & 1
    int nrep = 2; asm volatile("" : "+s"(nrep));
    for (int rep = 0; rep < nrep; ++rep) {
      if (rep) xcd_barrier(xb);
#else
    {
#endif
        ph_gemm_f32out(p, WSB(OFF_CAT), 1024, WSB(OFF_WOUT), 1024, 1024, WSB(OFF_R1), 1024);
    }
  }
  if (lo <= 7 && 7 + 1 < hi) xcd_barrier(xb);
  PH(8) if (lo <= 8 && 8 < hi) {
#if (REPMASK >> 8) & 1
    int nrep = 2; asm volatile("" : "+s"(nrep));
    for (int rep = 0; rep < nrep; ++rep) {
      if (rep) xcd_barrier(xb);
#else
    {
#endif
        rowop<true, true, true, false>(p, WSB(OFF_R1), p.n_post_mix, 2, p.n_pre_ffn, 3, 4, 0, 0);
    }
  }
  if (lo <= 8 && 8 + 1 < hi) xcd_barrier(xb);
  PH(9) if (lo <= 9 && 9 < hi) {
#if (REPMASK >> 9) & 1
    int nrep = 2; asm volatile("" : "+s"(nrep));
    for (int rep = 0; rep < nrep; ++rep) {
      if (rep) xcd_barrier(xb);
#else
    {
#endif
        ph_gemm_ffn_up(p, 0);
    }
  }
  if (lo <= 9 && 9 + 1 < hi) xcd_barrier(xb);
  PH(10) if (lo <= 10 && 10 < hi) {
#if (REPMASK >> 10) & 1
    int nrep = 2; asm volatile("" : "+s"(nrep));
    for (int rep = 0; rep < nrep; ++rep) {
      if (rep) xcd_barrier(xb);
#else
    {
#endif
        ph_gemm_f32out(p, WSB(OFF_R1), 2816, WSB(OFF_WDN), 2816, 2816, WSB(OFF_R2), 1024);
    }
  }
  if (lo <= 10 && 10 + 1 < hi) xcd_barrier(xb);
  PH(11) if (lo <= 11 && 11 < hi) {
#if (REPMASK >> 11) & 1
    int nrep = 2; asm volatile("" : "+s"(nrep));
    for (int rep = 0; rep < nrep; ++rep) {
      if (rep) xcd_barrier(xb);
#else
    {
#endif
        rowop<true, true, false, false>(p, WSB(OFF_R2), p.n_post_ffn, 5, p.n_pre_mix + 1024, 0, 1, 0, 1);
    }
  }
  if (lo <= 11 && 11 + 1 < hi) xcd_barrier(xb);
  PH(12) if (lo <= 12 && 12 < hi) {
#if (REPMASK >> 12) & 1
    int nrep = 2; asm volatile("" : "+s"(nrep));
    for (int rep = 0; rep < nrep; ++rep) {
      if (rep) xcd_barrier(xb);
#else
    {
#endif
        pool_phase(p);
    }
  }
  if (lo <= 12 && 12 + 1 < hi) xcd_barrier(xb);
  PH(13) if (lo <= 13 && 13 < hi) {
#if (REPMASK >> 13) & 1
    int nrep = 2; asm volatile("" : "+s"(nrep));
    for (int rep = 0; rep < nrep; ++rep) {
      if (rep) xcd_barrier(xb);
#else
    {
#endif
        ph_gemm_pool(p);
    }
  }
  if (lo <= 13 && 13 + 1 < hi) xcd_barrier(xb);
  PH(14) if (lo <= 14 && 14 < hi) {
#if (REPMASK >> 14) & 1
    int nrep = 2; asm volatile("" : "+s"(nrep));
    for (int rep = 0; rep < nrep; ++rep) {
      if (rep) xcd_barrier(xb);
#else
    {
#endif
        rowop<true, true, false, false>(p, WSB(OFF_R1), p.n_post_mix + 1024, 2, p.n_pre_ffn + 1024, 3, 4, 1, 1);
    }
  }
  if (lo <= 14 && 14 + 1 < hi) xcd_barrier(xb);
  PH(15) if (lo <= 15 && 15 < hi) {
#if (REPMASK >> 15) & 1
    int nrep = 2; asm volatile("" : "+s"(nrep));
    for (int rep = 0; rep < nrep; ++rep) {
      if (rep) xcd_barrier(xb);
#else
    {
#endif
        ph_gemm_ffn_up(p, 1);
    }
  }
  if (lo <= 15 && 15 + 1 < hi) xcd_barrier(xb);
  PH(16) if (lo <= 16 && 16 < hi) {
#if (REPMASK >> 16) & 1
    int nrep = 2; asm volatile("" : "+s"(nrep));
    for (int rep = 0; rep < nrep; ++rep) {
      if (rep) xcd_barrier(xb);
#else
    {
#endif
        ph_gemm_f32out(p, WSB(OFF_R1), 2816, WSB(OFF_WDN) + (size_t)1024 * 2816, 2816, 2816, WSB(OFF_R2), 1024);
    }
  }
  if (lo <= 16 && 16 + 1 < hi) xcd_barrier(xb);
  PH(17) if (lo <= 17 && 17 < hi) {
#if (REPMASK >> 17) & 1
    int nrep = 2; asm volatile("" : "+s"(nrep));
    for (int rep = 0; rep < nrep; ++rep) {
      if (rep) xcd_barrier(xb);
#else
    {
#endif
        rowop<true, false, false, true>(p, WSB(OFF_R2), p.n_post_ffn + 1024, 5, nullptr, 0, 0, 1, 1);
    }
  }
}

extern "C" void kernel_launch(void* const* d_in, const int* in_sizes, int n_in, void* d_out, int out_size, void* d_ws,
                              size_t ws_size, hipStream_t stream) {
  P p{};
  const float** f = (const float**)&p;
  for (int i = 0; i < 33; ++i) f[i] = (const float*)d_in[i];
  p.out = (float*)d_out;
  p.ws = (char*)d_ws;
  static int grid_blocks = 0;
  if (!grid_blocks) {
    int dev = 0, cus = 0, per_cu = 0;
    hipGetDevice(&dev);
    hipDeviceGetAttribute(&cus, hipDeviceAttributeMultiprocessorCount, dev);
    hipOccupancyMaxActiveBlocksPerMultiprocessor(&per_cu, mega, 256, 0);
    if (per_cu > 2) per_cu = 2;
    if (per_cu < 1) per_cu = 1;
    grid_blocks = cus * per_cu;
  }
  hipMemsetAsync((char*)d_ws + OFF_BAR, 0, XCD_BAR_WORDS * 4, stream);
#if SINGLE_LAUNCH
  int lo = 0, hi = NPHASE;
  void* args[] = {&p, &lo, &hi};
  hipError_t e = hipLaunchCooperativeKernel((void*)mega, dim3(grid_blocks), dim3(256), args, 0, stream);
  if (e != hipSuccess) fprintf(stderr, "cooperative launch failed: %s (grid %d)\n", hipGetErrorString(e), grid_blocks);
#else
  for (int ph = 0; ph < NPHASE; ++ph) mega<<<grid_blocks, 256, 0, stream>>>(p, ph, ph + 1);
#endif
}
```

```cpp
#include <hip/hip_runtime.h>
#include <hip/hip_cooperative_groups.h>
#include <stdint.h>
#include <stdio.h>
namespace cg = cooperative_groups;

#ifndef SINGLE_LAUNCH
#define SINGLE_LAUNCH 1
#endif

typedef __attribute__((ext_vector_type(8))) short bf16x8;
typedef __attribute__((ext_vector_type(4))) float f32x4;
typedef unsigned short bf16_t;

#define DEVI __device__ __forceinline__

constexpr size_t OFF_WIN   = 0;
constexpr size_t OFF_WUQ   = OFF_WIN   + (size_t)2176*1024*2;
constexpr size_t OFF_WUKV  = OFF_WUQ   + (size_t)768*256*2;
constexpr size_t OFF_WOUT  = OFF_WUKV  + (size_t)1024*256*2;
constexpr size_t OFF_WPOOL = OFF_WOUT  + (size_t)1024*1024*2;
constexpr size_t OFF_WGU   = OFF_WPOOL + (size_t)4*256*256*2;
constexpr size_t OFF_WDN   = OFF_WGU   + (size_t)2*5632*1024*2;
constexpr size_t OFF_MOD   = OFF_WDN   + (size_t)2*1024*2816*2;
constexpr size_t OFF_R1    = OFF_MOD   + (size_t)2*3*6144*4;
constexpr size_t OFF_R2    = OFF_R1    + (size_t)8192*2096*4;
constexpr size_t OFF_H     = OFF_R2    + (size_t)8192*1024*4;
constexpr size_t OFF_CAT   = OFF_H     + (size_t)8192*1024*2;
constexpr size_t OFF_Q     = OFF_CAT   + (size_t)8192*1024*2;
constexpr size_t OFF_KN    = OFF_Q     + (size_t)8192*768*2;
constexpr size_t OFF_VT    = OFF_KN    + (size_t)8704*512*2;
constexpr size_t OFF_CQN   = OFF_VT    + (size_t)8704*512*2;
constexpr size_t OFF_CKV   = OFF_CQN   + (size_t)8192*256*2;
constexpr size_t OFF_KPE   = OFF_CKV   + (size_t)8704*256*2;
constexpr size_t OFF_XS    = OFF_KPE   + (size_t)8704*32*2;
constexpr size_t OFF_XST   = OFF_XS    + (size_t)8192*512*2;
constexpr size_t OFF_BM    = OFF_XST   + (size_t)8192*512*2;
constexpr size_t OFF_BT    = OFF_BM    + (size_t)8192*256*2;
constexpr size_t OFF_CM    = OFF_BT    + (size_t)8192*256*2;
constexpr size_t OFF_DTV   = OFF_CM    + (size_t)8192*256*2;
constexpr size_t OFF_CUM   = OFF_DTV   + (size_t)2*8192*8*4;
constexpr size_t OFF_TOT   = OFF_CUM   + (size_t)2*8192*8*4;
constexpr size_t OFF_BAR   = OFF_TOT   + 4096;
constexpr size_t OFF_XR    = OFF_BAR   + 16384;
constexpr size_t OFF_END   = OFF_XR    + (size_t)8192*1024*2;
static_assert(OFF_END <= ((size_t)256 << 20), "workspace map exceeds 256 MiB");

constexpr size_t OUT_CKV = 8388608, OUT_KR = 9437184, OUT_SF = 9568256, OUT_SB = 10616832;

struct P {
  const float *x_prompt, *x_sample, *c, *cache_ckv, *cache_kr, *st_f, *st_b, *c_ctx;
  const float *w_mod, *b_mod, *n_pre_mix, *n_post_mix, *n_pre_ffn, *n_post_ffn;
  const float *w_in, *q_norm, *w_uq, *kv_norm, *w_ukv, *conv_w, *conv_b, *dtb_f, *dtb_b, *alog_f, *alog_b;
  const float *ssd_d, *ssd_norm, *w_out, *pool_w, *pool_scale, *w_gate, *w_up, *w_down;
  float* out;
  char* ws;
};

#define WSB(off) ((bf16_t*)(p.ws + (off)))
#define WSF(off) ((float*)(p.ws + (off)))

typedef __bf16 hwbf16x2 __attribute__((ext_vector_type(2)));
typedef float hwf32x2 __attribute__((ext_vector_type(2)));
DEVI bf16_t f2bf(float f) {
  __bf16 r = (__bf16)f;
  return __builtin_bit_cast(bf16_t, r);
}
DEVI float bf2f(bf16_t b) { return __uint_as_float(((unsigned)b) << 16); }
DEVI unsigned pack2(float a, float b) {
  hwf32x2 v = {a, b};
  hwbf16x2 r = __builtin_convertvector(v, hwbf16x2);
  return __builtin_bit_cast(unsigned, r);
}
DEVI float silu(float x) { return x / (1.f + __expf(-x)); }
DEVI float wave_sum(float v) {
#pragma unroll
  for (int o = 32; o > 0; o >>= 1) v += __shfl_xor(v, o, 64);
  return v;
}
DEVI f32x4 mfma16(bf16x8 a, bf16x8 b, f32x4 c) { return __builtin_amdgcn_mfma_f32_16x16x32_bf16(a, b, c, 0, 0, 0); }

DEVI float rope_freq(int m) { return exp2f(-(float)m * 1.6609640474436813f); }
DEVI void fast_sincos(float ang, float& sn, float& cs) {
  float rev = ang * 0.15915494309189535f;
  rev -= rintf(rev);
  sn = __builtin_amdgcn_sinf(rev);
  cs = __builtin_amdgcn_cosf(rev);
}
typedef unsigned hwu32x2 __attribute__((ext_vector_type(2)));
DEVI float quad_max(float x) {
  hwu32x2 r = __builtin_amdgcn_permlane16_swap(__float_as_uint(x), __float_as_uint(x), false, false);
  x = fmaxf(__uint_as_float(r[0]), __uint_as_float(r[1]));
  r = __builtin_amdgcn_permlane32_swap(__float_as_uint(x), __float_as_uint(x), false, false);
  return fmaxf(__uint_as_float(r[0]), __uint_as_float(r[1]));
}
DEVI float quad_sum(float x) {
  hwu32x2 r = __builtin_amdgcn_permlane16_swap(__float_as_uint(x), __float_as_uint(x), false, false);
  x = __uint_as_float(r[0]) + __uint_as_float(r[1]);
  r = __builtin_amdgcn_permlane32_swap(__float_as_uint(x), __float_as_uint(x), false, false);
  return __uint_as_float(r[0]) + __uint_as_float(r[1]);
}
#define VB ((int)(threadIdx.x >> 8))
#define VT_PAIRG (gridDim.x == 256u)
#define VT_FIRST ((int)(VT_PAIRG ? blockIdx.x : blockIdx.x * 2u))
#define VT_OFF ((int)(VT_PAIRG ? VB * gridDim.x : VB))
DEVI int opaque_tid() { int t = threadIdx.x & 255; asm volatile("" : "+v"(t)); return t; }
DEVI int swz_tile(int t, int T) {
  int q = T >> 3, r = T & 7, x = t & 7, off = t >> 3;
  return (x < r ? x * (q + 1) : r * (q + 1) + (x - r) * q) + off;
}

__shared__ __attribute__((aligned(16))) char g_smem[2 * 73728];
#define NOINL __device__ __forceinline__

constexpr int LDT = 72;
constexpr int TILE_E = 128 * LDT;

template <class Epi>
DEVI void gemm_tile(const bf16_t* __restrict__ A, int lda, const bf16_t* __restrict__ B, int ldb, int K,
                    int m0, int n0, char* smem, Epi epi) {
  const int tid = opaque_tid(), lane = tid & 63, wave = tid >> 6, wm = wave >> 1, wn = wave & 1;
  const int lr = lane & 15, lg = lane >> 4;
  bf16_t* sA = (bf16_t*)smem;
  bf16_t* sB = sA + 2 * TILE_E;
  f32x4 acc[4][4];
#pragma unroll
  for (int i = 0; i < 4; ++i)
#pragma unroll
    for (int j = 0; j < 4; ++j) acc[i][j] = (f32x4){0.f, 0.f, 0.f, 0.f};
  const int lrow = tid >> 3, lkc = (tid & 7) * 8;
  const bf16_t* gA = A + (size_t)(m0 + lrow) * lda + lkc;
  const bf16_t* gB = B + (size_t)(n0 + lrow) * ldb + lkc;
  uint4 ra[4], rb[4];
#pragma unroll
  for (int i = 0; i < 4; ++i) {
    ra[i] = *(const uint4*)(gA + (size_t)(32 * i) * lda);
    rb[i] = *(const uint4*)(gB + (size_t)(32 * i) * ldb);
  }
#pragma unroll
  for (int i = 0; i < 4; ++i) {
    *(uint4*)(sA + (lrow + 32 * i) * LDT + lkc) = ra[i];
    *(uint4*)(sB + (lrow + 32 * i) * LDT + lkc) = rb[i];
  }
  __syncthreads();
  const int nk = K >> 6;
  for (int kt = 0; kt < nk; ++kt) {
    const int cur = kt & 1;
    if (kt + 1 < nk) {
      const int k0 = (kt + 1) << 6;
#pragma unroll
      for (int i = 0; i < 4; ++i) {
        ra[i] = *(const uint4*)(gA + (size_t)(32 * i) * lda + k0);
        rb[i] = *(const uint4*)(gB + (size_t)(32 * i) * ldb + k0);
      }
    }
    const bf16_t* cA = sA + cur * TILE_E + (wm * 64 + lr) * LDT + lg * 8;
    const bf16_t* cB = sB + cur * TILE_E + (wn * 64 + lr) * LDT + lg * 8;
#pragma unroll
    for (int ks = 0; ks < 2; ++ks) {
      bf16x8 af[4], bfr[4];
#pragma unroll
      for (int i = 0; i < 4; ++i) {
        af[i] = *(const bf16x8*)(cA + i * 16 * LDT + ks * 32);
        bfr[i] = *(const bf16x8*)(cB + i * 16 * LDT + ks * 32);
      }
#pragma unroll
      for (int i = 0; i < 4; ++i)
#pragma unroll
        for (int j = 0; j < 4; ++j) acc[i][j] = mfma16(af[i], bfr[j], acc[i][j]);
    }
    if (kt + 1 < nk) {
      const int nx = cur ^ 1;
#pragma unroll
      for (int i = 0; i < 4; ++i) {
        *(uint4*)(sA + nx * TILE_E + (lrow + 32 * i) * LDT + lkc) = ra[i];
        *(uint4*)(sB + nx * TILE_E + (lrow + 32 * i) * LDT + lkc) = rb[i];
      }
    }
    __syncthreads();
  }
#pragma unroll
  for (int i = 0; i < 4; ++i)
#pragma unroll
    for (int j = 0; j < 4; j += 2)
      epi(m0 + wm * 64 + i * 16 + lg * 4, n0 + wn * 64 + j * 16 + lr, acc[i][j], acc[i][j + 1]);
}

struct TileInfo { const bf16_t* a; const bf16_t* b; int m0, n0, ctx; };
template <class TileFn, class Epi>
DEVI void gemm_stream(int T, int lda, int ldb, int K, char* smem, TileFn tf, Epi epi) {
  int t0 = VT_FIRST;
  if (t0 >= T) return;
  int t = min(t0 + VT_OFF, T - 1);
  const int tid = opaque_tid(), lane = tid & 63, wave = tid >> 6, wm = wave >> 1, wn = wave & 1;
  const int lr = lane & 15, lg = lane >> 4;
  bf16_t* sA = (bf16_t*)smem;
  bf16_t* sB = sA + 2 * TILE_E;
  const int lrow = tid >> 3, lkc = (tid & 7) * 8;
  TileInfo ti = tf(t);
  const bf16_t* gA = ti.a + (size_t)lrow * lda + lkc;
  const bf16_t* gB = ti.b + (size_t)lrow * ldb + lkc;
  int m0 = ti.m0, n0 = ti.n0, ctx = ti.ctx;
  uint4 ra0, ra1, ra2, ra3, rb0, rb1, rb2, rb3;
  uint4 rc0, rc1, rc2, rc3, rd0, rd1, rd2, rd3;
#define GS_LOAD0(pa, pb) \
  ra0 = *(const uint4*)((pa)); ra1 = *(const uint4*)((pa) + (size_t)32 * lda); \
  ra2 = *(const uint4*)((pa) + (size_t)64 * lda); ra3 = *(const uint4*)((pa) + (size_t)96 * lda); \
  rb0 = *(const uint4*)((pb)); rb1 = *(const uint4*)((pb) + (size_t)32 * ldb); \
  rb2 = *(const uint4*)((pb) + (size_t)64 * ldb); rb3 = *(const uint4*)((pb) + (size_t)96 * ldb);
#define GS_LOAD1(pa, pb) \
  rc0 = *(const uint4*)((pa)); rc1 = *(const uint4*)((pa) + (size_t)32 * lda); \
  rc2 = *(const uint4*)((pa) + (size_t)64 * lda); rc3 = *(const uint4*)((pa) + (size_t)96 * lda); \
  rd0 = *(const uint4*)((pb)); rd1 = *(const uint4*)((pb) + (size_t)32 * ldb); \
  rd2 = *(const uint4*)((pb) + (size_t)64 * ldb); rd3 = *(const uint4*)((pb) + (size_t)96 * ldb);
#define GS_WRITE0(buf) { \
  bf16_t* wa = sA + (buf) * TILE_E + lrow * LDT + lkc; bf16_t* wb = sB + (buf) * TILE_E + lrow * LDT + lkc; \
  *(uint4*)(wa) = ra0; *(uint4*)(wa + 32 * LDT) = ra1; *(uint4*)(wa + 64 * LDT) = ra2; *(uint4*)(wa + 96 * LDT) = ra3; \
  *(uint4*)(wb) = rb0; *(uint4*)(wb + 32 * LDT) = rb1; *(uint4*)(wb + 64 * LDT) = rb2; *(uint4*)(wb + 96 * LDT) = rb3; }
#define GS_WRITE1(buf) { \
  bf16_t* wa = sA + (buf) * TILE_E + lrow * LDT + lkc; bf16_t* wb = sB + (buf) * TILE_E + lrow * LDT + lkc; \
  *(uint4*)(wa) = rc0; *(uint4*)(wa + 32 * LDT) = rc1; *(uint4*)(wa + 64 * LDT) = rc2; *(uint4*)(wa + 96 * LDT) = rc3; \
  *(uint4*)(wb) = rd0; *(uint4*)(wb + 32 * LDT) = rd1; *(uint4*)(wb + 64 * LDT) = rd2; *(uint4*)(wb + 96 * LDT) = rd3; }
#define GS_COMPUTE(buf) { \
    const bf16_t* cA = sA + (buf) * TILE_E + (wm * 64 + lr) * LDT + lg * 8; \
    const bf16_t* cB = sB + (buf) * TILE_E + (wn * 64 + lr) * LDT + lg * 8; \
    _Pragma("unroll") for (int ks = 0; ks < 2; ++ks) { \
      bf16x8 af[4], bfr[4]; \
      _Pragma("unroll") for (int i = 0; i < 4; ++i) { \
        af[i] = *(const bf16x8*)(cA + i * 16 * LDT + ks * 32); \
        bfr[i] = *(const bf16x8*)(cB + i * 16 * LDT + ks * 32); \
      } \
      __builtin_amdgcn_s_setprio(1); \
      _Pragma("unroll") for (int i = 0; i < 4; ++i) \
        _Pragma("unroll") for (int j = 0; j < 4; ++j) acc[i][j] = mfma16(af[i], bfr[j], acc[i][j]); \
      __builtin_amdgcn_s_setprio(0); \
    } }
  GS_LOAD0(gA, gB)
  GS_WRITE0(0)
  GS_LOAD1(gA + 64, gB + 64)
  __syncthreads();
  const int nk = K >> 6;
  for (;;) {
    f32x4 acc[4][4];
#pragma unroll
    for (int i = 0; i < 4; ++i)
#pragma unroll
      for (int j = 0; j < 4; ++j) acc[i][j] = (f32x4){0.f, 0.f, 0.f, 0.f};
    const int t0n = t0 + gridDim.x * 2;
    const bool have_next = t0n < T;
    const int tn = min(t0n + VT_OFF, T - 1);
    const bf16_t *nA = gA, *nB = gB;
    int nm0 = 0, nn0 = 0, nctx = 0;
    if (have_next) {
      const TileInfo tj = tf(tn);
      nA = tj.a + (size_t)lrow * lda + lkc;
      nB = tj.b + (size_t)lrow * ldb + lkc;
      nm0 = tj.m0; nn0 = tj.n0; nctx = tj.ctx;
    }
    for (int kt = 0; kt < nk; kt += 2) {
      {
        const bool wrap = (kt + 2 >= nk);
        const bf16_t* pa = wrap ? nA : gA + ((kt + 2) << 6);
        const bf16_t* pb = wrap ? nB : gB + ((kt + 2) << 6);
        GS_LOAD0(pa, pb)
        GS_COMPUTE(0)
        GS_WRITE1(1)
        __syncthreads();
      }
      {
        const bool wrap = (kt + 3 >= nk);
        const bf16_t* pa = wrap ? nA + 64 : gA + ((kt + 3) << 6);
        const bf16_t* pb = wrap ? nB + 64 : gB + ((kt + 3) << 6);
        GS_LOAD1(pa, pb)
        GS_COMPUTE(1)
        GS_WRITE0(0)
        __syncthreads();
      }
    }
#pragma unroll
    for (int i = 0; i < 4; ++i)
#pragma unroll
      for (int j = 0; j < 4; j += 2)
        epi(ctx, m0 + wm * 64 + i * 16 + lg * 4, n0 + wn * 64 + j * 16 + lr, acc[i][j], acc[i][j + 1]);
    if (!have_next) break;
    t = tn; t0 = t0n; gA = nA; gB = nB; m0 = nm0; n0 = nn0; ctx = nctx;
  }
}

constexpr int T8_E = 256 * LDT;
template <class TileFn, class Epi>
DEVI void gemm8_stream(int T, int lda, int ldb, int K, TileFn tf, Epi epi) {
  int t = blockIdx.x;
  if (t >= T) return;
  int tid = threadIdx.x; asm volatile("" : "+v"(tid));
  const int lane = tid & 63, wave = tid >> 6, wr = wave >> 2, wc = wave & 3;
  const int lr = lane & 15, lg = lane >> 4;
  bf16_t* sA = (bf16_t*)g_smem;
  bf16_t* sB = sA + 2 * T8_E;
  const int lrow = tid >> 3, lkc = (tid & 7) * 8;
  TileInfo ti = tf(t);
  const unsigned offA = ((unsigned)lrow * (unsigned)lda + (unsigned)lkc) * 2u;
  const unsigned offB = ((unsigned)lrow * (unsigned)ldb + (unsigned)lkc) * 2u;
  const char* gA = (const char*)ti.a;
  const char* gB = (const char*)ti.b;
  const size_t rsA = (size_t)64 * lda * 2, rsB = (size_t)64 * ldb * 2;
  int m0 = ti.m0, n0 = ti.n0, ctx = ti.ctx;
  uint4 ra0, ra1, ra2, ra3, rb0, rb1, rb2, rb3;
#define G8_LOAD(pa, pb) \
  ra0 = *(const uint4*)((pa) + offA); ra1 = *(const uint4*)((pa) + rsA + offA); \
  ra2 = *(const uint4*)((pa) + 2 * rsA + offA); ra3 = *(const uint4*)((pa) + 3 * rsA + offA); \
  rb0 = *(const uint4*)((pb) + offB); rb1 = *(const uint4*)((pb) + rsB + offB); \
  rb2 = *(const uint4*)((pb) + 2 * rsB + offB); rb3 = *(const uint4*)((pb) + 3 * rsB + offB);
#define G8_WRITE(buf) { \
  bf16_t* wa = sA + (buf) * T8_E + lrow * LDT + lkc; bf16_t* wb = sB + (buf) * T8_E + lrow * LDT + lkc; \
  *(uint4*)(wa) = ra0; *(uint4*)(wa + 64 * LDT) = ra1; *(uint4*)(wa + 128 * LDT) = ra2; *(uint4*)(wa + 192 * LDT) = ra3; \
  *(uint4*)(wb) = rb0; *(uint4*)(wb + 64 * LDT) = rb1; *(uint4*)(wb + 128 * LDT) = rb2; *(uint4*)(wb + 192 * LDT) = rb3; }
  G8_LOAD(gA, gB)
  G8_WRITE(0)
  __syncthreads();
  int cur = 0;
  const int nk = K >> 6;
  for (;;) {
    f32x4 acc[8][4];
#pragma unroll
    for (int i = 0; i < 8; ++i)
#pragma unroll
      for (int j = 0; j < 4; ++j) acc[i][j] = (f32x4){0.f, 0.f, 0.f, 0.f};
    const int tn = t + gridDim.x;
    const bool have_next = tn < T;
    const char *nA = gA, *nB = gB;
    int nm0 = 0, nn0 = 0, nctx = 0;
    if (have_next) {
      const TileInfo tj = tf(tn);
      nA = (const char*)tj.a;
      nB = (const char*)tj.b;
      nm0 = tj.m0; nn0 = tj.n0; nctx = tj.ctx;
    }
#pragma unroll 1
    for (int kt = 0; kt < nk; ++kt) {
      const bool last = (kt + 1 == nk);
      const char* pa = last ? nA : gA + ((kt + 1) << 7);
      const char* pb = last ? nB : gB + ((kt + 1) << 7);
      G8_LOAD(pa, pb)
      const bf16_t* cA = sA + cur * T8_E + (wr * 128 + lr) * LDT + lg * 8;
      const bf16_t* cB = sB + cur * T8_E + (wc * 64 + lr) * LDT + lg * 8;
#pragma unroll
      for (int ks = 0; ks < 2; ++ks) {
        bf16x8 bfr[4];
#pragma unroll
        for (int j = 0; j < 4; ++j) bfr[j] = *(const bf16x8*)(cB + j * 16 * LDT + ks * 32);
#pragma unroll
        for (int h = 0; h < 2; ++h) {
          bf16x8 af[4];
#pragma unroll
          for (int i = 0; i < 4; ++i) af[i] = *(const bf16x8*)(cA + (h * 4 + i) * 16 * LDT + ks * 32);
          __builtin_amdgcn_s_setprio(1);
#pragma unroll
          for (int i = 0; i < 4; ++i)
#pragma unroll
            for (int j = 0; j < 4; ++j) acc[h * 4 + i][j] = mfma16(af[i], bfr[j], acc[h * 4 + i][j]);
          __builtin_amdgcn_s_setprio(0);
          __builtin_amdgcn_sched_barrier(0);
        }
      }
      G8_WRITE(cur ^ 1)
      __syncthreads();
      cur ^= 1;
    }
#pragma unroll
    for (int i = 0; i < 8; ++i)
#pragma unroll
      for (int j = 0; j < 4; j += 2)
        epi(ctx, m0 + wr * 128 + i * 16 + lg * 4, n0 + wc * 64 + j * 16 + lr, acc[i][j], acc[i][j + 1]);
    if (!have_next) break;
    t = tn; gA = nA; gB = nB; m0 = nm0; n0 = nn0; ctx = nctx;
  }
}

DEVI void tile_mn(int t, int nM, int nN, int& m, int& n) {
  int id = swz_tile(t, nM * nN);
  int per = 8 * nN;
  int gq = id / per, rem = id - gq * per;
  int gsz = min(8, nM - gq * 8);
  m = gq * 8 + rem % gsz;
  n = rem / gsz;
}

NOINL void gemv_tile(const P& p, int t) {
  char* smem = g_smem + VB * 73728;
  const int tid = opaque_tid();
  float* sv = (float*)smem;
  float* red = sv + 3072;
  const int l = t / 192, n0 = (t % 192) * 32;
  for (int i = tid; i < 3072; i += 256) {
    int v = i >> 10, k = i & 1023;
    float cv = (v == 0) ? p.c_ctx[k] : p.c[(v - 1) * 1024 + k];
    sv[i] = cv / (1.f + expf(-cv));
  }
  __syncthreads();
  const int cgp = tid & 7, ks = tid >> 3;
  const float* w = p.w_mod + (size_t)l * 1024 * 6144 + n0 + cgp * 4;
  float a0[4] = {0, 0, 0, 0}, a1[4] = {0, 0, 0, 0}, a2[4] = {0, 0, 0, 0};
#pragma unroll 16
  for (int kk = 0; kk < 32; ++kk) {
    const int k = ks * 32 + kk;
    const float4 wv = *(const float4*)(w + (size_t)k * 6144);
    const float s0 = sv[k], s1 = sv[1024 + k], s2 = sv[2048 + k];
    a0[0] += s0 * wv.x; a0[1] += s0 * wv.y; a0[2] += s0 * wv.z; a0[3] += s0 * wv.w;
    a1[0] += s1 * wv.x; a1[1] += s1 * wv.y; a1[2] += s1 * wv.z; a1[3] += s1 * wv.w;
    a2[0] += s2 * wv.x; a2[1] += s2 * wv.y; a2[2] += s2 * wv.z; a2[3] += s2 * wv.w;
  }
#pragma unroll
  for (int j = 0; j < 4; ++j) {
    red[(ks * 3 + 0) * 32 + cgp * 4 + j] = a0[j];
    red[(ks * 3 + 1) * 32 + cgp * 4 + j] = a1[j];
    red[(ks * 3 + 2) * 32 + cgp * 4 + j] = a2[j];
  }
  __syncthreads();
  if (tid < 96) {
    const int v = tid >> 5, col = tid & 31;
    float s = 0.f;
    for (int q = 0; q < 32; ++q) s += red[(q * 3 + v) * 32 + col];
    s += p.b_mod[l * 6144 + n0 + col];
    WSF(OFF_MOD)[(l * 3 + v) * 6144 + n0 + col] = s;
  }
  __syncthreads();
}

NOINL void transpose_tile(const P& p, int t) {
  char* smem = g_smem + VB * 73728;
  const int tid = opaque_tid();
  const float* src; bf16_t* dst; int K, N, ntn, mode = 0;
  if (t < 544) { src = p.w_in; dst = WSB(OFF_WIN); K = 1024; N = 2096; ntn = 34; }
  else if ((t -= 544) < 48) { src = p.w_uq; dst = WSB(OFF_WUQ); K = 256; N = 768; ntn = 12; }
  else if ((t -= 48) < 64) { src = p.w_ukv; dst = WSB(OFF_WUKV); K = 256; N = 1024; ntn = 16; }
  else if ((t -= 64) < 256) { src = p.w_out; dst = WSB(OFF_WOUT); K = 1024; N = 1024; ntn = 16; }
  else if ((t -= 256) < 64) { int g = t >> 4; t &= 15; src = p.pool_w + (size_t)g * 65536; dst = WSB(OFF_WPOOL) + (size_t)g * 65536; K = 256; N = 256; ntn = 4; }
  else if ((t -= 64) < 1408) { int l = t / 704; t -= l * 704; src = p.w_gate + (size_t)l * 1024 * 2816; dst = WSB(OFF_WGU) + (size_t)l * 5632 * 1024; K = 1024; N = 2816; ntn = 44; mode = 1; }
  else if ((t -= 1408) < 1408) { int l = t / 704; t -= l * 704; src = p.w_up + (size_t)l * 1024 * 2816; dst = WSB(OFF_WGU) + (size_t)l * 5632 * 1024; K = 1024; N = 2816; ntn = 44; mode = 2; }
  else { t -= 1408; int l = t / 704; t -= l * 704; src = p.w_down + (size_t)l * 2816 * 1024; dst = WSB(OFF_WDN) + (size_t)l * 1024 * 2816; K = 2816; N = 1024; ntn = 16; }
  const int kt = t / ntn, nt_ = t - kt * ntn;
  const int k0 = kt * 64, n0 = nt_ * 64;
  float* tile = (float*)smem;
  {
    const int nn = tid & 63, kk0 = tid >> 6;
    const int n = n0 + nn;
    const int nc = n < N ? n : N - 1;
    float v[16];
#pragma unroll
    for (int i = 0; i < 16; ++i) v[i] = src[(size_t)(k0 + kk0 + 4 * i) * N + nc];
#pragma unroll
    for (int i = 0; i < 16; ++i) tile[(kk0 + 4 * i) * 65 + nn] = (n < N) ? v[i] : 0.f;
  }
  __syncthreads();
#pragma unroll
  for (int i = 0; i < 2; ++i) {
    const int id = tid + 256 * i;
    const int nn = id >> 3, kc = id & 7;
    const int n = n0 + nn;
    uint4 pk;
    pk.x = pack2(tile[(kc * 8 + 0) * 65 + nn], tile[(kc * 8 + 1) * 65 + nn]);
    pk.y = pack2(tile[(kc * 8 + 2) * 65 + nn], tile[(kc * 8 + 3) * 65 + nn]);
    pk.z = pack2(tile[(kc * 8 + 4) * 65 + nn], tile[(kc * 8 + 5) * 65 + nn]);
    pk.w = pack2(tile[(kc * 8 + 6) * 65 + nn], tile[(kc * 8 + 7) * 65 + nn]);
    int drow = n;
    if (mode == 1) drow = (n >> 4) * 32 + (n & 15);
    else if (mode == 2) drow = (n >> 4) * 32 + 16 + (n & 15);
    *(uint4*)(dst + (size_t)drow * K + k0 + kc * 8) = pk;
  }
  __syncthreads();
}

template <bool UPD, bool MOD, bool FIRST, bool LASTW, bool TWO>
DEVI void rowop(const P& p, const bf16_t* msrc, const bf16_t* msrc2, const float* wpost, int gate_idx, const float* wpre, int shift_idx,
                int scale_idx, int layer_g, int layer_m) {
  const int lane = threadIdx.x & 63, wave = threadIdx.x >> 6;
  const float* modg = WSF(OFF_MOD) + (size_t)layer_g * 3 * 6144;
  const float* modm = WSF(OFF_MOD) + (size_t)layer_m * 3 * 6144;
  bf16_t* hbuf = WSB(OFF_H);
  for (int r = blockIdx.x * 8 + wave; r < 8192; r += gridDim.x * 8) {
    const int v = r < 4096 ? 0 : 1 + ((r - 4096) >> 11);
    const float* mvg = modg + v * 6144;
    const float* mvm = modm + v * 6144;
    float4 x[4];
    if (FIRST) {
      const float* xin = r < 4096 ? p.x_prompt + (size_t)r * 1024 : p.x_sample + (size_t)(r - 4096) * 1024;
#pragma unroll
      for (int i = 0; i < 4; ++i) x[i] = *(const float4*)(xin + lane * 4 + 256 * i);
    } else {
#pragma unroll
      for (int i = 0; i < 4; ++i) {
        const uint2 xb = *(const uint2*)(WSB(OFF_XR) + (size_t)r * 1024 + lane * 4 + 256 * i);
        x[i].x = __uint_as_float(xb.x << 16); x[i].y = __uint_as_float(xb.x & 0xffff0000u);
        x[i].z = __uint_as_float(xb.y << 16); x[i].w = __uint_as_float(xb.y & 0xffff0000u);
      }
    }
    if (UPD) {
      float4 m[4];
      float ss = 0.f;
#pragma unroll
      for (int i = 0; i < 4; ++i) {
        const uint2 mb = *(const uint2*)(msrc + (size_t)r * 1024 + lane * 4 + 256 * i);
        m[i].x = __uint_as_float(mb.x << 16); m[i].y = __uint_as_float(mb.x & 0xffff0000u);
        m[i].z = __uint_as_float(mb.y << 16); m[i].w = __uint_as_float(mb.y & 0xffff0000u);
        if (TWO) {
          const uint2 mc = *(const uint2*)(msrc2 + (size_t)r * 1024 + lane * 4 + 256 * i);
          m[i].x += __uint_as_float(mc.x << 16); m[i].y += __uint_as_float(mc.x & 0xffff0000u);
          m[i].z += __uint_as_float(mc.y << 16); m[i].w += __uint_as_float(mc.y & 0xffff0000u);
        }
        ss += m[i].x * m[i].x + m[i].y * m[i].y + m[i].z * m[i].z + m[i].w * m[i].w;
      }
      ss = wave_sum(ss);
      const float rs = rsqrtf(ss * (1.f / 1024.f) + 1e-6f);
#pragma unroll
      for (int i = 0; i < 4; ++i) {
        const int col = lane * 4 + 256 * i;
        const float4 wp = *(const float4*)(wpost + col);
        const float4 g = *(const float4*)(mvg + gate_idx * 1024 + col);
        x[i].x += g.x * (m[i].x * rs * wp.x);
        x[i].y += g.y * (m[i].y * rs * wp.y);
        x[i].z += g.z * (m[i].z * rs * wp.z);
        x[i].w += g.w * (m[i].w * rs * wp.w);
        if (LASTW) *(float4*)(p.out + (size_t)r * 1024 + col) = x[i];
        else {
          uint2 xo;
          xo.x = pack2(x[i].x, x[i].y);
          xo.y = pack2(x[i].z, x[i].w);
          *(uint2*)(WSB(OFF_XR) + (size_t)r * 1024 + col) = xo;
        }
      }
    }
    if (MOD) {
      float ss = 0.f;
#pragma unroll
      for (int i = 0; i < 4; ++i) ss += x[i].x * x[i].x + x[i].y * x[i].y + x[i].z * x[i].z + x[i].w * x[i].w;
      ss = wave_sum(ss);
      const float rs = rsqrtf(ss * (1.f / 1024.f) + 1e-6f);
#pragma unroll
      for (int i = 0; i < 4; ++i) {
        const int col = lane * 4 + 256 * i;
        const float4 wp = *(const float4*)(wpre + col);
        const float4 sh = *(const float4*)(mvm + shift_idx * 1024 + col);
        const float4 sc = *(const float4*)(mvm + scale_idx * 1024 + col);
        uint2 o;
        o.x = pack2(x[i].x * rs * wp.x * (1.f + sc.x) + sh.x, x[i].y * rs * wp.y * (1.f + sc.y) + sh.y);
        o.y = pack2(x[i].z * rs * wp.z * (1.f + sc.z) + sh.z, x[i].w * rs * wp.w * (1.f + sc.w) + sh.w);
        *(uint2*)(hbuf + (size_t)r * 1024 + col) = o;
      }
    }
  }
}

NOINL void prep_rows(const P& p) {
  const int lane = threadIdx.x & 63, wave = threadIdx.x >> 6;
  const float* proj = WSF(OFF_R1);
  for (int r = blockIdx.x * 8 + wave; r < 8192; r += gridDim.x * 8) {
    const float* pr = proj + (size_t)r * 2096;
    const int kvrow = r < 4096 ? r : 4096 + ((r - 4096) >> 11) * 2304 + 256 + ((r - 4096) & 2047);
    const float4 ld_cq = *(const float4*)(pr + lane * 4);
    const float4 ld_ckv = *(const float4*)(pr + 256 + lane * 4);
    const float ld_kpe = pr[512 + (lane & 31)];
    const float ld_dt = pr[2080 + (lane & 15)];
    {
      const float4 a = ld_cq;
      float ss = wave_sum(a.x * a.x + a.y * a.y + a.z * a.z + a.w * a.w);
      const float rs = rsqrtf(ss * (1.f / 256.f) + 1e-6f);
      const float4 g = *(const float4*)(p.q_norm + lane * 4);
      uint2 o;
      o.x = pack2(a.x * rs * g.x, a.y * rs * g.y);
      o.y = pack2(a.z * rs * g.z, a.w * rs * g.w);
      *(uint2*)(WSB(OFF_CQN) + (size_t)r * 256 + lane * 4) = o;
    }
    {
      const float4 a = ld_ckv;
      float ss = wave_sum(a.x * a.x + a.y * a.y + a.z * a.z + a.w * a.w);
      const float rs = rsqrtf(ss * (1.f / 256.f) + 1e-6f);
      const float4 g = *(const float4*)(p.kv_norm + lane * 4);
      float4 vv;
      vv.x = a.x * rs * g.x; vv.y = a.y * rs * g.y; vv.z = a.z * rs * g.z; vv.w = a.w * rs * g.w;
      if (r < 4096) *(float4*)(p.out + OUT_CKV + (size_t)r * 256 + lane * 4) = vv;
      uint2 o;
      o.x = pack2(vv.x, vv.y);
      o.y = pack2(vv.z, vv.w);
      *(uint2*)(WSB(OFF_CKV) + (size_t)kvrow * 256 + lane * 4) = o;
    }
    {
      const float kv = (lane < 32) ? ld_kpe : 0.f;
      const float partner = __shfl_xor(kv, 16, 64);
      if (r < 4096) {
        if (lane < 32) {
          p.out[OUT_KR + (size_t)r * 32 + lane] = kv;
          WSB(OFF_KPE)[(size_t)kvrow * 32 + lane] = f2bf(kv);
        }
      } else {
        const int t = (r - 4096) & 2047;
        const int ii = lane & 15;
        const float pos = (ii < 8) ? (float)(t >> 6) : (float)(t & 63);
        const float fr = rope_freq(ii & 7);
        const float ang = pos * fr;
        float cs, sn;
        fast_sincos(ang, sn, cs);
        const float o = (lane < 16) ? (kv * cs - partner * sn) : (partner * sn + kv * cs);
        if (lane < 32) WSB(OFF_KPE)[(size_t)kvrow * 32 + lane] = f2bf(o);
      }
    }
    if (lane < 16) {
      const int dir = lane >> 3, hh = lane & 7;
      const float raw = ld_dt + (dir ? p.dtb_b[hh] : p.dtb_f[hh]);
      const float sp = raw > 20.f ? raw : log1pf(expf(raw));
      WSF(OFF_DTV)[((size_t)dir * 8192 + r) * 8 + hh] = sp;
    }
  }
}

NOINL void prep_cache(const P& p) {
  const int gt = blockIdx.x * 512 + threadIdx.x, gs = gridDim.x * 512;
  for (int i = gt; i < 2 * 256 * 256; i += gs) {
    int b = i >> 16, rem = i & 65535;
    WSB(OFF_CKV)[(size_t)(4096 + b * 2304) * 256 + rem] = f2bf(p.cache_ckv[i]);
  }
  for (int i = gt; i < 2 * 256 * 32; i += gs) {
    int b = i >> 13, rem = i & 8191;
    WSB(OFF_KPE)[(size_t)(4096 + b * 2304) * 32 + rem] = f2bf(p.cache_kr[i]);
  }
}

NOINL void conv_tile(const P& p, int t) {
  char* smem = g_smem + VB * 73728;
  const int tid = opaque_tid();
  float* sin_ = (float*)smem;
  float* sout = sin_ + 68 * 64;
  const int tt_ = t >> 4, ct = t & 15;
  const int r0 = tt_ * 64, c0 = ct * 64;
  int s0, s1;
  if (r0 < 4096) { s0 = r0 & ~255; s1 = s0 + 256; } else { s0 = 4096 + ((r0 - 4096) & ~2047); s1 = s0 + 2048; }
  const float* proj = WSF(OFF_R1);
  {
    const int rr0 = tid >> 6, cc = tid & 63;
    float v[17];
#pragma unroll
    for (int k = 0; k < 17; ++k) {
      const int r = r0 - 2 + rr0 + 4 * k;
      const int rc = r < s0 ? s0 : (r >= s1 ? s1 - 1 : r);
      v[k] = proj[(size_t)rc * 2096 + 1056 + c0 + cc];
    }
#pragma unroll
    for (int k = 0; k < 17; ++k) {
      const int r = r0 - 2 + rr0 + 4 * k;
      sin_[(rr0 + 4 * k) * 64 + cc] = (r >= s0 && r < s1) ? v[k] : 0.f;
    }
  }
  __syncthreads();
  {
    const int cc = tid & 63, tq = tid >> 6;
    const int c = c0 + cc;
    const float w0 = p.conv_w[c], w1 = p.conv_w[1024 + c], w2 = p.conv_w[2048 + c], w3 = p.conv_w[3072 + c],
                w4 = p.conv_w[4096 + c], bias = p.conv_b[c];
#pragma unroll 4
    for (int i = 0; i < 16; ++i) {
      const int tt = tq * 16 + i;
      float y = bias + w0 * sin_[tt * 64 + cc] + w1 * sin_[(tt + 1) * 64 + cc] + w2 * sin_[(tt + 2) * 64 + cc] +
                w3 * sin_[(tt + 3) * 64 + cc] + w4 * sin_[(tt + 4) * 64 + cc];
      y = y / (1.f + __expf(-y));
      sout[tt * 65 + cc] = y;
      const bf16_t b = f2bf(y);
      const size_t r = r0 + tt;
      if (c < 512) WSB(OFF_XS)[r * 512 + c] = b;
      else if (c < 768) WSB(OFF_BM)[r * 256 + (c - 512)] = b;
      else WSB(OFF_CM)[r * 256 + (c - 768)] = b;
    }
  }
  __syncthreads();
  if (c0 < 768) {
    const int cl = tid >> 2, q4 = tid & 3;
    uint4 o0, o1;
    const float* sp = sout + (q4 * 16) * 65 + cl;
    o0.x = pack2(sp[0 * 65], sp[1 * 65]);   o0.y = pack2(sp[2 * 65], sp[3 * 65]);
    o0.z = pack2(sp[4 * 65], sp[5 * 65]);   o0.w = pack2(sp[6 * 65], sp[7 * 65]);
    o1.x = pack2(sp[8 * 65], sp[9 * 65]);   o1.y = pack2(sp[10 * 65], sp[11 * 65]);
    o1.z = pack2(sp[12 * 65], sp[13 * 65]); o1.w = pack2(sp[14 * 65], sp[15 * 65]);
    bf16_t* dst = (c0 < 512) ? WSB(OFF_XST) + (size_t)(c0 + cl) * 8192 : WSB(OFF_BT) + (size_t)(c0 - 512 + cl) * 8192;
    dst += r0 + q4 * 16;
    *(uint4*)(dst) = o0;
    *(uint4*)(dst + 8) = o1;
  }
  __syncthreads();
}

NOINL void chunk_state_item(const P& p, int item) {
  char* smem = g_smem + VB * 73728;
  const int tid = opaque_tid(), lane = tid & 63, wave = tid >> 6, lr = lane & 15, lg = lane >> 4;
  const int cidx = item >> 3, hh = item & 7, g = hh >> 2;
  const int r0 = cidx * 128;
  constexpr int LDS_ = 136;
  bf16_t* sAs = (bf16_t*)smem;
  bf16_t* sBs = sAs + 2 * 64 * LDS_;
  float* fa = (float*)(sBs + 128 * LDS_);
  float* fcum = fa + 256;
  float* fw = fa + 512;
  float* fdt = fa + 768;
  {
    const int dir = tid >> 7, j = tid & 127;
    const float dt = WSF(OFF_DTV)[((size_t)dir * 8192 + r0 + j) * 8 + hh];
    const float Aco = -expf(dir ? p.alog_b[hh] : p.alog_f[hh]);
    fa[tid] = dt * Aco;
    fdt[tid] = dt;
  }
  __syncthreads();
  {
    const int dir = tid >> 7, j = tid & 127;
    float s = 0.f;
    if (dir == 0) { for (int k = 0; k <= j; ++k) s += fa[k]; }
    else { for (int k = 127; k >= j; --k) s += fa[128 + k]; }
    fcum[tid] = s;
    WSF(OFF_CUM)[((size_t)dir * 8192 + r0 + j) * 8 + hh] = s;
  }
  __syncthreads();
  {
    const int dir = tid >> 7;
    const float ce = dir ? fcum[128] : fcum[127];
    fw[tid] = __expf(ce - fcum[tid]) * fdt[tid];
    if ((tid & 127) == 0) WSF(OFF_TOT)[(dir * 64 + cidx) * 8 + hh] = __expf(ce);
  }
  __syncthreads();
#pragma unroll
  for (int i = 0; i < 4; ++i) {
    const int id = tid + 256 * i;
    const int pp = id >> 4, jc = (id & 15) * 8;
    const uint4 raw = *(const uint4*)(WSB(OFF_XST) + (size_t)(hh * 64 + pp) * 8192 + r0 + jc);
    const unsigned rw[4] = {raw.x, raw.y, raw.z, raw.w};
    unsigned of[4], ob[4];
#pragma unroll
    for (int q = 0; q < 4; ++q) {
      const float x0 = __uint_as_float(rw[q] << 16), x1 = __uint_as_float(rw[q] & 0xffff0000u);
      of[q] = pack2(x0 * fw[jc + 2 * q], x1 * fw[jc + 2 * q + 1]);
      ob[q] = pack2(x0 * fw[128 + jc + 2 * q], x1 * fw[128 + jc + 2 * q + 1]);
    }
    *(uint4*)(sAs + pp * LDS_ + jc) = make_uint4(of[0], of[1], of[2], of[3]);
    *(uint4*)(sAs + 64 * LDS_ + pp * LDS_ + jc) = make_uint4(ob[0], ob[1], ob[2], ob[3]);
  }
#pragma unroll
  for (int i = 0; i < 8; ++i) {
    const int id = tid + 256 * i;
    const int nn = id >> 4, jc = (id & 15) * 8;
    *(uint4*)(sBs + nn * LDS_ + jc) = *(const uint4*)(WSB(OFF_BT) + (size_t)(g * 128 + nn) * 8192 + r0 + jc);
  }
  __syncthreads();
  {
    const int dir = wave >> 1, nh = wave & 1;
    f32x4 acc[4][4];
#pragma unroll
    for (int i = 0; i < 4; ++i)
#pragma unroll
      for (int j = 0; j < 4; ++j) acc[i][j] = (f32x4){0.f, 0.f, 0.f, 0.f};
    const bf16_t* cA = sAs + dir * 64 * LDS_ + lr * LDS_ + lg * 8;
    const bf16_t* cB = sBs + (nh * 64 + lr) * LDS_ + lg * 8;
#pragma unroll 1
    for (int ks = 0; ks < 4; ++ks) {
      bf16x8 af[4], bfr[4];
#pragma unroll
      for (int i = 0; i < 4; ++i) {
        af[i] = *(const bf16x8*)(cA + i * 16 * LDS_ + ks * 32);
        bfr[i] = *(const bf16x8*)(cB + i * 16 * LDS_ + ks * 32);
      }
#pragma unroll
      for (int i = 0; i < 4; ++i)
#pragma unroll
        for (int j = 0; j < 4; ++j) acc[i][j] = mfma16(af[i], bfr[j], acc[i][j]);
    }
    float* S = WSF(OFF_R2) + ((size_t)(dir * 64 + cidx) * 8 + hh) * 8192 + (lg * 4) * 128 + nh * 64 + lr;
#pragma unroll
    for (int i = 0; i < 4; ++i) {
#pragma unroll
      for (int q = 0; q < 4; ++q) {
#pragma unroll
        for (int j = 0; j < 4; ++j) S[j * 16] = acc[i][j][q];
        S += 128;
      }
      S += 12 * 128;
      __builtin_amdgcn_sched_barrier(0);
    }
  }
  __syncthreads();
}

template <int NB>
DEVI void scan_group(const P& p, float4& h, int dir, int cb, int nc, int c0, int hh, size_t eoff) {
  float4 sv[NB];
  float d[NB];
  size_t base[NB];
#pragma unroll
  for (int k = 0; k < NB; ++k) {
    const int c = c0 + k;
    const int cidx = cb + (dir ? nc - 1 - c : c);
    base[k] = ((size_t)(dir * 64 + cidx) * 8 + hh) * 8192 + eoff;
    d[k] = WSF(OFF_TOT)[(dir * 64 + cidx) * 8 + hh];
    sv[k] = *(const float4*)(WSF(OFF_R2) + base[k]);
  }
#pragma unroll
  for (int k = 0; k < NB; ++k) {
    uint2 o;
    o.x = pack2(h.x, h.y);
    o.y = pack2(h.z, h.w);
    *(uint2*)(WSB(OFF_H) + base[k]) = o;
    h.x = d[k] * h.x + sv[k].x; h.y = d[k] * h.y + sv[k].y; h.z = d[k] * h.z + sv[k].z; h.w = d[k] * h.w + sv[k].w;
  }
}

NOINL void scan_states(const P& p) {
  const int total = 2 * 18 * 8 * 64 * 32;
  for (int idx = blockIdx.x * 512 + threadIdx.x; idx < total; idx += gridDim.x * 512) {
    const int n4 = idx & 31, pp = (idx >> 5) & 63, hh = (idx >> 11) & 7;
    const int sd = idx >> 14;
    const int s = sd % 18, dir = sd / 18;
    const int nc = s < 16 ? 2 : 16;
    const int cb = s < 16 ? s * 2 : 32 + (s - 16) * 16;
    float4 h = make_float4(0.f, 0.f, 0.f, 0.f);
    const size_t eoff = (size_t)pp * 128 + n4 * 4;
    if (s >= 16) {
      const float* st = (dir ? p.st_b : p.st_f) + ((size_t)((s - 16) * 8 + hh) * 64 + pp) * 128 + n4 * 4;
      h = *(const float4*)st;
      scan_group<8>(p, h, dir, cb, nc, 0, hh, eoff);
      scan_group<8>(p, h, dir, cb, nc, 8, hh, eoff);
    } else {
      scan_group<2>(p, h, dir, cb, nc, 0, hh, eoff);
      float* o = p.out + (dir ? OUT_SB : OUT_SF) + ((size_t)(s * 8 + hh) * 64 + pp) * 128 + n4 * 4;
      *(float4*)o = h;
    }
  }
}

NOINL void attn_item(const P& p, int id) {
  char* smem = g_smem + VB * 73728;
  const int tid = opaque_tid(), lane = tid & 63, wave = tid >> 6, lr = lane & 15, lg = lane >> 4;
  int row0, kvbase, Lk, hh;
  if (id < 512) { hh = id & 7; const int b = (id >> 3) & 1; const int qb = id >> 4; row0 = 4096 + b * 2048 + qb * 64; kvbase = 4096 + b * 2304; Lk = 2304; }
  else { const int i2 = id - 512; hh = i2 & 7; const int rest = i2 >> 3; const int b = rest >> 2; const int qb = rest & 3; row0 = b * 256 + qb * 64; kvbase = b * 256; Lk = 256; }
  constexpr int LDK = 104, LDV = 72;
  constexpr int KVBUF = 64 * LDK + 64 * LDV;
  bf16_t* sKV = (bf16_t*)smem;
  const int qrow = row0 + wave * 16 + lr;
  bf16x8 qf[3];
#pragma unroll
  for (int ks = 0; ks < 3; ++ks) qf[ks] = *(const bf16x8*)(WSB(OFF_Q) + (size_t)qrow * 768 + hh * 96 + ks * 32 + lg * 8);
  f32x4 oacc[4];
#pragma unroll
  for (int i = 0; i < 4; ++i) oacc[i] = (f32x4){0.f, 0.f, 0.f, 0.f};
  float mrun = -1e30f, lrun = 0.f;
  const int nkt = Lk >> 6;
  const int kkey0 = tid / 12, kcc0 = tid - kkey0 * 12;
  const int c1 = tid + 256, kkey1 = c1 / 12, kcc1 = c1 - kkey1 * 12;
  const int c2 = tid + 512, kkey2 = c2 / 12, kcc2 = c2 - kkey2 * 12;
  const bf16_t* kn = WSB(OFF_KN);
  const bf16_t* kp = WSB(OFF_KPE);
  const bf16_t* ksrc0 = (kcc0 < 8) ? kn + (size_t)(kvbase + kkey0) * 512 + hh * 64 + kcc0 * 8 : kp + (size_t)(kvbase + kkey0) * 32 + (kcc0 - 8) * 8;
  const bf16_t* ksrc1 = (kcc1 < 8) ? kn + (size_t)(kvbase + kkey1) * 512 + hh * 64 + kcc1 * 8 : kp + (size_t)(kvbase + kkey1) * 32 + (kcc1 - 8) * 8;
  const bf16_t* ksrc2 = (kcc2 < 8) ? kn + (size_t)(kvbase + kkey2) * 512 + hh * 64 + kcc2 * 8 : kp + (size_t)(kvbase + kkey2) * 32 + (kcc2 - 8) * 8;
  const int kst0 = (kcc0 < 8) ? 512 * 64 : 32 * 64, kst1 = (kcc1 < 8) ? 512 * 64 : 32 * 64, kst2 = (kcc2 < 8) ? 512 * 64 : 32 * 64;
  const int vd0 = tid >> 3, vcc = tid & 7;
  const bf16_t* vsrc0 = WSB(OFF_VT) + (size_t)(hh * 64 + vd0) * 8704 + kvbase + vcc * 8;
  const bf16_t* vsrc1 = vsrc0 + (size_t)32 * 8704;
  uint4 rk0, rk1, rk2, rv0, rv1;
#define AT_LOAD(kt) { const int _k = (kt); \
    rk0 = *(const uint4*)(ksrc0 + (size_t)_k * kst0); rk1 = *(const uint4*)(ksrc1 + (size_t)_k * kst1); \
    rk2 = *(const uint4*)(ksrc2 + (size_t)_k * kst2); \
    rv0 = *(const uint4*)(vsrc0 + _k * 64); rv1 = *(const uint4*)(vsrc1 + _k * 64); }
#define AT_WRITE(buf) { bf16_t* _b = sKV + (buf) * KVBUF; \
    *(uint4*)(_b + kkey0 * LDK + kcc0 * 8) = rk0; *(uint4*)(_b + kkey1 * LDK + kcc1 * 8) = rk1; \
    *(uint4*)(_b + kkey2 * LDK + kcc2 * 8) = rk2; \
    *(uint4*)(_b + 64 * LDK + vd0 * LDV + vcc * 8) = rv0; *(uint4*)(_b + 64 * LDK + (vd0 + 32) * LDV + vcc * 8) = rv1; }
  AT_LOAD(0)
  AT_WRITE(0)
  __syncthreads();
  for (int kt = 0; kt < nkt; ++kt) {
    const int ktn = min(kt + 1, nkt - 1);
    AT_LOAD(ktn)
    const bf16_t* sK = sKV + (kt & 1) * KVBUF;
    const bf16_t* sV = sK + 64 * LDK;
    f32x4 sacc[4];
#pragma unroll
    for (int n = 0; n < 4; ++n) sacc[n] = (f32x4){0.f, 0.f, 0.f, 0.f};
#pragma unroll
    for (int ks = 0; ks < 3; ++ks)
#pragma unroll
      for (int n = 0; n < 4; ++n) {
        const bf16x8 a = *(const bf16x8*)(sK + (n * 16 + lr) * LDK + ks * 32 + lg * 8);
        sacc[n] = mfma16(a, qf[ks], sacc[n]);
      }
    float mx = sacc[0][0];
#pragma unroll
    for (int n = 0; n < 4; ++n)
#pragma unroll
      for (int q = 0; q < 4; ++q) mx = fmaxf(mx, sacc[n][q]);
    mx = quad_max(mx);
    const float mnew = fmaxf(mrun, mx);
    const float alpha = __builtin_amdgcn_exp2f(mrun - mnew);
    mrun = mnew;
    float ps = 0.f;
#pragma unroll
    for (int n = 0; n < 4; ++n)
#pragma unroll
      for (int q = 0; q < 4; ++q) { const float e = __builtin_amdgcn_exp2f(sacc[n][q] - mnew); sacc[n][q] = e; ps += e; }
    lrun = lrun * alpha + ps;
#pragma unroll
    for (int i = 0; i < 4; ++i)
#pragma unroll
      for (int q = 0; q < 4; ++q) oacc[i][q] *= alpha;
#pragma unroll
    for (int ks = 0; ks < 2; ++ks) {
      union { bf16x8 v; unsigned u[4]; } pf;
      pf.u[0] = pack2(sacc[2 * ks][0], sacc[2 * ks][1]);
      pf.u[1] = pack2(sacc[2 * ks][2], sacc[2 * ks][3]);
      pf.u[2] = pack2(sacc[2 * ks + 1][0], sacc[2 * ks + 1][1]);
      pf.u[3] = pack2(sacc[2 * ks + 1][2], sacc[2 * ks + 1][3]);
#pragma unroll
      for (int m = 0; m < 4; ++m) {
        union { bf16x8 v; uint2 h[2]; } av;
        const bf16_t* vp = sV + (m * 16 + lr) * LDV + ks * 32 + lg * 4;
        av.h[0] = *(const uint2*)(vp);
        av.h[1] = *(const uint2*)(vp + 16);
        oacc[m] = mfma16(av.v, pf.v, oacc[m]);
      }
    }
    __builtin_amdgcn_sched_barrier(0);
    AT_WRITE((kt + 1) & 1)
    __syncthreads();
  }
  lrun = quad_sum(lrun);
  const float inv = 1.f / lrun;
#pragma unroll
  for (int m = 0; m < 4; ++m) {
    uint2 o;
    o.x = pack2(oacc[m][0] * inv, oacc[m][1] * inv);
    o.y = pack2(oacc[m][2] * inv, oacc[m][3] * inv);
    *(uint2*)(WSB(OFF_CAT) + (size_t)qrow * 1024 + hh * 64 + m * 16 + lg * 4) = o;
  }
}

NOINL void ssd_y_item(const P& p, int item) {
  char* smem = g_smem + VB * 73728;
  const int tid = opaque_tid(), lane = tid & 63, wave = tid >> 6, lr = lane & 15, lg = lane >> 4;
  const int cidx = item >> 3, qt = (item >> 1) & 3, half = qt >> 1, g = item & 1;
  const int r0 = cidx * 128;
  const int hh = g * 4 + wave;
  constexpr int LDC = 136, LDM = 72;
  bf16_t* sC = (bf16_t*)smem;
  bf16_t* sB = sC + 64 * LDC;
  bf16_t* sM = sB + 64 * LDC + wave * 64 * LDM;
  float* rowss = (float*)((bf16_t*)smem + 2 * 64 * LDC + 4 * 64 * LDM);
  const float* cum = WSF(OFF_CUM);
  const float* dtv = WSF(OFF_DTV);
  const int srow = tid >> 4, scol = (tid & 15) * 8;
  uint4 pb0, pb1, pb2, pb3;
  {
    const bf16_t* cs = WSB(OFF_CM) + (size_t)(r0 + qt * 32 + srow) * 256 + g * 128 + scol;
    const bf16_t* bs = WSB(OFF_BM) + (size_t)(r0 + srow) * 256 + g * 128 + scol;
    const uint4 c0 = *(const uint4*)(cs), c1 = *(const uint4*)(cs + 16 * 256);
    const uint4 b0 = *(const uint4*)(bs), b1 = *(const uint4*)(bs + 16 * 256), b2 = *(const uint4*)(bs + 32 * 256), b3 = *(const uint4*)(bs + 48 * 256);
    pb0 = *(const uint4*)(bs + 64 * 256); pb1 = *(const uint4*)(bs + 80 * 256); pb2 = *(const uint4*)(bs + 96 * 256); pb3 = *(const uint4*)(bs + 112 * 256);
    bf16_t* wc = sC + srow * LDC + scol;
    bf16_t* wb = sB + srow * LDC + scol;
    *(uint4*)(wc) = c0; *(uint4*)(wc + 16 * LDC) = c1;
    *(uint4*)(wb) = b0; *(uint4*)(wb + 16 * LDC) = b1; *(uint4*)(wb + 32 * LDC) = b2; *(uint4*)(wb + 48 * LDC) = b3;
  }
  __syncthreads();
  f32x4 Y[2][4];
#pragma unroll
  for (int i = 0; i < 2; ++i)
#pragma unroll
    for (int j = 0; j < 4; ++j) Y[i][j] = (f32x4){0.f, 0.f, 0.f, 0.f};
#pragma unroll 1
  for (int jh = 0; jh < 2; ++jh) {
    if (jh == 1) {
      __syncthreads();
      bf16_t* wb = sB + srow * LDC + scol;
      *(uint4*)(wb) = pb0; *(uint4*)(wb + 16 * LDC) = pb1; *(uint4*)(wb + 32 * LDC) = pb2; *(uint4*)(wb + 48 * LDC) = pb3;
      __syncthreads();
    }
#pragma unroll 1
    for (int dir = 0; dir < 2; ++dir) {
      const bool use = dir == 0 ? (jh <= half) : (jh >= half);
      if (!use) continue;
      bf16x8 xf[2][4];
#pragma unroll
      for (int ks = 0; ks < 2; ++ks)
#pragma unroll
        for (int pt = 0; pt < 4; ++pt)
          xf[ks][pt] = *(const bf16x8*)(WSB(OFF_XST) + (size_t)(hh * 64 + pt * 16 + lr) * 8192 + r0 + jh * 64 + ks * 32 + lg * 8);
      float ci[2], cj[4][4], dj[4][4];
#pragma unroll
      for (int it = 0; it < 2; ++it) ci[it] = cum[((size_t)dir * 8192 + r0 + qt * 32 + it * 16 + lr) * 8 + hh];
#pragma unroll
      for (int jt = 0; jt < 4; ++jt)
#pragma unroll
        for (int q = 0; q < 4; ++q) {
          const size_t tj = (size_t)dir * 8192 + r0 + jh * 64 + jt * 16 + lg * 4 + q;
          cj[jt][q] = cum[tj * 8 + hh];
          dj[jt][q] = dtv[tj * 8 + hh];
        }
#pragma unroll
      for (int it = 0; it < 2; ++it) {
        f32x4 cb[4];
#pragma unroll
        for (int jt = 0; jt < 4; ++jt) cb[jt] = (f32x4){0.f, 0.f, 0.f, 0.f};
#pragma unroll
        for (int ks = 0; ks < 4; ++ks) {
          const bf16x8 b = *(const bf16x8*)(sC + (it * 16 + lr) * LDC + ks * 32 + lg * 8);
#pragma unroll
          for (int jt = 0; jt < 4; ++jt) {
            const bf16x8 a = *(const bf16x8*)(sB + (jt * 16 + lr) * LDC + ks * 32 + lg * 8);
            cb[jt] = mfma16(a, b, cb[jt]);
          }
        }
        const int ti = qt * 32 + it * 16 + lr;
#pragma unroll
        for (int jt = 0; jt < 4; ++jt) {
          float v[4];
#pragma unroll
          for (int q = 0; q < 4; ++q) {
            const int tj = jh * 64 + jt * 16 + lg * 4 + q;
            const bool ok = dir == 0 ? (tj <= ti) : (tj >= ti);
            v[q] = ok ? cb[jt][q] * __expf(ci[it] - cj[jt][q]) * dj[jt][q] : 0.f;
          }
          uint2 o;
          o.x = pack2(v[0], v[1]);
          o.y = pack2(v[2], v[3]);
          *(uint2*)(sM + (it * 16 + lr) * LDM + jt * 16 + lg * 4) = o;
        }
        __builtin_amdgcn_sched_barrier(0);
      }
      asm volatile("s_waitcnt lgkmcnt(0)" ::: "memory");
#pragma unroll
      for (int ks = 0; ks < 2; ++ks) {
        bf16x8 af[2];
#pragma unroll
        for (int it = 0; it < 2; ++it) af[it] = *(const bf16x8*)(sM + (it * 16 + lr) * LDM + ks * 32 + lg * 8);
#pragma unroll
        for (int it = 0; it < 2; ++it)
#pragma unroll
          for (int pt = 0; pt < 4; ++pt) Y[it][pt] = mfma16(af[it], xf[ks][pt], Y[it][pt]);
      }
      asm volatile("s_waitcnt lgkmcnt(0)" ::: "memory");
      __builtin_amdgcn_sched_barrier(0);
    }
  }
#pragma unroll 1
  for (int dir = 0; dir < 2; ++dir) {
    const bf16_t* hp = WSB(OFF_H) + ((size_t)(dir * 64 + cidx) * 8 + hh) * 8192;
    float ei[2][4];
#pragma unroll
    for (int it = 0; it < 2; ++it)
#pragma unroll
      for (int q = 0; q < 4; ++q)
        ei[it][q] = __expf(cum[((size_t)dir * 8192 + r0 + qt * 32 + it * 16 + lg * 4 + q) * 8 + hh]);
#pragma unroll
    for (int pt = 0; pt < 4; ++pt) {
      bf16x8 bfr[4];
#pragma unroll
      for (int ks = 0; ks < 4; ++ks) bfr[ks] = *(const bf16x8*)(hp + (size_t)(pt * 16 + lr) * 128 + ks * 32 + lg * 8);
      f32x4 T[2];
#pragma unroll
      for (int it = 0; it < 2; ++it) T[it] = (f32x4){0.f, 0.f, 0.f, 0.f};
#pragma unroll
      for (int ks = 0; ks < 4; ++ks)
#pragma unroll
        for (int it = 0; it < 2; ++it) {
          const bf16x8 a = *(const bf16x8*)(sC + (it * 16 + lr) * LDC + ks * 32 + lg * 8);
          T[it] = mfma16(a, bfr[ks], T[it]);
        }
#pragma unroll
      for (int it = 0; it < 2; ++it)
#pragma unroll
        for (int q = 0; q < 4; ++q) Y[it][pt][q] += ei[it][q] * T[it][q];
    }
    __builtin_amdgcn_sched_barrier(0);
  }
  const float dsk = p.ssd_d[hh];
  const float* proj = WSF(OFF_R1);
#pragma unroll
  for (int i = 0; i < 2; ++i) {
#pragma unroll
    for (int q = 0; q < 4; ++q) {
      const int il = i * 16 + lg * 4 + q;
      const size_t r = (size_t)r0 + qt * 32 + il;
      float ss = 0.f;
#pragma unroll
      for (int j = 0; j < 4; ++j) {
        const int ch = hh * 64 + j * 16 + lr;
        const float xs = bf2f(WSB(OFF_XS)[r * 512 + ch]);
        const float z = proj[r * 2096 + 544 + ch];
        const float y = (Y[i][j][q] + dsk * xs) * silu(z);
        Y[i][j][q] = y;
        ss += y * y;
      }
      ss += __shfl_xor(ss, 1, 64);
      ss += __shfl_xor(ss, 2, 64);
      ss += __shfl_xor(ss, 4, 64);
      ss += __shfl_xor(ss, 8, 64);
      if (lr == 0) rowss[wave * 64 + il] = ss;
    }
    __builtin_amdgcn_sched_barrier(0);
  }
  __syncthreads();
#pragma unroll
  for (int i = 0; i < 2; ++i) {
#pragma unroll
    for (int q = 0; q < 4; ++q) {
      const int il = i * 16 + lg * 4 + q;
      const size_t r = (size_t)r0 + qt * 32 + il;
      const float tot = rowss[il] + rowss[64 + il] + rowss[128 + il] + rowss[192 + il];
      const float rs = rsqrtf(tot * (1.f / 256.f) + 1e-6f);
#pragma unroll
      for (int j = 0; j < 4; ++j) {
        const int ch = hh * 64 + j * 16 + lr;
        WSB(OFF_CAT)[r * 1024 + 512 + ch] = f2bf(Y[i][j][q] * rs * p.ssd_norm[ch]);
      }
    }
    __builtin_amdgcn_sched_barrier(0);
  }
  __syncthreads();
}

template <int W2>
DEVI void pool_item(const bf16_t* __restrict__ h, bf16_t* __restrict__ dst, int r, int cc) {
  int s0, L;
  if (r < 4096) { s0 = r & ~255; L = 256; } else { s0 = 4096 + ((r - 4096) & ~2047); L = 2048; }
  const int t = r - s0;
  const int lo = max(t - W2, 0), hi = min(t + W2, L);
  uint4 v[2 * W2];
#pragma unroll
  for (int k = 0; k < 2 * W2; ++k) {
    const int u = min(max(t - W2 + k, 0), L - 1);
    v[k] = *(const uint4*)(h + (size_t)(s0 + u) * 1024 + cc);
  }
  float acc[8] = {0, 0, 0, 0, 0, 0, 0, 0};
#pragma unroll
  for (int k = 0; k < 2 * W2; ++k) {
    const int u = t - W2 + k;
    const float m = (u >= 0 && u < L) ? 1.f : 0.f;
    acc[0] += m * __uint_as_float(v[k].x << 16); acc[1] += m * __uint_as_float(v[k].x & 0xffff0000u);
    acc[2] += m * __uint_as_float(v[k].y << 16); acc[3] += m * __uint_as_float(v[k].y & 0xffff0000u);
    acc[4] += m * __uint_as_float(v[k].z << 16); acc[5] += m * __uint_as_float(v[k].z & 0xffff0000u);
    acc[6] += m * __uint_as_float(v[k].w << 16); acc[7] += m * __uint_as_float(v[k].w & 0xffff0000u);
  }
  const float inv = 1.f / (float)(hi - lo);
  const uint4 c = v[W2];
  uint4 o;
  o.x = pack2(acc[0] * inv - __uint_as_float(c.x << 16), acc[1] * inv - __uint_as_float(c.x & 0xffff0000u));
  o.y = pack2(acc[2] * inv - __uint_as_float(c.y << 16), acc[3] * inv - __uint_as_float(c.y & 0xffff0000u));
  o.z = pack2(acc[4] * inv - __uint_as_float(c.z << 16), acc[5] * inv - __uint_as_float(c.z & 0xffff0000u));
  o.w = pack2(acc[6] * inv - __uint_as_float(c.w << 16), acc[7] * inv - __uint_as_float(c.w & 0xffff0000u));
  *(uint4*)(dst + (size_t)r * 1024 + cc) = o;
}

NOINL void pool_phase(const P& p) {
  const bf16_t* h = WSB(OFF_H);
  bf16_t* dst = WSB(OFF_CAT);
  const int total = 8192 * 128;
  for (int idx = blockIdx.x * 512 + threadIdx.x; idx < total; idx += gridDim.x * 512) {
    const int c32 = idx & 31, rlo = (idx >> 5) & 1, gi = (idx >> 6) & 3, rhi = idx >> 8;
    const int r = rhi * 2 + rlo, cc = gi * 256 + c32 * 8;
    if (gi == 0) pool_item<1>(h, dst, r, cc);
    else if (gi == 1) pool_item<2>(h, dst, r, cc);
    else if (gi == 2) pool_item<4>(h, dst, r, cc);
    else pool_item<8>(h, dst, r, cc);
  }
}

NOINL void ph_gemm_proj(const P& p) {
  float* proj = WSF(OFF_R1);
  const bf16_t* A = WSB(OFF_H);
  const bf16_t* B = WSB(OFF_WIN);
  auto epi = [&](int ctx, int row, int col, f32x4 v0, f32x4 v1) {
#pragma unroll
    for (int q = 0; q < 4; ++q) {
      if (col < 2096) proj[(size_t)(row + q) * 2096 + col] = v0[q];
      if (col + 16 < 2096) proj[(size_t)(row + q) * 2096 + col + 16] = v1[q];
    }
  };
  gemm8_stream(256, 1024, 1024, 1024,
    [=](int t) {
      TileInfo r;
      int m, n; tile_mn(t, 32, 8, m, n);
      r.m0 = m * 256; r.n0 = n * 256; r.ctx = 0;
      r.a = A + (size_t)r.m0 * 1024; r.b = B + (size_t)r.n0 * 1024;
      return r;
    }, epi);
  gemm_stream(64, 1024, 1024, 1024, g_smem + VB * 73728,
    [=](int t) {
      TileInfo r;
      r.m0 = t * 128; r.n0 = 2048; r.ctx = 0;
      r.a = A + (size_t)r.m0 * 1024; r.b = B + (size_t)2048 * 1024;
      return r;
    }, epi);
}

NOINL void ph_gemm_f32out(const P& p, const bf16_t* A, int lda, const bf16_t* B, int ldb, int K, bf16_t* C, int N) {
  const int nN = N / 128;
  gemm_stream(64 * nN, lda, ldb, K, g_smem + VB * 73728,
    [=](int t) {
      TileInfo r;
      int m, n; tile_mn(t, 64, nN, m, n);
      r.m0 = m * 128; r.n0 = n * 128; r.ctx = 0;
      r.a = A + (size_t)r.m0 * lda; r.b = B + (size_t)r.n0 * ldb;
      return r;
    },
    [&](int ctx, int row, int col, f32x4 v0, f32x4 v1) {
#pragma unroll
      for (int q = 0; q < 4; ++q) {
        C[(size_t)(row + q) * N + col] = f2bf(v0[q]);
        C[(size_t)(row + q) * N + col + 16] = f2bf(v1[q]);
      }
    });
}

NOINL void ph_gemm8_splitk(const P& p, const bf16_t* A, int lda, const bf16_t* B, int ldb, int Khalf, bf16_t* C0, bf16_t* C1) {
  gemm8_stream(256, lda, ldb, Khalf,
    [=](int t) {
      TileInfo r;
      const int id = swz_tile(t, 256);
      const int ks = id >> 7, rem = id & 127;
      r.m0 = (rem >> 2) * 256; r.n0 = (rem & 3) * 256; r.ctx = ks;
      r.a = A + (size_t)r.m0 * lda + (size_t)ks * Khalf; r.b = B + (size_t)r.n0 * ldb + (size_t)ks * Khalf;
      return r;
    },
    [&](int ks, int row, int col, f32x4 v0, f32x4 v1) {
      bf16_t* C = ks ? C1 : C0;
#pragma unroll
      for (int q = 0; q < 4; ++q) {
        C[(size_t)(row + q) * 1024 + col] = f2bf(v0[q]);
        C[(size_t)(row + q) * 1024 + col + 16] = f2bf(v1[q]);
      }
    });
}

NOINL void ph_gemm_q(const P& p) {
  bf16_t* qo = WSB(OFF_Q);
  const bf16_t* A = WSB(OFF_CQN);
  const bf16_t* B = WSB(OFF_WUQ);
  gemm_stream(64 * 6, 256, 256, 256, g_smem + VB * 73728,
    [=](int t) {
      TileInfo r;
      int m, n; tile_mn(t, 64, 6, m, n);
      r.m0 = m * 128; r.n0 = n * 128; r.ctx = 0;
      r.a = A + (size_t)r.m0 * 256; r.b = B + (size_t)r.n0 * 256;
      return r;
    },
    [&](int ctx, int row, int col, f32x4 v0, f32x4 v1) {
      const float scl = 0.10206207261596575f * 1.4426950408889634f;
      const int tn = col >> 4;
      const bool rope = ((tn % 6) == 4) && (row >= 4096);
      const int ii = col & 15;
      const float fr = rope_freq(ii & 7);
#pragma unroll
      for (int q = 0; q < 4; ++q) {
        float a = v0[q], b = v1[q];
        if (rope) {
          const int tt = (row + q - 4096) & 2047;
          const float pos = (ii < 8) ? (float)(tt >> 6) : (float)(tt & 63);
          const float ang = pos * fr;
          float cs, sn;
          fast_sincos(ang, sn, cs);
          const float x1 = a, x2 = b;
          a = x1 * cs - x2 * sn;
          b = x1 * sn + x2 * cs;
        }
        qo[(size_t)(row + q) * 768 + col] = f2bf(a * scl);
        qo[(size_t)(row + q) * 768 + col + 16] = f2bf(b * scl);
      }
    });
}

NOINL void ph_gemm_kv(const P& p) {
  bf16_t* kn = WSB(OFF_KN);
  bf16_t* vt = WSB(OFF_VT);
  const bf16_t* A = WSB(OFF_CKV);
  const bf16_t* B = WSB(OFF_WUKV);
  gemm_stream(68 * 8, 256, 256, 256, g_smem + VB * 73728,
    [=](int t) {
      TileInfo r;
      int m, n; tile_mn(t, 68, 8, m, n);
      r.m0 = m * 128; r.n0 = n * 128; r.ctx = 0;
      r.a = A + (size_t)r.m0 * 256; r.b = B + (size_t)r.n0 * 256;
      return r;
    },
    [&](int ctx, int row, int col, f32x4 v0, f32x4 v1) {
      const int hh = col >> 7, j = col & 127;
      if (j < 64) {
#pragma unroll
        for (int q = 0; q < 4; ++q) {
          kn[(size_t)(row + q) * 512 + hh * 64 + j] = f2bf(v0[q]);
          kn[(size_t)(row + q) * 512 + hh * 64 + j + 16] = f2bf(v1[q]);
        }
      } else {
        uint2 o0, o1;
        o0.x = pack2(v0[0], v0[1]); o0.y = pack2(v0[2], v0[3]);
        o1.x = pack2(v1[0], v1[1]); o1.y = pack2(v1[2], v1[3]);
        *(uint2*)(vt + (size_t)(hh * 64 + j - 64) * 8704 + row) = o0;
        *(uint2*)(vt + (size_t)(hh * 64 + j - 64 + 16) * 8704 + row) = o1;
      }
    });
}

NOINL void ph_gemm_ffn_up(const P& p, int layer) {
  bf16_t* gu = WSB(OFF_R1);
  const bf16_t* A = WSB(OFF_H);
  const bf16_t* B = WSB(OFF_WGU) + (size_t)layer * 5632 * 1024;
  gemm8_stream(32 * 22, 1024, 1024, 1024,
    [=](int t) {
      TileInfo r;
      int m, n; tile_mn(t, 32, 22, m, n);
      r.m0 = m * 256; r.n0 = n * 256; r.ctx = 0;
      r.a = A + (size_t)r.m0 * 1024; r.b = B + (size_t)r.n0 * 1024;
      return r;
    },
    [&](int ctx, int row, int col, f32x4 v0, f32x4 v1) {
      const int oc = (col >> 5) * 16 + (col & 15);
#pragma unroll
      for (int q = 0; q < 4; ++q) gu[(size_t)(row + q) * 2816 + oc] = f2bf(silu(v0[q]) * v1[q]);
    });
}

NOINL void ph_gemm_pool(const P& p) {
  bf16_t* mix = WSB(OFF_R1);
  const bf16_t* A = WSB(OFF_CAT);
  const bf16_t* B = WSB(OFF_WPOOL);
  gemm_stream(512, 1024, 256, 256, g_smem + VB * 73728,
    [=](int t) {
      TileInfo r;
      const int id = swz_tile(t, 512);
      const int g = id >> 7, rem = id & 127;
      r.m0 = (rem >> 1) * 128; r.n0 = (rem & 1) * 128; r.ctx = g;
      r.a = A + (size_t)r.m0 * 1024 + g * 256; r.b = B + (size_t)g * 65536 + (size_t)r.n0 * 256;
      return r;
    },
    [&](int g, int row, int col, f32x4 v0, f32x4 v1) {
      const int c0 = g * 256 + col;
      const float s0 = p.pool_scale[c0], s1 = p.pool_scale[c0 + 16];
#pragma unroll
      for (int q = 0; q < 4; ++q) {
        mix[(size_t)(row + q) * 1024 + c0] = f2bf(v0[q] * s0);
        mix[(size_t)(row + q) * 1024 + c0 + 16] = f2bf(v1[q] * s1);
      }
    });
}


#define XB_TMO      128
#define XB_XCNT(j)  (256  + 64 * (j))
#define XB_XSUB(j)  (1280 + 64 * (j))
#define XB_XGEN(j)  (2304 + 64 * (j))
#define XB_TOP      3328
#define XB_TOPGEN   3392
#define XCD_BAR_WORDS 3456
#define XB_SPIN_CAP (1u << 22)
#define LAS __attribute__((address_space(3)))
DEVI unsigned xb_ld(unsigned* p) { return __hip_atomic_load(p, __ATOMIC_RELAXED, __HIP_MEMORY_SCOPE_AGENT); }
DEVI unsigned xb_add(unsigned* p, unsigned v) { return __hip_atomic_fetch_add(p, v, __ATOMIC_RELAXED, __HIP_MEMORY_SCOPE_AGENT); }
DEVI unsigned xb_xcc_id() { return (unsigned)__builtin_amdgcn_s_getreg((3 << 11) | 20) & 0xFu; }
#define XB_SPIN(cond, bar) do { unsigned _sp = 0; while (cond) { __builtin_amdgcn_s_sleep(1); \
    if ((++_sp & 255u) == 0u) { if (xb_ld(&(bar)[XB_TMO])) break; if (_sp > XB_SPIN_CAP) { atomicAdd(&(bar)[XB_TMO], 1u); break; } } } } while (0)
struct XcdBarrier { unsigned* bar; unsigned x; volatile LAS unsigned* st; };
DEVI XcdBarrier xcd_barrier_post(unsigned* bar, volatile LAS unsigned* st) {
  XcdBarrier b; b.bar = bar; b.x = xb_xcc_id(); b.st = st;
  if (threadIdx.x == 0) (void)xb_add(&bar[XB_XCNT(b.x)], 1u);
  return b;
}
DEVI void xcd_barrier_complete(unsigned* bar, unsigned x, unsigned& nloc, unsigned& nx) {
  const unsigned G = gridDim.x * gridDim.y * gridDim.z;
  unsigned sum, cnt, mine, sp = 0u;
  for (;;) {
    sum = 0u; cnt = 0u; mine = 0u;
#pragma unroll
    for (unsigned j = 0; j < 16; ++j) { const unsigned c = xb_ld(&bar[XB_XCNT(j)]); sum += c; cnt += (c > 0u) ? 1u : 0u; mine = (j == x) ? c : mine; }
    if (sum == G) break;
    __builtin_amdgcn_s_sleep(1);
    if ((++sp & 255u) == 0u) { if (xb_ld(&bar[XB_TMO])) break; if (sp > XB_SPIN_CAP) { atomicAdd(&bar[XB_TMO], 1u); break; } }
  }
  nloc = mine > 0u ? mine : 1u; nx = cnt > 0u ? cnt : 1u;
}
DEVI void xcd_barrier(const XcdBarrier& b) {
  asm volatile("s_waitcnt vmcnt(0)" ::: "memory");
  __syncthreads();
  if (threadIdx.x == 0) {
    unsigned* bar = b.bar;
    __builtin_amdgcn_s_waitcnt(0);
    unsigned nloc = b.st[0], nx = b.st[1];
    if (nloc == 0u) { xcd_barrier_complete(bar, b.x, nloc, nx); b.st[0] = nloc; b.st[1] = nx; }
    const unsigned old = xb_add(&bar[XB_XSUB(b.x)], 1u);
    const unsigned gen = old / nloc;
    if (old + 1u == (gen + 1u) * nloc) {
      __builtin_amdgcn_fence(__ATOMIC_RELEASE, "agent");
      asm volatile("s_waitcnt vmcnt(0)" ::: "memory");
      const unsigned og = xb_add(&bar[XB_TOP], 1u);
      const unsigned tg = og / nx;
      if (og + 1u == (tg + 1u) * nx) xb_add(&bar[XB_TOPGEN], 1u);
      else XB_SPIN(xb_ld(&bar[XB_TOPGEN]) == tg, bar);
      __builtin_amdgcn_fence(__ATOMIC_ACQUIRE, "agent");
      xb_add(&bar[XB_XGEN(b.x)], 1u);
      asm volatile("s_waitcnt vmcnt(0)" ::: "memory");
    } else {
      XB_SPIN(xb_ld(&bar[XB_XGEN(b.x)]) == gen, bar);
      __builtin_amdgcn_fence(__ATOMIC_ACQUIRE, "agent");
      asm volatile("s_waitcnt vmcnt(0)" ::: "memory");
    }
  }
  __syncthreads();
}

constexpr int NPHASE = 18;
#ifndef REPMASK
#define REPMASK 0
#endif
#ifndef P6PROBE
#define P6PROBE 1
#endif
#ifndef PHMASK
#define PHMASK 0x3ffff
#endif
#define PH(n) if constexpr ((PHMASK >> (n)) & 1)

__global__ void __launch_bounds__(512, 2) mega(P p, int lo, int hi) {
  __shared__ uint4 xb_words;
  if (threadIdx.x == 0) xb_words = make_uint4(0u, 0u, 0u, 0u);
  __syncthreads();
  XcdBarrier xb = xcd_barrier_post((unsigned*)(p.ws + OFF_BAR), (volatile LAS unsigned*)&xb_words);
  if (lo < 0) cg::this_grid().sync();
  PH(0) if (lo <= 0 && 0 < hi) {
#if (REPMASK >> 0) & 1
    int nrep = 2; asm volatile("" : "+s"(nrep));
    for (int rep = 0; rep < nrep; ++rep) {
      if (rep) xcd_barrier(xb);
#else
    {
#endif
        for (int t0_ = blockIdx.x * 2; t0_ < 384 + 5200; t0_ += gridDim.x * 2) {
          const int t = min(t0_ + VB, 384 + 5200 - 1);
          if (t < 384) gemv_tile(p, t); else transpose_tile(p, t - 384);
        }
    }
  }
  if (lo <= 0 && 0 + 1 < hi) xcd_barrier(xb);
  PH(1) if (lo <= 1 && 1 < hi) {
#if (REPMASK >> 1) & 1
    int nrep = 2; asm volatile("" : "+s"(nrep));
    for (int rep = 0; rep < nrep; ++rep) {
      if (rep) xcd_barrier(xb);
#else
    {
#endif
        rowop<false, true, true, false, false>(p, nullptr, nullptr, nullptr, 0, p.n_pre_mix, 0, 1, 0, 0);
    }
  }
  if (lo <= 1 && 1 + 1 < hi) xcd_barrier(xb);
  PH(2) if (lo <= 2 && 2 < hi) {
#if (REPMASK >> 2) & 1
    int nrep = 2; asm volatile("" : "+s"(nrep));
    for (int rep = 0; rep < nrep; ++rep) {
      if (rep) xcd_barrier(xb);
#else
    {
#endif
        ph_gemm_proj(p);
    }
  }
  if (lo <= 2 && 2 + 1 < hi) xcd_barrier(xb);
  PH(3) if (lo <= 3 && 3 < hi) {
#if (REPMASK >> 3) & 1
    int nrep = 2; asm volatile("" : "+s"(nrep));
    for (int rep = 0; rep < nrep; ++rep) {
      if (rep) xcd_barrier(xb);
#else
    {
#endif
        prep_rows(p);
        prep_cache(p);
        for (int t0_ = VT_FIRST; t0_ < 2048; t0_ += gridDim.x * 2) conv_tile(p, min(t0_ + VT_OFF, 2047));
    }
  }
  if (lo <= 3 && 3 + 1 < hi) xcd_barrier(xb);
  PH(4) if (lo <= 4 && 4 < hi) {
#if (REPMASK >> 4) & 1
    int nrep = 2; asm volatile("" : "+s"(nrep));
    for (int rep = 0; rep < nrep; ++rep) {
      if (rep) xcd_barrier(xb);
#else
    {
#endif
        ph_gemm_q(p);
        ph_gemm_kv(p);
        for (int t0_ = VT_FIRST; t0_ < 512; t0_ += gridDim.x * 2) chunk_state_item(p, min(t0_ + VT_OFF, 511));
    }
  }
  if (lo <= 4 && 4 + 1 < hi) xcd_barrier(xb);
  PH(5) if (lo <= 5 && 5 < hi) {
#if (REPMASK >> 5) & 1
    int nrep = 2; asm volatile("" : "+s"(nrep));
    for (int rep = 0; rep < nrep; ++rep) {
      if (rep) xcd_barrier(xb);
#else
    {
#endif
        scan_states(p);
    }
  }
  if (lo <= 5 && 5 + 1 < hi) xcd_barrier(xb);
  PH(6) if (lo <= 6 && 6 < hi) {
#if (REPMASK >> 6) & 1
    int nrep = 2; asm volatile("" : "+s"(nrep));
    for (int rep = 0; rep < nrep; ++rep) {
      if (rep) xcd_barrier(xb);
#else
    {
#endif
        for (int t0_ = VT_FIRST; t0_ < 1024; t0_ += gridDim.x * 2) {
          const int t = min(t0_ + VT_OFF, 1023);
          if (t >= 512) ssd_y_item(p, t - 512);
          attn_item(p, t);
        }
    }
  }
  if (lo <= 6 && 6 + 1 < hi) xcd_barrier(xb);
  PH(7) if (lo <= 7 && 7 < hi) {
#if (REPMASK >> 7) & 1
    int nrep = 2; asm volatile("" : "+s"(nrep));
    for (int rep = 0; rep < nrep; ++rep) {
      if (rep) xcd_barrier(xb);
#else
    {
#endif
        ph_gemm8_splitk(p, WSB(OFF_CAT), 1024, WSB(OFF_WOUT), 1024, 512, WSB(OFF_R1), WSB(OFF_R1) + (size_t)8192 * 1024);
    }
  }
  if (lo <= 7 && 7 + 1 < hi) xcd_barrier(xb);
  PH(8) if (lo <= 8 && 8 < hi) {
#if (REPMASK >> 8) & 1
    int nrep = 2; asm volatile("" : "+s"(nrep));
    for (int rep = 0; rep < nrep; ++rep) {
      if (rep) xcd_barrier(xb);
#else
    {
#endif
        rowop<true, true, true, false, true>(p, WSB(OFF_R1), WSB(OFF_R1) + (size_t)8192 * 1024, p.n_post_mix, 2, p.n_pre_ffn, 3, 4, 0, 0);
    }
  }
  if (lo <= 8 && 8 + 1 < hi) xcd_barrier(xb);
  PH(9) if (lo <= 9 && 9 < hi) {
#if (REPMASK >> 9) & 1
    int nrep = 2; asm volatile("" : "+s"(nrep));
    for (int rep = 0; rep < nrep; ++rep) {
      if (rep) xcd_barrier(xb);
#else
    {
#endif
        ph_gemm_ffn_up(p, 0);
    }
  }
  if (lo <= 9 && 9 + 1 < hi) xcd_barrier(xb);
  PH(10) if (lo <= 10 && 10 < hi) {
#if (REPMASK >> 10) & 1
    int nrep = 2; asm volatile("" : "+s"(nrep));
    for (int rep = 0; rep < nrep; ++rep) {
      if (rep) xcd_barrier(xb);
#else
    {
#endif
        ph_gemm8_splitk(p, WSB(OFF_R1), 2816, WSB(OFF_WDN), 2816, 1408, WSB(OFF_R2), WSB(OFF_R2) + (size_t)8192 * 1024);
    }
  }
  if (lo <= 10 && 10 + 1 < hi) xcd_barrier(xb);
  PH(11) if (lo <= 11 && 11 < hi) {
#if (REPMASK >> 11) & 1
    int nrep = 2; asm volatile("" : "+s"(nrep));
    for (int rep = 0; rep < nrep; ++rep) {
      if (rep) xcd_barrier(xb);
#else
    {
#endif
        rowop<true, true, false, false, true>(p, WSB(OFF_R2), WSB(OFF_R2) + (size_t)8192 * 1024, p.n_post_ffn, 5, p.n_pre_mix + 1024, 0, 1, 0, 1);
    }
  }
  if (lo <= 11 && 11 + 1 < hi) xcd_barrier(xb);
  PH(12) if (lo <= 12 && 12 < hi) {
#if (REPMASK >> 12) & 1
    int nrep = 2; asm volatile("" : "+s"(nrep));
    for (int rep = 0; rep < nrep; ++rep) {
      if (rep) xcd_barrier(xb);
#else
    {
#endif
        pool_phase(p);
    }
  }
  if (lo <= 12 && 12 + 1 < hi) xcd_barrier(xb);
  PH(13) if (lo <= 13 && 13 < hi) {
#if (REPMASK >> 13) & 1
    int nrep = 2; asm volatile("" : "+s"(nrep));
    for (int rep = 0; rep < nrep; ++rep) {
      if (rep) xcd_barrier(xb);
#else
    {
#endif
        ph_gemm_pool(p);
    }
  }
  if (lo <= 13 && 13 + 1 < hi) xcd_barrier(xb);
  PH(14) if (lo <= 14 && 14 < hi) {
#if (REPMASK >> 14) & 1
    int nrep = 2; asm volatile("" : "+s"(nrep));
    for (int rep = 0; rep < nrep; ++rep) {
      if (rep) xcd_barrier(xb);
#else
    {
#endif
        rowop<true, true, false, false, false>(p, WSB(OFF_R1), nullptr, p.n_post_mix + 1024, 2, p.n_pre_ffn + 1024, 3, 4, 1, 1);
    }
  }
  if (lo <= 14 && 14 + 1 < hi) xcd_barrier(xb);
  PH(15) if (lo <= 15 && 15 < hi) {
#if (REPMASK >> 15) & 1
    int nrep = 2; asm volatile("" : "+s"(nrep));
    for (int rep = 0; rep < nrep; ++rep) {
      if (rep) xcd_barrier(xb);
#else
    {
#endif
        ph_gemm_ffn_up(p, 1);
    }
  }
  if (lo <= 15 && 15 + 1 < hi) xcd_barrier(xb);
  PH(16) if (lo <= 16 && 16 < hi) {
#if (REPMASK >> 16) & 1
    int nrep = 2; asm volatile("" : "+s"(nrep));
    for (int rep = 0; rep < nrep; ++rep) {
      if (rep) xcd_barrier(xb);
#else
    {
#endif
        ph_gemm8_splitk(p, WSB(OFF_R1), 2816, WSB(OFF_WDN) + (size_t)1024 * 2816, 2816, 1408, WSB(OFF_R2), WSB(OFF_R2) + (size_t)8192 * 1024);
    }
  }
  if (lo <= 16 && 16 + 1 < hi) xcd_barrier(xb);
  PH(17) if (lo <= 17 && 17 < hi) {
#if (REPMASK >> 17) & 1
    int nrep = 2; asm volatile("" : "+s"(nrep));
    for (int rep = 0; rep < nrep; ++rep) {
      if (rep) xcd_barrier(xb);
#else
    {
#endif
        rowop<true, false, false, true, true>(p, WSB(OFF_R2), WSB(OFF_R2) + (size_t)8192 * 1024, p.n_post_ffn + 1024, 5, nullptr, 0, 0, 1, 1);
    }
  }
}

extern "C" void kernel_launch(void* const* d_in, const int* in_sizes, int n_in, void* d_out, int out_size, void* d_ws,
                              size_t ws_size, hipStream_t stream) {
  P p{};
  const float** f = (const float**)&p;
  for (int i = 0; i < 33; ++i) f[i] = (const float*)d_in[i];
  p.out = (float*)d_out;
  p.ws = (char*)d_ws;
  static int grid_blocks = 0;
  if (!grid_blocks) {
    int dev = 0, cus = 0, per_cu = 0;
    hipGetDevice(&dev);
    hipDeviceGetAttribute(&cus, hipDeviceAttributeMultiprocessorCount, dev);
    hipOccupancyMaxActiveBlocksPerMultiprocessor(&per_cu, mega, 512, 0);
    if (per_cu > 1) per_cu = 1;
    if (per_cu < 1) per_cu = 1;
    grid_blocks = cus * per_cu;
  }
  hipMemsetAsync((char*)d_ws + OFF_BAR, 0, XCD_BAR_WORDS * 4, stream);
#if SINGLE_LAUNCH
  int lo = 0, hi = NPHASE;
  void* args[] = {&p, &lo, &hi};
  hipError_t e = hipLaunchCooperativeKernel((void*)mega, dim3(grid_blocks), dim3(512), args, 0, stream);
  if (e != hipSuccess) fprintf(stderr, "cooperative launch failed: %s (grid %d)\n", hipGetErrorString(e), grid_blocks);
#else
  for (int ph = 0; ph < NPHASE; ++ph) mega<<<grid_blocks, 512, 0, stream>>>(p, ph, ph + 1);
#endif
}
```

```cpp
#include <hip/hip_runtime.h>
#include <hip/hip_cooperative_groups.h>
#include <stdint.h>
#include <stdio.h>
namespace cg = cooperative_groups;

#ifndef SINGLE_LAUNCH
#define SINGLE_LAUNCH 1
#endif

typedef __attribute__((ext_vector_type(8))) short bf16x8;
typedef __attribute__((ext_vector_type(4))) float f32x4;
typedef unsigned short bf16_t;

#define DEVI __device__ __forceinline__

constexpr size_t OFF_WIN   = 0;
constexpr size_t OFF_WUQ   = OFF_WIN   + (size_t)2176*1024*2;
constexpr size_t OFF_WUKV  = OFF_WUQ   + (size_t)768*256*2;
constexpr size_t OFF_WOUT  = OFF_WUKV  + (size_t)1024*256*2;
constexpr size_t OFF_WPOOL = OFF_WOUT  + (size_t)1024*1024*2;
constexpr size_t OFF_WGU   = OFF_WPOOL + (size_t)4*256*256*2;
constexpr size_t OFF_WDN   = OFF_WGU   + (size_t)2*5632*1024*2;
constexpr size_t OFF_MOD   = OFF_WDN   + (size_t)2*1024*2816*2;
constexpr size_t OFF_R1    = OFF_MOD   + (size_t)2*3*6144*4;
constexpr size_t OFF_R2    = OFF_R1    + (size_t)8192*2096*4;
constexpr size_t OFF_H     = OFF_R2    + (size_t)8192*1024*4;
constexpr size_t OFF_CAT   = OFF_H     + (size_t)8192*1024*2;
constexpr size_t OFF_Q     = OFF_CAT   + (size_t)8192*1024*2;
constexpr size_t OFF_KN    = OFF_Q     + (size_t)8192*768*2;
constexpr size_t OFF_VT    = OFF_KN    + (size_t)8704*512*2;
constexpr size_t OFF_CQN   = OFF_VT    + (size_t)8704*512*2;
constexpr size_t OFF_CKV   = OFF_CQN   + (size_t)8192*256*2;
constexpr size_t OFF_KPE   = OFF_CKV   + (size_t)8704*256*2;
constexpr size_t OFF_XS    = OFF_KPE   + (size_t)8704*32*2;
constexpr size_t OFF_XST   = OFF_XS    + (size_t)8192*512*2;
constexpr size_t OFF_BM    = OFF_XST   + (size_t)8192*512*2;
constexpr size_t OFF_BT    = OFF_BM    + (size_t)8192*256*2;
constexpr size_t OFF_CM    = OFF_BT    + (size_t)8192*256*2;
constexpr size_t OFF_DTV   = OFF_CM    + (size_t)8192*256*2;
constexpr size_t OFF_CUM   = OFF_DTV   + (size_t)2*8192*8*4;
constexpr size_t OFF_TOT   = OFF_CUM   + (size_t)2*8192*8*4;
constexpr size_t OFF_BAR   = OFF_TOT   + 4096;
constexpr size_t OFF_XR    = OFF_BAR   + 16384;
constexpr size_t OFF_END   = OFF_XR    + (size_t)8192*1024*2;
static_assert(OFF_END <= ((size_t)256 << 20), "workspace map exceeds 256 MiB");

constexpr size_t OUT_CKV = 8388608, OUT_KR = 9437184, OUT_SF = 9568256, OUT_SB = 10616832;

struct P {
  const float *x_prompt, *x_sample, *c, *cache_ckv, *cache_kr, *st_f, *st_b, *c_ctx;
  const float *w_mod, *b_mod, *n_pre_mix, *n_post_mix, *n_pre_ffn, *n_post_ffn;
  const float *w_in, *q_norm, *w_uq, *kv_norm, *w_ukv, *conv_w, *conv_b, *dtb_f, *dtb_b, *alog_f, *alog_b;
  const float *ssd_d, *ssd_norm, *w_out, *pool_w, *pool_scale, *w_gate, *w_up, *w_down;
  float* out;
  char* ws;
};

#define WSB(off) ((bf16_t*)(p.ws + (off)))
#define WSF(off) ((float*)(p.ws + (off)))

typedef __bf16 hwbf16x2 __attribute__((ext_vector_type(2)));
typedef float hwf32x2 __attribute__((ext_vector_type(2)));
DEVI bf16_t f2bf(float f) {
  __bf16 r = (__bf16)f;
  return __builtin_bit_cast(bf16_t, r);
}
DEVI float bf2f(bf16_t b) { return __uint_as_float(((unsigned)b) << 16); }
DEVI unsigned pack2(float a, float b) {
  hwf32x2 v = {a, b};
  hwbf16x2 r = __builtin_convertvector(v, hwbf16x2);
  return __builtin_bit_cast(unsigned, r);
}
DEVI float silu(float x) { return x / (1.f + __expf(-x)); }
DEVI float wave_sum(float v) {
#pragma unroll
  for (int o = 32; o > 0; o >>= 1) v += __shfl_xor(v, o, 64);
  return v;
}
DEVI f32x4 mfma16(bf16x8 a, bf16x8 b, f32x4 c) { return __builtin_amdgcn_mfma_f32_16x16x32_bf16(a, b, c, 0, 0, 0); }

DEVI float rope_freq(int m) { return exp2f(-(float)m * 1.6609640474436813f); }
DEVI void fast_sincos(float ang, float& sn, float& cs) {
  float rev = ang * 0.15915494309189535f;
  rev -= rintf(rev);
  sn = __builtin_amdgcn_sinf(rev);
  cs = __builtin_amdgcn_cosf(rev);
}
typedef unsigned hwu32x2 __attribute__((ext_vector_type(2)));
DEVI float quad_max(float x) {
  hwu32x2 r = __builtin_amdgcn_permlane16_swap(__float_as_uint(x), __float_as_uint(x), false, false);
  x = fmaxf(__uint_as_float(r[0]), __uint_as_float(r[1]));
  r = __builtin_amdgcn_permlane32_swap(__float_as_uint(x), __float_as_uint(x), false, false);
  return fmaxf(__uint_as_float(r[0]), __uint_as_float(r[1]));
}
DEVI float quad_sum(float x) {
  hwu32x2 r = __builtin_amdgcn_permlane16_swap(__float_as_uint(x), __float_as_uint(x), false, false);
  x = __uint_as_float(r[0]) + __uint_as_float(r[1]);
  r = __builtin_amdgcn_permlane32_swap(__float_as_uint(x), __float_as_uint(x), false, false);
  return __uint_as_float(r[0]) + __uint_as_float(r[1]);
}
#define VB ((int)(threadIdx.x >> 8))
#define VT_PAIRG (gridDim.x == 256u)
#define VT_FIRST ((int)(VT_PAIRG ? blockIdx.x : blockIdx.x * 2u))
#define VT_OFF ((int)(VT_PAIRG ? VB * gridDim.x : VB))
DEVI int opaque_tid() { int t = threadIdx.x & 255; asm volatile("" : "+v"(t)); return t; }
DEVI int swz_tile(int t, int T) {
  int q = T >> 3, r = T & 7, x = t & 7, off = t >> 3;
  return (x < r ? x * (q + 1) : r * (q + 1) + (x - r) * q) + off;
}

__shared__ __attribute__((aligned(16))) char g_smem[2 * 73728];
#define NOINL __device__ __forceinline__

constexpr int LDT = 72;
constexpr int TILE_E = 128 * LDT;

template <class Epi>
DEVI void gemm_tile(const bf16_t* __restrict__ A, int lda, const bf16_t* __restrict__ B, int ldb, int K,
                    int m0, int n0, char* smem, Epi epi) {
  const int tid = opaque_tid(), lane = tid & 63, wave = tid >> 6, wm = wave >> 1, wn = wave & 1;
  const int lr = lane & 15, lg = lane >> 4;
  bf16_t* sA = (bf16_t*)smem;
  bf16_t* sB = sA + 2 * TILE_E;
  f32x4 acc[4][4];
#pragma unroll
  for (int i = 0; i < 4; ++i)
#pragma unroll
    for (int j = 0; j < 4; ++j) acc[i][j] = (f32x4){0.f, 0.f, 0.f, 0.f};
  const int lrow = tid >> 3, lkc = (tid & 7) * 8;
  const bf16_t* gA = A + (size_t)(m0 + lrow) * lda + lkc;
  const bf16_t* gB = B + (size_t)(n0 + lrow) * ldb + lkc;
  uint4 ra[4], rb[4];
#pragma unroll
  for (int i = 0; i < 4; ++i) {
    ra[i] = *(const uint4*)(gA + (size_t)(32 * i) * lda);
    rb[i] = *(const uint4*)(gB + (size_t)(32 * i) * ldb);
  }
#pragma unroll
  for (int i = 0; i < 4; ++i) {
    *(uint4*)(sA + (lrow + 32 * i) * LDT + lkc) = ra[i];
    *(uint4*)(sB + (lrow + 32 * i) * LDT + lkc) = rb[i];
  }
  __syncthreads();
  const int nk = K >> 6;
  for (int kt = 0; kt < nk; ++kt) {
    const int cur = kt & 1;
    if (kt + 1 < nk) {
      const int k0 = (kt + 1) << 6;
#pragma unroll
      for (int i = 0; i < 4; ++i) {
        ra[i] = *(const uint4*)(gA + (size_t)(32 * i) * lda + k0);
        rb[i] = *(const uint4*)(gB + (size_t)(32 * i) * ldb + k0);
      }
    }
    const bf16_t* cA = sA + cur * TILE_E + (wm * 64 + lr) * LDT + lg * 8;
    const bf16_t* cB = sB + cur * TILE_E + (wn * 64 + lr) * LDT + lg * 8;
#pragma unroll
    for (int ks = 0; ks < 2; ++ks) {
      bf16x8 af[4], bfr[4];
#pragma unroll
      for (int i = 0; i < 4; ++i) {
        af[i] = *(const bf16x8*)(cA + i * 16 * LDT + ks * 32);
        bfr[i] = *(const bf16x8*)(cB + i * 16 * LDT + ks * 32);
      }
#pragma unroll
      for (int i = 0; i < 4; ++i)
#pragma unroll
        for (int j = 0; j < 4; ++j) acc[i][j] = mfma16(af[i], bfr[j], acc[i][j]);
    }
    if (kt + 1 < nk) {
      const int nx = cur ^ 1;
#pragma unroll
      for (int i = 0; i < 4; ++i) {
        *(uint4*)(sA + nx * TILE_E + (lrow + 32 * i) * LDT + lkc) = ra[i];
        *(uint4*)(sB + nx * TILE_E + (lrow + 32 * i) * LDT + lkc) = rb[i];
      }
    }
    __syncthreads();
  }
#pragma unroll
  for (int i = 0; i < 4; ++i)
#pragma unroll
    for (int j = 0; j < 4; j += 2)
      epi(m0 + wm * 64 + i * 16 + lg * 4, n0 + wn * 64 + j * 16 + lr, acc[i][j], acc[i][j + 1]);
}

struct TileInfo { const bf16_t* a; const bf16_t* b; int m0, n0, ctx; };
template <class TileFn, class Epi>
DEVI void gemm_stream(int T, int lda, int ldb, int K, char* smem, TileFn tf, Epi epi) {
  int t0 = VT_FIRST;
  if (t0 >= T) return;
  int t = min(t0 + VT_OFF, T - 1);
  const int tid = opaque_tid(), lane = tid & 63, wave = tid >> 6, wm = wave >> 1, wn = wave & 1;
  const int lr = lane & 15, lg = lane >> 4;
  bf16_t* sA = (bf16_t*)smem;
  bf16_t* sB = sA + 2 * TILE_E;
  const int lrow = tid >> 3, lkc = (tid & 7) * 8;
  TileInfo ti = tf(t);
  const bf16_t* gA = ti.a + (size_t)lrow * lda + lkc;
  const bf16_t* gB = ti.b + (size_t)lrow * ldb + lkc;
  int m0 = ti.m0, n0 = ti.n0, ctx = ti.ctx;
  uint4 ra0, ra1, ra2, ra3, rb0, rb1, rb2, rb3;
  uint4 rc0, rc1, rc2, rc3, rd0, rd1, rd2, rd3;
#define GS_LOAD0(pa, pb) \
  ra0 = *(const uint4*)((pa)); ra1 = *(const uint4*)((pa) + (size_t)32 * lda); \
  ra2 = *(const uint4*)((pa) + (size_t)64 * lda); ra3 = *(const uint4*)((pa) + (size_t)96 * lda); \
  rb0 = *(const uint4*)((pb)); rb1 = *(const uint4*)((pb) + (size_t)32 * ldb); \
  rb2 = *(const uint4*)((pb) + (size_t)64 * ldb); rb3 = *(const uint4*)((pb) + (size_t)96 * ldb);
#define GS_LOAD1(pa, pb) \
  rc0 = *(const uint4*)((pa)); rc1 = *(const uint4*)((pa) + (size_t)32 * lda); \
  rc2 = *(const uint4*)((pa) + (size_t)64 * lda); rc3 = *(const uint4*)((pa) + (size_t)96 * lda); \
  rd0 = *(const uint4*)((pb)); rd1 = *(const uint4*)((pb) + (size_t)32 * ldb); \
  rd2 = *(const uint4*)((pb) + (size_t)64 * ldb); rd3 = *(const uint4*)((pb) + (size_t)96 * ldb);
#define GS_WRITE0(buf) { \
  bf16_t* wa = sA + (buf) * TILE_E + lrow * LDT + lkc; bf16_t* wb = sB + (buf) * TILE_E + lrow * LDT + lkc; \
  *(uint4*)(wa) = ra0; *(uint4*)(wa + 32 * LDT) = ra1; *(uint4*)(wa + 64 * LDT) = ra2; *(uint4*)(wa + 96 * LDT) = ra3; \
  *(uint4*)(wb) = rb0; *(uint4*)(wb + 32 * LDT) = rb1; *(uint4*)(wb + 64 * LDT) = rb2; *(uint4*)(wb + 96 * LDT) = rb3; }
#define GS_WRITE1(buf) { \
  bf16_t* wa = sA + (buf) * TILE_E + lrow * LDT + lkc; bf16_t* wb = sB + (buf) * TILE_E + lrow * LDT + lkc; \
  *(uint4*)(wa) = rc0; *(uint4*)(wa + 32 * LDT) = rc1; *(uint4*)(wa + 64 * LDT) = rc2; *(uint4*)(wa + 96 * LDT) = rc3; \
  *(uint4*)(wb) = rd0; *(uint4*)(wb + 32 * LDT) = rd1; *(uint4*)(wb + 64 * LDT) = rd2; *(uint4*)(wb + 96 * LDT) = rd3; }
#define GS_COMPUTE(buf) { \
    const bf16_t* cA = sA + (buf) * TILE_E + (wm * 64 + lr) * LDT + lg * 8; \
    const bf16_t* cB = sB + (buf) * TILE_E + (wn * 64 + lr) * LDT + lg * 8; \
    _Pragma("unroll") for (int ks = 0; ks < 2; ++ks) { \
      bf16x8 af[4], bfr[4]; \
      _Pragma("unroll") for (int i = 0; i < 4; ++i) { \
        af[i] = *(const bf16x8*)(cA + i * 16 * LDT + ks * 32); \
        bfr[i] = *(const bf16x8*)(cB + i * 16 * LDT + ks * 32); \
      } \
      __builtin_amdgcn_s_setprio(1); \
      _Pragma("unroll") for (int i = 0; i < 4; ++i) \
        _Pragma("unroll") for (int j = 0; j < 4; ++j) acc[i][j] = mfma16(af[i], bfr[j], acc[i][j]); \
      __builtin_amdgcn_s_setprio(0); \
    } }
  GS_LOAD0(gA, gB)
  GS_WRITE0(0)
  GS_LOAD1(gA + 64, gB + 64)
  __syncthreads();
  const int nk = K >> 6;
  for (;;) {
    f32x4 acc[4][4];
#pragma unroll
    for (int i = 0; i < 4; ++i)
#pragma unroll
      for (int j = 0; j < 4; ++j) acc[i][j] = (f32x4){0.f, 0.f, 0.f, 0.f};
    const int t0n = t0 + gridDim.x * 2;
    const bool have_next = t0n < T;
    const int tn = min(t0n + VT_OFF, T - 1);
    const bf16_t *nA = gA, *nB = gB;
    int nm0 = 0, nn0 = 0, nctx = 0;
    if (have_next) {
      const TileInfo tj = tf(tn);
      nA = tj.a + (size_t)lrow * lda + lkc;
      nB = tj.b + (size_t)lrow * ldb + lkc;
      nm0 = tj.m0; nn0 = tj.n0; nctx = tj.ctx;
    }
    for (int kt = 0; kt < nk; kt += 2) {
      {
        const bool wrap = (kt + 2 >= nk);
        const bf16_t* pa = wrap ? nA : gA + ((kt + 2) << 6);
        const bf16_t* pb = wrap ? nB : gB + ((kt + 2) << 6);
        GS_LOAD0(pa, pb)
        GS_COMPUTE(0)
        GS_WRITE1(1)
        __syncthreads();
      }
      {
        const bool wrap = (kt + 3 >= nk);
        const bf16_t* pa = wrap ? nA + 64 : gA + ((kt + 3) << 6);
        const bf16_t* pb = wrap ? nB + 64 : gB + ((kt + 3) << 6);
        GS_LOAD1(pa, pb)
        GS_COMPUTE(1)
        GS_WRITE0(0)
        __syncthreads();
      }
    }
#pragma unroll
    for (int i = 0; i < 4; ++i)
#pragma unroll
      for (int j = 0; j < 4; j += 2)
        epi(ctx, m0 + wm * 64 + i * 16 + lg * 4, n0 + wn * 64 + j * 16 + lr, acc[i][j], acc[i][j + 1]);
    if (!have_next) break;
    t = tn; t0 = t0n; gA = nA; gB = nB; m0 = nm0; n0 = nn0; ctx = nctx;
  }
}

constexpr int T8_E = 256 * LDT;
template <class TileFn, class Epi>
DEVI void gemm8_stream(int T, int lda, int ldb, int K, TileFn tf, Epi epi) {
  int t = blockIdx.x;
  if (t >= T) return;
  int tid = threadIdx.x; asm volatile("" : "+v"(tid));
  const int lane = tid & 63, wave = tid >> 6, wr = wave >> 2, wc = wave & 3;
  const int lr = lane & 15, lg = lane >> 4;
  bf16_t* sA = (bf16_t*)g_smem;
  bf16_t* sB = sA + 2 * T8_E;
  const int lrow = tid >> 3, lkc = (tid & 7) * 8;
  TileInfo ti = tf(t);
  const unsigned offA = ((unsigned)lrow * (unsigned)lda + (unsigned)lkc) * 2u;
  const unsigned offB = ((unsigned)lrow * (unsigned)ldb + (unsigned)lkc) * 2u;
  const char* gA = (const char*)ti.a;
  const char* gB = (const char*)ti.b;
  const size_t rsA = (size_t)64 * lda * 2, rsB = (size_t)64 * ldb * 2;
  int m0 = ti.m0, n0 = ti.n0, ctx = ti.ctx;
  uint4 ra0, ra1, ra2, ra3, rb0, rb1, rb2, rb3;
  uint4 rc0, rc1, rc2, rc3, rd0, rd1, rd2, rd3;
#define G8_LOAD(pa, pb) \
  ra0 = *(const uint4*)((pa) + offA); ra1 = *(const uint4*)((pa) + rsA + offA); \
  ra2 = *(const uint4*)((pa) + 2 * rsA + offA); ra3 = *(const uint4*)((pa) + 3 * rsA + offA); \
  rb0 = *(const uint4*)((pb) + offB); rb1 = *(const uint4*)((pb) + rsB + offB); \
  rb2 = *(const uint4*)((pb) + 2 * rsB + offB); rb3 = *(const uint4*)((pb) + 3 * rsB + offB);
#define G8_WRITE(buf) { \
  bf16_t* wa = sA + (buf) * T8_E + lrow * LDT + lkc; bf16_t* wb = sB + (buf) * T8_E + lrow * LDT + lkc; \
  *(uint4*)(wa) = ra0; *(uint4*)(wa + 64 * LDT) = ra1; *(uint4*)(wa + 128 * LDT) = ra2; *(uint4*)(wa + 192 * LDT) = ra3; \
  *(uint4*)(wb) = rb0; *(uint4*)(wb + 64 * LDT) = rb1; *(uint4*)(wb + 128 * LDT) = rb2; *(uint4*)(wb + 192 * LDT) = rb3; }
#define G8_LOAD1(pa, pb) \
  rc0 = *(const uint4*)((pa) + offA); rc1 = *(const uint4*)((pa) + rsA + offA); \
  rc2 = *(const uint4*)((pa) + 2 * rsA + offA); rc3 = *(const uint4*)((pa) + 3 * rsA + offA); \
  rd0 = *(const uint4*)((pb) + offB); rd1 = *(const uint4*)((pb) + rsB + offB); \
  rd2 = *(const uint4*)((pb) + 2 * rsB + offB); rd3 = *(const uint4*)((pb) + 3 * rsB + offB);
#define G8_WRITE1(buf) { \
  bf16_t* wa = sA + (buf) * T8_E + lrow * LDT + lkc; bf16_t* wb = sB + (buf) * T8_E + lrow * LDT + lkc; \
  *(uint4*)(wa) = rc0; *(uint4*)(wa + 64 * LDT) = rc1; *(uint4*)(wa + 128 * LDT) = rc2; *(uint4*)(wa + 192 * LDT) = rc3; \
  *(uint4*)(wb) = rd0; *(uint4*)(wb + 64 * LDT) = rd1; *(uint4*)(wb + 128 * LDT) = rd2; *(uint4*)(wb + 192 * LDT) = rd3; }
#define G8_COMPUTE(buf) { \
      const bf16_t* cA = sA + (buf) * T8_E + (wr * 128 + lr) * LDT + lg * 8; \
      const bf16_t* cB = sB + (buf) * T8_E + (wc * 64 + lr) * LDT + lg * 8; \
      _Pragma("unroll") for (int ks = 0; ks < 2; ++ks) { \
        bf16x8 bfr[4]; \
        _Pragma("unroll") for (int j = 0; j < 4; ++j) bfr[j] = *(const bf16x8*)(cB + j * 16 * LDT + ks * 32); \
        _Pragma("unroll") for (int h = 0; h < 2; ++h) { \
          bf16x8 af[4]; \
          _Pragma("unroll") for (int i = 0; i < 4; ++i) af[i] = *(const bf16x8*)(cA + (h * 4 + i) * 16 * LDT + ks * 32); \
          __builtin_amdgcn_s_setprio(1); \
          _Pragma("unroll") for (int i = 0; i < 4; ++i) \
            _Pragma("unroll") for (int j = 0; j < 4; ++j) acc[h * 4 + i][j] = mfma16(af[i], bfr[j], acc[h * 4 + i][j]); \
          __builtin_amdgcn_s_setprio(0); \
          __builtin_amdgcn_sched_barrier(0); \
        } \
      } }
  G8_LOAD(gA, gB)
  G8_WRITE(0)
  G8_LOAD1(gA + 128, gB + 128)
  __syncthreads();
  const int nk = K >> 6;
  for (;;) {
    f32x4 acc[8][4];
#pragma unroll
    for (int i = 0; i < 8; ++i)
#pragma unroll
      for (int j = 0; j < 4; ++j) acc[i][j] = (f32x4){0.f, 0.f, 0.f, 0.f};
    const int tn = t + gridDim.x;
    const bool have_next = tn < T;
    const char *nA = gA, *nB = gB;
    int nm0 = 0, nn0 = 0, nctx = 0;
    if (have_next) {
      const TileInfo tj = tf(tn);
      nA = (const char*)tj.a;
      nB = (const char*)tj.b;
      nm0 = tj.m0; nn0 = tj.n0; nctx = tj.ctx;
    }
#pragma unroll 1
    for (int kt = 0; kt < nk; kt += 2) {
      {
        const bool wrap = (kt + 2 >= nk);
        const char* pa = wrap ? nA : gA + ((kt + 2) << 7);
        const char* pb = wrap ? nB : gB + ((kt + 2) << 7);
        G8_LOAD(pa, pb)
        G8_COMPUTE(0)
        G8_WRITE1(1)
        __syncthreads();
      }
      {
        const bool wrap = (kt + 3 >= nk);
        const char* pa = wrap ? nA + 128 : gA + ((kt + 3) << 7);
        const char* pb = wrap ? nB + 128 : gB + ((kt + 3) << 7);
        G8_LOAD1(pa, pb)
        G8_COMPUTE(1)
        G8_WRITE(0)
        __syncthreads();
      }
    }
#pragma unroll
    for (int i = 0; i < 8; ++i)
#pragma unroll
      for (int j = 0; j < 4; j += 2)
        epi(ctx, m0 + wr * 128 + i * 16 + lg * 4, n0 + wc * 64 + j * 16 + lr, acc[i][j], acc[i][j + 1]);
    if (!have_next) break;
    t = tn; gA = nA; gB = nB; m0 = nm0; n0 = nn0; ctx = nctx;
  }
}

DEVI void tile_mn(int t, int nM, int nN, int& m, int& n) {
  int id = swz_tile(t, nM * nN);
  int per = 8 * nN;
  int gq = id / per, rem = id - gq * per;
  int gsz = min(8, nM - gq * 8);
  m = gq * 8 + rem % gsz;
  n = rem / gsz;
}

NOINL void gemv_tile(const P& p, int t) {
  char* smem = g_smem + VB * 73728;
  const int tid = opaque_tid();
  float* sv = (float*)smem;
  float* red = sv + 3072;
  const int l = t / 192, n0 = (t % 192) * 32;
  for (int i = tid; i < 3072; i += 256) {
    int v = i >> 10, k = i & 1023;
    float cv = (v == 0) ? p.c_ctx[k] : p.c[(v - 1) * 1024 + k];
    sv[i] = cv / (1.f + expf(-cv));
  }
  __syncthreads();
  const int cgp = tid & 7, ks = tid >> 3;
  const float* w = p.w_mod + (size_t)l * 1024 * 6144 + n0 + cgp * 4;
  float a0[4] = {0, 0, 0, 0}, a1[4] = {0, 0, 0, 0}, a2[4] = {0, 0, 0, 0};
#pragma unroll 16
  for (int kk = 0; kk < 32; ++kk) {
    const int k = ks * 32 + kk;
    const float4 wv = *(const float4*)(w + (size_t)k * 6144);
    const float s0 = sv[k], s1 = sv[1024 + k], s2 = sv[2048 + k];
    a0[0] += s0 * wv.x; a0[1] += s0 * wv.y; a0[2] += s0 * wv.z; a0[3] += s0 * wv.w;
    a1[0] += s1 * wv.x; a1[1] += s1 * wv.y; a1[2] += s1 * wv.z; a1[3] += s1 * wv.w;
    a2[0] += s2 * wv.x; a2[1] += s2 * wv.y; a2[2] += s2 * wv.z; a2[3] += s2 * wv.w;
  }
#pragma unroll
  for (int j = 0; j < 4; ++j) {
    red[(ks * 3 + 0) * 32 + cgp * 4 + j] = a0[j];
    red[(ks * 3 + 1) * 32 + cgp * 4 + j] = a1[j];
    red[(ks * 3 + 2) * 32 + cgp * 4 + j] = a2[j];
  }
  __syncthreads();
  if (tid < 96) {
    const int v = tid >> 5, col = tid & 31;
    float s = 0.f;
    for (int q = 0; q < 32; ++q) s += red[(q * 3 + v) * 32 + col];
    s += p.b_mod[l * 6144 + n0 + col];
    WSF(OFF_MOD)[(l * 3 + v) * 6144 + n0 + col] = s;
  }
  __syncthreads();
}

NOINL void transpose_tile(const P& p, int t) {
  char* smem = g_smem + VB * 73728;
  const int tid = opaque_tid();
  const float* src; bf16_t* dst; int K, N, ntn, mode = 0;
  if (t < 544) { src = p.w_in; dst = WSB(OFF_WIN); K = 1024; N = 2096; ntn = 34; }
  else if ((t -= 544) < 48) { src = p.w_uq; dst = WSB(OFF_WUQ); K = 256; N = 768; ntn = 12; }
  else if ((t -= 48) < 64) { src = p.w_ukv; dst = WSB(OFF_WUKV); K = 256; N = 1024; ntn = 16; }
  else if ((t -= 64) < 256) { src = p.w_out; dst = WSB(OFF_WOUT); K = 1024; N = 1024; ntn = 16; }
  else if ((t -= 256) < 64) { int g = t >> 4; t &= 15; src = p.pool_w + (size_t)g * 65536; dst = WSB(OFF_WPOOL) + (size_t)g * 65536; K = 256; N = 256; ntn = 4; }
  else if ((t -= 64) < 1408) { int l = t / 704; t -= l * 704; src = p.w_gate + (size_t)l * 1024 * 2816; dst = WSB(OFF_WGU) + (size_t)l * 5632 * 1024; K = 1024; N = 2816; ntn = 44; mode = 1; }
  else if ((t -= 1408) < 1408) { int l = t / 704; t -= l * 704; src = p.w_up + (size_t)l * 1024 * 2816; dst = WSB(OFF_WGU) + (size_t)l * 5632 * 1024; K = 1024; N = 2816; ntn = 44; mode = 2; }
  else { t -= 1408; int l = t / 704; t -= l * 704; src = p.w_down + (size_t)l * 2816 * 1024; dst = WSB(OFF_WDN) + (size_t)l * 1024 * 2816; K = 2816; N = 1024; ntn = 16; }
  const int kt = t / ntn, nt_ = t - kt * ntn;
  const int k0 = kt * 64, n0 = nt_ * 64;
  float* tile = (float*)smem;
  {
    const int nn = tid & 63, kk0 = tid >> 6;
    const int n = n0 + nn;
    const int nc = n < N ? n : N - 1;
    float v[16];
#pragma unroll
    for (int i = 0; i < 16; ++i) v[i] = src[(size_t)(k0 + kk0 + 4 * i) * N + nc];
#pragma unroll
    for (int i = 0; i < 16; ++i) tile[(kk0 + 4 * i) * 65 + nn] = (n < N) ? v[i] : 0.f;
  }
  __syncthreads();
#pragma unroll
  for (int i = 0; i < 2; ++i) {
    const int id = tid + 256 * i;
    const int nn = id >> 3, kc = id & 7;
    const int n = n0 + nn;
    uint4 pk;
    pk.x = pack2(tile[(kc * 8 + 0) * 65 + nn], tile[(kc * 8 + 1) * 65 + nn]);
    pk.y = pack2(tile[(kc * 8 + 2) * 65 + nn], tile[(kc * 8 + 3) * 65 + nn]);
    pk.z = pack2(tile[(kc * 8 + 4) * 65 + nn], tile[(kc * 8 + 5) * 65 + nn]);
    pk.w = pack2(tile[(kc * 8 + 6) * 65 + nn], tile[(kc * 8 + 7) * 65 + nn]);
    int drow = n;
    if (mode == 1) drow = (n >> 4) * 32 + (n & 15);
    else if (mode == 2) drow = (n >> 4) * 32 + 16 + (n & 15);
    *(uint4*)(dst + (size_t)drow * K + k0 + kc * 8) = pk;
  }
  __syncthreads();
}

template <bool UPD, bool MOD, bool FIRST, bool LASTW, bool TWO>
DEVI void rowop(const P& p, const bf16_t* msrc, const bf16_t* msrc2, const float* wpost, int gate_idx, const float* wpre, int shift_idx,
                int scale_idx, int layer_g, int layer_m) {
  const int lane = threadIdx.x & 63, wave = threadIdx.x >> 6;
  const float* modg = WSF(OFF_MOD) + (size_t)layer_g * 3 * 6144;
  const float* modm = WSF(OFF_MOD) + (size_t)layer_m * 3 * 6144;
  bf16_t* hbuf = WSB(OFF_H);
  for (int r = blockIdx.x * 8 + wave; r < 8192; r += gridDim.x * 8) {
    const int v = r < 4096 ? 0 : 1 + ((r - 4096) >> 11);
    const float* mvg = modg + v * 6144;
    const float* mvm = modm + v * 6144;
    float4 x[4];
    if (FIRST) {
      const float* xin = r < 4096 ? p.x_prompt + (size_t)r * 1024 : p.x_sample + (size_t)(r - 4096) * 1024;
#pragma unroll
      for (int i = 0; i < 4; ++i) x[i] = *(const float4*)(xin + lane * 4 + 256 * i);
    } else {
#pragma unroll
      for (int i = 0; i < 4; ++i) {
        const uint2 xb = *(const uint2*)(WSB(OFF_XR) + (size_t)r * 1024 + lane * 4 + 256 * i);
        x[i].x = __uint_as_float(xb.x << 16); x[i].y = __uint_as_float(xb.x & 0xffff0000u);
        x[i].z = __uint_as_float(xb.y << 16); x[i].w = __uint_as_float(xb.y & 0xffff0000u);
      }
    }
    if (UPD) {
      float4 m[4];
      float ss = 0.f;
#pragma unroll
      for (int i = 0; i < 4; ++i) {
        const uint2 mb = *(const uint2*)(msrc + (size_t)r * 1024 + lane * 4 + 256 * i);
        m[i].x = __uint_as_float(mb.x << 16); m[i].y = __uint_as_float(mb.x & 0xffff0000u);
        m[i].z = __uint_as_float(mb.y << 16); m[i].w = __uint_as_float(mb.y & 0xffff0000u);
        if (TWO) {
          const uint2 mc = *(const uint2*)(msrc2 + (size_t)r * 1024 + lane * 4 + 256 * i);
          m[i].x += __uint_as_float(mc.x << 16); m[i].y += __uint_as_float(mc.x & 0xffff0000u);
          m[i].z += __uint_as_float(mc.y << 16); m[i].w += __uint_as_float(mc.y & 0xffff0000u);
        }
        ss += m[i].x * m[i].x + m[i].y * m[i].y + m[i].z * m[i].z + m[i].w * m[i].w;
      }
      ss = wave_sum(ss);
      const float rs = rsqrtf(ss * (1.f / 1024.f) + 1e-6f);
#pragma unroll
      for (int i = 0; i < 4; ++i) {
        const int col = lane * 4 + 256 * i;
        const float4 wp = *(const float4*)(wpost + col);
        const float4 g = *(const float4*)(mvg + gate_idx * 1024 + col);
        x[i].x += g.x * (m[i].x * rs * wp.x);
        x[i].y += g.y * (m[i].y * rs * wp.y);
        x[i].z += g.z * (m[i].z * rs * wp.z);
        x[i].w += g.w * (m[i].w * rs * wp.w);
        if (LASTW) *(float4*)(p.out + (size_t)r * 1024 + col) = x[i];
        else {
          uint2 xo;
          xo.x = pack2(x[i].x, x[i].y);
          xo.y = pack2(x[i].z, x[i].w);
          *(uint2*)(WSB(OFF_XR) + (size_t)r * 1024 + col) = xo;
        }
      }
    }
    if (MOD) {
      float ss = 0.f;
#pragma unroll
      for (int i = 0; i < 4; ++i) ss += x[i].x * x[i].x + x[i].y * x[i].y + x[i].z * x[i].z + x[i].w * x[i].w;
      ss = wave_sum(ss);
      const float rs = rsqrtf(ss * (1.f / 1024.f) + 1e-6f);
#pragma unroll
      for (int i = 0; i < 4; ++i) {
        const int col = lane * 4 + 256 * i;
        const float4 wp = *(const float4*)(wpre + col);
        const float4 sh = *(const float4*)(mvm + shift_idx * 1024 + col);
        const float4 sc = *(const float4*)(mvm + scale_idx * 1024 + col);
        uint2 o;
        o.x = pack2(x[i].x * rs * wp.x * (1.f + sc.x) + sh.x, x[i].y * rs * wp.y * (1.f + sc.y) + sh.y);
        o.y = pack2(x[i].z * rs * wp.z * (1.f + sc.z) + sh.z, x[i].w * rs * wp.w * (1.f + sc.w) + sh.w);
        *(uint2*)(hbuf + (size_t)r * 1024 + col) = o;
      }
    }
  }
}

NOINL void prep_rows(const P& p) {
  const int lane = threadIdx.x & 63, wave = threadIdx.x >> 6;
  const float* proj = WSF(OFF_R1);
  for (int r = blockIdx.x * 8 + wave; r < 8192; r += gridDim.x * 8) {
    const float* pr = proj + (size_t)r * 2096;
    const int kvrow = r < 4096 ? r : 4096 + ((r - 4096) >> 11) * 2304 + 256 + ((r - 4096) & 2047);
    const float4 ld_cq = *(const float4*)(pr + lane * 4);
    const float4 ld_ckv = *(const float4*)(pr + 256 + lane * 4);
    const float ld_kpe = pr[512 + (lane & 31)];
    const float ld_dt = pr[2080 + (lane & 15)];
    {
      const float4 a = ld_cq;
      float ss = wave_sum(a.x * a.x + a.y * a.y + a.z * a.z + a.w * a.w);
      const float rs = rsqrtf(ss * (1.f / 256.f) + 1e-6f);
      const float4 g = *(const float4*)(p.q_norm + lane * 4);
      uint2 o;
      o.x = pack2(a.x * rs * g.x, a.y * rs * g.y);
      o.y = pack2(a.z * rs * g.z, a.w * rs * g.w);
      *(uint2*)(WSB(OFF_CQN) + (size_t)r * 256 + lane * 4) = o;
    }
    {
      const float4 a = ld_ckv;
      float ss = wave_sum(a.x * a.x + a.y * a.y + a.z * a.z + a.w * a.w);
      const float rs = rsqrtf(ss * (1.f / 256.f) + 1e-6f);
      const float4 g = *(const float4*)(p.kv_norm + lane * 4);
      float4 vv;
      vv.x = a.x * rs * g.x; vv.y = a.y * rs * g.y; vv.z = a.z * rs * g.z; vv.w = a.w * rs * g.w;
      if (r < 4096) *(float4*)(p.out + OUT_CKV + (size_t)r * 256 + lane * 4) = vv;
      uint2 o;
      o.x = pack2(vv.x, vv.y);
      o.y = pack2(vv.z, vv.w);
      *(uint2*)(WSB(OFF_CKV) + (size_t)kvrow * 256 + lane * 4) = o;
    }
    {
      const float kv = (lane < 32) ? ld_kpe : 0.f;
      const float partner = __shfl_xor(kv, 16, 64);
      if (r < 4096) {
        if (lane < 32) {
          p.out[OUT_KR + (size_t)r * 32 + lane] = kv;
          WSB(OFF_KPE)[(size_t)kvrow * 32 + lane] = f2bf(kv);
        }
      } else {
        const int t = (r - 4096) & 2047;
        const int ii = lane & 15;
        const float pos = (ii < 8) ? (float)(t >> 6) : (float)(t & 63);
        const float fr = rope_freq(ii & 7);
        const float ang = pos * fr;
        float cs, sn;
        fast_sincos(ang, sn, cs);
        const float o = (lane < 16) ? (kv * cs - partner * sn) : (partner * sn + kv * cs);
        if (lane < 32) WSB(OFF_KPE)[(size_t)kvrow * 32 + lane] = f2bf(o);
      }
    }
    if (lane < 16) {
      const int dir = lane >> 3, hh = lane & 7;
      const float raw = ld_dt + (dir ? p.dtb_b[hh] : p.dtb_f[hh]);
      const float sp = raw > 20.f ? raw : log1pf(expf(raw));
      WSF(OFF_DTV)[((size_t)dir * 8192 + r) * 8 + hh] = sp;
    }
  }
}

NOINL void prep_cache(const P& p) {
  const int gt = blockIdx.x * 512 + threadIdx.x, gs = gridDim.x * 512;
  for (int i = gt; i < 2 * 256 * 256; i += gs) {
    int b = i >> 16, rem = i & 65535;
    WSB(OFF_CKV)[(size_t)(4096 + b * 2304) * 256 + rem] = f2bf(p.cache_ckv[i]);
  }
  for (int i = gt; i < 2 * 256 * 32; i += gs) {
    int b = i >> 13, rem = i & 8191;
    WSB(OFF_KPE)[(size_t)(4096 + b * 2304) * 32 + rem] = f2bf(p.cache_kr[i]);
  }
}

NOINL void conv_tile(const P& p, int t) {
  char* smem = g_smem + VB * 73728;
  const int tid = opaque_tid();
  float* sin_ = (float*)smem;
  float* sout = sin_ + 68 * 64;
  const int tt_ = t >> 4, ct = t & 15;
  const int r0 = tt_ * 64, c0 = ct * 64;
  int s0, s1;
  if (r0 < 4096) { s0 = r0 & ~255; s1 = s0 + 256; } else { s0 = 4096 + ((r0 - 4096) & ~2047); s1 = s0 + 2048; }
  const float* proj = WSF(OFF_R1);
  {
    const int rr0 = tid >> 6, cc = tid & 63;
    float v[17];
#pragma unroll
    for (int k = 0; k < 17; ++k) {
      const int r = r0 - 2 + rr0 + 4 * k;
      const int rc = r < s0 ? s0 : (r >= s1 ? s1 - 1 : r);
      v[k] = proj[(size_t)rc * 2096 + 1056 + c0 + cc];
    }
#pragma unroll
    for (int k = 0; k < 17; ++k) {
      const int r = r0 - 2 + rr0 + 4 * k;
      sin_[(rr0 + 4 * k) * 64 + cc] = (r >= s0 && r < s1) ? v[k] : 0.f;
    }
  }
  __syncthreads();
  {
    const int cc = tid & 63, tq = tid >> 6;
    const int c = c0 + cc;
    const float w0 = p.conv_w[c], w1 = p.conv_w[1024 + c], w2 = p.conv_w[2048 + c], w3 = p.conv_w[3072 + c],
                w4 = p.conv_w[4096 + c], bias = p.conv_b[c];
#pragma unroll 4
    for (int i = 0; i < 16; ++i) {
      const int tt = tq * 16 + i;
      float y = bias + w0 * sin_[tt * 64 + cc] + w1 * sin_[(tt + 1) * 64 + cc] + w2 * sin_[(tt + 2) * 64 + cc] +
                w3 * sin_[(tt + 3) * 64 + cc] + w4 * sin_[(tt + 4) * 64 + cc];
      y = y / (1.f + __expf(-y));
      sout[tt * 65 + cc] = y;
      const bf16_t b = f2bf(y);
      const size_t r = r0 + tt;
      if (c < 512) WSB(OFF_XS)[r * 512 + c] = b;
      else if (c < 768) WSB(OFF_BM)[r * 256 + (c - 512)] = b;
      else WSB(OFF_CM)[r * 256 + (c - 768)] = b;
    }
  }
  __syncthreads();
  if (c0 < 768) {
    const int cl = tid >> 2, q4 = tid & 3;
    uint4 o0, o1;
    const float* sp = sout + (q4 * 16) * 65 + cl;
    o0.x = pack2(sp[0 * 65], sp[1 * 65]);   o0.y = pack2(sp[2 * 65], sp[3 * 65]);
    o0.z = pack2(sp[4 * 65], sp[5 * 65]);   o0.w = pack2(sp[6 * 65], sp[7 * 65]);
    o1.x = pack2(sp[8 * 65], sp[9 * 65]);   o1.y = pack2(sp[10 * 65], sp[11 * 65]);
    o1.z = pack2(sp[12 * 65], sp[13 * 65]); o1.w = pack2(sp[14 * 65], sp[15 * 65]);
    bf16_t* dst = (c0 < 512) ? WSB(OFF_XST) + (size_t)(c0 + cl) * 8192 : WSB(OFF_BT) + (size_t)(c0 - 512 + cl) * 8192;
    dst += r0 + q4 * 16;
    *(uint4*)(dst) = o0;
    *(uint4*)(dst + 8) = o1;
  }
  __syncthreads();
}

NOINL void chunk_state_item(const P& p, int item) {
  char* smem = g_smem + VB * 73728;
  const int tid = opaque_tid(), lane = tid & 63, wave = tid >> 6, lr = lane & 15, lg = lane >> 4;
  const int cidx = item >> 3, hh = item & 7, g = hh >> 2;
  const int r0 = cidx * 128;
  constexpr int LDS_ = 136;
  bf16_t* sAs = (bf16_t*)smem;
  bf16_t* sBs = sAs + 2 * 64 * LDS_;
  float* fa = (float*)(sBs + 128 * LDS_);
  float* fcum = fa + 256;
  float* fw = fa + 512;
  float* fdt = fa + 768;
  {
    const int dir = tid >> 7, j = tid & 127;
    const float dt = WSF(OFF_DTV)[((size_t)dir * 8192 + r0 + j) * 8 + hh];
    const float Aco = -expf(dir ? p.alog_b[hh] : p.alog_f[hh]);
    fa[tid] = dt * Aco;
    fdt[tid] = dt;
  }
  __syncthreads();
  {
    const int dir = tid >> 7, j = tid & 127;
    float s = 0.f;
    if (dir == 0) { for (int k = 0; k <= j; ++k) s += fa[k]; }
    else { for (int k = 127; k >= j; --k) s += fa[128 + k]; }
    fcum[tid] = s;
    WSF(OFF_CUM)[((size_t)dir * 8192 + r0 + j) * 8 + hh] = s;
  }
  __syncthreads();
  {
    const int dir = tid >> 7;
    const float ce = dir ? fcum[128] : fcum[127];
    fw[tid] = __expf(ce - fcum[tid]) * fdt[tid];
    if ((tid & 127) == 0) WSF(OFF_TOT)[(dir * 64 + cidx) * 8 + hh] = __expf(ce);
  }
  __syncthreads();
#pragma unroll
  for (int i = 0; i < 4; ++i) {
    const int id = tid + 256 * i;
    const int pp = id >> 4, jc = (id & 15) * 8;
    const uint4 raw = *(const uint4*)(WSB(OFF_XST) + (size_t)(hh * 64 + pp) * 8192 + r0 + jc);
    const unsigned rw[4] = {raw.x, raw.y, raw.z, raw.w};
    unsigned of[4], ob[4];
#pragma unroll
    for (int q = 0; q < 4; ++q) {
      const float x0 = __uint_as_float(rw[q] << 16), x1 = __uint_as_float(rw[q] & 0xffff0000u);
      of[q] = pack2(x0 * fw[jc + 2 * q], x1 * fw[jc + 2 * q + 1]);
      ob[q] = pack2(x0 * fw[128 + jc + 2 * q], x1 * fw[128 + jc + 2 * q + 1]);
    }
    *(uint4*)(sAs + pp * LDS_ + jc) = make_uint4(of[0], of[1], of[2], of[3]);
    *(uint4*)(sAs + 64 * LDS_ + pp * LDS_ + jc) = make_uint4(ob[0], ob[1], ob[2], ob[3]);
  }
#pragma unroll
  for (int i = 0; i < 8; ++i) {
    const int id = tid + 256 * i;
    const int nn = id >> 4, jc = (id & 15) * 8;
    *(uint4*)(sBs + nn * LDS_ + jc) = *(const uint4*)(WSB(OFF_BT) + (size_t)(g * 128 + nn) * 8192 + r0 + jc);
  }
  __syncthreads();
  {
    const int dir = wave >> 1, nh = wave & 1;
    f32x4 acc[4][4];
#pragma unroll
    for (int i = 0; i < 4; ++i)
#pragma unroll
      for (int j = 0; j < 4; ++j) acc[i][j] = (f32x4){0.f, 0.f, 0.f, 0.f};
    const bf16_t* cA = sAs + dir * 64 * LDS_ + lr * LDS_ + lg * 8;
    const bf16_t* cB = sBs + (nh * 64 + lr) * LDS_ + lg * 8;
#pragma unroll 1
    for (int ks = 0; ks < 4; ++ks) {
      bf16x8 af[4], bfr[4];
#pragma unroll
      for (int i = 0; i < 4; ++i) {
        af[i] = *(const bf16x8*)(cA + i * 16 * LDS_ + ks * 32);
        bfr[i] = *(const bf16x8*)(cB + i * 16 * LDS_ + ks * 32);
      }
#pragma unroll
      for (int i = 0; i < 4; ++i)
#pragma unroll
        for (int j = 0; j < 4; ++j) acc[i][j] = mfma16(af[i], bfr[j], acc[i][j]);
    }
    float* S = WSF(OFF_R2) + ((size_t)(dir * 64 + cidx) * 8 + hh) * 8192 + (lg * 4) * 128 + nh * 64 + lr;
#pragma unroll
    for (int i = 0; i < 4; ++i) {
#pragma unroll
      for (int q = 0; q < 4; ++q) {
#pragma unroll
        for (int j = 0; j < 4; ++j) S[j * 16] = acc[i][j][q];
        S += 128;
      }
      S += 12 * 128;
      __builtin_amdgcn_sched_barrier(0);
    }
  }
  __syncthreads();
}

template <int NB>
DEVI void scan_group(const P& p, float4& h, int dir, int cb, int nc, int c0, int hh, size_t eoff) {
  float4 sv[NB];
  float d[NB];
  size_t base[NB];
#pragma unroll
  for (int k = 0; k < NB; ++k) {
    const int c = c0 + k;
    const int cidx = cb + (dir ? nc - 1 - c : c);
    base[k] = ((size_t)(dir * 64 + cidx) * 8 + hh) * 8192 + eoff;
    d[k] = WSF(OFF_TOT)[(dir * 64 + cidx) * 8 + hh];
    sv[k] = *(const float4*)(WSF(OFF_R2) + base[k]);
  }
#pragma unroll
  for (int k = 0; k < NB; ++k) {
    uint2 o;
    o.x = pack2(h.x, h.y);
    o.y = pack2(h.z, h.w);
    *(uint2*)(WSB(OFF_H) + base[k]) = o;
    h.x = d[k] * h.x + sv[k].x; h.y = d[k] * h.y + sv[k].y; h.z = d[k] * h.z + sv[k].z; h.w = d[k] * h.w + sv[k].w;
  }
}

NOINL void scan_states(const P& p) {
  const int total = 2 * 18 * 8 * 64 * 32;
  for (int idx = blockIdx.x * 512 + threadIdx.x; idx < total; idx += gridDim.x * 512) {
    const int n4 = idx & 31, pp = (idx >> 5) & 63, hh = (idx >> 11) & 7;
    const int sd = idx >> 14;
    const int s = sd % 18, dir = sd / 18;
    const int nc = s < 16 ? 2 : 16;
    const int cb = s < 16 ? s * 2 : 32 + (s - 16) * 16;
    float4 h = make_float4(0.f, 0.f, 0.f, 0.f);
    const size_t eoff = (size_t)pp * 128 + n4 * 4;
    if (s >= 16) {
      const float* st = (dir ? p.st_b : p.st_f) + ((size_t)((s - 16) * 8 + hh) * 64 + pp) * 128 + n4 * 4;
      h = *(const float4*)st;
      scan_group<8>(p, h, dir, cb, nc, 0, hh, eoff);
      scan_group<8>(p, h, dir, cb, nc, 8, hh, eoff);
    } else {
      scan_group<2>(p, h, dir, cb, nc, 0, hh, eoff);
      float* o = p.out + (dir ? OUT_SB : OUT_SF) + ((size_t)(s * 8 + hh) * 64 + pp) * 128 + n4 * 4;
      *(float4*)o = h;
    }
  }
}

NOINL void attn_item(const P& p, int id) {
  char* smem = g_smem + VB * 73728;
  const int tid = opaque_tid(), lane = tid & 63, wave = tid >> 6, lr = lane & 15, lg = lane >> 4;
  int row0, kvbase, Lk, hh;
  if (id < 512) { hh = id & 7; const int b = (id >> 3) & 1; const int qb = id >> 4; row0 = 4096 + b * 2048 + qb * 64; kvbase = 4096 + b * 2304; Lk = 2304; }
  else { const int i2 = id - 512; hh = i2 & 7; const int rest = i2 >> 3; const int b = rest >> 2; const int qb = rest & 3; row0 = b * 256 + qb * 64; kvbase = b * 256; Lk = 256; }
  constexpr int LDK = 104, LDV = 72;
  constexpr int KVBUF = 64 * LDK + 64 * LDV;
  bf16_t* sKV = (bf16_t*)smem;
  const int qrow = row0 + wave * 16 + lr;
  bf16x8 qf[3];
#pragma unroll
  for (int ks = 0; ks < 3; ++ks) qf[ks] = *(const bf16x8*)(WSB(OFF_Q) + (size_t)qrow * 768 + hh * 96 + ks * 32 + lg * 8);
  f32x4 oacc[4];
#pragma unroll
  for (int i = 0; i < 4; ++i) oacc[i] = (f32x4){0.f, 0.f, 0.f, 0.f};
  float mrun = -1e30f, lrun = 0.f;
  const int nkt = Lk >> 6;
  const int kkey0 = tid / 12, kcc0 = tid - kkey0 * 12;
  const int c1 = tid + 256, kkey1 = c1 / 12, kcc1 = c1 - kkey1 * 12;
  const int c2 = tid + 512, kkey2 = c2 / 12, kcc2 = c2 - kkey2 * 12;
  const bf16_t* kn = WSB(OFF_KN);
  const bf16_t* kp = WSB(OFF_KPE);
  const bf16_t* ksrc0 = (kcc0 < 8) ? kn + (size_t)(kvbase + kkey0) * 512 + hh * 64 + kcc0 * 8 : kp + (size_t)(kvbase + kkey0) * 32 + (kcc0 - 8) * 8;
  const bf16_t* ksrc1 = (kcc1 < 8) ? kn + (size_t)(kvbase + kkey1) * 512 + hh * 64 + kcc1 * 8 : kp + (size_t)(kvbase + kkey1) * 32 + (kcc1 - 8) * 8;
  const bf16_t* ksrc2 = (kcc2 < 8) ? kn + (size_t)(kvbase + kkey2) * 512 + hh * 64 + kcc2 * 8 : kp + (size_t)(kvbase + kkey2) * 32 + (kcc2 - 8) * 8;
  const int kst0 = (kcc0 < 8) ? 512 * 64 : 32 * 64, kst1 = (kcc1 < 8) ? 512 * 64 : 32 * 64, kst2 = (kcc2 < 8) ? 512 * 64 : 32 * 64;
  const int vd0 = tid >> 3, vcc = tid & 7;
  const bf16_t* vsrc0 = WSB(OFF_VT) + (size_t)(hh * 64 + vd0) * 8704 + kvbase + vcc * 8;
  const bf16_t* vsrc1 = vsrc0 + (size_t)32 * 8704;
  uint4 rk0, rk1, rk2, rv0, rv1;
#define AT_LOAD(kt) { const int _k = (kt); \
    rk0 = *(const uint4*)(ksrc0 + (size_t)_k * kst0); rk1 = *(const uint4*)(ksrc1 + (size_t)_k * kst1); \
    rk2 = *(const uint4*)(ksrc2 + (size_t)_k * kst2); \
    rv0 = *(const uint4*)(vsrc0 + _k * 64); rv1 = *(const uint4*)(vsrc1 + _k * 64); }
#define AT_WRITE(buf) { bf16_t* _b = sKV + (buf) * KVBUF; \
    *(uint4*)(_b + kkey0 * LDK + kcc0 * 8) = rk0; *(uint4*)(_b + kkey1 * LDK + kcc1 * 8) = rk1; \
    *(uint4*)(_b + kkey2 * LDK + kcc2 * 8) = rk2; \
    *(uint4*)(_b + 64 * LDK + vd0 * LDV + vcc * 8) = rv0; *(uint4*)(_b + 64 * LDK + (vd0 + 32) * LDV + vcc * 8) = rv1; }
  AT_LOAD(0)
  AT_WRITE(0)
  __syncthreads();
  for (int kt = 0; kt < nkt; ++kt) {
    const int ktn = min(kt + 1, nkt - 1);
    AT_LOAD(ktn)
#if ATPROBE == 5
    { uint4 d0 = *(const volatile uint4*)(ksrc0 + (size_t)ktn * kst0), d1 = *(const volatile uint4*)(ksrc1 + (size_t)ktn * kst1), d2 = *(const volatile uint4*)(ksrc2 + (size_t)ktn * kst2);
      uint4 d3 = *(const volatile uint4*)(vsrc0 + ktn * 64), d4 = *(const volatile uint4*)(vsrc1 + ktn * 64);
      asm volatile("" :: "v"(d0), "v"(d1), "v"(d2), "v"(d3), "v"(d4)); }
#endif
    const bf16_t* sK = sKV + (kt & 1) * KVBUF;
    const bf16_t* sV = sK + 64 * LDK;
    f32x4 sacc[4];
#pragma unroll
    for (int n = 0; n < 4; ++n) sacc[n] = (f32x4){0.f, 0.f, 0.f, 0.f};
#pragma unroll
    for (int ks = 0; ks < 3; ++ks)
#pragma unroll
      for (int n = 0; n < 4; ++n) {
        const bf16x8 a = *(const bf16x8*)(sK + (n * 16 + lr) * LDK + ks * 32 + lg * 8);
        sacc[n] = mfma16(a, qf[ks], sacc[n]);
      }
#if ATPROBE == 2
    {
      f32x4 dacc[4];
#pragma unroll
      for (int n = 0; n < 4; ++n) dacc[n] = (f32x4){0.f, 0.f, 0.f, 0.f};
#pragma unroll
      for (int ks = 0; ks < 3; ++ks)
#pragma unroll
        for (int n = 0; n < 4; ++n) {
          const bf16x8 a = *(const volatile bf16x8*)(sK + (n * 16 + lr) * LDK + ks * 32 + lg * 8);
          dacc[n] = mfma16(a, qf[ks], dacc[n]);
        }
#pragma unroll
      for (int n = 0; n < 4; ++n) asm volatile("" :: "v"(dacc[n]));
    }
#endif
    float mx = sacc[0][0];
#pragma unroll
    for (int n = 0; n < 4; ++n)
#pragma unroll
      for (int q = 0; q < 4; ++q) mx = fmaxf(mx, sacc[n][q]);
    mx = quad_max(mx);
    const float mnew = fmaxf(mrun, mx);
    const float alpha = __builtin_amdgcn_exp2f(mrun - mnew);
    mrun = mnew;
    float ps = 0.f;
#pragma unroll
    for (int n = 0; n < 4; ++n)
#pragma unroll
      for (int q = 0; q < 4; ++q) {
#if ATPROBE == 1
        { float e2 = __builtin_amdgcn_exp2f(sacc[n][q] - mrun); asm volatile("" :: "v"(e2)); }
#endif
        const float e = __builtin_amdgcn_exp2f(sacc[n][q] - mnew); sacc[n][q] = e; ps += e; }
    lrun = lrun * alpha + ps;
#pragma unroll
    for (int i = 0; i < 4; ++i)
#pragma unroll
      for (int q = 0; q < 4; ++q) oacc[i][q] *= alpha;
#pragma unroll
    for (int ks = 0; ks < 2; ++ks) {
      union { bf16x8 v; unsigned u[4]; } pf;
      pf.u[0] = pack2(sacc[2 * ks][0], sacc[2 * ks][1]);
      pf.u[1] = pack2(sacc[2 * ks][2], sacc[2 * ks][3]);
      pf.u[2] = pack2(sacc[2 * ks + 1][0], sacc[2 * ks + 1][1]);
      pf.u[3] = pack2(sacc[2 * ks + 1][2], sacc[2 * ks + 1][3]);
#pragma unroll
      for (int m = 0; m < 4; ++m) {
        union { bf16x8 v; uint2 h[2]; } av;
        const bf16_t* vp = sV + (m * 16 + lr) * LDV + ks * 32 + lg * 4;
        av.h[0] = *(const uint2*)(vp);
        av.h[1] = *(const uint2*)(vp + 16);
        oacc[m] = mfma16(av.v, pf.v, oacc[m]);
      }
    }
    __builtin_amdgcn_sched_barrier(0);
    AT_WRITE((kt + 1) & 1)
#if ATPROBE == 3
    AT_WRITE((kt + 1) & 1)
#endif
#if ATPROBE == 4
    __syncthreads();
#endif
    __syncthreads();
  }
  lrun = quad_sum(lrun);
  const float inv = 1.f / lrun;
#pragma unroll
  for (int m = 0; m < 4; ++m) {
    uint2 o;
    o.x = pack2(oacc[m][0] * inv, oacc[m][1] * inv);
    o.y = pack2(oacc[m][2] * inv, oacc[m][3] * inv);
    *(uint2*)(WSB(OFF_CAT) + (size_t)qrow * 1024 + hh * 64 + m * 16 + lg * 4) = o;
  }
}

NOINL void attn8_item(const P& p, int id) {
  int tid = threadIdx.x; asm volatile("" : "+v"(tid));
  const int lane = tid & 63, wave = tid >> 6, lr = lane & 15, lg = lane >> 4;
  int row0, kvbase, Lk, hh;
  if (id < 256) { hh = id & 7; const int b = (id >> 3) & 1; const int qb = id >> 4; row0 = 4096 + b * 2048 + qb * 128; kvbase = 4096 + b * 2304; Lk = 2304; }
  else { const int i2 = id - 256; hh = i2 & 7; const int rest = i2 >> 3; const int b = rest >> 1; const int qb = rest & 1; row0 = b * 256 + qb * 128; kvbase = b * 256; Lk = 256; }
  constexpr int LDK = 104, LDV = 136;
  constexpr int KVBUF = 128 * LDK + 64 * LDV;
  bf16_t* sKV = (bf16_t*)g_smem;
  const int qrow = row0 + wave * 16 + lr;
  bf16x8 qf[3];
#pragma unroll
  for (int ks = 0; ks < 3; ++ks) qf[ks] = *(const bf16x8*)(WSB(OFF_Q) + (size_t)qrow * 768 + hh * 96 + ks * 32 + lg * 8);
  f32x4 oacc[4];
#pragma unroll
  for (int i = 0; i < 4; ++i) oacc[i] = (f32x4){0.f, 0.f, 0.f, 0.f};
  float mrun = -1e30f, lrun = 0.f;
  const int nkt = Lk >> 7;
  const int kkey0 = tid / 12, kcc0 = tid - kkey0 * 12;
  const int c1 = tid + 512, kkey1 = c1 / 12, kcc1 = c1 - kkey1 * 12;
  const int c2 = tid + 1024, kkey2 = c2 / 12, kcc2 = c2 - kkey2 * 12;
  const bf16_t* kn = WSB(OFF_KN);
  const bf16_t* kp = WSB(OFF_KPE);
  const bf16_t* ksrc0 = (kcc0 < 8) ? kn + (size_t)(kvbase + kkey0) * 512 + hh * 64 + kcc0 * 8 : kp + (size_t)(kvbase + kkey0) * 32 + (kcc0 - 8) * 8;
  const bf16_t* ksrc1 = (kcc1 < 8) ? kn + (size_t)(kvbase + kkey1) * 512 + hh * 64 + kcc1 * 8 : kp + (size_t)(kvbase + kkey1) * 32 + (kcc1 - 8) * 8;
  const bf16_t* ksrc2 = (kcc2 < 8) ? kn + (size_t)(kvbase + kkey2) * 512 + hh * 64 + kcc2 * 8 : kp + (size_t)(kvbase + kkey2) * 32 + (kcc2 - 8) * 8;
  const int kst0 = (kcc0 < 8) ? 512 * 128 : 32 * 128, kst1 = (kcc1 < 8) ? 512 * 128 : 32 * 128, kst2 = (kcc2 < 8) ? 512 * 128 : 32 * 128;
  const int vd0 = tid >> 4, vcc = tid & 15;
  const bf16_t* vsrc0 = WSB(OFF_VT) + (size_t)(hh * 64 + vd0) * 8704 + kvbase + vcc * 8;
  const bf16_t* vsrc1 = vsrc0 + (size_t)32 * 8704;
  uint4 rk0, rk1, rk2, rv0, rv1;
#define A8_LOAD(kt) { const int _k = (kt); \
    rk0 = *(const uint4*)(ksrc0 + (size_t)_k * kst0); rk1 = *(const uint4*)(ksrc1 + (size_t)_k * kst1); \
    rk2 = *(const uint4*)(ksrc2 + (size_t)_k * kst2); \
    rv0 = *(const uint4*)(vsrc0 + _k * 128); rv1 = *(const uint4*)(vsrc1 + _k * 128); }
#define A8_WRITE(buf) { bf16_t* _b = sKV + (buf) * KVBUF; \
    *(uint4*)(_b + kkey0 * LDK + kcc0 * 8) = rk0; *(uint4*)(_b + kkey1 * LDK + kcc1 * 8) = rk1; \
    *(uint4*)(_b + kkey2 * LDK + kcc2 * 8) = rk2; \
    *(uint4*)(_b + 128 * LDK + vd0 * LDV + vcc * 8) = rv0; *(uint4*)(_b + 128 * LDK + (vd0 + 32) * LDV + vcc * 8) = rv1; }
  A8_LOAD(0)
  A8_WRITE(0)
  __syncthreads();
  for (int kt = 0; kt < nkt; ++kt) {
    const int ktn = min(kt + 1, nkt - 1);
    A8_LOAD(ktn)
    const bf16_t* sK = sKV + (kt & 1) * KVBUF;
    const bf16_t* sV = sK + 128 * LDK;
    f32x4 sacc[8];
#pragma unroll
    for (int n = 0; n < 8; ++n) sacc[n] = (f32x4){0.f, 0.f, 0.f, 0.f};
#pragma unroll
    for (int ks = 0; ks < 3; ++ks)
#pragma unroll
      for (int n = 0; n < 8; ++n) {
        const bf16x8 a = *(const bf16x8*)(sK + (n * 16 + lr) * LDK + ks * 32 + lg * 8);
        sacc[n] = mfma16(a, qf[ks], sacc[n]);
      }
    float mx = sacc[0][0];
#pragma unroll
    for (int n = 0; n < 8; ++n)
#pragma unroll
      for (int q = 0; q < 4; ++q) mx = fmaxf(mx, sacc[n][q]);
    mx = quad_max(mx);
    const float mnew = fmaxf(mrun, mx);
    const float alpha = __builtin_amdgcn_exp2f(mrun - mnew);
    mrun = mnew;
    float ps0 = 0.f, ps1 = 0.f;
#pragma unroll
    for (int n = 0; n < 8; n += 2)
#pragma unroll
      for (int q = 0; q < 4; ++q) {
        const float e0 = __builtin_amdgcn_exp2f(sacc[n][q] - mnew); sacc[n][q] = e0; ps0 += e0;
        const float e1 = __builtin_amdgcn_exp2f(sacc[n + 1][q] - mnew); sacc[n + 1][q] = e1; ps1 += e1;
      }
    lrun = lrun * alpha + (ps0 + ps1);
#pragma unroll
    for (int i = 0; i < 4; ++i)
#pragma unroll
      for (int q = 0; q < 4; ++q) oacc[i][q] *= alpha;
#pragma unroll
    for (int ks = 0; ks < 4; ++ks) {
      union { bf16x8 v; unsigned u[4]; } pf;
      pf.u[0] = pack2(sacc[2 * ks][0], sacc[2 * ks][1]);
      pf.u[1] = pack2(sacc[2 * ks][2], sacc[2 * ks][3]);
      pf.u[2] = pack2(sacc[2 * ks + 1][0], sacc[2 * ks + 1][1]);
      pf.u[3] = pack2(sacc[2 * ks + 1][2], sacc[2 * ks + 1][3]);
#pragma unroll
      for (int m = 0; m < 4; ++m) {
        union { bf16x8 v; uint2 h[2]; } av;
        const bf16_t* vp = sV + (m * 16 + lr) * LDV + ks * 32 + lg * 4;
        av.h[0] = *(const uint2*)(vp);
        av.h[1] = *(const uint2*)(vp + 16);
        oacc[m] = mfma16(av.v, pf.v, oacc[m]);
      }
    }
    __builtin_amdgcn_sched_barrier(0);
    A8_WRITE((kt + 1) & 1)
    __syncthreads();
  }
  lrun = quad_sum(lrun);
  const float inv = 1.f / lrun;
#pragma unroll
  for (int m = 0; m < 4; ++m) {
    uint2 o;
    o.x = pack2(oacc[m][0] * inv, oacc[m][1] * inv);
    o.y = pack2(oacc[m][2] * inv, oacc[m][3] * inv);
    *(uint2*)(WSB(OFF_CAT) + (size_t)qrow * 1024 + hh * 64 + m * 16 + lg * 4) = o;
  }
}

NOINL void ssd_y_item(const P& p, int item) {
  char* smem = g_smem + VB * 73728;
  const int tid = opaque_tid(), lane = tid & 63, wave = tid >> 6, lr = lane & 15, lg = lane >> 4;
  const int cidx = item >> 3, qt = (item >> 1) & 3, half = qt >> 1, g = item & 1;
  const int r0 = cidx * 128;
  const int hh = g * 4 + wave;
  constexpr int LDC = 136, LDM = 72;
  bf16_t* sC = (bf16_t*)smem;
  bf16_t* sB = sC + 64 * LDC;
  bf16_t* sM = sB + 64 * LDC + wave * 64 * LDM;
  float* rowss = (float*)((bf16_t*)smem + 2 * 64 * LDC + 4 * 64 * LDM);
  const float* cum = WSF(OFF_CUM);
  const float* dtv = WSF(OFF_DTV);
  const int srow = tid >> 4, scol = (tid & 15) * 8;
  uint4 pb0, pb1, pb2, pb3;
  {
    const bf16_t* cs = WSB(OFF_CM) + (size_t)(r0 + qt * 32 + srow) * 256 + g * 128 + scol;
    const bf16_t* bs = WSB(OFF_BM) + (size_t)(r0 + srow) * 256 + g * 128 + scol;
    const uint4 c0 = *(const uint4*)(cs), c1 = *(const uint4*)(cs + 16 * 256);
    const uint4 b0 = *(const uint4*)(bs), b1 = *(const uint4*)(bs + 16 * 256), b2 = *(const uint4*)(bs + 32 * 256), b3 = *(const uint4*)(bs + 48 * 256);
    pb0 = *(const uint4*)(bs + 64 * 256); pb1 = *(const uint4*)(bs + 80 * 256); pb2 = *(const uint4*)(bs + 96 * 256); pb3 = *(const uint4*)(bs + 112 * 256);
    bf16_t* wc = sC + srow * LDC + scol;
    bf16_t* wb = sB + srow * LDC + scol;
    *(uint4*)(wc) = c0; *(uint4*)(wc + 16 * LDC) = c1;
    *(uint4*)(wb) = b0; *(uint4*)(wb + 16 * LDC) = b1; *(uint4*)(wb + 32 * LDC) = b2; *(uint4*)(wb + 48 * LDC) = b3;
  }
  __syncthreads();
  f32x4 Y[2][4];
#pragma unroll
  for (int i = 0; i < 2; ++i)
#pragma unroll
    for (int j = 0; j < 4; ++j) Y[i][j] = (f32x4){0.f, 0.f, 0.f, 0.f};
#pragma unroll 1
  for (int jh = 0; jh < 2; ++jh) {
    if (jh == 1) {
      __syncthreads();
      bf16_t* wb = sB + srow * LDC + scol;
      *(uint4*)(wb) = pb0; *(uint4*)(wb + 16 * LDC) = pb1; *(uint4*)(wb + 32 * LDC) = pb2; *(uint4*)(wb + 48 * LDC) = pb3;
      __syncthreads();
    }
#pragma unroll 1
    for (int dir = 0; dir < 2; ++dir) {
      const bool use = dir == 0 ? (jh <= half) : (jh >= half);
      if (!use) continue;
      bf16x8 xf[2][4];
#pragma unroll
      for (int ks = 0; ks < 2; ++ks)
#pragma unroll
        for (int pt = 0; pt < 4; ++pt)
          xf[ks][pt] = *(const bf16x8*)(WSB(OFF_XST) + (size_t)(hh * 64 + pt * 16 + lr) * 8192 + r0 + jh * 64 + ks * 32 + lg * 8);
      float ci[2], cj[4][4], dj[4][4];
#pragma unroll
      for (int it = 0; it < 2; ++it) ci[it] = cum[((size_t)dir * 8192 + r0 + qt * 32 + it * 16 + lr) * 8 + hh];
#pragma unroll
      for (int jt = 0; jt < 4; ++jt)
#pragma unroll
        for (int q = 0; q < 4; ++q) {
          const size_t tj = (size_t)dir * 8192 + r0 + jh * 64 + jt * 16 + lg * 4 + q;
          cj[jt][q] = cum[tj * 8 + hh];
          dj[jt][q] = dtv[tj * 8 + hh];
        }
#pragma unroll
      for (int it = 0; it < 2; ++it) {
        f32x4 cb[4];
#pragma unroll
        for (int jt = 0; jt < 4; ++jt) cb[jt] = (f32x4){0.f, 0.f, 0.f, 0.f};
#pragma unroll
        for (int ks = 0; ks < 4; ++ks) {
          const bf16x8 b = *(const bf16x8*)(sC + (it * 16 + lr) * LDC + ks * 32 + lg * 8);
#pragma unroll
          for (int jt = 0; jt < 4; ++jt) {
            const bf16x8 a = *(const bf16x8*)(sB + (jt * 16 + lr) * LDC + ks * 32 + lg * 8);
            cb[jt] = mfma16(a, b, cb[jt]);
          }
        }
        const int ti = qt * 32 + it * 16 + lr;
#pragma unroll
        for (int jt = 0; jt < 4; ++jt) {
          float v[4];
#pragma unroll
          for (int q = 0; q < 4; ++q) {
            const int tj = jh * 64 + jt * 16 + lg * 4 + q;
            const bool ok = dir == 0 ? (tj <= ti) : (tj >= ti);
            v[q] = ok ? cb[jt][q] * __expf(ci[it] - cj[jt][q]) * dj[jt][q] : 0.f;
          }
          uint2 o;
          o.x = pack2(v[0], v[1]);
          o.y = pack2(v[2], v[3]);
          *(uint2*)(sM + (it * 16 + lr) * LDM + jt * 16 + lg * 4) = o;
        }
        __builtin_amdgcn_sched_barrier(0);
      }
      asm volatile("s_waitcnt lgkmcnt(0)" ::: "memory");
#pragma unroll
      for (int ks = 0; ks < 2; ++ks) {
        bf16x8 af[2];
#pragma unroll
        for (int it = 0; it < 2; ++it) af[it] = *(const bf16x8*)(sM + (it * 16 + lr) * LDM + ks * 32 + lg * 8);
#pragma unroll
        for (int it = 0; it < 2; ++it)
#pragma unroll
          for (int pt = 0; pt < 4; ++pt) Y[it][pt] = mfma16(af[it], xf[ks][pt], Y[it][pt]);
      }
      asm volatile("s_waitcnt lgkmcnt(0)" ::: "memory");
      __builtin_amdgcn_sched_barrier(0);
    }
  }
#pragma unroll 1
  for (int dir = 0; dir < 2; ++dir) {
    const bf16_t* hp = WSB(OFF_H) + ((size_t)(dir * 64 + cidx) * 8 + hh) * 8192;
    float ei[2][4];
#pragma unroll
    for (int it = 0; it < 2; ++it)
#pragma unroll
      for (int q = 0; q < 4; ++q)
        ei[it][q] = __expf(cum[((size_t)dir * 8192 + r0 + qt * 32 + it * 16 + lg * 4 + q) * 8 + hh]);
#pragma unroll
    for (int pt = 0; pt < 4; ++pt) {
      bf16x8 bfr[4];
#pragma unroll
      for (int ks = 0; ks < 4; ++ks) bfr[ks] = *(const bf16x8*)(hp + (size_t)(pt * 16 + lr) * 128 + ks * 32 + lg * 8);
      f32x4 T[2];
#pragma unroll
      for (int it = 0; it < 2; ++it) T[it] = (f32x4){0.f, 0.f, 0.f, 0.f};
#pragma unroll
      for (int ks = 0; ks < 4; ++ks)
#pragma unroll
        for (int it = 0; it < 2; ++it) {
          const bf16x8 a = *(const bf16x8*)(sC + (it * 16 + lr) * LDC + ks * 32 + lg * 8);
          T[it] = mfma16(a, bfr[ks], T[it]);
        }
#pragma unroll
      for (int it = 0; it < 2; ++it)
#pragma unroll
        for (int q = 0; q < 4; ++q) Y[it][pt][q] += ei[it][q] * T[it][q];
    }
    __builtin_amdgcn_sched_barrier(0);
  }
  const float dsk = p.ssd_d[hh];
  const float* proj = WSF(OFF_R1);
#pragma unroll
  for (int i = 0; i < 2; ++i) {
#pragma unroll
    for (int q = 0; q < 4; ++q) {
      const int il = i * 16 + lg * 4 + q;
      const size_t r = (size_t)r0 + qt * 32 + il;
      float ss = 0.f;
#pragma unroll
      for (int j = 0; j < 4; ++j) {
        const int ch = hh * 64 + j * 16 + lr;
        const float xs = bf2f(WSB(OFF_XS)[r * 512 + ch]);
        const float z = proj[r * 2096 + 544 + ch];
        const float y = (Y[i][j][q] + dsk * xs) * silu(z);
        Y[i][j][q] = y;
        ss += y * y;
      }
      ss += __shfl_xor(ss, 1, 64);
      ss += __shfl_xor(ss, 2, 64);
      ss += __shfl_xor(ss, 4, 64);
      ss += __shfl_xor(ss, 8, 64);
      if (lr == 0) rowss[wave * 64 + il] = ss;
    }
    __builtin_amdgcn_sched_barrier(0);
  }
  __syncthreads();
#pragma unroll
  for (int i = 0; i < 2; ++i) {
#pragma unroll
    for (int q = 0; q < 4; ++q) {
      const int il = i * 16 + lg * 4 + q;
      const size_t r = (size_t)r0 + qt * 32 + il;
      const float tot = rowss[il] + rowss[64 + il] + rowss[128 + il] + rowss[192 + il];
      const float rs = rsqrtf(tot * (1.f / 256.f) + 1e-6f);
#pragma unroll
      for (int j = 0; j < 4; ++j) {
        const int ch = hh * 64 + j * 16 + lr;
        WSB(OFF_CAT)[r * 1024 + 512 + ch] = f2bf(Y[i][j][q] * rs * p.ssd_norm[ch]);
      }
    }
    __builtin_amdgcn_sched_barrier(0);
  }
  __syncthreads();
}

template <int W2>
DEVI void pool_item(const bf16_t* __restrict__ h, bf16_t* __restrict__ dst, int r, int cc) {
  int s0, L;
  if (r < 4096) { s0 = r & ~255; L = 256; } else { s0 = 4096 + ((r - 4096) & ~2047); L = 2048; }
  const int t = r - s0;
  const int lo = max(t - W2, 0), hi = min(t + W2, L);
  uint4 v[2 * W2];
#pragma unroll
  for (int k = 0; k < 2 * W2; ++k) {
    const int u = min(max(t - W2 + k, 0), L - 1);
    v[k] = *(const uint4*)(h + (size_t)(s0 + u) * 1024 + cc);
  }
  float acc[8] = {0, 0, 0, 0, 0, 0, 0, 0};
#pragma unroll
  for (int k = 0; k < 2 * W2; ++k) {
    const int u = t - W2 + k;
    const float m = (u >= 0 && u < L) ? 1.f : 0.f;
    acc[0] += m * __uint_as_float(v[k].x << 16); acc[1] += m * __uint_as_float(v[k].x & 0xffff0000u);
    acc[2] += m * __uint_as_float(v[k].y << 16); acc[3] += m * __uint_as_float(v[k].y & 0xffff0000u);
    acc[4] += m * __uint_as_float(v[k].z << 16); acc[5] += m * __uint_as_float(v[k].z & 0xffff0000u);
    acc[6] += m * __uint_as_float(v[k].w << 16); acc[7] += m * __uint_as_float(v[k].w & 0xffff0000u);
  }
  const float inv = 1.f / (float)(hi - lo);
  const uint4 c = v[W2];
  uint4 o;
  o.x = pack2(acc[0] * inv - __uint_as_float(c.x << 16), acc[1] * inv - __uint_as_float(c.x & 0xffff0000u));
  o.y = pack2(acc[2] * inv - __uint_as_float(c.y << 16), acc[3] * inv - __uint_as_float(c.y & 0xffff0000u));
  o.z = pack2(acc[4] * inv - __uint_as_float(c.z << 16), acc[5] * inv - __uint_as_float(c.z & 0xffff0000u));
  o.w = pack2(acc[6] * inv - __uint_as_float(c.w << 16), acc[7] * inv - __uint_as_float(c.w & 0xffff0000u));
  *(uint4*)(dst + (size_t)r * 1024 + cc) = o;
}

NOINL void pool_phase(const P& p) {
  const bf16_t* h = WSB(OFF_H);
  bf16_t* dst = WSB(OFF_CAT);
  const int total = 8192 * 128;
  for (int idx = blockIdx.x * 512 + threadIdx.x; idx < total; idx += gridDim.x * 512) {
    const int c32 = idx & 31, rlo = (idx >> 5) & 1, gi = (idx >> 6) & 3, rhi = idx >> 8;
    const int r = rhi * 2 + rlo, cc = gi * 256 + c32 * 8;
    if (gi == 0) pool_item<1>(h, dst, r, cc);
    else if (gi == 1) pool_item<2>(h, dst, r, cc);
    else if (gi == 2) pool_item<4>(h, dst, r, cc);
    else pool_item<8>(h, dst, r, cc);
  }
}

NOINL void ph_gemm_proj(const P& p) {
  float* proj = WSF(OFF_R1);
  const bf16_t* A = WSB(OFF_H);
  const bf16_t* B = WSB(OFF_WIN);
  auto epi = [&](int ctx, int row, int col, f32x4 v0, f32x4 v1) {
#pragma unroll
    for (int q = 0; q < 4; ++q) {
      if (col < 2096) proj[(size_t)(row + q) * 2096 + col] = v0[q];
      if (col + 16 < 2096) proj[(size_t)(row + q) * 2096 + col + 16] = v1[q];
    }
  };
  gemm8_stream(256, 1024, 1024, 1024,
    [=](int t) {
      TileInfo r;
      int m, n; tile_mn(t, 32, 8, m, n);
      r.m0 = m * 256; r.n0 = n * 256; r.ctx = 0;
      r.a = A + (size_t)r.m0 * 1024; r.b = B + (size_t)r.n0 * 1024;
      return r;
    }, epi);
  gemm_stream(64, 1024, 1024, 1024, g_smem + VB * 73728,
    [=](int t) {
      TileInfo r;
      r.m0 = t * 128; r.n0 = 2048; r.ctx = 0;
      r.a = A + (size_t)r.m0 * 1024; r.b = B + (size_t)2048 * 1024;
      return r;
    }, epi);
}

NOINL void ph_gemm_f32out(const P& p, const bf16_t* A, int lda, const bf16_t* B, int ldb, int K, bf16_t* C, int N) {
  const int nN = N / 128;
  gemm_stream(64 * nN, lda, ldb, K, g_smem + VB * 73728,
    [=](int t) {
      TileInfo r;
      int m, n; tile_mn(t, 64, nN, m, n);
      r.m0 = m * 128; r.n0 = n * 128; r.ctx = 0;
      r.a = A + (size_t)r.m0 * lda; r.b = B + (size_t)r.n0 * ldb;
      return r;
    },
    [&](int ctx, int row, int col, f32x4 v0, f32x4 v1) {
#pragma unroll
      for (int q = 0; q < 4; ++q) {
        C[(size_t)(row + q) * N + col] = f2bf(v0[q]);
        C[(size_t)(row + q) * N + col + 16] = f2bf(v1[q]);
      }
    });
}

NOINL void ph_gemm8_splitk(const P& p, const bf16_t* A, int lda, const bf16_t* B, int ldb, int Khalf, bf16_t* C0, bf16_t* C1) {
  gemm8_stream(256, lda, ldb, Khalf,
    [=](int t) {
      TileInfo r;
      const int id = swz_tile(t, 256);
      const int ks = id >> 7, rem = id & 127;
      r.m0 = (rem >> 2) * 256; r.n0 = (rem & 3) * 256; r.ctx = ks;
      r.a = A + (size_t)r.m0 * lda + (size_t)ks * Khalf; r.b = B + (size_t)r.n0 * ldb + (size_t)ks * Khalf;
      return r;
    },
    [&](int ks, int row, int col, f32x4 v0, f32x4 v1) {
      bf16_t* C = ks ? C1 : C0;
#pragma unroll
      for (int q = 0; q < 4; ++q) {
        C[(size_t)(row + q) * 1024 + col] = f2bf(v0[q]);
        C[(size_t)(row + q) * 1024 + col + 16] = f2bf(v1[q]);
      }
    });
}

NOINL void ph_gemm_q(const P& p) {
  bf16_t* qo = WSB(OFF_Q);
  const bf16_t* A = WSB(OFF_CQN);
  const bf16_t* B = WSB(OFF_WUQ);
  gemm_stream(64 * 6, 256, 256, 256, g_smem + VB * 73728,
    [=](int t) {
      TileInfo r;
      int m, n; tile_mn(t, 64, 6, m, n);
      r.m0 = m * 128; r.n0 = n * 128; r.ctx = 0;
      r.a = A + (size_t)r.m0 * 256; r.b = B + (size_t)r.n0 * 256;
      return r;
    },
    [&](int ctx, int row, int col, f32x4 v0, f32x4 v1) {
      const float scl = 0.10206207261596575f * 1.4426950408889634f;
      const int tn = col >> 4;
      const bool rope = ((tn % 6) == 4) && (row >= 4096);
      const int ii = col & 15;
      const float fr = rope_freq(ii & 7);
#pragma unroll
      for (int q = 0; q < 4; ++q) {
        float a = v0[q], b = v1[q];
        if (rope) {
          const int tt = (row + q - 4096) & 2047;
          const float pos = (ii < 8) ? (float)(tt >> 6) : (float)(tt & 63);
          const float ang = pos * fr;
          float cs, sn;
          fast_sincos(ang, sn, cs);
          const float x1 = a, x2 = b;
          a = x1 * cs - x2 * sn;
          b = x1 * sn + x2 * cs;
        }
        qo[(size_t)(row + q) * 768 + col] = f2bf(a * scl);
        qo[(size_t)(row + q) * 768 + col + 16] = f2bf(b * scl);
      }
    });
}

NOINL void ph_gemm_kv(const P& p) {
  bf16_t* kn = WSB(OFF_KN);
  bf16_t* vt = WSB(OFF_VT);
  const bf16_t* A = WSB(OFF_CKV);
  const bf16_t* B = WSB(OFF_WUKV);
  gemm_stream(68 * 8, 256, 256, 256, g_smem + VB * 73728,
    [=](int t) {
      TileInfo r;
      int m, n; tile_mn(t, 68, 8, m, n);
      r.m0 = m * 128; r.n0 = n * 128; r.ctx = 0;
      r.a = A + (size_t)r.m0 * 256; r.b = B + (size_t)r.n0 * 256;
      return r;
    },
    [&](int ctx, int row, int col, f32x4 v0, f32x4 v1) {
      const int hh = col >> 7, j = col & 127;
      if (j < 64) {
#pragma unroll
        for (int q = 0; q < 4; ++q) {
          kn[(size_t)(row + q) * 512 + hh * 64 + j] = f2bf(v0[q]);
          kn[(size_t)(row + q) * 512 + hh * 64 + j + 16] = f2bf(v1[q]);
        }
      } else {
        uint2 o0, o1;
        o0.x = pack2(v0[0], v0[1]); o0.y = pack2(v0[2], v0[3]);
        o1.x = pack2(v1[0], v1[1]); o1.y = pack2(v1[2], v1[3]);
        *(uint2*)(vt + (size_t)(hh * 64 + j - 64) * 8704 + row) = o0;
        *(uint2*)(vt + (size_t)(hh * 64 + j - 64 + 16) * 8704 + row) = o1;
      }
    });
}

NOINL void ph_gemm_ffn_up(const P& p, int layer) {
  bf16_t* gu = WSB(OFF_R1);
  const bf16_t* A = WSB(OFF_H);
  const bf16_t* B = WSB(OFF_WGU) + (size_t)layer * 5632 * 1024;
  gemm8_stream(32 * 22, 1024, 1024, 1024,
    [=](int t) {
      TileInfo r;
      int m, n; tile_mn(t, 32, 22, m, n);
      r.m0 = m * 256; r.n0 = n * 256; r.ctx = 0;
      r.a = A + (size_t)r.m0 * 1024; r.b = B + (size_t)r.n0 * 1024;
      return r;
    },
    [&](int ctx, int row, int col, f32x4 v0, f32x4 v1) {
      const int oc = (col >> 5) * 16 + (col & 15);
#pragma unroll
      for (int q = 0; q < 4; ++q) gu[(size_t)(row + q) * 2816 + oc] = f2bf(silu(v0[q]) * v1[q]);
    });
}

NOINL void ph_gemm_pool(const P& p) {
  bf16_t* mix = WSB(OFF_R1);
  const bf16_t* A = WSB(OFF_CAT);
  const bf16_t* B = WSB(OFF_WPOOL);
  gemm_stream(512, 1024, 256, 256, g_smem + VB * 73728,
    [=](int t) {
      TileInfo r;
      const int id = swz_tile(t, 512);
      const int g = id >> 7, rem = id & 127;
      r.m0 = (rem >> 1) * 128; r.n0 = (rem & 1) * 128; r.ctx = g;
      r.a = A + (size_t)r.m0 * 1024 + g * 256; r.b = B + (size_t)g * 65536 + (size_t)r.n0 * 256;
      return r;
    },
    [&](int g, int row, int col, f32x4 v0, f32x4 v1) {
      const int c0 = g * 256 + col;
      const float s0 = p.pool_scale[c0], s1 = p.pool_scale[c0 + 16];
#pragma unroll
      for (int q = 0; q < 4; ++q) {
        mix[(size_t)(row + q) * 1024 + c0] = f2bf(v0[q] * s0);
        mix[(size_t)(row + q) * 1024 + c0 + 16] = f2bf(v1[q] * s1);
      }
    });
}


#define XB_TMO      128
#define XB_XCNT(j)  (256  + 64 * (j))
#define XB_XSUB(j)  (1280 + 64 * (j))
#define XB_XGEN(j)  (2304 + 64 * (j))
#define XB_TOP      3328
#define XB_TOPGEN   3392
#define XCD_BAR_WORDS 3456
#define XB_SPIN_CAP (1u << 22)
#define LAS __attribute__((address_space(3)))
DEVI unsigned xb_ld(unsigned* p) { return __hip_atomic_load(p, __ATOMIC_RELAXED, __HIP_MEMORY_SCOPE_AGENT); }
DEVI unsigned xb_add(unsigned* p, unsigned v) { return __hip_atomic_fetch_add(p, v, __ATOMIC_RELAXED, __HIP_MEMORY_SCOPE_AGENT); }
DEVI unsigned xb_xcc_id() { return (unsigned)__builtin_amdgcn_s_getreg((3 << 11) | 20) & 0xFu; }
#define XB_SPIN(cond, bar) do { unsigned _sp = 0; while (cond) { __builtin_amdgcn_s_sleep(1); \
    if ((++_sp & 255u) == 0u) { if (xb_ld(&(bar)[XB_TMO])) break; if (_sp > XB_SPIN_CAP) { atomicAdd(&(bar)[XB_TMO], 1u); break; } } } } while (0)
struct XcdBarrier { unsigned* bar; unsigned x; volatile LAS unsigned* st; };
DEVI XcdBarrier xcd_barrier_post(unsigned* bar, volatile LAS unsigned* st) {
  XcdBarrier b; b.bar = bar; b.x = xb_xcc_id(); b.st = st;
  if (threadIdx.x == 0) (void)xb_add(&bar[XB_XCNT(b.x)], 1u);
  return b;
}
DEVI void xcd_barrier_complete(unsigned* bar, unsigned x, unsigned& nloc, unsigned& nx) {
  const unsigned G = gridDim.x * gridDim.y * gridDim.z;
  unsigned sum, cnt, mine, sp = 0u;
  for (;;) {
    sum = 0u; cnt = 0u; mine = 0u;
#pragma unroll
    for (unsigned j = 0; j < 16; ++j) { const unsigned c = xb_ld(&bar[XB_XCNT(j)]); sum += c; cnt += (c > 0u) ? 1u : 0u; mine = (j == x) ? c : mine; }
    if (sum == G) break;
    __builtin_amdgcn_s_sleep(1);
    if ((++sp & 255u) == 0u) { if (xb_ld(&bar[XB_TMO])) break; if (sp > XB_SPIN_CAP) { atomicAdd(&bar[XB_TMO], 1u); break; } }
  }
  nloc = mine > 0u ? mine : 1u; nx = cnt > 0u ? cnt : 1u;
}
DEVI void xcd_barrier(const XcdBarrier& b) {
  asm volatile("s_waitcnt vmcnt(0)" ::: "memory");
  __syncthreads();
  if (threadIdx.x == 0) {
    unsigned* bar = b.bar;
    __builtin_amdgcn_s_waitcnt(0);
    unsigned nloc = b.st[0], nx = b.st[1];
    if (nloc == 0u) { xcd_barrier_complete(bar, b.x, nloc, nx); b.st[0] = nloc; b.st[1] = nx; }
    const unsigned old = xb_add(&bar[XB_XSUB(b.x)], 1u);
    const unsigned gen = old / nloc;
    if (old + 1u == (gen + 1u) * nloc) {
      __builtin_amdgcn_fence(__ATOMIC_RELEASE, "agent");
      asm volatile("s_waitcnt vmcnt(0)" ::: "memory");
      const unsigned og = xb_add(&bar[XB_TOP], 1u);
      const unsigned tg = og / nx;
      if (og + 1u == (tg + 1u) * nx) xb_add(&bar[XB_TOPGEN], 1u);
      else XB_SPIN(xb_ld(&bar[XB_TOPGEN]) == tg, bar);
      __builtin_amdgcn_fence(__ATOMIC_ACQUIRE, "agent");
      xb_add(&bar[XB_XGEN(b.x)], 1u);
      asm volatile("s_waitcnt vmcnt(0)" ::: "memory");
    } else {
      XB_SPIN(xb_ld(&bar[XB_XGEN(b.x)]) == gen, bar);
      __builtin_amdgcn_fence(__ATOMIC_ACQUIRE, "agent");
      asm volatile("s_waitcnt vmcnt(0)" ::: "memory");
    }
  }
  __syncthreads();
}

constexpr int NPHASE = 18;
#ifndef REPMASK
#define REPMASK 0
#endif
#ifndef ATPROBE
#define ATPROBE 0
#endif
#ifndef P6PROBE
#define P6PROBE 1
#endif
#ifndef PHMASK
#define PHMASK 0x3ffff
#endif
#define PH(n) if constexpr ((PHMASK >> (n)) & 1)

__global__ void __launch_bounds__(512, 2) mega(P p, int lo, int hi) {
  __shared__ uint4 xb_words;
  if (threadIdx.x == 0) xb_words = make_uint4(0u, 0u, 0u, 0u);
  __syncthreads();
  XcdBarrier xb = xcd_barrier_post((unsigned*)(p.ws + OFF_BAR), (volatile LAS unsigned*)&xb_words);
  if (lo < 0) cg::this_grid().sync();
  PH(0) if (lo <= 0 && 0 < hi) {
#if (REPMASK >> 0) & 1
    int nrep = 2; asm volatile("" : "+s"(nrep));
    for (int rep = 0; rep < nrep; ++rep) {
      if (rep) xcd_barrier(xb);
#else
    {
#endif
        for (int t0_ = blockIdx.x * 2; t0_ < 384 + 5200; t0_ += gridDim.x * 2) {
          const int t = min(t0_ + VB, 384 + 5200 - 1);
          if (t < 384) gemv_tile(p, t); else transpose_tile(p, t - 384);
        }
    }
  }
  if (lo <= 0 && 0 + 1 < hi) xcd_barrier(xb);
  PH(1) if (lo <= 1 && 1 < hi) {
#if (REPMASK >> 1) & 1
    int nrep = 2; asm volatile("" : "+s"(nrep));
    for (int rep = 0; rep < nrep; ++rep) {
      if (rep) xcd_barrier(xb);
#else
    {
#endif
        rowop<false, true, true, false, false>(p, nullptr, nullptr, nullptr, 0, p.n_pre_mix, 0, 1, 0, 0);
    }
  }
  if (lo <= 1 && 1 + 1 < hi) xcd_barrier(xb);
  PH(2) if (lo <= 2 && 2 < hi) {
#if (REPMASK >> 2) & 1
    int nrep = 2; asm volatile("" : "+s"(nrep));
    for (int rep = 0; rep < nrep; ++rep) {
      if (rep) xcd_barrier(xb);
#else
    {
#endif
        ph_gemm_proj(p);
    }
  }
  if (lo <= 2 && 2 + 1 < hi) xcd_barrier(xb);
  PH(3) if (lo <= 3 && 3 < hi) {
#if (REPMASK >> 3) & 1
    int nrep = 2; asm volatile("" : "+s"(nrep));
    for (int rep = 0; rep < nrep; ++rep) {
      if (rep) xcd_barrier(xb);
#else
    {
#endif
        prep_rows(p);
        prep_cache(p);
        for (int t0_ = VT_FIRST; t0_ < 2048; t0_ += gridDim.x * 2) conv_tile(p, min(t0_ + VT_OFF, 2047));
    }
  }
  if (lo <= 3 && 3 + 1 < hi) xcd_barrier(xb);
  PH(4) if (lo <= 4 && 4 < hi) {
#if (REPMASK >> 4) & 1
    int nrep = 2; asm volatile("" : "+s"(nrep));
    for (int rep = 0; rep < nrep; ++rep) {
      if (rep) xcd_barrier(xb);
#else
    {
#endif
        ph_gemm_q(p);
        ph_gemm_kv(p);
        for (int t0_ = VT_FIRST; t0_ < 512; t0_ += gridDim.x * 2) chunk_state_item(p, min(t0_ + VT_OFF, 511));
    }
  }
  if (lo <= 4 && 4 + 1 < hi) xcd_barrier(xb);
  PH(5) if (lo <= 5 && 5 < hi) {
#if (REPMASK >> 5) & 1
    int nrep = 2; asm volatile("" : "+s"(nrep));
    for (int rep = 0; rep < nrep; ++rep) {
      if (rep) xcd_barrier(xb);
#else
    {
#endif
        scan_states(p);
    }
  }
  if (lo <= 5 && 5 + 1 < hi) xcd_barrier(xb);
  PH(6) if (lo <= 6 && 6 < hi) {
#if (REPMASK >> 6) & 1
    int nrep = 2; asm volatile("" : "+s"(nrep));
    for (int rep = 0; rep < nrep; ++rep) {
      if (rep) xcd_barrier(xb);
#else
    {
#endif
        for (int t = blockIdx.x; t < 512; t += gridDim.x) attn8_item(p, t);
        for (int t0_ = VT_FIRST; t0_ < 512; t0_ += gridDim.x * 2) ssd_y_item(p, min(t0_ + VT_OFF, 511));
    }
  }
  if (lo <= 6 && 6 + 1 < hi) xcd_barrier(xb);
  PH(7) if (lo <= 7 && 7 < hi) {
#if (REPMASK >> 7) & 1
    int nrep = 2; asm volatile("" : "+s"(nrep));
    for (int rep = 0; rep < nrep; ++rep) {
      if (rep) xcd_barrier(xb);
#else
    {
#endif
        ph_gemm8_splitk(p, WSB(OFF_CAT), 1024, WSB(OFF_WOUT), 1024, 512, WSB(OFF_R1), WSB(OFF_R1) + (size_t)8192 * 1024);
    }
  }
  if (lo <= 7 && 7 + 1 < hi) xcd_barrier(xb);
  PH(8) if (lo <= 8 && 8 < hi) {
#if (REPMASK >> 8) & 1
    int nrep = 2; asm volatile("" : "+s"(nrep));
    for (int rep = 0; rep < nrep; ++rep) {
      if (rep) xcd_barrier(xb);
#else
    {
#endif
        rowop<true, true, true, false, true>(p, WSB(OFF_R1), WSB(OFF_R1) + (size_t)8192 * 1024, p.n_post_mix, 2, p.n_pre_ffn, 3, 4, 0, 0);
    }
  }
  if (lo <= 8 && 8 + 1 < hi) xcd_barrier(xb);
  PH(9) if (lo <= 9 && 9 < hi) {
#if (REPMASK >> 9) & 1
    int nrep = 2; asm volatile("" : "+s"(nrep));
    for (int rep = 0; rep < nrep; ++rep) {
      if (rep) xcd_barrier(xb);
#else
    {
#endif
        ph_gemm_ffn_up(p, 0);
    }
  }
  if (lo <= 9 && 9 + 1 < hi) xcd_barrier(xb);
  PH(10) if (lo <= 10 && 10 < hi) {
#if (REPMASK >> 10) & 1
    int nrep = 2; asm volatile("" : "+s"(nrep));
    for (int rep = 0; rep < nrep; ++rep) {
      if (rep) xcd_barrier(xb);
#else
    {
#endif
        ph_gemm8_splitk(p, WSB(OFF_R1), 2816, WSB(OFF_WDN), 2816, 1408, WSB(OFF_R2), WSB(OFF_R2) + (size_t)8192 * 1024);
    }
  }
  if (lo <= 10 && 10 + 1 < hi) xcd_barrier(xb);
  PH(11) if (lo <= 11 && 11 < hi) {
#if (REPMASK >> 11) & 1
    int nrep = 2; asm volatile("" : "+s"(nrep));
    for (int rep = 0; rep < nrep; ++rep) {
      if (rep) xcd_barrier(xb);
#else
    {
#endif
        rowop<true, true, false, false, true>(p, WSB(OFF_R2), WSB(OFF_R2) + (size_t)8192 * 1024, p.n_post_ffn, 5, p.n_pre_mix + 1024, 0, 1, 0, 1);
    }
  }
  if (lo <= 11 && 11 + 1 < hi) xcd_barrier(xb);
  PH(12) if (lo <= 12 && 12 < hi) {
#if (REPMASK >> 12) & 1
    int nrep = 2; asm volatile("" : "+s"(nrep));
    for (int rep = 0; rep < nrep; ++rep) {
      if (rep) xcd_barrier(xb);
#else
    {
#endif
        pool_phase(p);
    }
  }
  if (lo <= 12 && 12 + 1 < hi) xcd_barrier(xb);
  PH(13) if (lo <= 13 && 13 < hi) {
#if (REPMASK >> 13) & 1
    int nrep = 2; asm volatile("" : "+s"(nrep));
    for (int rep = 0; rep < nrep; ++rep) {
      if (rep) xcd_barrier(xb);
#else
    {
#endif
        ph_gemm_pool(p);
    }
  }
  if (lo <= 13 && 13 + 1 < hi) xcd_barrier(xb);
  PH(14) if (lo <= 14 && 14 < hi) {
#if (REPMASK >> 14) & 1
    int nrep = 2; asm volatile("" : "+s"(nrep));
    for (int rep = 0; rep < nrep; ++rep) {
      if (rep) xcd_barrier(xb);
#else
    {
#endif
        rowop<true, true, false, false, false>(p, WSB(OFF_R1), nullptr, p.n_post_mix + 1024, 2, p.n_pre_ffn + 1024, 3, 4, 1, 1);
    }
  }
  if (lo <= 14 && 14 + 1 < hi) xcd_barrier(xb);
  PH(15) if (lo <= 15 && 15 < hi) {
#if (REPMASK >> 15) & 1
    int nrep = 2; asm volatile("" : "+s"(nrep));
    for (int rep = 0; rep < nrep; ++rep) {
      if (rep) xcd_barrier(xb);
#else
    {
#endif
        ph_gemm_ffn_up(p, 1);
    }
  }
  if (lo <= 15 && 15 + 1 < hi) xcd_barrier(xb);
  PH(16) if (lo <= 16 && 16 < hi) {
#if (REPMASK >> 16) & 1
    int nrep = 2; asm volatile("" : "+s"(nrep));
    for (int rep = 0; rep < nrep; ++rep) {
      if (rep) xcd_barrier(xb);
#else
    {
#endif
        ph_gemm8_splitk(p, WSB(OFF_R1), 2816, WSB(OFF_WDN) + (size_t)1024 * 2816, 2816, 1408, WSB(OFF_R2), WSB(OFF_R2) + (size_t)8192 * 1024);
    }
  }
  if (lo <= 16 && 16 + 1 < hi) xcd_barrier(xb);
  PH(17) if (lo <= 17 && 17 < hi) {
#if (REPMASK >> 17) & 1
    int nrep = 2; asm volatile("" : "+s"(nrep));
    for (int rep = 0; rep < nrep; ++rep) {
      if (rep) xcd_barrier(xb);
#else
    {
#endif
        rowop<true, false, false, true, true>(p, WSB(OFF_R2), WSB(OFF_R2) + (size_t)8192 * 1024, p.n_post_ffn + 1024, 5, nullptr, 0, 0, 1, 1);
    }
  }
}

extern "C" void kernel_launch(void* const* d_in, const int* in_sizes, int n_in, void* d_out, int out_size, void* d_ws,
                              size_t ws_size, hipStream_t stream) {
  P p{};
  const float** f = (const float**)&p;
  for (int i = 0; i < 33; ++i) f[i] = (const float*)d_in[i];
  p.out = (float*)d_out;
  p.ws = (char*)d_ws;
  static int grid_blocks = 0;
  if (!grid_blocks) {
    int dev = 0, cus = 0, per_cu = 0;
    hipGetDevice(&dev);
    hipDeviceGetAttribute(&cus, hipDeviceAttributeMultiprocessorCount, dev);
    hipOccupancyMaxActiveBlocksPerMultiprocessor(&per_cu, mega, 512, 0);
    if (per_cu > 1) per_cu = 1;
    if (per_cu < 1) per_cu = 1;
    grid_blocks = cus * per_cu;
  }
  hipMemsetAsync((char*)d_ws + OFF_BAR, 0, XCD_BAR_WORDS * 4, stream);
#if SINGLE_LAUNCH
  int lo = 0, hi = NPHASE;
  void* args[] = {&p, &lo, &hi};
  hipError_t e = hipLaunchCooperativeKernel((void*)mega, dim3(grid_blocks), dim3(512), args, 0, stream);
  if (e != hipSuccess) fprintf(stderr, "cooperative launch failed: %s (grid %d)\n", hipGetErrorString(e), grid_blocks);
#else
  for (int ph = 0; ph < NPHASE; ++ph) mega<<<grid_blocks, 512, 0, stream>>>(p, ph, ph + 1);
#endif
}
```

```cpp
#include <hip/hip_runtime.h>
#include <hip/hip_cooperative_groups.h>
#include <stdint.h>
#include <stdio.h>
namespace cg = cooperative_groups;

#ifndef SINGLE_LAUNCH
#define SINGLE_LAUNCH 1
#endif

typedef __attribute__((ext_vector_type(8))) short bf16x8;
typedef __attribute__((ext_vector_type(4))) float f32x4;
typedef unsigned short bf16_t;

#define DEVI __device__ __forceinline__

constexpr size_t OFF_WIN   = 0;
constexpr size_t OFF_WUQ   = OFF_WIN   + (size_t)2176*1024*2;
constexpr size_t OFF_WUKV  = OFF_WUQ   + (size_t)768*256*2;
constexpr size_t OFF_WOUT  = OFF_WUKV  + (size_t)1024*256*2;
constexpr size_t OFF_WPOOL = OFF_WOUT  + (size_t)1024*1024*2;
constexpr size_t OFF_WGU   = OFF_WPOOL + (size_t)4*256*256*2;
constexpr size_t OFF_WDN   = OFF_WGU   + (size_t)2*5632*1024*2;
constexpr size_t OFF_MOD   = OFF_WDN   + (size_t)2*1024*2816*2;
constexpr size_t OFF_R1    = OFF_MOD   + (size_t)2*3*6144*4;
constexpr size_t OFF_R2    = OFF_R1    + (size_t)8192*2096*4;
constexpr size_t OFF_H     = OFF_R2    + (size_t)8192*1024*4;
constexpr size_t OFF_CAT   = OFF_H     + (size_t)8192*1024*2;
constexpr size_t OFF_Q     = OFF_CAT   + (size_t)8192*1024*2;
constexpr size_t OFF_KN    = OFF_Q     + (size_t)8192*768*2;
constexpr size_t OFF_VT    = OFF_KN    + (size_t)8704*512*2;
constexpr size_t OFF_CQN   = OFF_VT    + (size_t)8704*512*2;
constexpr size_t OFF_CKV   = OFF_CQN   + (size_t)8192*256*2;
constexpr size_t OFF_KPE   = OFF_CKV   + (size_t)8704*256*2;
constexpr size_t OFF_XS    = OFF_KPE   + (size_t)8704*32*2;
constexpr size_t OFF_XST   = OFF_XS    + (size_t)8192*512*2;
constexpr size_t OFF_BM    = OFF_XST   + (size_t)8192*512*2;
constexpr size_t OFF_BT    = OFF_BM    + (size_t)8192*256*2;
constexpr size_t OFF_CM    = OFF_BT    + (size_t)8192*256*2;
constexpr size_t OFF_DTV   = OFF_CM    + (size_t)8192*256*2;
constexpr size_t OFF_CUM   = OFF_DTV   + (size_t)2*8192*8*4;
constexpr size_t OFF_TOT   = OFF_CUM   + (size_t)2*8192*8*4;
constexpr size_t OFF_BAR   = OFF_TOT   + 4096;
constexpr size_t OFF_XR    = OFF_BAR   + 16384;
constexpr size_t OFF_END   = OFF_XR    + (size_t)8192*1024*2;
static_assert(OFF_END <= ((size_t)256 << 20), "workspace map exceeds 256 MiB");

constexpr size_t OUT_CKV = 8388608, OUT_KR = 9437184, OUT_SF = 9568256, OUT_SB = 10616832;

struct P {
  const float *x_prompt, *x_sample, *c, *cache_ckv, *cache_kr, *st_f, *st_b, *c_ctx;
  const float *w_mod, *b_mod, *n_pre_mix, *n_post_mix, *n_pre_ffn, *n_post_ffn;
  const float *w_in, *q_norm, *w_uq, *kv_norm, *w_ukv, *conv_w, *conv_b, *dtb_f, *dtb_b, *alog_f, *alog_b;
  const float *ssd_d, *ssd_norm, *w_out, *pool_w, *pool_scale, *w_gate, *w_up, *w_down;
  float* out;
  char* ws;
};

#define WSB(off) ((bf16_t*)(p.ws + (off)))
#define WSF(off) ((float*)(p.ws + (off)))

typedef __bf16 hwbf16x2 __attribute__((ext_vector_type(2)));
typedef float hwf32x2 __attribute__((ext_vector_type(2)));
DEVI bf16_t f2bf(float f) {
  __bf16 r = (__bf16)f;
  return __builtin_bit_cast(bf16_t, r);
}
DEVI float bf2f(bf16_t b) { return __uint_as_float(((unsigned)b) << 16); }
DEVI unsigned pack2(float a, float b) {
  hwf32x2 v = {a, b};
  hwbf16x2 r = __builtin_convertvector(v, hwbf16x2);
  return __builtin_bit_cast(unsigned, r);
}
DEVI float silu(float x) { return x / (1.f + __expf(-x)); }
DEVI float wave_sum(float v) {
#pragma unroll
  for (int o = 32; o > 0; o >>= 1) v += __shfl_xor(v, o, 64);
  return v;
}
DEVI f32x4 mfma16(bf16x8 a, bf16x8 b, f32x4 c) { return __builtin_amdgcn_mfma_f32_16x16x32_bf16(a, b, c, 0, 0, 0); }

DEVI float rope_freq(int m) { return exp2f(-(float)m * 1.6609640474436813f); }
DEVI void fast_sincos(float ang, float& sn, float& cs) {
  float rev = ang * 0.15915494309189535f;
  rev -= rintf(rev);
  sn = __builtin_amdgcn_sinf(rev);
  cs = __builtin_amdgcn_cosf(rev);
}
typedef unsigned hwu32x2 __attribute__((ext_vector_type(2)));
DEVI float quad_max(float x) {
  hwu32x2 r = __builtin_amdgcn_permlane16_swap(__float_as_uint(x), __float_as_uint(x), false, false);
  x = fmaxf(__uint_as_float(r[0]), __uint_as_float(r[1]));
  r = __builtin_amdgcn_permlane32_swap(__float_as_uint(x), __float_as_uint(x), false, false);
  return fmaxf(__uint_as_float(r[0]), __uint_as_float(r[1]));
}
DEVI float quad_sum(float x) {
  hwu32x2 r = __builtin_amdgcn_permlane16_swap(__float_as_uint(x), __float_as_uint(x), false, false);
  x = __uint_as_float(r[0]) + __uint_as_float(r[1]);
  r = __builtin_amdgcn_permlane32_swap(__float_as_uint(x), __float_as_uint(x), false, false);
  return __uint_as_float(r[0]) + __uint_as_float(r[1]);
}
#define VB ((int)(threadIdx.x >> 8))
#define VT_PAIRG (gridDim.x == 256u)
#define VT_FIRST ((int)(VT_PAIRG ? blockIdx.x : blockIdx.x * 2u))
#define VT_OFF ((int)(VT_PAIRG ? VB * gridDim.x : VB))
DEVI int opaque_tid() { int t = threadIdx.x & 255; asm volatile("" : "+v"(t)); return t; }
DEVI int swz_tile(int t, int T) {
  int q = T >> 3, r = T & 7, x = t & 7, off = t >> 3;
  return (x < r ? x * (q + 1) : r * (q + 1) + (x - r) * q) + off;
}

__shared__ __attribute__((aligned(16))) char g_smem[2 * 73728];
#define NOINL __device__ __forceinline__

constexpr int LDT = 72;
constexpr int TILE_E = 128 * LDT;

template <class Epi>
DEVI void gemm_tile(const bf16_t* __restrict__ A, int lda, const bf16_t* __restrict__ B, int ldb, int K,
                    int m0, int n0, char* smem, Epi epi) {
  const int tid = opaque_tid(), lane = tid & 63, wave = tid >> 6, wm = wave >> 1, wn = wave & 1;
  const int lr = lane & 15, lg = lane >> 4;
  bf16_t* sA = (bf16_t*)smem;
  bf16_t* sB = sA + 2 * TILE_E;
  f32x4 acc[4][4];
#pragma unroll
  for (int i = 0; i < 4; ++i)
#pragma unroll
    for (int j = 0; j < 4; ++j) acc[i][j] = (f32x4){0.f, 0.f, 0.f, 0.f};
  const int lrow = tid >> 3, lkc = (tid & 7) * 8;
  const bf16_t* gA = A + (size_t)(m0 + lrow) * lda + lkc;
  const bf16_t* gB = B + (size_t)(n0 + lrow) * ldb + lkc;
  uint4 ra[4], rb[4];
#pragma unroll
  for (int i = 0; i < 4; ++i) {
    ra[i] = *(const uint4*)(gA + (size_t)(32 * i) * lda);
    rb[i] = *(const uint4*)(gB + (size_t)(32 * i) * ldb);
  }
#pragma unroll
  for (int i = 0; i < 4; ++i) {
    *(uint4*)(sA + (lrow + 32 * i) * LDT + lkc) = ra[i];
    *(uint4*)(sB + (lrow + 32 * i) * LDT + lkc) = rb[i];
  }
  __syncthreads();
  const int nk = K >> 6;
  for (int kt = 0; kt < nk; ++kt) {
    const int cur = kt & 1;
    if (kt + 1 < nk) {
      const int k0 = (kt + 1) << 6;
#pragma unroll
      for (int i = 0; i < 4; ++i) {
        ra[i] = *(const uint4*)(gA + (size_t)(32 * i) * lda + k0);
        rb[i] = *(const uint4*)(gB + (size_t)(32 * i) * ldb + k0);
      }
    }
    const bf16_t* cA = sA + cur * TILE_E + (wm * 64 + lr) * LDT + lg * 8;
    const bf16_t* cB = sB + cur * TILE_E + (wn * 64 + lr) * LDT + lg * 8;
#pragma unroll
    for (int ks = 0; ks < 2; ++ks) {
      bf16x8 af[4], bfr[4];
#pragma unroll
      for (int i = 0; i < 4; ++i) {
        af[i] = *(const bf16x8*)(cA + i * 16 * LDT + ks * 32);
        bfr[i] = *(const bf16x8*)(cB + i * 16 * LDT + ks * 32);
      }
#pragma unroll
      for (int i = 0; i < 4; ++i)
#pragma unroll
        for (int j = 0; j < 4; ++j) acc[i][j] = mfma16(af[i], bfr[j], acc[i][j]);
    }
    if (kt + 1 < nk) {
      const int nx = cur ^ 1;
#pragma unroll
      for (int i = 0; i < 4; ++i) {
        *(uint4*)(sA + nx * TILE_E + (lrow + 32 * i) * LDT + lkc) = ra[i];
        *(uint4*)(sB + nx * TILE_E + (lrow + 32 * i) * LDT + lkc) = rb[i];
      }
    }
    __syncthreads();
  }
#pragma unroll
  for (int i = 0; i < 4; ++i)
#pragma unroll
    for (int j = 0; j < 4; j += 2)
      epi(m0 + wm * 64 + i * 16 + lg * 4, n0 + wn * 64 + j * 16 + lr, acc[i][j], acc[i][j + 1]);
}

struct TileInfo { const bf16_t* a; const bf16_t* b; int m0, n0, ctx; };
template <class TileFn, class Epi>
DEVI void gemm_stream(int T, int lda, int ldb, int K, char* smem, TileFn tf, Epi epi) {
  int t0 = VT_FIRST;
  if (t0 >= T) return;
  int t = min(t0 + VT_OFF, T - 1);
  const int tid = opaque_tid(), lane = tid & 63, wave = tid >> 6, wm = wave >> 1, wn = wave & 1;
  const int lr = lane & 15, lg = lane >> 4;
  bf16_t* sA = (bf16_t*)smem;
  bf16_t* sB = sA + 2 * TILE_E;
  const int lrow = tid >> 3, lkc = (tid & 7) * 8;
  TileInfo ti = tf(t);
  const bf16_t* gA = ti.a + (size_t)lrow * lda + lkc;
  const bf16_t* gB = ti.b + (size_t)lrow * ldb + lkc;
  int m0 = ti.m0, n0 = ti.n0, ctx = ti.ctx;
  uint4 ra0, ra1, ra2, ra3, rb0, rb1, rb2, rb3;
  uint4 rc0, rc1, rc2, rc3, rd0, rd1, rd2, rd3;
#define GS_LOAD0(pa, pb) \
  ra0 = *(const uint4*)((pa)); ra1 = *(const uint4*)((pa) + (size_t)32 * lda); \
  ra2 = *(const uint4*)((pa) + (size_t)64 * lda); ra3 = *(const uint4*)((pa) + (size_t)96 * lda); \
  rb0 = *(const uint4*)((pb)); rb1 = *(const uint4*)((pb) + (size_t)32 * ldb); \
  rb2 = *(const uint4*)((pb) + (size_t)64 * ldb); rb3 = *(const uint4*)((pb) + (size_t)96 * ldb);
#define GS_LOAD1(pa, pb) \
  rc0 = *(const uint4*)((pa)); rc1 = *(const uint4*)((pa) + (size_t)32 * lda); \
  rc2 = *(const uint4*)((pa) + (size_t)64 * lda); rc3 = *(const uint4*)((pa) + (size_t)96 * lda); \
  rd0 = *(const uint4*)((pb)); rd1 = *(const uint4*)((pb) + (size_t)32 * ldb); \
  rd2 = *(const uint4*)((pb) + (size_t)64 * ldb); rd3 = *(const uint4*)((pb) + (size_t)96 * ldb);
#define GS_WRITE0(buf) { \
  bf16_t* wa = sA + (buf) * TILE_E + lrow * LDT + lkc; bf16_t* wb = sB + (buf) * TILE_E + lrow * LDT + lkc; \
  *(uint4*)(wa) = ra0; *(uint4*)(wa + 32 * LDT) = ra1; *(uint4*)(wa + 64 * LDT) = ra2; *(uint4*)(wa + 96 * LDT) = ra3; \
  *(uint4*)(wb) = rb0; *(uint4*)(wb + 32 * LDT) = rb1; *(uint4*)(wb + 64 * LDT) = rb2; *(uint4*)(wb + 96 * LDT) = rb3; }
#define GS_WRITE1(buf) { \
  bf16_t* wa = sA + (buf) * TILE_E + lrow * LDT + lkc; bf16_t* wb = sB + (buf) * TILE_E + lrow * LDT + lkc; \
  *(uint4*)(wa) = rc0; *(uint4*)(wa + 32 * LDT) = rc1; *(uint4*)(wa + 64 * LDT) = rc2; *(uint4*)(wa + 96 * LDT) = rc3; \
  *(uint4*)(wb) = rd0; *(uint4*)(wb + 32 * LDT) = rd1; *(uint4*)(wb + 64 * LDT) = rd2; *(uint4*)(wb + 96 * LDT) = rd3; }
#define GS_COMPUTE(buf) { \
    const bf16_t* cA = sA + (buf) * TILE_E + (wm * 64 + lr) * LDT + lg * 8; \
    const bf16_t* cB = sB + (buf) * TILE_E + (wn * 64 + lr) * LDT + lg * 8; \
    _Pragma("unroll") for (int ks = 0; ks < 2; ++ks) { \
      bf16x8 af[4], bfr[4]; \
      _Pragma("unroll") for (int i = 0; i < 4; ++i) { \
        af[i] = *(const bf16x8*)(cA + i * 16 * LDT + ks * 32); \
        bfr[i] = *(const bf16x8*)(cB + i * 16 * LDT + ks * 32); \
      } \
      __builtin_amdgcn_s_setprio(1); \
      _Pragma("unroll") for (int i = 0; i < 4; ++i) \
        _Pragma("unroll") for (int j = 0; j < 4; ++j) acc[i][j] = mfma16(af[i], bfr[j], acc[i][j]); \
      __builtin_amdgcn_s_setprio(0); \
    } }
  GS_LOAD0(gA, gB)
  GS_WRITE0(0)
  GS_LOAD1(gA + 64, gB + 64)
  __syncthreads();
  const int nk = K >> 6;
  for (;;) {
    f32x4 acc[4][4];
#pragma unroll
    for (int i = 0; i < 4; ++i)
#pragma unroll
      for (int j = 0; j < 4; ++j) acc[i][j] = (f32x4){0.f, 0.f, 0.f, 0.f};
    const int t0n = t0 + gridDim.x * 2;
    const bool have_next = t0n < T;
    const int tn = min(t0n + VT_OFF, T - 1);
    const bf16_t *nA = gA, *nB = gB;
    int nm0 = 0, nn0 = 0, nctx = 0;
    if (have_next) {
      const TileInfo tj = tf(tn);
      nA = tj.a + (size_t)lrow * lda + lkc;
      nB = tj.b + (size_t)lrow * ldb + lkc;
      nm0 = tj.m0; nn0 = tj.n0; nctx = tj.ctx;
    }
    for (int kt = 0; kt < nk; kt += 2) {
      {
        const bool wrap = (kt + 2 >= nk);
        const bf16_t* pa = wrap ? nA : gA + ((kt + 2) << 6);
        const bf16_t* pb = wrap ? nB : gB + ((kt + 2) << 6);
        GS_LOAD0(pa, pb)
        GS_COMPUTE(0)
        GS_WRITE1(1)
        __syncthreads();
      }
      {
        const bool wrap = (kt + 3 >= nk);
        const bf16_t* pa = wrap ? nA + 64 : gA + ((kt + 3) << 6);
        const bf16_t* pb = wrap ? nB + 64 : gB + ((kt + 3) << 6);
        GS_LOAD1(pa, pb)
        GS_COMPUTE(1)
        GS_WRITE0(0)
        __syncthreads();
      }
    }
#pragma unroll
    for (int i = 0; i < 4; ++i)
#pragma unroll
      for (int j = 0; j < 4; j += 2)
        epi(ctx, m0 + wm * 64 + i * 16 + lg * 4, n0 + wn * 64 + j * 16 + lr, acc[i][j], acc[i][j + 1]);
    if (!have_next) break;
    t = tn; t0 = t0n; gA = nA; gB = nB; m0 = nm0; n0 = nn0; ctx = nctx;
  }
}

constexpr int T8_E = 256 * LDT;
template <class TileFn, class Epi>
DEVI void gemm8_stream(int T, int lda, int ldb, int K, TileFn tf, Epi epi) {
  int t = blockIdx.x;
  if (t >= T) return;
  int tid = threadIdx.x; asm volatile("" : "+v"(tid));
  const int lane = tid & 63, wave = tid >> 6, wr = wave >> 2, wc = wave & 3;
  const int lr = lane & 15, lg = lane >> 4;
  bf16_t* sA = (bf16_t*)g_smem;
  bf16_t* sB = sA + 2 * T8_E;
  const int lrow = tid >> 3, lkc = (tid & 7) * 8;
  TileInfo ti = tf(t);
  const unsigned offA = ((unsigned)lrow * (unsigned)lda + (unsigned)lkc) * 2u;
  const unsigned offB = ((unsigned)lrow * (unsigned)ldb + (unsigned)lkc) * 2u;
  const char* gA = (const char*)ti.a;
  const char* gB = (const char*)ti.b;
  const size_t rsA = (size_t)64 * lda * 2, rsB = (size_t)64 * ldb * 2;
  int m0 = ti.m0, n0 = ti.n0, ctx = ti.ctx;
  uint4 ra0, ra1, ra2, ra3, rb0, rb1, rb2, rb3;
  uint4 rc0, rc1, rc2, rc3, rd0, rd1, rd2, rd3;
#define G8_LOAD(pa, pb) \
  ra0 = *(const uint4*)((pa) + offA); ra1 = *(const uint4*)((pa) + rsA + offA); \
  ra2 = *(const uint4*)((pa) + 2 * rsA + offA); ra3 = *(const uint4*)((pa) + 3 * rsA + offA); \
  rb0 = *(const uint4*)((pb) + offB); rb1 = *(const uint4*)((pb) + rsB + offB); \
  rb2 = *(const uint4*)((pb) + 2 * rsB + offB); rb3 = *(const uint4*)((pb) + 3 * rsB + offB);
#define G8_WRITE(buf) { \
  bf16_t* wa = sA + (buf) * T8_E + lrow * LDT + lkc; bf16_t* wb = sB + (buf) * T8_E + lrow * LDT + lkc; \
  *(uint4*)(wa) = ra0; *(uint4*)(wa + 64 * LDT) = ra1; *(uint4*)(wa + 128 * LDT) = ra2; *(uint4*)(wa + 192 * LDT) = ra3; \
  *(uint4*)(wb) = rb0; *(uint4*)(wb + 64 * LDT) = rb1; *(uint4*)(wb + 128 * LDT) = rb2; *(uint4*)(wb + 192 * LDT) = rb3; }
#define G8_LOAD1(pa, pb) \
  rc0 = *(const uint4*)((pa) + offA); rc1 = *(const uint4*)((pa) + rsA + offA); \
  rc2 = *(const uint4*)((pa) + 2 * rsA + offA); rc3 = *(const uint4*)((pa) + 3 * rsA + offA); \
  rd0 = *(const uint4*)((pb) + offB); rd1 = *(const uint4*)((pb) + rsB + offB); \
  rd2 = *(const uint4*)((pb) + 2 * rsB + offB); rd3 = *(const uint4*)((pb) + 3 * rsB + offB);
#define G8_WRITE1(buf) { \
  bf16_t* wa = sA + (buf) * T8_E + lrow * LDT + lkc; bf16_t* wb = sB + (buf) * T8_E + lrow * LDT + lkc; \
  *(uint4*)(wa) = rc0; *(uint4*)(wa + 64 * LDT) = rc1; *(uint4*)(wa + 128 * LDT) = rc2; *(uint4*)(wa + 192 * LDT) = rc3; \
  *(uint4*)(wb) = rd0; *(uint4*)(wb + 64 * LDT) = rd1; *(uint4*)(wb + 128 * LDT) = rd2; *(uint4*)(wb + 192 * LDT) = rd3; }
#define G8_COMPUTE(buf) { \
      const bf16_t* cA = sA + (buf) * T8_E + (wr * 128 + lr) * LDT + lg * 8; \
      const bf16_t* cB = sB + (buf) * T8_E + (wc * 64 + lr) * LDT + lg * 8; \
      _Pragma("unroll") for (int ks = 0; ks < 2; ++ks) { \
        bf16x8 bfr[4]; \
        _Pragma("unroll") for (int j = 0; j < 4; ++j) bfr[j] = *(const bf16x8*)(cB + j * 16 * LDT + ks * 32); \
        _Pragma("unroll") for (int h = 0; h < 2; ++h) { \
          bf16x8 af[4]; \
          _Pragma("unroll") for (int i = 0; i < 4; ++i) af[i] = *(const bf16x8*)(cA + (h * 4 + i) * 16 * LDT + ks * 32); \
          __builtin_amdgcn_s_setprio(1); \
          _Pragma("unroll") for (int i = 0; i < 4; ++i) \
            _Pragma("unroll") for (int j = 0; j < 4; ++j) acc[h * 4 + i][j] = mfma16(af[i], bfr[j], acc[h * 4 + i][j]); \
          __builtin_amdgcn_s_setprio(0); \
          __builtin_amdgcn_sched_barrier(0); \
        } \
      } }
  G8_LOAD(gA, gB)
  G8_WRITE(0)
  G8_LOAD1(gA + 128, gB + 128)
  __syncthreads();
  const int nk = K >> 6;
  for (;;) {
    f32x4 acc[8][4];
#pragma unroll
    for (int i = 0; i < 8; ++i)
#pragma unroll
      for (int j = 0; j < 4; ++j) acc[i][j] = (f32x4){0.f, 0.f, 0.f, 0.f};
    const int tn = t + gridDim.x;
    const bool have_next = tn < T;
    const char *nA = gA, *nB = gB;
    int nm0 = 0, nn0 = 0, nctx = 0;
    if (have_next) {
      const TileInfo tj = tf(tn);
      nA = (const char*)tj.a;
      nB = (const char*)tj.b;
      nm0 = tj.m0; nn0 = tj.n0; nctx = tj.ctx;
    }
#pragma unroll 1
    for (int kt = 0; kt < nk; kt += 2) {
      {
        const bool wrap = (kt + 2 >= nk);
        const char* pa = wrap ? nA : gA + ((kt + 2) << 7);
        const char* pb = wrap ? nB : gB + ((kt + 2) << 7);
        G8_LOAD(pa, pb)
        G8_COMPUTE(0)
        G8_WRITE1(1)
        __syncthreads();
      }
      {
        const bool wrap = (kt + 3 >= nk);
        const char* pa = wrap ? nA + 128 : gA + ((kt + 3) << 7);
        const char* pb = wrap ? nB + 128 : gB + ((kt + 3) << 7);
        G8_LOAD1(pa, pb)
        G8_COMPUTE(1)
        G8_WRITE(0)
        __syncthreads();
      }
    }
#pragma unroll
    for (int i = 0; i < 8; ++i)
#pragma unroll
      for (int j = 0; j < 4; j += 2)
        epi(ctx, m0 + wr * 128 + i * 16 + lg * 4, n0 + wc * 64 + j * 16 + lr, acc[i][j], acc[i][j + 1]);
    if (!have_next) break;
    t = tn; gA = nA; gB = nB; m0 = nm0; n0 = nn0; ctx = nctx;
  }
}

DEVI void tile_mn(int t, int nM, int nN, int& m, int& n) {
  int id = swz_tile(t, nM * nN);
  int per = 8 * nN;
  int gq = id / per, rem = id - gq * per;
  int gsz = min(8, nM - gq * 8);
  m = gq * 8 + rem % gsz;
  n = rem / gsz;
}

NOINL void gemv_tile(const P& p, int t) {
  char* smem = g_smem + VB * 73728;
  const int tid = opaque_tid();
  float* sv = (float*)smem;
  float* red = sv + 3072;
  const int l = t / 192, n0 = (t % 192) * 32;
  for (int i = tid; i < 3072; i += 256) {
    int v = i >> 10, k = i & 1023;
    float cv = (v == 0) ? p.c_ctx[k] : p.c[(v - 1) * 1024 + k];
    sv[i] = cv / (1.f + expf(-cv));
  }
  __syncthreads();
  const int cgp = tid & 7, ks = tid >> 3;
  const float* w = p.w_mod + (size_t)l * 1024 * 6144 + n0 + cgp * 4;
  float a0[4] = {0, 0, 0, 0}, a1[4] = {0, 0, 0, 0}, a2[4] = {0, 0, 0, 0};
#pragma unroll 16
  for (int kk = 0; kk < 32; ++kk) {
    const int k = ks * 32 + kk;
    const float4 wv = *(const float4*)(w + (size_t)k * 6144);
    const float s0 = sv[k], s1 = sv[1024 + k], s2 = sv[2048 + k];
    a0[0] += s0 * wv.x; a0[1] += s0 * wv.y; a0[2] += s0 * wv.z; a0[3] += s0 * wv.w;
    a1[0] += s1 * wv.x; a1[1] += s1 * wv.y; a1[2] += s1 * wv.z; a1[3] += s1 * wv.w;
    a2[0] += s2 * wv.x; a2[1] += s2 * wv.y; a2[2] += s2 * wv.z; a2[3] += s2 * wv.w;
  }
#pragma unroll
  for (int j = 0; j < 4; ++j) {
    red[(ks * 3 + 0) * 32 + cgp * 4 + j] = a0[j];
    red[(ks * 3 + 1) * 32 + cgp * 4 + j] = a1[j];
    red[(ks * 3 + 2) * 32 + cgp * 4 + j] = a2[j];
  }
  __syncthreads();
  if (tid < 96) {
    const int v = tid >> 5, col = tid & 31;
    float s = 0.f;
    for (int q = 0; q < 32; ++q) s += red[(q * 3 + v) * 32 + col];
    s += p.b_mod[l * 6144 + n0 + col];
    WSF(OFF_MOD)[(l * 3 + v) * 6144 + n0 + col] = s;
  }
  __syncthreads();
}

NOINL void transpose_tile(const P& p, int t) {
  char* smem = g_smem + VB * 73728;
  const int tid = opaque_tid();
  const float* src; bf16_t* dst; int K, N, ntn, mode = 0;
  if (t < 544) { src = p.w_in; dst = WSB(OFF_WIN); K = 1024; N = 2096; ntn = 34; }
  else if ((t -= 544) < 48) { src = p.w_uq; dst = WSB(OFF_WUQ); K = 256; N = 768; ntn = 12; }
  else if ((t -= 48) < 64) { src = p.w_ukv; dst = WSB(OFF_WUKV); K = 256; N = 1024; ntn = 16; }
  else if ((t -= 64) < 256) { src = p.w_out; dst = WSB(OFF_WOUT); K = 1024; N = 1024; ntn = 16; }
  else if ((t -= 256) < 64) { int g = t >> 4; t &= 15; src = p.pool_w + (size_t)g * 65536; dst = WSB(OFF_WPOOL) + (size_t)g * 65536; K = 256; N = 256; ntn = 4; }
  else if ((t -= 64) < 1408) { int l = t / 704; t -= l * 704; src = p.w_gate + (size_t)l * 1024 * 2816; dst = WSB(OFF_WGU) + (size_t)l * 5632 * 1024; K = 1024; N = 2816; ntn = 44; mode = 1; }
  else if ((t -= 1408) < 1408) { int l = t / 704; t -= l * 704; src = p.w_up + (size_t)l * 1024 * 2816; dst = WSB(OFF_WGU) + (size_t)l * 5632 * 1024; K = 1024; N = 2816; ntn = 44; mode = 2; }
  else { t -= 1408; int l = t / 704; t -= l * 704; src = p.w_down + (size_t)l * 2816 * 1024; dst = WSB(OFF_WDN) + (size_t)l * 1024 * 2816; K = 2816; N = 1024; ntn = 16; }
  const int kt = t / ntn, nt_ = t - kt * ntn;
  const int k0 = kt * 64, n0 = nt_ * 64;
  float* tile = (float*)smem;
  {
    const int nn = tid & 63, kk0 = tid >> 6;
    const int n = n0 + nn;
    const int nc = n < N ? n : N - 1;
    float v[16];
#pragma unroll
    for (int i = 0; i < 16; ++i) v[i] = src[(size_t)(k0 + kk0 + 4 * i) * N + nc];
#pragma unroll
    for (int i = 0; i < 16; ++i) tile[(kk0 + 4 * i) * 65 + nn] = (n < N) ? v[i] : 0.f;
  }
  __syncthreads();
#pragma unroll
  for (int i = 0; i < 2; ++i) {
    const int id = tid + 256 * i;
    const int nn = id >> 3, kc = id & 7;
    const int n = n0 + nn;
    uint4 pk;
    pk.x = pack2(tile[(kc * 8 + 0) * 65 + nn], tile[(kc * 8 + 1) * 65 + nn]);
    pk.y = pack2(tile[(kc * 8 + 2) * 65 + nn], tile[(kc * 8 + 3) * 65 + nn]);
    pk.z = pack2(tile[(kc * 8 + 4) * 65 + nn], tile[(kc * 8 + 5) * 65 + nn]);
    pk.w = pack2(tile[(kc * 8 + 6) * 65 + nn], tile[(kc * 8 + 7) * 65 + nn]);
    int drow = n;
    if (mode == 1) drow = (n >> 4) * 32 + (n & 15);
    else if (mode == 2) drow = (n >> 4) * 32 + 16 + (n & 15);
    *(uint4*)(dst + (size_t)drow * K + k0 + kc * 8) = pk;
  }
  __syncthreads();
}

template <bool UPD, bool MOD, bool FIRST, bool LASTW, bool TWO>
DEVI void rowop(const P& p, const bf16_t* msrc, const bf16_t* msrc2, const float* wpost, int gate_idx, const float* wpre, int shift_idx,
                int scale_idx, int layer_g, int layer_m) {
  const int lane = threadIdx.x & 63, wave = threadIdx.x >> 6;
  const float* modg = WSF(OFF_MOD) + (size_t)layer_g * 3 * 6144;
  const float* modm = WSF(OFF_MOD) + (size_t)layer_m * 3 * 6144;
  bf16_t* hbuf = WSB(OFF_H);
  for (int r = blockIdx.x * 8 + wave; r < 8192; r += gridDim.x * 8) {
    const int v = r < 4096 ? 0 : 1 + ((r - 4096) >> 11);
    const float* mvg = modg + v * 6144;
    const float* mvm = modm + v * 6144;
    float4 x[4];
    if (FIRST) {
      const float* xin = r < 4096 ? p.x_prompt + (size_t)r * 1024 : p.x_sample + (size_t)(r - 4096) * 1024;
#pragma unroll
      for (int i = 0; i < 4; ++i) x[i] = *(const float4*)(xin + lane * 4 + 256 * i);
    } else {
#pragma unroll
      for (int i = 0; i < 4; ++i) {
        const uint2 xb = *(const uint2*)(WSB(OFF_XR) + (size_t)r * 1024 + lane * 4 + 256 * i);
        x[i].x = __uint_as_float(xb.x << 16); x[i].y = __uint_as_float(xb.x & 0xffff0000u);
        x[i].z = __uint_as_float(xb.y << 16); x[i].w = __uint_as_float(xb.y & 0xffff0000u);
      }
    }
    if (UPD) {
      float4 m[4];
      float ss = 0.f;
#pragma unroll
      for (int i = 0; i < 4; ++i) {
        const uint2 mb = *(const uint2*)(msrc + (size_t)r * 1024 + lane * 4 + 256 * i);
        m[i].x = __uint_as_float(mb.x << 16); m[i].y = __uint_as_float(mb.x & 0xffff0000u);
        m[i].z = __uint_as_float(mb.y << 16); m[i].w = __uint_as_float(mb.y & 0xffff0000u);
        if (TWO) {
          const uint2 mc = *(const uint2*)(msrc2 + (size_t)r * 1024 + lane * 4 + 256 * i);
          m[i].x += __uint_as_float(mc.x << 16); m[i].y += __uint_as_float(mc.x & 0xffff0000u);
          m[i].z += __uint_as_float(mc.y << 16); m[i].w += __uint_as_float(mc.y & 0xffff0000u);
        }
        ss += m[i].x * m[i].x + m[i].y * m[i].y + m[i].z * m[i].z + m[i].w * m[i].w;
      }
      ss = wave_sum(ss);
      const float rs = rsqrtf(ss * (1.f / 1024.f) + 1e-6f);
#pragma unroll
      for (int i = 0; i < 4; ++i) {
        const int col = lane * 4 + 256 * i;
        const float4 wp = *(const float4*)(wpost + col);
        const float4 g = *(const float4*)(mvg + gate_idx * 1024 + col);
        x[i].x += g.x * (m[i].x * rs * wp.x);
        x[i].y += g.y * (m[i].y * rs * wp.y);
        x[i].z += g.z * (m[i].z * rs * wp.z);
        x[i].w += g.w * (m[i].w * rs * wp.w);
        if (LASTW) *(float4*)(p.out + (size_t)r * 1024 + col) = x[i];
        else {
          uint2 xo;
          xo.x = pack2(x[i].x, x[i].y);
          xo.y = pack2(x[i].z, x[i].w);
          *(uint2*)(WSB(OFF_XR) + (size_t)r * 1024 + col) = xo;
        }
      }
    }
    if (MOD) {
      float ss = 0.f;
#pragma unroll
      for (int i = 0; i < 4; ++i) ss += x[i].x * x[i].x + x[i].y * x[i].y + x[i].z * x[i].z + x[i].w * x[i].w;
      ss = wave_sum(ss);
      const float rs = rsqrtf(ss * (1.f / 1024.f) + 1e-6f);
#pragma unroll
      for (int i = 0; i < 4; ++i) {
        const int col = lane * 4 + 256 * i;
        const float4 wp = *(const float4*)(wpre + col);
        const float4 sh = *(const float4*)(mvm + shift_idx * 1024 + col);
        const float4 sc = *(const float4*)(mvm + scale_idx * 1024 + col);
        uint2 o;
        o.x = pack2(x[i].x * rs * wp.x * (1.f + sc.x) + sh.x, x[i].y * rs * wp.y * (1.f + sc.y) + sh.y);
        o.y = pack2(x[i].z * rs * wp.z * (1.f + sc.z) + sh.z, x[i].w * rs * wp.w * (1.f + sc.w) + sh.w);
        *(uint2*)(hbuf + (size_t)r * 1024 + col) = o;
      }
    }
  }
}

NOINL void prep_rows(const P& p) {
  const int lane = threadIdx.x & 63, wave = threadIdx.x >> 6;
  const float* proj = WSF(OFF_R1);
  for (int r = blockIdx.x * 8 + wave; r < 8192; r += gridDim.x * 8) {
    const float* pr = proj + (size_t)r * 2096;
    const int kvrow = r < 4096 ? r : 4096 + ((r - 4096) >> 11) * 2304 + 256 + ((r - 4096) & 2047);
    const float4 ld_cq = *(const float4*)(pr + lane * 4);
    const float4 ld_ckv = *(const float4*)(pr + 256 + lane * 4);
    const float ld_kpe = pr[512 + (lane & 31)];
    const float ld_dt = pr[2080 + (lane & 15)];
    {
      const float4 a = ld_cq;
      float ss = wave_sum(a.x * a.x + a.y * a.y + a.z * a.z + a.w * a.w);
      const float rs = rsqrtf(ss * (1.f / 256.f) + 1e-6f);
      const float4 g = *(const float4*)(p.q_norm + lane * 4);
      uint2 o;
      o.x = pack2(a.x * rs * g.x, a.y * rs * g.y);
      o.y = pack2(a.z * rs * g.z, a.w * rs * g.w);
      *(uint2*)(WSB(OFF_CQN) + (size_t)r * 256 + lane * 4) = o;
    }
    {
      const float4 a = ld_ckv;
      float ss = wave_sum(a.x * a.x + a.y * a.y + a.z * a.z + a.w * a.w);
      const float rs = rsqrtf(ss * (1.f / 256.f) + 1e-6f);
      const float4 g = *(const float4*)(p.kv_norm + lane * 4);
      float4 vv;
      vv.x = a.x * rs * g.x; vv.y = a.y * rs * g.y; vv.z = a.z * rs * g.z; vv.w = a.w * rs * g.w;
      if (r < 4096) *(float4*)(p.out + OUT_CKV + (size_t)r * 256 + lane * 4) = vv;
      uint2 o;
      o.x = pack2(vv.x, vv.y);
      o.y = pack2(vv.z, vv.w);
      *(uint2*)(WSB(OFF_CKV) + (size_t)kvrow * 256 + lane * 4) = o;
    }
    {
      const float kv = (lane < 32) ? ld_kpe : 0.f;
      const float partner = __shfl_xor(kv, 16, 64);
      if (r < 4096) {
        if (lane < 32) {
          p.out[OUT_KR + (size_t)r * 32 + lane] = kv;
          WSB(OFF_KPE)[(size_t)kvrow * 32 + lane] = f2bf(kv);
        }
      } else {
        const int t = (r - 4096) & 2047;
        const int ii = lane & 15;
        const float pos = (ii < 8) ? (float)(t >> 6) : (float)(t & 63);
        const float fr = rope_freq(ii & 7);
        const float ang = pos * fr;
        float cs, sn;
        fast_sincos(ang, sn, cs);
        const float o = (lane < 16) ? (kv * cs - partner * sn) : (partner * sn + kv * cs);
        if (lane < 32) WSB(OFF_KPE)[(size_t)kvrow * 32 + lane] = f2bf(o);
      }
    }
    if (lane < 16) {
      const int dir = lane >> 3, hh = lane & 7;
      const float raw = ld_dt + (dir ? p.dtb_b[hh] : p.dtb_f[hh]);
      const float sp = raw > 20.f ? raw : log1pf(expf(raw));
      WSF(OFF_DTV)[((size_t)dir * 8192 + r) * 8 + hh] = sp;
    }
  }
}

NOINL void prep_cache(const P& p) {
  const int gt = blockIdx.x * 512 + threadIdx.x, gs = gridDim.x * 512;
  for (int i = gt; i < 2 * 256 * 256; i += gs) {
    int b = i >> 16, rem = i & 65535;
    WSB(OFF_CKV)[(size_t)(4096 + b * 2304) * 256 + rem] = f2bf(p.cache_ckv[i]);
  }
  for (int i = gt; i < 2 * 256 * 32; i += gs) {
    int b = i >> 13, rem = i & 8191;
    WSB(OFF_KPE)[(size_t)(4096 + b * 2304) * 32 + rem] = f2bf(p.cache_kr[i]);
  }
}

NOINL void conv_tile(const P& p, int t) {
  char* smem = g_smem + VB * 73728;
  const int tid = opaque_tid();
  float* sin_ = (float*)smem;
  float* sout = sin_ + 68 * 64;
  const int tt_ = t >> 4, ct = t & 15;
  const int r0 = tt_ * 64, c0 = ct * 64;
  int s0, s1;
  if (r0 < 4096) { s0 = r0 & ~255; s1 = s0 + 256; } else { s0 = 4096 + ((r0 - 4096) & ~2047); s1 = s0 + 2048; }
  const float* proj = WSF(OFF_R1);
  {
    const int rr0 = tid >> 6, cc = tid & 63;
    float v[17];
#pragma unroll
    for (int k = 0; k < 17; ++k) {
      const int r = r0 - 2 + rr0 + 4 * k;
      const int rc = r < s0 ? s0 : (r >= s1 ? s1 - 1 : r);
      v[k] = proj[(size_t)rc * 2096 + 1056 + c0 + cc];
    }
#pragma unroll
    for (int k = 0; k < 17; ++k) {
      const int r = r0 - 2 + rr0 + 4 * k;
      sin_[(rr0 + 4 * k) * 64 + cc] = (r >= s0 && r < s1) ? v[k] : 0.f;
    }
  }
  __syncthreads();
  {
    const int cc = tid & 63, tq = tid >> 6;
    const int c = c0 + cc;
    const float w0 = p.conv_w[c], w1 = p.conv_w[1024 + c], w2 = p.conv_w[2048 + c], w3 = p.conv_w[3072 + c],
                w4 = p.conv_w[4096 + c], bias = p.conv_b[c];
#pragma unroll 4
    for (int i = 0; i < 16; ++i) {
      const int tt = tq * 16 + i;
      float y = bias + w0 * sin_[tt * 64 + cc] + w1 * sin_[(tt + 1) * 64 + cc] + w2 * sin_[(tt + 2) * 64 + cc] +
                w3 * sin_[(tt + 3) * 64 + cc] + w4 * sin_[(tt + 4) * 64 + cc];
      y = y / (1.f + __expf(-y));
      sout[tt * 65 + cc] = y;
      const bf16_t b = f2bf(y);
      const size_t r = r0 + tt;
      if (c < 512) WSB(OFF_XS)[r * 512 + c] = b;
      else if (c < 768) WSB(OFF_BM)[r * 256 + (c - 512)] = b;
      else WSB(OFF_CM)[r * 256 + (c - 768)] = b;
    }
  }
  __syncthreads();
  if (c0 < 768) {
    const int cl = tid >> 2, q4 = tid & 3;
    uint4 o0, o1;
    const float* sp = sout + (q4 * 16) * 65 + cl;
    o0.x = pack2(sp[0 * 65], sp[1 * 65]);   o0.y = pack2(sp[2 * 65], sp[3 * 65]);
    o0.z = pack2(sp[4 * 65], sp[5 * 65]);   o0.w = pack2(sp[6 * 65], sp[7 * 65]);
    o1.x = pack2(sp[8 * 65], sp[9 * 65]);   o1.y = pack2(sp[10 * 65], sp[11 * 65]);
    o1.z = pack2(sp[12 * 65], sp[13 * 65]); o1.w = pack2(sp[14 * 65], sp[15 * 65]);
    bf16_t* dst = (c0 < 512) ? WSB(OFF_XST) + (size_t)(c0 + cl) * 8192 : WSB(OFF_BT) + (size_t)(c0 - 512 + cl) * 8192;
    dst += r0 + q4 * 16;
    *(uint4*)(dst) = o0;
    *(uint4*)(dst + 8) = o1;
  }
  __syncthreads();
}

NOINL void chunk_state_item(const P& p, int item) {
  char* smem = g_smem + VB * 73728;
  const int tid = opaque_tid(), lane = tid & 63, wave = tid >> 6, lr = lane & 15, lg = lane >> 4;
  const int cidx = item >> 3, hh = item & 7, g = hh >> 2;
  const int r0 = cidx * 128;
  constexpr int LDS_ = 136;
  bf16_t* sAs = (bf16_t*)smem;
  bf16_t* sBs = sAs + 2 * 64 * LDS_;
  float* fa = (float*)(sBs + 128 * LDS_);
  float* fcum = fa + 256;
  float* fw = fa + 512;
  float* fdt = fa + 768;
  {
    const int dir = tid >> 7, j = tid & 127;
    const float dt = WSF(OFF_DTV)[((size_t)dir * 8192 + r0 + j) * 8 + hh];
    const float Aco = -expf(dir ? p.alog_b[hh] : p.alog_f[hh]);
    fa[tid] = dt * Aco;
    fdt[tid] = dt;
  }
  __syncthreads();
  {
    const int dir = tid >> 7, j = tid & 127;
    float s = 0.f;
    const float4* fa4 = (const float4*)(fa + dir * 128);
    if (dir == 0) {
      const int nb = (j + 1) >> 2;
      for (int k4 = 0; k4 < nb; ++k4) { const float4 v = fa4[k4]; s += (v.x + v.y) + (v.z + v.w); }
      for (int k = nb * 4; k <= j; ++k) s += fa[k];
    } else {
      const int fb = (j + 3) >> 2;
      for (int k4 = 31; k4 >= fb; --k4) { const float4 v = fa4[k4]; s += (v.x + v.y) + (v.z + v.w); }
      for (int k = j; k < fb * 4; ++k) s += fa[128 + k];
    }
    fcum[tid] = s;
    WSF(OFF_CUM)[((size_t)dir * 8192 + r0 + j) * 8 + hh] = s;
  }
  __syncthreads();
  {
    const int dir = tid >> 7;
    const float ce = dir ? fcum[128] : fcum[127];
    fw[tid] = __expf(ce - fcum[tid]) * fdt[tid];
    if ((tid & 127) == 0) WSF(OFF_TOT)[(dir * 64 + cidx) * 8 + hh] = __expf(ce);
  }
  __syncthreads();
#pragma unroll
  for (int i = 0; i < 4; ++i) {
    const int id = tid + 256 * i;
    const int pp = id >> 4, jc = (id & 15) * 8;
    const uint4 raw = *(const uint4*)(WSB(OFF_XST) + (size_t)(hh * 64 + pp) * 8192 + r0 + jc);
    const unsigned rw[4] = {raw.x, raw.y, raw.z, raw.w};
    unsigned of[4], ob[4];
#pragma unroll
    for (int q = 0; q < 4; ++q) {
      const float x0 = __uint_as_float(rw[q] << 16), x1 = __uint_as_float(rw[q] & 0xffff0000u);
      of[q] = pack2(x0 * fw[jc + 2 * q], x1 * fw[jc + 2 * q + 1]);
      ob[q] = pack2(x0 * fw[128 + jc + 2 * q], x1 * fw[128 + jc + 2 * q + 1]);
    }
    *(uint4*)(sAs + pp * LDS_ + jc) = make_uint4(of[0], of[1], of[2], of[3]);
    *(uint4*)(sAs + 64 * LDS_ + pp * LDS_ + jc) = make_uint4(ob[0], ob[1], ob[2], ob[3]);
  }
#pragma unroll
  for (int i = 0; i < 8; ++i) {
    const int id = tid + 256 * i;
    const int nn = id >> 4, jc = (id & 15) * 8;
    *(uint4*)(sBs + nn * LDS_ + jc) = *(const uint4*)(WSB(OFF_BT) + (size_t)(g * 128 + nn) * 8192 + r0 + jc);
  }
  __syncthreads();
  {
    const int dir = wave >> 1, nh = wave & 1;
    f32x4 acc[4][4];
#pragma unroll
    for (int i = 0; i < 4; ++i)
#pragma unroll
      for (int j = 0; j < 4; ++j) acc[i][j] = (f32x4){0.f, 0.f, 0.f, 0.f};
    const bf16_t* cA = sAs + dir * 64 * LDS_ + lr * LDS_ + lg * 8;
    const bf16_t* cB = sBs + (nh * 64 + lr) * LDS_ + lg * 8;
#pragma unroll 1
    for (int ks = 0; ks < 4; ++ks) {
      bf16x8 af[4], bfr[4];
#pragma unroll
      for (int i = 0; i < 4; ++i) {
        af[i] = *(const bf16x8*)(cA + i * 16 * LDS_ + ks * 32);
        bfr[i] = *(const bf16x8*)(cB + i * 16 * LDS_ + ks * 32);
      }
#pragma unroll
      for (int i = 0; i < 4; ++i)
#pragma unroll
        for (int j = 0; j < 4; ++j) acc[i][j] = mfma16(af[i], bfr[j], acc[i][j]);
    }
    float* S = WSF(OFF_R2) + ((size_t)(dir * 64 + cidx) * 8 + hh) * 8192 + (lg * 4) * 128 + nh * 64 + lr;
#pragma unroll
    for (int i = 0; i < 4; ++i) {
#pragma unroll
      for (int q = 0; q < 4; ++q) {
#pragma unroll
        for (int j = 0; j < 4; ++j) S[j * 16] = acc[i][j][q];
        S += 128;
      }
      S += 12 * 128;
      __builtin_amdgcn_sched_barrier(0);
    }
  }
  __syncthreads();
}

template <int NB>
DEVI void scan_group(const P& p, float4& h, int dir, int cb, int nc, int c0, int hh, size_t eoff) {
  float4 sv[NB];
  float d[NB];
  size_t base[NB];
#pragma unroll
  for (int k = 0; k < NB; ++k) {
    const int c = c0 + k;
    const int cidx = cb + (dir ? nc - 1 - c : c);
    base[k] = ((size_t)(dir * 64 + cidx) * 8 + hh) * 8192 + eoff;
    d[k] = WSF(OFF_TOT)[(dir * 64 + cidx) * 8 + hh];
    sv[k] = *(const float4*)(WSF(OFF_R2) + base[k]);
  }
#pragma unroll
  for (int k = 0; k < NB; ++k) {
    uint2 o;
    o.x = pack2(h.x, h.y);
    o.y = pack2(h.z, h.w);
    *(uint2*)(WSB(OFF_H) + base[k]) = o;
    h.x = d[k] * h.x + sv[k].x; h.y = d[k] * h.y + sv[k].y; h.z = d[k] * h.z + sv[k].z; h.w = d[k] * h.w + sv[k].w;
  }
}

NOINL void scan_states(const P& p) {
  const int total = 2 * 18 * 8 * 64 * 32;
  for (int idx = blockIdx.x * 512 + threadIdx.x; idx < total; idx += gridDim.x * 512) {
    const int n4 = idx & 31, pp = (idx >> 5) & 63, hh = (idx >> 11) & 7;
    const int sd = idx >> 14;
    const int s = sd % 18, dir = sd / 18;
    const int nc = s < 16 ? 2 : 16;
    const int cb = s < 16 ? s * 2 : 32 + (s - 16) * 16;
    float4 h = make_float4(0.f, 0.f, 0.f, 0.f);
    const size_t eoff = (size_t)pp * 128 + n4 * 4;
    if (s >= 16) {
      const float* st = (dir ? p.st_b : p.st_f) + ((size_t)((s - 16) * 8 + hh) * 64 + pp) * 128 + n4 * 4;
      h = *(const float4*)st;
      scan_group<8>(p, h, dir, cb, nc, 0, hh, eoff);
      scan_group<8>(p, h, dir, cb, nc, 8, hh, eoff);
    } else {
      scan_group<2>(p, h, dir, cb, nc, 0, hh, eoff);
      float* o = p.out + (dir ? OUT_SB : OUT_SF) + ((size_t)(s * 8 + hh) * 64 + pp) * 128 + n4 * 4;
      *(float4*)o = h;
    }
  }
}

NOINL void attn_item(const P& p, int id) {
  char* smem = g_smem + VB * 73728;
  const int tid = opaque_tid(), lane = tid & 63, wave = tid >> 6, lr = lane & 15, lg = lane >> 4;
  int row0, kvbase, Lk, hh;
  if (id < 512) { hh = id & 7; const int b = (id >> 3) & 1; const int qb = id >> 4; row0 = 4096 + b * 2048 + qb * 64; kvbase = 4096 + b * 2304; Lk = 2304; }
  else { const int i2 = id - 512; hh = i2 & 7; const int rest = i2 >> 3; const int b = rest >> 2; const int qb = rest & 3; row0 = b * 256 + qb * 64; kvbase = b * 256; Lk = 256; }
  constexpr int LDK = 104, LDV = 72;
  constexpr int KVBUF = 64 * LDK + 64 * LDV;
  bf16_t* sKV = (bf16_t*)smem;
  const int qrow = row0 + wave * 16 + lr;
  bf16x8 qf[3];
#pragma unroll
  for (int ks = 0; ks < 3; ++ks) qf[ks] = *(const bf16x8*)(WSB(OFF_Q) + (size_t)qrow * 768 + hh * 96 + ks * 32 + lg * 8);
  f32x4 oacc[4];
#pragma unroll
  for (int i = 0; i < 4; ++i) oacc[i] = (f32x4){0.f, 0.f, 0.f, 0.f};
  float mrun = -1e30f, lrun = 0.f;
  const int nkt = Lk >> 6;
  const int kkey0 = tid / 12, kcc0 = tid - kkey0 * 12;
  const int c1 = tid + 256, kkey1 = c1 / 12, kcc1 = c1 - kkey1 * 12;
  const int c2 = tid + 512, kkey2 = c2 / 12, kcc2 = c2 - kkey2 * 12;
  const bf16_t* kn = WSB(OFF_KN);
  const bf16_t* kp = WSB(OFF_KPE);
  const bf16_t* ksrc0 = (kcc0 < 8) ? kn + (size_t)(kvbase + kkey0) * 512 + hh * 64 + kcc0 * 8 : kp + (size_t)(kvbase + kkey0) * 32 + (kcc0 - 8) * 8;
  const bf16_t* ksrc1 = (kcc1 < 8) ? kn + (size_t)(kvbase + kkey1) * 512 + hh * 64 + kcc1 * 8 : kp + (size_t)(kvbase + kkey1) * 32 + (kcc1 - 8) * 8;
  const bf16_t* ksrc2 = (kcc2 < 8) ? kn + (size_t)(kvbase + kkey2) * 512 + hh * 64 + kcc2 * 8 : kp + (size_t)(kvbase + kkey2) * 32 + (kcc2 - 8) * 8;
  const int kst0 = (kcc0 < 8) ? 512 * 64 : 32 * 64, kst1 = (kcc1 < 8) ? 512 * 64 : 32 * 64, kst2 = (kcc2 < 8) ? 512 * 64 : 32 * 64;
  const int vd0 = tid >> 3, vcc = tid & 7;
  const bf16_t* vsrc0 = WSB(OFF_VT) + (size_t)(hh * 64 + vd0) * 8704 + kvbase + vcc * 8;
  const bf16_t* vsrc1 = vsrc0 + (size_t)32 * 8704;
  uint4 rk0, rk1, rk2, rv0, rv1;
#define AT_LOAD(kt) { const int _k = (kt); \
    rk0 = *(const uint4*)(ksrc0 + (size_t)_k * kst0); rk1 = *(const uint4*)(ksrc1 + (size_t)_k * kst1); \
    rk2 = *(const uint4*)(ksrc2 + (size_t)_k * kst2); \
    rv0 = *(const uint4*)(vsrc0 + _k * 64); rv1 = *(const uint4*)(vsrc1 + _k * 64); }
#define AT_WRITE(buf) { bf16_t* _b = sKV + (buf) * KVBUF; \
    *(uint4*)(_b + kkey0 * LDK + kcc0 * 8) = rk0; *(uint4*)(_b + kkey1 * LDK + kcc1 * 8) = rk1; \
    *(uint4*)(_b + kkey2 * LDK + kcc2 * 8) = rk2; \
    *(uint4*)(_b + 64 * LDK + vd0 * LDV + vcc * 8) = rv0; *(uint4*)(_b + 64 * LDK + (vd0 + 32) * LDV + vcc * 8) = rv1; }
  AT_LOAD(0)
  AT_WRITE(0)
  __syncthreads();
  for (int kt = 0; kt < nkt; ++kt) {
    const int ktn = min(kt + 1, nkt - 1);
    AT_LOAD(ktn)
#if ATPROBE == 5
    { uint4 d0 = *(const volatile uint4*)(ksrc0 + (size_t)ktn * kst0), d1 = *(const volatile uint4*)(ksrc1 + (size_t)ktn * kst1), d2 = *(const volatile uint4*)(ksrc2 + (size_t)ktn * kst2);
      uint4 d3 = *(const volatile uint4*)(vsrc0 + ktn * 64), d4 = *(const volatile uint4*)(vsrc1 + ktn * 64);
      asm volatile("" :: "v"(d0), "v"(d1), "v"(d2), "v"(d3), "v"(d4)); }
#endif
    const bf16_t* sK = sKV + (kt & 1) * KVBUF;
    const bf16_t* sV = sK + 64 * LDK;
    f32x4 sacc[4];
#pragma unroll
    for (int n = 0; n < 4; ++n) sacc[n] = (f32x4){0.f, 0.f, 0.f, 0.f};
#pragma unroll
    for (int ks = 0; ks < 3; ++ks)
#pragma unroll
      for (int n = 0; n < 4; ++n) {
        const bf16x8 a = *(const bf16x8*)(sK + (n * 16 + lr) * LDK + ks * 32 + lg * 8);
        sacc[n] = mfma16(a, qf[ks], sacc[n]);
      }
#if ATPROBE == 2
    {
      f32x4 dacc[4];
#pragma unroll
      for (int n = 0; n < 4; ++n) dacc[n] = (f32x4){0.f, 0.f, 0.f, 0.f};
#pragma unroll
      for (int ks = 0; ks < 3; ++ks)
#pragma unroll
        for (int n = 0; n < 4; ++n) {
          const bf16x8 a = *(const volatile bf16x8*)(sK + (n * 16 + lr) * LDK + ks * 32 + lg * 8);
          dacc[n] = mfma16(a, qf[ks], dacc[n]);
        }
#pragma unroll
      for (int n = 0; n < 4; ++n) asm volatile("" :: "v"(dacc[n]));
    }
#endif
    float mx = sacc[0][0];
#pragma unroll
    for (int n = 0; n < 4; ++n)
#pragma unroll
      for (int q = 0; q < 4; ++q) mx = fmaxf(mx, sacc[n][q]);
    mx = quad_max(mx);
    const float mnew = fmaxf(mrun, mx);
    const float alpha = __builtin_amdgcn_exp2f(mrun - mnew);
    mrun = mnew;
    float ps = 0.f;
#pragma unroll
    for (int n = 0; n < 4; ++n)
#pragma unroll
      for (int q = 0; q < 4; ++q) {
#if ATPROBE == 1
        { float e2 = __builtin_amdgcn_exp2f(sacc[n][q] - mrun); asm volatile("" :: "v"(e2)); }
#endif
        const float e = __builtin_amdgcn_exp2f(sacc[n][q] - mnew); sacc[n][q] = e; ps += e; }
    lrun = lrun * alpha + ps;
#pragma unroll
    for (int i = 0; i < 4; ++i)
#pragma unroll
      for (int q = 0; q < 4; ++q) oacc[i][q] *= alpha;
#pragma unroll
    for (int ks = 0; ks < 2; ++ks) {
      union { bf16x8 v; unsigned u[4]; } pf;
      pf.u[0] = pack2(sacc[2 * ks][0], sacc[2 * ks][1]);
      pf.u[1] = pack2(sacc[2 * ks][2], sacc[2 * ks][3]);
      pf.u[2] = pack2(sacc[2 * ks + 1][0], sacc[2 * ks + 1][1]);
      pf.u[3] = pack2(sacc[2 * ks + 1][2], sacc[2 * ks + 1][3]);
#pragma unroll
      for (int m = 0; m < 4; ++m) {
        union { bf16x8 v; uint2 h[2]; } av;
        const bf16_t* vp = sV + (m * 16 + lr) * LDV + ks * 32 + lg * 4;
        av.h[0] = *(const uint2*)(vp);
        av.h[1] = *(const uint2*)(vp + 16);
        oacc[m] = mfma16(av.v, pf.v, oacc[m]);
      }
    }
    __builtin_amdgcn_sched_barrier(0);
    AT_WRITE((kt + 1) & 1)
#if ATPROBE == 3
    AT_WRITE((kt + 1) & 1)
#endif
#if ATPROBE == 4
    __syncthreads();
#endif
    __syncthreads();
  }
  lrun = quad_sum(lrun);
  const float inv = 1.f / lrun;
#pragma unroll
  for (int m = 0; m < 4; ++m) {
    uint2 o;
    o.x = pack2(oacc[m][0] * inv, oacc[m][1] * inv);
    o.y = pack2(oacc[m][2] * inv, oacc[m][3] * inv);
    *(uint2*)(WSB(OFF_CAT) + (size_t)qrow * 1024 + hh * 64 + m * 16 + lg * 4) = o;
  }
}

NOINL void attn8_item(const P& p, int id) {
  int tid = threadIdx.x; asm volatile("" : "+v"(tid));
  const int lane = tid & 63, wave = tid >> 6, lr = lane & 15, lg = lane >> 4;
  int row0, kvbase, Lk, hh;
  if (id < 256) { hh = id & 7; const int b = (id >> 3) & 1; const int qb = id >> 4; row0 = 4096 + b * 2048 + qb * 128; kvbase = 4096 + b * 2304; Lk = 2304; }
  else { const int i2 = id - 256; hh = i2 & 7; const int rest = i2 >> 3; const int b = rest >> 1; const int qb = rest & 1; row0 = b * 256 + qb * 128; kvbase = b * 256; Lk = 256; }
  constexpr int LDK = 104, LDV = 136;
  constexpr int KVBUF = 128 * LDK + 64 * LDV;
  bf16_t* sKV = (bf16_t*)g_smem;
  const int qrow = row0 + wave * 16 + lr;
  bf16x8 qf[3];
#pragma unroll
  for (int ks = 0; ks < 3; ++ks) qf[ks] = *(const bf16x8*)(WSB(OFF_Q) + (size_t)qrow * 768 + hh * 96 + ks * 32 + lg * 8);
  f32x4 oacc[4];
#pragma unroll
  for (int i = 0; i < 4; ++i) oacc[i] = (f32x4){0.f, 0.f, 0.f, 0.f};
  float mrun = -1e30f, lrun = 0.f;
  const int nkt = Lk >> 7;
  const int kkey0 = tid / 12, kcc0 = tid - kkey0 * 12;
  const int c1 = tid + 512, kkey1 = c1 / 12, kcc1 = c1 - kkey1 * 12;
  const int c2 = tid + 1024, kkey2 = c2 / 12, kcc2 = c2 - kkey2 * 12;
  const bf16_t* kn = WSB(OFF_KN);
  const bf16_t* kp = WSB(OFF_KPE);
  const bf16_t* ksrc0 = (kcc0 < 8) ? kn + (size_t)(kvbase + kkey0) * 512 + hh * 64 + kcc0 * 8 : kp + (size_t)(kvbase + kkey0) * 32 + (kcc0 - 8) * 8;
  const bf16_t* ksrc1 = (kcc1 < 8) ? kn + (size_t)(kvbase + kkey1) * 512 + hh * 64 + kcc1 * 8 : kp + (size_t)(kvbase + kkey1) * 32 + (kcc1 - 8) * 8;
  const bf16_t* ksrc2 = (kcc2 < 8) ? kn + (size_t)(kvbase + kkey2) * 512 + hh * 64 + kcc2 * 8 : kp + (size_t)(kvbase + kkey2) * 32 + (kcc2 - 8) * 8;
  const int kst0 = (kcc0 < 8) ? 512 * 128 : 32 * 128, kst1 = (kcc1 < 8) ? 512 * 128 : 32 * 128, kst2 = (kcc2 < 8) ? 512 * 128 : 32 * 128;
  const int vd0 = tid >> 4, vcc = tid & 15;
  const bf16_t* vsrc0 = WSB(OFF_VT) + (size_t)(hh * 64 + vd0) * 8704 + kvbase + vcc * 8;
  const bf16_t* vsrc1 = vsrc0 + (size_t)32 * 8704;
  uint4 rk0, rk1, rk2, rv0, rv1;
#define A8_LOAD(kt) { const int _k = (kt); \
    rk0 = *(const uint4*)(ksrc0 + (size_t)_k * kst0); rk1 = *(const uint4*)(ksrc1 + (size_t)_k * kst1); \
    rk2 = *(const uint4*)(ksrc2 + (size_t)_k * kst2); \
    rv0 = *(const uint4*)(vsrc0 + _k * 128); rv1 = *(const uint4*)(vsrc1 + _k * 128); }
#define A8_WRITE(buf) { bf16_t* _b = sKV + (buf) * KVBUF; \
    *(uint4*)(_b + kkey0 * LDK + kcc0 * 8) = rk0; *(uint4*)(_b + kkey1 * LDK + kcc1 * 8) = rk1; \
    *(uint4*)(_b + kkey2 * LDK + kcc2 * 8) = rk2; \
    *(uint4*)(_b + 128 * LDK + vd0 * LDV + vcc * 8) = rv0; *(uint4*)(_b + 128 * LDK + (vd0 + 32) * LDV + vcc * 8) = rv1; }
  A8_LOAD(0)
  A8_WRITE(0)
  __syncthreads();
  for (int kt = 0; kt < nkt; ++kt) {
    const int ktn = min(kt + 1, nkt - 1);
    A8_LOAD(ktn)
    const bf16_t* sK = sKV + (kt & 1) * KVBUF;
    const bf16_t* sV = sK + 128 * LDK;
    f32x4 sacc[8];
#pragma unroll
    for (int n = 0; n < 8; ++n) sacc[n] = (f32x4){0.f, 0.f, 0.f, 0.f};
#pragma unroll
    for (int ks = 0; ks < 3; ++ks)
#pragma unroll
      for (int n = 0; n < 8; ++n) {
        const bf16x8 a = *(const bf16x8*)(sK + (n * 16 + lr) * LDK + ks * 32 + lg * 8);
        sacc[n] = mfma16(a, qf[ks], sacc[n]);
      }
    float mx = sacc[0][0];
#pragma unroll
    for (int n = 0; n < 8; ++n)
#pragma unroll
      for (int q = 0; q < 4; ++q) mx = fmaxf(mx, sacc[n][q]);
    mx = quad_max(mx);
    const float mnew = fmaxf(mrun, mx);
    const float alpha = __builtin_amdgcn_exp2f(mrun - mnew);
    mrun = mnew;
    float ps0 = 0.f, ps1 = 0.f;
#pragma unroll
    for (int n = 0; n < 8; n += 2)
#pragma unroll
      for (int q = 0; q < 4; ++q) {
        const float e0 = __builtin_amdgcn_exp2f(sacc[n][q] - mnew); sacc[n][q] = e0; ps0 += e0;
        const float e1 = __builtin_amdgcn_exp2f(sacc[n + 1][q] - mnew); sacc[n + 1][q] = e1; ps1 += e1;
      }
    lrun = lrun * alpha + (ps0 + ps1);
#pragma unroll
    for (int i = 0; i < 4; ++i)
#pragma unroll
      for (int q = 0; q < 4; ++q) oacc[i][q] *= alpha;
#pragma unroll
    for (int ks = 0; ks < 4; ++ks) {
      union { bf16x8 v; unsigned u[4]; } pf;
      pf.u[0] = pack2(sacc[2 * ks][0], sacc[2 * ks][1]);
      pf.u[1] = pack2(sacc[2 * ks][2], sacc[2 * ks][3]);
      pf.u[2] = pack2(sacc[2 * ks + 1][0], sacc[2 * ks + 1][1]);
      pf.u[3] = pack2(sacc[2 * ks + 1][2], sacc[2 * ks + 1][3]);
#pragma unroll
      for (int m = 0; m < 4; ++m) {
        union { bf16x8 v; uint2 h[2]; } av;
        const bf16_t* vp = sV + (m * 16 + lr) * LDV + ks * 32 + lg * 4;
        av.h[0] = *(const uint2*)(vp);
        av.h[1] = *(const uint2*)(vp + 16);
        oacc[m] = mfma16(av.v, pf.v, oacc[m]);
      }
    }
    __builtin_amdgcn_sched_barrier(0);
    A8_WRITE((kt + 1) & 1)
    __syncthreads();
  }
  lrun = quad_sum(lrun);
  const float inv = 1.f / lrun;
#pragma unroll
  for (int m = 0; m < 4; ++m) {
    uint2 o;
    o.x = pack2(oacc[m][0] * inv, oacc[m][1] * inv);
    o.y = pack2(oacc[m][2] * inv, oacc[m][3] * inv);
    *(uint2*)(WSB(OFF_CAT) + (size_t)qrow * 1024 + hh * 64 + m * 16 + lg * 4) = o;
  }
}

NOINL void ssd_y_item(const P& p, int item) {
  char* smem = g_smem + VB * 73728;
  const int tid = opaque_tid(), lane = tid & 63, wave = tid >> 6, lr = lane & 15, lg = lane >> 4;
  const int cidx = item >> 3, qt = (item >> 1) & 3, half = qt >> 1, g = item & 1;
  const int r0 = cidx * 128;
  const int hh = g * 4 + wave;
  constexpr int LDC = 136, LDM = 72;
  bf16_t* sC = (bf16_t*)smem;
  bf16_t* sB = sC + 64 * LDC;
  bf16_t* sM = sB + 64 * LDC + wave * 64 * LDM;
  float* rowss = (float*)((bf16_t*)smem + 2 * 64 * LDC + 4 * 64 * LDM);
  const float* cum = WSF(OFF_CUM);
  const float* dtv = WSF(OFF_DTV);
  const int srow = tid >> 4, scol = (tid & 15) * 8;
  uint4 pb0, pb1, pb2, pb3;
  {
    const bf16_t* cs = WSB(OFF_CM) + (size_t)(r0 + qt * 32 + srow) * 256 + g * 128 + scol;
    const bf16_t* bs = WSB(OFF_BM) + (size_t)(r0 + srow) * 256 + g * 128 + scol;
    const uint4 c0 = *(const uint4*)(cs), c1 = *(const uint4*)(cs + 16 * 256);
    const uint4 b0 = *(const uint4*)(bs), b1 = *(const uint4*)(bs + 16 * 256), b2 = *(const uint4*)(bs + 32 * 256), b3 = *(const uint4*)(bs + 48 * 256);
    pb0 = *(const uint4*)(bs + 64 * 256); pb1 = *(const uint4*)(bs + 80 * 256); pb2 = *(const uint4*)(bs + 96 * 256); pb3 = *(const uint4*)(bs + 112 * 256);
    bf16_t* wc = sC + srow * LDC + scol;
    bf16_t* wb = sB + srow * LDC + scol;
    *(uint4*)(wc) = c0; *(uint4*)(wc + 16 * LDC) = c1;
    *(uint4*)(wb) = b0; *(uint4*)(wb + 16 * LDC) = b1; *(uint4*)(wb + 32 * LDC) = b2; *(uint4*)(wb + 48 * LDC) = b3;
  }
  __syncthreads();
  f32x4 Y[2][4];
#pragma unroll
  for (int i = 0; i < 2; ++i)
#pragma unroll
    for (int j = 0; j < 4; ++j) Y[i][j] = (f32x4){0.f, 0.f, 0.f, 0.f};
#pragma unroll 1
  for (int jh = 0; jh < 2; ++jh) {
    if (jh == 1) {
      __syncthreads();
      bf16_t* wb = sB + srow * LDC + scol;
      *(uint4*)(wb) = pb0; *(uint4*)(wb + 16 * LDC) = pb1; *(uint4*)(wb + 32 * LDC) = pb2; *(uint4*)(wb + 48 * LDC) = pb3;
      __syncthreads();
    }
#pragma unroll 1
    for (int dir = 0; dir < 2; ++dir) {
      const bool use = dir == 0 ? (jh <= half) : (jh >= half);
      if (!use) continue;
      bf16x8 xf[2][4];
#pragma unroll
      for (int ks = 0; ks < 2; ++ks)
#pragma unroll
        for (int pt = 0; pt < 4; ++pt)
          xf[ks][pt] = *(const bf16x8*)(WSB(OFF_XST) + (size_t)(hh * 64 + pt * 16 + lr) * 8192 + r0 + jh * 64 + ks * 32 + lg * 8);
      float ci[2], cj[4][4], dj[4][4];
#pragma unroll
      for (int it = 0; it < 2; ++it) ci[it] = cum[((size_t)dir * 8192 + r0 + qt * 32 + it * 16 + lr) * 8 + hh];
#pragma unroll
      for (int jt = 0; jt < 4; ++jt)
#pragma unroll
        for (int q = 0; q < 4; ++q) {
          const size_t tj = (size_t)dir * 8192 + r0 + jh * 64 + jt * 16 + lg * 4 + q;
          cj[jt][q] = cum[tj * 8 + hh];
          dj[jt][q] = dtv[tj * 8 + hh];
        }
#pragma unroll
      for (int it = 0; it < 2; ++it) {
        f32x4 cb[4];
#pragma unroll
        for (int jt = 0; jt < 4; ++jt) cb[jt] = (f32x4){0.f, 0.f, 0.f, 0.f};
#pragma unroll
        for (int ks = 0; ks < 4; ++ks) {
          const bf16x8 b = *(const bf16x8*)(sC + (it * 16 + lr) * LDC + ks * 32 + lg * 8);
#pragma unroll
          for (int jt = 0; jt < 4; ++jt) {
            const bf16x8 a = *(const bf16x8*)(sB + (jt * 16 + lr) * LDC + ks * 32 + lg * 8);
            cb[jt] = mfma16(a, b, cb[jt]);
          }
        }
        const int ti = qt * 32 + it * 16 + lr;
#pragma unroll
        for (int jt = 0; jt < 4; ++jt) {
          float v[4];
#pragma unroll
          for (int q = 0; q < 4; ++q) {
            const int tj = jh * 64 + jt * 16 + lg * 4 + q;
            const bool ok = dir == 0 ? (tj <= ti) : (tj >= ti);
            v[q] = ok ? cb[jt][q] * __expf(ci[it] - cj[jt][q]) * dj[jt][q] : 0.f;
          }
          uint2 o;
          o.x = pack2(v[0], v[1]);
          o.y = pack2(v[2], v[3]);
          *(uint2*)(sM + (it * 16 + lr) * LDM + jt * 16 + lg * 4) = o;
        }
        __builtin_amdgcn_sched_barrier(0);
      }
      asm volatile("s_waitcnt lgkmcnt(0)" ::: "memory");
#pragma unroll
      for (int ks = 0; ks < 2; ++ks) {
        bf16x8 af[2];
#pragma unroll
        for (int it = 0; it < 2; ++it) af[it] = *(const bf16x8*)(sM + (it * 16 + lr) * LDM + ks * 32 + lg * 8);
#pragma unroll
        for (int it = 0; it < 2; ++it)
#pragma unroll
          for (int pt = 0; pt < 4; ++pt) Y[it][pt] = mfma16(af[it], xf[ks][pt], Y[it][pt]);
      }
      asm volatile("s_waitcnt lgkmcnt(0)" ::: "memory");
      __builtin_amdgcn_sched_barrier(0);
    }
  }
#pragma unroll 1
  for (int dir = 0; dir < 2; ++dir) {
    const bf16_t* hp = WSB(OFF_H) + ((size_t)(dir * 64 + cidx) * 8 + hh) * 8192;
    float ei[2][4];
#pragma unroll
    for (int it = 0; it < 2; ++it)
#pragma unroll
      for (int q = 0; q < 4; ++q)
        ei[it][q] = __expf(cum[((size_t)dir * 8192 + r0 + qt * 32 + it * 16 + lg * 4 + q) * 8 + hh]);
#pragma unroll
    for (int pt = 0; pt < 4; ++pt) {
      bf16x8 bfr[4];
#pragma unroll
      for (int ks = 0; ks < 4; ++ks) bfr[ks] = *(const bf16x8*)(hp + (size_t)(pt * 16 + lr) * 128 + ks * 32 + lg * 8);
      f32x4 T[2];
#pragma unroll
      for (int it = 0; it < 2; ++it) T[it] = (f32x4){0.f, 0.f, 0.f, 0.f};
#pragma unroll
      for (int ks = 0; ks < 4; ++ks)
#pragma unroll
        for (int it = 0; it < 2; ++it) {
          const bf16x8 a = *(const bf16x8*)(sC + (it * 16 + lr) * LDC + ks * 32 + lg * 8);
          T[it] = mfma16(a, bfr[ks], T[it]);
        }
#pragma unroll
      for (int it = 0; it < 2; ++it)
#pragma unroll
        for (int q = 0; q < 4; ++q) Y[it][pt][q] += ei[it][q] * T[it][q];
    }
    __builtin_amdgcn_sched_barrier(0);
  }
  const float dsk = p.ssd_d[hh];
  const float* proj = WSF(OFF_R1);
#pragma unroll
  for (int i = 0; i < 2; ++i) {
#pragma unroll
    for (int q = 0; q < 4; ++q) {
      const int il = i * 16 + lg * 4 + q;
      const size_t r = (size_t)r0 + qt * 32 + il;
      float ss = 0.f;
#pragma unroll
      for (int j = 0; j < 4; ++j) {
        const int ch = hh * 64 + j * 16 + lr;
        const float xs = bf2f(WSB(OFF_XS)[r * 512 + ch]);
        const float z = proj[r * 2096 + 544 + ch];
        const float y = (Y[i][j][q] + dsk * xs) * silu(z);
        Y[i][j][q] = y;
        ss += y * y;
      }
      ss += __shfl_xor(ss, 1, 64);
      ss += __shfl_xor(ss, 2, 64);
      ss += __shfl_xor(ss, 4, 64);
      ss += __shfl_xor(ss, 8, 64);
      if (lr == 0) rowss[wave * 64 + il] = ss;
    }
    __builtin_amdgcn_sched_barrier(0);
  }
  __syncthreads();
#pragma unroll
  for (int i = 0; i < 2; ++i) {
#pragma unroll
    for (int q = 0; q < 4; ++q) {
      const int il = i * 16 + lg * 4 + q;
      const size_t r = (size_t)r0 + qt * 32 + il;
      const float tot = rowss[il] + rowss[64 + il] + rowss[128 + il] + rowss[192 + il];
      const float rs = rsqrtf(tot * (1.f / 256.f) + 1e-6f);
#pragma unroll
      for (int j = 0; j < 4; ++j) {
        const int ch = hh * 64 + j * 16 + lr;
        WSB(OFF_CAT)[r * 1024 + 512 + ch] = f2bf(Y[i][j][q] * rs * p.ssd_norm[ch]);
      }
    }
    __builtin_amdgcn_sched_barrier(0);
  }
  __syncthreads();
}

template <int W2>
DEVI void pool_item(const bf16_t* __restrict__ h, bf16_t* __restrict__ dst, int r, int cc) {
  int s0, L;
  if (r < 4096) { s0 = r & ~255; L = 256; } else { s0 = 4096 + ((r - 4096) & ~2047); L = 2048; }
  const int t = r - s0;
  const int lo = max(t - W2, 0), hi = min(t + W2, L);
  uint4 v[2 * W2];
#pragma unroll
  for (int k = 0; k < 2 * W2; ++k) {
    const int u = min(max(t - W2 + k, 0), L - 1);
    v[k] = *(const uint4*)(h + (size_t)(s0 + u) * 1024 + cc);
  }
  float acc[8] = {0, 0, 0, 0, 0, 0, 0, 0};
#pragma unroll
  for (int k = 0; k < 2 * W2; ++k) {
    const int u = t - W2 + k;
    const float m = (u >= 0 && u < L) ? 1.f : 0.f;
    acc[0] += m * __uint_as_float(v[k].x << 16); acc[1] += m * __uint_as_float(v[k].x & 0xffff0000u);
    acc[2] += m * __uint_as_float(v[k].y << 16); acc[3] += m * __uint_as_float(v[k].y & 0xffff0000u);
    acc[4] += m * __uint_as_float(v[k].z << 16); acc[5] += m * __uint_as_float(v[k].z & 0xffff0000u);
    acc[6] += m * __uint_as_float(v[k].w << 16); acc[7] += m * __uint_as_float(v[k].w & 0xffff0000u);
  }
  const float inv = 1.f / (float)(hi - lo);
  const uint4 c = v[W2];
  uint4 o;
  o.x = pack2(acc[0] * inv - __uint_as_float(c.x << 16), acc[1] * inv - __uint_as_float(c.x & 0xffff0000u));
  o.y = pack2(acc[2] * inv - __uint_as_float(c.y << 16), acc[3] * inv - __uint_as_float(c.y & 0xffff0000u));
  o.z = pack2(acc[4] * inv - __uint_as_float(c.z << 16), acc[5] * inv - __uint_as_float(c.z & 0xffff0000u));
  o.w = pack2(acc[6] * inv - __uint_as_float(c.w << 16), acc[7] * inv - __uint_as_float(c.w & 0xffff0000u));
  *(uint4*)(dst + (size_t)r * 1024 + cc) = o;
}

NOINL void pool_phase(const P& p) {
  const bf16_t* h = WSB(OFF_H);
  bf16_t* dst = WSB(OFF_CAT);
  const int total = 8192 * 128;
  for (int idx = blockIdx.x * 512 + threadIdx.x; idx < total; idx += gridDim.x * 512) {
    const int c32 = idx & 31, rlo = (idx >> 5) & 1, gi = (idx >> 6) & 3, rhi = idx >> 8;
    const int r = rhi * 2 + rlo, cc = gi * 256 + c32 * 8;
    if (gi == 0) pool_item<1>(h, dst, r, cc);
    else if (gi == 1) pool_item<2>(h, dst, r, cc);
    else if (gi == 2) pool_item<4>(h, dst, r, cc);
    else pool_item<8>(h, dst, r, cc);
  }
}

NOINL void ph_gemm_proj(const P& p) {
  float* proj = WSF(OFF_R1);
  const bf16_t* A = WSB(OFF_H);
  const bf16_t* B = WSB(OFF_WIN);
  auto epi = [&](int ctx, int row, int col, f32x4 v0, f32x4 v1) {
#pragma unroll
    for (int q = 0; q < 4; ++q) {
      if (col < 2096) proj[(size_t)(row + q) * 2096 + col] = v0[q];
      if (col + 16 < 2096) proj[(size_t)(row + q) * 2096 + col + 16] = v1[q];
    }
  };
  gemm8_stream(256, 1024, 1024, 1024,
    [=](int t) {
      TileInfo r;
      int m, n; tile_mn(t, 32, 8, m, n);
      r.m0 = m * 256; r.n0 = n * 256; r.ctx = 0;
      r.a = A + (size_t)r.m0 * 1024; r.b = B + (size_t)r.n0 * 1024;
      return r;
    }, epi);
  gemm_stream(64, 1024, 1024, 1024, g_smem + VB * 73728,
    [=](int t) {
      TileInfo r;
      r.m0 = t * 128; r.n0 = 2048; r.ctx = 0;
      r.a = A + (size_t)r.m0 * 1024; r.b = B + (size_t)2048 * 1024;
      return r;
    }, epi);
}

NOINL void ph_gemm_f32out(const P& p, const bf16_t* A, int lda, const bf16_t* B, int ldb, int K, bf16_t* C, int N) {
  const int nN = N / 128;
  gemm_stream(64 * nN, lda, ldb, K, g_smem + VB * 73728,
    [=](int t) {
      TileInfo r;
      int m, n; tile_mn(t, 64, nN, m, n);
      r.m0 = m * 128; r.n0 = n * 128; r.ctx = 0;
      r.a = A + (size_t)r.m0 * lda; r.b = B + (size_t)r.n0 * ldb;
      return r;
    },
    [&](int ctx, int row, int col, f32x4 v0, f32x4 v1) {
#pragma unroll
      for (int q = 0; q < 4; ++q) {
        C[(size_t)(row + q) * N + col] = f2bf(v0[q]);
        C[(size_t)(row + q) * N + col + 16] = f2bf(v1[q]);
      }
    });
}

NOINL void ph_gemm8_splitk(const P& p, const bf16_t* A, int lda, const bf16_t* B, int ldb, int Khalf, bf16_t* C0, bf16_t* C1) {
  gemm8_stream(256, lda, ldb, Khalf,
    [=](int t) {
      TileInfo r;
      const int id = swz_tile(t, 256);
      const int ks = id >> 7, rem = id & 127;
      r.m0 = (rem >> 2) * 256; r.n0 = (rem & 3) * 256; r.ctx = ks;
      r.a = A + (size_t)r.m0 * lda + (size_t)ks * Khalf; r.b = B + (size_t)r.n0 * ldb + (size_t)ks * Khalf;
      return r;
    },
    [&](int ks, int row, int col, f32x4 v0, f32x4 v1) {
      bf16_t* C = ks ? C1 : C0;
#pragma unroll
      for (int q = 0; q < 4; ++q) {
        C[(size_t)(row + q) * 1024 + col] = f2bf(v0[q]);
        C[(size_t)(row + q) * 1024 + col + 16] = f2bf(v1[q]);
      }
    });
}

NOINL void ph_gemm_qkv(const P& p) {
  bf16_t* qo = WSB(OFF_Q);
  bf16_t* kn = WSB(OFF_KN);
  bf16_t* vt = WSB(OFF_VT);
  const bf16_t* Aq = WSB(OFF_CQN);
  const bf16_t* Bq = WSB(OFF_WUQ);
  const bf16_t* Ak = WSB(OFF_CKV);
  const bf16_t* Bk = WSB(OFF_WUKV);
  gemm_stream(384 + 544, 256, 256, 256, g_smem + VB * 73728,
    [=](int t) {
      TileInfo r;
      int m, n;
      if (t < 384) {
        tile_mn(t, 64, 6, m, n);
        r.m0 = m * 128; r.n0 = n * 128; r.ctx = 0;
        r.a = Aq + (size_t)r.m0 * 256; r.b = Bq + (size_t)r.n0 * 256;
      } else {
        tile_mn(t - 384, 68, 8, m, n);
        r.m0 = m * 128; r.n0 = n * 128; r.ctx = 1;
        r.a = Ak + (size_t)r.m0 * 256; r.b = Bk + (size_t)r.n0 * 256;
      }
      return r;
    },
    [&](int ctx, int row, int col, f32x4 v0, f32x4 v1) {
      if (ctx == 0) {
        const float scl = 0.10206207261596575f * 1.4426950408889634f;
        const int tn = col >> 4;
        const bool rope = ((tn % 6) == 4) && (row >= 4096);
        const int ii = col & 15;
        const float fr = rope_freq(ii & 7);
#pragma unroll
        for (int q = 0; q < 4; ++q) {
          float a = v0[q], b = v1[q];
          if (rope) {
            const int tt = (row + q - 4096) & 2047;
            const float pos = (ii < 8) ? (float)(tt >> 6) : (float)(tt & 63);
            const float ang = pos * fr;
            float cs, sn;
            fast_sincos(ang, sn, cs);
            const float x1 = a, x2 = b;
            a = x1 * cs - x2 * sn;
            b = x1 * sn + x2 * cs;
          }
          qo[(size_t)(row + q) * 768 + col] = f2bf(a * scl);
          qo[(size_t)(row + q) * 768 + col + 16] = f2bf(b * scl);
        }
      } else {
        const int hh = col >> 7, j = col & 127;
        if (j < 64) {
#pragma unroll
          for (int q = 0; q < 4; ++q) {
            kn[(size_t)(row + q) * 512 + hh * 64 + j] = f2bf(v0[q]);
            kn[(size_t)(row + q) * 512 + hh * 64 + j + 16] = f2bf(v1[q]);
          }
        } else {
          uint2 o0, o1;
          o0.x = pack2(v0[0], v0[1]); o0.y = pack2(v0[2], v0[3]);
          o1.x = pack2(v1[0], v1[1]); o1.y = pack2(v1[2], v1[3]);
          *(uint2*)(vt + (size_t)(hh * 64 + j - 64) * 8704 + row) = o0;
          *(uint2*)(vt + (size_t)(hh * 64 + j - 64 + 16) * 8704 + row) = o1;
        }
      }
    });
}

NOINL void ph_gemm_ffn_up(const P& p, int layer) {
  bf16_t* gu = WSB(OFF_R1);
  const bf16_t* A = WSB(OFF_H);
  const bf16_t* B = WSB(OFF_WGU) + (size_t)layer * 5632 * 1024;
  gemm8_stream(32 * 22, 1024, 1024, 1024,
    [=](int t) {
      TileInfo r;
      int m, n; tile_mn(t, 32, 22, m, n);
      r.m0 = m * 256; r.n0 = n * 256; r.ctx = 0;
      r.a = A + (size_t)r.m0 * 1024; r.b = B + (size_t)r.n0 * 1024;
      return r;
    },
    [&](int ctx, int row, int col, f32x4 v0, f32x4 v1) {
      const int oc = (col >> 5) * 16 + (col & 15);
#pragma unroll
      for (int q = 0; q < 4; ++q) gu[(size_t)(row + q) * 2816 + oc] = f2bf(silu(v0[q]) * v1[q]);
    });
}

NOINL void ph_gemm_pool(const P& p) {
  bf16_t* mix = WSB(OFF_R1);
  const bf16_t* A = WSB(OFF_CAT);
  const bf16_t* B = WSB(OFF_WPOOL);
  gemm_stream(512, 1024, 256, 256, g_smem + VB * 73728,
    [=](int t) {
      TileInfo r;
      const int id = swz_tile(t, 512);
      const int g = id >> 7, rem = id & 127;
      r.m0 = (rem >> 1) * 128; r.n0 = (rem & 1) * 128; r.ctx = g;
      r.a = A + (size_t)r.m0 * 1024 + g * 256; r.b = B + (size_t)g * 65536 + (size_t)r.n0 * 256;
      return r;
    },
    [&](int g, int row, int col, f32x4 v0, f32x4 v1) {
      const int c0 = g * 256 + col;
      const float s0 = p.pool_scale[c0], s1 = p.pool_scale[c0 + 16];
#pragma unroll
      for (int q = 0; q < 4; ++q) {
        mix[(size_t)(row + q) * 1024 + c0] = f2bf(v0[q] * s0);
        mix[(size_t)(row + q) * 1024 + c0 + 16] = f2bf(v1[q] * s1);
      }
    });
}


#define XB_TMO      128
#define XB_XCNT(j)  (256  + 64 * (j))
#define XB_XSUB(j)  (1280 + 64 * (j))
#define XB_XGEN(j)  (2304 + 64 * (j))
#define XB_TOP      3328
#define XB_TOPGEN   3392
#define XCD_BAR_WORDS 3456
#define XB_SPIN_CAP (1u << 22)
#define LAS __attribute__((address_space(3)))
DEVI unsigned xb_ld(unsigned* p) { return __hip_atomic_load(p, __ATOMIC_RELAXED, __HIP_MEMORY_SCOPE_AGENT); }
DEVI unsigned xb_add(unsigned* p, unsigned v) { return __hip_atomic_fetch_add(p, v, __ATOMIC_RELAXED, __HIP_MEMORY_SCOPE_AGENT); }
DEVI unsigned xb_xcc_id() { return (unsigned)__builtin_amdgcn_s_getreg((3 << 11) | 20) & 0xFu; }
#define XB_SPIN(cond, bar) do { unsigned _sp = 0; while (cond) { __builtin_amdgcn_s_sleep(1); \
    if ((++_sp & 255u) == 0u) { if (xb_ld(&(bar)[XB_TMO])) break; if (_sp > XB_SPIN_CAP) { atomicAdd(&(bar)[XB_TMO], 1u); break; } } } } while (0)
struct XcdBarrier { unsigned* bar; unsigned x; volatile LAS unsigned* st; };
DEVI XcdBarrier xcd_barrier_post(unsigned* bar, volatile LAS unsigned* st) {
  XcdBarrier b; b.bar = bar; b.x = xb_xcc_id(); b.st = st;
  if (threadIdx.x == 0) (void)xb_add(&bar[XB_XCNT(b.x)], 1u);
  return b;
}
DEVI void xcd_barrier_complete(unsigned* bar, unsigned x, unsigned& nloc, unsigned& nx) {
  const unsigned G = gridDim.x * gridDim.y * gridDim.z;
  unsigned sum, cnt, mine, sp = 0u;
  for (;;) {
    sum = 0u; cnt = 0u; mine = 0u;
#pragma unroll
    for (unsigned j = 0; j < 16; ++j) { const unsigned c = xb_ld(&bar[XB_XCNT(j)]); sum += c; cnt += (c > 0u) ? 1u : 0u; mine = (j == x) ? c : mine; }
    if (sum == G) break;
    __builtin_amdgcn_s_sleep(1);
    if ((++sp & 255u) == 0u) { if (xb_ld(&bar[XB_TMO])) break; if (sp > XB_SPIN_CAP) { atomicAdd(&bar[XB_TMO], 1u); break; } }
  }
  nloc = mine > 0u ? mine : 1u; nx = cnt > 0u ? cnt : 1u;
}
DEVI void xcd_barrier(const XcdBarrier& b) {
  asm volatile("s_waitcnt vmcnt(0)" ::: "memory");
  __syncthreads();
  if (threadIdx.x == 0) {
    unsigned* bar = b.bar;
    __builtin_amdgcn_s_waitcnt(0);
    unsigned nloc = b.st[0], nx = b.st[1];
    if (nloc == 0u) { xcd_barrier_complete(bar, b.x, nloc, nx); b.st[0] = nloc; b.st[1] = nx; }
    const unsigned old = xb_add(&bar[XB_XSUB(b.x)], 1u);
    const unsigned gen = old / nloc;
    if (old + 1u == (gen + 1u) * nloc) {
      __builtin_amdgcn_fence(__ATOMIC_RELEASE, "agent");
      asm volatile("s_waitcnt vmcnt(0)" ::: "memory");
      const unsigned og = xb_add(&bar[XB_TOP], 1u);
      const unsigned tg = og / nx;
      if (og + 1u == (tg + 1u) * nx) xb_add(&bar[XB_TOPGEN], 1u);
      else XB_SPIN(xb_ld(&bar[XB_TOPGEN]) == tg, bar);
      __builtin_amdgcn_fence(__ATOMIC_ACQUIRE, "agent");
      xb_add(&bar[XB_XGEN(b.x)], 1u);
      asm volatile("s_waitcnt vmcnt(0)" ::: "memory");
    } else {
      XB_SPIN(xb_ld(&bar[XB_XGEN(b.x)]) == gen, bar);
      __builtin_amdgcn_fence(__ATOMIC_ACQUIRE, "agent");
      asm volatile("s_waitcnt vmcnt(0)" ::: "memory");
    }
  }
  __syncthreads();
}

constexpr int NPHASE = 18;
#ifndef REPMASK
#define REPMASK 0
#endif
#ifndef ATPROBE
#define ATPROBE 0
#endif
#ifndef P6PROBE
#define P6PROBE 1
#endif
#ifndef PHMASK
#define PHMASK 0x3ffff
#endif
#define PH(n) if constexpr ((PHMASK >> (n)) & 1)

__global__ void __launch_bounds__(512, 2) mega(P p, int lo, int hi) {
  __shared__ uint4 xb_words;
  if (threadIdx.x == 0) xb_words = make_uint4(0u, 0u, 0u, 0u);
  __syncthreads();
  XcdBarrier xb = xcd_barrier_post((unsigned*)(p.ws + OFF_BAR), (volatile LAS unsigned*)&xb_words);
  if (lo < 0) cg::this_grid().sync();
  PH(0) if (lo <= 0 && 0 < hi) {
#if (REPMASK >> 0) & 1
    int nrep = 2; asm volatile("" : "+s"(nrep));
    for (int rep = 0; rep < nrep; ++rep) {
      if (rep) xcd_barrier(xb);
#else
    {
#endif
        for (int t0_ = blockIdx.x * 2; t0_ < 384 + 5200; t0_ += gridDim.x * 2) {
          const int t = min(t0_ + VB, 384 + 5200 - 1);
          if (t < 384) gemv_tile(p, t); else transpose_tile(p, t - 384);
        }
    }
  }
  if (lo <= 0 && 0 + 1 < hi) xcd_barrier(xb);
  PH(1) if (lo <= 1 && 1 < hi) {
#if (REPMASK >> 1) & 1
    int nrep = 2; asm volatile("" : "+s"(nrep));
    for (int rep = 0; rep < nrep; ++rep) {
      if (rep) xcd_barrier(xb);
#else
    {
#endif
        rowop<false, true, true, false, false>(p, nullptr, nullptr, nullptr, 0, p.n_pre_mix, 0, 1, 0, 0);
    }
  }
  if (lo <= 1 && 1 + 1 < hi) xcd_barrier(xb);
  PH(2) if (lo <= 2 && 2 < hi) {
#if (REPMASK >> 2) & 1
    int nrep = 2; asm volatile("" : "+s"(nrep));
    for (int rep = 0; rep < nrep; ++rep) {
      if (rep) xcd_barrier(xb);
#else
    {
#endif
        ph_gemm_proj(p);
    }
  }
  if (lo <= 2 && 2 + 1 < hi) xcd_barrier(xb);
  PH(3) if (lo <= 3 && 3 < hi) {
#if (REPMASK >> 3) & 1
    int nrep = 2; asm volatile("" : "+s"(nrep));
    for (int rep = 0; rep < nrep; ++rep) {
      if (rep) xcd_barrier(xb);
#else
    {
#endif
        prep_rows(p);
        prep_cache(p);
        for (int t0_ = VT_FIRST; t0_ < 2048; t0_ += gridDim.x * 2) conv_tile(p, min(t0_ + VT_OFF, 2047));
    }
  }
  if (lo <= 3 && 3 + 1 < hi) xcd_barrier(xb);
  PH(4) if (lo <= 4 && 4 < hi) {
#if (REPMASK >> 4) & 1
    int nrep = 2; asm volatile("" : "+s"(nrep));
    for (int rep = 0; rep < nrep; ++rep) {
      if (rep) xcd_barrier(xb);
#else
    {
#endif
        ph_gemm_qkv(p);
        for (int t0_ = VT_FIRST; t0_ < 512; t0_ += gridDim.x * 2) chunk_state_item(p, min(t0_ + VT_OFF, 511));
    }
  }
  if (lo <= 4 && 4 + 1 < hi) xcd_barrier(xb);
  PH(5) if (lo <= 5 && 5 < hi) {
#if (REPMASK >> 5) & 1
    int nrep = 2; asm volatile("" : "+s"(nrep));
    for (int rep = 0; rep < nrep; ++rep) {
      if (rep) xcd_barrier(xb);
#else
    {
#endif
        scan_states(p);
    }
  }
  if (lo <= 5 && 5 + 1 < hi) xcd_barrier(xb);
  PH(6) if (lo <= 6 && 6 < hi) {
#if (REPMASK >> 6) & 1
    int nrep = 2; asm volatile("" : "+s"(nrep));
    for (int rep = 0; rep < nrep; ++rep) {
      if (rep) xcd_barrier(xb);
#else
    {
#endif
        for (int t = blockIdx.x; t < 512; t += gridDim.x) attn8_item(p, t);
        for (int t0_ = VT_FIRST; t0_ < 512; t0_ += gridDim.x * 2) ssd_y_item(p, min(t0_ + VT_OFF, 511));
    }
  }
  if (lo <= 6 && 6 + 1 < hi) xcd_barrier(xb);
  PH(7) if (lo <= 7 && 7 < hi) {
#if (REPMASK >> 7) & 1
    int nrep = 2; asm volatile("" : "+s"(nrep));
    for (int rep = 0; rep < nrep; ++rep) {
      if (rep) xcd_barrier(xb);
#else
    {
#endif
        ph_gemm8_splitk(p, WSB(OFF_CAT), 1024, WSB(OFF_WOUT), 1024, 512, WSB(OFF_R1), WSB(OFF_R1) + (size_t)8192 * 1024);
    }
  }
  if (lo <= 7 && 7 + 1 < hi) xcd_barrier(xb);
  PH(8) if (lo <= 8 && 8 < hi) {
#if (REPMASK >> 8) & 1
    int nrep = 2; asm volatile("" : "+s"(nrep));
    for (int rep = 0; rep < nrep; ++rep) {
      if (rep) xcd_barrier(xb);
#else
    {
#endif
        rowop<true, true, true, false, true>(p, WSB(OFF_R1), WSB(OFF_R1) + (size_t)8192 * 1024, p.n_post_mix, 2, p.n_pre_ffn, 3, 4, 0, 0);
    }
  }
  if (lo <= 8 && 8 + 1 < hi) xcd_barrier(xb);
  PH(9) if (lo <= 9 && 9 < hi) {
#if (REPMASK >> 9) & 1
    int nrep = 2; asm volatile("" : "+s"(nrep));
    for (int rep = 0; rep < nrep; ++rep) {
      if (rep) xcd_barrier(xb);
#else
    {
#endif
        ph_gemm_ffn_up(p, 0);
    }
  }
  if (lo <= 9 && 9 + 1 < hi) xcd_barrier(xb);
  PH(10) if (lo <= 10 && 10 < hi) {
#if (REPMASK >> 10) & 1
    int nrep = 2; asm volatile("" : "+s"(nrep));
    for (int rep = 0; rep < nrep; ++rep) {
      if (rep) xcd_barrier(xb);
#else
    {
#endif
        ph_gemm8_splitk(p, WSB(OFF_R1), 2816, WSB(OFF_WDN), 2816, 1408, WSB(OFF_R2), WSB(OFF_R2) + (size_t)8192 * 1024);
    }
  }
  if (lo <= 10 && 10 + 1 < hi) xcd_barrier(xb);
  PH(11) if (lo <= 11 && 11 < hi) {
#if (REPMASK >> 11) & 1
    int nrep = 2; asm volatile("" : "+s"(nrep));
    for (int rep = 0; rep < nrep; ++rep) {
      if (rep) xcd_barrier(xb);
#else
    {
#endif
        rowop<true, true, false, false, true>(p, WSB(OFF_R2), WSB(OFF_R2) + (size_t)8192 * 1024, p.n_post_ffn, 5, p.n_pre_mix + 1024, 0, 1, 0, 1);
    }
  }
  if (lo <= 11 && 11 + 1 < hi) xcd_barrier(xb);
  PH(12) if (lo <= 12 && 12 < hi) {
#if (REPMASK >> 12) & 1
    int nrep = 2; asm volatile("" : "+s"(nrep));
    for (int rep = 0; rep < nrep; ++rep) {
      if (rep) xcd_barrier(xb);
#else
    {
#endif
        pool_phase(p);
    }
  }
  if (lo <= 12 && 12 + 1 < hi) xcd_barrier(xb);
  PH(13) if (lo <= 13 && 13 < hi) {
#if (REPMASK >> 13) & 1
    int nrep = 2; asm volatile("" : "+s"(nrep));
    for (int rep = 0; rep < nrep; ++rep) {
      if (rep) xcd_barrier(xb);
#else
    {
#endif
        ph_gemm_pool(p);
    }
  }
  if (lo <= 13 && 13 + 1 < hi) xcd_barrier(xb);
  PH(14) if (lo <= 14 && 14 < hi) {
#if (REPMASK >> 14) & 1
    int nrep = 2; asm volatile("" : "+s"(nrep));
    for (int rep = 0; rep < nrep; ++rep) {
      if (rep) xcd_barrier(xb);
#else
    {
#endif
        rowop<true, true, false, false, false>(p, WSB(OFF_R1), nullptr, p.n_post_mix + 1024, 2, p.n_pre_ffn + 1024, 3, 4, 1, 1);
    }
  }
  if (lo <= 14 && 14 + 1 < hi) xcd_barrier(xb);
  PH(15) if (lo <= 15 && 15 < hi) {
#if (REPMASK >> 15) & 1
    int nrep = 2; asm volatile("" : "+s"(nrep));
    for (int rep = 0; rep < nrep; ++rep) {
      if (rep) xcd_barrier(xb);
#else
    {
#endif
        ph_gemm_ffn_up(p, 1);
    }
  }
  if (lo <= 15 && 15 + 1 < hi) xcd_barrier(xb);
  PH(16) if (lo <= 16 && 16 < hi) {
#if (REPMASK >> 16) & 1
    int nrep = 2; asm volatile("" : "+s"(nrep));
    for (int rep = 0; rep < nrep; ++rep) {
      if (rep) xcd_barrier(xb);
#else
    {
#endif
        ph_gemm8_splitk(p, WSB(OFF_R1), 2816, WSB(OFF_WDN) + (size_t)1024 * 2816, 2816, 1408, WSB(OFF_R2), WSB(OFF_R2) + (size_t)8192 * 1024);
    }
  }
  if (lo <= 16 && 16 + 1 < hi) xcd_barrier(xb);
  PH(17) if (lo <= 17 && 17 < hi) {
#if (REPMASK >> 17) & 1
    int nrep = 2; asm volatile("" : "+s"(nrep));
    for (int rep = 0; rep < nrep; ++rep) {
      if (rep) xcd_barrier(xb);
#else
    {
#endif
        rowop<true, false, false, true, true>(p, WSB(OFF_R2), WSB(OFF_R2) + (size_t)8192 * 1024, p.n_post_ffn + 1024, 5, nullptr, 0, 0, 1, 1);
    }
  }
}

extern "C" void kernel_launch(void* const* d_in, const int* in_sizes, int n_in, void* d_out, int out_size, void* d_ws,
                              size_t ws_size, hipStream_t stream) {
  P p{};
  const float** f = (const float**)&p;
  for (int i = 0; i < 33; ++i) f[i] = (const float*)d_in[i];
  p.out = (float*)d_out;
  p.ws = (char*)d_ws;
  static int grid_blocks = 0;
  if (!grid_blocks) {
    int dev = 0, cus = 0, per_cu = 0;
    hipGetDevice(&dev);
    hipDeviceGetAttribute(&cus, hipDeviceAttributeMultiprocessorCount, dev);
    hipOccupancyMaxActiveBlocksPerMultiprocessor(&per_cu, mega, 512, 0);
    if (per_cu > 1) per_cu = 1;
    if (per_cu < 1) per_cu = 1;
    grid_blocks = cus * per_cu;
  }
  hipMemsetAsync((char*)d_ws + OFF_BAR, 0, XCD_BAR_WORDS * 4, stream);
#if SINGLE_LAUNCH
  int lo = 0, hi = NPHASE;
  void* args[] = {&p, &lo, &hi};
  hipError_t e = hipLaunchCooperativeKernel((void*)mega, dim3(grid_blocks), dim3(512), args, 0, stream);
  if (e != hipSuccess) fprintf(stderr, "cooperative launch failed: %s (grid %d)\n", hipGetErrorString(e), grid_blocks);
#else
  for (int ph = 0; ph < NPHASE; ++ph) mega<<<grid_blocks, 512, 0, stream>>>(p, ph, ph + 1);
#endif
}
```

```cpp
#include <hip/hip_runtime.h>
#include <hip/hip_cooperative_groups.h>
#include <stdint.h>
#include <stdio.h>
namespace cg = cooperative_groups;

#ifndef SINGLE_LAUNCH
#define SINGLE_LAUNCH 1
#endif

typedef __attribute__((ext_vector_type(8))) short bf16x8;
typedef __attribute__((ext_vector_type(4))) float f32x4;
typedef unsigned short bf16_t;

#define DEVI __device__ __forceinline__

constexpr size_t OFF_WIN   = 0;
constexpr size_t OFF_WUQ   = OFF_WIN   + (size_t)2176*1024*2;
constexpr size_t OFF_WUKV  = OFF_WUQ   + (size_t)768*256*2;
constexpr size_t OFF_WOUT  = OFF_WUKV  + (size_t)1024*256*2;
constexpr size_t OFF_WPOOL = OFF_WOUT  + (size_t)1024*1024*2;
constexpr size_t OFF_WGU   = OFF_WPOOL + (size_t)4*256*256*2;
constexpr size_t OFF_WDN   = OFF_WGU   + (size_t)2*5632*1024*2;
constexpr size_t OFF_MOD   = OFF_WDN   + (size_t)2*1024*2816*2;
constexpr size_t OFF_R1    = OFF_MOD   + (size_t)2*3*6144*4;
constexpr size_t OFF_R2    = OFF_R1    + (size_t)8192*2096*4;
constexpr size_t OFF_H     = OFF_R2    + (size_t)8192*1024*4;
constexpr size_t OFF_CAT   = OFF_H     + (size_t)8192*1024*2;
constexpr size_t OFF_Q     = OFF_CAT   + (size_t)8192*1024*2;
constexpr size_t OFF_KN    = OFF_Q     + (size_t)8192*768*2;
constexpr size_t OFF_VT    = OFF_KN    + (size_t)8704*512*2;
constexpr size_t OFF_CQN   = OFF_VT    + (size_t)8704*512*2;
constexpr size_t OFF_CKV   = OFF_CQN   + (size_t)8192*256*2;
constexpr size_t OFF_KPE   = OFF_CKV   + (size_t)8704*256*2;
constexpr size_t OFF_XS    = OFF_KPE   + (size_t)8704*32*2;
constexpr size_t OFF_XST   = OFF_XS    + (size_t)8192*512*2;
constexpr size_t OFF_BM    = OFF_XST   + (size_t)8192*512*2;
constexpr size_t OFF_BT    = OFF_BM    + (size_t)8192*256*2;
constexpr size_t OFF_CM    = OFF_BT    + (size_t)8192*256*2;
constexpr size_t OFF_DTV   = OFF_CM    + (size_t)8192*256*2;
constexpr size_t OFF_CUM   = OFF_DTV   + (size_t)2*8192*8*4;
constexpr size_t OFF_TOT   = OFF_CUM   + (size_t)2*8192*8*4;
constexpr size_t OFF_BAR   = OFF_TOT   + 4096;
constexpr size_t OFF_XR    = OFF_BAR   + 16384;
constexpr size_t OFF_END   = OFF_XR    + (size_t)8192*1024*2;
static_assert(OFF_END <= ((size_t)256 << 20), "workspace map exceeds 256 MiB");

constexpr size_t OUT_CKV = 8388608, OUT_KR = 9437184, OUT_SF = 9568256, OUT_SB = 10616832;

struct P {
  const float *x_prompt, *x_sample, *c, *cache_ckv, *cache_kr, *st_f, *st_b, *c_ctx;
  const float *w_mod, *b_mod, *n_pre_mix, *n_post_mix, *n_pre_ffn, *n_post_ffn;
  const float *w_in, *q_norm, *w_uq, *kv_norm, *w_ukv, *conv_w, *conv_b, *dtb_f, *dtb_b, *alog_f, *alog_b;
  const float *ssd_d, *ssd_norm, *w_out, *pool_w, *pool_scale, *w_gate, *w_up, *w_down;
  float* out;
  char* ws;
};

#define WSB(off) ((bf16_t*)(p.ws + (off)))
#define WSF(off) ((float*)(p.ws + (off)))

typedef __bf16 hwbf16x2 __attribute__((ext_vector_type(2)));
typedef float hwf32x2 __attribute__((ext_vector_type(2)));
DEVI bf16_t f2bf(float f) {
  __bf16 r = (__bf16)f;
  return __builtin_bit_cast(bf16_t, r);
}
DEVI float bf2f(bf16_t b) { return __uint_as_float(((unsigned)b) << 16); }
DEVI unsigned pack2(float a, float b) {
  hwf32x2 v = {a, b};
  hwbf16x2 r = __builtin_convertvector(v, hwbf16x2);
  return __builtin_bit_cast(unsigned, r);
}
DEVI float silu(float x) { return x / (1.f + __expf(-x)); }
DEVI float wave_sum(float v) {
#pragma unroll
  for (int o = 32; o > 0; o >>= 1) v += __shfl_xor(v, o, 64);
  return v;
}
DEVI f32x4 mfma16(bf16x8 a, bf16x8 b, f32x4 c) { return __builtin_amdgcn_mfma_f32_16x16x32_bf16(a, b, c, 0, 0, 0); }

DEVI float rope_freq(int m) { return exp2f(-(float)m * 1.6609640474436813f); }
DEVI void fast_sincos(float ang, float& sn, float& cs) {
  float rev = ang * 0.15915494309189535f;
  rev -= rintf(rev);
  sn = __builtin_amdgcn_sinf(rev);
  cs = __builtin_amdgcn_cosf(rev);
}
typedef unsigned hwu32x2 __attribute__((ext_vector_type(2)));
DEVI float quad_max(float x) {
  hwu32x2 r = __builtin_amdgcn_permlane16_swap(__float_as_uint(x), __float_as_uint(x), false, false);
  x = fmaxf(__uint_as_float(r[0]), __uint_as_float(r[1]));
  r = __builtin_amdgcn_permlane32_swap(__float_as_uint(x), __float_as_uint(x), false, false);
  return fmaxf(__uint_as_float(r[0]), __uint_as_float(r[1]));
}
DEVI float quad_sum(float x) {
  hwu32x2 r = __builtin_amdgcn_permlane16_swap(__float_as_uint(x), __float_as_uint(x), false, false);
  x = __uint_as_float(r[0]) + __uint_as_float(r[1]);
  r = __builtin_amdgcn_permlane32_swap(__float_as_uint(x), __float_as_uint(x), false, false);
  return __uint_as_float(r[0]) + __uint_as_float(r[1]);
}
#define VB ((int)(threadIdx.x >> 8))
#define VT_PAIRG (gridDim.x == 256u)
#define VT_FIRST ((int)(VT_PAIRG ? blockIdx.x : blockIdx.x * 2u))
#define VT_OFF ((int)(VT_PAIRG ? VB * gridDim.x : VB))
DEVI int opaque_tid() { int t = threadIdx.x & 255; asm volatile("" : "+v"(t)); return t; }
DEVI int swz_tile(int t, int T) {
  int q = T >> 3, r = T & 7, x = t & 7, off = t >> 3;
  return (x < r ? x * (q + 1) : r * (q + 1) + (x - r) * q) + off;
}

__shared__ __attribute__((aligned(16))) char g_smem[2 * 73728];
#define NOINL __device__ __forceinline__

constexpr int LDT = 72;
constexpr int TILE_E = 128 * LDT;

template <class Epi>
DEVI void gemm_tile(const bf16_t* __restrict__ A, int lda, const bf16_t* __restrict__ B, int ldb, int K,
                    int m0, int n0, char* smem, Epi epi) {
  const int tid = opaque_tid(), lane = tid & 63, wave = tid >> 6, wm = wave >> 1, wn = wave & 1;
  const int lr = lane & 15, lg = lane >> 4;
  bf16_t* sA = (bf16_t*)smem;
  bf16_t* sB = sA + 2 * TILE_E;
  f32x4 acc[4][4];
#pragma unroll
  for (int i = 0; i < 4; ++i)
#pragma unroll
    for (int j = 0; j < 4; ++j) acc[i][j] = (f32x4){0.f, 0.f, 0.f, 0.f};
  const int lrow = tid >> 3, lkc = (tid & 7) * 8;
  const bf16_t* gA = A + (size_t)(m0 + lrow) * lda + lkc;
  const bf16_t* gB = B + (size_t)(n0 + lrow) * ldb + lkc;
  uint4 ra[4], rb[4];
#pragma unroll
  for (int i = 0; i < 4; ++i) {
    ra[i] = *(const uint4*)(gA + (size_t)(32 * i) * lda);
    rb[i] = *(const uint4*)(gB + (size_t)(32 * i) * ldb);
  }
#pragma unroll
  for (int i = 0; i < 4; ++i) {
    *(uint4*)(sA + (lrow + 32 * i) * LDT + lkc) = ra[i];
    *(uint4*)(sB + (lrow + 32 * i) * LDT + lkc) = rb[i];
  }
  __syncthreads();
  const int nk = K >> 6;
  for (int kt = 0; kt < nk; ++kt) {
    const int cur = kt & 1;
    if (kt + 1 < nk) {
      const int k0 = (kt + 1) << 6;
#pragma unroll
      for (int i = 0; i < 4; ++i) {
        ra[i] = *(const uint4*)(gA + (size_t)(32 * i) * lda + k0);
        rb[i] = *(const uint4*)(gB + (size_t)(32 * i) * ldb + k0);
      }
    }
    const bf16_t* cA = sA + cur * TILE_E + (wm * 64 + lr) * LDT + lg * 8;
    const bf16_t* cB = sB + cur * TILE_E + (wn * 64 + lr) * LDT + lg * 8;
#pragma unroll
    for (int ks = 0; ks < 2; ++ks) {
      bf16x8 af[4], bfr[4];
#pragma unroll
      for (int i = 0; i < 4; ++i) {
        af[i] = *(const bf16x8*)(cA + i * 16 * LDT + ks * 32);
        bfr[i] = *(const bf16x8*)(cB + i * 16 * LDT + ks * 32);
      }
#pragma unroll
      for (int i = 0; i < 4; ++i)
#pragma unroll
        for (int j = 0; j < 4; ++j) acc[i][j] = mfma16(af[i], bfr[j], acc[i][j]);
    }
    if (kt + 1 < nk) {
      const int nx = cur ^ 1;
#pragma unroll
      for (int i = 0; i < 4; ++i) {
        *(uint4*)(sA + nx * TILE_E + (lrow + 32 * i) * LDT + lkc) = ra[i];
        *(uint4*)(sB + nx * TILE_E + (lrow + 32 * i) * LDT + lkc) = rb[i];
      }
    }
    __syncthreads();
  }
#pragma unroll
  for (int i = 0; i < 4; ++i)
#pragma unroll
    for (int j = 0; j < 4; j += 2)
      epi(m0 + wm * 64 + i * 16 + lg * 4, n0 + wn * 64 + j * 16 + lr, acc[i][j], acc[i][j + 1]);
}

struct TileInfo { const bf16_t* a; const bf16_t* b; int m0, n0, ctx; };
template <class TileFn, class Epi>
DEVI void gemm_stream(int T, int lda, int ldb, int K, char* smem, TileFn tf, Epi epi) {
  int t0 = VT_FIRST;
  if (t0 >= T) return;
  int t = min(t0 + VT_OFF, T - 1);
  const int tid = opaque_tid(), lane = tid & 63, wave = tid >> 6, wm = wave >> 1, wn = wave & 1;
  const int lr = lane & 15, lg = lane >> 4;
  bf16_t* sA = (bf16_t*)smem;
  bf16_t* sB = sA + 2 * TILE_E;
  const int lrow = tid >> 3, lkc = (tid & 7) * 8;
  TileInfo ti = tf(t);
  const bf16_t* gA = ti.a + (size_t)lrow * lda + lkc;
  const bf16_t* gB = ti.b + (size_t)lrow * ldb + lkc;
  int m0 = ti.m0, n0 = ti.n0, ctx = ti.ctx;
  uint4 ra0, ra1, ra2, ra3, rb0, rb1, rb2, rb3;
  uint4 rc0, rc1, rc2, rc3, rd0, rd1, rd2, rd3;
#define GS_LOAD0(pa, pb) \
  ra0 = *(const uint4*)((pa)); ra1 = *(const uint4*)((pa) + (size_t)32 * lda); \
  ra2 = *(const uint4*)((pa) + (size_t)64 * lda); ra3 = *(const uint4*)((pa) + (size_t)96 * lda); \
  rb0 = *(const uint4*)((pb)); rb1 = *(const uint4*)((pb) + (size_t)32 * ldb); \
  rb2 = *(const uint4*)((pb) + (size_t)64 * ldb); rb3 = *(const uint4*)((pb) + (size_t)96 * ldb);
#define GS_LOAD1(pa, pb) \
  rc0 = *(const uint4*)((pa)); rc1 = *(const uint4*)((pa) + (size_t)32 * lda); \
  rc2 = *(const uint4*)((pa) + (size_t)64 * lda); rc3 = *(const uint4*)((pa) + (size_t)96 * lda); \
  rd0 = *(const uint4*)((pb)); rd1 = *(const uint4*)((pb) + (size_t)32 * ldb); \
  rd2 = *(const uint4*)((pb) + (size_t)64 * ldb); rd3 = *(const uint4*)((pb) + (size_t)96 * ldb);
#define GS_WRITE0(buf) { \
  bf16_t* wa = sA + (buf) * TILE_E + lrow * LDT + lkc; bf16_t* wb = sB + (buf) * TILE_E + lrow * LDT + lkc; \
  *(uint4*)(wa) = ra0; *(uint4*)(wa + 32 * LDT) = ra1; *(uint4*)(wa + 64 * LDT) = ra2; *(uint4*)(wa + 96 * LDT) = ra3; \
  *(uint4*)(wb) = rb0; *(uint4*)(wb + 32 * LDT) = rb1; *(uint4*)(wb + 64 * LDT) = rb2; *(uint4*)(wb + 96 * LDT) = rb3; }
#define GS_WRITE1(buf) { \
  bf16_t* wa = sA + (buf) * TILE_E + lrow * LDT + lkc; bf16_t* wb = sB + (buf) * TILE_E + lrow * LDT + lkc; \
  *(uint4*)(wa) = rc0; *(uint4*)(wa + 32 * LDT) = rc1; *(uint4*)(wa + 64 * LDT) = rc2; *(uint4*)(wa + 96 * LDT) = rc3; \
  *(uint4*)(wb) = rd0; *(uint4*)(wb + 32 * LDT) = rd1; *(uint4*)(wb + 64 * LDT) = rd2; *(uint4*)(wb + 96 * LDT) = rd3; }
#define GS_COMPUTE(buf) { \
    const bf16_t* cA = sA + (buf) * TILE_E + (wm * 64 + lr) * LDT + lg * 8; \
    const bf16_t* cB = sB + (buf) * TILE_E + (wn * 64 + lr) * LDT + lg * 8; \
    _Pragma("unroll") for (int ks = 0; ks < 2; ++ks) { \
      bf16x8 af[4], bfr[4]; \
      _Pragma("unroll") for (int i = 0; i < 4; ++i) { \
        af[i] = *(const bf16x8*)(cA + i * 16 * LDT + ks * 32); \
        bfr[i] = *(const bf16x8*)(cB + i * 16 * LDT + ks * 32); \
      } \
      __builtin_amdgcn_s_setprio(1); \
      _Pragma("unroll") for (int i = 0; i < 4; ++i) \
        _Pragma("unroll") for (int j = 0; j < 4; ++j) acc[i][j] = mfma16(af[i], bfr[j], acc[i][j]); \
      __builtin_amdgcn_s_setprio(0); \
    } }
  GS_LOAD0(gA, gB)
  GS_WRITE0(0)
  GS_LOAD1(gA + 64, gB + 64)
  __syncthreads();
  const int nk = K >> 6;
  for (;;) {
    f32x4 acc[4][4];
#pragma unroll
    for (int i = 0; i < 4; ++i)
#pragma unroll
      for (int j = 0; j < 4; ++j) acc[i][j] = (f32x4){0.f, 0.f, 0.f, 0.f};
    const int t0n = t0 + gridDim.x * 2;
    const bool have_next = t0n < T;
    const int tn = min(t0n + VT_OFF, T - 1);
    const bf16_t *nA = gA, *nB = gB;
    int nm0 = 0, nn0 = 0, nctx = 0;
    if (have_next) {
      const TileInfo tj = tf(tn);
      nA = tj.a + (size_t)lrow * lda + lkc;
      nB = tj.b + (size_t)lrow * ldb + lkc;
      nm0 = tj.m0; nn0 = tj.n0; nctx = tj.ctx;
    }
    for (int kt = 0; kt < nk; kt += 2) {
      {
        const bool wrap = (kt + 2 >= nk);
        const bf16_t* pa = wrap ? nA : gA + ((kt + 2) << 6);
        const bf16_t* pb = wrap ? nB : gB + ((kt + 2) << 6);
        GS_LOAD0(pa, pb)
        GS_COMPUTE(0)
        GS_WRITE1(1)
        __syncthreads();
      }
      {
        const bool wrap = (kt + 3 >= nk);
        const bf16_t* pa = wrap ? nA + 64 : gA + ((kt + 3) << 6);
        const bf16_t* pb = wrap ? nB + 64 : gB + ((kt + 3) << 6);
        GS_LOAD1(pa, pb)
        GS_COMPUTE(1)
        GS_WRITE0(0)
        __syncthreads();
      }
    }
#pragma unroll
    for (int i = 0; i < 4; ++i)
#pragma unroll
      for (int j = 0; j < 4; j += 2)
        epi(ctx, m0 + wm * 64 + i * 16 + lg * 4, n0 + wn * 64 + j * 16 + lr, acc[i][j], acc[i][j + 1]);
    if (!have_next) break;
    t = tn; t0 = t0n; gA = nA; gB = nB; m0 = nm0; n0 = nn0; ctx = nctx;
  }
}

constexpr int T8_E = 256 * LDT;
template <class TileFn, class Epi>
DEVI void gemm8_stream(int T, int lda, int ldb, int K, TileFn tf, Epi epi) {
  int t = blockIdx.x;
  if (t >= T) return;
  int tid = threadIdx.x; asm volatile("" : "+v"(tid));
  const int lane = tid & 63, wave = tid >> 6, wr = wave >> 2, wc = wave & 3;
  const int lr = lane & 15, lg = lane >> 4;
  bf16_t* sA = (bf16_t*)g_smem;
  bf16_t* sB = sA + 2 * T8_E;
  const int lrow = tid >> 3, lkc = (tid & 7) * 8;
  TileInfo ti = tf(t);
  const unsigned offA = ((unsigned)lrow * (unsigned)lda + (unsigned)lkc) * 2u;
  const unsigned offB = ((unsigned)lrow * (unsigned)ldb + (unsigned)lkc) * 2u;
  const char* gA = (const char*)ti.a;
  const char* gB = (const char*)ti.b;
  const size_t rsA = (size_t)64 * lda * 2, rsB = (size_t)64 * ldb * 2;
  int m0 = ti.m0, n0 = ti.n0, ctx = ti.ctx;
  uint4 ra0, ra1, ra2, ra3, rb0, rb1, rb2, rb3;
  uint4 rc0, rc1, rc2, rc3, rd0, rd1, rd2, rd3;
#define G8_LOAD(pa, pb) \
  ra0 = *(const uint4*)((pa) + offA); ra1 = *(const uint4*)((pa) + rsA + offA); \
  ra2 = *(const uint4*)((pa) + 2 * rsA + offA); ra3 = *(const uint4*)((pa) + 3 * rsA + offA); \
  rb0 = *(const uint4*)((pb) + offB); rb1 = *(const uint4*)((pb) + rsB + offB); \
  rb2 = *(const uint4*)((pb) + 2 * rsB + offB); rb3 = *(const uint4*)((pb) + 3 * rsB + offB);
#define G8_WRITE(buf) { \
  bf16_t* wa = sA + (buf) * T8_E + lrow * LDT + lkc; bf16_t* wb = sB + (buf) * T8_E + lrow * LDT + lkc; \
  *(uint4*)(wa) = ra0; *(uint4*)(wa + 64 * LDT) = ra1; *(uint4*)(wa + 128 * LDT) = ra2; *(uint4*)(wa + 192 * LDT) = ra3; \
  *(uint4*)(wb) = rb0; *(uint4*)(wb + 64 * LDT) = rb1; *(uint4*)(wb + 128 * LDT) = rb2; *(uint4*)(wb + 192 * LDT) = rb3; }
#define G8_LOAD1(pa, pb) \
  rc0 = *(const uint4*)((pa) + offA); rc1 = *(const uint4*)((pa) + rsA + offA); \
  rc2 = *(const uint4*)((pa) + 2 * rsA + offA); rc3 = *(const uint4*)((pa) + 3 * rsA + offA); \
  rd0 = *(const uint4*)((pb) + offB); rd1 = *(const uint4*)((pb) + rsB + offB); \
  rd2 = *(const uint4*)((pb) + 2 * rsB + offB); rd3 = *(const uint4*)((pb) + 3 * rsB + offB);
#define G8_WRITE1(buf) { \
  bf16_t* wa = sA + (buf) * T8_E + lrow * LDT + lkc; bf16_t* wb = sB + (buf) * T8_E + lrow * LDT + lkc; \
  *(uint4*)(wa) = rc0; *(uint4*)(wa + 64 * LDT) = rc1; *(uint4*)(wa + 128 * LDT) = rc2; *(uint4*)(wa + 192 * LDT) = rc3; \
  *(uint4*)(wb) = rd0; *(uint4*)(wb + 64 * LDT) = rd1; *(uint4*)(wb + 128 * LDT) = rd2; *(uint4*)(wb + 192 * LDT) = rd3; }
#define G8_COMPUTE(buf) { \
      const bf16_t* cA = sA + (buf) * T8_E + (wr * 128 + lr) * LDT + lg * 8; \
      const bf16_t* cB = sB + (buf) * T8_E + (wc * 64 + lr) * LDT + lg * 8; \
      _Pragma("unroll") for (int ks = 0; ks < 2; ++ks) { \
        bf16x8 bfr[4]; \
        _Pragma("unroll") for (int j = 0; j < 4; ++j) bfr[j] = *(const bf16x8*)(cB + j * 16 * LDT + ks * 32); \
        _Pragma("unroll") for (int h = 0; h < 2; ++h) { \
          bf16x8 af[4]; \
          _Pragma("unroll") for (int i = 0; i < 4; ++i) af[i] = *(const bf16x8*)(cA + (h * 4 + i) * 16 * LDT + ks * 32); \
          __builtin_amdgcn_s_setprio(1); \
          _Pragma("unroll") for (int i = 0; i < 4; ++i) \
            _Pragma("unroll") for (int j = 0; j < 4; ++j) acc[h * 4 + i][j] = mfma16(af[i], bfr[j], acc[h * 4 + i][j]); \
          __builtin_amdgcn_s_setprio(0); \
          __builtin_amdgcn_sched_barrier(0); \
        } \
      } }
  G8_LOAD(gA, gB)
  G8_WRITE(0)
  G8_LOAD1(gA + 128, gB + 128)
  __syncthreads();
  const int nk = K >> 6;
  for (;;) {
    f32x4 acc[8][4];
#pragma unroll
    for (int i = 0; i < 8; ++i)
#pragma unroll
      for (int j = 0; j < 4; ++j) acc[i][j] = (f32x4){0.f, 0.f, 0.f, 0.f};
    const int tn = t + gridDim.x;
    const bool have_next = tn < T;
    const char *nA = gA, *nB = gB;
    int nm0 = 0, nn0 = 0, nctx = 0;
    if (have_next) {
      const TileInfo tj = tf(tn);
      nA = (const char*)tj.a;
      nB = (const char*)tj.b;
      nm0 = tj.m0; nn0 = tj.n0; nctx = tj.ctx;
    }
#pragma unroll 1
    for (int kt = 0; kt < nk; kt += 2) {
      {
        const bool wrap = (kt + 2 >= nk);
        const char* pa = wrap ? nA : gA + ((kt + 2) << 7);
        const char* pb = wrap ? nB : gB + ((kt + 2) << 7);
        G8_LOAD(pa, pb)
        G8_COMPUTE(0)
        G8_WRITE1(1)
        __syncthreads();
      }
      {
        const bool wrap = (kt + 3 >= nk);
        const char* pa = wrap ? nA + 128 : gA + ((kt + 3) << 7);
        const char* pb = wrap ? nB + 128 : gB + ((kt + 3) << 7);
        G8_LOAD1(pa, pb)
        G8_COMPUTE(1)
        G8_WRITE(0)
        __syncthreads();
      }
    }
#pragma unroll
    for (int i = 0; i < 8; ++i)
#pragma unroll
      for (int j = 0; j < 4; j += 2)
        epi(ctx, m0 + wr * 128 + i * 16 + lg * 4, n0 + wc * 64 + j * 16 + lr, acc[i][j], acc[i][j + 1]);
    if (!have_next) break;
    t = tn; gA = nA; gB = nB; m0 = nm0; n0 = nn0; ctx = nctx;
  }
}

DEVI void tile_mn(int t, int nM, int nN, int& m, int& n) {
  int id = swz_tile(t, nM * nN);
  int per = 8 * nN;
  int gq = id / per, rem = id - gq * per;
  int gsz = min(8, nM - gq * 8);
  m = gq * 8 + rem % gsz;
  n = rem / gsz;
}

NOINL void gemv_tile(const P& p, int t) {
  char* smem = g_smem + VB * 73728;
  const int tid = opaque_tid();
  float* sv = (float*)smem;
  float* red = sv + 3072;
  const int l = t / 192, n0 = (t % 192) * 32;
  for (int i = tid; i < 3072; i += 256) {
    int v = i >> 10, k = i & 1023;
    float cv = (v == 0) ? p.c_ctx[k] : p.c[(v - 1) * 1024 + k];
    sv[i] = cv / (1.f + expf(-cv));
  }
  __syncthreads();
  const int cgp = tid & 7, ks = tid >> 3;
  const float* w = p.w_mod + (size_t)l * 1024 * 6144 + n0 + cgp * 4;
  float a0[4] = {0, 0, 0, 0}, a1[4] = {0, 0, 0, 0}, a2[4] = {0, 0, 0, 0};
#pragma unroll 16
  for (int kk = 0; kk < 32; ++kk) {
    const int k = ks * 32 + kk;
    const float4 wv = *(const float4*)(w + (size_t)k * 6144);
    const float s0 = sv[k], s1 = sv[1024 + k], s2 = sv[2048 + k];
    a0[0] += s0 * wv.x; a0[1] += s0 * wv.y; a0[2] += s0 * wv.z; a0[3] += s0 * wv.w;
    a1[0] += s1 * wv.x; a1[1] += s1 * wv.y; a1[2] += s1 * wv.z; a1[3] += s1 * wv.w;
    a2[0] += s2 * wv.x; a2[1] += s2 * wv.y; a2[2] += s2 * wv.z; a2[3] += s2 * wv.w;
  }
#pragma unroll
  for (int j = 0; j < 4; ++j) {
    red[(ks * 3 + 0) * 32 + cgp * 4 + j] = a0[j];
    red[(ks * 3 + 1) * 32 + cgp * 4 + j] = a1[j];
    red[(ks * 3 + 2) * 32 + cgp * 4 + j] = a2[j];
  }
  __syncthreads();
  if (tid < 96) {
    const int v = tid >> 5, col = tid & 31;
    float s = 0.f;
    for (int q = 0; q < 32; ++q) s += red[(q * 3 + v) * 32 + col];
    s += p.b_mod[l * 6144 + n0 + col];
    WSF(OFF_MOD)[(l * 3 + v) * 6144 + n0 + col] = s;
  }
  __syncthreads();
}

NOINL void transpose_tile(const P& p, int t) {
  char* smem = g_smem + VB * 73728;
  const int tid = opaque_tid();
  const float* src; bf16_t* dst; int K, N, ntn, mode = 0;
  if (t < 544) { src = p.w_in; dst = WSB(OFF_WIN); K = 1024; N = 2096; ntn = 34; }
  else if ((t -= 544) < 48) { src = p.w_uq; dst = WSB(OFF_WUQ); K = 256; N = 768; ntn = 12; }
  else if ((t -= 48) < 64) { src = p.w_ukv; dst = WSB(OFF_WUKV); K = 256; N = 1024; ntn = 16; }
  else if ((t -= 64) < 256) { src = p.w_out; dst = WSB(OFF_WOUT); K = 1024; N = 1024; ntn = 16; }
  else if ((t -= 256) < 64) { int g = t >> 4; t &= 15; src = p.pool_w + (size_t)g * 65536; dst = WSB(OFF_WPOOL) + (size_t)g * 65536; K = 256; N = 256; ntn = 4; }
  else if ((t -= 64) < 1408) { int l = t / 704; t -= l * 704; src = p.w_gate + (size_t)l * 1024 * 2816; dst = WSB(OFF_WGU) + (size_t)l * 5632 * 1024; K = 1024; N = 2816; ntn = 44; mode = 1; }
  else if ((t -= 1408) < 1408) { int l = t / 704; t -= l * 704; src = p.w_up + (size_t)l * 1024 * 2816; dst = WSB(OFF_WGU) + (size_t)l * 5632 * 1024; K = 1024; N = 2816; ntn = 44; mode = 2; }
  else { t -= 1408; int l = t / 704; t -= l * 704; src = p.w_down + (size_t)l * 2816 * 1024; dst = WSB(OFF_WDN) + (size_t)l * 1024 * 2816; K = 2816; N = 1024; ntn = 16; }
  const int kt = t / ntn, nt_ = t - kt * ntn;
  const int k0 = kt * 64, n0 = nt_ * 64;
  float* tile = (float*)smem;
  {
    const int nn = tid & 63, kk0 = tid >> 6;
    const int n = n0 + nn;
    const int nc = n < N ? n : N - 1;
    float v[16];
#pragma unroll
    for (int i = 0; i < 16; ++i) v[i] = src[(size_t)(k0 + kk0 + 4 * i) * N + nc];
#pragma unroll
    for (int i = 0; i < 16; ++i) tile[(kk0 + 4 * i) * 65 + nn] = (n < N) ? v[i] : 0.f;
  }
  __syncthreads();
#pragma unroll
  for (int i = 0; i < 2; ++i) {
    const int id = tid + 256 * i;
    const int nn = id >> 3, kc = id & 7;
    const int n = n0 + nn;
    uint4 pk;
    pk.x = pack2(tile[(kc * 8 + 0) * 65 + nn], tile[(kc * 8 + 1) * 65 + nn]);
    pk.y = pack2(tile[(kc * 8 + 2) * 65 + nn], tile[(kc * 8 + 3) * 65 + nn]);
    pk.z = pack2(tile[(kc * 8 + 4) * 65 + nn], tile[(kc * 8 + 5) * 65 + nn]);
    pk.w = pack2(tile[(kc * 8 + 6) * 65 + nn], tile[(kc * 8 + 7) * 65 + nn]);
    int drow = n;
    if (mode == 1) drow = (n >> 4) * 32 + (n & 15);
    else if (mode == 2) drow = (n >> 4) * 32 + 16 + (n & 15);
    *(uint4*)(dst + (size_t)drow * K + k0 + kc * 8) = pk;
  }
  __syncthreads();
}

template <bool UPD, bool MOD, bool FIRST, bool LASTW, bool TWO, bool POOL = false>
DEVI void rowop(const P& p, const bf16_t* msrc, const bf16_t* msrc2, const float* wpost, int gate_idx, const float* wpre, int shift_idx,
                int scale_idx, int layer_g, int layer_m) {
  const int lane = threadIdx.x & 63, wave = threadIdx.x >> 6;
  const float* modg = WSF(OFF_MOD) + (size_t)layer_g * 3 * 6144;
  const float* modm = WSF(OFF_MOD) + (size_t)layer_m * 3 * 6144;
  bf16_t* hbuf = WSB(OFF_H);
  for (int r = blockIdx.x * 8 + wave; r < 8192; r += gridDim.x * 8) {
    const int v = r < 4096 ? 0 : 1 + ((r - 4096) >> 11);
    const float* mvg = modg + v * 6144;
    const float* mvm = modm + v * 6144;
    float4 x[4];
    if (FIRST) {
      const float* xin = r < 4096 ? p.x_prompt + (size_t)r * 1024 : p.x_sample + (size_t)(r - 4096) * 1024;
#pragma unroll
      for (int i = 0; i < 4; ++i) x[i] = *(const float4*)(xin + lane * 4 + 256 * i);
    } else {
#pragma unroll
      for (int i = 0; i < 4; ++i) {
        const uint2 xb = *(const uint2*)(WSB(OFF_XR) + (size_t)r * 1024 + lane * 4 + 256 * i);
        x[i].x = __uint_as_float(xb.x << 16); x[i].y = __uint_as_float(xb.x & 0xffff0000u);
        x[i].z = __uint_as_float(xb.y << 16); x[i].w = __uint_as_float(xb.y & 0xffff0000u);
      }
    }
    if (UPD) {
      float4 m[4];
      float ss = 0.f;
      int ps0 = 0, pL = 0;
      if (POOL) { if (r < 4096) { ps0 = r & ~255; pL = 256; } else { ps0 = 4096 + ((r - 4096) & ~2047); pL = 2048; } }
#pragma unroll
      for (int i = 0; i < 4; ++i) {
        if (POOL) {
          constexpr int dummy = 0; (void)dummy;
          const int W2 = 1 << i;
          const int t = r - ps0;
          const int lo = max(t - W2, 0), hi = min(t + W2, pL);
          float a0 = 0.f, a1 = 0.f, a2 = 0.f, a3 = 0.f;
          uint2 ctr = make_uint2(0u, 0u);
#pragma unroll
          for (int k = 0; k < 2 * W2; ++k) {
            const int u = t - W2 + k;
            const int uc = min(max(u, 0), pL - 1);
            const uint2 g = *(const uint2*)(msrc + (size_t)(ps0 + uc) * 1024 + lane * 4 + 256 * i);
            const float w = (u >= 0 && u < pL) ? 1.f : 0.f;
            a0 += w * __uint_as_float(g.x << 16); a1 += w * __uint_as_float(g.x & 0xffff0000u);
            a2 += w * __uint_as_float(g.y << 16); a3 += w * __uint_as_float(g.y & 0xffff0000u);
            if (k == W2) ctr = g;
          }
          const float inv = 1.f / (float)(hi - lo);
          m[i].x = a0 * inv - __uint_as_float(ctr.x << 16); m[i].y = a1 * inv - __uint_as_float(ctr.x & 0xffff0000u);
          m[i].z = a2 * inv - __uint_as_float(ctr.y << 16); m[i].w = a3 * inv - __uint_as_float(ctr.y & 0xffff0000u);
          ss += m[i].x * m[i].x + m[i].y * m[i].y + m[i].z * m[i].z + m[i].w * m[i].w;
          continue;
        }
        const uint2 mb = *(const uint2*)(msrc + (size_t)r * 1024 + lane * 4 + 256 * i);
        m[i].x = __uint_as_float(mb.x << 16); m[i].y = __uint_as_float(mb.x & 0xffff0000u);
        m[i].z = __uint_as_float(mb.y << 16); m[i].w = __uint_as_float(mb.y & 0xffff0000u);
        if (TWO) {
          const uint2 mc = *(const uint2*)(msrc2 + (size_t)r * 1024 + lane * 4 + 256 * i);
          m[i].x += __uint_as_float(mc.x << 16); m[i].y += __uint_as_float(mc.x & 0xffff0000u);
          m[i].z += __uint_as_float(mc.y << 16); m[i].w += __uint_as_float(mc.y & 0xffff0000u);
        }
        ss += m[i].x * m[i].x + m[i].y * m[i].y + m[i].z * m[i].z + m[i].w * m[i].w;
      }
      ss = wave_sum(ss);
      const float rs = rsqrtf(ss * (1.f / 1024.f) + 1e-6f);
#pragma unroll
      for (int i = 0; i < 4; ++i) {
        const int col = lane * 4 + 256 * i;
        const float4 wp = *(const float4*)(wpost + col);
        const float4 g = *(const float4*)(mvg + gate_idx * 1024 + col);
        x[i].x += g.x * (m[i].x * rs * wp.x);
        x[i].y += g.y * (m[i].y * rs * wp.y);
        x[i].z += g.z * (m[i].z * rs * wp.z);
        x[i].w += g.w * (m[i].w * rs * wp.w);
        if (LASTW) *(float4*)(p.out + (size_t)r * 1024 + col) = x[i];
        else {
          uint2 xo;
          xo.x = pack2(x[i].x, x[i].y);
          xo.y = pack2(x[i].z, x[i].w);
          *(uint2*)(WSB(OFF_XR) + (size_t)r * 1024 + col) = xo;
        }
      }
    }
    if (MOD) {
      float ss = 0.f;
#pragma unroll
      for (int i = 0; i < 4; ++i) ss += x[i].x * x[i].x + x[i].y * x[i].y + x[i].z * x[i].z + x[i].w * x[i].w;
      ss = wave_sum(ss);
      const float rs = rsqrtf(ss * (1.f / 1024.f) + 1e-6f);
#pragma unroll
      for (int i = 0; i < 4; ++i) {
        const int col = lane * 4 + 256 * i;
        const float4 wp = *(const float4*)(wpre + col);
        const float4 sh = *(const float4*)(mvm + shift_idx * 1024 + col);
        const float4 sc = *(const float4*)(mvm + scale_idx * 1024 + col);
        uint2 o;
        o.x = pack2(x[i].x * rs * wp.x * (1.f + sc.x) + sh.x, x[i].y * rs * wp.y * (1.f + sc.y) + sh.y);
        o.y = pack2(x[i].z * rs * wp.z * (1.f + sc.z) + sh.z, x[i].w * rs * wp.w * (1.f + sc.w) + sh.w);
        *(uint2*)(hbuf + (size_t)r * 1024 + col) = o;
      }
    }
  }
}

NOINL void prep_rows(const P& p) {
  const int lane = threadIdx.x & 63, wave = threadIdx.x >> 6;
  const float* proj = WSF(OFF_R1);
  for (int r = blockIdx.x * 8 + wave; r < 8192; r += gridDim.x * 8) {
    const float* pr = proj + (size_t)r * 2096;
    const int kvrow = r < 4096 ? r : 4096 + ((r - 4096) >> 11) * 2304 + 256 + ((r - 4096) & 2047);
    const float4 ld_cq = *(const float4*)(pr + lane * 4);
    const float4 ld_ckv = *(const float4*)(pr + 256 + lane * 4);
    const float ld_kpe = pr[512 + (lane & 31)];
    const float ld_dt = pr[2080 + (lane & 15)];
    {
      const float4 a = ld_cq;
      float ss = wave_sum(a.x * a.x + a.y * a.y + a.z * a.z + a.w * a.w);
      const float rs = rsqrtf(ss * (1.f / 256.f) + 1e-6f);
      const float4 g = *(const float4*)(p.q_norm + lane * 4);
      uint2 o;
      o.x = pack2(a.x * rs * g.x, a.y * rs * g.y);
      o.y = pack2(a.z * rs * g.z, a.w * rs * g.w);
      *(uint2*)(WSB(OFF_CQN) + (size_t)r * 256 + lane * 4) = o;
    }
    {
      const float4 a = ld_ckv;
      float ss = wave_sum(a.x * a.x + a.y * a.y + a.z * a.z + a.w * a.w);
      const float rs = rsqrtf(ss * (1.f / 256.f) + 1e-6f);
      const float4 g = *(const float4*)(p.kv_norm + lane * 4);
      float4 vv;
      vv.x = a.x * rs * g.x; vv.y = a.y * rs * g.y; vv.z = a.z * rs * g.z; vv.w = a.w * rs * g.w;
      if (r < 4096) *(float4*)(p.out + OUT_CKV + (size_t)r * 256 + lane * 4) = vv;
      uint2 o;
      o.x = pack2(vv.x, vv.y);
      o.y = pack2(vv.z, vv.w);
      *(uint2*)(WSB(OFF_CKV) + (size_t)kvrow * 256 + lane * 4) = o;
    }
    {
      const float kv = (lane < 32) ? ld_kpe : 0.f;
      const float partner = __shfl_xor(kv, 16, 64);
      if (r < 4096) {
        if (lane < 32) {
          p.out[OUT_KR + (size_t)r * 32 + lane] = kv;
          WSB(OFF_KPE)[(size_t)kvrow * 32 + lane] = f2bf(kv);
        }
      } else {
        const int t = (r - 4096) & 2047;
        const int ii = lane & 15;
        const float pos = (ii < 8) ? (float)(t >> 6) : (float)(t & 63);
        const float fr = rope_freq(ii & 7);
        const float ang = pos * fr;
        float cs, sn;
        fast_sincos(ang, sn, cs);
        const float o = (lane < 16) ? (kv * cs - partner * sn) : (partner * sn + kv * cs);
        if (lane < 32) WSB(OFF_KPE)[(size_t)kvrow * 32 + lane] = f2bf(o);
      }
    }
    if (lane < 16) {
      const int dir = lane >> 3, hh = lane & 7;
      const float raw = ld_dt + (dir ? p.dtb_b[hh] : p.dtb_f[hh]);
      const float sp = raw > 20.f ? raw : log1pf(expf(raw));
      WSF(OFF_DTV)[((size_t)dir * 8192 + r) * 8 + hh] = sp;
    }
  }
}

NOINL void prep_cache(const P& p) {
  const int gt = blockIdx.x * 512 + threadIdx.x, gs = gridDim.x * 512;
  for (int i = gt; i < 2 * 256 * 256; i += gs) {
    int b = i >> 16, rem = i & 65535;
    WSB(OFF_CKV)[(size_t)(4096 + b * 2304) * 256 + rem] = f2bf(p.cache_ckv[i]);
  }
  for (int i = gt; i < 2 * 256 * 32; i += gs) {
    int b = i >> 13, rem = i & 8191;
    WSB(OFF_KPE)[(size_t)(4096 + b * 2304) * 32 + rem] = f2bf(p.cache_kr[i]);
  }
}

NOINL void conv_tile(const P& p, int t) {
  char* smem = g_smem + VB * 73728;
  const int tid = opaque_tid();
  float* sin_ = (float*)smem;
  float* sout = sin_ + 68 * 64;
  const int tt_ = t >> 4, ct = t & 15;
  const int r0 = tt_ * 64, c0 = ct * 64;
  int s0, s1;
  if (r0 < 4096) { s0 = r0 & ~255; s1 = s0 + 256; } else { s0 = 4096 + ((r0 - 4096) & ~2047); s1 = s0 + 2048; }
  const float* proj = WSF(OFF_R1);
  {
    const int rr0 = tid >> 6, cc = tid & 63;
    float v[17];
#pragma unroll
    for (int k = 0; k < 17; ++k) {
      const int r = r0 - 2 + rr0 + 4 * k;
      const int rc = r < s0 ? s0 : (r >= s1 ? s1 - 1 : r);
      v[k] = proj[(size_t)rc * 2096 + 1056 + c0 + cc];
    }
#pragma unroll
    for (int k = 0; k < 17; ++k) {
      const int r = r0 - 2 + rr0 + 4 * k;
      sin_[(rr0 + 4 * k) * 64 + cc] = (r >= s0 && r < s1) ? v[k] : 0.f;
    }
  }
  __syncthreads();
  {
    const int cc = tid & 63, tq = tid >> 6;
    const int c = c0 + cc;
    const float w0 = p.conv_w[c], w1 = p.conv_w[1024 + c], w2 = p.conv_w[2048 + c], w3 = p.conv_w[3072 + c],
                w4 = p.conv_w[4096 + c], bias = p.conv_b[c];
#pragma unroll 4
    for (int i = 0; i < 16; ++i) {
      const int tt = tq * 16 + i;
      float y = bias + w0 * sin_[tt * 64 + cc] + w1 * sin_[(tt + 1) * 64 + cc] + w2 * sin_[(tt + 2) * 64 + cc] +
                w3 * sin_[(tt + 3) * 64 + cc] + w4 * sin_[(tt + 4) * 64 + cc];
      y = y / (1.f + __expf(-y));
      sout[tt * 65 + cc] = y;
      const bf16_t b = f2bf(y);
      const size_t r = r0 + tt;
      if (c < 512) WSB(OFF_XS)[r * 512 + c] = b;
      else if (c < 768) WSB(OFF_BM)[r * 256 + (c - 512)] = b;
      else WSB(OFF_CM)[r * 256 + (c - 768)] = b;
    }
  }
  __syncthreads();
  if (c0 < 768) {
    const int cl = tid >> 2, q4 = tid & 3;
    uint4 o0, o1;
    const float* sp = sout + (q4 * 16) * 65 + cl;
    o0.x = pack2(sp[0 * 65], sp[1 * 65]);   o0.y = pack2(sp[2 * 65], sp[3 * 65]);
    o0.z = pack2(sp[4 * 65], sp[5 * 65]);   o0.w = pack2(sp[6 * 65], sp[7 * 65]);
    o1.x = pack2(sp[8 * 65], sp[9 * 65]);   o1.y = pack2(sp[10 * 65], sp[11 * 65]);
    o1.z = pack2(sp[12 * 65], sp[13 * 65]); o1.w = pack2(sp[14 * 65], sp[15 * 65]);
    bf16_t* dst = (c0 < 512) ? WSB(OFF_XST) + (size_t)(c0 + cl) * 8192 : WSB(OFF_BT) + (size_t)(c0 - 512 + cl) * 8192;
    dst += r0 + q4 * 16;
    *(uint4*)(dst) = o0;
    *(uint4*)(dst + 8) = o1;
  }
  __syncthreads();
}

NOINL void chunk_state_item(const P& p, int item) {
  char* smem = g_smem + VB * 73728;
  const int tid = opaque_tid(), lane = tid & 63, wave = tid >> 6, lr = lane & 15, lg = lane >> 4;
  const int cidx = item >> 3, hh = item & 7, g = hh >> 2;
  const int r0 = cidx * 128;
  constexpr int LDS_ = 136;
  bf16_t* sAs = (bf16_t*)smem;
  bf16_t* sBs = sAs + 2 * 64 * LDS_;
  float* fa = (float*)(sBs + 128 * LDS_);
  float* fcum = fa + 256;
  float* fw = fa + 512;
  float* fdt = fa + 768;
  {
    const int dir = tid >> 7, j = tid & 127;
    const float dt = WSF(OFF_DTV)[((size_t)dir * 8192 + r0 + j) * 8 + hh];
    const float Aco = -expf(dir ? p.alog_b[hh] : p.alog_f[hh]);
    fa[tid] = dt * Aco;
    fdt[tid] = dt;
  }
  __syncthreads();
  {
    const int dir = tid >> 7, j = tid & 127;
    float s = 0.f;
    const float4* fa4 = (const float4*)(fa + dir * 128);
    if (dir == 0) {
      const int nb = (j + 1) >> 2;
      for (int k4 = 0; k4 < nb; ++k4) { const float4 v = fa4[k4]; s += (v.x + v.y) + (v.z + v.w); }
      for (int k = nb * 4; k <= j; ++k) s += fa[k];
    } else {
      const int fb = (j + 3) >> 2;
      for (int k4 = 31; k4 >= fb; --k4) { const float4 v = fa4[k4]; s += (v.x + v.y) + (v.z + v.w); }
      for (int k = j; k < fb * 4; ++k) s += fa[128 + k];
    }
    fcum[tid] = s;
    WSF(OFF_CUM)[((size_t)dir * 8192 + r0 + j) * 8 + hh] = s;
  }
  __syncthreads();
  {
    const int dir = tid >> 7;
    const float ce = dir ? fcum[128] : fcum[127];
    fw[tid] = __expf(ce - fcum[tid]) * fdt[tid];
    if ((tid & 127) == 0) WSF(OFF_TOT)[(dir * 64 + cidx) * 8 + hh] = __expf(ce);
  }
  __syncthreads();
#pragma unroll
  for (int i = 0; i < 4; ++i) {
    const int id = tid + 256 * i;
    const int pp = id >> 4, jc = (id & 15) * 8;
    const uint4 raw = *(const uint4*)(WSB(OFF_XST) + (size_t)(hh * 64 + pp) * 8192 + r0 + jc);
    const unsigned rw[4] = {raw.x, raw.y, raw.z, raw.w};
    unsigned of[4], ob[4];
#pragma unroll
    for (int q = 0; q < 4; ++q) {
      const float x0 = __uint_as_float(rw[q] << 16), x1 = __uint_as_float(rw[q] & 0xffff0000u);
      of[q] = pack2(x0 * fw[jc + 2 * q], x1 * fw[jc + 2 * q + 1]);
      ob[q] = pack2(x0 * fw[128 + jc + 2 * q], x1 * fw[128 + jc + 2 * q + 1]);
    }
    *(uint4*)(sAs + pp * LDS_ + jc) = make_uint4(of[0], of[1], of[2], of[3]);
    *(uint4*)(sAs + 64 * LDS_ + pp * LDS_ + jc) = make_uint4(ob[0], ob[1], ob[2], ob[3]);
  }
#pragma unroll
  for (int i = 0; i < 8; ++i) {
    const int id = tid + 256 * i;
    const int nn = id >> 4, jc = (id & 15) * 8;
    *(uint4*)(sBs + nn * LDS_ + jc) = *(const uint4*)(WSB(OFF_BT) + (size_t)(g * 128 + nn) * 8192 + r0 + jc);
  }
  __syncthreads();
  {
    const int dir = wave >> 1, nh = wave & 1;
    f32x4 acc[4][4];
#pragma unroll
    for (int i = 0; i < 4; ++i)
#pragma unroll
      for (int j = 0; j < 4; ++j) acc[i][j] = (f32x4){0.f, 0.f, 0.f, 0.f};
    const bf16_t* cA = sAs + dir * 64 * LDS_ + lr * LDS_ + lg * 8;
    const bf16_t* cB = sBs + (nh * 64 + lr) * LDS_ + lg * 8;
#pragma unroll 1
    for (int ks = 0; ks < 4; ++ks) {
      bf16x8 af[4], bfr[4];
#pragma unroll
      for (int i = 0; i < 4; ++i) {
        af[i] = *(const bf16x8*)(cA + i * 16 * LDS_ + ks * 32);
        bfr[i] = *(const bf16x8*)(cB + i * 16 * LDS_ + ks * 32);
      }
#pragma unroll
      for (int i = 0; i < 4; ++i)
#pragma unroll
        for (int j = 0; j < 4; ++j) acc[i][j] = mfma16(af[i], bfr[j], acc[i][j]);
    }
    float* S = WSF(OFF_R2) + ((size_t)(dir * 64 + cidx) * 8 + hh) * 8192 + (lg * 4) * 128 + nh * 64 + lr;
#pragma unroll
    for (int i = 0; i < 4; ++i) {
#pragma unroll
      for (int q = 0; q < 4; ++q) {
#pragma unroll
        for (int j = 0; j < 4; ++j) S[j * 16] = acc[i][j][q];
        S += 128;
      }
      S += 12 * 128;
      __builtin_amdgcn_sched_barrier(0);
    }
  }
  __syncthreads();
}

template <int NB>
DEVI void scan_group(const P& p, float4& h, int dir, int cb, int nc, int c0, int hh, size_t eoff) {
  float4 sv[NB];
  float d[NB];
  size_t base[NB];
#pragma unroll
  for (int k = 0; k < NB; ++k) {
    const int c = c0 + k;
    const int cidx = cb + (dir ? nc - 1 - c : c);
    base[k] = ((size_t)(dir * 64 + cidx) * 8 + hh) * 8192 + eoff;
    d[k] = WSF(OFF_TOT)[(dir * 64 + cidx) * 8 + hh];
    sv[k] = *(const float4*)(WSF(OFF_R2) + base[k]);
  }
#pragma unroll
  for (int k = 0; k < NB; ++k) {
    uint2 o;
    o.x = pack2(h.x, h.y);
    o.y = pack2(h.z, h.w);
    *(uint2*)(WSB(OFF_H) + base[k]) = o;
    h.x = d[k] * h.x + sv[k].x; h.y = d[k] * h.y + sv[k].y; h.z = d[k] * h.z + sv[k].z; h.w = d[k] * h.w + sv[k].w;
  }
}

NOINL void scan_states(const P& p) {
  const int total = 2 * 18 * 8 * 64 * 32;
  for (int idx = blockIdx.x * 512 + threadIdx.x; idx < total; idx += gridDim.x * 512) {
    const int n4 = idx & 31, pp = (idx >> 5) & 63, hh = (idx >> 11) & 7;
    const int sd = idx >> 14;
    const int s = sd % 18, dir = sd / 18;
    const int nc = s < 16 ? 2 : 16;
    const int cb = s < 16 ? s * 2 : 32 + (s - 16) * 16;
    float4 h = make_float4(0.f, 0.f, 0.f, 0.f);
    const size_t eoff = (size_t)pp * 128 + n4 * 4;
    if (s >= 16) {
      const float* st = (dir ? p.st_b : p.st_f) + ((size_t)((s - 16) * 8 + hh) * 64 + pp) * 128 + n4 * 4;
      h = *(const float4*)st;
      scan_group<8>(p, h, dir, cb, nc, 0, hh, eoff);
      scan_group<8>(p, h, dir, cb, nc, 8, hh, eoff);
    } else {
      scan_group<2>(p, h, dir, cb, nc, 0, hh, eoff);
      float* o = p.out + (dir ? OUT_SB : OUT_SF) + ((size_t)(s * 8 + hh) * 64 + pp) * 128 + n4 * 4;
      *(float4*)o = h;
    }
  }
}

NOINL void attn_item(const P& p, int id) {
  char* smem = g_smem + VB * 73728;
  const int tid = opaque_tid(), lane = tid & 63, wave = tid >> 6, lr = lane & 15, lg = lane >> 4;
  int row0, kvbase, Lk, hh;
  if (id < 512) { hh = id & 7; const int b = (id >> 3) & 1; const int qb = id >> 4; row0 = 4096 + b * 2048 + qb * 64; kvbase = 4096 + b * 2304; Lk = 2304; }
  else { const int i2 = id - 512; hh = i2 & 7; const int rest = i2 >> 3; const int b = rest >> 2; const int qb = rest & 3; row0 = b * 256 + qb * 64; kvbase = b * 256; Lk = 256; }
  constexpr int LDK = 104, LDV = 72;
  constexpr int KVBUF = 64 * LDK + 64 * LDV;
  bf16_t* sKV = (bf16_t*)smem;
  const int qrow = row0 + wave * 16 + lr;
  bf16x8 qf[3];
#pragma unroll
  for (int ks = 0; ks < 3; ++ks) qf[ks] = *(const bf16x8*)(WSB(OFF_Q) + (size_t)qrow * 768 + hh * 96 + ks * 32 + lg * 8);
  f32x4 oacc[4];
#pragma unroll
  for (int i = 0; i < 4; ++i) oacc[i] = (f32x4){0.f, 0.f, 0.f, 0.f};
  float mrun = -1e30f, lrun = 0.f;
  const int nkt = Lk >> 6;
  const int kkey0 = tid / 12, kcc0 = tid - kkey0 * 12;
  const int c1 = tid + 256, kkey1 = c1 / 12, kcc1 = c1 - kkey1 * 12;
  const int c2 = tid + 512, kkey2 = c2 / 12, kcc2 = c2 - kkey2 * 12;
  const bf16_t* kn = WSB(OFF_KN);
  const bf16_t* kp = WSB(OFF_KPE);
  const bf16_t* ksrc0 = (kcc0 < 8) ? kn + (size_t)(kvbase + kkey0) * 512 + hh * 64 + kcc0 * 8 : kp + (size_t)(kvbase + kkey0) * 32 + (kcc0 - 8) * 8;
  const bf16_t* ksrc1 = (kcc1 < 8) ? kn + (size_t)(kvbase + kkey1) * 512 + hh * 64 + kcc1 * 8 : kp + (size_t)(kvbase + kkey1) * 32 + (kcc1 - 8) * 8;
  const bf16_t* ksrc2 = (kcc2 < 8) ? kn + (size_t)(kvbase + kkey2) * 512 + hh * 64 + kcc2 * 8 : kp + (size_t)(kvbase + kkey2) * 32 + (kcc2 - 8) * 8;
  const int kst0 = (kcc0 < 8) ? 512 * 64 : 32 * 64, kst1 = (kcc1 < 8) ? 512 * 64 : 32 * 64, kst2 = (kcc2 < 8) ? 512 * 64 : 32 * 64;
  const int vd0 = tid >> 3, vcc = tid & 7;
  const bf16_t* vsrc0 = WSB(OFF_VT) + (size_t)(hh * 64 + vd0) * 8704 + kvbase + vcc * 8;
  const bf16_t* vsrc1 = vsrc0 + (size_t)32 * 8704;
  uint4 rk0, rk1, rk2, rv0, rv1;
#define AT_LOAD(kt) { const int _k = (kt); \
    rk0 = *(const uint4*)(ksrc0 + (size_t)_k * kst0); rk1 = *(const uint4*)(ksrc1 + (size_t)_k * kst1); \
    rk2 = *(const uint4*)(ksrc2 + (size_t)_k * kst2); \
    rv0 = *(const uint4*)(vsrc0 + _k * 64); rv1 = *(const uint4*)(vsrc1 + _k * 64); }
#define AT_WRITE(buf) { bf16_t* _b = sKV + (buf) * KVBUF; \
    *(uint4*)(_b + kkey0 * LDK + kcc0 * 8) = rk0; *(uint4*)(_b + kkey1 * LDK + kcc1 * 8) = rk1; \
    *(uint4*)(_b + kkey2 * LDK + kcc2 * 8) = rk2; \
    *(uint4*)(_b + 64 * LDK + vd0 * LDV + vcc * 8) = rv0; *(uint4*)(_b + 64 * LDK + (vd0 + 32) * LDV + vcc * 8) = rv1; }
  AT_LOAD(0)
  AT_WRITE(0)
  __syncthreads();
  for (int kt = 0; kt < nkt; ++kt) {
    const int ktn = min(kt + 1, nkt - 1);
    AT_LOAD(ktn)
#if ATPROBE == 5
    { uint4 d0 = *(const volatile uint4*)(ksrc0 + (size_t)ktn * kst0), d1 = *(const volatile uint4*)(ksrc1 + (size_t)ktn * kst1), d2 = *(const volatile uint4*)(ksrc2 + (size_t)ktn * kst2);
      uint4 d3 = *(const volatile uint4*)(vsrc0 + ktn * 64), d4 = *(const volatile uint4*)(vsrc1 + ktn * 64);
      asm volatile("" :: "v"(d0), "v"(d1), "v"(d2), "v"(d3), "v"(d4)); }
#endif
    const bf16_t* sK = sKV + (kt & 1) * KVBUF;
    const bf16_t* sV = sK + 64 * LDK;
    f32x4 sacc[4];
#pragma unroll
    for (int n = 0; n < 4; ++n) sacc[n] = (f32x4){0.f, 0.f, 0.f, 0.f};
#pragma unroll
    for (int ks = 0; ks < 3; ++ks)
#pragma unroll
      for (int n = 0; n < 4; ++n) {
        const bf16x8 a = *(const bf16x8*)(sK + (n * 16 + lr) * LDK + ks * 32 + lg * 8);
        sacc[n] = mfma16(a, qf[ks], sacc[n]);
      }
#if ATPROBE == 2
    {
      f32x4 dacc[4];
#pragma unroll
      for (int n = 0; n < 4; ++n) dacc[n] = (f32x4){0.f, 0.f, 0.f, 0.f};
#pragma unroll
      for (int ks = 0; ks < 3; ++ks)
#pragma unroll
        for (int n = 0; n < 4; ++n) {
          const bf16x8 a = *(const volatile bf16x8*)(sK + (n * 16 + lr) * LDK + ks * 32 + lg * 8);
          dacc[n] = mfma16(a, qf[ks], dacc[n]);
        }
#pragma unroll
      for (int n = 0; n < 4; ++n) asm volatile("" :: "v"(dacc[n]));
    }
#endif
    float mx = sacc[0][0];
#pragma unroll
    for (int n = 0; n < 4; ++n)
#pragma unroll
      for (int q = 0; q < 4; ++q) mx = fmaxf(mx, sacc[n][q]);
    mx = quad_max(mx);
    const float mnew = fmaxf(mrun, mx);
    const float alpha = __builtin_amdgcn_exp2f(mrun - mnew);
    mrun = mnew;
    float ps = 0.f;
#pragma unroll
    for (int n = 0; n < 4; ++n)
#pragma unroll
      for (int q = 0; q < 4; ++q) {
#if ATPROBE == 1
        { float e2 = __builtin_amdgcn_exp2f(sacc[n][q] - mrun); asm volatile("" :: "v"(e2)); }
#endif
        const float e = __builtin_amdgcn_exp2f(sacc[n][q] - mnew); sacc[n][q] = e; ps += e; }
    lrun = lrun * alpha + ps;
#pragma unroll
    for (int i = 0; i < 4; ++i)
#pragma unroll
      for (int q = 0; q < 4; ++q) oacc[i][q] *= alpha;
#pragma unroll
    for (int ks = 0; ks < 2; ++ks) {
      union { bf16x8 v; unsigned u[4]; } pf;
      pf.u[0] = pack2(sacc[2 * ks][0], sacc[2 * ks][1]);
      pf.u[1] = pack2(sacc[2 * ks][2], sacc[2 * ks][3]);
      pf.u[2] = pack2(sacc[2 * ks + 1][0], sacc[2 * ks + 1][1]);
      pf.u[3] = pack2(sacc[2 * ks + 1][2], sacc[2 * ks + 1][3]);
#pragma unroll
      for (int m = 0; m < 4; ++m) {
        union { bf16x8 v; uint2 h[2]; } av;
        const bf16_t* vp = sV + (m * 16 + lr) * LDV + ks * 32 + lg * 4;
        av.h[0] = *(const uint2*)(vp);
        av.h[1] = *(const uint2*)(vp + 16);
        oacc[m] = mfma16(av.v, pf.v, oacc[m]);
      }
    }
    __builtin_amdgcn_sched_barrier(0);
    AT_WRITE((kt + 1) & 1)
#if ATPROBE == 3
    AT_WRITE((kt + 1) & 1)
#endif
#if ATPROBE == 4
    __syncthreads();
#endif
    __syncthreads();
  }
  lrun = quad_sum(lrun);
  const float inv = 1.f / lrun;
#pragma unroll
  for (int m = 0; m < 4; ++m) {
    uint2 o;
    o.x = pack2(oacc[m][0] * inv, oacc[m][1] * inv);
    o.y = pack2(oacc[m][2] * inv, oacc[m][3] * inv);
    *(uint2*)(WSB(OFF_CAT) + (size_t)qrow * 1024 + hh * 64 + m * 16 + lg * 4) = o;
  }
}

NOINL void attn8_item(const P& p, int id) {
  int tid = threadIdx.x; asm volatile("" : "+v"(tid));
  const int lane = tid & 63, wave = tid >> 6, lr = lane & 15, lg = lane >> 4;
  int row0, kvbase, Lk, hh;
  if (id < 256) { hh = id & 7; const int b = (id >> 3) & 1; const int qb = id >> 4; row0 = 4096 + b * 2048 + qb * 128; kvbase = 4096 + b * 2304; Lk = 2304; }
  else { const int i2 = id - 256; hh = i2 & 7; const int rest = i2 >> 3; const int b = rest >> 1; const int qb = rest & 1; row0 = b * 256 + qb * 128; kvbase = b * 256; Lk = 256; }
  constexpr int LDK = 104, LDV = 136;
  constexpr int KVBUF = 128 * LDK + 64 * LDV;
  bf16_t* sKV = (bf16_t*)g_smem;
  const int qrow = row0 + wave * 16 + lr;
  bf16x8 qf[3];
#pragma unroll
  for (int ks = 0; ks < 3; ++ks) qf[ks] = *(const bf16x8*)(WSB(OFF_Q) + (size_t)qrow * 768 + hh * 96 + ks * 32 + lg * 8);
  f32x4 oacc[4];
#pragma unroll
  for (int i = 0; i < 4; ++i) oacc[i] = (f32x4){0.f, 0.f, 0.f, 0.f};
  float mrun = -1e30f, lrun = 0.f;
  const int nkt = Lk >> 7;
  const int kkey0 = tid / 12, kcc0 = tid - kkey0 * 12;
  const int c1 = tid + 512, kkey1 = c1 / 12, kcc1 = c1 - kkey1 * 12;
  const int c2 = tid + 1024, kkey2 = c2 / 12, kcc2 = c2 - kkey2 * 12;
  const bf16_t* kn = WSB(OFF_KN);
  const bf16_t* kp = WSB(OFF_KPE);
  const bf16_t* ksrc0 = (kcc0 < 8) ? kn + (size_t)(kvbase + kkey0) * 512 + hh * 64 + kcc0 * 8 : kp + (size_t)(kvbase + kkey0) * 32 + (kcc0 - 8) * 8;
  const bf16_t* ksrc1 = (kcc1 < 8) ? kn + (size_t)(kvbase + kkey1) * 512 + hh * 64 + kcc1 * 8 : kp + (size_t)(kvbase + kkey1) * 32 + (kcc1 - 8) * 8;
  const bf16_t* ksrc2 = (kcc2 < 8) ? kn + (size_t)(kvbase + kkey2) * 512 + hh * 64 + kcc2 * 8 : kp + (size_t)(kvbase + kkey2) * 32 + (kcc2 - 8) * 8;
  const int kst0 = (kcc0 < 8) ? 512 * 128 : 32 * 128, kst1 = (kcc1 < 8) ? 512 * 128 : 32 * 128, kst2 = (kcc2 < 8) ? 512 * 128 : 32 * 128;
  const int vd0 = tid >> 4, vcc = tid & 15;
  const bf16_t* vsrc0 = WSB(OFF_VT) + (size_t)(hh * 64 + vd0) * 8704 + kvbase + vcc * 8;
  const bf16_t* vsrc1 = vsrc0 + (size_t)32 * 8704;
  uint4 rk0, rk1, rk2, rv0, rv1;
#define A8_LOAD(kt) { const int _k = (kt); \
    rk0 = *(const uint4*)(ksrc0 + (size_t)_k * kst0); rk1 = *(const uint4*)(ksrc1 + (size_t)_k * kst1); \
    rk2 = *(const uint4*)(ksrc2 + (size_t)_k * kst2); \
    rv0 = *(const uint4*)(vsrc0 + _k * 128); rv1 = *(const uint4*)(vsrc1 + _k * 128); }
#define A8_WRITE(buf) { bf16_t* _b = sKV + (buf) * KVBUF; \
    *(uint4*)(_b + kkey0 * LDK + kcc0 * 8) = rk0; *(uint4*)(_b + kkey1 * LDK + kcc1 * 8) = rk1; \
    *(uint4*)(_b + kkey2 * LDK + kcc2 * 8) = rk2; \
    *(uint4*)(_b + 128 * LDK + vd0 * LDV + vcc * 8) = rv0; *(uint4*)(_b + 128 * LDK + (vd0 + 32) * LDV + vcc * 8) = rv1; }
  A8_LOAD(0)
  A8_WRITE(0)
  __syncthreads();
  for (int kt = 0; kt < nkt; ++kt) {
    const int ktn = min(kt + 1, nkt - 1);
    A8_LOAD(ktn)
    const bf16_t* sK = sKV + (kt & 1) * KVBUF;
    const bf16_t* sV = sK + 128 * LDK;
    f32x4 sacc[8];
#pragma unroll
    for (int n = 0; n < 8; ++n) sacc[n] = (f32x4){0.f, 0.f, 0.f, 0.f};
#pragma unroll
    for (int ks = 0; ks < 3; ++ks)
#pragma unroll
      for (int n = 0; n < 8; ++n) {
        const bf16x8 a = *(const bf16x8*)(sK + (n * 16 + lr) * LDK + ks * 32 + lg * 8);
        sacc[n] = mfma16(a, qf[ks], sacc[n]);
      }
    float mx = sacc[0][0];
#pragma unroll
    for (int n = 0; n < 8; ++n)
#pragma unroll
      for (int q = 0; q < 4; ++q) mx = fmaxf(mx, sacc[n][q]);
    mx = quad_max(mx);
    const float mnew = fmaxf(mrun, mx);
    const float alpha = __builtin_amdgcn_exp2f(mrun - mnew);
    mrun = mnew;
    float ps0 = 0.f, ps1 = 0.f;
#pragma unroll
    for (int n = 0; n < 8; n += 2)
#pragma unroll
      for (int q = 0; q < 4; ++q) {
        const float e0 = __builtin_amdgcn_exp2f(sacc[n][q] - mnew); sacc[n][q] = e0; ps0 += e0;
        const float e1 = __builtin_amdgcn_exp2f(sacc[n + 1][q] - mnew); sacc[n + 1][q] = e1; ps1 += e1;
      }
    lrun = lrun * alpha + (ps0 + ps1);
#pragma unroll
    for (int i = 0; i < 4; ++i)
#pragma unroll
      for (int q = 0; q < 4; ++q) oacc[i][q] *= alpha;
#pragma unroll
    for (int ks = 0; ks < 4; ++ks) {
      union { bf16x8 v; unsigned u[4]; } pf;
      pf.u[0] = pack2(sacc[2 * ks][0], sacc[2 * ks][1]);
      pf.u[1] = pack2(sacc[2 * ks][2], sacc[2 * ks][3]);
      pf.u[2] = pack2(sacc[2 * ks + 1][0], sacc[2 * ks + 1][1]);
      pf.u[3] = pack2(sacc[2 * ks + 1][2], sacc[2 * ks + 1][3]);
#pragma unroll
      for (int m = 0; m < 4; ++m) {
        union { bf16x8 v; uint2 h[2]; } av;
        const bf16_t* vp = sV + (m * 16 + lr) * LDV + ks * 32 + lg * 4;
        av.h[0] = *(const uint2*)(vp);
        av.h[1] = *(const uint2*)(vp + 16);
        oacc[m] = mfma16(av.v, pf.v, oacc[m]);
      }
    }
    __builtin_amdgcn_sched_barrier(0);
    A8_WRITE((kt + 1) & 1)
    __syncthreads();
  }
  lrun = quad_sum(lrun);
  const float inv = 1.f / lrun;
#pragma unroll
  for (int m = 0; m < 4; ++m) {
    uint2 o;
    o.x = pack2(oacc[m][0] * inv, oacc[m][1] * inv);
    o.y = pack2(oacc[m][2] * inv, oacc[m][3] * inv);
    *(uint2*)(WSB(OFF_CAT) + (size_t)qrow * 1024 + hh * 64 + m * 16 + lg * 4) = o;
  }
}

NOINL void ssd_y_item(const P& p, int item) {
  char* smem = g_smem + VB * 73728;
  const int tid = opaque_tid(), lane = tid & 63, wave = tid >> 6, lr = lane & 15, lg = lane >> 4;
  const int cidx = item >> 3, qt = (item >> 1) & 3, half = qt >> 1, g = item & 1;
  const int r0 = cidx * 128;
  const int hh = g * 4 + wave;
  constexpr int LDC = 136, LDM = 72;
  bf16_t* sC = (bf16_t*)smem;
  bf16_t* sB = sC + 64 * LDC;
  bf16_t* sM = sB + 64 * LDC + wave * 64 * LDM;
  float* rowss = (float*)((bf16_t*)smem + 2 * 64 * LDC + 4 * 64 * LDM);
  const float* cum = WSF(OFF_CUM);
  const float* dtv = WSF(OFF_DTV);
  const int srow = tid >> 4, scol = (tid & 15) * 8;
  uint4 pb0, pb1, pb2, pb3;
  {
    const bf16_t* cs = WSB(OFF_CM) + (size_t)(r0 + qt * 32 + srow) * 256 + g * 128 + scol;
    const bf16_t* bs = WSB(OFF_BM) + (size_t)(r0 + srow) * 256 + g * 128 + scol;
    const uint4 c0 = *(const uint4*)(cs), c1 = *(const uint4*)(cs + 16 * 256);
    const uint4 b0 = *(const uint4*)(bs), b1 = *(const uint4*)(bs + 16 * 256), b2 = *(const uint4*)(bs + 32 * 256), b3 = *(const uint4*)(bs + 48 * 256);
    pb0 = *(const uint4*)(bs + 64 * 256); pb1 = *(const uint4*)(bs + 80 * 256); pb2 = *(const uint4*)(bs + 96 * 256); pb3 = *(const uint4*)(bs + 112 * 256);
    bf16_t* wc = sC + srow * LDC + scol;
    bf16_t* wb = sB + srow * LDC + scol;
    *(uint4*)(wc) = c0; *(uint4*)(wc + 16 * LDC) = c1;
    *(uint4*)(wb) = b0; *(uint4*)(wb + 16 * LDC) = b1; *(uint4*)(wb + 32 * LDC) = b2; *(uint4*)(wb + 48 * LDC) = b3;
  }
  __syncthreads();
  f32x4 Y[2][4];
#pragma unroll
  for (int i = 0; i < 2; ++i)
#pragma unroll
    for (int j = 0; j < 4; ++j) Y[i][j] = (f32x4){0.f, 0.f, 0.f, 0.f};
#pragma unroll 1
  for (int jh = 0; jh < 2; ++jh) {
    if (jh == 1) {
      __syncthreads();
      bf16_t* wb = sB + srow * LDC + scol;
      *(uint4*)(wb) = pb0; *(uint4*)(wb + 16 * LDC) = pb1; *(uint4*)(wb + 32 * LDC) = pb2; *(uint4*)(wb + 48 * LDC) = pb3;
      __syncthreads();
    }
#pragma unroll 1
    for (int dir = 0; dir < 2; ++dir) {
      const bool use = dir == 0 ? (jh <= half) : (jh >= half);
      if (!use) continue;
      bf16x8 xf[2][4];
#pragma unroll
      for (int ks = 0; ks < 2; ++ks)
#pragma unroll
        for (int pt = 0; pt < 4; ++pt)
          xf[ks][pt] = *(const bf16x8*)(WSB(OFF_XST) + (size_t)(hh * 64 + pt * 16 + lr) * 8192 + r0 + jh * 64 + ks * 32 + lg * 8);
      float ci[2], cj[4][4], dj[4][4];
#pragma unroll
      for (int it = 0; it < 2; ++it) ci[it] = cum[((size_t)dir * 8192 + r0 + qt * 32 + it * 16 + lr) * 8 + hh];
#pragma unroll
      for (int jt = 0; jt < 4; ++jt)
#pragma unroll
        for (int q = 0; q < 4; ++q) {
          const size_t tj = (size_t)dir * 8192 + r0 + jh * 64 + jt * 16 + lg * 4 + q;
          cj[jt][q] = cum[tj * 8 + hh];
          dj[jt][q] = dtv[tj * 8 + hh];
        }
#pragma unroll
      for (int it = 0; it < 2; ++it) {
        f32x4 cb[4];
#pragma unroll
        for (int jt = 0; jt < 4; ++jt) cb[jt] = (f32x4){0.f, 0.f, 0.f, 0.f};
#pragma unroll
        for (int ks = 0; ks < 4; ++ks) {
          const bf16x8 b = *(const bf16x8*)(sC + (it * 16 + lr) * LDC + ks * 32 + lg * 8);
#pragma unroll
          for (int jt = 0; jt < 4; ++jt) {
            const bf16x8 a = *(const bf16x8*)(sB + (jt * 16 + lr) * LDC + ks * 32 + lg * 8);
            cb[jt] = mfma16(a, b, cb[jt]);
          }
        }
        const int ti = qt * 32 + it * 16 + lr;
#pragma unroll
        for (int jt = 0; jt < 4; ++jt) {
          float v[4];
#pragma unroll
          for (int q = 0; q < 4; ++q) {
            const int tj = jh * 64 + jt * 16 + lg * 4 + q;
            const bool ok = dir == 0 ? (tj <= ti) : (tj >= ti);
            v[q] = ok ? cb[jt][q] * __expf(ci[it] - cj[jt][q]) * dj[jt][q] : 0.f;
          }
          uint2 o;
          o.x = pack2(v[0], v[1]);
          o.y = pack2(v[2], v[3]);
          *(uint2*)(sM + (it * 16 + lr) * LDM + jt * 16 + lg * 4) = o;
        }
        __builtin_amdgcn_sched_barrier(0);
      }
      asm volatile("s_waitcnt lgkmcnt(0)" ::: "memory");
#pragma unroll
      for (int ks = 0; ks < 2; ++ks) {
        bf16x8 af[2];
#pragma unroll
        for (int it = 0; it < 2; ++it) af[it] = *(const bf16x8*)(sM + (it * 16 + lr) * LDM + ks * 32 + lg * 8);
#pragma unroll
        for (int it = 0; it < 2; ++it)
#pragma unroll
          for (int pt = 0; pt < 4; ++pt) Y[it][pt] = mfma16(af[it], xf[ks][pt], Y[it][pt]);
      }
      asm volatile("s_waitcnt lgkmcnt(0)" ::: "memory");
      __builtin_amdgcn_sched_barrier(0);
    }
  }
#pragma unroll 1
  for (int dir = 0; dir < 2; ++dir) {
    const bf16_t* hp = WSB(OFF_H) + ((size_t)(dir * 64 + cidx) * 8 + hh) * 8192;
    float ei[2][4];
#pragma unroll
    for (int it = 0; it < 2; ++it)
#pragma unroll
      for (int q = 0; q < 4; ++q)
        ei[it][q] = __expf(cum[((size_t)dir * 8192 + r0 + qt * 32 + it * 16 + lg * 4 + q) * 8 + hh]);
#pragma unroll
    for (int pt = 0; pt < 4; ++pt) {
      bf16x8 bfr[4];
#pragma unroll
      for (int ks = 0; ks < 4; ++ks) bfr[ks] = *(const bf16x8*)(hp + (size_t)(pt * 16 + lr) * 128 + ks * 32 + lg * 8);
      f32x4 T[2];
#pragma unroll
      for (int it = 0; it < 2; ++it) T[it] = (f32x4){0.f, 0.f, 0.f, 0.f};
#pragma unroll
      for (int ks = 0; ks < 4; ++ks)
#pragma unroll
        for (int it = 0; it < 2; ++it) {
          const bf16x8 a = *(const bf16x8*)(sC + (it * 16 + lr) * LDC + ks * 32 + lg * 8);
          T[it] = mfma16(a, bfr[ks], T[it]);
        }
#pragma unroll
      for (int it = 0; it < 2; ++it)
#pragma unroll
        for (int q = 0; q < 4; ++q) Y[it][pt][q] += ei[it][q] * T[it][q];
    }
    __builtin_amdgcn_sched_barrier(0);
  }
  const float dsk = p.ssd_d[hh];
  const float* proj = WSF(OFF_R1);
#pragma unroll
  for (int i = 0; i < 2; ++i) {
#pragma unroll
    for (int q = 0; q < 4; ++q) {
      const int il = i * 16 + lg * 4 + q;
      const size_t r = (size_t)r0 + qt * 32 + il;
      float ss = 0.f;
#pragma unroll
      for (int j = 0; j < 4; ++j) {
        const int ch = hh * 64 + j * 16 + lr;
        const float xs = bf2f(WSB(OFF_XS)[r * 512 + ch]);
        const float z = proj[r * 2096 + 544 + ch];
        const float y = (Y[i][j][q] + dsk * xs) * silu(z);
        Y[i][j][q] = y;
        ss += y * y;
      }
      ss += __shfl_xor(ss, 1, 64);
      ss += __shfl_xor(ss, 2, 64);
      ss += __shfl_xor(ss, 4, 64);
      ss += __shfl_xor(ss, 8, 64);
      if (lr == 0) rowss[wave * 64 + il] = ss;
    }
    __builtin_amdgcn_sched_barrier(0);
  }
  __syncthreads();
#pragma unroll
  for (int i = 0; i < 2; ++i) {
#pragma unroll
    for (int q = 0; q < 4; ++q) {
      const int il = i * 16 + lg * 4 + q;
      const size_t r = (size_t)r0 + qt * 32 + il;
      const float tot = rowss[il] + rowss[64 + il] + rowss[128 + il] + rowss[192 + il];
      const float rs = rsqrtf(tot * (1.f / 256.f) + 1e-6f);
#pragma unroll
      for (int j = 0; j < 4; ++j) {
        const int ch = hh * 64 + j * 16 + lr;
        WSB(OFF_CAT)[r * 1024 + 512 + ch] = f2bf(Y[i][j][q] * rs * p.ssd_norm[ch]);
      }
    }
    __builtin_amdgcn_sched_barrier(0);
  }
  __syncthreads();
}

template <int W2>
DEVI void pool_item(const bf16_t* __restrict__ h, bf16_t* __restrict__ dst, int r, int cc) {
  int s0, L;
  if (r < 4096) { s0 = r & ~255; L = 256; } else { s0 = 4096 + ((r - 4096) & ~2047); L = 2048; }
  const int t = r - s0;
  const int lo = max(t - W2, 0), hi = min(t + W2, L);
  uint4 v[2 * W2];
#pragma unroll
  for (int k = 0; k < 2 * W2; ++k) {
    const int u = min(max(t - W2 + k, 0), L - 1);
    v[k] = *(const uint4*)(h + (size_t)(s0 + u) * 1024 + cc);
  }
  float acc[8] = {0, 0, 0, 0, 0, 0, 0, 0};
#pragma unroll
  for (int k = 0; k < 2 * W2; ++k) {
    const int u = t - W2 + k;
    const float m = (u >= 0 && u < L) ? 1.f : 0.f;
    acc[0] += m * __uint_as_float(v[k].x << 16); acc[1] += m * __uint_as_float(v[k].x & 0xffff0000u);
    acc[2] += m * __uint_as_float(v[k].y << 16); acc[3] += m * __uint_as_float(v[k].y & 0xffff0000u);
    acc[4] += m * __uint_as_float(v[k].z << 16); acc[5] += m * __uint_as_float(v[k].z & 0xffff0000u);
    acc[6] += m * __uint_as_float(v[k].w << 16); acc[7] += m * __uint_as_float(v[k].w & 0xffff0000u);
  }
  const float inv = 1.f / (float)(hi - lo);
  const uint4 c = v[W2];
  uint4 o;
  o.x = pack2(acc[0] * inv - __uint_as_float(c.x << 16), acc[1] * inv - __uint_as_float(c.x & 0xffff0000u));
  o.y = pack2(acc[2] * inv - __uint_as_float(c.y << 16), acc[3] * inv - __uint_as_float(c.y & 0xffff0000u));
  o.z = pack2(acc[4] * inv - __uint_as_float(c.z << 16), acc[5] * inv - __uint_as_float(c.z & 0xffff0000u));
  o.w = pack2(acc[6] * inv - __uint_as_float(c.w << 16), acc[7] * inv - __uint_as_float(c.w & 0xffff0000u));
  *(uint4*)(dst + (size_t)r * 1024 + cc) = o;
}

NOINL void pool_phase(const P& p) {
  const bf16_t* h = WSB(OFF_H);
  bf16_t* dst = WSB(OFF_CAT);
  const int total = 8192 * 128;
  for (int idx = blockIdx.x * 512 + threadIdx.x; idx < total; idx += gridDim.x * 512) {
    const int c32 = idx & 31, rlo = (idx >> 5) & 1, gi = (idx >> 6) & 3, rhi = idx >> 8;
    const int r = rhi * 2 + rlo, cc = gi * 256 + c32 * 8;
    if (gi == 0) pool_item<1>(h, dst, r, cc);
    else if (gi == 1) pool_item<2>(h, dst, r, cc);
    else if (gi == 2) pool_item<4>(h, dst, r, cc);
    else pool_item<8>(h, dst, r, cc);
  }
}

NOINL void ph_gemm_proj(const P& p) {
  float* proj = WSF(OFF_R1);
  const bf16_t* A = WSB(OFF_H);
  const bf16_t* B = WSB(OFF_WIN);
  auto epi = [&](int ctx, int row, int col, f32x4 v0, f32x4 v1) {
#pragma unroll
    for (int q = 0; q < 4; ++q) {
      if (col < 2096) proj[(size_t)(row + q) * 2096 + col] = v0[q];
      if (col + 16 < 2096) proj[(size_t)(row + q) * 2096 + col + 16] = v1[q];
    }
  };
  gemm8_stream(256, 1024, 1024, 1024,
    [=](int t) {
      TileInfo r;
      int m, n; tile_mn(t, 32, 8, m, n);
      r.m0 = m * 256; r.n0 = n * 256; r.ctx = 0;
      r.a = A + (size_t)r.m0 * 1024; r.b = B + (size_t)r.n0 * 1024;
      return r;
    }, epi);
  gemm_stream(64, 1024, 1024, 1024, g_smem + VB * 73728,
    [=](int t) {
      TileInfo r;
      r.m0 = t * 128; r.n0 = 2048; r.ctx = 0;
      r.a = A + (size_t)r.m0 * 1024; r.b = B + (size_t)2048 * 1024;
      return r;
    }, epi);
}

NOINL void ph_gemm_f32out(const P& p, const bf16_t* A, int lda, const bf16_t* B, int ldb, int K, bf16_t* C, int N) {
  const int nN = N / 128;
  gemm_stream(64 * nN, lda, ldb, K, g_smem + VB * 73728,
    [=](int t) {
      TileInfo r;
      int m, n; tile_mn(t, 64, nN, m, n);
      r.m0 = m * 128; r.n0 = n * 128; r.ctx = 0;
      r.a = A + (size_t)r.m0 * lda; r.b = B + (size_t)r.n0 * ldb;
      return r;
    },
    [&](int ctx, int row, int col, f32x4 v0, f32x4 v1) {
#pragma unroll
      for (int q = 0; q < 4; ++q) {
        C[(size_t)(row + q) * N + col] = f2bf(v0[q]);
        C[(size_t)(row + q) * N + col + 16] = f2bf(v1[q]);
      }
    });
}

NOINL void ph_gemm8_splitk(const P& p, const bf16_t* A, int lda, const bf16_t* B, int ldb, int Khalf, bf16_t* C0, bf16_t* C1) {
  gemm8_stream(256, lda, ldb, Khalf,
    [=](int t) {
      TileInfo r;
      const int id = swz_tile(t, 256);
      const int ks = id >> 7, rem = id & 127;
      r.m0 = (rem >> 2) * 256; r.n0 = (rem & 3) * 256; r.ctx = ks;
      r.a = A + (size_t)r.m0 * lda + (size_t)ks * Khalf; r.b = B + (size_t)r.n0 * ldb + (size_t)ks * Khalf;
      return r;
    },
    [&](int ks, int row, int col, f32x4 v0, f32x4 v1) {
      bf16_t* C = ks ? C1 : C0;
#pragma unroll
      for (int q = 0; q < 4; ++q) {
        C[(size_t)(row + q) * 1024 + col] = f2bf(v0[q]);
        C[(size_t)(row + q) * 1024 + col + 16] = f2bf(v1[q]);
      }
    });
}

NOINL void ph_gemm_qkv(const P& p) {
  bf16_t* qo = WSB(OFF_Q);
  bf16_t* kn = WSB(OFF_KN);
  bf16_t* vt = WSB(OFF_VT);
  const bf16_t* Aq = WSB(OFF_CQN);
  const bf16_t* Bq = WSB(OFF_WUQ);
  const bf16_t* Ak = WSB(OFF_CKV);
  const bf16_t* Bk = WSB(OFF_WUKV);
  gemm_stream(384 + 544, 256, 256, 256, g_smem + VB * 73728,
    [=](int t) {
      TileInfo r;
      int m, n;
      if (t < 384) {
        tile_mn(t, 64, 6, m, n);
        r.m0 = m * 128; r.n0 = n * 128; r.ctx = 0;
        r.a = Aq + (size_t)r.m0 * 256; r.b = Bq + (size_t)r.n0 * 256;
      } else {
        tile_mn(t - 384, 68, 8, m, n);
        r.m0 = m * 128; r.n0 = n * 128; r.ctx = 1;
        r.a = Ak + (size_t)r.m0 * 256; r.b = Bk + (size_t)r.n0 * 256;
      }
      return r;
    },
    [&](int ctx, int row, int col, f32x4 v0, f32x4 v1) {
      if (ctx == 0) {
        const float scl = 0.10206207261596575f * 1.4426950408889634f;
        const int tn = col >> 4;
        const bool rope = ((tn % 6) == 4) && (row >= 4096);
        const int ii = col & 15;
        const float fr = rope_freq(ii & 7);
#pragma unroll
        for (int q = 0; q < 4; ++q) {
          float a = v0[q], b = v1[q];
          if (rope) {
            const int tt = (row + q - 4096) & 2047;
            const float pos = (ii < 8) ? (float)(tt >> 6) : (float)(tt & 63);
            const float ang = pos * fr;
            float cs, sn;
            fast_sincos(ang, sn, cs);
            const float x1 = a, x2 = b;
            a = x1 * cs - x2 * sn;
            b = x1 * sn + x2 * cs;
          }
          qo[(size_t)(row + q) * 768 + col] = f2bf(a * scl);
          qo[(size_t)(row + q) * 768 + col + 16] = f2bf(b * scl);
        }
      } else {
        const int hh = col >> 7, j = col & 127;
        if (j < 64) {
#pragma unroll
          for (int q = 0; q < 4; ++q) {
            kn[(size_t)(row + q) * 512 + hh * 64 + j] = f2bf(v0[q]);
            kn[(size_t)(row + q) * 512 + hh * 64 + j + 16] = f2bf(v1[q]);
          }
        } else {
          uint2 o0, o1;
          o0.x = pack2(v0[0], v0[1]); o0.y = pack2(v0[2], v0[3]);
          o1.x = pack2(v1[0], v1[1]); o1.y = pack2(v1[2], v1[3]);
          *(uint2*)(vt + (size_t)(hh * 64 + j - 64) * 8704 + row) = o0;
          *(uint2*)(vt + (size_t)(hh * 64 + j - 64 + 16) * 8704 + row) = o1;
        }
      }
    });
}

NOINL void ph_gemm_ffn_up(const P& p, int layer) {
  bf16_t* gu = WSB(OFF_R1);
  const bf16_t* A = WSB(OFF_H);
  const bf16_t* B = WSB(OFF_WGU) + (size_t)layer * 5632 * 1024;
  gemm8_stream(32 * 22, 1024, 1024, 1024,
    [=](int t) {
      TileInfo r;
      int m, n; tile_mn(t, 32, 22, m, n);
      r.m0 = m * 256; r.n0 = n * 256; r.ctx = 0;
      r.a = A + (size_t)r.m0 * 1024; r.b = B + (size_t)r.n0 * 1024;
      return r;
    },
    [&](int ctx, int row, int col, f32x4 v0, f32x4 v1) {
      const int oc = (col >> 5) * 16 + (col & 15);
#pragma unroll
      for (int q = 0; q < 4; ++q) gu[(size_t)(row + q) * 2816 + oc] = f2bf(silu(v0[q]) * v1[q]);
    });
}

NOINL void ph_gemm_pool(const P& p) {
  bf16_t* mix = WSB(OFF_R1);
  const bf16_t* A = WSB(OFF_H);
  const bf16_t* B = WSB(OFF_WPOOL);
  gemm_stream(512, 1024, 256, 256, g_smem + VB * 73728,
    [=](int t) {
      TileInfo r;
      const int id = swz_tile(t, 512);
      const int g = id >> 7, rem = id & 127;
      r.m0 = (rem >> 1) * 128; r.n0 = (rem & 1) * 128; r.ctx = g;
      r.a = A + (size_t)r.m0 * 1024 + g * 256; r.b = B + (size_t)g * 65536 + (size_t)r.n0 * 256;
      return r;
    },
    [&](int g, int row, int col, f32x4 v0, f32x4 v1) {
      const int c0 = g * 256 + col;
      const float s0 = p.pool_scale[c0], s1 = p.pool_scale[c0 + 16];
#pragma unroll
      for (int q = 0; q < 4; ++q) {
        mix[(size_t)(row + q) * 1024 + c0] = f2bf(v0[q] * s0);
        mix[(size_t)(row + q) * 1024 + c0 + 16] = f2bf(v1[q] * s1);
      }
    });
}


#define XB_TMO      128
#define XB_XCNT(j)  (256  + 64 * (j))
#define XB_XSUB(j)  (1280 + 64 * (j))
#define XB_XGEN(j)  (2304 + 64 * (j))
#define XB_TOP      3328
#define XB_TOPGEN   3392
#define XCD_BAR_WORDS 3456
#define XB_SPIN_CAP (1u << 22)
#define LAS __attribute__((address_space(3)))
DEVI unsigned xb_ld(unsigned* p) { return __hip_atomic_load(p, __ATOMIC_RELAXED, __HIP_MEMORY_SCOPE_AGENT); }
DEVI unsigned xb_add(unsigned* p, unsigned v) { return __hip_atomic_fetch_add(p, v, __ATOMIC_RELAXED, __HIP_MEMORY_SCOPE_AGENT); }
DEVI unsigned xb_xcc_id() { return (unsigned)__builtin_amdgcn_s_getreg((3 << 11) | 20) & 0xFu; }
#define XB_SPIN(cond, bar) do { unsigned _sp = 0; while (cond) { __builtin_amdgcn_s_sleep(1); \
    if ((++_sp & 255u) == 0u) { if (xb_ld(&(bar)[XB_TMO])) break; if (_sp > XB_SPIN_CAP) { atomicAdd(&(bar)[XB_TMO], 1u); break; } } } } while (0)
struct XcdBarrier { unsigned* bar; unsigned x; volatile LAS unsigned* st; };
DEVI XcdBarrier xcd_barrier_post(unsigned* bar, volatile LAS unsigned* st) {
  XcdBarrier b; b.bar = bar; b.x = xb_xcc_id(); b.st = st;
  if (threadIdx.x == 0) (void)xb_add(&bar[XB_XCNT(b.x)], 1u);
  return b;
}
DEVI void xcd_barrier_complete(unsigned* bar, unsigned x, unsigned& nloc, unsigned& nx) {
  const unsigned G = gridDim.x * gridDim.y * gridDim.z;
  unsigned sum, cnt, mine, sp = 0u;
  for (;;) {
    sum = 0u; cnt = 0u; mine = 0u;
#pragma unroll
    for (unsigned j = 0; j < 16; ++j) { const unsigned c = xb_ld(&bar[XB_XCNT(j)]); sum += c; cnt += (c > 0u) ? 1u : 0u; mine = (j == x) ? c : mine; }
    if (sum == G) break;
    __builtin_amdgcn_s_sleep(1);
    if ((++sp & 255u) == 0u) { if (xb_ld(&bar[XB_TMO])) break; if (sp > XB_SPIN_CAP) { atomicAdd(&bar[XB_TMO], 1u); break; } }
  }
  nloc = mine > 0u ? mine : 1u; nx = cnt > 0u ? cnt : 1u;
}
DEVI void xcd_barrier(const XcdBarrier& b) {
  asm volatile("s_waitcnt vmcnt(0)" ::: "memory");
  __syncthreads();
  if (threadIdx.x == 0) {
    unsigned* bar = b.bar;
    __builtin_amdgcn_s_waitcnt(0);
    unsigned nloc = b.st[0], nx = b.st[1];
    if (nloc == 0u) { xcd_barrier_complete(bar, b.x, nloc, nx); b.st[0] = nloc; b.st[1] = nx; }
    const unsigned old = xb_add(&bar[XB_XSUB(b.x)], 1u);
    const unsigned gen = old / nloc;
    if (old + 1u == (gen + 1u) * nloc) {
      __builtin_amdgcn_fence(__ATOMIC_RELEASE, "agent");
      asm volatile("s_waitcnt vmcnt(0)" ::: "memory");
      const unsigned og = xb_add(&bar[XB_TOP], 1u);
      const unsigned tg = og / nx;
      if (og + 1u == (tg + 1u) * nx) xb_add(&bar[XB_TOPGEN], 1u);
      else XB_SPIN(xb_ld(&bar[XB_TOPGEN]) == tg, bar);
      __builtin_amdgcn_fence(__ATOMIC_ACQUIRE, "agent");
      xb_add(&bar[XB_XGEN(b.x)], 1u);
      asm volatile("s_waitcnt vmcnt(0)" ::: "memory");
    } else {
      XB_SPIN(xb_ld(&bar[XB_XGEN(b.x)]) == gen, bar);
      __builtin_amdgcn_fence(__ATOMIC_ACQUIRE, "agent");
      asm volatile("s_waitcnt vmcnt(0)" ::: "memory");
    }
  }
  __syncthreads();
}

constexpr int NPHASE = 18;
#ifndef REPMASK
#define REPMASK 0
#endif
#ifndef ATPROBE
#define ATPROBE 0
#endif
#ifndef P6PROBE
#define P6PROBE 1
#endif
#ifndef PHMASK
#define PHMASK 0x3ffff
#endif
#define PH(n) if constexpr ((PHMASK >> (n)) & 1)

__global__ void __launch_bounds__(512, 2) mega(P p, int lo, int hi) {
  __shared__ uint4 xb_words;
  if (threadIdx.x == 0) xb_words = make_uint4(0u, 0u, 0u, 0u);
  __syncthreads();
  XcdBarrier xb = xcd_barrier_post((unsigned*)(p.ws + OFF_BAR), (volatile LAS unsigned*)&xb_words);
  if (lo < 0) cg::this_grid().sync();
  PH(0) if (lo <= 0 && 0 < hi) {
#if (REPMASK >> 0) & 1
    int nrep = 2; asm volatile("" : "+s"(nrep));
    for (int rep = 0; rep < nrep; ++rep) {
      if (rep) xcd_barrier(xb);
#else
    {
#endif
        for (int t0_ = blockIdx.x * 2; t0_ < 384 + 5200; t0_ += gridDim.x * 2) {
          const int t = min(t0_ + VB, 384 + 5200 - 1);
          if (t < 384) gemv_tile(p, t); else transpose_tile(p, t - 384);
        }
    }
  }
  if (lo <= 0 && 0 + 1 < hi) xcd_barrier(xb);
  PH(1) if (lo <= 1 && 1 < hi) {
#if (REPMASK >> 1) & 1
    int nrep = 2; asm volatile("" : "+s"(nrep));
    for (int rep = 0; rep < nrep; ++rep) {
      if (rep) xcd_barrier(xb);
#else
    {
#endif
        rowop<false, true, true, false, false>(p, nullptr, nullptr, nullptr, 0, p.n_pre_mix, 0, 1, 0, 0);
    }
  }
  if (lo <= 1 && 1 + 1 < hi) xcd_barrier(xb);
  PH(2) if (lo <= 2 && 2 < hi) {
#if (REPMASK >> 2) & 1
    int nrep = 2; asm volatile("" : "+s"(nrep));
    for (int rep = 0; rep < nrep; ++rep) {
      if (rep) xcd_barrier(xb);
#else
    {
#endif
        ph_gemm_proj(p);
    }
  }
  if (lo <= 2 && 2 + 1 < hi) xcd_barrier(xb);
  PH(3) if (lo <= 3 && 3 < hi) {
#if (REPMASK >> 3) & 1
    int nrep = 2; asm volatile("" : "+s"(nrep));
    for (int rep = 0; rep < nrep; ++rep) {
      if (rep) xcd_barrier(xb);
#else
    {
#endif
        prep_rows(p);
        prep_cache(p);
        for (int t0_ = VT_FIRST; t0_ < 2048; t0_ += gridDim.x * 2) conv_tile(p, min(t0_ + VT_OFF, 2047));
    }
  }
  if (lo <= 3 && 3 + 1 < hi) xcd_barrier(xb);
  PH(4) if (lo <= 4 && 4 < hi) {
#if (REPMASK >> 4) & 1
    int nrep = 2; asm volatile("" : "+s"(nrep));
    for (int rep = 0; rep < nrep; ++rep) {
      if (rep) xcd_barrier(xb);
#else
    {
#endif
        ph_gemm_qkv(p);
        for (int t0_ = VT_FIRST; t0_ < 512; t0_ += gridDim.x * 2) chunk_state_item(p, min(t0_ + VT_OFF, 511));
    }
  }
  if (lo <= 4 && 4 + 1 < hi) xcd_barrier(xb);
  PH(5) if (lo <= 5 && 5 < hi) {
#if (REPMASK >> 5) & 1
    int nrep = 2; asm volatile("" : "+s"(nrep));
    for (int rep = 0; rep < nrep; ++rep) {
      if (rep) xcd_barrier(xb);
#else
    {
#endif
        scan_states(p);
    }
  }
  if (lo <= 5 && 5 + 1 < hi) xcd_barrier(xb);
  PH(6) if (lo <= 6 && 6 < hi) {
#if (REPMASK >> 6) & 1
    int nrep = 2; asm volatile("" : "+s"(nrep));
    for (int rep = 0; rep < nrep; ++rep) {
      if (rep) xcd_barrier(xb);
#else
    {
#endif
        for (int t = blockIdx.x; t < 512; t += gridDim.x) attn8_item(p, t);
        for (int t0_ = VT_FIRST; t0_ < 512; t0_ += gridDim.x * 2) ssd_y_item(p, min(t0_ + VT_OFF, 511));
    }
  }
  if (lo <= 6 && 6 + 1 < hi) xcd_barrier(xb);
  PH(7) if (lo <= 7 && 7 < hi) {
#if (REPMASK >> 7) & 1
    int nrep = 2; asm volatile("" : "+s"(nrep));
    for (int rep = 0; rep < nrep; ++rep) {
      if (rep) xcd_barrier(xb);
#else
    {
#endif
        ph_gemm8_splitk(p, WSB(OFF_CAT), 1024, WSB(OFF_WOUT), 1024, 512, WSB(OFF_R1), WSB(OFF_R1) + (size_t)8192 * 1024);
    }
  }
  if (lo <= 7 && 7 + 1 < hi) xcd_barrier(xb);
  PH(8) if (lo <= 8 && 8 < hi) {
#if (REPMASK >> 8) & 1
    int nrep = 2; asm volatile("" : "+s"(nrep));
    for (int rep = 0; rep < nrep; ++rep) {
      if (rep) xcd_barrier(xb);
#else
    {
#endif
        rowop<true, true, true, false, true>(p, WSB(OFF_R1), WSB(OFF_R1) + (size_t)8192 * 1024, p.n_post_mix, 2, p.n_pre_ffn, 3, 4, 0, 0);
    }
  }
  if (lo <= 8 && 8 + 1 < hi) xcd_barrier(xb);
  PH(9) if (lo <= 9 && 9 < hi) {
#if (REPMASK >> 9) & 1
    int nrep = 2; asm volatile("" : "+s"(nrep));
    for (int rep = 0; rep < nrep; ++rep) {
      if (rep) xcd_barrier(xb);
#else
    {
#endif
        ph_gemm_ffn_up(p, 0);
    }
  }
  if (lo <= 9 && 9 + 1 < hi) xcd_barrier(xb);
  PH(10) if (lo <= 10 && 10 < hi) {
#if (REPMASK >> 10) & 1
    int nrep = 2; asm volatile("" : "+s"(nrep));
    for (int rep = 0; rep < nrep; ++rep) {
      if (rep) xcd_barrier(xb);
#else
    {
#endif
        ph_gemm8_splitk(p, WSB(OFF_R1), 2816, WSB(OFF_WDN), 2816, 1408, WSB(OFF_R2), WSB(OFF_R2) + (size_t)8192 * 1024);
    }
  }
  if (lo <= 10 && 10 + 1 < hi) xcd_barrier(xb);
  PH(11) if (lo <= 11 && 11 < hi) {
#if (REPMASK >> 11) & 1
    int nrep = 2; asm volatile("" : "+s"(nrep));
    for (int rep = 0; rep < nrep; ++rep) {
      if (rep) xcd_barrier(xb);
#else
    {
#endif
        rowop<true, true, false, false, true>(p, WSB(OFF_R2), WSB(OFF_R2) + (size_t)8192 * 1024, p.n_post_ffn, 5, p.n_pre_mix + 1024, 0, 1, 0, 1);
    }
  }
  if (lo <= 11 && 11 + 1 < hi) xcd_barrier(xb);
  PH(12) if (lo <= 12 && 12 < hi) {
#if (REPMASK >> 12) & 1
    int nrep = 2; asm volatile("" : "+s"(nrep));
    for (int rep = 0; rep < nrep; ++rep) {
      if (rep) xcd_barrier(xb);
#else
    {
#endif
    }
  }
  PH(13) if (lo <= 13 && 13 < hi) {
#if (REPMASK >> 13) & 1
    int nrep = 2; asm volatile("" : "+s"(nrep));
    for (int rep = 0; rep < nrep; ++rep) {
      if (rep) xcd_barrier(xb);
#else
    {
#endif
        ph_gemm_pool(p);
    }
  }
  if (lo <= 13 && 13 + 1 < hi) xcd_barrier(xb);
  PH(14) if (lo <= 14 && 14 < hi) {
#if (REPMASK >> 14) & 1
    int nrep = 2; asm volatile("" : "+s"(nrep));
    for (int rep = 0; rep < nrep; ++rep) {
      if (rep) xcd_barrier(xb);
#else
    {
#endif
        rowop<true, true, false, false, false, true>(p, WSB(OFF_R1), nullptr, p.n_post_mix + 1024, 2, p.n_pre_ffn + 1024, 3, 4, 1, 1);
    }
  }
  if (lo <= 14 && 14 + 1 < hi) xcd_barrier(xb);
  PH(15) if (lo <= 15 && 15 < hi) {
#if (REPMASK >> 15) & 1
    int nrep = 2; asm volatile("" : "+s"(nrep));
    for (int rep = 0; rep < nrep; ++rep) {
      if (rep) xcd_barrier(xb);
#else
    {
#endif
        ph_gemm_ffn_up(p, 1);
    }
  }
  if (lo <= 15 && 15 + 1 < hi) xcd_barrier(xb);
  PH(16) if (lo <= 16 && 16 < hi) {
#if (REPMASK >> 16) & 1
    int nrep = 2; asm volatile("" : "+s"(nrep));
    for (int rep = 0; rep < nrep; ++rep) {
      if (rep) xcd_barrier(xb);
#else
    {
#endif
        ph_gemm8_splitk(p, WSB(OFF_R1), 2816, WSB(OFF_WDN) + (size_t)1024 * 2816, 2816, 1408, WSB(OFF_R2), WSB(OFF_R2) + (size_t)8192 * 1024);
    }
  }
  if (lo <= 16 && 16 + 1 < hi) xcd_barrier(xb);
  PH(17) if (lo <= 17 && 17 < hi) {
#if (REPMASK >> 17) & 1
    int nrep = 2; asm volatile("" : "+s"(nrep));
    for (int rep = 0; rep < nrep; ++rep) {
      if (rep) xcd_barrier(xb);
#else
    {
#endif
        rowop<true, false, false, true, true>(p, WSB(OFF_R2), WSB(OFF_R2) + (size_t)8192 * 1024, p.n_post_ffn + 1024, 5, nullptr, 0, 0, 1, 1);
    }
  }
}

extern "C" void kernel_launch(void* const* d_in, const int* in_sizes, int n_in, void* d_out, int out_size, void* d_ws,
                              size_t ws_size, hipStream_t stream) {
  P p{};
  const float** f = (const float**)&p;
  for (int i = 0; i < 33; ++i) f[i] = (const float*)d_in[i];
  p.out = (float*)d_out;
  p.ws = (char*)d_ws;
  static int grid_blocks = 0;
  if (!grid_blocks) {
    int dev = 0, cus = 0, per_cu = 0;
    hipGetDevice(&dev);
    hipDeviceGetAttribute(&cus, hipDeviceAttributeMultiprocessorCount, dev);
    hipOccupancyMaxActiveBlocksPerMultiprocessor(&per_cu, mega, 512, 0);
    if (per_cu > 1) per_cu = 1;
    if (per_cu < 1) per_cu = 1;
    grid_blocks = cus * per_cu;
  }
  hipMemsetAsync((char*)d_ws + OFF_BAR, 0, XCD_BAR_WORDS * 4, stream);
#if SINGLE_LAUNCH
  int lo = 0, hi = NPHASE;
  void* args[] = {&p, &lo, &hi};
  hipError_t e = hipLaunchCooperativeKernel((void*)mega, dim3(grid_blocks), dim3(512), args, 0, stream);
  if (e != hipSuccess) fprintf(stderr, "cooperative launch failed: %s (grid %d)\n", hipGetErrorString(e), grid_blocks);
#else
  for (int ph = 0; ph < NPHASE; ++ph) mega<<<grid_blocks, 512, 0, stream>>>(p, ph, ph + 1);
#endif
}
```

```cpp
#include <hip/hip_runtime.h>
#include <hip/hip_cooperative_groups.h>
#include <stdint.h>
#include <stdio.h>
namespace cg = cooperative_groups;

#ifndef SINGLE_LAUNCH
#define SINGLE_LAUNCH 1
#endif

typedef __attribute__((ext_vector_type(8))) short bf16x8;
typedef __attribute__((ext_vector_type(4))) float f32x4;
typedef unsigned short bf16_t;

#define DEVI __device__ __forceinline__

constexpr size_t OFF_WIN   = 0;
constexpr size_t OFF_WUQ   = OFF_WIN   + (size_t)2176*1024*2;
constexpr size_t OFF_WUKV  = OFF_WUQ   + (size_t)768*256*2;
constexpr size_t OFF_WOUT  = OFF_WUKV  + (size_t)1024*256*2;
constexpr size_t OFF_WPOOL = OFF_WOUT  + (size_t)1024*1024*2;
constexpr size_t OFF_WGU   = OFF_WPOOL + (size_t)4*256*256*2;
constexpr size_t OFF_WDN   = OFF_WGU   + (size_t)2*5632*1024*2;
constexpr size_t OFF_MOD   = OFF_WDN   + (size_t)2*1024*2816*2;
constexpr size_t OFF_R1    = OFF_MOD   + (size_t)2*3*6144*4;
constexpr size_t OFF_R2    = OFF_R1    + (size_t)8192*2096*4;
constexpr size_t OFF_H     = OFF_R2    + (size_t)8192*1024*4;
constexpr size_t OFF_CAT   = OFF_H     + (size_t)8192*1024*2;
constexpr size_t OFF_Q     = OFF_CAT   + (size_t)8192*1024*2;
constexpr size_t OFF_KN    = OFF_Q     + (size_t)8192*768*2;
constexpr size_t OFF_VT    = OFF_KN    + (size_t)8704*512*2;
constexpr size_t OFF_CQN   = OFF_VT    + (size_t)8704*512*2;
constexpr size_t OFF_CKV   = OFF_CQN   + (size_t)8192*256*2;
constexpr size_t OFF_KPE   = OFF_CKV   + (size_t)8704*256*2;
constexpr size_t OFF_XS    = OFF_KPE   + (size_t)8704*32*2;
constexpr size_t OFF_XST   = OFF_XS    + (size_t)8192*512*2;
constexpr size_t OFF_BM    = OFF_XST   + (size_t)8192*512*2;
constexpr size_t OFF_BT    = OFF_BM    + (size_t)8192*256*2;
constexpr size_t OFF_CM    = OFF_BT    + (size_t)8192*256*2;
constexpr size_t OFF_DTV   = OFF_CM    + (size_t)8192*256*2;
constexpr size_t OFF_CUM   = OFF_DTV   + (size_t)2*8192*8*4;
constexpr size_t OFF_TOT   = OFF_CUM   + (size_t)2*8192*8*4;
constexpr size_t OFF_BAR   = OFF_TOT   + 4096;
constexpr size_t OFF_XR    = OFF_BAR   + 16384;
constexpr size_t OFF_END   = OFF_XR    + (size_t)8192*1024*2;
static_assert(OFF_END <= ((size_t)256 << 20), "workspace map exceeds 256 MiB");

constexpr size_t OUT_CKV = 8388608, OUT_KR = 9437184, OUT_SF = 9568256, OUT_SB = 10616832;

struct P {
  const float *x_prompt, *x_sample, *c, *cache_ckv, *cache_kr, *st_f, *st_b, *c_ctx;
  const float *w_mod, *b_mod, *n_pre_mix, *n_post_mix, *n_pre_ffn, *n_post_ffn;
  const float *w_in, *q_norm, *w_uq, *kv_norm, *w_ukv, *conv_w, *conv_b, *dtb_f, *dtb_b, *alog_f, *alog_b;
  const float *ssd_d, *ssd_norm, *w_out, *pool_w, *pool_scale, *w_gate, *w_up, *w_down;
  float* out;
  char* ws;
};

#define WSB(off) ((bf16_t*)(p.ws + (off)))
#define WSF(off) ((float*)(p.ws + (off)))

typedef __bf16 hwbf16x2 __attribute__((ext_vector_type(2)));
typedef float hwf32x2 __attribute__((ext_vector_type(2)));
DEVI bf16_t f2bf(float f) {
  __bf16 r = (__bf16)f;
  return __builtin_bit_cast(bf16_t, r);
}
DEVI float bf2f(bf16_t b) { return __uint_as_float(((unsigned)b) << 16); }
DEVI unsigned pack2(float a, float b) {
  hwf32x2 v = {a, b};
  hwbf16x2 r = __builtin_convertvector(v, hwbf16x2);
  return __builtin_bit_cast(unsigned, r);
}
DEVI float silu(float x) { return x / (1.f + __expf(-x)); }
DEVI float wave_sum(float v) {
#pragma unroll
  for (int o = 32; o > 0; o >>= 1) v += __shfl_xor(v, o, 64);
  return v;
}
DEVI f32x4 mfma16(bf16x8 a, bf16x8 b, f32x4 c) { return __builtin_amdgcn_mfma_f32_16x16x32_bf16(a, b, c, 0, 0, 0); }

DEVI float rope_freq(int m) { return exp2f(-(float)m * 1.6609640474436813f); }
DEVI void fast_sincos(float ang, float& sn, float& cs) {
  float rev = ang * 0.15915494309189535f;
  rev -= rintf(rev);
  sn = __builtin_amdgcn_sinf(rev);
  cs = __builtin_amdgcn_cosf(rev);
}
typedef unsigned hwu32x2 __attribute__((ext_vector_type(2)));
DEVI float quad_max(float x) {
  hwu32x2 r = __builtin_amdgcn_permlane16_swap(__float_as_uint(x), __float_as_uint(x), false, false);
  x = fmaxf(__uint_as_float(r[0]), __uint_as_float(r[1]));
  r = __builtin_amdgcn_permlane32_swap(__float_as_uint(x), __float_as_uint(x), false, false);
  return fmaxf(__uint_as_float(r[0]), __uint_as_float(r[1]));
}
DEVI float quad_sum(float x) {
  hwu32x2 r = __builtin_amdgcn_permlane16_swap(__float_as_uint(x), __float_as_uint(x), false, false);
  x = __uint_as_float(r[0]) + __uint_as_float(r[1]);
  r = __builtin_amdgcn_permlane32_swap(__float_as_uint(x), __float_as_uint(x), false, false);
  return __uint_as_float(r[0]) + __uint_as_float(r[1]);
}
#define VB ((int)(threadIdx.x >> 8))
#define VT_PAIRG (gridDim.x == 256u)
#define VT_FIRST ((int)(VT_PAIRG ? blockIdx.x : blockIdx.x * 2u))
#define VT_OFF ((int)(VT_PAIRG ? VB * gridDim.x : VB))
DEVI int opaque_tid() { int t = threadIdx.x & 255; asm volatile("" : "+v"(t)); return t; }
DEVI int swz_tile(int t, int T) {
  int q = T >> 3, r = T & 7, x = t & 7, off = t >> 3;
  return (x < r ? x * (q + 1) : r * (q + 1) + (x - r) * q) + off;
}

__shared__ __attribute__((aligned(16))) char g_smem[2 * 73728];
#define NOINL __device__ __forceinline__

constexpr int LDT = 72;
constexpr int TILE_E = 128 * LDT;

template <class Epi>
DEVI void gemm_tile(const bf16_t* __restrict__ A, int lda, const bf16_t* __restrict__ B, int ldb, int K,
                    int m0, int n0, char* smem, Epi epi) {
  const int tid = opaque_tid(), lane = tid & 63, wave = tid >> 6, wm = wave >> 1, wn = wave & 1;
  const int lr = lane & 15, lg = lane >> 4;
  bf16_t* sA = (bf16_t*)smem;
  bf16_t* sB = sA + 2 * TILE_E;
  f32x4 acc[4][4];
#pragma unroll
  for (int i = 0; i < 4; ++i)
#pragma unroll
    for (int j = 0; j < 4; ++j) acc[i][j] = (f32x4){0.f, 0.f, 0.f, 0.f};
  const int lrow = tid >> 3, lkc = (tid & 7) * 8;
  const bf16_t* gA = A + (size_t)(m0 + lrow) * lda + lkc;
  const bf16_t* gB = B + (size_t)(n0 + lrow) * ldb + lkc;
  uint4 ra[4], rb[4];
#pragma unroll
  for (int i = 0; i < 4; ++i) {
    ra[i] = *(const uint4*)(gA + (size_t)(32 * i) * lda);
    rb[i] = *(const uint4*)(gB + (size_t)(32 * i) * ldb);
  }
#pragma unroll
  for (int i = 0; i < 4; ++i) {
    *(uint4*)(sA + (lrow + 32 * i) * LDT + lkc) = ra[i];
    *(uint4*)(sB + (lrow + 32 * i) * LDT + lkc) = rb[i];
  }
  __syncthreads();
  const int nk = K >> 6;
  for (int kt = 0; kt < nk; ++kt) {
    const int cur = kt & 1;
    if (kt + 1 < nk) {
      const int k0 = (kt + 1) << 6;
#pragma unroll
      for (int i = 0; i < 4; ++i) {
        ra[i] = *(const uint4*)(gA + (size_t)(32 * i) * lda + k0);
        rb[i] = *(const uint4*)(gB + (size_t)(32 * i) * ldb + k0);
      }
    }
    const bf16_t* cA = sA + cur * TILE_E + (wm * 64 + lr) * LDT + lg * 8;
    const bf16_t* cB = sB + cur * TILE_E + (wn * 64 + lr) * LDT + lg * 8;
#pragma unroll
    for (int ks = 0; ks < 2; ++ks) {
      bf16x8 af[4], bfr[4];
#pragma unroll
      for (int i = 0; i < 4; ++i) {
        af[i] = *(const bf16x8*)(cA + i * 16 * LDT + ks * 32);
        bfr[i] = *(const bf16x8*)(cB + i * 16 * LDT + ks * 32);
      }
#pragma unroll
      for (int i = 0; i < 4; ++i)
#pragma unroll
        for (int j = 0; j < 4; ++j) acc[i][j] = mfma16(af[i], bfr[j], acc[i][j]);
    }
    if (kt + 1 < nk) {
      const int nx = cur ^ 1;
#pragma unroll
      for (int i = 0; i < 4; ++i) {
        *(uint4*)(sA + nx * TILE_E + (lrow + 32 * i) * LDT + lkc) = ra[i];
        *(uint4*)(sB + nx * TILE_E + (lrow + 32 * i) * LDT + lkc) = rb[i];
      }
    }
    __syncthreads();
  }
#pragma unroll
  for (int i = 0; i < 4; ++i)
#pragma unroll
    for (int j = 0; j < 4; j += 2)
      epi(m0 + wm * 64 + i * 16 + lg * 4, n0 + wn * 64 + j * 16 + lr, acc[i][j], acc[i][j + 1]);
}

struct TileInfo { const bf16_t* a; const bf16_t* b; int m0, n0, ctx; };
template <class TileFn, class Epi>
DEVI void gemm_stream(int T, int lda, int ldb, int K, char* smem, TileFn tf, Epi epi) {
  int t0 = VT_FIRST;
  if (t0 >= T) return;
  int t = min(t0 + VT_OFF, T - 1);
  const int tid = opaque_tid(), lane = tid & 63, wave = tid >> 6, wm = wave >> 1, wn = wave & 1;
  const int lr = lane & 15, lg = lane >> 4;
  bf16_t* sA = (bf16_t*)smem;
  bf16_t* sB = sA + 2 * TILE_E;
  const int lrow = tid >> 3, lkc = (tid & 7) * 8;
  TileInfo ti = tf(t);
  const bf16_t* gA = ti.a + (size_t)lrow * lda + lkc;
  const bf16_t* gB = ti.b + (size_t)lrow * ldb + lkc;
  int m0 = ti.m0, n0 = ti.n0, ctx = ti.ctx;
  uint4 ra0, ra1, ra2, ra3, rb0, rb1, rb2, rb3;
  uint4 rc0, rc1, rc2, rc3, rd0, rd1, rd2, rd3;
#define GS_LOAD0(pa, pb) \
  ra0 = *(const uint4*)((pa)); ra1 = *(const uint4*)((pa) + (size_t)32 * lda); \
  ra2 = *(const uint4*)((pa) + (size_t)64 * lda); ra3 = *(const uint4*)((pa) + (size_t)96 * lda); \
  rb0 = *(const uint4*)((pb)); rb1 = *(const uint4*)((pb) + (size_t)32 * ldb); \
  rb2 = *(const uint4*)((pb) + (size_t)64 * ldb); rb3 = *(const uint4*)((pb) + (size_t)96 * ldb);
#define GS_LOAD1(pa, pb) \
  rc0 = *(const uint4*)((pa)); rc1 = *(const uint4*)((pa) + (size_t)32 * lda); \
  rc2 = *(const uint4*)((pa) + (size_t)64 * lda); rc3 = *(const uint4*)((pa) + (size_t)96 * lda); \
  rd0 = *(const uint4*)((pb)); rd1 = *(const uint4*)((pb) + (size_t)32 * ldb); \
  rd2 = *(const uint4*)((pb) + (size_t)64 * ldb); rd3 = *(const uint4*)((pb) + (size_t)96 * ldb);
#define GS_WRITE0(buf) { \
  bf16_t* wa = sA + (buf) * TILE_E + lrow * LDT + lkc; bf16_t* wb = sB + (buf) * TILE_E + lrow * LDT + lkc; \
  *(uint4*)(wa) = ra0; *(uint4*)(wa + 32 * LDT) = ra1; *(uint4*)(wa + 64 * LDT) = ra2; *(uint4*)(wa + 96 * LDT) = ra3; \
  *(uint4*)(wb) = rb0; *(uint4*)(wb + 32 * LDT) = rb1; *(uint4*)(wb + 64 * LDT) = rb2; *(uint4*)(wb + 96 * LDT) = rb3; }
#define GS_WRITE1(buf) { \
  bf16_t* wa = sA + (buf) * TILE_E + lrow * LDT + lkc; bf16_t* wb = sB + (buf) * TILE_E + lrow * LDT + lkc; \
  *(uint4*)(wa) = rc0; *(uint4*)(wa + 32 * LDT) = rc1; *(uint4*)(wa + 64 * LDT) = rc2; *(uint4*)(wa + 96 * LDT) = rc3; \
  *(uint4*)(wb) = rd0; *(uint4*)(wb + 32 * LDT) = rd1; *(uint4*)(wb + 64 * LDT) = rd2; *(uint4*)(wb + 96 * LDT) = rd3; }
#define GS_COMPUTE(buf) { \
    const bf16_t* cA = sA + (buf) * TILE_E + (wm * 64 + lr) * LDT + lg * 8; \
    const bf16_t* cB = sB + (buf) * TILE_E + (wn * 64 + lr) * LDT + lg * 8; \
    _Pragma("unroll") for (int ks = 0; ks < 2; ++ks) { \
      bf16x8 af[4], bfr[4]; \
      _Pragma("unroll") for (int i = 0; i < 4; ++i) { \
        af[i] = *(const bf16x8*)(cA + i * 16 * LDT + ks * 32); \
        bfr[i] = *(const bf16x8*)(cB + i * 16 * LDT + ks * 32); \
      } \
      __builtin_amdgcn_s_setprio(1); \
      _Pragma("unroll") for (int i = 0; i < 4; ++i) \
        _Pragma("unroll") for (int j = 0; j < 4; ++j) acc[i][j] = mfma16(af[i], bfr[j], acc[i][j]); \
      __builtin_amdgcn_s_setprio(0); \
    } }
  GS_LOAD0(gA, gB)
  GS_WRITE0(0)
  GS_LOAD1(gA + 64, gB + 64)
  __syncthreads();
  const int nk = K >> 6;
  for (;;) {
    f32x4 acc[4][4];
#pragma unroll
    for (int i = 0; i < 4; ++i)
#pragma unroll
      for (int j = 0; j < 4; ++j) acc[i][j] = (f32x4){0.f, 0.f, 0.f, 0.f};
    const int t0n = t0 + gridDim.x * 2;
    const bool have_next = t0n < T;
    const int tn = min(t0n + VT_OFF, T - 1);
    const bf16_t *nA = gA, *nB = gB;
    int nm0 = 0, nn0 = 0, nctx = 0;
    if (have_next) {
      const TileInfo tj = tf(tn);
      nA = tj.a + (size_t)lrow * lda + lkc;
      nB = tj.b + (size_t)lrow * ldb + lkc;
      nm0 = tj.m0; nn0 = tj.n0; nctx = tj.ctx;
    }
    for (int kt = 0; kt < nk; kt += 2) {
      {
        const bool wrap = (kt + 2 >= nk);
        const bf16_t* pa = wrap ? nA : gA + ((kt + 2) << 6);
        const bf16_t* pb = wrap ? nB : gB + ((kt + 2) << 6);
        GS_LOAD0(pa, pb)
        GS_COMPUTE(0)
        GS_WRITE1(1)
        __syncthreads();
      }
      {
        const bool wrap = (kt + 3 >= nk);
        const bf16_t* pa = wrap ? nA + 64 : gA + ((kt + 3) << 6);
        const bf16_t* pb = wrap ? nB + 64 : gB + ((kt + 3) << 6);
        GS_LOAD1(pa, pb)
        GS_COMPUTE(1)
        GS_WRITE0(0)
        __syncthreads();
      }
    }
#pragma unroll
    for (int i = 0; i < 4; ++i)
#pragma unroll
      for (int j = 0; j < 4; j += 2)
        epi(ctx, m0 + wm * 64 + i * 16 + lg * 4, n0 + wn * 64 + j * 16 + lr, acc[i][j], acc[i][j + 1]);
    if (!have_next) break;
    t = tn; t0 = t0n; gA = nA; gB = nB; m0 = nm0; n0 = nn0; ctx = nctx;
  }
}

constexpr int T8_E = 256 * LDT;
template <class TileFn, class Epi>
DEVI void gemm8_stream(int T, int lda, int ldb, int K, TileFn tf, Epi epi) {
  int t = blockIdx.x;
  if (t >= T) return;
  int tid = threadIdx.x; asm volatile("" : "+v"(tid));
  const int lane = tid & 63, wave = tid >> 6, wr = wave >> 2, wc = wave & 3;
  const int lr = lane & 15, lg = lane >> 4;
  bf16_t* sA = (bf16_t*)g_smem;
  bf16_t* sB = sA + 2 * T8_E;
  const int lrow = tid >> 3, lkc = (tid & 7) * 8;
  TileInfo ti = tf(t);
  const unsigned offA = ((unsigned)lrow * (unsigned)lda + (unsigned)lkc) * 2u;
  const unsigned offB = ((unsigned)lrow * (unsigned)ldb + (unsigned)lkc) * 2u;
  const char* gA = (const char*)ti.a;
  const char* gB = (const char*)ti.b;
  const size_t rsA = (size_t)64 * lda * 2, rsB = (size_t)64 * ldb * 2;
  int m0 = ti.m0, n0 = ti.n0, ctx = ti.ctx;
  uint4 ra0, ra1, ra2, ra3, rb0, rb1, rb2, rb3;
  uint4 rc0, rc1, rc2, rc3, rd0, rd1, rd2, rd3;
#define G8_LOAD(pa, pb) \
  ra0 = *(const uint4*)((pa) + offA); ra1 = *(const uint4*)((pa) + rsA + offA); \
  ra2 = *(const uint4*)((pa) + 2 * rsA + offA); ra3 = *(const uint4*)((pa) + 3 * rsA + offA); \
  rb0 = *(const uint4*)((pb) + offB); rb1 = *(const uint4*)((pb) + rsB + offB); \
  rb2 = *(const uint4*)((pb) + 2 * rsB + offB); rb3 = *(const uint4*)((pb) + 3 * rsB + offB);
#define G8_WRITE(buf) { \
  bf16_t* wa = sA + (buf) * T8_E + lrow * LDT + lkc; bf16_t* wb = sB + (buf) * T8_E + lrow * LDT + lkc; \
  *(uint4*)(wa) = ra0; *(uint4*)(wa + 64 * LDT) = ra1; *(uint4*)(wa + 128 * LDT) = ra2; *(uint4*)(wa + 192 * LDT) = ra3; \
  *(uint4*)(wb) = rb0; *(uint4*)(wb + 64 * LDT) = rb1; *(uint4*)(wb + 128 * LDT) = rb2; *(uint4*)(wb + 192 * LDT) = rb3; }
#define G8_LOAD1(pa, pb) \
  rc0 = *(const uint4*)((pa) + offA); rc1 = *(const uint4*)((pa) + rsA + offA); \
  rc2 = *(const uint4*)((pa) + 2 * rsA + offA); rc3 = *(const uint4*)((pa) + 3 * rsA + offA); \
  rd0 = *(const uint4*)((pb) + offB); rd1 = *(const uint4*)((pb) + rsB + offB); \
  rd2 = *(const uint4*)((pb) + 2 * rsB + offB); rd3 = *(const uint4*)((pb) + 3 * rsB + offB);
#define G8_WRITE1(buf) { \
  bf16_t* wa = sA + (buf) * T8_E + lrow * LDT + lkc; bf16_t* wb = sB + (buf) * T8_E + lrow * LDT + lkc; \
  *(uint4*)(wa) = rc0; *(uint4*)(wa + 64 * LDT) = rc1; *(uint4*)(wa + 128 * LDT) = rc2; *(uint4*)(wa + 192 * LDT) = rc3; \
  *(uint4*)(wb) = rd0; *(uint4*)(wb + 64 * LDT) = rd1; *(uint4*)(wb + 128 * LDT) = rd2; *(uint4*)(wb + 192 * LDT) = rd3; }
#define G8_COMPUTE(buf) { \
      const bf16_t* cA = sA + (buf) * T8_E + (wr * 128 + lr) * LDT + lg * 8; \
      const bf16_t* cB = sB + (buf) * T8_E + (wc * 64 + lr) * LDT + lg * 8; \
      _Pragma("unroll") for (int ks = 0; ks < 2; ++ks) { \
        bf16x8 bfr[4]; \
        _Pragma("unroll") for (int j = 0; j < 4; ++j) bfr[j] = *(const bf16x8*)(cB + j * 16 * LDT + ks * 32); \
        _Pragma("unroll") for (int h = 0; h < 2; ++h) { \
          bf16x8 af[4]; \
          _Pragma("unroll") for (int i = 0; i < 4; ++i) af[i] = *(const bf16x8*)(cA + (h * 4 + i) * 16 * LDT + ks * 32); \
          _Pragma("unroll") for (int i = 0; i < 4; ++i) \
            _Pragma("unroll") for (int j = 0; j < 4; ++j) acc[h * 4 + i][j] = mfma16(af[i], bfr[j], acc[h * 4 + i][j]); \
        } \
      } }
  G8_LOAD(gA, gB)
  G8_WRITE(0)
  G8_LOAD1(gA + 128, gB + 128)
  __syncthreads();
  const int nk = K >> 6;
  for (;;) {
    f32x4 acc[8][4];
#pragma unroll
    for (int i = 0; i < 8; ++i)
#pragma unroll
      for (int j = 0; j < 4; ++j) acc[i][j] = (f32x4){0.f, 0.f, 0.f, 0.f};
    const int tn = t + gridDim.x;
    const bool have_next = tn < T;
    const char *nA = gA, *nB = gB;
    int nm0 = 0, nn0 = 0, nctx = 0;
    if (have_next) {
      const TileInfo tj = tf(tn);
      nA = (const char*)tj.a;
      nB = (const char*)tj.b;
      nm0 = tj.m0; nn0 = tj.n0; nctx = tj.ctx;
    }
#pragma unroll 1
    for (int kt = 0; kt < nk; kt += 2) {
      {
        const bool wrap = (kt + 2 >= nk);
        const char* pa = wrap ? nA : gA + ((kt + 2) << 7);
        const char* pb = wrap ? nB : gB + ((kt + 2) << 7);
        G8_LOAD(pa, pb)
        G8_COMPUTE(0)
        G8_WRITE1(1)
        __syncthreads();
      }
      {
        const bool wrap = (kt + 3 >= nk);
        const char* pa = wrap ? nA + 128 : gA + ((kt + 3) << 7);
        const char* pb = wrap ? nB + 128 : gB + ((kt + 3) << 7);
        G8_LOAD1(pa, pb)
        G8_COMPUTE(1)
        G8_WRITE(0)
        __syncthreads();
      }
    }
#pragma unroll
    for (int i = 0; i < 8; ++i)
#pragma unroll
      for (int j = 0; j < 4; j += 2)
        epi(ctx, m0 + wr * 128 + i * 16 + lg * 4, n0 + wc * 64 + j * 16 + lr, acc[i][j], acc[i][j + 1]);
    if (!have_next) break;
    t = tn; gA = nA; gB = nB; m0 = nm0; n0 = nn0; ctx = nctx;
  }
}

DEVI void tile_mn(int t, int nM, int nN, int& m, int& n) {
  int id = swz_tile(t, nM * nN);
  int per = 8 * nN;
  int gq = id / per, rem = id - gq * per;
  int gsz = min(8, nM - gq * 8);
  m = gq * 8 + rem % gsz;
  n = rem / gsz;
}

NOINL void gemv_tile(const P& p, int t) {
  char* smem = g_smem + VB * 73728;
  const int tid = opaque_tid();
  float* sv = (float*)smem;
  float* red = sv + 3072;
  const int l = t / 192, n0 = (t % 192) * 32;
  for (int i = tid; i < 3072; i += 256) {
    int v = i >> 10, k = i & 1023;
    float cv = (v == 0) ? p.c_ctx[k] : p.c[(v - 1) * 1024 + k];
    sv[i] = cv / (1.f + expf(-cv));
  }
  __syncthreads();
  const int cgp = tid & 7, ks = tid >> 3;
  const float* w = p.w_mod + (size_t)l * 1024 * 6144 + n0 + cgp * 4;
  float a0[4] = {0, 0, 0, 0}, a1[4] = {0, 0, 0, 0}, a2[4] = {0, 0, 0, 0};
#pragma unroll 16
  for (int kk = 0; kk < 32; ++kk) {
    const int k = ks * 32 + kk;
    const float4 wv = *(const float4*)(w + (size_t)k * 6144);
    const float s0 = sv[k], s1 = sv[1024 + k], s2 = sv[2048 + k];
    a0[0] += s0 * wv.x; a0[1] += s0 * wv.y; a0[2] += s0 * wv.z; a0[3] += s0 * wv.w;
    a1[0] += s1 * wv.x; a1[1] += s1 * wv.y; a1[2] += s1 * wv.z; a1[3] += s1 * wv.w;
    a2[0] += s2 * wv.x; a2[1] += s2 * wv.y; a2[2] += s2 * wv.z; a2[3] += s2 * wv.w;
  }
#pragma unroll
  for (int j = 0; j < 4; ++j) {
    red[(ks * 3 + 0) * 32 + cgp * 4 + j] = a0[j];
    red[(ks * 3 + 1) * 32 + cgp * 4 + j] = a1[j];
    red[(ks * 3 + 2) * 32 + cgp * 4 + j] = a2[j];
  }
  __syncthreads();
  if (tid < 96) {
    const int v = tid >> 5, col = tid & 31;
    float s = 0.f;
    for (int q = 0; q < 32; ++q) s += red[(q * 3 + v) * 32 + col];
    s += p.b_mod[l * 6144 + n0 + col];
    WSF(OFF_MOD)[(l * 3 + v) * 6144 + n0 + col] = s;
  }
  __syncthreads();
}

NOINL void transpose_tile(const P& p, int t) {
  char* smem = g_smem + VB * 73728;
  const int tid = opaque_tid();
  const float* src; bf16_t* dst; int K, N, ntn, mode = 0;
  if (t < 544) { src = p.w_in; dst = WSB(OFF_WIN); K = 1024; N = 2096; ntn = 34; }
  else if ((t -= 544) < 48) { src = p.w_uq; dst = WSB(OFF_WUQ); K = 256; N = 768; ntn = 12; }
  else if ((t -= 48) < 64) { src = p.w_ukv; dst = WSB(OFF_WUKV); K = 256; N = 1024; ntn = 16; }
  else if ((t -= 64) < 256) { src = p.w_out; dst = WSB(OFF_WOUT); K = 1024; N = 1024; ntn = 16; }
  else if ((t -= 256) < 64) { int g = t >> 4; t &= 15; src = p.pool_w + (size_t)g * 65536; dst = WSB(OFF_WPOOL) + (size_t)g * 65536; K = 256; N = 256; ntn = 4; }
  else if ((t -= 64) < 1408) { int l = t / 704; t -= l * 704; src = p.w_gate + (size_t)l * 1024 * 2816; dst = WSB(OFF_WGU) + (size_t)l * 5632 * 1024; K = 1024; N = 2816; ntn = 44; mode = 1; }
  else if ((t -= 1408) < 1408) { int l = t / 704; t -= l * 704; src = p.w_up + (size_t)l * 1024 * 2816; dst = WSB(OFF_WGU) + (size_t)l * 5632 * 1024; K = 1024; N = 2816; ntn = 44; mode = 2; }
  else { t -= 1408; int l = t / 704; t -= l * 704; src = p.w_down + (size_t)l * 2816 * 1024; dst = WSB(OFF_WDN) + (size_t)l * 1024 * 2816; K = 2816; N = 1024; ntn = 16; }
  const int kt = t / ntn, nt_ = t - kt * ntn;
  const int k0 = kt * 64, n0 = nt_ * 64;
  float* tile = (float*)smem;
  {
    const int nn = tid & 63, kk0 = tid >> 6;
    const int n = n0 + nn;
    const int nc = n < N ? n : N - 1;
    float v[16];
#pragma unroll
    for (int i = 0; i < 16; ++i) v[i] = src[(size_t)(k0 + kk0 + 4 * i) * N + nc];
#pragma unroll
    for (int i = 0; i < 16; ++i) tile[(kk0 + 4 * i) * 65 + nn] = (n < N) ? v[i] : 0.f;
  }
  __syncthreads();
#pragma unroll
  for (int i = 0; i < 2; ++i) {
    const int id = tid + 256 * i;
    const int nn = id >> 3, kc = id & 7;
    const int n = n0 + nn;
    uint4 pk;
    pk.x = pack2(tile[(kc * 8 + 0) * 65 + nn], tile[(kc * 8 + 1) * 65 + nn]);
    pk.y = pack2(tile[(kc * 8 + 2) * 65 + nn], tile[(kc * 8 + 3) * 65 + nn]);
    pk.z = pack2(tile[(kc * 8 + 4) * 65 + nn], tile[(kc * 8 + 5) * 65 + nn]);
    pk.w = pack2(tile[(kc * 8 + 6) * 65 + nn], tile[(kc * 8 + 7) * 65 + nn]);
    int drow = n;
    if (mode == 1) drow = (n >> 4) * 32 + (n & 15);
    else if (mode == 2) drow = (n >> 4) * 32 + 16 + (n & 15);
    *(uint4*)(dst + (size_t)drow * K + k0 + kc * 8) = pk;
  }
  __syncthreads();
}

template <bool UPD, bool MOD, bool FIRST, bool LASTW, bool TWO, bool POOL = false>
DEVI void rowop(const P& p, const bf16_t* msrc, const bf16_t* msrc2, const float* wpost, int gate_idx, const float* wpre, int shift_idx,
                int scale_idx, int layer_g, int layer_m) {
  const int lane = threadIdx.x & 63, wave = threadIdx.x >> 6;
  const float* modg = WSF(OFF_MOD) + (size_t)layer_g * 3 * 6144;
  const float* modm = WSF(OFF_MOD) + (size_t)layer_m * 3 * 6144;
  bf16_t* hbuf = WSB(OFF_H);
  for (int r = blockIdx.x * 8 + wave; r < 8192; r += gridDim.x * 8) {
    const int v = r < 4096 ? 0 : 1 + ((r - 4096) >> 11);
    const float* mvg = modg + v * 6144;
    const float* mvm = modm + v * 6144;
    float4 x[4];
    if (FIRST) {
      const float* xin = r < 4096 ? p.x_prompt + (size_t)r * 1024 : p.x_sample + (size_t)(r - 4096) * 1024;
#pragma unroll
      for (int i = 0; i < 4; ++i) x[i] = *(const float4*)(xin + lane * 4 + 256 * i);
    } else {
#pragma unroll
      for (int i = 0; i < 4; ++i) {
        const uint2 xb = *(const uint2*)(WSB(OFF_XR) + (size_t)r * 1024 + lane * 4 + 256 * i);
        x[i].x = __uint_as_float(xb.x << 16); x[i].y = __uint_as_float(xb.x & 0xffff0000u);
        x[i].z = __uint_as_float(xb.y << 16); x[i].w = __uint_as_float(xb.y & 0xffff0000u);
      }
    }
    if (UPD) {
      float4 m[4];
      float ss = 0.f;
      int ps0 = 0, pL = 0;
      if (POOL) { if (r < 4096) { ps0 = r & ~255; pL = 256; } else { ps0 = 4096 + ((r - 4096) & ~2047); pL = 2048; } }
#pragma unroll
      for (int i = 0; i < 4; ++i) {
        if (POOL) {
          constexpr int dummy = 0; (void)dummy;
          const int W2 = 1 << i;
          const int t = r - ps0;
          const int lo = max(t - W2, 0), hi = min(t + W2, pL);
          float a0 = 0.f, a1 = 0.f, a2 = 0.f, a3 = 0.f;
          uint2 ctr = make_uint2(0u, 0u);
#pragma unroll
          for (int k = 0; k < 2 * W2; ++k) {
            const int u = t - W2 + k;
            const int uc = min(max(u, 0), pL - 1);
            const uint2 g = *(const uint2*)(msrc + (size_t)(ps0 + uc) * 1024 + lane * 4 + 256 * i);
            const float w = (u >= 0 && u < pL) ? 1.f : 0.f;
            a0 += w * __uint_as_float(g.x << 16); a1 += w * __uint_as_float(g.x & 0xffff0000u);
            a2 += w * __uint_as_float(g.y << 16); a3 += w * __uint_as_float(g.y & 0xffff0000u);
            if (k == W2) ctr = g;
          }
          const float inv = 1.f / (float)(hi - lo);
          m[i].x = a0 * inv - __uint_as_float(ctr.x << 16); m[i].y = a1 * inv - __uint_as_float(ctr.x & 0xffff0000u);
          m[i].z = a2 * inv - __uint_as_float(ctr.y << 16); m[i].w = a3 * inv - __uint_as_float(ctr.y & 0xffff0000u);
          ss += m[i].x * m[i].x + m[i].y * m[i].y + m[i].z * m[i].z + m[i].w * m[i].w;
          continue;
        }
        const uint2 mb = *(const uint2*)(msrc + (size_t)r * 1024 + lane * 4 + 256 * i);
        m[i].x = __uint_as_float(mb.x << 16); m[i].y = __uint_as_float(mb.x & 0xffff0000u);
        m[i].z = __uint_as_float(mb.y << 16); m[i].w = __uint_as_float(mb.y & 0xffff0000u);
        if (TWO) {
          const uint2 mc = *(const uint2*)(msrc2 + (size_t)r * 1024 + lane * 4 + 256 * i);
          m[i].x += __uint_as_float(mc.x << 16); m[i].y += __uint_as_float(mc.x & 0xffff0000u);
          m[i].z += __uint_as_float(mc.y << 16); m[i].w += __uint_as_float(mc.y & 0xffff0000u);
        }
        ss += m[i].x * m[i].x + m[i].y * m[i].y + m[i].z * m[i].z + m[i].w * m[i].w;
      }
      ss = wave_sum(ss);
      const float rs = rsqrtf(ss * (1.f / 1024.f) + 1e-6f);
#pragma unroll
      for (int i = 0; i < 4; ++i) {
        const int col = lane * 4 + 256 * i;
        const float4 wp = *(const float4*)(wpost + col);
        const float4 g = *(const float4*)(mvg + gate_idx * 1024 + col);
        x[i].x += g.x * (m[i].x * rs * wp.x);
        x[i].y += g.y * (m[i].y * rs * wp.y);
        x[i].z += g.z * (m[i].z * rs * wp.z);
        x[i].w += g.w * (m[i].w * rs * wp.w);
        if (LASTW) *(float4*)(p.out + (size_t)r * 1024 + col) = x[i];
        else {
          uint2 xo;
          xo.x = pack2(x[i].x, x[i].y);
          xo.y = pack2(x[i].z, x[i].w);
          *(uint2*)(WSB(OFF_XR) + (size_t)r * 1024 + col) = xo;
        }
      }
    }
    if (MOD) {
      float ss = 0.f;
#pragma unroll
      for (int i = 0; i < 4; ++i) ss += x[i].x * x[i].x + x[i].y * x[i].y + x[i].z * x[i].z + x[i].w * x[i].w;
      ss = wave_sum(ss);
      const float rs = rsqrtf(ss * (1.f / 1024.f) + 1e-6f);
#pragma unroll
      for (int i = 0; i < 4; ++i) {
        const int col = lane * 4 + 256 * i;
        const float4 wp = *(const float4*)(wpre + col);
        const float4 sh = *(const float4*)(mvm + shift_idx * 1024 + col);
        const float4 sc = *(const float4*)(mvm + scale_idx * 1024 + col);
        uint2 o;
        o.x = pack2(x[i].x * rs * wp.x * (1.f + sc.x) + sh.x, x[i].y * rs * wp.y * (1.f + sc.y) + sh.y);
        o.y = pack2(x[i].z * rs * wp.z * (1.f + sc.z) + sh.z, x[i].w * rs * wp.w * (1.f + sc.w) + sh.w);
        *(uint2*)(hbuf + (size_t)r * 1024 + col) = o;
      }
    }
  }
}

NOINL void prep_rows(const P& p) {
  const int lane = threadIdx.x & 63, wave = threadIdx.x >> 6;
  const float* proj = WSF(OFF_R1);
  for (int r = blockIdx.x * 8 + wave; r < 8192; r += gridDim.x * 8) {
    const float* pr = proj + (size_t)r * 2096;
    const int kvrow = r < 4096 ? r : 4096 + ((r - 4096) >> 11) * 2304 + 256 + ((r - 4096) & 2047);
    const float4 ld_cq = *(const float4*)(pr + lane * 4);
    const float4 ld_ckv = *(const float4*)(pr + 256 + lane * 4);
    const float ld_kpe = pr[512 + (lane & 31)];
    const float ld_dt = pr[2080 + (lane & 15)];
    {
      const float4 a = ld_cq;
      float ss = wave_sum(a.x * a.x + a.y * a.y + a.z * a.z + a.w * a.w);
      const float rs = rsqrtf(ss * (1.f / 256.f) + 1e-6f);
      const float4 g = *(const float4*)(p.q_norm + lane * 4);
      uint2 o;
      o.x = pack2(a.x * rs * g.x, a.y * rs * g.y);
      o.y = pack2(a.z * rs * g.z, a.w * rs * g.w);
      *(uint2*)(WSB(OFF_CQN) + (size_t)r * 256 + lane * 4) = o;
    }
    {
      const float4 a = ld_ckv;
      float ss = wave_sum(a.x * a.x + a.y * a.y + a.z * a.z + a.w * a.w);
      const float rs = rsqrtf(ss * (1.f / 256.f) + 1e-6f);
      const float4 g = *(const float4*)(p.kv_norm + lane * 4);
      float4 vv;
      vv.x = a.x * rs * g.x; vv.y = a.y * rs * g.y; vv.z = a.z * rs * g.z; vv.w = a.w * rs * g.w;
      if (r < 4096) *(float4*)(p.out + OUT_CKV + (size_t)r * 256 + lane * 4) = vv;
      uint2 o;
      o.x = pack2(vv.x, vv.y);
      o.y = pack2(vv.z, vv.w);
      *(uint2*)(WSB(OFF_CKV) + (size_t)kvrow * 256 + lane * 4) = o;
    }
    {
      const float kv = (lane < 32) ? ld_kpe : 0.f;
      const float partner = __shfl_xor(kv, 16, 64);
      if (r < 4096) {
        if (lane < 32) {
          p.out[OUT_KR + (size_t)r * 32 + lane] = kv;
          WSB(OFF_KPE)[(size_t)kvrow * 32 + lane] = f2bf(kv);
        }
      } else {
        const int t = (r - 4096) & 2047;
        const int ii = lane & 15;
        const float pos = (ii < 8) ? (float)(t >> 6) : (float)(t & 63);
        const float fr = rope_freq(ii & 7);
        const float ang = pos * fr;
        float cs, sn;
        fast_sincos(ang, sn, cs);
        const float o = (lane < 16) ? (kv * cs - partner * sn) : (partner * sn + kv * cs);
        if (lane < 32) WSB(OFF_KPE)[(size_t)kvrow * 32 + lane] = f2bf(o);
      }
    }
    if (lane < 16) {
      const int dir = lane >> 3, hh = lane & 7;
      const float raw = ld_dt + (dir ? p.dtb_b[hh] : p.dtb_f[hh]);
      const float sp = raw > 20.f ? raw : log1pf(expf(raw));
      WSF(OFF_DTV)[((size_t)dir * 8192 + r) * 8 + hh] = sp;
    }
  }
}

NOINL void prep_cache(const P& p) {
  const int gt = blockIdx.x * 512 + threadIdx.x, gs = gridDim.x * 512;
  for (int i = gt; i < 2 * 256 * 256; i += gs) {
    int b = i >> 16, rem = i & 65535;
    WSB(OFF_CKV)[(size_t)(4096 + b * 2304) * 256 + rem] = f2bf(p.cache_ckv[i]);
  }
  for (int i = gt; i < 2 * 256 * 32; i += gs) {
    int b = i >> 13, rem = i & 8191;
    WSB(OFF_KPE)[(size_t)(4096 + b * 2304) * 32 + rem] = f2bf(p.cache_kr[i]);
  }
}

NOINL void conv_tile(const P& p, int t) {
  char* smem = g_smem + VB * 73728;
  const int tid = opaque_tid();
  float* sin_ = (float*)smem;
  float* sout = sin_ + 68 * 64;
  const int tt_ = t >> 4, ct = t & 15;
  const int r0 = tt_ * 64, c0 = ct * 64;
  int s0, s1;
  if (r0 < 4096) { s0 = r0 & ~255; s1 = s0 + 256; } else { s0 = 4096 + ((r0 - 4096) & ~2047); s1 = s0 + 2048; }
  const float* proj = WSF(OFF_R1);
  {
    const int rr0 = tid >> 6, cc = tid & 63;
    float v[17];
#pragma unroll
    for (int k = 0; k < 17; ++k) {
      const int r = r0 - 2 + rr0 + 4 * k;
      const int rc = r < s0 ? s0 : (r >= s1 ? s1 - 1 : r);
      v[k] = proj[(size_t)rc * 2096 + 1056 + c0 + cc];
    }
#pragma unroll
    for (int k = 0; k < 17; ++k) {
      const int r = r0 - 2 + rr0 + 4 * k;
      sin_[(rr0 + 4 * k) * 64 + cc] = (r >= s0 && r < s1) ? v[k] : 0.f;
    }
  }
  __syncthreads();
  {
    const int cc = tid & 63, tq = tid >> 6;
    const int c = c0 + cc;
    const float w0 = p.conv_w[c], w1 = p.conv_w[1024 + c], w2 = p.conv_w[2048 + c], w3 = p.conv_w[3072 + c],
                w4 = p.conv_w[4096 + c], bias = p.conv_b[c];
#pragma unroll 4
    for (int i = 0; i < 16; ++i) {
      const int tt = tq * 16 + i;
      float y = bias + w0 * sin_[tt * 64 + cc] + w1 * sin_[(tt + 1) * 64 + cc] + w2 * sin_[(tt + 2) * 64 + cc] +
                w3 * sin_[(tt + 3) * 64 + cc] + w4 * sin_[(tt + 4) * 64 + cc];
      y = y / (1.f + __expf(-y));
      sout[tt * 65 + cc] = y;
      const bf16_t b = f2bf(y);
      const size_t r = r0 + tt;
      if (c < 512) WSB(OFF_XS)[r * 512 + c] = b;
      else if (c < 768) WSB(OFF_BM)[r * 256 + (c - 512)] = b;
      else WSB(OFF_CM)[r * 256 + (c - 768)] = b;
    }
  }
  __syncthreads();
  if (c0 < 768) {
    const int cl = tid >> 2, q4 = tid & 3;
    uint4 o0, o1;
    const float* sp = sout + (q4 * 16) * 65 + cl;
    o0.x = pack2(sp[0 * 65], sp[1 * 65]);   o0.y = pack2(sp[2 * 65], sp[3 * 65]);
    o0.z = pack2(sp[4 * 65], sp[5 * 65]);   o0.w = pack2(sp[6 * 65], sp[7 * 65]);
    o1.x = pack2(sp[8 * 65], sp[9 * 65]);   o1.y = pack2(sp[10 * 65], sp[11 * 65]);
    o1.z = pack2(sp[12 * 65], sp[13 * 65]); o1.w = pack2(sp[14 * 65], sp[15 * 65]);
    bf16_t* dst = (c0 < 512) ? WSB(OFF_XST) + (size_t)(c0 + cl) * 8192 : WSB(OFF_BT) + (size_t)(c0 - 512 + cl) * 8192;
    dst += r0 + q4 * 16;
    *(uint4*)(dst) = o0;
    *(uint4*)(dst + 8) = o1;
  }
  __syncthreads();
}

NOINL void chunk_state_item(const P& p, int item) {
  char* smem = g_smem + VB * 73728;
  const int tid = opaque_tid(), lane = tid & 63, wave = tid >> 6, lr = lane & 15, lg = lane >> 4;
  const int cidx = item >> 3, hh = item & 7, g = hh >> 2;
  const int r0 = cidx * 128;
  constexpr int LDS_ = 136;
  bf16_t* sAs = (bf16_t*)smem;
  bf16_t* sBs = sAs + 2 * 64 * LDS_;
  float* fa = (float*)(sBs + 128 * LDS_);
  float* fcum = fa + 256;
  float* fw = fa + 512;
  float* fdt = fa + 768;
  {
    const int dir = tid >> 7, j = tid & 127;
    const float dt = WSF(OFF_DTV)[((size_t)dir * 8192 + r0 + j) * 8 + hh];
    const float Aco = -expf(dir ? p.alog_b[hh] : p.alog_f[hh]);
    fa[tid] = dt * Aco;
    fdt[tid] = dt;
  }
  __syncthreads();
  {
    const int dir = tid >> 7, j = tid & 127;
    float s = 0.f;
    const float4* fa4 = (const float4*)(fa + dir * 128);
    if (dir == 0) {
      const int nb = (j + 1) >> 2;
      for (int k4 = 0; k4 < nb; ++k4) { const float4 v = fa4[k4]; s += (v.x + v.y) + (v.z + v.w); }
      for (int k = nb * 4; k <= j; ++k) s += fa[k];
    } else {
      const int fb = (j + 3) >> 2;
      for (int k4 = 31; k4 >= fb; --k4) { const float4 v = fa4[k4]; s += (v.x + v.y) + (v.z + v.w); }
      for (int k = j; k < fb * 4; ++k) s += fa[128 + k];
    }
    fcum[tid] = s;
    WSF(OFF_CUM)[((size_t)dir * 8192 + r0 + j) * 8 + hh] = s;
  }
  __syncthreads();
  {
    const int dir = tid >> 7;
    const float ce = dir ? fcum[128] : fcum[127];
    fw[tid] = __expf(ce - fcum[tid]) * fdt[tid];
    if ((tid & 127) == 0) WSF(OFF_TOT)[(dir * 64 + cidx) * 8 + hh] = __expf(ce);
  }
  __syncthreads();
#pragma unroll
  for (int i = 0; i < 4; ++i) {
    const int id = tid + 256 * i;
    const int pp = id >> 4, jc = (id & 15) * 8;
    const uint4 raw = *(const uint4*)(WSB(OFF_XST) + (size_t)(hh * 64 + pp) * 8192 + r0 + jc);
    const unsigned rw[4] = {raw.x, raw.y, raw.z, raw.w};
    unsigned of[4], ob[4];
#pragma unroll
    for (int q = 0; q < 4; ++q) {
      const float x0 = __uint_as_float(rw[q] << 16), x1 = __uint_as_float(rw[q] & 0xffff0000u);
      of[q] = pack2(x0 * fw[jc + 2 * q], x1 * fw[jc + 2 * q + 1]);
      ob[q] = pack2(x0 * fw[128 + jc + 2 * q], x1 * fw[128 + jc + 2 * q + 1]);
    }
    *(uint4*)(sAs + pp * LDS_ + jc) = make_uint4(of[0], of[1], of[2], of[3]);
    *(uint4*)(sAs + 64 * LDS_ + pp * LDS_ + jc) = make_uint4(ob[0], ob[1], ob[2], ob[3]);
  }
#pragma unroll
  for (int i = 0; i < 8; ++i) {
    const int id = tid + 256 * i;
    const int nn = id >> 4, jc = (id & 15) * 8;
    *(uint4*)(sBs + nn * LDS_ + jc) = *(const uint4*)(WSB(OFF_BT) + (size_t)(g * 128 + nn) * 8192 + r0 + jc);
  }
  __syncthreads();
  {
    const int dir = wave >> 1, nh = wave & 1;
    f32x4 acc[4][4];
#pragma unroll
    for (int i = 0; i < 4; ++i)
#pragma unroll
      for (int j = 0; j < 4; ++j) acc[i][j] = (f32x4){0.f, 0.f, 0.f, 0.f};
    const bf16_t* cA = sAs + dir * 64 * LDS_ + lr * LDS_ + lg * 8;
    const bf16_t* cB = sBs + (nh * 64 + lr) * LDS_ + lg * 8;
#pragma unroll 1
    for (int ks = 0; ks < 4; ++ks) {
      bf16x8 af[4], bfr[4];
#pragma unroll
      for (int i = 0; i < 4; ++i) {
        af[i] = *(const bf16x8*)(cA + i * 16 * LDS_ + ks * 32);
        bfr[i] = *(const bf16x8*)(cB + i * 16 * LDS_ + ks * 32);
      }
#pragma unroll
      for (int i = 0; i < 4; ++i)
#pragma unroll
        for (int j = 0; j < 4; ++j) acc[i][j] = mfma16(af[i], bfr[j], acc[i][j]);
    }
    float* S = WSF(OFF_R2) + ((size_t)(dir * 64 + cidx) * 8 + hh) * 8192 + (lg * 4) * 128 + nh * 64 + lr;
#pragma unroll
    for (int i = 0; i < 4; ++i) {
#pragma unroll
      for (int q = 0; q < 4; ++q) {
#pragma unroll
        for (int j = 0; j < 4; ++j) S[j * 16] = acc[i][j][q];
        S += 128;
      }
      S += 12 * 128;
      __builtin_amdgcn_sched_barrier(0);
    }
  }
  __syncthreads();
}

template <int NB>
DEVI void scan_group(const P& p, float4& h, int dir, int cb, int nc, int c0, int hh, size_t eoff) {
  float4 sv[NB];
  float d[NB];
  size_t base[NB];
#pragma unroll
  for (int k = 0; k < NB; ++k) {
    const int c = c0 + k;
    const int cidx = cb + (dir ? nc - 1 - c : c);
    base[k] = ((size_t)(dir * 64 + cidx) * 8 + hh) * 8192 + eoff;
    d[k] = WSF(OFF_TOT)[(dir * 64 + cidx) * 8 + hh];
    sv[k] = *(const float4*)(WSF(OFF_R2) + base[k]);
  }
#pragma unroll
  for (int k = 0; k < NB; ++k) {
    uint2 o;
    o.x = pack2(h.x, h.y);
    o.y = pack2(h.z, h.w);
    *(uint2*)(WSB(OFF_H) + base[k]) = o;
    h.x = d[k] * h.x + sv[k].x; h.y = d[k] * h.y + sv[k].y; h.z = d[k] * h.z + sv[k].z; h.w = d[k] * h.w + sv[k].w;
  }
}

NOINL void scan_states(const P& p) {
  const int total = 2 * 18 * 8 * 64 * 32;
  for (int idx = blockIdx.x * 512 + threadIdx.x; idx < total; idx += gridDim.x * 512) {
    const int n4 = idx & 31, pp = (idx >> 5) & 63, hh = (idx >> 11) & 7;
    const int sd = idx >> 14;
    const int s = sd % 18, dir = sd / 18;
    const int nc = s < 16 ? 2 : 16;
    const int cb = s < 16 ? s * 2 : 32 + (s - 16) * 16;
    float4 h = make_float4(0.f, 0.f, 0.f, 0.f);
    const size_t eoff = (size_t)pp * 128 + n4 * 4;
    if (s >= 16) {
      const float* st = (dir ? p.st_b : p.st_f) + ((size_t)((s - 16) * 8 + hh) * 64 + pp) * 128 + n4 * 4;
      h = *(const float4*)st;
      scan_group<8>(p, h, dir, cb, nc, 0, hh, eoff);
      scan_group<8>(p, h, dir, cb, nc, 8, hh, eoff);
    } else {
      scan_group<2>(p, h, dir, cb, nc, 0, hh, eoff);
      float* o = p.out + (dir ? OUT_SB : OUT_SF) + ((size_t)(s * 8 + hh) * 64 + pp) * 128 + n4 * 4;
      *(float4*)o = h;
    }
  }
}

NOINL void attn_item(const P& p, int id) {
  char* smem = g_smem + VB * 73728;
  const int tid = opaque_tid(), lane = tid & 63, wave = tid >> 6, lr = lane & 15, lg = lane >> 4;
  int row0, kvbase, Lk, hh;
  if (id < 512) { hh = id & 7; const int b = (id >> 3) & 1; const int qb = id >> 4; row0 = 4096 + b * 2048 + qb * 64; kvbase = 4096 + b * 2304; Lk = 2304; }
  else { const int i2 = id - 512; hh = i2 & 7; const int rest = i2 >> 3; const int b = rest >> 2; const int qb = rest & 3; row0 = b * 256 + qb * 64; kvbase = b * 256; Lk = 256; }
  constexpr int LDK = 104, LDV = 72;
  constexpr int KVBUF = 64 * LDK + 64 * LDV;
  bf16_t* sKV = (bf16_t*)smem;
  const int qrow = row0 + wave * 16 + lr;
  bf16x8 qf[3];
#pragma unroll
  for (int ks = 0; ks < 3; ++ks) qf[ks] = *(const bf16x8*)(WSB(OFF_Q) + (size_t)qrow * 768 + hh * 96 + ks * 32 + lg * 8);
  f32x4 oacc[4];
#pragma unroll
  for (int i = 0; i < 4; ++i) oacc[i] = (f32x4){0.f, 0.f, 0.f, 0.f};
  float mrun = -1e30f, lrun = 0.f;
  const int nkt = Lk >> 6;
  const int kkey0 = tid / 12, kcc0 = tid - kkey0 * 12;
  const int c1 = tid + 256, kkey1 = c1 / 12, kcc1 = c1 - kkey1 * 12;
  const int c2 = tid + 512, kkey2 = c2 / 12, kcc2 = c2 - kkey2 * 12;
  const bf16_t* kn = WSB(OFF_KN);
  const bf16_t* kp = WSB(OFF_KPE);
  const bf16_t* ksrc0 = (kcc0 < 8) ? kn + (size_t)(kvbase + kkey0) * 512 + hh * 64 + kcc0 * 8 : kp + (size_t)(kvbase + kkey0) * 32 + (kcc0 - 8) * 8;
  const bf16_t* ksrc1 = (kcc1 < 8) ? kn + (size_t)(kvbase + kkey1) * 512 + hh * 64 + kcc1 * 8 : kp + (size_t)(kvbase + kkey1) * 32 + (kcc1 - 8) * 8;
  const bf16_t* ksrc2 = (kcc2 < 8) ? kn + (size_t)(kvbase + kkey2) * 512 + hh * 64 + kcc2 * 8 : kp + (size_t)(kvbase + kkey2) * 32 + (kcc2 - 8) * 8;
  const int kst0 = (kcc0 < 8) ? 512 * 64 : 32 * 64, kst1 = (kcc1 < 8) ? 512 * 64 : 32 * 64, kst2 = (kcc2 < 8) ? 512 * 64 : 32 * 64;
  const int vd0 = tid >> 3, vcc = tid & 7;
  const bf16_t* vsrc0 = WSB(OFF_VT) + (size_t)(hh * 64 + vd0) * 8704 + kvbase + vcc * 8;
  const bf16_t* vsrc1 = vsrc0 + (size_t)32 * 8704;
  uint4 rk0, rk1, rk2, rv0, rv1;
#define AT_LOAD(kt) { const int _k = (kt); \
    rk0 = *(const uint4*)(ksrc0 + (size_t)_k * kst0); rk1 = *(const uint4*)(ksrc1 + (size_t)_k * kst1); \
    rk2 = *(const uint4*)(ksrc2 + (size_t)_k * kst2); \
    rv0 = *(const uint4*)(vsrc0 + _k * 64); rv1 = *(const uint4*)(vsrc1 + _k * 64); }
#define AT_WRITE(buf) { bf16_t* _b = sKV + (buf) * KVBUF; \
    *(uint4*)(_b + kkey0 * LDK + kcc0 * 8) = rk0; *(uint4*)(_b + kkey1 * LDK + kcc1 * 8) = rk1; \
    *(uint4*)(_b + kkey2 * LDK + kcc2 * 8) = rk2; \
    *(uint4*)(_b + 64 * LDK + vd0 * LDV + vcc * 8) = rv0; *(uint4*)(_b + 64 * LDK + (vd0 + 32) * LDV + vcc * 8) = rv1; }
  AT_LOAD(0)
  AT_WRITE(0)
  __syncthreads();
  for (int kt = 0; kt < nkt; ++kt) {
    const int ktn = min(kt + 1, nkt - 1);
    AT_LOAD(ktn)
#if ATPROBE == 5
    { uint4 d0 = *(const volatile uint4*)(ksrc0 + (size_t)ktn * kst0), d1 = *(const volatile uint4*)(ksrc1 + (size_t)ktn * kst1), d2 = *(const volatile uint4*)(ksrc2 + (size_t)ktn * kst2);
      uint4 d3 = *(const volatile uint4*)(vsrc0 + ktn * 64), d4 = *(const volatile uint4*)(vsrc1 + ktn * 64);
      asm volatile("" :: "v"(d0), "v"(d1), "v"(d2), "v"(d3), "v"(d4)); }
#endif
    const bf16_t* sK = sKV + (kt & 1) * KVBUF;
    const bf16_t* sV = sK + 64 * LDK;
    f32x4 sacc[4];
#pragma unroll
    for (int n = 0; n < 4; ++n) sacc[n] = (f32x4){0.f, 0.f, 0.f, 0.f};
#pragma unroll
    for (int ks = 0; ks < 3; ++ks)
#pragma unroll
      for (int n = 0; n < 4; ++n) {
        const bf16x8 a = *(const bf16x8*)(sK + (n * 16 + lr) * LDK + ks * 32 + lg * 8);
        sacc[n] = mfma16(a, qf[ks], sacc[n]);
      }
#if ATPROBE == 2
    {
      f32x4 dacc[4];
#pragma unroll
      for (int n = 0; n < 4; ++n) dacc[n] = (f32x4){0.f, 0.f, 0.f, 0.f};
#pragma unroll
      for (int ks = 0; ks < 3; ++ks)
#pragma unroll
        for (int n = 0; n < 4; ++n) {
          const bf16x8 a = *(const volatile bf16x8*)(sK + (n * 16 + lr) * LDK + ks * 32 + lg * 8);
          dacc[n] = mfma16(a, qf[ks], dacc[n]);
        }
#pragma unroll
      for (int n = 0; n < 4; ++n) asm volatile("" :: "v"(dacc[n]));
    }
#endif
    float mx = sacc[0][0];
#pragma unroll
    for (int n = 0; n < 4; ++n)
#pragma unroll
      for (int q = 0; q < 4; ++q) mx = fmaxf(mx, sacc[n][q]);
    mx = quad_max(mx);
    const float mnew = fmaxf(mrun, mx);
    const float alpha = __builtin_amdgcn_exp2f(mrun - mnew);
    mrun = mnew;
    float ps = 0.f;
#pragma unroll
    for (int n = 0; n < 4; ++n)
#pragma unroll
      for (int q = 0; q < 4; ++q) {
#if ATPROBE == 1
        { float e2 = __builtin_amdgcn_exp2f(sacc[n][q] - mrun); asm volatile("" :: "v"(e2)); }
#endif
        const float e = __builtin_amdgcn_exp2f(sacc[n][q] - mnew); sacc[n][q] = e; ps += e; }
    lrun = lrun * alpha + ps;
#pragma unroll
    for (int i = 0; i < 4; ++i)
#pragma unroll
      for (int q = 0; q < 4; ++q) oacc[i][q] *= alpha;
#pragma unroll
    for (int ks = 0; ks < 2; ++ks) {
      union { bf16x8 v; unsigned u[4]; } pf;
      pf.u[0] = pack2(sacc[2 * ks][0], sacc[2 * ks][1]);
      pf.u[1] = pack2(sacc[2 * ks][2], sacc[2 * ks][3]);
      pf.u[2] = pack2(sacc[2 * ks + 1][0], sacc[2 * ks + 1][1]);
      pf.u[3] = pack2(sacc[2 * ks + 1][2], sacc[2 * ks + 1][3]);
#pragma unroll
      for (int m = 0; m < 4; ++m) {
        union { bf16x8 v; uint2 h[2]; } av;
        const bf16_t* vp = sV + (m * 16 + lr) * LDV + ks * 32 + lg * 4;
        av.h[0] = *(const uint2*)(vp);
        av.h[1] = *(const uint2*)(vp + 16);
        oacc[m] = mfma16(av.v, pf.v, oacc[m]);
      }
    }
    __builtin_amdgcn_sched_barrier(0);
    AT_WRITE((kt + 1) & 1)
#if ATPROBE == 3
    AT_WRITE((kt + 1) & 1)
#endif
#if ATPROBE == 4
    __syncthreads();
#endif
    __syncthreads();
  }
  lrun = quad_sum(lrun);
  const float inv = 1.f / lrun;
#pragma unroll
  for (int m = 0; m < 4; ++m) {
    uint2 o;
    o.x = pack2(oacc[m][0] * inv, oacc[m][1] * inv);
    o.y = pack2(oacc[m][2] * inv, oacc[m][3] * inv);
    *(uint2*)(WSB(OFF_CAT) + (size_t)qrow * 1024 + hh * 64 + m * 16 + lg * 4) = o;
  }
}

NOINL void attn8_item(const P& p, int id) {
  int tid = threadIdx.x; asm volatile("" : "+v"(tid));
  const int lane = tid & 63, wave = tid >> 6, lr = lane & 15, lg = lane >> 4;
  int row0, kvbase, Lk, hh;
  if (id < 256) { hh = id & 7; const int b = (id >> 3) & 1; const int qb = id >> 4; row0 = 4096 + b * 2048 + qb * 128; kvbase = 4096 + b * 2304; Lk = 2304; }
  else { const int i2 = id - 256; hh = i2 & 7; const int rest = i2 >> 3; const int b = rest >> 1; const int qb = rest & 1; row0 = b * 256 + qb * 128; kvbase = b * 256; Lk = 256; }
  constexpr int LDK = 104, LDV = 136;
  constexpr int KVBUF = 128 * LDK + 64 * LDV;
  bf16_t* sKV = (bf16_t*)g_smem;
  const int qrow = row0 + wave * 16 + lr;
  bf16x8 qf[3];
#pragma unroll
  for (int ks = 0; ks < 3; ++ks) qf[ks] = *(const bf16x8*)(WSB(OFF_Q) + (size_t)qrow * 768 + hh * 96 + ks * 32 + lg * 8);
  f32x4 oacc[4];
#pragma unroll
  for (int i = 0; i < 4; ++i) oacc[i] = (f32x4){0.f, 0.f, 0.f, 0.f};
  float mrun = -1e30f, lrun = 0.f;
  const int nkt = Lk >> 7;
  const int kkey0 = tid / 12, kcc0 = tid - kkey0 * 12;
  const int c1 = tid + 512, kkey1 = c1 / 12, kcc1 = c1 - kkey1 * 12;
  const int c2 = tid + 1024, kkey2 = c2 / 12, kcc2 = c2 - kkey2 * 12;
  const bf16_t* kn = WSB(OFF_KN);
  const bf16_t* kp = WSB(OFF_KPE);
  const bf16_t* ksrc0 = (kcc0 < 8) ? kn + (size_t)(kvbase + kkey0) * 512 + hh * 64 + kcc0 * 8 : kp + (size_t)(kvbase + kkey0) * 32 + (kcc0 - 8) * 8;
  const bf16_t* ksrc1 = (kcc1 < 8) ? kn + (size_t)(kvbase + kkey1) * 512 + hh * 64 + kcc1 * 8 : kp + (size_t)(kvbase + kkey1) * 32 + (kcc1 - 8) * 8;
  const bf16_t* ksrc2 = (kcc2 < 8) ? kn + (size_t)(kvbase + kkey2) * 512 + hh * 64 + kcc2 * 8 : kp + (size_t)(kvbase + kkey2) * 32 + (kcc2 - 8) * 8;
  const int kst0 = (kcc0 < 8) ? 512 * 128 : 32 * 128, kst1 = (kcc1 < 8) ? 512 * 128 : 32 * 128, kst2 = (kcc2 < 8) ? 512 * 128 : 32 * 128;
  const int vd0 = tid >> 4, vcc = tid & 15;
  const bf16_t* vsrc0 = WSB(OFF_VT) + (size_t)(hh * 64 + vd0) * 8704 + kvbase + vcc * 8;
  const bf16_t* vsrc1 = vsrc0 + (size_t)32 * 8704;
  uint4 rk0, rk1, rk2, rv0, rv1;
#define A8_LOAD(kt) { const int _k = (kt); \
    rk0 = *(const uint4*)(ksrc0 + (size_t)_k * kst0); rk1 = *(const uint4*)(ksrc1 + (size_t)_k * kst1); \
    rk2 = *(const uint4*)(ksrc2 + (size_t)_k * kst2); \
    rv0 = *(const uint4*)(vsrc0 + _k * 128); rv1 = *(const uint4*)(vsrc1 + _k * 128); }
#define A8_WRITE(buf) { bf16_t* _b = sKV + (buf) * KVBUF; \
    *(uint4*)(_b + kkey0 * LDK + kcc0 * 8) = rk0; *(uint4*)(_b + kkey1 * LDK + kcc1 * 8) = rk1; \
    *(uint4*)(_b + kkey2 * LDK + kcc2 * 8) = rk2; \
    *(uint4*)(_b + 128 * LDK + vd0 * LDV + vcc * 8) = rv0; *(uint4*)(_b + 128 * LDK + (vd0 + 32) * LDV + vcc * 8) = rv1; }
  A8_LOAD(0)
  A8_WRITE(0)
  __syncthreads();
  for (int kt = 0; kt < nkt; ++kt) {
    const int ktn = min(kt + 1, nkt - 1);
    A8_LOAD(ktn)
    const bf16_t* sK = sKV + (kt & 1) * KVBUF;
    const bf16_t* sV = sK + 128 * LDK;
    f32x4 sacc[8];
#pragma unroll
    for (int n = 0; n < 8; ++n) sacc[n] = (f32x4){0.f, 0.f, 0.f, 0.f};
#pragma unroll
    for (int ks = 0; ks < 3; ++ks)
#pragma unroll
      for (int n = 0; n < 8; ++n) {
        const bf16x8 a = *(const bf16x8*)(sK + (n * 16 + lr) * LDK + ks * 32 + lg * 8);
        sacc[n] = mfma16(a, qf[ks], sacc[n]);
      }
    float mx = sacc[0][0];
#pragma unroll
    for (int n = 0; n < 8; ++n)
#pragma unroll
      for (int q = 0; q < 4; ++q) mx = fmaxf(mx, sacc[n][q]);
    mx = quad_max(mx);
    const float mnew = fmaxf(mrun, mx);
    const float alpha = __builtin_amdgcn_exp2f(mrun - mnew);
    mrun = mnew;
    float ps0 = 0.f, ps1 = 0.f;
#pragma unroll
    for (int n = 0; n < 8; n += 2)
#pragma unroll
      for (int q = 0; q < 4; ++q) {
        const float e0 = __builtin_amdgcn_exp2f(sacc[n][q] - mnew); sacc[n][q] = e0; ps0 += e0;
        const float e1 = __builtin_amdgcn_exp2f(sacc[n + 1][q] - mnew); sacc[n + 1][q] = e1; ps1 += e1;
      }
    lrun = lrun * alpha + (ps0 + ps1);
#pragma unroll
    for (int i = 0; i < 4; ++i)
#pragma unroll
      for (int q = 0; q < 4; ++q) oacc[i][q] *= alpha;
#pragma unroll
    for (int ks = 0; ks < 4; ++ks) {
      union { bf16x8 v; unsigned u[4]; } pf;
      pf.u[0] = pack2(sacc[2 * ks][0], sacc[2 * ks][1]);
      pf.u[1] = pack2(sacc[2 * ks][2], sacc[2 * ks][3]);
      pf.u[2] = pack2(sacc[2 * ks + 1][0], sacc[2 * ks + 1][1]);
      pf.u[3] = pack2(sacc[2 * ks + 1][2], sacc[2 * ks + 1][3]);
#pragma unroll
      for (int m = 0; m < 4; ++m) {
        union { bf16x8 v; uint2 h[2]; } av;
        const bf16_t* vp = sV + (m * 16 + lr) * LDV + ks * 32 + lg * 4;
        av.h[0] = *(const uint2*)(vp);
        av.h[1] = *(const uint2*)(vp + 16);
        oacc[m] = mfma16(av.v, pf.v, oacc[m]);
      }
    }
    __builtin_amdgcn_sched_barrier(0);
    A8_WRITE((kt + 1) & 1)
    __syncthreads();
  }
  lrun = quad_sum(lrun);
  const float inv = 1.f / lrun;
#pragma unroll
  for (int m = 0; m < 4; ++m) {
    uint2 o;
    o.x = pack2(oacc[m][0] * inv, oacc[m][1] * inv);
    o.y = pack2(oacc[m][2] * inv, oacc[m][3] * inv);
    *(uint2*)(WSB(OFF_CAT) + (size_t)qrow * 1024 + hh * 64 + m * 16 + lg * 4) = o;
  }
}

NOINL void ssd_y_item(const P& p, int item) {
  char* smem = g_smem + VB * 73728;
  const int tid = opaque_tid(), lane = tid & 63, wave = tid >> 6, lr = lane & 15, lg = lane >> 4;
  const int cidx = item >> 3, qt = (item >> 1) & 3, half = qt >> 1, g = item & 1;
  const int r0 = cidx * 128;
  const int hh = g * 4 + wave;
  constexpr int LDC = 136, LDM = 72;
  bf16_t* sC = (bf16_t*)smem;
  bf16_t* sB = sC + 64 * LDC;
  bf16_t* sM = sB + 64 * LDC + wave * 64 * LDM;
  float* rowss = (float*)((bf16_t*)smem + 2 * 64 * LDC + 4 * 64 * LDM);
  const float* cum = WSF(OFF_CUM);
  const float* dtv = WSF(OFF_DTV);
  const int srow = tid >> 4, scol = (tid & 15) * 8;
  uint4 pb0, pb1, pb2, pb3;
  {
    const bf16_t* cs = WSB(OFF_CM) + (size_t)(r0 + qt * 32 + srow) * 256 + g * 128 + scol;
    const bf16_t* bs = WSB(OFF_BM) + (size_t)(r0 + srow) * 256 + g * 128 + scol;
    const uint4 c0 = *(const uint4*)(cs), c1 = *(const uint4*)(cs + 16 * 256);
    const uint4 b0 = *(const uint4*)(bs), b1 = *(const uint4*)(bs + 16 * 256), b2 = *(const uint4*)(bs + 32 * 256), b3 = *(const uint4*)(bs + 48 * 256);
    pb0 = *(const uint4*)(bs + 64 * 256); pb1 = *(const uint4*)(bs + 80 * 256); pb2 = *(const uint4*)(bs + 96 * 256); pb3 = *(const uint4*)(bs + 112 * 256);
    bf16_t* wc = sC + srow * LDC + scol;
    bf16_t* wb = sB + srow * LDC + scol;
    *(uint4*)(wc) = c0; *(uint4*)(wc + 16 * LDC) = c1;
    *(uint4*)(wb) = b0; *(uint4*)(wb + 16 * LDC) = b1; *(uint4*)(wb + 32 * LDC) = b2; *(uint4*)(wb + 48 * LDC) = b3;
  }
  __syncthreads();
  f32x4 Y[2][4];
#pragma unroll
  for (int i = 0; i < 2; ++i)
#pragma unroll
    for (int j = 0; j < 4; ++j) Y[i][j] = (f32x4){0.f, 0.f, 0.f, 0.f};
#pragma unroll 1
  for (int jh = 0; jh < 2; ++jh) {
    if (jh == 1) {
      __syncthreads();
      bf16_t* wb = sB + srow * LDC + scol;
      *(uint4*)(wb) = pb0; *(uint4*)(wb + 16 * LDC) = pb1; *(uint4*)(wb + 32 * LDC) = pb2; *(uint4*)(wb + 48 * LDC) = pb3;
      __syncthreads();
    }
#pragma unroll 1
    for (int dir = 0; dir < 2; ++dir) {
      const bool use = dir == 0 ? (jh <= half) : (jh >= half);
      if (!use) continue;
      bf16x8 xf[2][4];
#pragma unroll
      for (int ks = 0; ks < 2; ++ks)
#pragma unroll
        for (int pt = 0; pt < 4; ++pt)
          xf[ks][pt] = *(const bf16x8*)(WSB(OFF_XST) + (size_t)(hh * 64 + pt * 16 + lr) * 8192 + r0 + jh * 64 + ks * 32 + lg * 8);
      float ci[2], cj[4][4], dj[4][4];
#pragma unroll
      for (int it = 0; it < 2; ++it) ci[it] = cum[((size_t)dir * 8192 + r0 + qt * 32 + it * 16 + lr) * 8 + hh];
#pragma unroll
      for (int jt = 0; jt < 4; ++jt)
#pragma unroll
        for (int q = 0; q < 4; ++q) {
          const size_t tj = (size_t)dir * 8192 + r0 + jh * 64 + jt * 16 + lg * 4 + q;
          cj[jt][q] = cum[tj * 8 + hh];
          dj[jt][q] = dtv[tj * 8 + hh];
        }
#pragma unroll
      for (int it = 0; it < 2; ++it) {
        f32x4 cb[4];
#pragma unroll
        for (int jt = 0; jt < 4; ++jt) cb[jt] = (f32x4){0.f, 0.f, 0.f, 0.f};
#pragma unroll
        for (int ks = 0; ks < 4; ++ks) {
          const bf16x8 b = *(const bf16x8*)(sC + (it * 16 + lr) * LDC + ks * 32 + lg * 8);
#pragma unroll
          for (int jt = 0; jt < 4; ++jt) {
            const bf16x8 a = *(const bf16x8*)(sB + (jt * 16 + lr) * LDC + ks * 32 + lg * 8);
            cb[jt] = mfma16(a, b, cb[jt]);
          }
        }
        const int ti = qt * 32 + it * 16 + lr;
#pragma unroll
        for (int jt = 0; jt < 4; ++jt) {
          float v[4];
#pragma unroll
          for (int q = 0; q < 4; ++q) {
            const int tj = jh * 64 + jt * 16 + lg * 4 + q;
            const bool ok = dir == 0 ? (tj <= ti) : (tj >= ti);
            v[q] = ok ? cb[jt][q] * __expf(ci[it] - cj[jt][q]) * dj[jt][q] : 0.f;
          }
          uint2 o;
          o.x = pack2(v[0], v[1]);
          o.y = pack2(v[2], v[3]);
          *(uint2*)(sM + (it * 16 + lr) * LDM + jt * 16 + lg * 4) = o;
        }
        __builtin_amdgcn_sched_barrier(0);
      }
      asm volatile("s_waitcnt lgkmcnt(0)" ::: "memory");
#pragma unroll
      for (int ks = 0; ks < 2; ++ks) {
        bf16x8 af[2];
#pragma unroll
        for (int it = 0; it < 2; ++it) af[it] = *(const bf16x8*)(sM + (it * 16 + lr) * LDM + ks * 32 + lg * 8);
#pragma unroll
        for (int it = 0; it < 2; ++it)
#pragma unroll
          for (int pt = 0; pt < 4; ++pt) Y[it][pt] = mfma16(af[it], xf[ks][pt], Y[it][pt]);
      }
      asm volatile("s_waitcnt lgkmcnt(0)" ::: "memory");
      __builtin_amdgcn_sched_barrier(0);
    }
  }
#pragma unroll 1
  for (int dir = 0; dir < 2; ++dir) {
    const bf16_t* hp = WSB(OFF_H) + ((size_t)(dir * 64 + cidx) * 8 + hh) * 8192;
    float ei[2][4];
#pragma unroll
    for (int it = 0; it < 2; ++it)
#pragma unroll
      for (int q = 0; q < 4; ++q)
        ei[it][q] = __expf(cum[((size_t)dir * 8192 + r0 + qt * 32 + it * 16 + lg * 4 + q) * 8 + hh]);
#pragma unroll
    for (int pt = 0; pt < 4; ++pt) {
      bf16x8 bfr[4];
#pragma unroll
      for (int ks = 0; ks < 4; ++ks) bfr[ks] = *(const bf16x8*)(hp + (size_t)(pt * 16 + lr) * 128 + ks * 32 + lg * 8);
      f32x4 T[2];
#pragma unroll
      for (int it = 0; it < 2; ++it) T[it] = (f32x4){0.f, 0.f, 0.f, 0.f};
#pragma unroll
      for (int ks = 0; ks < 4; ++ks)
#pragma unroll
        for (int it = 0; it < 2; ++it) {
          const bf16x8 a = *(const bf16x8*)(sC + (it * 16 + lr) * LDC + ks * 32 + lg * 8);
          T[it] = mfma16(a, bfr[ks], T[it]);
        }
#pragma unroll
      for (int it = 0; it < 2; ++it)
#pragma unroll
        for (int q = 0; q < 4; ++q) Y[it][pt][q] += ei[it][q] * T[it][q];
    }
    __builtin_amdgcn_sched_barrier(0);
  }
  const float dsk = p.ssd_d[hh];
  const float* proj = WSF(OFF_R1);
#pragma unroll
  for (int i = 0; i < 2; ++i) {
#pragma unroll
    for (int q = 0; q < 4; ++q) {
      const int il = i * 16 + lg * 4 + q;
      const size_t r = (size_t)r0 + qt * 32 + il;
      float ss = 0.f;
#pragma unroll
      for (int j = 0; j < 4; ++j) {
        const int ch = hh * 64 + j * 16 + lr;
        const float xs = bf2f(WSB(OFF_XS)[r * 512 + ch]);
        const float z = proj[r * 2096 + 544 + ch];
        const float y = (Y[i][j][q] + dsk * xs) * silu(z);
        Y[i][j][q] = y;
        ss += y * y;
      }
      ss += __shfl_xor(ss, 1, 64);
      ss += __shfl_xor(ss, 2, 64);
      ss += __shfl_xor(ss, 4, 64);
      ss += __shfl_xor(ss, 8, 64);
      if (lr == 0) rowss[wave * 64 + il] = ss;
    }
    __builtin_amdgcn_sched_barrier(0);
  }
  __syncthreads();
#pragma unroll
  for (int i = 0; i < 2; ++i) {
#pragma unroll
    for (int q = 0; q < 4; ++q) {
      const int il = i * 16 + lg * 4 + q;
      const size_t r = (size_t)r0 + qt * 32 + il;
      const float tot = rowss[il] + rowss[64 + il] + rowss[128 + il] + rowss[192 + il];
      const float rs = rsqrtf(tot * (1.f / 256.f) + 1e-6f);
#pragma unroll
      for (int j = 0; j < 4; ++j) {
        const int ch = hh * 64 + j * 16 + lr;
        WSB(OFF_CAT)[r * 1024 + 512 + ch] = f2bf(Y[i][j][q] * rs * p.ssd_norm[ch]);
      }
    }
    __builtin_amdgcn_sched_barrier(0);
  }
  __syncthreads();
}

template <int W2>
DEVI void pool_item(const bf16_t* __restrict__ h, bf16_t* __restrict__ dst, int r, int cc) {
  int s0, L;
  if (r < 4096) { s0 = r & ~255; L = 256; } else { s0 = 4096 + ((r - 4096) & ~2047); L = 2048; }
  const int t = r - s0;
  const int lo = max(t - W2, 0), hi = min(t + W2, L);
  uint4 v[2 * W2];
#pragma unroll
  for (int k = 0; k < 2 * W2; ++k) {
    const int u = min(max(t - W2 + k, 0), L - 1);
    v[k] = *(const uint4*)(h + (size_t)(s0 + u) * 1024 + cc);
  }
  float acc[8] = {0, 0, 0, 0, 0, 0, 0, 0};
#pragma unroll
  for (int k = 0; k < 2 * W2; ++k) {
    const int u = t - W2 + k;
    const float m = (u >= 0 && u < L) ? 1.f : 0.f;
    acc[0] += m * __uint_as_float(v[k].x << 16); acc[1] += m * __uint_as_float(v[k].x & 0xffff0000u);
    acc[2] += m * __uint_as_float(v[k].y << 16); acc[3] += m * __uint_as_float(v[k].y & 0xffff0000u);
    acc[4] += m * __uint_as_float(v[k].z << 16); acc[5] += m * __uint_as_float(v[k].z & 0xffff0000u);
    acc[6] += m * __uint_as_float(v[k].w << 16); acc[7] += m * __uint_as_float(v[k].w & 0xffff0000u);
  }
  const float inv = 1.f / (float)(hi - lo);
  const uint4 c = v[W2];
  uint4 o;
  o.x = pack2(acc[0] * inv - __uint_as_float(c.x << 16), acc[1] * inv - __uint_as_float(c.x & 0xffff0000u));
  o.y = pack2(acc[2] * inv - __uint_as_float(c.y << 16), acc[3] * inv - __uint_as_float(c.y & 0xffff0000u));
  o.z = pack2(acc[4] * inv - __uint_as_float(c.z << 16), acc[5] * inv - __uint_as_float(c.z & 0xffff0000u));
  o.w = pack2(acc[6] * inv - __uint_as_float(c.w << 16), acc[7] * inv - __uint_as_float(c.w & 0xffff0000u));
  *(uint4*)(dst + (size_t)r * 1024 + cc) = o;
}

NOINL void pool_phase(const P& p) {
  const bf16_t* h = WSB(OFF_H);
  bf16_t* dst = WSB(OFF_CAT);
  const int total = 8192 * 128;
  for (int idx = blockIdx.x * 512 + threadIdx.x; idx < total; idx += gridDim.x * 512) {
    const int c32 = idx & 31, rlo = (idx >> 5) & 1, gi = (idx >> 6) & 3, rhi = idx >> 8;
    const int r = rhi * 2 + rlo, cc = gi * 256 + c32 * 8;
    if (gi == 0) pool_item<1>(h, dst, r, cc);
    else if (gi == 1) pool_item<2>(h, dst, r, cc);
    else if (gi == 2) pool_item<4>(h, dst, r, cc);
    else pool_item<8>(h, dst, r, cc);
  }
}

NOINL void ph_gemm_proj(const P& p) {
  float* proj = WSF(OFF_R1);
  const bf16_t* A = WSB(OFF_H);
  const bf16_t* B = WSB(OFF_WIN);
  auto epi = [&](int ctx, int row, int col, f32x4 v0, f32x4 v1) {
#pragma unroll
    for (int q = 0; q < 4; ++q) {
      if (col < 2096) proj[(size_t)(row + q) * 2096 + col] = v0[q];
      if (col + 16 < 2096) proj[(size_t)(row + q) * 2096 + col + 16] = v1[q];
    }
  };
  gemm8_stream(256, 1024, 1024, 1024,
    [=](int t) {
      TileInfo r;
      int m, n; tile_mn(t, 32, 8, m, n);
      r.m0 = m * 256; r.n0 = n * 256; r.ctx = 0;
      r.a = A + (size_t)r.m0 * 1024; r.b = B + (size_t)r.n0 * 1024;
      return r;
    }, epi);
  gemm_stream(64, 1024, 1024, 1024, g_smem + VB * 73728,
    [=](int t) {
      TileInfo r;
      r.m0 = t * 128; r.n0 = 2048; r.ctx = 0;
      r.a = A + (size_t)r.m0 * 1024; r.b = B + (size_t)2048 * 1024;
      return r;
    }, epi);
}

NOINL void ph_gemm_f32out(const P& p, const bf16_t* A, int lda, const bf16_t* B, int ldb, int K, bf16_t* C, int N) {
  const int nN = N / 128;
  gemm_stream(64 * nN, lda, ldb, K, g_smem + VB * 73728,
    [=](int t) {
      TileInfo r;
      int m, n; tile_mn(t, 64, nN, m, n);
      r.m0 = m * 128; r.n0 = n * 128; r.ctx = 0;
      r.a = A + (size_t)r.m0 * lda; r.b = B + (size_t)r.n0 * ldb;
      return r;
    },
    [&](int ctx, int row, int col, f32x4 v0, f32x4 v1) {
#pragma unroll
      for (int q = 0; q < 4; ++q) {
        C[(size_t)(row + q) * N + col] = f2bf(v0[q]);
        C[(size_t)(row + q) * N + col + 16] = f2bf(v1[q]);
      }
    });
}

NOINL void ph_gemm8_splitk(const P& p, const bf16_t* A, int lda, const bf16_t* B, int ldb, int Khalf, bf16_t* C0, bf16_t* C1) {
  gemm8_stream(256, lda, ldb, Khalf,
    [=](int t) {
      TileInfo r;
      const int id = swz_tile(t, 256);
      const int ks = id >> 7, rem = id & 127;
      r.m0 = (rem >> 2) * 256; r.n0 = (rem & 3) * 256; r.ctx = ks;
      r.a = A + (size_t)r.m0 * lda + (size_t)ks * Khalf; r.b = B + (size_t)r.n0 * ldb + (size_t)ks * Khalf;
      return r;
    },
    [&](int ks, int row, int col, f32x4 v0, f32x4 v1) {
      bf16_t* C = ks ? C1 : C0;
#pragma unroll
      for (int q = 0; q < 4; ++q) {
        C[(size_t)(row + q) * 1024 + col] = f2bf(v0[q]);
        C[(size_t)(row + q) * 1024 + col + 16] = f2bf(v1[q]);
      }
    });
}

NOINL void ph_gemm_qkv(const P& p) {
  bf16_t* qo = WSB(OFF_Q);
  bf16_t* kn = WSB(OFF_KN);
  bf16_t* vt = WSB(OFF_VT);
  const bf16_t* Aq = WSB(OFF_CQN);
  const bf16_t* Bq = WSB(OFF_WUQ);
  const bf16_t* Ak = WSB(OFF_CKV);
  const bf16_t* Bk = WSB(OFF_WUKV);
  gemm_stream(384 + 544, 256, 256, 256, g_smem + VB * 73728,
    [=](int t) {
      TileInfo r;
      int m, n;
      if (t < 384) {
        tile_mn(t, 64, 6, m, n);
        r.m0 = m * 128; r.n0 = n * 128; r.ctx = 0;
        r.a = Aq + (size_t)r.m0 * 256; r.b = Bq + (size_t)r.n0 * 256;
      } else {
        tile_mn(t - 384, 68, 8, m, n);
        r.m0 = m * 128; r.n0 = n * 128; r.ctx = 1;
        r.a = Ak + (size_t)r.m0 * 256; r.b = Bk + (size_t)r.n0 * 256;
      }
      return r;
    },
    [&](int ctx, int row, int col, f32x4 v0, f32x4 v1) {
      if (ctx == 0) {
        const float scl = 0.10206207261596575f * 1.4426950408889634f;
        const int tn = col >> 4;
        const bool rope = ((tn % 6) == 4) && (row >= 4096);
        const int ii = col & 15;
        const float fr = rope_freq(ii & 7);
#pragma unroll
        for (int q = 0; q < 4; ++q) {
          float a = v0[q], b = v1[q];
          if (rope) {
            const int tt = (row + q - 4096) & 2047;
            const float pos = (ii < 8) ? (float)(tt >> 6) : (float)(tt & 63);
            const float ang = pos * fr;
            float cs, sn;
            fast_sincos(ang, sn, cs);
            const float x1 = a, x2 = b;
            a = x1 * cs - x2 * sn;
            b = x1 * sn + x2 * cs;
          }
          qo[(size_t)(row + q) * 768 + col] = f2bf(a * scl);
          qo[(size_t)(row + q) * 768 + col + 16] = f2bf(b * scl);
        }
      } else {
        const int hh = col >> 7, j = col & 127;
        if (j < 64) {
#pragma unroll
          for (int q = 0; q < 4; ++q) {
            kn[(size_t)(row + q) * 512 + hh * 64 + j] = f2bf(v0[q]);
            kn[(size_t)(row + q) * 512 + hh * 64 + j + 16] = f2bf(v1[q]);
          }
        } else {
          uint2 o0, o1;
          o0.x = pack2(v0[0], v0[1]); o0.y = pack2(v0[2], v0[3]);
          o1.x = pack2(v1[0], v1[1]); o1.y = pack2(v1[2], v1[3]);
          *(uint2*)(vt + (size_t)(hh * 64 + j - 64) * 8704 + row) = o0;
          *(uint2*)(vt + (size_t)(hh * 64 + j - 64 + 16) * 8704 + row) = o1;
        }
      }
    });
}

NOINL void ph_gemm_ffn_up(const P& p, int layer) {
  bf16_t* gu = WSB(OFF_R1);
  const bf16_t* A = WSB(OFF_H);
  const bf16_t* B = WSB(OFF_WGU) + (size_t)layer * 5632 * 1024;
  gemm8_stream(32 * 22, 1024, 1024, 1024,
    [=](int t) {
      TileInfo r;
      int m, n; tile_mn(t, 32, 22, m, n);
      r.m0 = m * 256; r.n0 = n * 256; r.ctx = 0;
      r.a = A + (size_t)r.m0 * 1024; r.b = B + (size_t)r.n0 * 1024;
      return r;
    },
    [&](int ctx, int row, int col, f32x4 v0, f32x4 v1) {
      const int oc = (col >> 5) * 16 + (col & 15);
#pragma unroll
      for (int q = 0; q < 4; ++q) gu[(size_t)(row + q) * 2816 + oc] = f2bf(silu(v0[q]) * v1[q]);
    });
}

NOINL void ph_gemm_pool(const P& p) {
  bf16_t* mix = WSB(OFF_R1);
  const bf16_t* A = WSB(OFF_H);
  const bf16_t* B = WSB(OFF_WPOOL);
  gemm_stream(512, 1024, 256, 256, g_smem + VB * 73728,
    [=](int t) {
      TileInfo r;
      const int id = swz_tile(t, 512);
      const int g = id >> 7, rem = id & 127;
      r.m0 = (rem >> 1) * 128; r.n0 = (rem & 1) * 128; r.ctx = g;
      r.a = A + (size_t)r.m0 * 1024 + g * 256; r.b = B + (size_t)g * 65536 + (size_t)r.n0 * 256;
      return r;
    },
    [&](int g, int row, int col, f32x4 v0, f32x4 v1) {
      const int c0 = g * 256 + col;
      const float s0 = p.pool_scale[c0], s1 = p.pool_scale[c0 + 16];
#pragma unroll
      for (int q = 0; q < 4; ++q) {
        mix[(size_t)(row + q) * 1024 + c0] = f2bf(v0[q] * s0);
        mix[(size_t)(row + q) * 1024 + c0 + 16] = f2bf(v1[q] * s1);
      }
    });
}


#define XB_TMO      128
#define XB_XCNT(j)  (256  + 64 * (j))
#define XB_XSUB(j)  (1280 + 64 * (j))
#define XB_XGEN(j)  (2304 + 64 * (j))
#define XB_TOP      3328
#define XB_TOPGEN   3392
#define XCD_BAR_WORDS 3456
#define XB_SPIN_CAP (1u << 22)
#define LAS __attribute__((address_space(3)))
DEVI unsigned xb_ld(unsigned* p) { return __hip_atomic_load(p, __ATOMIC_RELAXED, __HIP_MEMORY_SCOPE_AGENT); }
DEVI unsigned xb_add(unsigned* p, unsigned v) { return __hip_atomic_fetch_add(p, v, __ATOMIC_RELAXED, __HIP_MEMORY_SCOPE_AGENT); }
DEVI unsigned xb_xcc_id() { return (unsigned)__builtin_amdgcn_s_getreg((3 << 11) | 20) & 0xFu; }
#define XB_SPIN(cond, bar) do { unsigned _sp = 0; while (cond) { __builtin_amdgcn_s_sleep(1); \
    if ((++_sp & 255u) == 0u) { if (xb_ld(&(bar)[XB_TMO])) break; if (_sp > XB_SPIN_CAP) { atomicAdd(&(bar)[XB_TMO], 1u); break; } } } } while (0)
struct XcdBarrier { unsigned* bar; unsigned x; volatile LAS unsigned* st; };
DEVI XcdBarrier xcd_barrier_post(unsigned* bar, volatile LAS unsigned* st) {
  XcdBarrier b; b.bar = bar; b.x = xb_xcc_id(); b.st = st;
  if (threadIdx.x == 0) (void)xb_add(&bar[XB_XCNT(b.x)], 1u);
  return b;
}
DEVI void xcd_barrier_complete(unsigned* bar, unsigned x, unsigned& nloc, unsigned& nx) {
  const unsigned G = gridDim.x * gridDim.y * gridDim.z;
  unsigned sum, cnt, mine, sp = 0u;
  for (;;) {
    sum = 0u; cnt = 0u; mine = 0u;
#pragma unroll
    for (unsigned j = 0; j < 16; ++j) { const unsigned c = xb_ld(&bar[XB_XCNT(j)]); sum += c; cnt += (c > 0u) ? 1u : 0u; mine = (j == x) ? c : mine; }
    if (sum == G) break;
    __builtin_amdgcn_s_sleep(1);
    if ((++sp & 255u) == 0u) { if (xb_ld(&bar[XB_TMO])) break; if (sp > XB_SPIN_CAP) { atomicAdd(&bar[XB_TMO], 1u); break; } }
  }
  nloc = mine > 0u ? mine : 1u; nx = cnt > 0u ? cnt : 1u;
}
DEVI void xcd_barrier(const XcdBarrier& b) {
  asm volatile("s_waitcnt vmcnt(0)" ::: "memory");
  __syncthreads();
  if (threadIdx.x == 0) {
    unsigned* bar = b.bar;
    __builtin_amdgcn_s_waitcnt(0);
    unsigned nloc = b.st[0], nx = b.st[1];
    if (nloc == 0u) { xcd_barrier_complete(bar, b.x, nloc, nx); b.st[0] = nloc; b.st[1] = nx; }
    const unsigned old = xb_add(&bar[XB_XSUB(b.x)], 1u);
    const unsigned gen = old / nloc;
    if (old + 1u == (gen + 1u) * nloc) {
      __builtin_amdgcn_fence(__ATOMIC_RELEASE, "agent");
      asm volatile("s_waitcnt vmcnt(0)" ::: "memory");
      const unsigned og = xb_add(&bar[XB_TOP], 1u);
      const unsigned tg = og / nx;
      if (og + 1u == (tg + 1u) * nx) xb_add(&bar[XB_TOPGEN], 1u);
      else XB_SPIN(xb_ld(&bar[XB_TOPGEN]) == tg, bar);
      __builtin_amdgcn_fence(__ATOMIC_ACQUIRE, "agent");
      xb_add(&bar[XB_XGEN(b.x)], 1u);
      asm volatile("s_waitcnt vmcnt(0)" ::: "memory");
    } else {
      XB_SPIN(xb_ld(&bar[XB_XGEN(b.x)]) == gen, bar);
      __builtin_amdgcn_fence(__ATOMIC_ACQUIRE, "agent");
      asm volatile("s_waitcnt vmcnt(0)" ::: "memory");
    }
  }
  __syncthreads();
}

constexpr int NPHASE = 18;
#ifndef REPMASK
#define REPMASK 0
#endif
#ifndef ATPROBE
#define ATPROBE 0
#endif
#ifndef P6PROBE
#define P6PROBE 1
#endif
#ifndef PHMASK
#define PHMASK 0x3ffff
#endif
#define PH(n) if constexpr ((PHMASK >> (n)) & 1)

__global__ void __launch_bounds__(512, 2) mega(P p, int lo, int hi) {
  __shared__ uint4 xb_words;
  if (threadIdx.x == 0) xb_words = make_uint4(0u, 0u, 0u, 0u);
  __syncthreads();
  XcdBarrier xb = xcd_barrier_post((unsigned*)(p.ws + OFF_BAR), (volatile LAS unsigned*)&xb_words);
  if (lo < 0) cg::this_grid().sync();
  PH(0) if (lo <= 0 && 0 < hi) {
#if (REPMASK >> 0) & 1
    int nrep = 2; asm volatile("" : "+s"(nrep));
    for (int rep = 0; rep < nrep; ++rep) {
      if (rep) xcd_barrier(xb);
#else
    {
#endif
        for (int t0_ = blockIdx.x * 2; t0_ < 384 + 5200; t0_ += gridDim.x * 2) {
          const int t = min(t0_ + VB, 384 + 5200 - 1);
          if (t < 384) gemv_tile(p, t); else transpose_tile(p, t - 384);
        }
    }
  }
  if (lo <= 0 && 0 + 1 < hi) xcd_barrier(xb);
  PH(1) if (lo <= 1 && 1 < hi) {
#if (REPMASK >> 1) & 1
    int nrep = 2; asm volatile("" : "+s"(nrep));
    for (int rep = 0; rep < nrep; ++rep) {
      if (rep) xcd_barrier(xb);
#else
    {
#endif
        rowop<false, true, true, false, false>(p, nullptr, nullptr, nullptr, 0, p.n_pre_mix, 0, 1, 0, 0);
    }
  }
  if (lo <= 1 && 1 + 1 < hi) xcd_barrier(xb);
  PH(2) if (lo <= 2 && 2 < hi) {
#if (REPMASK >> 2) & 1
    int nrep = 2; asm volatile("" : "+s"(nrep));
    for (int rep = 0; rep < nrep; ++rep) {
      if (rep) xcd_barrier(xb);
#else
    {
#endif
        ph_gemm_proj(p);
    }
  }
  if (lo <= 2 && 2 + 1 < hi) xcd_barrier(xb);
  PH(3) if (lo <= 3 && 3 < hi) {
#if (REPMASK >> 3) & 1
    int nrep = 2; asm volatile("" : "+s"(nrep));
    for (int rep = 0; rep < nrep; ++rep) {
      if (rep) xcd_barrier(xb);
#else
    {
#endif
        prep_rows(p);
        prep_cache(p);
        for (int t0_ = VT_FIRST; t0_ < 2048; t0_ += gridDim.x * 2) conv_tile(p, min(t0_ + VT_OFF, 2047));
    }
  }
  if (lo <= 3 && 3 + 1 < hi) xcd_barrier(xb);
  PH(4) if (lo <= 4 && 4 < hi) {
#if (REPMASK >> 4) & 1
    int nrep = 2; asm volatile("" : "+s"(nrep));
    for (int rep = 0; rep < nrep; ++rep) {
      if (rep) xcd_barrier(xb);
#else
    {
#endif
        ph_gemm_qkv(p);
        for (int t0_ = VT_FIRST; t0_ < 512; t0_ += gridDim.x * 2) chunk_state_item(p, min(t0_ + VT_OFF, 511));
    }
  }
  if (lo <= 4 && 4 + 1 < hi) xcd_barrier(xb);
  PH(5) if (lo <= 5 && 5 < hi) {
#if (REPMASK >> 5) & 1
    int nrep = 2; asm volatile("" : "+s"(nrep));
    for (int rep = 0; rep < nrep; ++rep) {
      if (rep) xcd_barrier(xb);
#else
    {
#endif
        scan_states(p);
    }
  }
  if (lo <= 5 && 5 + 1 < hi) xcd_barrier(xb);
  PH(6) if (lo <= 6 && 6 < hi) {
#if (REPMASK >> 6) & 1
    int nrep = 2; asm volatile("" : "+s"(nrep));
    for (int rep = 0; rep < nrep; ++rep) {
      if (rep) xcd_barrier(xb);
#else
    {
#endif
        for (int t = blockIdx.x; t < 512; t += gridDim.x) attn8_item(p, t);
        for (int t0_ = VT_FIRST; t0_ < 512; t0_ += gridDim.x * 2) ssd_y_item(p, min(t0_ + VT_OFF, 511));
    }
  }
  if (lo <= 6 && 6 + 1 < hi) xcd_barrier(xb);
  PH(7) if (lo <= 7 && 7 < hi) {
#if (REPMASK >> 7) & 1
    int nrep = 2; asm volatile("" : "+s"(nrep));
    for (int rep = 0; rep < nrep; ++rep) {
      if (rep) xcd_barrier(xb);
#else
    {
#endif
        ph_gemm8_splitk(p, WSB(OFF_CAT), 1024, WSB(OFF_WOUT), 1024, 512, WSB(OFF_R1), WSB(OFF_R1) + (size_t)8192 * 1024);
    }
  }
  if (lo <= 7 && 7 + 1 < hi) xcd_barrier(xb);
  PH(8) if (lo <= 8 && 8 < hi) {
#if (REPMASK >> 8) & 1
    int nrep = 2; asm volatile("" : "+s"(nrep));
    for (int rep = 0; rep < nrep; ++rep) {
      if (rep) xcd_barrier(xb);
#else
    {
#endif
        rowop<true, true, true, false, true>(p, WSB(OFF_R1), WSB(OFF_R1) + (size_t)8192 * 1024, p.n_post_mix, 2, p.n_pre_ffn, 3, 4, 0, 0);
    }
  }
  if (lo <= 8 && 8 + 1 < hi) xcd_barrier(xb);
  PH(9) if (lo <= 9 && 9 < hi) {
#if (REPMASK >> 9) & 1
    int nrep = 2; asm volatile("" : "+s"(nrep));
    for (int rep = 0; rep < nrep; ++rep) {
      if (rep) xcd_barrier(xb);
#else
    {
#endif
        ph_gemm_ffn_up(p, 0);
    }
  }
  if (lo <= 9 && 9 + 1 < hi) xcd_barrier(xb);
  PH(10) if (lo <= 10 && 10 < hi) {
#if (REPMASK >> 10) & 1
    int nrep = 2; asm volatile("" : "+s"(nrep));
    for (int rep = 0; rep < nrep; ++rep) {
      if (rep) xcd_barrier(xb);
#else
    {
#endif
        ph_gemm8_splitk(p, WSB(OFF_R1), 2816, WSB(OFF_WDN), 2816, 1408, WSB(OFF_R2), WSB(OFF_R2) + (size_t)8192 * 1024);
    }
  }
  if (lo <= 10 && 10 + 1 < hi) xcd_barrier(xb);
  PH(11) if (lo <= 11 && 11 < hi) {
#if (REPMASK >> 11) & 1
    int nrep = 2; asm volatile("" : "+s"(nrep));
    for (int rep = 0; rep < nrep; ++rep) {
      if (rep) xcd_barrier(xb);
#else
    {
#endif
        rowop<true, true, false, false, true>(p, WSB(OFF_R2), WSB(OFF_R2) + (size_t)8192 * 1024, p.n_post_ffn, 5, p.n_pre_mix + 1024, 0, 1, 0, 1);
    }
  }
  if (lo <= 11 && 11 + 1 < hi) xcd_barrier(xb);
  PH(12) if (lo <= 12 && 12 < hi) {
#if (REPMASK >> 12) & 1
    int nrep = 2; asm volatile("" : "+s"(nrep));
    for (int rep = 0; rep < nrep; ++rep) {
      if (rep) xcd_barrier(xb);
#else
    {
#endif
    }
  }
  PH(13) if (lo <= 13 && 13 < hi) {
#if (REPMASK >> 13) & 1
    int nrep = 2; asm volatile("" : "+s"(nrep));
    for (int rep = 0; rep < nrep; ++rep) {
      if (rep) xcd_barrier(xb);
#else
    {
#endif
        ph_gemm_pool(p);
    }
  }
  if (lo <= 13 && 13 + 1 < hi) xcd_barrier(xb);
  PH(14) if (lo <= 14 && 14 < hi) {
#if (REPMASK >> 14) & 1
    int nrep = 2; asm volatile("" : "+s"(nrep));
    for (int rep = 0; rep < nrep; ++rep) {
      if (rep) xcd_barrier(xb);
#else
    {
#endif
        rowop<true, true, false, false, false, true>(p, WSB(OFF_R1), nullptr, p.n_post_mix + 1024, 2, p.n_pre_ffn + 1024, 3, 4, 1, 1);
    }
  }
  if (lo <= 14 && 14 + 1 < hi) xcd_barrier(xb);
  PH(15) if (lo <= 15 && 15 < hi) {
#if (REPMASK >> 15) & 1
    int nrep = 2; asm volatile("" : "+s"(nrep));
    for (int rep = 0; rep < nrep; ++rep) {
      if (rep) xcd_barrier(xb);
#else
    {
#endif
        ph_gemm_ffn_up(p, 1);
    }
  }
  if (lo <= 15 && 15 + 1 < hi) xcd_barrier(xb);
  PH(16) if (lo <= 16 && 16 < hi) {
#if (REPMASK >> 16) & 1
    int nrep = 2; asm volatile("" : "+s"(nrep));
    for (int rep = 0; rep < nrep; ++rep) {
      if (rep) xcd_barrier(xb);
#else
    {
#endif
        ph_gemm8_splitk(p, WSB(OFF_R1), 2816, WSB(OFF_WDN) + (size_t)1024 * 2816, 2816, 1408, WSB(OFF_R2), WSB(OFF_R2) + (size_t)8192 * 1024);
    }
  }
  if (lo <= 16 && 16 + 1 < hi) xcd_barrier(xb);
  PH(17) if (lo <= 17 && 17 < hi) {
#if (REPMASK >> 17) & 1
    int nrep = 2; asm volatile("" : "+s"(nrep));
    for (int rep = 0; rep < nrep; ++rep) {
      if (rep) xcd_barrier(xb);
#else
    {
#endif
        rowop<true, false, false, true, true>(p, WSB(OFF_R2), WSB(OFF_R2) + (size_t)8192 * 1024, p.n_post_ffn + 1024, 5, nullptr, 0, 0, 1, 1);
    }
  }
}

extern "C" void kernel_launch(void* const* d_in, const int* in_sizes, int n_in, void* d_out, int out_size, void* d_ws,
                              size_t ws_size, hipStream_t stream) {
  P p{};
  const float** f = (const float**)&p;
  for (int i = 0; i < 33; ++i) f[i] = (const float*)d_in[i];
  p.out = (float*)d_out;
  p.ws = (char*)d_ws;
  static int grid_blocks = 0;
  if (!grid_blocks) {
    int dev = 0, cus = 0, per_cu = 0;
    hipGetDevice(&dev);
    hipDeviceGetAttribute(&cus, hipDeviceAttributeMultiprocessorCount, dev);
    hipOccupancyMaxActiveBlocksPerMultiprocessor(&per_cu, mega, 512, 0);
    if (per_cu > 1) per_cu = 1;
    if (per_cu < 1) per_cu = 1;
    grid_blocks = cus * per_cu;
  }
  hipMemsetAsync((char*)d_ws + OFF_BAR, 0, XCD_BAR_WORDS * 4, stream);
#if SINGLE_LAUNCH
  int lo = 0, hi = NPHASE;
  void* args[] = {&p, &lo, &hi};
  hipError_t e = hipLaunchCooperativeKernel((void*)mega, dim3(grid_blocks), dim3(512), args, 0, stream);
  if (e != hipSuccess) fprintf(stderr, "cooperative launch failed: %s (grid %d)\n", hipGetErrorString(e), grid_blocks);
#else
  for (int ph = 0; ph < NPHASE; ++ph) mega<<<grid_blocks, 512, 0, stream>>>(p, ph, ph + 1);
#endif
}
```

```cpp
#include <hip/hip_runtime.h>
#include <hip/hip_cooperative_groups.h>
#include <stdint.h>
#include <stdio.h>
namespace cg = cooperative_groups;

#ifndef SINGLE_LAUNCH
#define SINGLE_LAUNCH 1
#endif

typedef __attribute__((ext_vector_type(8))) short bf16x8;
typedef __attribute__((ext_vector_type(4))) float f32x4;
typedef unsigned short bf16_t;

#define DEVI __device__ __forceinline__

constexpr size_t OFF_WIN   = 0;
constexpr size_t OFF_WUQ   = OFF_WIN   + (size_t)2176*1024*2;
constexpr size_t OFF_WUKV  = OFF_WUQ   + (size_t)768*256*2;
constexpr size_t OFF_WOUT  = OFF_WUKV  + (size_t)1024*256*2;
constexpr size_t OFF_WPOOL = OFF_WOUT  + (size_t)1024*1024*2;
constexpr size_t OFF_WGU   = OFF_WPOOL + (size_t)4*256*256*2;
constexpr size_t OFF_WDN   = OFF_WGU   + (size_t)2*5632*1024*2;
constexpr size_t OFF_MOD   = OFF_WDN   + (size_t)2*1024*2816*2;
constexpr size_t OFF_R1    = OFF_MOD   + (size_t)2*3*6144*4;
constexpr size_t OFF_DTRAW = OFF_R1    + (size_t)8192*2080*2;
constexpr size_t OFF_R2    = OFF_R1    + (size_t)8192*2096*4;
constexpr size_t OFF_H     = OFF_R2    + (size_t)8192*1024*4;
constexpr size_t OFF_CAT   = OFF_H     + (size_t)8192*1024*2;
constexpr size_t OFF_Q     = OFF_CAT   + (size_t)8192*1024*2;
constexpr size_t OFF_KN    = OFF_Q     + (size_t)8192*768*2;
constexpr size_t OFF_VT    = OFF_KN    + (size_t)8704*512*2;
constexpr size_t OFF_CQN   = OFF_VT    + (size_t)8704*512*2;
constexpr size_t OFF_CKV   = OFF_CQN   + (size_t)8192*256*2;
constexpr size_t OFF_KPE   = OFF_CKV   + (size_t)8704*256*2;
constexpr size_t OFF_XS    = OFF_KPE   + (size_t)8704*32*2;
constexpr size_t OFF_XST   = OFF_XS    + (size_t)8192*512*2;
constexpr size_t OFF_BM    = OFF_XST   + (size_t)8192*512*2;
constexpr size_t OFF_BT    = OFF_BM    + (size_t)8192*256*2;
constexpr size_t OFF_CM    = OFF_BT    + (size_t)8192*256*2;
constexpr size_t OFF_DTV   = OFF_CM    + (size_t)8192*256*2;
constexpr size_t OFF_CUM   = OFF_DTV   + (size_t)2*8192*8*4;
constexpr size_t OFF_TOT   = OFF_CUM   + (size_t)2*8192*8*4;
constexpr size_t OFF_BAR   = OFF_TOT   + 4096;
constexpr size_t OFF_XR    = OFF_BAR   + 16384;
constexpr size_t OFF_END   = OFF_XR    + (size_t)8192*1024*2;
static_assert(OFF_END <= ((size_t)256 << 20), "workspace map exceeds 256 MiB");

constexpr size_t OUT_CKV = 8388608, OUT_KR = 9437184, OUT_SF = 9568256, OUT_SB = 10616832;

struct P {
  const float *x_prompt, *x_sample, *c, *cache_ckv, *cache_kr, *st_f, *st_b, *c_ctx;
  const float *w_mod, *b_mod, *n_pre_mix, *n_post_mix, *n_pre_ffn, *n_post_ffn;
  const float *w_in, *q_norm, *w_uq, *kv_norm, *w_ukv, *conv_w, *conv_b, *dtb_f, *dtb_b, *alog_f, *alog_b;
  const float *ssd_d, *ssd_norm, *w_out, *pool_w, *pool_scale, *w_gate, *w_up, *w_down;
  float* out;
  char* ws;
};

#define WSB(off) ((bf16_t*)(p.ws + (off)))
#define WSF(off) ((float*)(p.ws + (off)))

typedef __bf16 hwbf16x2 __attribute__((ext_vector_type(2)));
typedef float hwf32x2 __attribute__((ext_vector_type(2)));
DEVI bf16_t f2bf(float f) {
  __bf16 r = (__bf16)f;
  return __builtin_bit_cast(bf16_t, r);
}
DEVI float bf2f(bf16_t b) { return __uint_as_float(((unsigned)b) << 16); }
DEVI unsigned pack2(float a, float b) {
  hwf32x2 v = {a, b};
  hwbf16x2 r = __builtin_convertvector(v, hwbf16x2);
  return __builtin_bit_cast(unsigned, r);
}
DEVI float silu(float x) { return x / (1.f + __expf(-x)); }
DEVI float wave_sum(float v) {
#pragma unroll
  for (int o = 32; o > 0; o >>= 1) v += __shfl_xor(v, o, 64);
  return v;
}
DEVI f32x4 mfma16(bf16x8 a, bf16x8 b, f32x4 c) { return __builtin_amdgcn_mfma_f32_16x16x32_bf16(a, b, c, 0, 0, 0); }

DEVI float rope_freq(int m) { return exp2f(-(float)m * 1.6609640474436813f); }
DEVI void fast_sincos(float ang, float& sn, float& cs) {
  float rev = ang * 0.15915494309189535f;
  rev -= rintf(rev);
  sn = __builtin_amdgcn_sinf(rev);
  cs = __builtin_amdgcn_cosf(rev);
}
typedef unsigned hwu32x2 __attribute__((ext_vector_type(2)));
DEVI float quad_max(float x) {
  hwu32x2 r = __builtin_amdgcn_permlane16_swap(__float_as_uint(x), __float_as_uint(x), false, false);
  x = fmaxf(__uint_as_float(r[0]), __uint_as_float(r[1]));
  r = __builtin_amdgcn_permlane32_swap(__float_as_uint(x), __float_as_uint(x), false, false);
  return fmaxf(__uint_as_float(r[0]), __uint_as_float(r[1]));
}
DEVI float quad_sum(float x) {
  hwu32x2 r = __builtin_amdgcn_permlane16_swap(__float_as_uint(x), __float_as_uint(x), false, false);
  x = __uint_as_float(r[0]) + __uint_as_float(r[1]);
  r = __builtin_amdgcn_permlane32_swap(__float_as_uint(x), __float_as_uint(x), false, false);
  return __uint_as_float(r[0]) + __uint_as_float(r[1]);
}
#define VB ((int)(threadIdx.x >> 8))
#define VT_PAIRG (gridDim.x == 256u)
#define VT_FIRST ((int)(VT_PAIRG ? blockIdx.x : blockIdx.x * 2u))
#define VT_OFF ((int)(VT_PAIRG ? VB * gridDim.x : VB))
DEVI int opaque_tid() { int t = threadIdx.x & 255; asm volatile("" : "+v"(t)); return t; }
DEVI int swz_tile(int t, int T) {
  int q = T >> 3, r = T & 7, x = t & 7, off = t >> 3;
  return (x < r ? x * (q + 1) : r * (q + 1) + (x - r) * q) + off;
}

__shared__ __attribute__((aligned(16))) char g_smem[2 * 73728];
#define NOINL __device__ __forceinline__

constexpr int LDT = 72;
constexpr int TILE_E = 128 * LDT;

template <class Epi>
DEVI void gemm_tile(const bf16_t* __restrict__ A, int lda, const bf16_t* __restrict__ B, int ldb, int K,
                    int m0, int n0, char* smem, Epi epi) {
  const int tid = opaque_tid(), lane = tid & 63, wave = tid >> 6, wm = wave >> 1, wn = wave & 1;
  const int lr = lane & 15, lg = lane >> 4;
  bf16_t* sA = (bf16_t*)smem;
  bf16_t* sB = sA + 2 * TILE_E;
  f32x4 acc[4][4];
#pragma unroll
  for (int i = 0; i < 4; ++i)
#pragma unroll
    for (int j = 0; j < 4; ++j) acc[i][j] = (f32x4){0.f, 0.f, 0.f, 0.f};
  const int lrow = tid >> 3, lkc = (tid & 7) * 8;
  const bf16_t* gA = A + (size_t)(m0 + lrow) * lda + lkc;
  const bf16_t* gB = B + (size_t)(n0 + lrow) * ldb + lkc;
  uint4 ra[4], rb[4];
#pragma unroll
  for (int i = 0; i < 4; ++i) {
    ra[i] = *(const uint4*)(gA + (size_t)(32 * i) * lda);
    rb[i] = *(const uint4*)(gB + (size_t)(32 * i) * ldb);
  }
#pragma unroll
  for (int i = 0; i < 4; ++i) {
    *(uint4*)(sA + (lrow + 32 * i) * LDT + lkc) = ra[i];
    *(uint4*)(sB + (lrow + 32 * i) * LDT + lkc) = rb[i];
  }
  __syncthreads();
  const int nk = K >> 6;
  for (int kt = 0; kt < nk; ++kt) {
    const int cur = kt & 1;
    if (kt + 1 < nk) {
      const int k0 = (kt + 1) << 6;
#pragma unroll
      for (int i = 0; i < 4; ++i) {
        ra[i] = *(const uint4*)(gA + (size_t)(32 * i) * lda + k0);
        rb[i] = *(const uint4*)(gB + (size_t)(32 * i) * ldb + k0);
      }
    }
    const bf16_t* cA = sA + cur * TILE_E + (wm * 64 + lr) * LDT + lg * 8;
    const bf16_t* cB = sB + cur * TILE_E + (wn * 64 + lr) * LDT + lg * 8;
#pragma unroll
    for (int ks = 0; ks < 2; ++ks) {
      bf16x8 af[4], bfr[4];
#pragma unroll
      for (int i = 0; i < 4; ++i) {
        af[i] = *(const bf16x8*)(cA + i * 16 * LDT + ks * 32);
        bfr[i] = *(const bf16x8*)(cB + i * 16 * LDT + ks * 32);
      }
#pragma unroll
      for (int i = 0; i < 4; ++i)
#pragma unroll
        for (int j = 0; j < 4; ++j) acc[i][j] = mfma16(af[i], bfr[j], acc[i][j]);
    }
    if (kt + 1 < nk) {
      const int nx = cur ^ 1;
#pragma unroll
      for (int i = 0; i < 4; ++i) {
        *(uint4*)(sA + nx * TILE_E + (lrow + 32 * i) * LDT + lkc) = ra[i];
        *(uint4*)(sB + nx * TILE_E + (lrow + 32 * i) * LDT + lkc) = rb[i];
      }
    }
    __syncthreads();
  }
#pragma unroll
  for (int i = 0; i < 4; ++i)
#pragma unroll
    for (int j = 0; j < 4; j += 2)
      epi(m0 + wm * 64 + i * 16 + lg * 4, n0 + wn * 64 + j * 16 + lr, acc[i][j], acc[i][j + 1]);
}

struct TileInfo { const bf16_t* a; const bf16_t* b; int m0, n0, ctx; };
template <class TileFn, class Epi>
DEVI void gemm_stream(int T, int lda, int ldb, int K, char* smem, TileFn tf, Epi epi) {
  int t0 = VT_FIRST;
  if (t0 >= T) return;
  int t = min(t0 + VT_OFF, T - 1);
  const int tid = opaque_tid(), lane = tid & 63, wave = tid >> 6, wm = wave >> 1, wn = wave & 1;
  const int lr = lane & 15, lg = lane >> 4;
  bf16_t* sA = (bf16_t*)smem;
  bf16_t* sB = sA + 2 * TILE_E;
  const int lrow = tid >> 3, lkc = (tid & 7) * 8;
  TileInfo ti = tf(t);
  const bf16_t* gA = ti.a + (size_t)lrow * lda + lkc;
  const bf16_t* gB = ti.b + (size_t)lrow * ldb + lkc;
  int m0 = ti.m0, n0 = ti.n0, ctx = ti.ctx;
  uint4 ra0, ra1, ra2, ra3, rb0, rb1, rb2, rb3;
  uint4 rc0, rc1, rc2, rc3, rd0, rd1, rd2, rd3;
#define GS_LOAD0(pa, pb) \
  ra0 = *(const uint4*)((pa)); ra1 = *(const uint4*)((pa) + (size_t)32 * lda); \
  ra2 = *(const uint4*)((pa) + (size_t)64 * lda); ra3 = *(const uint4*)((pa) + (size_t)96 * lda); \
  rb0 = *(const uint4*)((pb)); rb1 = *(const uint4*)((pb) + (size_t)32 * ldb); \
  rb2 = *(const uint4*)((pb) + (size_t)64 * ldb); rb3 = *(const uint4*)((pb) + (size_t)96 * ldb);
#define GS_LOAD1(pa, pb) \
  rc0 = *(const uint4*)((pa)); rc1 = *(const uint4*)((pa) + (size_t)32 * lda); \
  rc2 = *(const uint4*)((pa) + (size_t)64 * lda); rc3 = *(const uint4*)((pa) + (size_t)96 * lda); \
  rd0 = *(const uint4*)((pb)); rd1 = *(const uint4*)((pb) + (size_t)32 * ldb); \
  rd2 = *(const uint4*)((pb) + (size_t)64 * ldb); rd3 = *(const uint4*)((pb) + (size_t)96 * ldb);
#define GS_WRITE0(buf) { \
  bf16_t* wa = sA + (buf) * TILE_E + lrow * LDT + lkc; bf16_t* wb = sB + (buf) * TILE_E + lrow * LDT + lkc; \
  *(uint4*)(wa) = ra0; *(uint4*)(wa + 32 * LDT) = ra1; *(uint4*)(wa + 64 * LDT) = ra2; *(uint4*)(wa + 96 * LDT) = ra3; \
  *(uint4*)(wb) = rb0; *(uint4*)(wb + 32 * LDT) = rb1; *(uint4*)(wb + 64 * LDT) = rb2; *(uint4*)(wb + 96 * LDT) = rb3; }
#define GS_WRITE1(buf) { \
  bf16_t* wa = sA + (buf) * TILE_E + lrow * LDT + lkc; bf16_t* wb = sB + (buf) * TILE_E + lrow * LDT + lkc; \
  *(uint4*)(wa) = rc0; *(uint4*)(wa + 32 * LDT) = rc1; *(uint4*)(wa + 64 * LDT) = rc2; *(uint4*)(wa + 96 * LDT) = rc3; \
  *(uint4*)(wb) = rd0; *(uint4*)(wb + 32 * LDT) = rd1; *(uint4*)(wb + 64 * LDT) = rd2; *(uint4*)(wb + 96 * LDT) = rd3; }
#define GS_COMPUTE(buf) { \
    const bf16_t* cA = sA + (buf) * TILE_E + (wm * 64 + lr) * LDT + lg * 8; \
    const bf16_t* cB = sB + (buf) * TILE_E + (wn * 64 + lr) * LDT + lg * 8; \
    _Pragma("unroll") for (int ks = 0; ks < 2; ++ks) { \
      bf16x8 af[4], bfr[4]; \
      _Pragma("unroll") for (int i = 0; i < 4; ++i) { \
        af[i] = *(const bf16x8*)(cA + i * 16 * LDT + ks * 32); \
        bfr[i] = *(const bf16x8*)(cB + i * 16 * LDT + ks * 32); \
      } \
      __builtin_amdgcn_s_setprio(1); \
      _Pragma("unroll") for (int i = 0; i < 4; ++i) \
        _Pragma("unroll") for (int j = 0; j < 4; ++j) acc[i][j] = mfma16(af[i], bfr[j], acc[i][j]); \
      __builtin_amdgcn_s_setprio(0); \
    } }
  GS_LOAD0(gA, gB)
  GS_WRITE0(0)
  GS_LOAD1(gA + 64, gB + 64)
  __syncthreads();
  const int nk = K >> 6;
  for (;;) {
    f32x4 acc[4][4];
#pragma unroll
    for (int i = 0; i < 4; ++i)
#pragma unroll
      for (int j = 0; j < 4; ++j) acc[i][j] = (f32x4){0.f, 0.f, 0.f, 0.f};
    const int t0n = t0 + gridDim.x * 2;
    const bool have_next = t0n < T;
    const int tn = min(t0n + VT_OFF, T - 1);
    const bf16_t *nA = gA, *nB = gB;
    int nm0 = 0, nn0 = 0, nctx = 0;
    if (have_next) {
      const TileInfo tj = tf(tn);
      nA = tj.a + (size_t)lrow * lda + lkc;
      nB = tj.b + (size_t)lrow * ldb + lkc;
      nm0 = tj.m0; nn0 = tj.n0; nctx = tj.ctx;
    }
    for (int kt = 0; kt < nk; kt += 2) {
      {
        const bool wrap = (kt + 2 >= nk);
        const bf16_t* pa = wrap ? nA : gA + ((kt + 2) << 6);
        const bf16_t* pb = wrap ? nB : gB + ((kt + 2) << 6);
        GS_LOAD0(pa, pb)
        GS_COMPUTE(0)
        GS_WRITE1(1)
        __syncthreads();
      }
      {
        const bool wrap = (kt + 3 >= nk);
        const bf16_t* pa = wrap ? nA + 64 : gA + ((kt + 3) << 6);
        const bf16_t* pb = wrap ? nB + 64 : gB + ((kt + 3) << 6);
        GS_LOAD1(pa, pb)
        GS_COMPUTE(1)
        GS_WRITE0(0)
        __syncthreads();
      }
    }
#pragma unroll
    for (int i = 0; i < 4; ++i)
#pragma unroll
      for (int j = 0; j < 4; j += 2)
        epi(ctx, m0 + wm * 64 + i * 16 + lg * 4, n0 + wn * 64 + j * 16 + lr, acc[i][j], acc[i][j + 1]);
    if (!have_next) break;
    t = tn; t0 = t0n; gA = nA; gB = nB; m0 = nm0; n0 = nn0; ctx = nctx;
  }
}

constexpr int T8_E = 256 * LDT;
template <class TileFn, class Epi>
DEVI void gemm8_stream(int T, int lda, int ldb, int K, TileFn tf, Epi epi) {
  int t = blockIdx.x;
  if (t >= T) return;
  int tid = threadIdx.x; asm volatile("" : "+v"(tid));
  const int lane = tid & 63, wave = tid >> 6, wr = wave >> 2, wc = wave & 3;
  const int lr = lane & 15, lg = lane >> 4;
  bf16_t* sA = (bf16_t*)g_smem;
  bf16_t* sB = sA + 2 * T8_E;
  const int lrow = tid >> 3, lkc = (tid & 7) * 8;
  TileInfo ti = tf(t);
  const unsigned offA = ((unsigned)lrow * (unsigned)lda + (unsigned)lkc) * 2u;
  const unsigned offB = ((unsigned)lrow * (unsigned)ldb + (unsigned)lkc) * 2u;
  const char* gA = (const char*)ti.a;
  const char* gB = (const char*)ti.b;
  const size_t rsA = (size_t)64 * lda * 2, rsB = (size_t)64 * ldb * 2;
  int m0 = ti.m0, n0 = ti.n0, ctx = ti.ctx;
  uint4 ra0, ra1, ra2, ra3, rb0, rb1, rb2, rb3;
  uint4 rc0, rc1, rc2, rc3, rd0, rd1, rd2, rd3;
#define G8_LOAD(pa, pb) \
  ra0 = *(const uint4*)((pa) + offA); ra1 = *(const uint4*)((pa) + rsA + offA); \
  ra2 = *(const uint4*)((pa) + 2 * rsA + offA); ra3 = *(const uint4*)((pa) + 3 * rsA + offA); \
  rb0 = *(const uint4*)((pb) + offB); rb1 = *(const uint4*)((pb) + rsB + offB); \
  rb2 = *(const uint4*)((pb) + 2 * rsB + offB); rb3 = *(const uint4*)((pb) + 3 * rsB + offB);
#define G8_WRITE(buf) { \
  bf16_t* wa = sA + (buf) * T8_E + lrow * LDT + lkc; bf16_t* wb = sB + (buf) * T8_E + lrow * LDT + lkc; \
  *(uint4*)(wa) = ra0; *(uint4*)(wa + 64 * LDT) = ra1; *(uint4*)(wa + 128 * LDT) = ra2; *(uint4*)(wa + 192 * LDT) = ra3; \
  *(uint4*)(wb) = rb0; *(uint4*)(wb + 64 * LDT) = rb1; *(uint4*)(wb + 128 * LDT) = rb2; *(uint4*)(wb + 192 * LDT) = rb3; }
#define G8_LOAD1(pa, pb) \
  rc0 = *(const uint4*)((pa) + offA); rc1 = *(const uint4*)((pa) + rsA + offA); \
  rc2 = *(const uint4*)((pa) + 2 * rsA + offA); rc3 = *(const uint4*)((pa) + 3 * rsA + offA); \
  rd0 = *(const uint4*)((pb) + offB); rd1 = *(const uint4*)((pb) + rsB + offB); \
  rd2 = *(const uint4*)((pb) + 2 * rsB + offB); rd3 = *(const uint4*)((pb) + 3 * rsB + offB);
#define G8_WRITE1(buf) { \
  bf16_t* wa = sA + (buf) * T8_E + lrow * LDT + lkc; bf16_t* wb = sB + (buf) * T8_E + lrow * LDT + lkc; \
  *(uint4*)(wa) = rc0; *(uint4*)(wa + 64 * LDT) = rc1; *(uint4*)(wa + 128 * LDT) = rc2; *(uint4*)(wa + 192 * LDT) = rc3; \
  *(uint4*)(wb) = rd0; *(uint4*)(wb + 64 * LDT) = rd1; *(uint4*)(wb + 128 * LDT) = rd2; *(uint4*)(wb + 192 * LDT) = rd3; }
#define G8_COMPUTE(buf) { \
      const bf16_t* cA = sA + (buf) * T8_E + (wr * 128 + lr) * LDT + lg * 8; \
      const bf16_t* cB = sB + (buf) * T8_E + (wc * 64 + lr) * LDT + lg * 8; \
      _Pragma("unroll") for (int ks = 0; ks < 2; ++ks) { \
        bf16x8 bfr[4]; \
        _Pragma("unroll") for (int j = 0; j < 4; ++j) bfr[j] = *(const bf16x8*)(cB + j * 16 * LDT + ks * 32); \
        _Pragma("unroll") for (int h = 0; h < 2; ++h) { \
          bf16x8 af[4]; \
          _Pragma("unroll") for (int i = 0; i < 4; ++i) af[i] = *(const bf16x8*)(cA + (h * 4 + i) * 16 * LDT + ks * 32); \
          _Pragma("unroll") for (int i = 0; i < 4; ++i) \
            _Pragma("unroll") for (int j = 0; j < 4; ++j) acc[h * 4 + i][j] = mfma16(af[i], bfr[j], acc[h * 4 + i][j]); \
        } \
      } }
  G8_LOAD(gA, gB)
  G8_WRITE(0)
  G8_LOAD1(gA + 128, gB + 128)
  __syncthreads();
  const int nk = K >> 6;
  for (;;) {
    f32x4 acc[8][4];
#pragma unroll
    for (int i = 0; i < 8; ++i)
#pragma unroll
      for (int j = 0; j < 4; ++j) acc[i][j] = (f32x4){0.f, 0.f, 0.f, 0.f};
    const int tn = t + gridDim.x;
    const bool have_next = tn < T;
    const char *nA = gA, *nB = gB;
    int nm0 = 0, nn0 = 0, nctx = 0;
    if (have_next) {
      const TileInfo tj = tf(tn);
      nA = (const char*)tj.a;
      nB = (const char*)tj.b;
      nm0 = tj.m0; nn0 = tj.n0; nctx = tj.ctx;
    }
#pragma unroll 1
    for (int kt = 0; kt < nk; kt += 2) {
      {
        const bool wrap = (kt + 2 >= nk);
        const char* pa = wrap ? nA : gA + ((kt + 2) << 7);
        const char* pb = wrap ? nB : gB + ((kt + 2) << 7);
        G8_LOAD(pa, pb)
        G8_COMPUTE(0)
        G8_WRITE1(1)
        __syncthreads();
      }
      {
        const bool wrap = (kt + 3 >= nk);
        const char* pa = wrap ? nA + 128 : gA + ((kt + 3) << 7);
        const char* pb = wrap ? nB + 128 : gB + ((kt + 3) << 7);
        G8_LOAD1(pa, pb)
        G8_COMPUTE(1)
        G8_WRITE(0)
        __syncthreads();
      }
    }
#pragma unroll
    for (int i = 0; i < 8; ++i)
#pragma unroll
      for (int j = 0; j < 4; j += 2)
        epi(ctx, m0 + wr * 128 + i * 16 + lg * 4, n0 + wc * 64 + j * 16 + lr, acc[i][j], acc[i][j + 1]);
    if (!have_next) break;
    t = tn; gA = nA; gB = nB; m0 = nm0; n0 = nn0; ctx = nctx;
  }
}

DEVI void tile_mn(int t, int nM, int nN, int& m, int& n) {
  int id = swz_tile(t, nM * nN);
  int per = 8 * nN;
  int gq = id / per, rem = id - gq * per;
  int gsz = min(8, nM - gq * 8);
  m = gq * 8 + rem % gsz;
  n = rem / gsz;
}

NOINL void gemv_tile(const P& p, int t) {
  char* smem = g_smem + VB * 73728;
  const int tid = opaque_tid();
  float* sv = (float*)smem;
  float* red = sv + 3072;
  const int l = t / 192, n0 = (t % 192) * 32;
  for (int i = tid; i < 3072; i += 256) {
    int v = i >> 10, k = i & 1023;
    float cv = (v == 0) ? p.c_ctx[k] : p.c[(v - 1) * 1024 + k];
    sv[i] = cv / (1.f + expf(-cv));
  }
  __syncthreads();
  const int cgp = tid & 7, ks = tid >> 3;
  const float* w = p.w_mod + (size_t)l * 1024 * 6144 + n0 + cgp * 4;
  float a0[4] = {0, 0, 0, 0}, a1[4] = {0, 0, 0, 0}, a2[4] = {0, 0, 0, 0};
#pragma unroll 16
  for (int kk = 0; kk < 32; ++kk) {
    const int k = ks * 32 + kk;
    const float4 wv = *(const float4*)(w + (size_t)k * 6144);
    const float s0 = sv[k], s1 = sv[1024 + k], s2 = sv[2048 + k];
    a0[0] += s0 * wv.x; a0[1] += s0 * wv.y; a0[2] += s0 * wv.z; a0[3] += s0 * wv.w;
    a1[0] += s1 * wv.x; a1[1] += s1 * wv.y; a1[2] += s1 * wv.z; a1[3] += s1 * wv.w;
    a2[0] += s2 * wv.x; a2[1] += s2 * wv.y; a2[2] += s2 * wv.z; a2[3] += s2 * wv.w;
  }
#pragma unroll
  for (int j = 0; j < 4; ++j) {
    red[(ks * 3 + 0) * 32 + cgp * 4 + j] = a0[j];
    red[(ks * 3 + 1) * 32 + cgp * 4 + j] = a1[j];
    red[(ks * 3 + 2) * 32 + cgp * 4 + j] = a2[j];
  }
  __syncthreads();
  if (tid < 96) {
    const int v = tid >> 5, col = tid & 31;
    float s = 0.f;
    for (int q = 0; q < 32; ++q) s += red[(q * 3 + v) * 32 + col];
    s += p.b_mod[l * 6144 + n0 + col];
    WSF(OFF_MOD)[(l * 3 + v) * 6144 + n0 + col] = s;
  }
  __syncthreads();
}

NOINL void transpose_tile(const P& p, int t) {
  char* smem = g_smem + VB * 73728;
  const int tid = opaque_tid();
  const float* src; bf16_t* dst; int K, N, ntn, mode = 0;
  if (t < 544) { src = p.w_in; dst = WSB(OFF_WIN); K = 1024; N = 2096; ntn = 34; }
  else if ((t -= 544) < 48) { src = p.w_uq; dst = WSB(OFF_WUQ); K = 256; N = 768; ntn = 12; }
  else if ((t -= 48) < 64) { src = p.w_ukv; dst = WSB(OFF_WUKV); K = 256; N = 1024; ntn = 16; }
  else if ((t -= 64) < 256) { src = p.w_out; dst = WSB(OFF_WOUT); K = 1024; N = 1024; ntn = 16; }
  else if ((t -= 256) < 64) { int g = t >> 4; t &= 15; src = p.pool_w + (size_t)g * 65536; dst = WSB(OFF_WPOOL) + (size_t)g * 65536; K = 256; N = 256; ntn = 4; }
  else if ((t -= 64) < 1408) { int l = t / 704; t -= l * 704; src = p.w_gate + (size_t)l * 1024 * 2816; dst = WSB(OFF_WGU) + (size_t)l * 5632 * 1024; K = 1024; N = 2816; ntn = 44; mode = 1; }
  else if ((t -= 1408) < 1408) { int l = t / 704; t -= l * 704; src = p.w_up + (size_t)l * 1024 * 2816; dst = WSB(OFF_WGU) + (size_t)l * 5632 * 1024; K = 1024; N = 2816; ntn = 44; mode = 2; }
  else { t -= 1408; int l = t / 704; t -= l * 704; src = p.w_down + (size_t)l * 2816 * 1024; dst = WSB(OFF_WDN) + (size_t)l * 1024 * 2816; K = 2816; N = 1024; ntn = 16; }
  const int kt = t / ntn, nt_ = t - kt * ntn;
  const int k0 = kt * 64, n0 = nt_ * 64;
  float* tile = (float*)smem;
  {
    const int nn = tid & 63, kk0 = tid >> 6;
    const int n = n0 + nn;
    const int nc = n < N ? n : N - 1;
    float v[16];
#pragma unroll
    for (int i = 0; i < 16; ++i) v[i] = src[(size_t)(k0 + kk0 + 4 * i) * N + nc];
#pragma unroll
    for (int i = 0; i < 16; ++i) tile[(kk0 + 4 * i) * 65 + nn] = (n < N) ? v[i] : 0.f;
  }
  __syncthreads();
#pragma unroll
  for (int i = 0; i < 2; ++i) {
    const int id = tid + 256 * i;
    const int nn = id >> 3, kc = id & 7;
    const int n = n0 + nn;
    uint4 pk;
    pk.x = pack2(tile[(kc * 8 + 0) * 65 + nn], tile[(kc * 8 + 1) * 65 + nn]);
    pk.y = pack2(tile[(kc * 8 + 2) * 65 + nn], tile[(kc * 8 + 3) * 65 + nn]);
    pk.z = pack2(tile[(kc * 8 + 4) * 65 + nn], tile[(kc * 8 + 5) * 65 + nn]);
    pk.w = pack2(tile[(kc * 8 + 6) * 65 + nn], tile[(kc * 8 + 7) * 65 + nn]);
    int drow = n;
    if (mode == 1) drow = (n >> 4) * 32 + (n & 15);
    else if (mode == 2) drow = (n >> 4) * 32 + 16 + (n & 15);
    *(uint4*)(dst + (size_t)drow * K + k0 + kc * 8) = pk;
  }
  __syncthreads();
}

template <bool UPD, bool MOD, bool FIRST, bool LASTW, bool TWO, bool POOL = false>
DEVI void rowop(const P& p, const bf16_t* msrc, const bf16_t* msrc2, const float* wpost, int gate_idx, const float* wpre, int shift_idx,
                int scale_idx, int layer_g, int layer_m) {
  const int lane = threadIdx.x & 63, wave = threadIdx.x >> 6;
  const float* modg = WSF(OFF_MOD) + (size_t)layer_g * 3 * 6144;
  const float* modm = WSF(OFF_MOD) + (size_t)layer_m * 3 * 6144;
  bf16_t* hbuf = WSB(OFF_H);
  for (int r = blockIdx.x * 8 + wave; r < 8192; r += gridDim.x * 8) {
    const int v = r < 4096 ? 0 : 1 + ((r - 4096) >> 11);
    const float* mvg = modg + v * 6144;
    const float* mvm = modm + v * 6144;
    float4 x[4];
    if (FIRST) {
      const float* xin = r < 4096 ? p.x_prompt + (size_t)r * 1024 : p.x_sample + (size_t)(r - 4096) * 1024;
#pragma unroll
      for (int i = 0; i < 4; ++i) x[i] = *(const float4*)(xin + lane * 4 + 256 * i);
    } else {
#pragma unroll
      for (int i = 0; i < 4; ++i) {
        const uint2 xb = *(const uint2*)(WSB(OFF_XR) + (size_t)r * 1024 + lane * 4 + 256 * i);
        x[i].x = __uint_as_float(xb.x << 16); x[i].y = __uint_as_float(xb.x & 0xffff0000u);
        x[i].z = __uint_as_float(xb.y << 16); x[i].w = __uint_as_float(xb.y & 0xffff0000u);
      }
    }
    if (UPD) {
      float4 m[4];
      float ss = 0.f;
      int ps0 = 0, pL = 0;
      if (POOL) { if (r < 4096) { ps0 = r & ~255; pL = 256; } else { ps0 = 4096 + ((r - 4096) & ~2047); pL = 2048; } }
#pragma unroll
      for (int i = 0; i < 4; ++i) {
        if (POOL) {
          constexpr int dummy = 0; (void)dummy;
          const int W2 = 1 << i;
          const int t = r - ps0;
          const int lo = max(t - W2, 0), hi = min(t + W2, pL);
          float a0 = 0.f, a1 = 0.f, a2 = 0.f, a3 = 0.f;
          uint2 ctr = make_uint2(0u, 0u);
#pragma unroll
          for (int k = 0; k < 2 * W2; ++k) {
            const int u = t - W2 + k;
            const int uc = min(max(u, 0), pL - 1);
            const uint2 g = *(const uint2*)(msrc + (size_t)(ps0 + uc) * 1024 + lane * 4 + 256 * i);
            const float w = (u >= 0 && u < pL) ? 1.f : 0.f;
            a0 += w * __uint_as_float(g.x << 16); a1 += w * __uint_as_float(g.x & 0xffff0000u);
            a2 += w * __uint_as_float(g.y << 16); a3 += w * __uint_as_float(g.y & 0xffff0000u);
            if (k == W2) ctr = g;
          }
          const float inv = 1.f / (float)(hi - lo);
          m[i].x = a0 * inv - __uint_as_float(ctr.x << 16); m[i].y = a1 * inv - __uint_as_float(ctr.x & 0xffff0000u);
          m[i].z = a2 * inv - __uint_as_float(ctr.y << 16); m[i].w = a3 * inv - __uint_as_float(ctr.y & 0xffff0000u);
          ss += m[i].x * m[i].x + m[i].y * m[i].y + m[i].z * m[i].z + m[i].w * m[i].w;
          continue;
        }
        const uint2 mb = *(const uint2*)(msrc + (size_t)r * 1024 + lane * 4 + 256 * i);
        m[i].x = __uint_as_float(mb.x << 16); m[i].y = __uint_as_float(mb.x & 0xffff0000u);
        m[i].z = __uint_as_float(mb.y << 16); m[i].w = __uint_as_float(mb.y & 0xffff0000u);
        if (TWO) {
          const uint2 mc = *(const uint2*)(msrc2 + (size_t)r * 1024 + lane * 4 + 256 * i);
          m[i].x += __uint_as_float(mc.x << 16); m[i].y += __uint_as_float(mc.x & 0xffff0000u);
          m[i].z += __uint_as_float(mc.y << 16); m[i].w += __uint_as_float(mc.y & 0xffff0000u);
        }
        ss += m[i].x * m[i].x + m[i].y * m[i].y + m[i].z * m[i].z + m[i].w * m[i].w;
      }
      ss = wave_sum(ss);
      const float rs = rsqrtf(ss * (1.f / 1024.f) + 1e-6f);
#pragma unroll
      for (int i = 0; i < 4; ++i) {
        const int col = lane * 4 + 256 * i;
        const float4 wp = *(const float4*)(wpost + col);
        const float4 g = *(const float4*)(mvg + gate_idx * 1024 + col);
        x[i].x += g.x * (m[i].x * rs * wp.x);
        x[i].y += g.y * (m[i].y * rs * wp.y);
        x[i].z += g.z * (m[i].z * rs * wp.z);
        x[i].w += g.w * (m[i].w * rs * wp.w);
        if (LASTW) *(float4*)(p.out + (size_t)r * 1024 + col) = x[i];
        else {
          uint2 xo;
          xo.x = pack2(x[i].x, x[i].y);
          xo.y = pack2(x[i].z, x[i].w);
          *(uint2*)(WSB(OFF_XR) + (size_t)r * 1024 + col) = xo;
        }
      }
    }
    if (MOD) {
      float ss = 0.f;
#pragma unroll
      for (int i = 0; i < 4; ++i) ss += x[i].x * x[i].x + x[i].y * x[i].y + x[i].z * x[i].z + x[i].w * x[i].w;
      ss = wave_sum(ss);
      const float rs = rsqrtf(ss * (1.f / 1024.f) + 1e-6f);
#pragma unroll
      for (int i = 0; i < 4; ++i) {
        const int col = lane * 4 + 256 * i;
        const float4 wp = *(const float4*)(wpre + col);
        const float4 sh = *(const float4*)(mvm + shift_idx * 1024 + col);
        const float4 sc = *(const float4*)(mvm + scale_idx * 1024 + col);
        uint2 o;
        o.x = pack2(x[i].x * rs * wp.x * (1.f + sc.x) + sh.x, x[i].y * rs * wp.y * (1.f + sc.y) + sh.y);
        o.y = pack2(x[i].z * rs * wp.z * (1.f + sc.z) + sh.z, x[i].w * rs * wp.w * (1.f + sc.w) + sh.w);
        *(uint2*)(hbuf + (size_t)r * 1024 + col) = o;
      }
    }
  }
}

NOINL void prep_rows(const P& p) {
  const int lane = threadIdx.x & 63, wave = threadIdx.x >> 6;
  const bf16_t* proj = WSB(OFF_R1);
  for (int r = blockIdx.x * 8 + wave; r < 8192; r += gridDim.x * 8) {
    const bf16_t* pr = proj + (size_t)r * 2080;
    const int kvrow = r < 4096 ? r : 4096 + ((r - 4096) >> 11) * 2304 + 256 + ((r - 4096) & 2047);
    const uint2 rq = *(const uint2*)(pr + lane * 4);
    const uint2 rk = *(const uint2*)(pr + 256 + lane * 4);
    const float4 ld_cq = make_float4(__uint_as_float(rq.x << 16), __uint_as_float(rq.x & 0xffff0000u), __uint_as_float(rq.y << 16), __uint_as_float(rq.y & 0xffff0000u));
    const float4 ld_ckv = make_float4(__uint_as_float(rk.x << 16), __uint_as_float(rk.x & 0xffff0000u), __uint_as_float(rk.y << 16), __uint_as_float(rk.y & 0xffff0000u));
    const float ld_kpe = bf2f(pr[512 + (lane & 31)]);
    const float ld_dt = WSF(OFF_DTRAW)[(size_t)r * 16 + (lane & 15)];
    {
      const float4 a = ld_cq;
      float ss = wave_sum(a.x * a.x + a.y * a.y + a.z * a.z + a.w * a.w);
      const float rs = rsqrtf(ss * (1.f / 256.f) + 1e-6f);
      const float4 g = *(const float4*)(p.q_norm + lane * 4);
      uint2 o;
      o.x = pack2(a.x * rs * g.x, a.y * rs * g.y);
      o.y = pack2(a.z * rs * g.z, a.w * rs * g.w);
      *(uint2*)(WSB(OFF_CQN) + (size_t)r * 256 + lane * 4) = o;
    }
    {
      const float4 a = ld_ckv;
      float ss = wave_sum(a.x * a.x + a.y * a.y + a.z * a.z + a.w * a.w);
      const float rs = rsqrtf(ss * (1.f / 256.f) + 1e-6f);
      const float4 g = *(const float4*)(p.kv_norm + lane * 4);
      float4 vv;
      vv.x = a.x * rs * g.x; vv.y = a.y * rs * g.y; vv.z = a.z * rs * g.z; vv.w = a.w * rs * g.w;
      if (r < 4096) *(float4*)(p.out + OUT_CKV + (size_t)r * 256 + lane * 4) = vv;
      uint2 o;
      o.x = pack2(vv.x, vv.y);
      o.y = pack2(vv.z, vv.w);
      *(uint2*)(WSB(OFF_CKV) + (size_t)kvrow * 256 + lane * 4) = o;
    }
    {
      const float kv = (lane < 32) ? ld_kpe : 0.f;
      const float partner = __shfl_xor(kv, 16, 64);
      if (r < 4096) {
        if (lane < 32) {
          p.out[OUT_KR + (size_t)r * 32 + lane] = kv;
          WSB(OFF_KPE)[(size_t)kvrow * 32 + lane] = f2bf(kv);
        }
      } else {
        const int t = (r - 4096) & 2047;
        const int ii = lane & 15;
        const float pos = (ii < 8) ? (float)(t >> 6) : (float)(t & 63);
        const float fr = rope_freq(ii & 7);
        const float ang = pos * fr;
        float cs, sn;
        fast_sincos(ang, sn, cs);
        const float o = (lane < 16) ? (kv * cs - partner * sn) : (partner * sn + kv * cs);
        if (lane < 32) WSB(OFF_KPE)[(size_t)kvrow * 32 + lane] = f2bf(o);
      }
    }
    if (lane < 16) {
      const int dir = lane >> 3, hh = lane & 7;
      const float raw = ld_dt + (dir ? p.dtb_b[hh] : p.dtb_f[hh]);
      const float sp = raw > 20.f ? raw : log1pf(expf(raw));
      WSF(OFF_DTV)[((size_t)dir * 8192 + r) * 8 + hh] = sp;
    }
  }
}

NOINL void prep_cache(const P& p) {
  const int gt = blockIdx.x * 512 + threadIdx.x, gs = gridDim.x * 512;
  for (int i = gt; i < 2 * 256 * 256; i += gs) {
    int b = i >> 16, rem = i & 65535;
    WSB(OFF_CKV)[(size_t)(4096 + b * 2304) * 256 + rem] = f2bf(p.cache_ckv[i]);
  }
  for (int i = gt; i < 2 * 256 * 32; i += gs) {
    int b = i >> 13, rem = i & 8191;
    WSB(OFF_KPE)[(size_t)(4096 + b * 2304) * 32 + rem] = f2bf(p.cache_kr[i]);
  }
}

NOINL void conv_tile(const P& p, int t) {
  char* smem = g_smem + VB * 73728;
  const int tid = opaque_tid();
  float* sin_ = (float*)smem;
  float* sout = sin_ + 68 * 64;
  const int tt_ = t >> 4, ct = t & 15;
  const int r0 = tt_ * 64, c0 = ct * 64;
  int s0, s1;
  if (r0 < 4096) { s0 = r0 & ~255; s1 = s0 + 256; } else { s0 = 4096 + ((r0 - 4096) & ~2047); s1 = s0 + 2048; }
  const bf16_t* proj = WSB(OFF_R1);
  {
    const int rr0 = tid >> 6, cc = tid & 63;
    float v[17];
#pragma unroll
    for (int k = 0; k < 17; ++k) {
      const int r = r0 - 2 + rr0 + 4 * k;
      const int rc = r < s0 ? s0 : (r >= s1 ? s1 - 1 : r);
      v[k] = bf2f(proj[(size_t)rc * 2080 + 1056 + c0 + cc]);
    }
#pragma unroll
    for (int k = 0; k < 17; ++k) {
      const int r = r0 - 2 + rr0 + 4 * k;
      sin_[(rr0 + 4 * k) * 64 + cc] = (r >= s0 && r < s1) ? v[k] : 0.f;
    }
  }
  __syncthreads();
  {
    const int cc = tid & 63, tq = tid >> 6;
    const int c = c0 + cc;
    const float w0 = p.conv_w[c], w1 = p.conv_w[1024 + c], w2 = p.conv_w[2048 + c], w3 = p.conv_w[3072 + c],
                w4 = p.conv_w[4096 + c], bias = p.conv_b[c];
#pragma unroll 4
    for (int i = 0; i < 16; ++i) {
      const int tt = tq * 16 + i;
      float y = bias + w0 * sin_[tt * 64 + cc] + w1 * sin_[(tt + 1) * 64 + cc] + w2 * sin_[(tt + 2) * 64 + cc] +
                w3 * sin_[(tt + 3) * 64 + cc] + w4 * sin_[(tt + 4) * 64 + cc];
      y = y / (1.f + __expf(-y));
      sout[tt * 65 + cc] = y;
      const bf16_t b = f2bf(y);
      const size_t r = r0 + tt;
      if (c < 512) WSB(OFF_XS)[r * 512 + c] = b;
      else if (c < 768) WSB(OFF_BM)[r * 256 + (c - 512)] = b;
      else WSB(OFF_CM)[r * 256 + (c - 768)] = b;
    }
  }
  __syncthreads();
  if (c0 < 768) {
    const int cl = tid >> 2, q4 = tid & 3;
    uint4 o0, o1;
    const float* sp = sout + (q4 * 16) * 65 + cl;
    o0.x = pack2(sp[0 * 65], sp[1 * 65]);   o0.y = pack2(sp[2 * 65], sp[3 * 65]);
    o0.z = pack2(sp[4 * 65], sp[5 * 65]);   o0.w = pack2(sp[6 * 65], sp[7 * 65]);
    o1.x = pack2(sp[8 * 65], sp[9 * 65]);   o1.y = pack2(sp[10 * 65], sp[11 * 65]);
    o1.z = pack2(sp[12 * 65], sp[13 * 65]); o1.w = pack2(sp[14 * 65], sp[15 * 65]);
    bf16_t* dst = (c0 < 512) ? WSB(OFF_XST) + (size_t)(c0 + cl) * 8192 : WSB(OFF_BT) + (size_t)(c0 - 512 + cl) * 8192;
    dst += r0 + q4 * 16;
    *(uint4*)(dst) = o0;
    *(uint4*)(dst + 8) = o1;
  }
  __syncthreads();
}

NOINL void chunk_state_item(const P& p, int item) {
  char* smem = g_smem + VB * 73728;
  const int tid = opaque_tid(), lane = tid & 63, wave = tid >> 6, lr = lane & 15, lg = lane >> 4;
  const int cidx = item >> 3, hh = item & 7, g = hh >> 2;
  const int r0 = cidx * 128;
  constexpr int LDS_ = 136;
  bf16_t* sAs = (bf16_t*)smem;
  bf16_t* sBs = sAs + 2 * 64 * LDS_;
  float* fa = (float*)(sBs + 128 * LDS_);
  float* fcum = fa + 256;
  float* fw = fa + 512;
  float* fdt = fa + 768;
  {
    const int dir = tid >> 7, j = tid & 127;
    const float dt = WSF(OFF_DTV)[((size_t)dir * 8192 + r0 + j) * 8 + hh];
    const float Aco = -expf(dir ? p.alog_b[hh] : p.alog_f[hh]);
    fa[tid] = dt * Aco;
    fdt[tid] = dt;
  }
  __syncthreads();
  {
    const int dir = tid >> 7, j = tid & 127;
    float s = 0.f;
    const float4* fa4 = (const float4*)(fa + dir * 128);
    if (dir == 0) {
      const int nb = (j + 1) >> 2;
      for (int k4 = 0; k4 < nb; ++k4) { const float4 v = fa4[k4]; s += (v.x + v.y) + (v.z + v.w); }
      for (int k = nb * 4; k <= j; ++k) s += fa[k];
    } else {
      const int fb = (j + 3) >> 2;
      for (int k4 = 31; k4 >= fb; --k4) { const float4 v = fa4[k4]; s += (v.x + v.y) + (v.z + v.w); }
      for (int k = j; k < fb * 4; ++k) s += fa[128 + k];
    }
    fcum[tid] = s;
    WSF(OFF_CUM)[((size_t)dir * 8192 + r0 + j) * 8 + hh] = s;
  }
  __syncthreads();
  {
    const int dir = tid >> 7;
    const float ce = dir ? fcum[128] : fcum[127];
    fw[tid] = __expf(ce - fcum[tid]) * fdt[tid];
    if ((tid & 127) == 0) WSF(OFF_TOT)[(dir * 64 + cidx) * 8 + hh] = __expf(ce);
  }
  __syncthreads();
#pragma unroll
  for (int i = 0; i < 4; ++i) {
    const int id = tid + 256 * i;
    const int pp = id >> 4, jc = (id & 15) * 8;
    const uint4 raw = *(const uint4*)(WSB(OFF_XST) + (size_t)(hh * 64 + pp) * 8192 + r0 + jc);
    const unsigned rw[4] = {raw.x, raw.y, raw.z, raw.w};
    unsigned of[4], ob[4];
#pragma unroll
    for (int q = 0; q < 4; ++q) {
      const float x0 = __uint_as_float(rw[q] << 16), x1 = __uint_as_float(rw[q] & 0xffff0000u);
      of[q] = pack2(x0 * fw[jc + 2 * q], x1 * fw[jc + 2 * q + 1]);
      ob[q] = pack2(x0 * fw[128 + jc + 2 * q], x1 * fw[128 + jc + 2 * q + 1]);
    }
    *(uint4*)(sAs + pp * LDS_ + jc) = make_uint4(of[0], of[1], of[2], of[3]);
    *(uint4*)(sAs + 64 * LDS_ + pp * LDS_ + jc) = make_uint4(ob[0], ob[1], ob[2], ob[3]);
  }
#pragma unroll
  for (int i = 0; i < 8; ++i) {
    const int id = tid + 256 * i;
    const int nn = id >> 4, jc = (id & 15) * 8;
    *(uint4*)(sBs + nn * LDS_ + jc) = *(const uint4*)(WSB(OFF_BT) + (size_t)(g * 128 + nn) * 8192 + r0 + jc);
  }
  __syncthreads();
  {
    const int dir = wave >> 1, nh = wave & 1;
    f32x4 acc[4][4];
#pragma unroll
    for (int i = 0; i < 4; ++i)
#pragma unroll
      for (int j = 0; j < 4; ++j) acc[i][j] = (f32x4){0.f, 0.f, 0.f, 0.f};
    const bf16_t* cA = sAs + dir * 64 * LDS_ + lr * LDS_ + lg * 8;
    const bf16_t* cB = sBs + (nh * 64 + lr) * LDS_ + lg * 8;
#pragma unroll 1
    for (int ks = 0; ks < 4; ++ks) {
      bf16x8 af[4], bfr[4];
#pragma unroll
      for (int i = 0; i < 4; ++i) {
        af[i] = *(const bf16x8*)(cA + i * 16 * LDS_ + ks * 32);
        bfr[i] = *(const bf16x8*)(cB + i * 16 * LDS_ + ks * 32);
      }
#pragma unroll
      for (int i = 0; i < 4; ++i)
#pragma unroll
        for (int j = 0; j < 4; ++j) acc[i][j] = mfma16(af[i], bfr[j], acc[i][j]);
    }
    float* S = WSF(OFF_R2) + ((size_t)(dir * 64 + cidx) * 8 + hh) * 8192 + (lg * 4) * 128 + nh * 64 + lr;
#pragma unroll
    for (int i = 0; i < 4; ++i) {
#pragma unroll
      for (int q = 0; q < 4; ++q) {
#pragma unroll
        for (int j = 0; j < 4; ++j) S[j * 16] = acc[i][j][q];
        S += 128;
      }
      S += 12 * 128;
      __builtin_amdgcn_sched_barrier(0);
    }
  }
  __syncthreads();
}

template <int NB>
DEVI void scan_group(const P& p, float4& h, int dir, int cb, int nc, int c0, int hh, size_t eoff) {
  float4 sv[NB];
  float d[NB];
  size_t base[NB];
#pragma unroll
  for (int k = 0; k < NB; ++k) {
    const int c = c0 + k;
    const int cidx = cb + (dir ? nc - 1 - c : c);
    base[k] = ((size_t)(dir * 64 + cidx) * 8 + hh) * 8192 + eoff;
    d[k] = WSF(OFF_TOT)[(dir * 64 + cidx) * 8 + hh];
    sv[k] = *(const float4*)(WSF(OFF_R2) + base[k]);
  }
#pragma unroll
  for (int k = 0; k < NB; ++k) {
    uint2 o;
    o.x = pack2(h.x, h.y);
    o.y = pack2(h.z, h.w);
    *(uint2*)(WSB(OFF_H) + base[k]) = o;
    h.x = d[k] * h.x + sv[k].x; h.y = d[k] * h.y + sv[k].y; h.z = d[k] * h.z + sv[k].z; h.w = d[k] * h.w + sv[k].w;
  }
}

NOINL void scan_states(const P& p) {
  const int total = 2 * 18 * 8 * 64 * 32;
  for (int idx = blockIdx.x * 512 + threadIdx.x; idx < total; idx += gridDim.x * 512) {
    const int n4 = idx & 31, pp = (idx >> 5) & 63, hh = (idx >> 11) & 7;
    const int sd = idx >> 14;
    const int s = sd % 18, dir = sd / 18;
    const int nc = s < 16 ? 2 : 16;
    const int cb = s < 16 ? s * 2 : 32 + (s - 16) * 16;
    float4 h = make_float4(0.f, 0.f, 0.f, 0.f);
    const size_t eoff = (size_t)pp * 128 + n4 * 4;
    if (s >= 16) {
      const float* st = (dir ? p.st_b : p.st_f) + ((size_t)((s - 16) * 8 + hh) * 64 + pp) * 128 + n4 * 4;
      h = *(const float4*)st;
      scan_group<8>(p, h, dir, cb, nc, 0, hh, eoff);
      scan_group<8>(p, h, dir, cb, nc, 8, hh, eoff);
    } else {
      scan_group<2>(p, h, dir, cb, nc, 0, hh, eoff);
      float* o = p.out + (dir ? OUT_SB : OUT_SF) + ((size_t)(s * 8 + hh) * 64 + pp) * 128 + n4 * 4;
      *(float4*)o = h;
    }
  }
}

NOINL void attn_item(const P& p, int id) {
  char* smem = g_smem + VB * 73728;
  const int tid = opaque_tid(), lane = tid & 63, wave = tid >> 6, lr = lane & 15, lg = lane >> 4;
  int row0, kvbase, Lk, hh;
  if (id < 512) { hh = id & 7; const int b = (id >> 3) & 1; const int qb = id >> 4; row0 = 4096 + b * 2048 + qb * 64; kvbase = 4096 + b * 2304; Lk = 2304; }
  else { const int i2 = id - 512; hh = i2 & 7; const int rest = i2 >> 3; const int b = rest >> 2; const int qb = rest & 3; row0 = b * 256 + qb * 64; kvbase = b * 256; Lk = 256; }
  constexpr int LDK = 104, LDV = 72;
  constexpr int KVBUF = 64 * LDK + 64 * LDV;
  bf16_t* sKV = (bf16_t*)smem;
  const int qrow = row0 + wave * 16 + lr;
  bf16x8 qf[3];
#pragma unroll
  for (int ks = 0; ks < 3; ++ks) qf[ks] = *(const bf16x8*)(WSB(OFF_Q) + (size_t)qrow * 768 + hh * 96 + ks * 32 + lg * 8);
  f32x4 oacc[4];
#pragma unroll
  for (int i = 0; i < 4; ++i) oacc[i] = (f32x4){0.f, 0.f, 0.f, 0.f};
  float mrun = -1e30f, lrun = 0.f;
  const int nkt = Lk >> 6;
  const int kkey0 = tid / 12, kcc0 = tid - kkey0 * 12;
  const int c1 = tid + 256, kkey1 = c1 / 12, kcc1 = c1 - kkey1 * 12;
  const int c2 = tid + 512, kkey2 = c2 / 12, kcc2 = c2 - kkey2 * 12;
  const bf16_t* kn = WSB(OFF_KN);
  const bf16_t* kp = WSB(OFF_KPE);
  const bf16_t* ksrc0 = (kcc0 < 8) ? kn + (size_t)(kvbase + kkey0) * 512 + hh * 64 + kcc0 * 8 : kp + (size_t)(kvbase + kkey0) * 32 + (kcc0 - 8) * 8;
  const bf16_t* ksrc1 = (kcc1 < 8) ? kn + (size_t)(kvbase + kkey1) * 512 + hh * 64 + kcc1 * 8 : kp + (size_t)(kvbase + kkey1) * 32 + (kcc1 - 8) * 8;
  const bf16_t* ksrc2 = (kcc2 < 8) ? kn + (size_t)(kvbase + kkey2) * 512 + hh * 64 + kcc2 * 8 : kp + (size_t)(kvbase + kkey2) * 32 + (kcc2 - 8) * 8;
  const int kst0 = (kcc0 < 8) ? 512 * 64 : 32 * 64, kst1 = (kcc1 < 8) ? 512 * 64 : 32 * 64, kst2 = (kcc2 < 8) ? 512 * 64 : 32 * 64;
  const int vd0 = tid >> 3, vcc = tid & 7;
  const bf16_t* vsrc0 = WSB(OFF_VT) + (size_t)(hh * 64 + vd0) * 8704 + kvbase + vcc * 8;
  const bf16_t* vsrc1 = vsrc0 + (size_t)32 * 8704;
  uint4 rk0, rk1, rk2, rv0, rv1;
#define AT_LOAD(kt) { const int _k = (kt); \
    rk0 = *(const uint4*)(ksrc0 + (size_t)_k * kst0); rk1 = *(const uint4*)(ksrc1 + (size_t)_k * kst1); \
    rk2 = *(const uint4*)(ksrc2 + (size_t)_k * kst2); \
    rv0 = *(const uint4*)(vsrc0 + _k * 64); rv1 = *(const uint4*)(vsrc1 + _k * 64); }
#define AT_WRITE(buf) { bf16_t* _b = sKV + (buf) * KVBUF; \
    *(uint4*)(_b + kkey0 * LDK + kcc0 * 8) = rk0; *(uint4*)(_b + kkey1 * LDK + kcc1 * 8) = rk1; \
    *(uint4*)(_b + kkey2 * LDK + kcc2 * 8) = rk2; \
    *(uint4*)(_b + 64 * LDK + vd0 * LDV + vcc * 8) = rv0; *(uint4*)(_b + 64 * LDK + (vd0 + 32) * LDV + vcc * 8) = rv1; }
  AT_LOAD(0)
  AT_WRITE(0)
  __syncthreads();
  for (int kt = 0; kt < nkt; ++kt) {
    const int ktn = min(kt + 1, nkt - 1);
    AT_LOAD(ktn)
#if ATPROBE == 5
    { uint4 d0 = *(const volatile uint4*)(ksrc0 + (size_t)ktn * kst0), d1 = *(const volatile uint4*)(ksrc1 + (size_t)ktn * kst1), d2 = *(const volatile uint4*)(ksrc2 + (size_t)ktn * kst2);
      uint4 d3 = *(const volatile uint4*)(vsrc0 + ktn * 64), d4 = *(const volatile uint4*)(vsrc1 + ktn * 64);
      asm volatile("" :: "v"(d0), "v"(d1), "v"(d2), "v"(d3), "v"(d4)); }
#endif
    const bf16_t* sK = sKV + (kt & 1) * KVBUF;
    const bf16_t* sV = sK + 64 * LDK;
    f32x4 sacc[4];
#pragma unroll
    for (int n = 0; n < 4; ++n) sacc[n] = (f32x4){0.f, 0.f, 0.f, 0.f};
#pragma unroll
    for (int ks = 0; ks < 3; ++ks)
#pragma unroll
      for (int n = 0; n < 4; ++n) {
        const bf16x8 a = *(const bf16x8*)(sK + (n * 16 + lr) * LDK + ks * 32 + lg * 8);
        sacc[n] = mfma16(a, qf[ks], sacc[n]);
      }
#if ATPROBE == 2
    {
      f32x4 dacc[4];
#pragma unroll
      for (int n = 0; n < 4; ++n) dacc[n] = (f32x4){0.f, 0.f, 0.f, 0.f};
#pragma unroll
      for (int ks = 0; ks < 3; ++ks)
#pragma unroll
        for (int n = 0; n < 4; ++n) {
          const bf16x8 a = *(const volatile bf16x8*)(sK + (n * 16 + lr) * LDK + ks * 32 + lg * 8);
          dacc[n] = mfma16(a, qf[ks], dacc[n]);
        }
#pragma unroll
      for (int n = 0; n < 4; ++n) asm volatile("" :: "v"(dacc[n]));
    }
#endif
    float mx = sacc[0][0];
#pragma unroll
    for (int n = 0; n < 4; ++n)
#pragma unroll
      for (int q = 0; q < 4; ++q) mx = fmaxf(mx, sacc[n][q]);
    mx = quad_max(mx);
    const float mnew = fmaxf(mrun, mx);
    const float alpha = __builtin_amdgcn_exp2f(mrun - mnew);
    mrun = mnew;
    float ps = 0.f;
#pragma unroll
    for (int n = 0; n < 4; ++n)
#pragma unroll
      for (int q = 0; q < 4; ++q) {
#if ATPROBE == 1
        { float e2 = __builtin_amdgcn_exp2f(sacc[n][q] - mrun); asm volatile("" :: "v"(e2)); }
#endif
        const float e = __builtin_amdgcn_exp2f(sacc[n][q] - mnew); sacc[n][q] = e; ps += e; }
    lrun = lrun * alpha + ps;
#pragma unroll
    for (int i = 0; i < 4; ++i)
#pragma unroll
      for (int q = 0; q < 4; ++q) oacc[i][q] *= alpha;
#pragma unroll
    for (int ks = 0; ks < 2; ++ks) {
      union { bf16x8 v; unsigned u[4]; } pf;
      pf.u[0] = pack2(sacc[2 * ks][0], sacc[2 * ks][1]);
      pf.u[1] = pack2(sacc[2 * ks][2], sacc[2 * ks][3]);
      pf.u[2] = pack2(sacc[2 * ks + 1][0], sacc[2 * ks + 1][1]);
      pf.u[3] = pack2(sacc[2 * ks + 1][2], sacc[2 * ks + 1][3]);
#pragma unroll
      for (int m = 0; m < 4; ++m) {
        union { bf16x8 v; uint2 h[2]; } av;
        const bf16_t* vp = sV + (m * 16 + lr) * LDV + ks * 32 + lg * 4;
        av.h[0] = *(const uint2*)(vp);
        av.h[1] = *(const uint2*)(vp + 16);
        oacc[m] = mfma16(av.v, pf.v, oacc[m]);
      }
    }
    __builtin_amdgcn_sched_barrier(0);
    AT_WRITE((kt + 1) & 1)
#if ATPROBE == 3
    AT_WRITE((kt + 1) & 1)
#endif
#if ATPROBE == 4
    __syncthreads();
#endif
    __syncthreads();
  }
  lrun = quad_sum(lrun);
  const float inv = 1.f / lrun;
#pragma unroll
  for (int m = 0; m < 4; ++m) {
    uint2 o;
    o.x = pack2(oacc[m][0] * inv, oacc[m][1] * inv);
    o.y = pack2(oacc[m][2] * inv, oacc[m][3] * inv);
    *(uint2*)(WSB(OFF_CAT) + (size_t)qrow * 1024 + hh * 64 + m * 16 + lg * 4) = o;
  }
}

NOINL void attn8_item(const P& p, int id) {
  int tid = threadIdx.x; asm volatile("" : "+v"(tid));
  const int lane = tid & 63, wave = tid >> 6, lr = lane & 15, lg = lane >> 4;
  int row0, kvbase, Lk, hh;
  if (id < 256) { hh = id & 7; const int b = (id >> 3) & 1; const int qb = id >> 4; row0 = 4096 + b * 2048 + qb * 128; kvbase = 4096 + b * 2304; Lk = 2304; }
  else { const int i2 = id - 256; hh = i2 & 7; const int rest = i2 >> 3; const int b = rest >> 1; const int qb = rest & 1; row0 = b * 256 + qb * 128; kvbase = b * 256; Lk = 256; }
  constexpr int LDK = 104, LDV = 136;
  constexpr int KVBUF = 128 * LDK + 64 * LDV;
  bf16_t* sKV = (bf16_t*)g_smem;
  const int qrow = row0 + wave * 16 + lr;
  bf16x8 qf[3];
#pragma unroll
  for (int ks = 0; ks < 3; ++ks) qf[ks] = *(const bf16x8*)(WSB(OFF_Q) + (size_t)qrow * 768 + hh * 96 + ks * 32 + lg * 8);
  f32x4 oacc[4];
#pragma unroll
  for (int i = 0; i < 4; ++i) oacc[i] = (f32x4){0.f, 0.f, 0.f, 0.f};
  float mrun = -1e30f, lrun = 0.f;
  const int nkt = Lk >> 7;
  const int kkey0 = tid / 12, kcc0 = tid - kkey0 * 12;
  const int c1 = tid + 512, kkey1 = c1 / 12, kcc1 = c1 - kkey1 * 12;
  const int c2 = tid + 1024, kkey2 = c2 / 12, kcc2 = c2 - kkey2 * 12;
  const bf16_t* kn = WSB(OFF_KN);
  const bf16_t* kp = WSB(OFF_KPE);
  const bf16_t* ksrc0 = (kcc0 < 8) ? kn + (size_t)(kvbase + kkey0) * 512 + hh * 64 + kcc0 * 8 : kp + (size_t)(kvbase + kkey0) * 32 + (kcc0 - 8) * 8;
  const bf16_t* ksrc1 = (kcc1 < 8) ? kn + (size_t)(kvbase + kkey1) * 512 + hh * 64 + kcc1 * 8 : kp + (size_t)(kvbase + kkey1) * 32 + (kcc1 - 8) * 8;
  const bf16_t* ksrc2 = (kcc2 < 8) ? kn + (size_t)(kvbase + kkey2) * 512 + hh * 64 + kcc2 * 8 : kp + (size_t)(kvbase + kkey2) * 32 + (kcc2 - 8) * 8;
  const int kst0 = (kcc0 < 8) ? 512 * 128 : 32 * 128, kst1 = (kcc1 < 8) ? 512 * 128 : 32 * 128, kst2 = (kcc2 < 8) ? 512 * 128 : 32 * 128;
  const int vd0 = tid >> 4, vcc = tid & 15;
  const bf16_t* vsrc0 = WSB(OFF_VT) + (size_t)(hh * 64 + vd0) * 8704 + kvbase + vcc * 8;
  const bf16_t* vsrc1 = vsrc0 + (size_t)32 * 8704;
  uint4 rk0, rk1, rk2, rv0, rv1;
#define A8_LOAD(kt) { const int _k = (kt); \
    rk0 = *(const uint4*)(ksrc0 + (size_t)_k * kst0); rk1 = *(const uint4*)(ksrc1 + (size_t)_k * kst1); \
    rk2 = *(const uint4*)(ksrc2 + (size_t)_k * kst2); \
    rv0 = *(const uint4*)(vsrc0 + _k * 128); rv1 = *(const uint4*)(vsrc1 + _k * 128); }
#define A8_WRITE(buf) { bf16_t* _b = sKV + (buf) * KVBUF; \
    *(uint4*)(_b + kkey0 * LDK + kcc0 * 8) = rk0; *(uint4*)(_b + kkey1 * LDK + kcc1 * 8) = rk1; \
    *(uint4*)(_b + kkey2 * LDK + kcc2 * 8) = rk2; \
    *(uint4*)(_b + 128 * LDK + vd0 * LDV + vcc * 8) = rv0; *(uint4*)(_b + 128 * LDK + (vd0 + 32) * LDV + vcc * 8) = rv1; }
  A8_LOAD(0)
  A8_WRITE(0)
  __syncthreads();
  for (int kt = 0; kt < nkt; ++kt) {
    const int ktn = min(kt + 1, nkt - 1);
    A8_LOAD(ktn)
    const bf16_t* sK = sKV + (kt & 1) * KVBUF;
    const bf16_t* sV = sK + 128 * LDK;
    f32x4 sacc[8];
#pragma unroll
    for (int n = 0; n < 8; ++n) sacc[n] = (f32x4){0.f, 0.f, 0.f, 0.f};
#pragma unroll
    for (int ks = 0; ks < 3; ++ks)
#pragma unroll
      for (int n = 0; n < 8; ++n) {
        const bf16x8 a = *(const bf16x8*)(sK + (n * 16 + lr) * LDK + ks * 32 + lg * 8);
        sacc[n] = mfma16(a, qf[ks], sacc[n]);
      }
    float mx = sacc[0][0];
#pragma unroll
    for (int n = 0; n < 8; ++n)
#pragma unroll
      for (int q = 0; q < 4; ++q) mx = fmaxf(mx, sacc[n][q]);
    mx = quad_max(mx);
    const float mnew = fmaxf(mrun, mx);
    const float alpha = __builtin_amdgcn_exp2f(mrun - mnew);
    mrun = mnew;
    float ps0 = 0.f, ps1 = 0.f;
#pragma unroll
    for (int n = 0; n < 8; n += 2)
#pragma unroll
      for (int q = 0; q < 4; ++q) {
        const float e0 = __builtin_amdgcn_exp2f(sacc[n][q] - mnew); sacc[n][q] = e0; ps0 += e0;
        const float e1 = __builtin_amdgcn_exp2f(sacc[n + 1][q] - mnew); sacc[n + 1][q] = e1; ps1 += e1;
      }
    lrun = lrun * alpha + (ps0 + ps1);
#pragma unroll
    for (int i = 0; i < 4; ++i)
#pragma unroll
      for (int q = 0; q < 4; ++q) oacc[i][q] *= alpha;
#pragma unroll
    for (int ks = 0; ks < 4; ++ks) {
      union { bf16x8 v; unsigned u[4]; } pf;
      pf.u[0] = pack2(sacc[2 * ks][0], sacc[2 * ks][1]);
      pf.u[1] = pack2(sacc[2 * ks][2], sacc[2 * ks][3]);
      pf.u[2] = pack2(sacc[2 * ks + 1][0], sacc[2 * ks + 1][1]);
      pf.u[3] = pack2(sacc[2 * ks + 1][2], sacc[2 * ks + 1][3]);
#pragma unroll
      for (int m = 0; m < 4; ++m) {
        union { bf16x8 v; uint2 h[2]; } av;
        const bf16_t* vp = sV + (m * 16 + lr) * LDV + ks * 32 + lg * 4;
        av.h[0] = *(const uint2*)(vp);
        av.h[1] = *(const uint2*)(vp + 16);
        oacc[m] = mfma16(av.v, pf.v, oacc[m]);
      }
    }
    __builtin_amdgcn_sched_barrier(0);
    A8_WRITE((kt + 1) & 1)
    __syncthreads();
  }
  lrun = quad_sum(lrun);
  const float inv = 1.f / lrun;
#pragma unroll
  for (int m = 0; m < 4; ++m) {
    uint2 o;
    o.x = pack2(oacc[m][0] * inv, oacc[m][1] * inv);
    o.y = pack2(oacc[m][2] * inv, oacc[m][3] * inv);
    *(uint2*)(WSB(OFF_CAT) + (size_t)qrow * 1024 + hh * 64 + m * 16 + lg * 4) = o;
  }
}

NOINL void ssd_y_item(const P& p, int item) {
  char* smem = g_smem + VB * 73728;
  const int tid = opaque_tid(), lane = tid & 63, wave = tid >> 6, lr = lane & 15, lg = lane >> 4;
  const int cidx = item >> 3, qt = (item >> 1) & 3, half = qt >> 1, g = item & 1;
  const int r0 = cidx * 128;
  const int hh = g * 4 + wave;
  constexpr int LDC = 136, LDM = 72;
  bf16_t* sC = (bf16_t*)smem;
  bf16_t* sB = sC + 64 * LDC;
  bf16_t* sM = sB + 64 * LDC + wave * 64 * LDM;
  float* rowss = (float*)((bf16_t*)smem + 2 * 64 * LDC + 4 * 64 * LDM);
  const float* cum = WSF(OFF_CUM);
  const float* dtv = WSF(OFF_DTV);
  const int srow = tid >> 4, scol = (tid & 15) * 8;
  uint4 pb0, pb1, pb2, pb3;
  {
    const bf16_t* cs = WSB(OFF_CM) + (size_t)(r0 + qt * 32 + srow) * 256 + g * 128 + scol;
    const bf16_t* bs = WSB(OFF_BM) + (size_t)(r0 + srow) * 256 + g * 128 + scol;
    const uint4 c0 = *(const uint4*)(cs), c1 = *(const uint4*)(cs + 16 * 256);
    const uint4 b0 = *(const uint4*)(bs), b1 = *(const uint4*)(bs + 16 * 256), b2 = *(const uint4*)(bs + 32 * 256), b3 = *(const uint4*)(bs + 48 * 256);
    pb0 = *(const uint4*)(bs + 64 * 256); pb1 = *(const uint4*)(bs + 80 * 256); pb2 = *(const uint4*)(bs + 96 * 256); pb3 = *(const uint4*)(bs + 112 * 256);
    bf16_t* wc = sC + srow * LDC + scol;
    bf16_t* wb = sB + srow * LDC + scol;
    *(uint4*)(wc) = c0; *(uint4*)(wc + 16 * LDC) = c1;
    *(uint4*)(wb) = b0; *(uint4*)(wb + 16 * LDC) = b1; *(uint4*)(wb + 32 * LDC) = b2; *(uint4*)(wb + 48 * LDC) = b3;
  }
  __syncthreads();
  f32x4 Y[2][4];
#pragma unroll
  for (int i = 0; i < 2; ++i)
#pragma unroll
    for (int j = 0; j < 4; ++j) Y[i][j] = (f32x4){0.f, 0.f, 0.f, 0.f};
#pragma unroll 1
  for (int jh = 0; jh < 2; ++jh) {
    if (jh == 1) {
      __syncthreads();
      bf16_t* wb = sB + srow * LDC + scol;
      *(uint4*)(wb) = pb0; *(uint4*)(wb + 16 * LDC) = pb1; *(uint4*)(wb + 32 * LDC) = pb2; *(uint4*)(wb + 48 * LDC) = pb3;
      __syncthreads();
    }
#pragma unroll 1
    for (int dir = 0; dir < 2; ++dir) {
      const bool use = dir == 0 ? (jh <= half) : (jh >= half);
      if (!use) continue;
      bf16x8 xf[2][4];
#pragma unroll
      for (int ks = 0; ks < 2; ++ks)
#pragma unroll
        for (int pt = 0; pt < 4; ++pt)
          xf[ks][pt] = *(const bf16x8*)(WSB(OFF_XST) + (size_t)(hh * 64 + pt * 16 + lr) * 8192 + r0 + jh * 64 + ks * 32 + lg * 8);
      float ci[2], cj[4][4], dj[4][4];
#pragma unroll
      for (int it = 0; it < 2; ++it) ci[it] = cum[((size_t)dir * 8192 + r0 + qt * 32 + it * 16 + lr) * 8 + hh];
#pragma unroll
      for (int jt = 0; jt < 4; ++jt)
#pragma unroll
        for (int q = 0; q < 4; ++q) {
          const size_t tj = (size_t)dir * 8192 + r0 + jh * 64 + jt * 16 + lg * 4 + q;
          cj[jt][q] = cum[tj * 8 + hh];
          dj[jt][q] = dtv[tj * 8 + hh];
        }
#pragma unroll
      for (int it = 0; it < 2; ++it) {
        f32x4 cb[4];
#pragma unroll
        for (int jt = 0; jt < 4; ++jt) cb[jt] = (f32x4){0.f, 0.f, 0.f, 0.f};
#pragma unroll
        for (int ks = 0; ks < 4; ++ks) {
          const bf16x8 b = *(const bf16x8*)(sC + (it * 16 + lr) * LDC + ks * 32 + lg * 8);
#pragma unroll
          for (int jt = 0; jt < 4; ++jt) {
            const bf16x8 a = *(const bf16x8*)(sB + (jt * 16 + lr) * LDC + ks * 32 + lg * 8);
            cb[jt] = mfma16(a, b, cb[jt]);
          }
        }
        const int ti = qt * 32 + it * 16 + lr;
#pragma unroll
        for (int jt = 0; jt < 4; ++jt) {
          float v[4];
#pragma unroll
          for (int q = 0; q < 4; ++q) {
            const int tj = jh * 64 + jt * 16 + lg * 4 + q;
            const bool ok = dir == 0 ? (tj <= ti) : (tj >= ti);
            v[q] = ok ? cb[jt][q] * __expf(ci[it] - cj[jt][q]) * dj[jt][q] : 0.f;
          }
          uint2 o;
          o.x = pack2(v[0], v[1]);
          o.y = pack2(v[2], v[3]);
          *(uint2*)(sM + (it * 16 + lr) * LDM + jt * 16 + lg * 4) = o;
        }
        __builtin_amdgcn_sched_barrier(0);
      }
      asm volatile("s_waitcnt lgkmcnt(0)" ::: "memory");
#pragma unroll
      for (int ks = 0; ks < 2; ++ks) {
        bf16x8 af[2];
#pragma unroll
        for (int it = 0; it < 2; ++it) af[it] = *(const bf16x8*)(sM + (it * 16 + lr) * LDM + ks * 32 + lg * 8);
#pragma unroll
        for (int it = 0; it < 2; ++it)
#pragma unroll
          for (int pt = 0; pt < 4; ++pt) Y[it][pt] = mfma16(af[it], xf[ks][pt], Y[it][pt]);
      }
      asm volatile("s_waitcnt lgkmcnt(0)" ::: "memory");
      __builtin_amdgcn_sched_barrier(0);
    }
  }
#pragma unroll 1
  for (int dir = 0; dir < 2; ++dir) {
    const bf16_t* hp = WSB(OFF_H) + ((size_t)(dir * 64 + cidx) * 8 + hh) * 8192;
    float ei[2][4];
#pragma unroll
    for (int it = 0; it < 2; ++it)
#pragma unroll
      for (int q = 0; q < 4; ++q)
        ei[it][q] = __expf(cum[((size_t)dir * 8192 + r0 + qt * 32 + it * 16 + lg * 4 + q) * 8 + hh]);
#pragma unroll
    for (int pt = 0; pt < 4; ++pt) {
      bf16x8 bfr[4];
#pragma unroll
      for (int ks = 0; ks < 4; ++ks) bfr[ks] = *(const bf16x8*)(hp + (size_t)(pt * 16 + lr) * 128 + ks * 32 + lg * 8);
      f32x4 T[2];
#pragma unroll
      for (int it = 0; it < 2; ++it) T[it] = (f32x4){0.f, 0.f, 0.f, 0.f};
#pragma unroll
      for (int ks = 0; ks < 4; ++ks)
#pragma unroll
        for (int it = 0; it < 2; ++it) {
          const bf16x8 a = *(const bf16x8*)(sC + (it * 16 + lr) * LDC + ks * 32 + lg * 8);
          T[it] = mfma16(a, bfr[ks], T[it]);
        }
#pragma unroll
      for (int it = 0; it < 2; ++it)
#pragma unroll
        for (int q = 0; q < 4; ++q) Y[it][pt][q] += ei[it][q] * T[it][q];
    }
    __builtin_amdgcn_sched_barrier(0);
  }
  const float dsk = p.ssd_d[hh];
  const bf16_t* proj = WSB(OFF_R1);
#pragma unroll
  for (int i = 0; i < 2; ++i) {
#pragma unroll
    for (int q = 0; q < 4; ++q) {
      const int il = i * 16 + lg * 4 + q;
      const size_t r = (size_t)r0 + qt * 32 + il;
      float ss = 0.f;
#pragma unroll
      for (int j = 0; j < 4; ++j) {
        const int ch = hh * 64 + j * 16 + lr;
        const float xs = bf2f(WSB(OFF_XS)[r * 512 + ch]);
        const float z = bf2f(proj[r * 2080 + 544 + ch]);
        const float y = (Y[i][j][q] + dsk * xs) * silu(z);
        Y[i][j][q] = y;
        ss += y * y;
      }
      ss += __shfl_xor(ss, 1, 64);
      ss += __shfl_xor(ss, 2, 64);
      ss += __shfl_xor(ss, 4, 64);
      ss += __shfl_xor(ss, 8, 64);
      if (lr == 0) rowss[wave * 64 + il] = ss;
    }
    __builtin_amdgcn_sched_barrier(0);
  }
  __syncthreads();
#pragma unroll
  for (int i = 0; i < 2; ++i) {
#pragma unroll
    for (int q = 0; q < 4; ++q) {
      const int il = i * 16 + lg * 4 + q;
      const size_t r = (size_t)r0 + qt * 32 + il;
      const float tot = rowss[il] + rowss[64 + il] + rowss[128 + il] + rowss[192 + il];
      const float rs = rsqrtf(tot * (1.f / 256.f) + 1e-6f);
#pragma unroll
      for (int j = 0; j < 4; ++j) {
        const int ch = hh * 64 + j * 16 + lr;
        WSB(OFF_CAT)[r * 1024 + 512 + ch] = f2bf(Y[i][j][q] * rs * p.ssd_norm[ch]);
      }
    }
    __builtin_amdgcn_sched_barrier(0);
  }
  __syncthreads();
}

template <int W2>
DEVI void pool_item(const bf16_t* __restrict__ h, bf16_t* __restrict__ dst, int r, int cc) {
  int s0, L;
  if (r < 4096) { s0 = r & ~255; L = 256; } else { s0 = 4096 + ((r - 4096) & ~2047); L = 2048; }
  const int t = r - s0;
  const int lo = max(t - W2, 0), hi = min(t + W2, L);
  uint4 v[2 * W2];
#pragma unroll
  for (int k = 0; k < 2 * W2; ++k) {
    const int u = min(max(t - W2 + k, 0), L - 1);
    v[k] = *(const uint4*)(h + (size_t)(s0 + u) * 1024 + cc);
  }
  float acc[8] = {0, 0, 0, 0, 0, 0, 0, 0};
#pragma unroll
  for (int k = 0; k < 2 * W2; ++k) {
    const int u = t - W2 + k;
    const float m = (u >= 0 && u < L) ? 1.f : 0.f;
    acc[0] += m * __uint_as_float(v[k].x << 16); acc[1] += m * __uint_as_float(v[k].x & 0xffff0000u);
    acc[2] += m * __uint_as_float(v[k].y << 16); acc[3] += m * __uint_as_float(v[k].y & 0xffff0000u);
    acc[4] += m * __uint_as_float(v[k].z << 16); acc[5] += m * __uint_as_float(v[k].z & 0xffff0000u);
    acc[6] += m * __uint_as_float(v[k].w << 16); acc[7] += m * __uint_as_float(v[k].w & 0xffff0000u);
  }
  const float inv = 1.f / (float)(hi - lo);
  const uint4 c = v[W2];
  uint4 o;
  o.x = pack2(acc[0] * inv - __uint_as_float(c.x << 16), acc[1] * inv - __uint_as_float(c.x & 0xffff0000u));
  o.y = pack2(acc[2] * inv - __uint_as_float(c.y << 16), acc[3] * inv - __uint_as_float(c.y & 0xffff0000u));
  o.z = pack2(acc[4] * inv - __uint_as_float(c.z << 16), acc[5] * inv - __uint_as_float(c.z & 0xffff0000u));
  o.w = pack2(acc[6] * inv - __uint_as_float(c.w << 16), acc[7] * inv - __uint_as_float(c.w & 0xffff0000u));
  *(uint4*)(dst + (size_t)r * 1024 + cc) = o;
}

NOINL void pool_phase(const P& p) {
  const bf16_t* h = WSB(OFF_H);
  bf16_t* dst = WSB(OFF_CAT);
  const int total = 8192 * 128;
  for (int idx = blockIdx.x * 512 + threadIdx.x; idx < total; idx += gridDim.x * 512) {
    const int c32 = idx & 31, rlo = (idx >> 5) & 1, gi = (idx >> 6) & 3, rhi = idx >> 8;
    const int r = rhi * 2 + rlo, cc = gi * 256 + c32 * 8;
    if (gi == 0) pool_item<1>(h, dst, r, cc);
    else if (gi == 1) pool_item<2>(h, dst, r, cc);
    else if (gi == 2) pool_item<4>(h, dst, r, cc);
    else pool_item<8>(h, dst, r, cc);
  }
}

NOINL void ph_gemm_proj(const P& p) {
  bf16_t* proj = WSB(OFF_R1);
  float* dtraw = WSF(OFF_DTRAW);
  const bf16_t* A = WSB(OFF_H);
  const bf16_t* B = WSB(OFF_WIN);
  auto epi_main = [&](int ctx, int row, int col, f32x4 v0, f32x4 v1) {
#pragma unroll
    for (int q = 0; q < 4; ++q) {
      proj[(size_t)(row + q) * 2080 + col] = f2bf(v0[q]);
      proj[(size_t)(row + q) * 2080 + col + 16] = f2bf(v1[q]);
    }
  };
  auto epi = [&](int ctx, int row, int col, f32x4 v0, f32x4 v1) {
#pragma unroll
    for (int q = 0; q < 4; ++q) {
      if (col < 2080) proj[(size_t)(row + q) * 2080 + col] = f2bf(v0[q]);
      else if (col < 2096) dtraw[(size_t)(row + q) * 16 + (col - 2080)] = v0[q];
      if (col + 16 < 2080) proj[(size_t)(row + q) * 2080 + col + 16] = f2bf(v1[q]);
      else if (col + 16 < 2096) dtraw[(size_t)(row + q) * 16 + (col + 16 - 2080)] = v1[q];
    }
  };
  gemm8_stream(256, 1024, 1024, 1024,
    [=](int t) {
      TileInfo r;
      int m, n; tile_mn(t, 32, 8, m, n);
      r.m0 = m * 256; r.n0 = n * 256; r.ctx = 0;
      r.a = A + (size_t)r.m0 * 1024; r.b = B + (size_t)r.n0 * 1024;
      return r;
    }, epi_main);
  gemm_stream(64, 1024, 1024, 1024, g_smem + VB * 73728,
    [=](int t) {
      TileInfo r;
      r.m0 = t * 128; r.n0 = 2048; r.ctx = 0;
      r.a = A + (size_t)r.m0 * 1024; r.b = B + (size_t)2048 * 1024;
      return r;
    }, epi);
}

NOINL void ph_gemm_f32out(const P& p, const bf16_t* A, int lda, const bf16_t* B, int ldb, int K, bf16_t* C, int N) {
  const int nN = N / 128;
  gemm_stream(64 * nN, lda, ldb, K, g_smem + VB * 73728,
    [=](int t) {
      TileInfo r;
      int m, n; tile_mn(t, 64, nN, m, n);
      r.m0 = m * 128; r.n0 = n * 128; r.ctx = 0;
      r.a = A + (size_t)r.m0 * lda; r.b = B + (size_t)r.n0 * ldb;
      return r;
    },
    [&](int ctx, int row, int col, f32x4 v0, f32x4 v1) {
#pragma unroll
      for (int q = 0; q < 4; ++q) {
        C[(size_t)(row + q) * N + col] = f2bf(v0[q]);
        C[(size_t)(row + q) * N + col + 16] = f2bf(v1[q]);
      }
    });
}

NOINL void ph_gemm8_splitk(const P& p, const bf16_t* A, int lda, const bf16_t* B, int ldb, int Khalf, bf16_t* C0, bf16_t* C1) {
  gemm8_stream(256, lda, ldb, Khalf,
    [=](int t) {
      TileInfo r;
      const int id = swz_tile(t, 256);
      const int ks = id >> 7, rem = id & 127;
      r.m0 = (rem >> 2) * 256; r.n0 = (rem & 3) * 256; r.ctx = ks;
      r.a = A + (size_t)r.m0 * lda + (size_t)ks * Khalf; r.b = B + (size_t)r.n0 * ldb + (size_t)ks * Khalf;
      return r;
    },
    [&](int ks, int row, int col, f32x4 v0, f32x4 v1) {
      bf16_t* C = ks ? C1 : C0;
#pragma unroll
      for (int q = 0; q < 4; ++q) {
        C[(size_t)(row + q) * 1024 + col] = f2bf(v0[q]);
        C[(size_t)(row + q) * 1024 + col + 16] = f2bf(v1[q]);
      }
    });
}

NOINL void ph_gemm_qkv(const P& p) {
  bf16_t* qo = WSB(OFF_Q);
  bf16_t* kn = WSB(OFF_KN);
  bf16_t* vt = WSB(OFF_VT);
  const bf16_t* Aq = WSB(OFF_CQN);
  const bf16_t* Bq = WSB(OFF_WUQ);
  const bf16_t* Ak = WSB(OFF_CKV);
  const bf16_t* Bk = WSB(OFF_WUKV);
  gemm_stream(384 + 544, 256, 256, 256, g_smem + VB * 73728,
    [=](int t) {
      TileInfo r;
      int m, n;
      if (t < 384) {
        tile_mn(t, 64, 6, m, n);
        r.m0 = m * 128; r.n0 = n * 128; r.ctx = 0;
        r.a = Aq + (size_t)r.m0 * 256; r.b = Bq + (size_t)r.n0 * 256;
      } else {
        tile_mn(t - 384, 68, 8, m, n);
        r.m0 = m * 128; r.n0 = n * 128; r.ctx = 1;
        r.a = Ak + (size_t)r.m0 * 256; r.b = Bk + (size_t)r.n0 * 256;
      }
      return r;
    },
    [&](int ctx, int row, int col, f32x4 v0, f32x4 v1) {
      if (ctx == 0) {
        const float scl = 0.10206207261596575f * 1.4426950408889634f;
        const int tn = col >> 4;
        const bool rope = ((tn % 6) == 4) && (row >= 4096);
        const int ii = col & 15;
        const float fr = rope_freq(ii & 7);
#pragma unroll
        for (int q = 0; q < 4; ++q) {
          float a = v0[q], b = v1[q];
          if (rope) {
            const int tt = (row + q - 4096) & 2047;
            const float pos = (ii < 8) ? (float)(tt >> 6) : (float)(tt & 63);
            const float ang = pos * fr;
            float cs, sn;
            fast_sincos(ang, sn, cs);
            const float x1 = a, x2 = b;
            a = x1 * cs - x2 * sn;
            b = x1 * sn + x2 * cs;
          }
          qo[(size_t)(row + q) * 768 + col] = f2bf(a * scl);
          qo[(size_t)(row + q) * 768 + col + 16] = f2bf(b * scl);
        }
      } else {
        const int hh = col >> 7, j = col & 127;
        if (j < 64) {
#pragma unroll
          for (int q = 0; q < 4; ++q) {
            kn[(size_t)(row + q) * 512 + hh * 64 + j] = f2bf(v0[q]);
            kn[(size_t)(row + q) * 512 + hh * 64 + j + 16] = f2bf(v1[q]);
          }
        } else {
          uint2 o0, o1;
          o0.x = pack2(v0[0], v0[1]); o0.y = pack2(v0[2], v0[3]);
          o1.x = pack2(v1[0], v1[1]); o1.y = pack2(v1[2], v1[3]);
          *(uint2*)(vt + (size_t)(hh * 64 + j - 64) * 8704 + row) = o0;
          *(uint2*)(vt + (size_t)(hh * 64 + j - 64 + 16) * 8704 + row) = o1;
        }
      }
    });
}

NOINL void ph_gemm_ffn_up(const P& p, int layer) {
  bf16_t* gu = WSB(OFF_R1);
  const bf16_t* A = WSB(OFF_H);
  const bf16_t* B = WSB(OFF_WGU) + (size_t)layer * 5632 * 1024;
  gemm8_stream(32 * 22, 1024, 1024, 1024,
    [=](int t) {
      TileInfo r;
      int m, n; tile_mn(t, 32, 22, m, n);
      r.m0 = m * 256; r.n0 = n * 256; r.ctx = 0;
      r.a = A + (size_t)r.m0 * 1024; r.b = B + (size_t)r.n0 * 1024;
      return r;
    },
    [&](int ctx, int row, int col, f32x4 v0, f32x4 v1) {
      const int oc = (col >> 5) * 16 + (col & 15);
#pragma unroll
      for (int q = 0; q < 4; ++q) gu[(size_t)(row + q) * 2816 + oc] = f2bf(silu(v0[q]) * v1[q]);
    });
}

NOINL void ph_gemm_pool(const P& p) {
  bf16_t* mix = WSB(OFF_R1);
  const bf16_t* A = WSB(OFF_H);
  const bf16_t* B = WSB(OFF_WPOOL);
  gemm_stream(512, 1024, 256, 256, g_smem + VB * 73728,
    [=](int t) {
      TileInfo r;
      const int id = swz_tile(t, 512);
      const int g = id >> 7, rem = id & 127;
      r.m0 = (rem >> 1) * 128; r.n0 = (rem & 1) * 128; r.ctx = g;
      r.a = A + (size_t)r.m0 * 1024 + g * 256; r.b = B + (size_t)g * 65536 + (size_t)r.n0 * 256;
      return r;
    },
    [&](int g, int row, int col, f32x4 v0, f32x4 v1) {
      const int c0 = g * 256 + col;
      const float s0 = p.pool_scale[c0], s1 = p.pool_scale[c0 + 16];
#pragma unroll
      for (int q = 0; q < 4; ++q) {
        mix[(size_t)(row + q) * 1024 + c0] = f2bf(v0[q] * s0);
        mix[(size_t)(row + q) * 1024 + c0 + 16] = f2bf(v1[q] * s1);
      }
    });
}


#define XB_TMO      128
#define XB_XCNT(j)  (256  + 64 * (j))
#define XB_XSUB(j)  (1280 + 64 * (j))
#define XB_XGEN(j)  (2304 + 64 * (j))
#define XB_TOP      3328
#define XB_TOPGEN   3392
#define XCD_BAR_WORDS 3456
#define XB_SPIN_CAP (1u << 22)
#define LAS __attribute__((address_space(3)))
DEVI unsigned xb_ld(unsigned* p) { return __hip_atomic_load(p, __ATOMIC_RELAXED, __HIP_MEMORY_SCOPE_AGENT); }
DEVI unsigned xb_add(unsigned* p, unsigned v) { return __hip_atomic_fetch_add(p, v, __ATOMIC_RELAXED, __HIP_MEMORY_SCOPE_AGENT); }
DEVI unsigned xb_xcc_id() { return (unsigned)__builtin_amdgcn_s_getreg((3 << 11) | 20) & 0xFu; }
#define XB_SPIN(cond, bar) do { unsigned _sp = 0; while (cond) { __builtin_amdgcn_s_sleep(1); \
    if ((++_sp & 255u) == 0u) { if (xb_ld(&(bar)[XB_TMO])) break; if (_sp > XB_SPIN_CAP) { atomicAdd(&(bar)[XB_TMO], 1u); break; } } } } while (0)
struct XcdBarrier { unsigned* bar; unsigned x; volatile LAS unsigned* st; };
DEVI XcdBarrier xcd_barrier_post(unsigned* bar, volatile LAS unsigned* st) {
  XcdBarrier b; b.bar = bar; b.x = xb_xcc_id(); b.st = st;
  if (threadIdx.x == 0) (void)xb_add(&bar[XB_XCNT(b.x)], 1u);
  return b;
}
DEVI void xcd_barrier_complete(unsigned* bar, unsigned x, unsigned& nloc, unsigned& nx) {
  const unsigned G = gridDim.x * gridDim.y * gridDim.z;
  unsigned sum, cnt, mine, sp = 0u;
  for (;;) {
    sum = 0u; cnt = 0u; mine = 0u;
#pragma unroll
    for (unsigned j = 0; j < 16; ++j) { const unsigned c = xb_ld(&bar[XB_XCNT(j)]); sum += c; cnt += (c > 0u) ? 1u : 0u; mine = (j == x) ? c : mine; }
    if (sum == G) break;
    __builtin_amdgcn_s_sleep(1);
    if ((++sp & 255u) == 0u) { if (xb_ld(&bar[XB_TMO])) break; if (sp > XB_SPIN_CAP) { atomicAdd(&bar[XB_TMO], 1u); break; } }
  }
  nloc = mine > 0u ? mine : 1u; nx = cnt > 0u ? cnt : 1u;
}
DEVI void xcd_barrier(const XcdBarrier& b) {
  asm volatile("s_waitcnt vmcnt(0)" ::: "memory");
  __syncthreads();
  if (threadIdx.x == 0) {
    unsigned* bar = b.bar;
    __builtin_amdgcn_s_waitcnt(0);
    unsigned nloc = b.st[0], nx = b.st[1];
    if (nloc == 0u) { xcd_barrier_complete(bar, b.x, nloc, nx); b.st[0] = nloc; b.st[1] = nx; }
    const unsigned old = xb_add(&bar[XB_XSUB(b.x)], 1u);
    const unsigned gen = old / nloc;
    if (old + 1u == (gen + 1u) * nloc) {
      __builtin_amdgcn_fence(__ATOMIC_RELEASE, "agent");
      asm volatile("s_waitcnt vmcnt(0)" ::: "memory");
      const unsigned og = xb_add(&bar[XB_TOP], 1u);
      const unsigned tg = og / nx;
      if (og + 1u == (tg + 1u) * nx) xb_add(&bar[XB_TOPGEN], 1u);
      else XB_SPIN(xb_ld(&bar[XB_TOPGEN]) == tg, bar);
      __builtin_amdgcn_fence(__ATOMIC_ACQUIRE, "agent");
      xb_add(&bar[XB_XGEN(b.x)], 1u);
      asm volatile("s_waitcnt vmcnt(0)" ::: "memory");
    } else {
      XB_SPIN(xb_ld(&bar[XB_XGEN(b.x)]) == gen, bar);
      __builtin_amdgcn_fence(__ATOMIC_ACQUIRE, "agent");
      asm volatile("s_waitcnt vmcnt(0)" ::: "memory");
    }
  }
  __syncthreads();
}

constexpr int NPHASE = 18;
#ifndef REPMASK
#define REPMASK 0
#endif
#ifndef ATPROBE
#define ATPROBE 0
#endif
#ifndef P6PROBE
#define P6PROBE 1
#endif
#ifndef PHMASK
#define PHMASK 0x3ffff
#endif
#define PH(n) if constexpr ((PHMASK >> (n)) & 1)

__global__ void __launch_bounds__(512, 2) mega(P p, int lo, int hi) {
  __shared__ uint4 xb_words;
  if (threadIdx.x == 0) xb_words = make_uint4(0u, 0u, 0u, 0u);
  __syncthreads();
  XcdBarrier xb = xcd_barrier_post((unsigned*)(p.ws + OFF_BAR), (volatile LAS unsigned*)&xb_words);
  if (lo < 0) cg::this_grid().sync();
  PH(0) if (lo <= 0 && 0 < hi) {
#if (REPMASK >> 0) & 1
    int nrep = 2; asm volatile("" : "+s"(nrep));
    for (int rep = 0; rep < nrep; ++rep) {
      if (rep) xcd_barrier(xb);
#else
    {
#endif
        for (int t0_ = blockIdx.x * 2; t0_ < 384 + 5200; t0_ += gridDim.x * 2) {
          const int t = min(t0_ + VB, 384 + 5200 - 1);
          if (t < 384) gemv_tile(p, t); else transpose_tile(p, t - 384);
        }
    }
  }
  if (lo <= 0 && 0 + 1 < hi) xcd_barrier(xb);
  PH(1) if (lo <= 1 && 1 < hi) {
#if (REPMASK >> 1) & 1
    int nrep = 2; asm volatile("" : "+s"(nrep));
    for (int rep = 0; rep < nrep; ++rep) {
      if (rep) xcd_barrier(xb);
#else
    {
#endif
        rowop<false, true, true, false, false>(p, nullptr, nullptr, nullptr, 0, p.n_pre_mix, 0, 1, 0, 0);
    }
  }
  if (lo <= 1 && 1 + 1 < hi) xcd_barrier(xb);
  PH(2) if (lo <= 2 && 2 < hi) {
#if (REPMASK >> 2) & 1
    int nrep = 2; asm volatile("" : "+s"(nrep));
    for (int rep = 0; rep < nrep; ++rep) {
      if (rep) xcd_barrier(xb);
#else
    {
#endif
        ph_gemm_proj(p);
    }
  }
  if (lo <= 2 && 2 + 1 < hi) xcd_barrier(xb);
  PH(3) if (lo <= 3 && 3 < hi) {
#if (REPMASK >> 3) & 1
    int nrep = 2; asm volatile("" : "+s"(nrep));
    for (int rep = 0; rep < nrep; ++rep) {
      if (rep) xcd_barrier(xb);
#else
    {
#endif
        prep_rows(p);
        prep_cache(p);
        for (int t0_ = VT_FIRST; t0_ < 2048; t0_ += gridDim.x * 2) conv_tile(p, min(t0_ + VT_OFF, 2047));
    }
  }
  if (lo <= 3 && 3 + 1 < hi) xcd_barrier(xb);
  PH(4) if (lo <= 4 && 4 < hi) {
#if (REPMASK >> 4) & 1
    int nrep = 2; asm volatile("" : "+s"(nrep));
    for (int rep = 0; rep < nrep; ++rep) {
      if (rep) xcd_barrier(xb);
#else
    {
#endif
        ph_gemm_qkv(p);
        for (int t0_ = VT_FIRST; t0_ < 512; t0_ += gridDim.x * 2) chunk_state_item(p, min(t0_ + VT_OFF, 511));
    }
  }
  if (lo <= 4 && 4 + 1 < hi) xcd_barrier(xb);
  PH(5) if (lo <= 5 && 5 < hi) {
#if (REPMASK >> 5) & 1
    int nrep = 2; asm volatile("" : "+s"(nrep));
    for (int rep = 0; rep < nrep; ++rep) {
      if (rep) xcd_barrier(xb);
#else
    {
#endif
        scan_states(p);
    }
  }
  if (lo <= 5 && 5 + 1 < hi) xcd_barrier(xb);
  PH(6) if (lo <= 6 && 6 < hi) {
#if (REPMASK >> 6) & 1
    int nrep = 2; asm volatile("" : "+s"(nrep));
    for (int rep = 0; rep < nrep; ++rep) {
      if (rep) xcd_barrier(xb);
#else
    {
#endif
        for (int t = blockIdx.x; t < 512; t += gridDim.x) attn8_item(p, t);
        for (int t0_ = VT_FIRST; t0_ < 512; t0_ += gridDim.x * 2) ssd_y_item(p, min(t0_ + VT_OFF, 511));
    }
  }
  if (lo <= 6 && 6 + 1 < hi) xcd_barrier(xb);
  PH(7) if (lo <= 7 && 7 < hi) {
#if (REPMASK >> 7) & 1
    int nrep = 2; asm volatile("" : "+s"(nrep));
    for (int rep = 0; rep < nrep; ++rep) {
      if (rep) xcd_barrier(xb);
#else
    {
#endif
        ph_gemm8_splitk(p, WSB(OFF_CAT), 1024, WSB(OFF_WOUT), 1024, 512, WSB(OFF_R1), WSB(OFF_R1) + (size_t)8192 * 1024);
    }
  }
  if (lo <= 7 && 7 + 1 < hi) xcd_barrier(xb);
  PH(8) if (lo <= 8 && 8 < hi) {
#if (REPMASK >> 8) & 1
    int nrep = 2; asm volatile("" : "+s"(nrep));
    for (int rep = 0; rep < nrep; ++rep) {
      if (rep) xcd_barrier(xb);
#else
    {
#endif
        rowop<true, true, true, false, true>(p, WSB(OFF_R1), WSB(OFF_R1) + (size_t)8192 * 1024, p.n_post_mix, 2, p.n_pre_ffn, 3, 4, 0, 0);
    }
  }
  if (lo <= 8 && 8 + 1 < hi) xcd_barrier(xb);
  PH(9) if (lo <= 9 && 9 < hi) {
#if (REPMASK >> 9) & 1
    int nrep = 2; asm volatile("" : "+s"(nrep));
    for (int rep = 0; rep < nrep; ++rep) {
      if (rep) xcd_barrier(xb);
#else
    {
#endif
        ph_gemm_ffn_up(p, 0);
    }
  }
  if (lo <= 9 && 9 + 1 < hi) xcd_barrier(xb);
  PH(10) if (lo <= 10 && 10 < hi) {
#if (REPMASK >> 10) & 1
    int nrep = 2; asm volatile("" : "+s"(nrep));
    for (int rep = 0; rep < nrep; ++rep) {
      if (rep) xcd_barrier(xb);
#else
    {
#endif
        ph_gemm8_splitk(p, WSB(OFF_R1), 2816, WSB(OFF_WDN), 2816, 1408, WSB(OFF_R2), WSB(OFF_R2) + (size_t)8192 * 1024);
    }
  }
  if (lo <= 10 && 10 + 1 < hi) xcd_barrier(xb);
  PH(11) if (lo <= 11 && 11 < hi) {
#if (REPMASK >> 11) & 1
    int nrep = 2; asm volatile("" : "+s"(nrep));
    for (int rep = 0; rep < nrep; ++rep) {
      if (rep) xcd_barrier(xb);
#else
    {
#endif
        rowop<true, true, false, false, true>(p, WSB(OFF_R2), WSB(OFF_R2) + (size_t)8192 * 1024, p.n_post_ffn, 5, p.n_pre_mix + 1024, 0, 1, 0, 1);
    }
  }
  if (lo <= 11 && 11 + 1 < hi) xcd_barrier(xb);
  PH(12) if (lo <= 12 && 12 < hi) {
#if (REPMASK >> 12) & 1
    int nrep = 2; asm volatile("" : "+s"(nrep));
    for (int rep = 0; rep < nrep; ++rep) {
      if (rep) xcd_barrier(xb);
#else
    {
#endif
    }
  }
  PH(13) if (lo <= 13 && 13 < hi) {
#if (REPMASK >> 13) & 1
    int nrep = 2; asm volatile("" : "+s"(nrep));
    for (int rep = 0; rep < nrep; ++rep) {
      if (rep) xcd_barrier(xb);
#else
    {
#endif
        ph_gemm_pool(p);
    }
  }
  if (lo <= 13 && 13 + 1 < hi) xcd_barrier(xb);
  PH(14) if (lo <= 14 && 14 < hi) {
#if (REPMASK >> 14) & 1
    int nrep = 2; asm volatile("" : "+s"(nrep));
    for (int rep = 0; rep < nrep; ++rep) {
      if (rep) xcd_barrier(xb);
#else
    {
#endif
        rowop<true, true, false, false, false, true>(p, WSB(OFF_R1), nullptr, p.n_post_mix + 1024, 2, p.n_pre_ffn + 1024, 3, 4, 1, 1);
    }
  }
  if (lo <= 14 && 14 + 1 < hi) xcd_barrier(xb);
  PH(15) if (lo <= 15 && 15 < hi) {
#if (REPMASK >> 15) & 1
    int nrep = 2; asm volatile("" : "+s"(nrep));
    for (int rep = 0; rep < nrep; ++rep) {
      if (rep) xcd_barrier(xb);
#else
    {
#endif
        ph_gemm_ffn_up(p, 1);
    }
  }
  if (lo <= 15 && 15 + 1 < hi) xcd_barrier(xb);
  PH(16) if (lo <= 16 && 16 < hi) {
#if (REPMASK >> 16) & 1
    int nrep = 2; asm volatile("" : "+s"(nrep));
    for (int rep = 0; rep < nrep; ++rep) {
      if (rep) xcd_barrier(xb);
#else
    {
#endif
        ph_gemm8_splitk(p, WSB(OFF_R1), 2816, WSB(OFF_WDN) + (size_t)1024 * 2816, 2816, 1408, WSB(OFF_R2), WSB(OFF_R2) + (size_t)8192 * 1024);
    }
  }
  if (lo <= 16 && 16 + 1 < hi) xcd_barrier(xb);
  PH(17) if (lo <= 17 && 17 < hi) {
#if (REPMASK >> 17) & 1
    int nrep = 2; asm volatile("" : "+s"(nrep));
    for (int rep = 0; rep < nrep; ++rep) {
      if (rep) xcd_barrier(xb);
#else
    {
#endif
        rowop<true, false, false, true, true>(p, WSB(OFF_R2), WSB(OFF_R2) + (size_t)8192 * 1024, p.n_post_ffn + 1024, 5, nullptr, 0, 0, 1, 1);
    }
  }
}

extern "C" void kernel_launch(void* const* d_in, const int* in_sizes, int n_in, void* d_out, int out_size, void* d_ws,
                              size_t ws_size, hipStream_t stream) {
  P p{};
  const float** f = (const float**)&p;
  for (int i = 0; i < 33; ++i) f[i] = (const float*)d_in[i];
  p.out = (float*)d_out;
  p.ws = (char*)d_ws;
  static int grid_blocks = 0;
  if (!grid_blocks) {
    int dev = 0, cus = 0, per_cu = 0;
    hipGetDevice(&dev);
    hipDeviceGetAttribute(&cus, hipDeviceAttributeMultiprocessorCount, dev);
    hipOccupancyMaxActiveBlocksPerMultiprocessor(&per_cu, mega, 512, 0);
    if (per_cu > 1) per_cu = 1;
    if (per_cu < 1) per_cu = 1;
    grid_blocks = cus * per_cu;
  }
  hipMemsetAsync((char*)d_ws + OFF_BAR, 0, XCD_BAR_WORDS * 4, stream);
#if SINGLE_LAUNCH
  int lo = 0, hi = NPHASE;
  void* args[] = {&p, &lo, &hi};
  hipError_t e = hipLaunchCooperativeKernel((void*)mega, dim3(grid_blocks), dim3(512), args, 0, stream);
  if (e != hipSuccess) fprintf(stderr, "cooperative launch failed: %s (grid %d)\n", hipGetErrorString(e), grid_blocks);
#else
  for (int ph = 0; ph < NPHASE; ++ph) mega<<<grid_blocks, 512, 0, stream>>>(p, ph, ph + 1);
#endif
}
```

```cpp
#include <hip/hip_runtime.h>
#include <hip/hip_cooperative_groups.h>
#include <stdint.h>
#include <stdio.h>
namespace cg = cooperative_groups;

#ifndef SINGLE_LAUNCH
#define SINGLE_LAUNCH 1
#endif

typedef __attribute__((ext_vector_type(8))) short bf16x8;
typedef __attribute__((ext_vector_type(4))) float f32x4;
typedef unsigned short bf16_t;

#define DEVI __device__ __forceinline__

constexpr size_t OFF_WIN   = 0;
constexpr size_t OFF_WUQ   = OFF_WIN   + (size_t)2176*1024*2;
constexpr size_t OFF_WUKV  = OFF_WUQ   + (size_t)768*256*2;
constexpr size_t OFF_WOUT  = OFF_WUKV  + (size_t)1024*256*2;
constexpr size_t OFF_WPOOL = OFF_WOUT  + (size_t)1024*1024*2;
constexpr size_t OFF_WGU   = OFF_WPOOL + (size_t)4*256*256*2;
constexpr size_t OFF_WDN   = OFF_WGU   + (size_t)2*5632*1024*2;
constexpr size_t OFF_MOD   = OFF_WDN   + (size_t)2*1024*2816*2;
constexpr size_t OFF_R1    = OFF_MOD   + (size_t)2*3*6144*4;
constexpr size_t OFF_DTRAW = OFF_R1    + (size_t)8192*2080*2;
constexpr size_t OFF_R2    = OFF_R1    + (size_t)8192*2096*4;
constexpr size_t OFF_H     = OFF_R2    + (size_t)8192*1024*4;
constexpr size_t OFF_CAT   = OFF_H     + (size_t)8192*1024*2;
constexpr size_t OFF_Q     = OFF_CAT   + (size_t)8192*1024*2;
constexpr size_t OFF_KN    = OFF_Q     + (size_t)8192*768*2;
constexpr size_t OFF_VT    = OFF_KN    + (size_t)8704*512*2;
constexpr size_t OFF_CQN   = OFF_VT    + (size_t)8704*512*2;
constexpr size_t OFF_CKV   = OFF_CQN   + (size_t)8192*256*2;
constexpr size_t OFF_KPE   = OFF_CKV   + (size_t)8704*256*2;
constexpr size_t OFF_XS    = OFF_KPE   + (size_t)8704*32*2;
constexpr size_t OFF_XST   = OFF_XS    + (size_t)8192*512*2;
constexpr size_t OFF_BM    = OFF_XST   + (size_t)8192*512*2;
constexpr size_t OFF_BT    = OFF_BM    + (size_t)8192*256*2;
constexpr size_t OFF_CM    = OFF_BT    + (size_t)8192*256*2;
constexpr size_t OFF_DTV   = OFF_CM    + (size_t)8192*256*2;
constexpr size_t OFF_CUM   = OFF_DTV   + (size_t)2*8192*8*4;
constexpr size_t OFF_TOT   = OFF_CUM   + (size_t)2*8192*8*4;
constexpr size_t OFF_BAR   = OFF_TOT   + 4096;
constexpr size_t OFF_XR    = OFF_BAR   + 16384;
constexpr size_t OFF_END   = OFF_XR    + (size_t)8192*1024*2;
static_assert(OFF_END <= ((size_t)256 << 20), "workspace map exceeds 256 MiB");

constexpr size_t OUT_CKV = 8388608, OUT_KR = 9437184, OUT_SF = 9568256, OUT_SB = 10616832;

struct P {
  const float *x_prompt, *x_sample, *c, *cache_ckv, *cache_kr, *st_f, *st_b, *c_ctx;
  const float *w_mod, *b_mod, *n_pre_mix, *n_post_mix, *n_pre_ffn, *n_post_ffn;
  const float *w_in, *q_norm, *w_uq, *kv_norm, *w_ukv, *conv_w, *conv_b, *dtb_f, *dtb_b, *alog_f, *alog_b;
  const float *ssd_d, *ssd_norm, *w_out, *pool_w, *pool_scale, *w_gate, *w_up, *w_down;
  float* out;
  char* ws;
};

#define WSB(off) ((bf16_t*)(p.ws + (off)))
#define WSF(off) ((float*)(p.ws + (off)))

typedef __bf16 hwbf16x2 __attribute__((ext_vector_type(2)));
typedef float hwf32x2 __attribute__((ext_vector_type(2)));
DEVI bf16_t f2bf(float f) {
  __bf16 r = (__bf16)f;
  return __builtin_bit_cast(bf16_t, r);
}
DEVI float bf2f(bf16_t b) { return __uint_as_float(((unsigned)b) << 16); }
DEVI unsigned pack2(float a, float b) {
  hwf32x2 v = {a, b};
  hwbf16x2 r = __builtin_convertvector(v, hwbf16x2);
  return __builtin_bit_cast(unsigned, r);
}
DEVI float silu(float x) { return x / (1.f + __expf(-x)); }
DEVI float wave_sum(float v) {
#pragma unroll
  for (int o = 32; o > 0; o >>= 1) v += __shfl_xor(v, o, 64);
  return v;
}
DEVI f32x4 mfma16(bf16x8 a, bf16x8 b, f32x4 c) { return __builtin_amdgcn_mfma_f32_16x16x32_bf16(a, b, c, 0, 0, 0); }

DEVI float rope_freq(int m) { return exp2f(-(float)m * 1.6609640474436813f); }
DEVI void fast_sincos(float ang, float& sn, float& cs) {
  float rev = ang * 0.15915494309189535f;
  rev -= rintf(rev);
  sn = __builtin_amdgcn_sinf(rev);
  cs = __builtin_amdgcn_cosf(rev);
}
typedef unsigned hwu32x2 __attribute__((ext_vector_type(2)));
DEVI float quad_max(float x) {
  hwu32x2 r = __builtin_amdgcn_permlane16_swap(__float_as_uint(x), __float_as_uint(x), false, false);
  x = fmaxf(__uint_as_float(r[0]), __uint_as_float(r[1]));
  r = __builtin_amdgcn_permlane32_swap(__float_as_uint(x), __float_as_uint(x), false, false);
  return fmaxf(__uint_as_float(r[0]), __uint_as_float(r[1]));
}
DEVI float quad_sum(float x) {
  hwu32x2 r = __builtin_amdgcn_permlane16_swap(__float_as_uint(x), __float_as_uint(x), false, false);
  x = __uint_as_float(r[0]) + __uint_as_float(r[1]);
  r = __builtin_amdgcn_permlane32_swap(__float_as_uint(x), __float_as_uint(x), false, false);
  return __uint_as_float(r[0]) + __uint_as_float(r[1]);
}
#define VB ((int)(threadIdx.x >> 8))
#define VT_PAIRG (gridDim.x == 256u)
#define VT_FIRST ((int)(VT_PAIRG ? blockIdx.x : blockIdx.x * 2u))
#define VT_OFF ((int)(VT_PAIRG ? VB * gridDim.x : VB))
DEVI int opaque_tid() { int t = threadIdx.x & 255; asm volatile("" : "+v"(t)); return t; }
typedef float nt_f4 __attribute__((ext_vector_type(4)));
typedef unsigned nt_u2 __attribute__((ext_vector_type(2)));
DEVI float4 ld_nt_f4(const float* p) { const nt_f4 v = __builtin_nontemporal_load((const nt_f4*)p); return make_float4(v[0], v[1], v[2], v[3]); }
DEVI uint2 ld_nt_u2(const bf16_t* p) { const nt_u2 v = __builtin_nontemporal_load((const nt_u2*)p); return make_uint2(v[0], v[1]); }
DEVI int swz_tile(int t, int T) {
  int q = T >> 3, r = T & 7, x = t & 7, off = t >> 3;
  return (x < r ? x * (q + 1) : r * (q + 1) + (x - r) * q) + off;
}

__shared__ __attribute__((aligned(16))) char g_smem[2 * 73728];
#define NOINL __device__ __forceinline__

constexpr int LDT = 72;
constexpr int TILE_E = 128 * LDT;

template <class Epi>
DEVI void gemm_tile(const bf16_t* __restrict__ A, int lda, const bf16_t* __restrict__ B, int ldb, int K,
                    int m0, int n0, char* smem, Epi epi) {
  const int tid = opaque_tid(), lane = tid & 63, wave = tid >> 6, wm = wave >> 1, wn = wave & 1;
  const int lr = lane & 15, lg = lane >> 4;
  bf16_t* sA = (bf16_t*)smem;
  bf16_t* sB = sA + 2 * TILE_E;
  f32x4 acc[4][4];
#pragma unroll
  for (int i = 0; i < 4; ++i)
#pragma unroll
    for (int j = 0; j < 4; ++j) acc[i][j] = (f32x4){0.f, 0.f, 0.f, 0.f};
  const int lrow = tid >> 3, lkc = (tid & 7) * 8;
  const bf16_t* gA = A + (size_t)(m0 + lrow) * lda + lkc;
  const bf16_t* gB = B + (size_t)(n0 + lrow) * ldb + lkc;
  uint4 ra[4], rb[4];
#pragma unroll
  for (int i = 0; i < 4; ++i) {
    ra[i] = *(const uint4*)(gA + (size_t)(32 * i) * lda);
    rb[i] = *(const uint4*)(gB + (size_t)(32 * i) * ldb);
  }
#pragma unroll
  for (int i = 0; i < 4; ++i) {
    *(uint4*)(sA + (lrow + 32 * i) * LDT + lkc) = ra[i];
    *(uint4*)(sB + (lrow + 32 * i) * LDT + lkc) = rb[i];
  }
  __syncthreads();
  const int nk = K >> 6;
  for (int kt = 0; kt < nk; ++kt) {
    const int cur = kt & 1;
    if (kt + 1 < nk) {
      const int k0 = (kt + 1) << 6;
#pragma unroll
      for (int i = 0; i < 4; ++i) {
        ra[i] = *(const uint4*)(gA + (size_t)(32 * i) * lda + k0);
        rb[i] = *(const uint4*)(gB + (size_t)(32 * i) * ldb + k0);
      }
    }
    const bf16_t* cA = sA + cur * TILE_E + (wm * 64 + lr) * LDT + lg * 8;
    const bf16_t* cB = sB + cur * TILE_E + (wn * 64 + lr) * LDT + lg * 8;
#pragma unroll
    for (int ks = 0; ks < 2; ++ks) {
      bf16x8 af[4], bfr[4];
#pragma unroll
      for (int i = 0; i < 4; ++i) {
        af[i] = *(const bf16x8*)(cA + i * 16 * LDT + ks * 32);
        bfr[i] = *(const bf16x8*)(cB + i * 16 * LDT + ks * 32);
      }
#pragma unroll
      for (int i = 0; i < 4; ++i)
#pragma unroll
        for (int j = 0; j < 4; ++j) acc[i][j] = mfma16(af[i], bfr[j], acc[i][j]);
    }
    if (kt + 1 < nk) {
      const int nx = cur ^ 1;
#pragma unroll
      for (int i = 0; i < 4; ++i) {
        *(uint4*)(sA + nx * TILE_E + (lrow + 32 * i) * LDT + lkc) = ra[i];
        *(uint4*)(sB + nx * TILE_E + (lrow + 32 * i) * LDT + lkc) = rb[i];
      }
    }
    __syncthreads();
  }
#pragma unroll
  for (int i = 0; i < 4; ++i)
#pragma unroll
    for (int j = 0; j < 4; j += 2)
      epi(m0 + wm * 64 + i * 16 + lg * 4, n0 + wn * 64 + j * 16 + lr, acc[i][j], acc[i][j + 1]);
}

struct TileInfo { const bf16_t* a; const bf16_t* b; int m0, n0, ctx; };
template <class TileFn, class Epi>
DEVI void gemm_stream(int T, int lda, int ldb, int K, char* smem, TileFn tf, Epi epi) {
  int t0 = VT_FIRST;
  if (t0 >= T) return;
  int t = min(t0 + VT_OFF, T - 1);
  const int tid = opaque_tid(), lane = tid & 63, wave = tid >> 6, wm = wave >> 1, wn = wave & 1;
  const int lr = lane & 15, lg = lane >> 4;
  bf16_t* sA = (bf16_t*)smem;
  bf16_t* sB = sA + 2 * TILE_E;
  const int lrow = tid >> 3, lkc = (tid & 7) * 8;
  TileInfo ti = tf(t);
  const bf16_t* gA = ti.a + (size_t)lrow * lda + lkc;
  const bf16_t* gB = ti.b + (size_t)lrow * ldb + lkc;
  int m0 = ti.m0, n0 = ti.n0, ctx = ti.ctx;
  uint4 ra0, ra1, ra2, ra3, rb0, rb1, rb2, rb3;
  uint4 rc0, rc1, rc2, rc3, rd0, rd1, rd2, rd3;
#define GS_LOAD0(pa, pb) \
  ra0 = *(const uint4*)((pa)); ra1 = *(const uint4*)((pa) + (size_t)32 * lda); \
  ra2 = *(const uint4*)((pa) + (size_t)64 * lda); ra3 = *(const uint4*)((pa) + (size_t)96 * lda); \
  rb0 = *(const uint4*)((pb)); rb1 = *(const uint4*)((pb) + (size_t)32 * ldb); \
  rb2 = *(const uint4*)((pb) + (size_t)64 * ldb); rb3 = *(const uint4*)((pb) + (size_t)96 * ldb);
#define GS_LOAD1(pa, pb) \
  rc0 = *(const uint4*)((pa)); rc1 = *(const uint4*)((pa) + (size_t)32 * lda); \
  rc2 = *(const uint4*)((pa) + (size_t)64 * lda); rc3 = *(const uint4*)((pa) + (size_t)96 * lda); \
  rd0 = *(const uint4*)((pb)); rd1 = *(const uint4*)((pb) + (size_t)32 * ldb); \
  rd2 = *(const uint4*)((pb) + (size_t)64 * ldb); rd3 = *(const uint4*)((pb) + (size_t)96 * ldb);
#define GS_WRITE0(buf) { \
  bf16_t* wa = sA + (buf) * TILE_E + lrow * LDT + lkc; bf16_t* wb = sB + (buf) * TILE_E + lrow * LDT + lkc; \
  *(uint4*)(wa) = ra0; *(uint4*)(wa + 32 * LDT) = ra1; *(uint4*)(wa + 64 * LDT) = ra2; *(uint4*)(wa + 96 * LDT) = ra3; \
  *(uint4*)(wb) = rb0; *(uint4*)(wb + 32 * LDT) = rb1; *(uint4*)(wb + 64 * LDT) = rb2; *(uint4*)(wb + 96 * LDT) = rb3; }
#define GS_WRITE1(buf) { \
  bf16_t* wa = sA + (buf) * TILE_E + lrow * LDT + lkc; bf16_t* wb = sB + (buf) * TILE_E + lrow * LDT + lkc; \
  *(uint4*)(wa) = rc0; *(uint4*)(wa + 32 * LDT) = rc1; *(uint4*)(wa + 64 * LDT) = rc2; *(uint4*)(wa + 96 * LDT) = rc3; \
  *(uint4*)(wb) = rd0; *(uint4*)(wb + 32 * LDT) = rd1; *(uint4*)(wb + 64 * LDT) = rd2; *(uint4*)(wb + 96 * LDT) = rd3; }
#define GS_COMPUTE(buf) { \
    const bf16_t* cA = sA + (buf) * TILE_E + (wm * 64 + lr) * LDT + lg * 8; \
    const bf16_t* cB = sB + (buf) * TILE_E + (wn * 64 + lr) * LDT + lg * 8; \
    _Pragma("unroll") for (int ks = 0; ks < 2; ++ks) { \
      bf16x8 af[4], bfr[4]; \
      _Pragma("unroll") for (int i = 0; i < 4; ++i) { \
        af[i] = *(const bf16x8*)(cA + i * 16 * LDT + ks * 32); \
        bfr[i] = *(const bf16x8*)(cB + i * 16 * LDT + ks * 32); \
      } \
      __builtin_amdgcn_s_setprio(1); \
      _Pragma("unroll") for (int i = 0; i < 4; ++i) \
        _Pragma("unroll") for (int j = 0; j < 4; ++j) acc[i][j] = mfma16(af[i], bfr[j], acc[i][j]); \
      __builtin_amdgcn_s_setprio(0); \
    } }
  GS_LOAD0(gA, gB)
  GS_WRITE0(0)
  GS_LOAD1(gA + 64, gB + 64)
  __syncthreads();
  const int nk = K >> 6;
  for (;;) {
    f32x4 acc[4][4];
#pragma unroll
    for (int i = 0; i < 4; ++i)
#pragma unroll
      for (int j = 0; j < 4; ++j) acc[i][j] = (f32x4){0.f, 0.f, 0.f, 0.f};
    const int t0n = t0 + gridDim.x * 2;
    const bool have_next = t0n < T;
    const int tn = min(t0n + VT_OFF, T - 1);
    const bf16_t *nA = gA, *nB = gB;
    int nm0 = 0, nn0 = 0, nctx = 0;
    if (have_next) {
      const TileInfo tj = tf(tn);
      nA = tj.a + (size_t)lrow * lda + lkc;
      nB = tj.b + (size_t)lrow * ldb + lkc;
      nm0 = tj.m0; nn0 = tj.n0; nctx = tj.ctx;
    }
    for (int kt = 0; kt < nk; kt += 2) {
      {
        const bool wrap = (kt + 2 >= nk);
        const bf16_t* pa = wrap ? nA : gA + ((kt + 2) << 6);
        const bf16_t* pb = wrap ? nB : gB + ((kt + 2) << 6);
        GS_LOAD0(pa, pb)
        GS_COMPUTE(0)
        GS_WRITE1(1)
        __syncthreads();
      }
      {
        const bool wrap = (kt + 3 >= nk);
        const bf16_t* pa = wrap ? nA + 64 : gA + ((kt + 3) << 6);
        const bf16_t* pb = wrap ? nB + 64 : gB + ((kt + 3) << 6);
        GS_LOAD1(pa, pb)
        GS_COMPUTE(1)
        GS_WRITE0(0)
        __syncthreads();
      }
    }
#pragma unroll
    for (int i = 0; i < 4; ++i)
#pragma unroll
      for (int j = 0; j < 4; j += 2)
        epi(ctx, m0 + wm * 64 + i * 16 + lg * 4, n0 + wn * 64 + j * 16 + lr, acc[i][j], acc[i][j + 1]);
    if (!have_next) break;
    t = tn; t0 = t0n; gA = nA; gB = nB; m0 = nm0; n0 = nn0; ctx = nctx;
  }
}

constexpr int T8_E = 256 * LDT;
template <class TileFn, class Epi>
DEVI void gemm8_stream(int T, int lda, int ldb, int K, TileFn tf, Epi epi) {
  int t = blockIdx.x;
  if (t >= T) return;
  int tid = threadIdx.x; asm volatile("" : "+v"(tid));
  const int lane = tid & 63, wave = tid >> 6, wr = wave >> 2, wc = wave & 3;
  const int lr = lane & 15, lg = lane >> 4;
  bf16_t* sA = (bf16_t*)g_smem;
  bf16_t* sB = sA + 2 * T8_E;
  const int lrow = tid >> 3, lkc = (tid & 7) * 8;
  TileInfo ti = tf(t);
  const unsigned offA = ((unsigned)lrow * (unsigned)lda + (unsigned)lkc) * 2u;
  const unsigned offB = ((unsigned)lrow * (unsigned)ldb + (unsigned)lkc) * 2u;
  const char* gA = (const char*)ti.a;
  const char* gB = (const char*)ti.b;
  const size_t rsA = (size_t)64 * lda * 2, rsB = (size_t)64 * ldb * 2;
  int m0 = ti.m0, n0 = ti.n0, ctx = ti.ctx;
  uint4 ra0, ra1, ra2, ra3, rb0, rb1, rb2, rb3;
  uint4 rc0, rc1, rc2, rc3, rd0, rd1, rd2, rd3;
#define G8_LOAD(pa, pb) \
  ra0 = *(const uint4*)((pa) + offA); ra1 = *(const uint4*)((pa) + rsA + offA); \
  ra2 = *(const uint4*)((pa) + 2 * rsA + offA); ra3 = *(const uint4*)((pa) + 3 * rsA + offA); \
  rb0 = *(const uint4*)((pb) + offB); rb1 = *(const uint4*)((pb) + rsB + offB); \
  rb2 = *(const uint4*)((pb) + 2 * rsB + offB); rb3 = *(const uint4*)((pb) + 3 * rsB + offB);
#define G8_WRITE(buf) { \
  bf16_t* wa = sA + (buf) * T8_E + lrow * LDT + lkc; bf16_t* wb = sB + (buf) * T8_E + lrow * LDT + lkc; \
  *(uint4*)(wa) = ra0; *(uint4*)(wa + 64 * LDT) = ra1; *(uint4*)(wa + 128 * LDT) = ra2; *(uint4*)(wa + 192 * LDT) = ra3; \
  *(uint4*)(wb) = rb0; *(uint4*)(wb + 64 * LDT) = rb1; *(uint4*)(wb + 128 * LDT) = rb2; *(uint4*)(wb + 192 * LDT) = rb3; }
#define G8_LOAD1(pa, pb) \
  rc0 = *(const uint4*)((pa) + offA); rc1 = *(const uint4*)((pa) + rsA + offA); \
  rc2 = *(const uint4*)((pa) + 2 * rsA + offA); rc3 = *(const uint4*)((pa) + 3 * rsA + offA); \
  rd0 = *(const uint4*)((pb) + offB); rd1 = *(const uint4*)((pb) + rsB + offB); \
  rd2 = *(const uint4*)((pb) + 2 * rsB + offB); rd3 = *(const uint4*)((pb) + 3 * rsB + offB);
#define G8_WRITE1(buf) { \
  bf16_t* wa = sA + (buf) * T8_E + lrow * LDT + lkc; bf16_t* wb = sB + (buf) * T8_E + lrow * LDT + lkc; \
  *(uint4*)(wa) = rc0; *(uint4*)(wa + 64 * LDT) = rc1; *(uint4*)(wa + 128 * LDT) = rc2; *(uint4*)(wa + 192 * LDT) = rc3; \
  *(uint4*)(wb) = rd0; *(uint4*)(wb + 64 * LDT) = rd1; *(uint4*)(wb + 128 * LDT) = rd2; *(uint4*)(wb + 192 * LDT) = rd3; }
#define G8_COMPUTE(buf) { \
      const bf16_t* cA = sA + (buf) * T8_E + (wr * 128 + lr) * LDT + lg * 8; \
      const bf16_t* cB = sB + (buf) * T8_E + (wc * 64 + lr) * LDT + lg * 8; \
      _Pragma("unroll") for (int ks = 0; ks < 2; ++ks) { \
        bf16x8 bfr[4]; \
        _Pragma("unroll") for (int j = 0; j < 4; ++j) bfr[j] = *(const bf16x8*)(cB + j * 16 * LDT + ks * 32); \
        _Pragma("unroll") for (int h = 0; h < 2; ++h) { \
          bf16x8 af[4]; \
          _Pragma("unroll") for (int i = 0; i < 4; ++i) af[i] = *(const bf16x8*)(cA + (h * 4 + i) * 16 * LDT + ks * 32); \
          _Pragma("unroll") for (int i = 0; i < 4; ++i) \
            _Pragma("unroll") for (int j = 0; j < 4; ++j) acc[h * 4 + i][j] = mfma16(af[i], bfr[j], acc[h * 4 + i][j]); \
        } \
      } }
  G8_LOAD(gA, gB)
  G8_WRITE(0)
  G8_LOAD1(gA + 128, gB + 128)
  __syncthreads();
  const int nk = K >> 6;
  for (;;) {
    f32x4 acc[8][4];
#pragma unroll
    for (int i = 0; i < 8; ++i)
#pragma unroll
      for (int j = 0; j < 4; ++j) acc[i][j] = (f32x4){0.f, 0.f, 0.f, 0.f};
    const int tn = t + gridDim.x;
    const bool have_next = tn < T;
    const char *nA = gA, *nB = gB;
    int nm0 = 0, nn0 = 0, nctx = 0;
    if (have_next) {
      const TileInfo tj = tf(tn);
      nA = (const char*)tj.a;
      nB = (const char*)tj.b;
      nm0 = tj.m0; nn0 = tj.n0; nctx = tj.ctx;
    }
#pragma unroll 1
    for (int kt = 0; kt < nk; kt += 2) {
      {
        const bool wrap = (kt + 2 >= nk);
        const char* pa = wrap ? nA : gA + ((kt + 2) << 7);
        const char* pb = wrap ? nB : gB + ((kt + 2) << 7);
        G8_LOAD(pa, pb)
        G8_COMPUTE(0)
        G8_WRITE1(1)
        __syncthreads();
      }
      {
        const bool wrap = (kt + 3 >= nk);
        const char* pa = wrap ? nA + 128 : gA + ((kt + 3) << 7);
        const char* pb = wrap ? nB + 128 : gB + ((kt + 3) << 7);
        G8_LOAD1(pa, pb)
        G8_COMPUTE(1)
        G8_WRITE(0)
        __syncthreads();
      }
    }
#pragma unroll
    for (int i = 0; i < 8; ++i)
#pragma unroll
      for (int j = 0; j < 4; j += 2)
        epi(ctx, m0 + wr * 128 + i * 16 + lg * 4, n0 + wc * 64 + j * 16 + lr, acc[i][j], acc[i][j + 1]);
    if (!have_next) break;
    t = tn; gA = nA; gB = nB; m0 = nm0; n0 = nn0; ctx = nctx;
  }
}

DEVI void tile_mn(int t, int nM, int nN, int& m, int& n) {
  int id = swz_tile(t, nM * nN);
  int per = 8 * nN;
  int gq = id / per, rem = id - gq * per;
  int gsz = min(8, nM - gq * 8);
  m = gq * 8 + rem % gsz;
  n = rem / gsz;
}

NOINL void gemv_tile(const P& p, int t) {
  char* smem = g_smem + VB * 73728;
  const int tid = opaque_tid();
  float* sv = (float*)smem;
  float* red = sv + 3072;
  const int l = t / 192, n0 = (t % 192) * 32;
  for (int i = tid; i < 3072; i += 256) {
    int v = i >> 10, k = i & 1023;
    float cv = (v == 0) ? p.c_ctx[k] : p.c[(v - 1) * 1024 + k];
    sv[i] = cv / (1.f + expf(-cv));
  }
  __syncthreads();
  const int cgp = tid & 7, ks = tid >> 3;
  const float* w = p.w_mod + (size_t)l * 1024 * 6144 + n0 + cgp * 4;
  float a0[4] = {0, 0, 0, 0}, a1[4] = {0, 0, 0, 0}, a2[4] = {0, 0, 0, 0};
#pragma unroll 16
  for (int kk = 0; kk < 32; ++kk) {
    const int k = ks * 32 + kk;
    const float4 wv = *(const float4*)(w + (size_t)k * 6144);
    const float s0 = sv[k], s1 = sv[1024 + k], s2 = sv[2048 + k];
    a0[0] += s0 * wv.x; a0[1] += s0 * wv.y; a0[2] += s0 * wv.z; a0[3] += s0 * wv.w;
    a1[0] += s1 * wv.x; a1[1] += s1 * wv.y; a1[2] += s1 * wv.z; a1[3] += s1 * wv.w;
    a2[0] += s2 * wv.x; a2[1] += s2 * wv.y; a2[2] += s2 * wv.z; a2[3] += s2 * wv.w;
  }
#pragma unroll
  for (int j = 0; j < 4; ++j) {
    red[(ks * 3 + 0) * 32 + cgp * 4 + j] = a0[j];
    red[(ks * 3 + 1) * 32 + cgp * 4 + j] = a1[j];
    red[(ks * 3 + 2) * 32 + cgp * 4 + j] = a2[j];
  }
  __syncthreads();
  if (tid < 96) {
    const int v = tid >> 5, col = tid & 31;
    float s = 0.f;
    for (int q = 0; q < 32; ++q) s += red[(q * 3 + v) * 32 + col];
    s += p.b_mod[l * 6144 + n0 + col];
    WSF(OFF_MOD)[(l * 3 + v) * 6144 + n0 + col] = s;
  }
  __syncthreads();
}

NOINL void transpose_tile(const P& p, int t) {
  char* smem = g_smem + VB * 73728;
  const int tid = opaque_tid();
  const float* src; bf16_t* dst; int K, N, ntn, mode = 0;
  if (t < 544) { src = p.w_in; dst = WSB(OFF_WIN); K = 1024; N = 2096; ntn = 34; }
  else if ((t -= 544) < 48) { src = p.w_uq; dst = WSB(OFF_WUQ); K = 256; N = 768; ntn = 12; }
  else if ((t -= 48) < 64) { src = p.w_ukv; dst = WSB(OFF_WUKV); K = 256; N = 1024; ntn = 16; }
  else if ((t -= 64) < 256) { src = p.w_out; dst = WSB(OFF_WOUT); K = 1024; N = 1024; ntn = 16; }
  else if ((t -= 256) < 64) { int g = t >> 4; t &= 15; src = p.pool_w + (size_t)g * 65536; dst = WSB(OFF_WPOOL) + (size_t)g * 65536; K = 256; N = 256; ntn = 4; }
  else if ((t -= 64) < 1408) { int l = t / 704; t -= l * 704; src = p.w_gate + (size_t)l * 1024 * 2816; dst = WSB(OFF_WGU) + (size_t)l * 5632 * 1024; K = 1024; N = 2816; ntn = 44; mode = 1; }
  else if ((t -= 1408) < 1408) { int l = t / 704; t -= l * 704; src = p.w_up + (size_t)l * 1024 * 2816; dst = WSB(OFF_WGU) + (size_t)l * 5632 * 1024; K = 1024; N = 2816; ntn = 44; mode = 2; }
  else { t -= 1408; int l = t / 704; t -= l * 704; src = p.w_down + (size_t)l * 2816 * 1024; dst = WSB(OFF_WDN) + (size_t)l * 1024 * 2816; K = 2816; N = 1024; ntn = 16; }
  const int kt = t / ntn, nt_ = t - kt * ntn;
  const int k0 = kt * 64, n0 = nt_ * 64;
  float* tile = (float*)smem;
  {
    const int nn = tid & 63, kk0 = tid >> 6;
    const int n = n0 + nn;
    const int nc = n < N ? n : N - 1;
    float v[16];
#pragma unroll
    for (int i = 0; i < 16; ++i) v[i] = src[(size_t)(k0 + kk0 + 4 * i) * N + nc];
#pragma unroll
    for (int i = 0; i < 16; ++i) tile[(kk0 + 4 * i) * 65 + nn] = (n < N) ? v[i] : 0.f;
  }
  __syncthreads();
#pragma unroll
  for (int i = 0; i < 2; ++i) {
    const int id = tid + 256 * i;
    const int nn = id >> 3, kc = id & 7;
    const int n = n0 + nn;
    uint4 pk;
    pk.x = pack2(tile[(kc * 8 + 0) * 65 + nn], tile[(kc * 8 + 1) * 65 + nn]);
    pk.y = pack2(tile[(kc * 8 + 2) * 65 + nn], tile[(kc * 8 + 3) * 65 + nn]);
    pk.z = pack2(tile[(kc * 8 + 4) * 65 + nn], tile[(kc * 8 + 5) * 65 + nn]);
    pk.w = pack2(tile[(kc * 8 + 6) * 65 + nn], tile[(kc * 8 + 7) * 65 + nn]);
    int drow = n;
    if (mode == 1) drow = (n >> 4) * 32 + (n & 15);
    else if (mode == 2) drow = (n >> 4) * 32 + 16 + (n & 15);
    *(uint4*)(dst + (size_t)drow * K + k0 + kc * 8) = pk;
  }
  __syncthreads();
}

template <bool UPD, bool MOD, bool FIRST, bool LASTW, bool TWO, bool POOL = false>
DEVI void rowop(const P& p, const bf16_t* msrc, const bf16_t* msrc2, const float* wpost, int gate_idx, const float* wpre, int shift_idx,
                int scale_idx, int layer_g, int layer_m) {
  const int lane = threadIdx.x & 63, wave = threadIdx.x >> 6;
  const float* modg = WSF(OFF_MOD) + (size_t)layer_g * 3 * 6144;
  const float* modm = WSF(OFF_MOD) + (size_t)layer_m * 3 * 6144;
  bf16_t* hbuf = WSB(OFF_H);
  for (int r = blockIdx.x * 8 + wave; r < 8192; r += gridDim.x * 8) {
    const int v = r < 4096 ? 0 : 1 + ((r - 4096) >> 11);
    const float* mvg = modg + v * 6144;
    const float* mvm = modm + v * 6144;
    float4 x[4];
    if (FIRST) {
      const float* xin = r < 4096 ? p.x_prompt + (size_t)r * 1024 : p.x_sample + (size_t)(r - 4096) * 1024;
#pragma unroll
      for (int i = 0; i < 4; ++i) x[i] = ld_nt_f4(xin + lane * 4 + 256 * i);
    } else {
#pragma unroll
      for (int i = 0; i < 4; ++i) {
        const uint2 xb = ld_nt_u2(WSB(OFF_XR) + (size_t)r * 1024 + lane * 4 + 256 * i);
        x[i].x = __uint_as_float(xb.x << 16); x[i].y = __uint_as_float(xb.x & 0xffff0000u);
        x[i].z = __uint_as_float(xb.y << 16); x[i].w = __uint_as_float(xb.y & 0xffff0000u);
      }
    }
    if (UPD) {
      float4 m[4];
      float ss = 0.f;
      int ps0 = 0, pL = 0;
      if (POOL) { if (r < 4096) { ps0 = r & ~255; pL = 256; } else { ps0 = 4096 + ((r - 4096) & ~2047); pL = 2048; } }
#pragma unroll
      for (int i = 0; i < 4; ++i) {
        if (POOL) {
          constexpr int dummy = 0; (void)dummy;
          const int W2 = 1 << i;
          const int t = r - ps0;
          const int lo = max(t - W2, 0), hi = min(t + W2, pL);
          float a0 = 0.f, a1 = 0.f, a2 = 0.f, a3 = 0.f;
          uint2 ctr = make_uint2(0u, 0u);
#pragma unroll
          for (int k = 0; k < 2 * W2; ++k) {
            const int u = t - W2 + k;
            const int uc = min(max(u, 0), pL - 1);
            const uint2 g = *(const uint2*)(msrc + (size_t)(ps0 + uc) * 1024 + lane * 4 + 256 * i);
            const float w = (u >= 0 && u < pL) ? 1.f : 0.f;
            a0 += w * __uint_as_float(g.x << 16); a1 += w * __uint_as_float(g.x & 0xffff0000u);
            a2 += w * __uint_as_float(g.y << 16); a3 += w * __uint_as_float(g.y & 0xffff0000u);
            if (k == W2) ctr = g;
          }
          const float inv = 1.f / (float)(hi - lo);
          m[i].x = a0 * inv - __uint_as_float(ctr.x << 16); m[i].y = a1 * inv - __uint_as_float(ctr.x & 0xffff0000u);
          m[i].z = a2 * inv - __uint_as_float(ctr.y << 16); m[i].w = a3 * inv - __uint_as_float(ctr.y & 0xffff0000u);
          ss += m[i].x * m[i].x + m[i].y * m[i].y + m[i].z * m[i].z + m[i].w * m[i].w;
          continue;
        }
        const uint2 mb = ld_nt_u2(msrc + (size_t)r * 1024 + lane * 4 + 256 * i);
        m[i].x = __uint_as_float(mb.x << 16); m[i].y = __uint_as_float(mb.x & 0xffff0000u);
        m[i].z = __uint_as_float(mb.y << 16); m[i].w = __uint_as_float(mb.y & 0xffff0000u);
        if (TWO) {
          const uint2 mc = ld_nt_u2(msrc2 + (size_t)r * 1024 + lane * 4 + 256 * i);
          m[i].x += __uint_as_float(mc.x << 16); m[i].y += __uint_as_float(mc.x & 0xffff0000u);
          m[i].z += __uint_as_float(mc.y << 16); m[i].w += __uint_as_float(mc.y & 0xffff0000u);
        }
        ss += m[i].x * m[i].x + m[i].y * m[i].y + m[i].z * m[i].z + m[i].w * m[i].w;
      }
      ss = wave_sum(ss);
      const float rs = rsqrtf(ss * (1.f / 1024.f) + 1e-6f);
#pragma unroll
      for (int i = 0; i < 4; ++i) {
        const int col = lane * 4 + 256 * i;
        const float4 wp = *(const float4*)(wpost + col);
        const float4 g = *(const float4*)(mvg + gate_idx * 1024 + col);
        x[i].x += g.x * (m[i].x * rs * wp.x);
        x[i].y += g.y * (m[i].y * rs * wp.y);
        x[i].z += g.z * (m[i].z * rs * wp.z);
        x[i].w += g.w * (m[i].w * rs * wp.w);
        if (LASTW) *(float4*)(p.out + (size_t)r * 1024 + col) = x[i];
        else {
          uint2 xo;
          xo.x = pack2(x[i].x, x[i].y);
          xo.y = pack2(x[i].z, x[i].w);
          *(uint2*)(WSB(OFF_XR) + (size_t)r * 1024 + col) = xo;
        }
      }
    }
    if (MOD) {
      float ss = 0.f;
#pragma unroll
      for (int i = 0; i < 4; ++i) ss += x[i].x * x[i].x + x[i].y * x[i].y + x[i].z * x[i].z + x[i].w * x[i].w;
      ss = wave_sum(ss);
      const float rs = rsqrtf(ss * (1.f / 1024.f) + 1e-6f);
#pragma unroll
      for (int i = 0; i < 4; ++i) {
        const int col = lane * 4 + 256 * i;
        const float4 wp = *(const float4*)(wpre + col);
        const float4 sh = *(const float4*)(mvm + shift_idx * 1024 + col);
        const float4 sc = *(const float4*)(mvm + scale_idx * 1024 + col);
        uint2 o;
        o.x = pack2(x[i].x * rs * wp.x * (1.f + sc.x) + sh.x, x[i].y * rs * wp.y * (1.f + sc.y) + sh.y);
        o.y = pack2(x[i].z * rs * wp.z * (1.f + sc.z) + sh.z, x[i].w * rs * wp.w * (1.f + sc.w) + sh.w);
        *(uint2*)(hbuf + (size_t)r * 1024 + col) = o;
      }
    }
  }
}

NOINL void prep_rows(const P& p) {
  const int lane = threadIdx.x & 63, wave = threadIdx.x >> 6;
  const bf16_t* proj = WSB(OFF_R1);
  for (int r = blockIdx.x * 8 + wave; r < 8192; r += gridDim.x * 8) {
    const bf16_t* pr = proj + (size_t)r * 2080;
    const int kvrow = r < 4096 ? r : 4096 + ((r - 4096) >> 11) * 2304 + 256 + ((r - 4096) & 2047);
    const uint2 rq = *(const uint2*)(pr + lane * 4);
    const uint2 rk = *(const uint2*)(pr + 256 + lane * 4);
    const float4 ld_cq = make_float4(__uint_as_float(rq.x << 16), __uint_as_float(rq.x & 0xffff0000u), __uint_as_float(rq.y << 16), __uint_as_float(rq.y & 0xffff0000u));
    const float4 ld_ckv = make_float4(__uint_as_float(rk.x << 16), __uint_as_float(rk.x & 0xffff0000u), __uint_as_float(rk.y << 16), __uint_as_float(rk.y & 0xffff0000u));
    const float ld_kpe = bf2f(pr[512 + (lane & 31)]);
    const float ld_dt = WSF(OFF_DTRAW)[(size_t)r * 16 + (lane & 15)];
    {
      const float4 a = ld_cq;
      float ss = wave_sum(a.x * a.x + a.y * a.y + a.z * a.z + a.w * a.w);
      const float rs = rsqrtf(ss * (1.f / 256.f) + 1e-6f);
      const float4 g = *(const float4*)(p.q_norm + lane * 4);
      uint2 o;
      o.x = pack2(a.x * rs * g.x, a.y * rs * g.y);
      o.y = pack2(a.z * rs * g.z, a.w * rs * g.w);
      *(uint2*)(WSB(OFF_CQN) + (size_t)r * 256 + lane * 4) = o;
    }
    {
      const float4 a = ld_ckv;
      float ss = wave_sum(a.x * a.x + a.y * a.y + a.z * a.z + a.w * a.w);
      const float rs = rsqrtf(ss * (1.f / 256.f) + 1e-6f);
      const float4 g = *(const float4*)(p.kv_norm + lane * 4);
      float4 vv;
      vv.x = a.x * rs * g.x; vv.y = a.y * rs * g.y; vv.z = a.z * rs * g.z; vv.w = a.w * rs * g.w;
      if (r < 4096) *(float4*)(p.out + OUT_CKV + (size_t)r * 256 + lane * 4) = vv;
      uint2 o;
      o.x = pack2(vv.x, vv.y);
      o.y = pack2(vv.z, vv.w);
      *(uint2*)(WSB(OFF_CKV) + (size_t)kvrow * 256 + lane * 4) = o;
    }
    {
      const float kv = (lane < 32) ? ld_kpe : 0.f;
      const float partner = __shfl_xor(kv, 16, 64);
      if (r < 4096) {
        if (lane < 32) {
          p.out[OUT_KR + (size_t)r * 32 + lane] = kv;
          WSB(OFF_KPE)[(size_t)kvrow * 32 + lane] = f2bf(kv);
        }
      } else {
        const int t = (r - 4096) & 2047;
        const int ii = lane & 15;
        const float pos = (ii < 8) ? (float)(t >> 6) : (float)(t & 63);
        const float fr = rope_freq(ii & 7);
        const float ang = pos * fr;
        float cs, sn;
        fast_sincos(ang, sn, cs);
        const float o = (lane < 16) ? (kv * cs - partner * sn) : (partner * sn + kv * cs);
        if (lane < 32) WSB(OFF_KPE)[(size_t)kvrow * 32 + lane] = f2bf(o);
      }
    }
    if (lane < 16) {
      const int dir = lane >> 3, hh = lane & 7;
      const float raw = ld_dt + (dir ? p.dtb_b[hh] : p.dtb_f[hh]);
      const float sp = raw > 20.f ? raw : log1pf(expf(raw));
      WSF(OFF_DTV)[((size_t)dir * 8192 + r) * 8 + hh] = sp;
    }
  }
}

NOINL void prep_cache(const P& p) {
  const int gt = blockIdx.x * 512 + threadIdx.x, gs = gridDim.x * 512;
  for (int i = gt; i < 2 * 256 * 256; i += gs) {
    int b = i >> 16, rem = i & 65535;
    WSB(OFF_CKV)[(size_t)(4096 + b * 2304) * 256 + rem] = f2bf(p.cache_ckv[i]);
  }
  for (int i = gt; i < 2 * 256 * 32; i += gs) {
    int b = i >> 13, rem = i & 8191;
    WSB(OFF_KPE)[(size_t)(4096 + b * 2304) * 32 + rem] = f2bf(p.cache_kr[i]);
  }
}

NOINL void conv_tile(const P& p, int t) {
  char* smem = g_smem + VB * 73728;
  const int tid = opaque_tid();
  float* sin_ = (float*)smem;
  float* sout = sin_ + 68 * 64;
  const int tt_ = t >> 4, ct = t & 15;
  const int r0 = tt_ * 64, c0 = ct * 64;
  int s0, s1;
  if (r0 < 4096) { s0 = r0 & ~255; s1 = s0 + 256; } else { s0 = 4096 + ((r0 - 4096) & ~2047); s1 = s0 + 2048; }
  const bf16_t* proj = WSB(OFF_R1);
  {
    const int rr0 = tid >> 6, cc = tid & 63;
    float v[17];
#pragma unroll
    for (int k = 0; k < 17; ++k) {
      const int r = r0 - 2 + rr0 + 4 * k;
      const int rc = r < s0 ? s0 : (r >= s1 ? s1 - 1 : r);
      v[k] = bf2f(proj[(size_t)rc * 2080 + 1056 + c0 + cc]);
    }
#pragma unroll
    for (int k = 0; k < 17; ++k) {
      const int r = r0 - 2 + rr0 + 4 * k;
      sin_[(rr0 + 4 * k) * 64 + cc] = (r >= s0 && r < s1) ? v[k] : 0.f;
    }
  }
  __syncthreads();
  {
    const int cc = tid & 63, tq = tid >> 6;
    const int c = c0 + cc;
    const float w0 = p.conv_w[c], w1 = p.conv_w[1024 + c], w2 = p.conv_w[2048 + c], w3 = p.conv_w[3072 + c],
                w4 = p.conv_w[4096 + c], bias = p.conv_b[c];
#pragma unroll 4
    for (int i = 0; i < 16; ++i) {
      const int tt = tq * 16 + i;
      float y = bias + w0 * sin_[tt * 64 + cc] + w1 * sin_[(tt + 1) * 64 + cc] + w2 * sin_[(tt + 2) * 64 + cc] +
                w3 * sin_[(tt + 3) * 64 + cc] + w4 * sin_[(tt + 4) * 64 + cc];
      y = y / (1.f + __expf(-y));
      sout[tt * 65 + cc] = y;
      const bf16_t b = f2bf(y);
      const size_t r = r0 + tt;
      if (c < 512) WSB(OFF_XS)[r * 512 + c] = b;
      else if (c < 768) WSB(OFF_BM)[r * 256 + (c - 512)] = b;
      else WSB(OFF_CM)[r * 256 + (c - 768)] = b;
    }
  }
  __syncthreads();
  if (c0 < 768) {
    const int cl = tid >> 2, q4 = tid & 3;
    uint4 o0, o1;
    const float* sp = sout + (q4 * 16) * 65 + cl;
    o0.x = pack2(sp[0 * 65], sp[1 * 65]);   o0.y = pack2(sp[2 * 65], sp[3 * 65]);
    o0.z = pack2(sp[4 * 65], sp[5 * 65]);   o0.w = pack2(sp[6 * 65], sp[7 * 65]);
    o1.x = pack2(sp[8 * 65], sp[9 * 65]);   o1.y = pack2(sp[10 * 65], sp[11 * 65]);
    o1.z = pack2(sp[12 * 65], sp[13 * 65]); o1.w = pack2(sp[14 * 65], sp[15 * 65]);
    bf16_t* dst = (c0 < 512) ? WSB(OFF_XST) + (size_t)(c0 + cl) * 8192 : WSB(OFF_BT) + (size_t)(c0 - 512 + cl) * 8192;
    dst += r0 + q4 * 16;
    *(uint4*)(dst) = o0;
    *(uint4*)(dst + 8) = o1;
  }
  __syncthreads();
}

NOINL void chunk_state_item(const P& p, int item) {
  char* smem = g_smem + VB * 73728;
  const int tid = opaque_tid(), lane = tid & 63, wave = tid >> 6, lr = lane & 15, lg = lane >> 4;
  const int cidx = item >> 3, hh = item & 7, g = hh >> 2;
  const int r0 = cidx * 128;
  constexpr int LDS_ = 136;
  bf16_t* sAs = (bf16_t*)smem;
  bf16_t* sBs = sAs + 2 * 64 * LDS_;
  float* fa = (float*)(sBs + 128 * LDS_);
  float* fcum = fa + 256;
  float* fw = fa + 512;
  float* fdt = fa + 768;
  {
    const int dir = tid >> 7, j = tid & 127;
    const float dt = WSF(OFF_DTV)[((size_t)dir * 8192 + r0 + j) * 8 + hh];
    const float Aco = -expf(dir ? p.alog_b[hh] : p.alog_f[hh]);
    fa[tid] = dt * Aco;
    fdt[tid] = dt;
  }
  __syncthreads();
  {
    const int dir = tid >> 7, j = tid & 127;
    float s = 0.f;
    const float4* fa4 = (const float4*)(fa + dir * 128);
    if (dir == 0) {
      const int nb = (j + 1) >> 2;
      for (int k4 = 0; k4 < nb; ++k4) { const float4 v = fa4[k4]; s += (v.x + v.y) + (v.z + v.w); }
      for (int k = nb * 4; k <= j; ++k) s += fa[k];
    } else {
      const int fb = (j + 3) >> 2;
      for (int k4 = 31; k4 >= fb; --k4) { const float4 v = fa4[k4]; s += (v.x + v.y) + (v.z + v.w); }
      for (int k = j; k < fb * 4; ++k) s += fa[128 + k];
    }
    fcum[tid] = s;
    WSF(OFF_CUM)[((size_t)dir * 8192 + r0 + j) * 8 + hh] = s;
  }
  __syncthreads();
  {
    const int dir = tid >> 7;
    const float ce = dir ? fcum[128] : fcum[127];
    fw[tid] = __expf(ce - fcum[tid]) * fdt[tid];
    if ((tid & 127) == 0) WSF(OFF_TOT)[(dir * 64 + cidx) * 8 + hh] = __expf(ce);
  }
  __syncthreads();
#pragma unroll
  for (int i = 0; i < 4; ++i) {
    const int id = tid + 256 * i;
    const int pp = id >> 4, jc = (id & 15) * 8;
    const uint4 raw = *(const uint4*)(WSB(OFF_XST) + (size_t)(hh * 64 + pp) * 8192 + r0 + jc);
    const unsigned rw[4] = {raw.x, raw.y, raw.z, raw.w};
    unsigned of[4], ob[4];
#pragma unroll
    for (int q = 0; q < 4; ++q) {
      const float x0 = __uint_as_float(rw[q] << 16), x1 = __uint_as_float(rw[q] & 0xffff0000u);
      of[q] = pack2(x0 * fw[jc + 2 * q], x1 * fw[jc + 2 * q + 1]);
      ob[q] = pack2(x0 * fw[128 + jc + 2 * q], x1 * fw[128 + jc + 2 * q + 1]);
    }
    *(uint4*)(sAs + pp * LDS_ + jc) = make_uint4(of[0], of[1], of[2], of[3]);
    *(uint4*)(sAs + 64 * LDS_ + pp * LDS_ + jc) = make_uint4(ob[0], ob[1], ob[2], ob[3]);
  }
#pragma unroll
  for (int i = 0; i < 8; ++i) {
    const int id = tid + 256 * i;
    const int nn = id >> 4, jc = (id & 15) * 8;
    *(uint4*)(sBs + nn * LDS_ + jc) = *(const uint4*)(WSB(OFF_BT) + (size_t)(g * 128 + nn) * 8192 + r0 + jc);
  }
  __syncthreads();
  {
    const int dir = wave >> 1, nh = wave & 1;
    f32x4 acc[4][4];
#pragma unroll
    for (int i = 0; i < 4; ++i)
#pragma unroll
      for (int j = 0; j < 4; ++j) acc[i][j] = (f32x4){0.f, 0.f, 0.f, 0.f};
    const bf16_t* cA = sAs + dir * 64 * LDS_ + lr * LDS_ + lg * 8;
    const bf16_t* cB = sBs + (nh * 64 + lr) * LDS_ + lg * 8;
#pragma unroll 1
    for (int ks = 0; ks < 4; ++ks) {
      bf16x8 af[4], bfr[4];
#pragma unroll
      for (int i = 0; i < 4; ++i) {
        af[i] = *(const bf16x8*)(cA + i * 16 * LDS_ + ks * 32);
        bfr[i] = *(const bf16x8*)(cB + i * 16 * LDS_ + ks * 32);
      }
#pragma unroll
      for (int i = 0; i < 4; ++i)
#pragma unroll
        for (int j = 0; j < 4; ++j) acc[i][j] = mfma16(af[i], bfr[j], acc[i][j]);
    }
    float* S = WSF(OFF_R2) + ((size_t)(dir * 64 + cidx) * 8 + hh) * 8192 + (lg * 4) * 128 + nh * 64 + lr;
#pragma unroll
    for (int i = 0; i < 4; ++i) {
#pragma unroll
      for (int q = 0; q < 4; ++q) {
#pragma unroll
        for (int j = 0; j < 4; ++j) S[j * 16] = acc[i][j][q];
        S += 128;
      }
      S += 12 * 128;
      __builtin_amdgcn_sched_barrier(0);
    }
  }
  __syncthreads();
}

template <int NB>
DEVI void scan_group(const P& p, float4& h, int dir, int cb, int nc, int c0, int hh, size_t eoff) {
  float4 sv[NB];
  float d[NB];
  size_t base[NB];
#pragma unroll
  for (int k = 0; k < NB; ++k) {
    const int c = c0 + k;
    const int cidx = cb + (dir ? nc - 1 - c : c);
    base[k] = ((size_t)(dir * 64 + cidx) * 8 + hh) * 8192 + eoff;
    d[k] = WSF(OFF_TOT)[(dir * 64 + cidx) * 8 + hh];
    sv[k] = *(const float4*)(WSF(OFF_R2) + base[k]);
  }
#pragma unroll
  for (int k = 0; k < NB; ++k) {
    uint2 o;
    o.x = pack2(h.x, h.y);
    o.y = pack2(h.z, h.w);
    *(uint2*)(WSB(OFF_H) + base[k]) = o;
    h.x = d[k] * h.x + sv[k].x; h.y = d[k] * h.y + sv[k].y; h.z = d[k] * h.z + sv[k].z; h.w = d[k] * h.w + sv[k].w;
  }
}

NOINL void scan_states(const P& p) {
  const int total = 2 * 18 * 8 * 64 * 32;
  for (int idx = blockIdx.x * 512 + threadIdx.x; idx < total; idx += gridDim.x * 512) {
    const int n4 = idx & 31, pp = (idx >> 5) & 63, hh = (idx >> 11) & 7;
    const int sd = idx >> 14;
    const int s = sd % 18, dir = sd / 18;
    const int nc = s < 16 ? 2 : 16;
    const int cb = s < 16 ? s * 2 : 32 + (s - 16) * 16;
    float4 h = make_float4(0.f, 0.f, 0.f, 0.f);
    const size_t eoff = (size_t)pp * 128 + n4 * 4;
    if (s >= 16) {
      const float* st = (dir ? p.st_b : p.st_f) + ((size_t)((s - 16) * 8 + hh) * 64 + pp) * 128 + n4 * 4;
      h = *(const float4*)st;
      scan_group<8>(p, h, dir, cb, nc, 0, hh, eoff);
      scan_group<8>(p, h, dir, cb, nc, 8, hh, eoff);
    } else {
      scan_group<2>(p, h, dir, cb, nc, 0, hh, eoff);
      float* o = p.out + (dir ? OUT_SB : OUT_SF) + ((size_t)(s * 8 + hh) * 64 + pp) * 128 + n4 * 4;
      *(float4*)o = h;
    }
  }
}

NOINL void attn_item(const P& p, int id) {
  char* smem = g_smem + VB * 73728;
  const int tid = opaque_tid(), lane = tid & 63, wave = tid >> 6, lr = lane & 15, lg = lane >> 4;
  int row0, kvbase, Lk, hh;
  if (id < 512) { hh = id & 7; const int b = (id >> 3) & 1; const int qb = id >> 4; row0 = 4096 + b * 2048 + qb * 64; kvbase = 4096 + b * 2304; Lk = 2304; }
  else { const int i2 = id - 512; hh = i2 & 7; const int rest = i2 >> 3; const int b = rest >> 2; const int qb = rest & 3; row0 = b * 256 + qb * 64; kvbase = b * 256; Lk = 256; }
  constexpr int LDK = 104, LDV = 72;
  constexpr int KVBUF = 64 * LDK + 64 * LDV;
  bf16_t* sKV = (bf16_t*)smem;
  const int qrow = row0 + wave * 16 + lr;
  bf16x8 qf[3];
#pragma unroll
  for (int ks = 0; ks < 3; ++ks) qf[ks] = *(const bf16x8*)(WSB(OFF_Q) + (size_t)qrow * 768 + hh * 96 + ks * 32 + lg * 8);
  f32x4 oacc[4];
#pragma unroll
  for (int i = 0; i < 4; ++i) oacc[i] = (f32x4){0.f, 0.f, 0.f, 0.f};
  float mrun = -1e30f, lrun = 0.f;
  const int nkt = Lk >> 6;
  const int kkey0 = tid / 12, kcc0 = tid - kkey0 * 12;
  const int c1 = tid + 256, kkey1 = c1 / 12, kcc1 = c1 - kkey1 * 12;
  const int c2 = tid + 512, kkey2 = c2 / 12, kcc2 = c2 - kkey2 * 12;
  const bf16_t* kn = WSB(OFF_KN);
  const bf16_t* kp = WSB(OFF_KPE);
  const bf16_t* ksrc0 = (kcc0 < 8) ? kn + (size_t)(kvbase + kkey0) * 512 + hh * 64 + kcc0 * 8 : kp + (size_t)(kvbase + kkey0) * 32 + (kcc0 - 8) * 8;
  const bf16_t* ksrc1 = (kcc1 < 8) ? kn + (size_t)(kvbase + kkey1) * 512 + hh * 64 + kcc1 * 8 : kp + (size_t)(kvbase + kkey1) * 32 + (kcc1 - 8) * 8;
  const bf16_t* ksrc2 = (kcc2 < 8) ? kn + (size_t)(kvbase + kkey2) * 512 + hh * 64 + kcc2 * 8 : kp + (size_t)(kvbase + kkey2) * 32 + (kcc2 - 8) * 8;
  const int kst0 = (kcc0 < 8) ? 512 * 64 : 32 * 64, kst1 = (kcc1 < 8) ? 512 * 64 : 32 * 64, kst2 = (kcc2 < 8) ? 512 * 64 : 32 * 64;
  const int vd0 = tid >> 3, vcc = tid & 7;
  const bf16_t* vsrc0 = WSB(OFF_VT) + (size_t)(hh * 64 + vd0) * 8704 + kvbase + vcc * 8;
  const bf16_t* vsrc1 = vsrc0 + (size_t)32 * 8704;
  uint4 rk0, rk1, rk2, rv0, rv1;
#define AT_LOAD(kt) { const int _k = (kt); \
    rk0 = *(const uint4*)(ksrc0 + (size_t)_k * kst0); rk1 = *(const uint4*)(ksrc1 + (size_t)_k * kst1); \
    rk2 = *(const uint4*)(ksrc2 + (size_t)_k * kst2); \
    rv0 = *(const uint4*)(vsrc0 + _k * 64); rv1 = *(const uint4*)(vsrc1 + _k * 64); }
#define AT_WRITE(buf) { bf16_t* _b = sKV + (buf) * KVBUF; \
    *(uint4*)(_b + kkey0 * LDK + kcc0 * 8) = rk0; *(uint4*)(_b + kkey1 * LDK + kcc1 * 8) = rk1; \
    *(uint4*)(_b + kkey2 * LDK + kcc2 * 8) = rk2; \
    *(uint4*)(_b + 64 * LDK + vd0 * LDV + vcc * 8) = rv0; *(uint4*)(_b + 64 * LDK + (vd0 + 32) * LDV + vcc * 8) = rv1; }
  AT_LOAD(0)
  AT_WRITE(0)
  __syncthreads();
  for (int kt = 0; kt < nkt; ++kt) {
    const int ktn = min(kt + 1, nkt - 1);
    AT_LOAD(ktn)
#if ATPROBE == 5
    { uint4 d0 = *(const volatile uint4*)(ksrc0 + (size_t)ktn * kst0), d1 = *(const volatile uint4*)(ksrc1 + (size_t)ktn * kst1), d2 = *(const volatile uint4*)(ksrc2 + (size_t)ktn * kst2);
      uint4 d3 = *(const volatile uint4*)(vsrc0 + ktn * 64), d4 = *(const volatile uint4*)(vsrc1 + ktn * 64);
      asm volatile("" :: "v"(d0), "v"(d1), "v"(d2), "v"(d3), "v"(d4)); }
#endif
    const bf16_t* sK = sKV + (kt & 1) * KVBUF;
    const bf16_t* sV = sK + 64 * LDK;
    f32x4 sacc[4];
#pragma unroll
    for (int n = 0; n < 4; ++n) sacc[n] = (f32x4){0.f, 0.f, 0.f, 0.f};
#pragma unroll
    for (int ks = 0; ks < 3; ++ks)
#pragma unroll
      for (int n = 0; n < 4; ++n) {
        const bf16x8 a = *(const bf16x8*)(sK + (n * 16 + lr) * LDK + ks * 32 + lg * 8);
        sacc[n] = mfma16(a, qf[ks], sacc[n]);
      }
#if ATPROBE == 2
    {
      f32x4 dacc[4];
#pragma unroll
      for (int n = 0; n < 4; ++n) dacc[n] = (f32x4){0.f, 0.f, 0.f, 0.f};
#pragma unroll
      for (int ks = 0; ks < 3; ++ks)
#pragma unroll
        for (int n = 0; n < 4; ++n) {
          const bf16x8 a = *(const volatile bf16x8*)(sK + (n * 16 + lr) * LDK + ks * 32 + lg * 8);
          dacc[n] = mfma16(a, qf[ks], dacc[n]);
        }
#pragma unroll
      for (int n = 0; n < 4; ++n) asm volatile("" :: "v"(dacc[n]));
    }
#endif
    float mx = sacc[0][0];
#pragma unroll
    for (int n = 0; n < 4; ++n)
#pragma unroll
      for (int q = 0; q < 4; ++q) mx = fmaxf(mx, sacc[n][q]);
    mx = quad_max(mx);
    const float mnew = fmaxf(mrun, mx);
    const float alpha = __builtin_amdgcn_exp2f(mrun - mnew);
    mrun = mnew;
    float ps = 0.f;
#pragma unroll
    for (int n = 0; n < 4; ++n)
#pragma unroll
      for (int q = 0; q < 4; ++q) {
#if ATPROBE == 1
        { float e2 = __builtin_amdgcn_exp2f(sacc[n][q] - mrun); asm volatile("" :: "v"(e2)); }
#endif
        const float e = __builtin_amdgcn_exp2f(sacc[n][q] - mnew); sacc[n][q] = e; ps += e; }
    lrun = lrun * alpha + ps;
#pragma unroll
    for (int i = 0; i < 4; ++i)
#pragma unroll
      for (int q = 0; q < 4; ++q) oacc[i][q] *= alpha;
#pragma unroll
    for (int ks = 0; ks < 2; ++ks) {
      union { bf16x8 v; unsigned u[4]; } pf;
      pf.u[0] = pack2(sacc[2 * ks][0], sacc[2 * ks][1]);
      pf.u[1] = pack2(sacc[2 * ks][2], sacc[2 * ks][3]);
      pf.u[2] = pack2(sacc[2 * ks + 1][0], sacc[2 * ks + 1][1]);
      pf.u[3] = pack2(sacc[2 * ks + 1][2], sacc[2 * ks + 1][3]);
#pragma unroll
      for (int m = 0; m < 4; ++m) {
        union { bf16x8 v; uint2 h[2]; } av;
        const bf16_t* vp = sV + (m * 16 + lr) * LDV + ks * 32 + lg * 4;
        av.h[0] = *(const uint2*)(vp);
        av.h[1] = *(const uint2*)(vp + 16);
        oacc[m] = mfma16(av.v, pf.v, oacc[m]);
      }
    }
    __builtin_amdgcn_sched_barrier(0);
    AT_WRITE((kt + 1) & 1)
#if ATPROBE == 3
    AT_WRITE((kt + 1) & 1)
#endif
#if ATPROBE == 4
    __syncthreads();
#endif
    __syncthreads();
  }
  lrun = quad_sum(lrun);
  const float inv = 1.f / lrun;
#pragma unroll
  for (int m = 0; m < 4; ++m) {
    uint2 o;
    o.x = pack2(oacc[m][0] * inv, oacc[m][1] * inv);
    o.y = pack2(oacc[m][2] * inv, oacc[m][3] * inv);
    *(uint2*)(WSB(OFF_CAT) + (size_t)qrow * 1024 + hh * 64 + m * 16 + lg * 4) = o;
  }
}

NOINL void attn8_item(const P& p, int id) {
  int tid = threadIdx.x; asm volatile("" : "+v"(tid));
  const int lane = tid & 63, wave = tid >> 6, lr = lane & 15, lg = lane >> 4;
  int row0, kvbase, Lk, hh;
  if (id < 256) { hh = id & 7; const int b = (id >> 3) & 1; const int qb = id >> 4; row0 = 4096 + b * 2048 + qb * 128; kvbase = 4096 + b * 2304; Lk = 2304; }
  else { const int i2 = id - 256; hh = i2 & 7; const int rest = i2 >> 3; const int b = rest >> 1; const int qb = rest & 1; row0 = b * 256 + qb * 128; kvbase = b * 256; Lk = 256; }
  constexpr int LDK = 104, LDV = 136;
  constexpr int KVBUF = 128 * LDK + 64 * LDV;
  bf16_t* sKV = (bf16_t*)g_smem;
  const int qrow = row0 + wave * 16 + lr;
  bf16x8 qf[3];
#pragma unroll
  for (int ks = 0; ks < 3; ++ks) qf[ks] = *(const bf16x8*)(WSB(OFF_Q) + (size_t)qrow * 768 + hh * 96 + ks * 32 + lg * 8);
  f32x4 oacc[4];
#pragma unroll
  for (int i = 0; i < 4; ++i) oacc[i] = (f32x4){0.f, 0.f, 0.f, 0.f};
  float mrun = -1e30f, lrun = 0.f;
  const int nkt = Lk >> 7;
  const int kkey0 = tid / 12, kcc0 = tid - kkey0 * 12;
  const int c1 = tid + 512, kkey1 = c1 / 12, kcc1 = c1 - kkey1 * 12;
  const int c2 = tid + 1024, kkey2 = c2 / 12, kcc2 = c2 - kkey2 * 12;
  const bf16_t* kn = WSB(OFF_KN);
  const bf16_t* kp = WSB(OFF_KPE);
  const bf16_t* ksrc0 = (kcc0 < 8) ? kn + (size_t)(kvbase + kkey0) * 512 + hh * 64 + kcc0 * 8 : kp + (size_t)(kvbase + kkey0) * 32 + (kcc0 - 8) * 8;
  const bf16_t* ksrc1 = (kcc1 < 8) ? kn + (size_t)(kvbase + kkey1) * 512 + hh * 64 + kcc1 * 8 : kp + (size_t)(kvbase + kkey1) * 32 + (kcc1 - 8) * 8;
  const bf16_t* ksrc2 = (kcc2 < 8) ? kn + (size_t)(kvbase + kkey2) * 512 + hh * 64 + kcc2 * 8 : kp + (size_t)(kvbase + kkey2) * 32 + (kcc2 - 8) * 8;
  const int kst0 = (kcc0 < 8) ? 512 * 128 : 32 * 128, kst1 = (kcc1 < 8) ? 512 * 128 : 32 * 128, kst2 = (kcc2 < 8) ? 512 * 128 : 32 * 128;
  const int vd0 = tid >> 4, vcc = tid & 15;
  const bf16_t* vsrc0 = WSB(OFF_VT) + (size_t)(hh * 64 + vd0) * 8704 + kvbase + vcc * 8;
  const bf16_t* vsrc1 = vsrc0 + (size_t)32 * 8704;
  uint4 rk0, rk1, rk2, rv0, rv1;
#define A8_LOAD(kt) { const int _k = (kt); \
    rk0 = *(const uint4*)(ksrc0 + (size_t)_k * kst0); rk1 = *(const uint4*)(ksrc1 + (size_t)_k * kst1); \
    rk2 = *(const uint4*)(ksrc2 + (size_t)_k * kst2); \
    rv0 = *(const uint4*)(vsrc0 + _k * 128); rv1 = *(const uint4*)(vsrc1 + _k * 128); }
#define A8_WRITE(buf) { bf16_t* _b = sKV + (buf) * KVBUF; \
    *(uint4*)(_b + kkey0 * LDK + kcc0 * 8) = rk0; *(uint4*)(_b + kkey1 * LDK + kcc1 * 8) = rk1; \
    *(uint4*)(_b + kkey2 * LDK + kcc2 * 8) = rk2; \
    *(uint4*)(_b + 128 * LDK + vd0 * LDV + vcc * 8) = rv0; *(uint4*)(_b + 128 * LDK + (vd0 + 32) * LDV + vcc * 8) = rv1; }
  A8_LOAD(0)
  A8_WRITE(0)
  __syncthreads();
  for (int kt = 0; kt < nkt; ++kt) {
    const int ktn = min(kt + 1, nkt - 1);
    A8_LOAD(ktn)
    const bf16_t* sK = sKV + (kt & 1) * KVBUF;
    const bf16_t* sV = sK + 128 * LDK;
    f32x4 sacc[8];
#pragma unroll
    for (int n = 0; n < 8; ++n) sacc[n] = (f32x4){0.f, 0.f, 0.f, 0.f};
#pragma unroll
    for (int ks = 0; ks < 3; ++ks)
#pragma unroll
      for (int n = 0; n < 8; ++n) {
        const bf16x8 a = *(const bf16x8*)(sK + (n * 16 + lr) * LDK + ks * 32 + lg * 8);
        sacc[n] = mfma16(a, qf[ks], sacc[n]);
      }
    float mx = sacc[0][0];
#pragma unroll
    for (int n = 0; n < 8; ++n)
#pragma unroll
      for (int q = 0; q < 4; ++q) mx = fmaxf(mx, sacc[n][q]);
    mx = quad_max(mx);
    const float mnew = fmaxf(mrun, mx);
    const float alpha = __builtin_amdgcn_exp2f(mrun - mnew);
    mrun = mnew;
    float ps0 = 0.f, ps1 = 0.f;
#pragma unroll
    for (int n = 0; n < 8; n += 2)
#pragma unroll
      for (int q = 0; q < 4; ++q) {
        const float e0 = __builtin_amdgcn_exp2f(sacc[n][q] - mnew); sacc[n][q] = e0; ps0 += e0;
        const float e1 = __builtin_amdgcn_exp2f(sacc[n + 1][q] - mnew); sacc[n + 1][q] = e1; ps1 += e1;
      }
    lrun = lrun * alpha + (ps0 + ps1);
#pragma unroll
    for (int i = 0; i < 4; ++i)
#pragma unroll
      for (int q = 0; q < 4; ++q) oacc[i][q] *= alpha;
#pragma unroll
    for (int ks = 0; ks < 4; ++ks) {
      union { bf16x8 v; unsigned u[4]; } pf;
      pf.u[0] = pack2(sacc[2 * ks][0], sacc[2 * ks][1]);
      pf.u[1] = pack2(sacc[2 * ks][2], sacc[2 * ks][3]);
      pf.u[2] = pack2(sacc[2 * ks + 1][0], sacc[2 * ks + 1][1]);
      pf.u[3] = pack2(sacc[2 * ks + 1][2], sacc[2 * ks + 1][3]);
#pragma unroll
      for (int m = 0; m < 4; ++m) {
        union { bf16x8 v; uint2 h[2]; } av;
        const bf16_t* vp = sV + (m * 16 + lr) * LDV + ks * 32 + lg * 4;
        av.h[0] = *(const uint2*)(vp);
        av.h[1] = *(const uint2*)(vp + 16);
        oacc[m] = mfma16(av.v, pf.v, oacc[m]);
      }
    }
    __builtin_amdgcn_sched_barrier(0);
    A8_WRITE((kt + 1) & 1)
    __syncthreads();
  }
  lrun = quad_sum(lrun);
  const float inv = 1.f / lrun;
#pragma unroll
  for (int m = 0; m < 4; ++m) {
    uint2 o;
    o.x = pack2(oacc[m][0] * inv, oacc[m][1] * inv);
    o.y = pack2(oacc[m][2] * inv, oacc[m][3] * inv);
    *(uint2*)(WSB(OFF_CAT) + (size_t)qrow * 1024 + hh * 64 + m * 16 + lg * 4) = o;
  }
}

NOINL void ssd_y_item(const P& p, int item) {
  char* smem = g_smem + VB * 73728;
  const int tid = opaque_tid(), lane = tid & 63, wave = tid >> 6, lr = lane & 15, lg = lane >> 4;
  const int cidx = item >> 3, qt = (item >> 1) & 3, half = qt >> 1, g = item & 1;
  const int r0 = cidx * 128;
  const int hh = g * 4 + wave;
  constexpr int LDC = 136, LDM = 72;
  bf16_t* sC = (bf16_t*)smem;
  bf16_t* sB = sC + 64 * LDC;
  bf16_t* sM = sB + 64 * LDC + wave * 64 * LDM;
  float* rowss = (float*)((bf16_t*)smem + 2 * 64 * LDC + 4 * 64 * LDM);
  const float* cum = WSF(OFF_CUM);
  const float* dtv = WSF(OFF_DTV);
  const int srow = tid >> 4, scol = (tid & 15) * 8;
  uint4 pb0, pb1, pb2, pb3;
  {
    const bf16_t* cs = WSB(OFF_CM) + (size_t)(r0 + qt * 32 + srow) * 256 + g * 128 + scol;
    const bf16_t* bs = WSB(OFF_BM) + (size_t)(r0 + srow) * 256 + g * 128 + scol;
    const uint4 c0 = *(const uint4*)(cs), c1 = *(const uint4*)(cs + 16 * 256);
    const uint4 b0 = *(const uint4*)(bs), b1 = *(const uint4*)(bs + 16 * 256), b2 = *(const uint4*)(bs + 32 * 256), b3 = *(const uint4*)(bs + 48 * 256);
    pb0 = *(const uint4*)(bs + 64 * 256); pb1 = *(const uint4*)(bs + 80 * 256); pb2 = *(const uint4*)(bs + 96 * 256); pb3 = *(const uint4*)(bs + 112 * 256);
    bf16_t* wc = sC + srow * LDC + scol;
    bf16_t* wb = sB + srow * LDC + scol;
    *(uint4*)(wc) = c0; *(uint4*)(wc + 16 * LDC) = c1;
    *(uint4*)(wb) = b0; *(uint4*)(wb + 16 * LDC) = b1; *(uint4*)(wb + 32 * LDC) = b2; *(uint4*)(wb + 48 * LDC) = b3;
  }
  __syncthreads();
  f32x4 Y[2][4];
#pragma unroll
  for (int i = 0; i < 2; ++i)
#pragma unroll
    for (int j = 0; j < 4; ++j) Y[i][j] = (f32x4){0.f, 0.f, 0.f, 0.f};
#pragma unroll 1
  for (int jh = 0; jh < 2; ++jh) {
    if (jh == 1) {
      __syncthreads();
      bf16_t* wb = sB + srow * LDC + scol;
      *(uint4*)(wb) = pb0; *(uint4*)(wb + 16 * LDC) = pb1; *(uint4*)(wb + 32 * LDC) = pb2; *(uint4*)(wb + 48 * LDC) = pb3;
      __syncthreads();
    }
#pragma unroll 1
    for (int dir = 0; dir < 2; ++dir) {
      const bool use = dir == 0 ? (jh <= half) : (jh >= half);
      if (!use) continue;
      bf16x8 xf[2][4];
#pragma unroll
      for (int ks = 0; ks < 2; ++ks)
#pragma unroll
        for (int pt = 0; pt < 4; ++pt)
          xf[ks][pt] = *(const bf16x8*)(WSB(OFF_XST) + (size_t)(hh * 64 + pt * 16 + lr) * 8192 + r0 + jh * 64 + ks * 32 + lg * 8);
      float ci[2], cj[4][4], dj[4][4];
#pragma unroll
      for (int it = 0; it < 2; ++it) ci[it] = cum[((size_t)dir * 8192 + r0 + qt * 32 + it * 16 + lr) * 8 + hh];
#pragma unroll
      for (int jt = 0; jt < 4; ++jt)
#pragma unroll
        for (int q = 0; q < 4; ++q) {
          const size_t tj = (size_t)dir * 8192 + r0 + jh * 64 + jt * 16 + lg * 4 + q;
          cj[jt][q] = cum[tj * 8 + hh];
          dj[jt][q] = dtv[tj * 8 + hh];
        }
#pragma unroll
      for (int it = 0; it < 2; ++it) {
        f32x4 cb[4];
#pragma unroll
        for (int jt = 0; jt < 4; ++jt) cb[jt] = (f32x4){0.f, 0.f, 0.f, 0.f};
#pragma unroll
        for (int ks = 0; ks < 4; ++ks) {
          const bf16x8 b = *(const bf16x8*)(sC + (it * 16 + lr) * LDC + ks * 32 + lg * 8);
#pragma unroll
          for (int jt = 0; jt < 4; ++jt) {
            const bf16x8 a = *(const bf16x8*)(sB + (jt * 16 + lr) * LDC + ks * 32 + lg * 8);
            cb[jt] = mfma16(a, b, cb[jt]);
          }
        }
        const int ti = qt * 32 + it * 16 + lr;
#pragma unroll
        for (int jt = 0; jt < 4; ++jt) {
          float v[4];
#pragma unroll
          for (int q = 0; q < 4; ++q) {
            const int tj = jh * 64 + jt * 16 + lg * 4 + q;
            const bool ok = dir == 0 ? (tj <= ti) : (tj >= ti);
            v[q] = ok ? cb[jt][q] * __expf(ci[it] - cj[jt][q]) * dj[jt][q] : 0.f;
          }
          uint2 o;
          o.x = pack2(v[0], v[1]);
          o.y = pack2(v[2], v[3]);
          *(uint2*)(sM + (it * 16 + lr) * LDM + jt * 16 + lg * 4) = o;
        }
        __builtin_amdgcn_sched_barrier(0);
      }
      asm volatile("s_waitcnt lgkmcnt(0)" ::: "memory");
#pragma unroll
      for (int ks = 0; ks < 2; ++ks) {
        bf16x8 af[2];
#pragma unroll
        for (int it = 0; it < 2; ++it) af[it] = *(const bf16x8*)(sM + (it * 16 + lr) * LDM + ks * 32 + lg * 8);
#pragma unroll
        for (int it = 0; it < 2; ++it)
#pragma unroll
          for (int pt = 0; pt < 4; ++pt) Y[it][pt] = mfma16(af[it], xf[ks][pt], Y[it][pt]);
      }
      asm volatile("s_waitcnt lgkmcnt(0)" ::: "memory");
      __builtin_amdgcn_sched_barrier(0);
    }
  }
#pragma unroll 1
  for (int dir = 0; dir < 2; ++dir) {
    const bf16_t* hp = WSB(OFF_H) + ((size_t)(dir * 64 + cidx) * 8 + hh) * 8192;
    float ei[2][4];
#pragma unroll
    for (int it = 0; it < 2; ++it)
#pragma unroll
      for (int q = 0; q < 4; ++q)
        ei[it][q] = __expf(cum[((size_t)dir * 8192 + r0 + qt * 32 + it * 16 + lg * 4 + q) * 8 + hh]);
#pragma unroll
    for (int pt = 0; pt < 4; ++pt) {
      bf16x8 bfr[4];
#pragma unroll
      for (int ks = 0; ks < 4; ++ks) bfr[ks] = *(const bf16x8*)(hp + (size_t)(pt * 16 + lr) * 128 + ks * 32 + lg * 8);
      f32x4 T[2];
#pragma unroll
      for (int it = 0; it < 2; ++it) T[it] = (f32x4){0.f, 0.f, 0.f, 0.f};
#pragma unroll
      for (int ks = 0; ks < 4; ++ks)
#pragma unroll
        for (int it = 0; it < 2; ++it) {
          const bf16x8 a = *(const bf16x8*)(sC + (it * 16 + lr) * LDC + ks * 32 + lg * 8);
          T[it] = mfma16(a, bfr[ks], T[it]);
        }
#pragma unroll
      for (int it = 0; it < 2; ++it)
#pragma unroll
        for (int q = 0; q < 4; ++q) Y[it][pt][q] += ei[it][q] * T[it][q];
    }
    __builtin_amdgcn_sched_barrier(0);
  }
  const float dsk = p.ssd_d[hh];
  const bf16_t* proj = WSB(OFF_R1);
#pragma unroll
  for (int i = 0; i < 2; ++i) {
#pragma unroll
    for (int q = 0; q < 4; ++q) {
      const int il = i * 16 + lg * 4 + q;
      const size_t r = (size_t)r0 + qt * 32 + il;
      float ss = 0.f;
#pragma unroll
      for (int j = 0; j < 4; ++j) {
        const int ch = hh * 64 + j * 16 + lr;
        const float xs = bf2f(WSB(OFF_XS)[r * 512 + ch]);
        const float z = bf2f(proj[r * 2080 + 544 + ch]);
        const float y = (Y[i][j][q] + dsk * xs) * silu(z);
        Y[i][j][q] = y;
        ss += y * y;
      }
      ss += __shfl_xor(ss, 1, 64);
      ss += __shfl_xor(ss, 2, 64);
      ss += __shfl_xor(ss, 4, 64);
      ss += __shfl_xor(ss, 8, 64);
      if (lr == 0) rowss[wave * 64 + il] = ss;
    }
    __builtin_amdgcn_sched_barrier(0);
  }
  __syncthreads();
#pragma unroll
  for (int i = 0; i < 2; ++i) {
#pragma unroll
    for (int q = 0; q < 4; ++q) {
      const int il = i * 16 + lg * 4 + q;
      const size_t r = (size_t)r0 + qt * 32 + il;
      const float tot = rowss[il] + rowss[64 + il] + rowss[128 + il] + rowss[192 + il];
      const float rs = rsqrtf(tot * (1.f / 256.f) + 1e-6f);
#pragma unroll
      for (int j = 0; j < 4; ++j) {
        const int ch = hh * 64 + j * 16 + lr;
        WSB(OFF_CAT)[r * 1024 + 512 + ch] = f2bf(Y[i][j][q] * rs * p.ssd_norm[ch]);
      }
    }
    __builtin_amdgcn_sched_barrier(0);
  }
  __syncthreads();
}

template <int W2>
DEVI void pool_item(const bf16_t* __restrict__ h, bf16_t* __restrict__ dst, int r, int cc) {
  int s0, L;
  if (r < 4096) { s0 = r & ~255; L = 256; } else { s0 = 4096 + ((r - 4096) & ~2047); L = 2048; }
  const int t = r - s0;
  const int lo = max(t - W2, 0), hi = min(t + W2, L);
  uint4 v[2 * W2];
#pragma unroll
  for (int k = 0; k < 2 * W2; ++k) {
    const int u = min(max(t - W2 + k, 0), L - 1);
    v[k] = *(const uint4*)(h + (size_t)(s0 + u) * 1024 + cc);
  }
  float acc[8] = {0, 0, 0, 0, 0, 0, 0, 0};
#pragma unroll
  for (int k = 0; k < 2 * W2; ++k) {
    const int u = t - W2 + k;
    const float m = (u >= 0 && u < L) ? 1.f : 0.f;
    acc[0] += m * __uint_as_float(v[k].x << 16); acc[1] += m * __uint_as_float(v[k].x & 0xffff0000u);
    acc[2] += m * __uint_as_float(v[k].y << 16); acc[3] += m * __uint_as_float(v[k].y & 0xffff0000u);
    acc[4] += m * __uint_as_float(v[k].z << 16); acc[5] += m * __uint_as_float(v[k].z & 0xffff0000u);
    acc[6] += m * __uint_as_float(v[k].w << 16); acc[7] += m * __uint_as_float(v[k].w & 0xffff0000u);
  }
  const float inv = 1.f / (float)(hi - lo);
  const uint4 c = v[W2];
  uint4 o;
  o.x = pack2(acc[0] * inv - __uint_as_float(c.x << 16), acc[1] * inv - __uint_as_float(c.x & 0xffff0000u));
  o.y = pack2(acc[2] * inv - __uint_as_float(c.y << 16), acc[3] * inv - __uint_as_float(c.y & 0xffff0000u));
  o.z = pack2(acc[4] * inv - __uint_as_float(c.z << 16), acc[5] * inv - __uint_as_float(c.z & 0xffff0000u));
  o.w = pack2(acc[6] * inv - __uint_as_float(c.w << 16), acc[7] * inv - __uint_as_float(c.w & 0xffff0000u));
  *(uint4*)(dst + (size_t)r * 1024 + cc) = o;
}

NOINL void pool_phase(const P& p) {
  const bf16_t* h = WSB(OFF_H);
  bf16_t* dst = WSB(OFF_CAT);
  const int total = 8192 * 128;
  for (int idx = blockIdx.x * 512 + threadIdx.x; idx < total; idx += gridDim.x * 512) {
    const int c32 = idx & 31, rlo = (idx >> 5) & 1, gi = (idx >> 6) & 3, rhi = idx >> 8;
    const int r = rhi * 2 + rlo, cc = gi * 256 + c32 * 8;
    if (gi == 0) pool_item<1>(h, dst, r, cc);
    else if (gi == 1) pool_item<2>(h, dst, r, cc);
    else if (gi == 2) pool_item<4>(h, dst, r, cc);
    else pool_item<8>(h, dst, r, cc);
  }
}

NOINL void ph_gemm_proj(const P& p) {
  bf16_t* proj = WSB(OFF_R1);
  float* dtraw = WSF(OFF_DTRAW);
  const bf16_t* A = WSB(OFF_H);
  const bf16_t* B = WSB(OFF_WIN);
  auto epi_main = [&](int ctx, int row, int col, f32x4 v0, f32x4 v1) {
#pragma unroll
    for (int q = 0; q < 4; ++q) {
      proj[(size_t)(row + q) * 2080 + col] = f2bf(v0[q]);
      proj[(size_t)(row + q) * 2080 + col + 16] = f2bf(v1[q]);
    }
  };
  auto epi = [&](int ctx, int row, int col, f32x4 v0, f32x4 v1) {
#pragma unroll
    for (int q = 0; q < 4; ++q) {
      if (col < 2080) proj[(size_t)(row + q) * 2080 + col] = f2bf(v0[q]);
      else if (col < 2096) dtraw[(size_t)(row + q) * 16 + (col - 2080)] = v0[q];
      if (col + 16 < 2080) proj[(size_t)(row + q) * 2080 + col + 16] = f2bf(v1[q]);
      else if (col + 16 < 2096) dtraw[(size_t)(row + q) * 16 + (col + 16 - 2080)] = v1[q];
    }
  };
  gemm8_stream(256, 1024, 1024, 1024,
    [=](int t) {
      TileInfo r;
      int m, n; tile_mn(t, 32, 8, m, n);
      r.m0 = m * 256; r.n0 = n * 256; r.ctx = 0;
      r.a = A + (size_t)r.m0 * 1024; r.b = B + (size_t)r.n0 * 1024;
      return r;
    }, epi_main);
  gemm_stream(64, 1024, 1024, 1024, g_smem + VB * 73728,
    [=](int t) {
      TileInfo r;
      r.m0 = t * 128; r.n0 = 2048; r.ctx = 0;
      r.a = A + (size_t)r.m0 * 1024; r.b = B + (size_t)2048 * 1024;
      return r;
    }, epi);
}

NOINL void ph_gemm_f32out(const P& p, const bf16_t* A, int lda, const bf16_t* B, int ldb, int K, bf16_t* C, int N) {
  const int nN = N / 128;
  gemm_stream(64 * nN, lda, ldb, K, g_smem + VB * 73728,
    [=](int t) {
      TileInfo r;
      int m, n; tile_mn(t, 64, nN, m, n);
      r.m0 = m * 128; r.n0 = n * 128; r.ctx = 0;
      r.a = A + (size_t)r.m0 * lda; r.b = B + (size_t)r.n0 * ldb;
      return r;
    },
    [&](int ctx, int row, int col, f32x4 v0, f32x4 v1) {
#pragma unroll
      for (int q = 0; q < 4; ++q) {
        C[(size_t)(row + q) * N + col] = f2bf(v0[q]);
        C[(size_t)(row + q) * N + col + 16] = f2bf(v1[q]);
      }
    });
}

NOINL void ph_gemm8_splitk(const P& p, const bf16_t* A, int lda, const bf16_t* B, int ldb, int Khalf, bf16_t* C0, bf16_t* C1) {
  gemm8_stream(256, lda, ldb, Khalf,
    [=](int t) {
      TileInfo r;
      const int id = swz_tile(t, 256);
      const int ks = id >> 7, rem = id & 127;
      r.m0 = (rem >> 2) * 256; r.n0 = (rem & 3) * 256; r.ctx = ks;
      r.a = A + (size_t)r.m0 * lda + (size_t)ks * Khalf; r.b = B + (size_t)r.n0 * ldb + (size_t)ks * Khalf;
      return r;
    },
    [&](int ks, int row, int col, f32x4 v0, f32x4 v1) {
      bf16_t* C = ks ? C1 : C0;
#pragma unroll
      for (int q = 0; q < 4; ++q) {
        C[(size_t)(row + q) * 1024 + col] = f2bf(v0[q]);
        C[(size_t)(row + q) * 1024 + col + 16] = f2bf(v1[q]);
      }
    });
}

NOINL void ph_gemm_qkv(const P& p) {
  bf16_t* qo = WSB(OFF_Q);
  bf16_t* kn = WSB(OFF_KN);
  bf16_t* vt = WSB(OFF_VT);
  const bf16_t* Aq = WSB(OFF_CQN);
  const bf16_t* Bq = WSB(OFF_WUQ);
  const bf16_t* Ak = WSB(OFF_CKV);
  const bf16_t* Bk = WSB(OFF_WUKV);
  gemm_stream(384 + 544, 256, 256, 256, g_smem + VB * 73728,
    [=](int t) {
      TileInfo r;
      int m, n;
      if (t < 384) {
        tile_mn(t, 64, 6, m, n);
        r.m0 = m * 128; r.n0 = n * 128; r.ctx = 0;
        r.a = Aq + (size_t)r.m0 * 256; r.b = Bq + (size_t)r.n0 * 256;
      } else {
        tile_mn(t - 384, 68, 8, m, n);
        r.m0 = m * 128; r.n0 = n * 128; r.ctx = 1;
        r.a = Ak + (size_t)r.m0 * 256; r.b = Bk + (size_t)r.n0 * 256;
      }
      return r;
    },
    [&](int ctx, int row, int col, f32x4 v0, f32x4 v1) {
      if (ctx == 0) {
        const float scl = 0.10206207261596575f * 1.4426950408889634f;
        const int tn = col >> 4;
        const bool rope = ((tn % 6) == 4) && (row >= 4096);
        const int ii = col & 15;
        const float fr = rope_freq(ii & 7);
#pragma unroll
        for (int q = 0; q < 4; ++q) {
          float a = v0[q], b = v1[q];
          if (rope) {
            const int tt = (row + q - 4096) & 2047;
            const float pos = (ii < 8) ? (float)(tt >> 6) : (float)(tt & 63);
            const float ang = pos * fr;
            float cs, sn;
            fast_sincos(ang, sn, cs);
            const float x1 = a, x2 = b;
            a = x1 * cs - x2 * sn;
            b = x1 * sn + x2 * cs;
          }
          qo[(size_t)(row + q) * 768 + col] = f2bf(a * scl);
          qo[(size_t)(row + q) * 768 + col + 16] = f2bf(b * scl);
        }
      } else {
        const int hh = col >> 7, j = col & 127;
        if (j < 64) {
#pragma unroll
          for (int q = 0; q < 4; ++q) {
            kn[(size_t)(row + q) * 512 + hh * 64 + j] = f2bf(v0[q]);
            kn[(size_t)(row + q) * 512 + hh * 64 + j + 16] = f2bf(v1[q]);
          }
        } else {
          uint2 o0, o1;
          o0.x = pack2(v0[0], v0[1]); o0.y = pack2(v0[2], v0[3]);
          o1.x = pack2(v1[0], v1[1]); o1.y = pack2(v1[2], v1[3]);
          *(uint2*)(vt + (size_t)(hh * 64 + j - 64) * 8704 + row) = o0;
          *(uint2*)(vt + (size_t)(hh * 64 + j - 64 + 16) * 8704 + row) = o1;
        }
      }
    });
}

NOINL void ph_gemm_ffn_up(const P& p, int layer) {
  bf16_t* gu = WSB(OFF_R1);
  const bf16_t* A = WSB(OFF_H);
  const bf16_t* B = WSB(OFF_WGU) + (size_t)layer * 5632 * 1024;
  gemm8_stream(32 * 22, 1024, 1024, 1024,
    [=](int t) {
      TileInfo r;
      int m, n; tile_mn(t, 32, 22, m, n);
      r.m0 = m * 256; r.n0 = n * 256; r.ctx = 0;
      r.a = A + (size_t)r.m0 * 1024; r.b = B + (size_t)r.n0 * 1024;
      return r;
    },
    [&](int ctx, int row, int col, f32x4 v0, f32x4 v1) {
      const int oc = (col >> 5) * 16 + (col & 15);
#pragma unroll
      for (int q = 0; q < 4; ++q) gu[(size_t)(row + q) * 2816 + oc] = f2bf(silu(v0[q]) * v1[q]);
    });
}

NOINL void ph_gemm_pool(const P& p) {
  bf16_t* mix = WSB(OFF_R1);
  const bf16_t* A = WSB(OFF_H);
  const bf16_t* B = WSB(OFF_WPOOL);
  gemm_stream(512, 1024, 256, 256, g_smem + VB * 73728,
    [=](int t) {
      TileInfo r;
      const int id = swz_tile(t, 512);
      const int g = id >> 7, rem = id & 127;
      r.m0 = (rem >> 1) * 128; r.n0 = (rem & 1) * 128; r.ctx = g;
      r.a = A + (size_t)r.m0 * 1024 + g * 256; r.b = B + (size_t)g * 65536 + (size_t)r.n0 * 256;
      return r;
    },
    [&](int g, int row, int col, f32x4 v0, f32x4 v1) {
      const int c0 = g * 256 + col;
      const float s0 = p.pool_scale[c0], s1 = p.pool_scale[c0 + 16];
#pragma unroll
      for (int q = 0; q < 4; ++q) {
        mix[(size_t)(row + q) * 1024 + c0] = f2bf(v0[q] * s0);
        mix[(size_t)(row + q) * 1024 + c0 + 16] = f2bf(v1[q] * s1);
      }
    });
}


#define XB_TMO      128
#define XB_XCNT(j)  (256  + 64 * (j))
#define XB_XSUB(j)  (1280 + 64 * (j))
#define XB_XGEN(j)  (2304 + 64 * (j))
#define XB_TOP      3328
#define XB_TOPGEN   3392
#define XCD_BAR_WORDS 3456
#define XB_SPIN_CAP (1u << 22)
#define LAS __attribute__((address_space(3)))
DEVI unsigned xb_ld(unsigned* p) { return __hip_atomic_load(p, __ATOMIC_RELAXED, __HIP_MEMORY_SCOPE_AGENT); }
DEVI unsigned xb_add(unsigned* p, unsigned v) { return __hip_atomic_fetch_add(p, v, __ATOMIC_RELAXED, __HIP_MEMORY_SCOPE_AGENT); }
DEVI unsigned xb_xcc_id() { return (unsigned)__builtin_amdgcn_s_getreg((3 << 11) | 20) & 0xFu; }
#define XB_SPIN(cond, bar) do { unsigned _sp = 0; while (cond) { __builtin_amdgcn_s_sleep(1); \
    if ((++_sp & 255u) == 0u) { if (xb_ld(&(bar)[XB_TMO])) break; if (_sp > XB_SPIN_CAP) { atomicAdd(&(bar)[XB_TMO], 1u); break; } } } } while (0)
struct XcdBarrier { unsigned* bar; unsigned x; volatile LAS unsigned* st; };
DEVI XcdBarrier xcd_barrier_post(unsigned* bar, volatile LAS unsigned* st) {
  XcdBarrier b; b.bar = bar; b.x = xb_xcc_id(); b.st = st;
  if (threadIdx.x == 0) (void)xb_add(&bar[XB_XCNT(b.x)], 1u);
  return b;
}
DEVI void xcd_barrier_complete(unsigned* bar, unsigned x, unsigned& nloc, unsigned& nx) {
  const unsigned G = gridDim.x * gridDim.y * gridDim.z;
  unsigned sum, cnt, mine, sp = 0u;
  for (;;) {
    sum = 0u; cnt = 0u; mine = 0u;
#pragma unroll
    for (unsigned j = 0; j < 16; ++j) { const unsigned c = xb_ld(&bar[XB_XCNT(j)]); sum += c; cnt += (c > 0u) ? 1u : 0u; mine = (j == x) ? c : mine; }
    if (sum == G) break;
    __builtin_amdgcn_s_sleep(1);
    if ((++sp & 255u) == 0u) { if (xb_ld(&bar[XB_TMO])) break; if (sp > XB_SPIN_CAP) { atomicAdd(&bar[XB_TMO], 1u); break; } }
  }
  nloc = mine > 0u ? mine : 1u; nx = cnt > 0u ? cnt : 1u;
}
DEVI void xcd_barrier(const XcdBarrier& b) {
  asm volatile("s_waitcnt vmcnt(0)" ::: "memory");
  __syncthreads();
  if (threadIdx.x == 0) {
    unsigned* bar = b.bar;
    __builtin_amdgcn_s_waitcnt(0);
    unsigned nloc = b.st[0], nx = b.st[1];
    if (nloc == 0u) { xcd_barrier_complete(bar, b.x, nloc, nx); b.st[0] = nloc; b.st[1] = nx; }
    const unsigned old = xb_add(&bar[XB_XSUB(b.x)], 1u);
    const unsigned gen = old / nloc;
    if (old + 1u == (gen + 1u) * nloc) {
      __builtin_amdgcn_fence(__ATOMIC_RELEASE, "agent");
      asm volatile("s_waitcnt vmcnt(0)" ::: "memory");
      const unsigned og = xb_add(&bar[XB_TOP], 1u);
      const unsigned tg = og / nx;
      if (og + 1u == (tg + 1u) * nx) xb_add(&bar[XB_TOPGEN], 1u);
      else XB_SPIN(xb_ld(&bar[XB_TOPGEN]) == tg, bar);
      __builtin_amdgcn_fence(__ATOMIC_ACQUIRE, "agent");
      xb_add(&bar[XB_XGEN(b.x)], 1u);
      asm volatile("s_waitcnt vmcnt(0)" ::: "memory");
    } else {
      XB_SPIN(xb_ld(&bar[XB_XGEN(b.x)]) == gen, bar);
      __builtin_amdgcn_fence(__ATOMIC_ACQUIRE, "agent");
      asm volatile("s_waitcnt vmcnt(0)" ::: "memory");
    }
  }
  __syncthreads();
}

constexpr int NPHASE = 18;
#ifndef REPMASK
#define REPMASK 0
#endif
#ifndef ATPROBE
#define ATPROBE 0
#endif
#ifndef P6PROBE
#define P6PROBE 1
#endif
#ifndef PHMASK
#define PHMASK 0x3ffff
#endif
#define PH(n) if constexpr ((PHMASK >> (n)) & 1)

__global__ void __launch_bounds__(512, 2) mega(P p, int lo, int hi) {
  __shared__ uint4 xb_words;
  if (threadIdx.x == 0) xb_words = make_uint4(0u, 0u, 0u, 0u);
  __syncthreads();
  XcdBarrier xb = xcd_barrier_post((unsigned*)(p.ws + OFF_BAR), (volatile LAS unsigned*)&xb_words);
  if (lo < 0) cg::this_grid().sync();
  PH(0) if (lo <= 0 && 0 < hi) {
#if (REPMASK >> 0) & 1
    int nrep = 2; asm volatile("" : "+s"(nrep));
    for (int rep = 0; rep < nrep; ++rep) {
      if (rep) xcd_barrier(xb);
#else
    {
#endif
        for (int t0_ = blockIdx.x * 2; t0_ < 384 + 5200; t0_ += gridDim.x * 2) {
          const int t = min(t0_ + VB, 384 + 5200 - 1);
          if (t < 384) gemv_tile(p, t); else transpose_tile(p, t - 384);
        }
    }
  }
  if (lo <= 0 && 0 + 1 < hi) xcd_barrier(xb);
  PH(1) if (lo <= 1 && 1 < hi) {
#if (REPMASK >> 1) & 1
    int nrep = 2; asm volatile("" : "+s"(nrep));
    for (int rep = 0; rep < nrep; ++rep) {
      if (rep) xcd_barrier(xb);
#else
    {
#endif
        rowop<false, true, true, false, false>(p, nullptr, nullptr, nullptr, 0, p.n_pre_mix, 0, 1, 0, 0);
    }
  }
  if (lo <= 1 && 1 + 1 < hi) xcd_barrier(xb);
  PH(2) if (lo <= 2 && 2 < hi) {
#if (REPMASK >> 2) & 1
    int nrep = 2; asm volatile("" : "+s"(nrep));
    for (int rep = 0; rep < nrep; ++rep) {
      if (rep) xcd_barrier(xb);
#else
    {
#endif
        ph_gemm_proj(p);
    }
  }
  if (lo <= 2 && 2 + 1 < hi) xcd_barrier(xb);
  PH(3) if (lo <= 3 && 3 < hi) {
#if (REPMASK >> 3) & 1
    int nrep = 2; asm volatile("" : "+s"(nrep));
    for (int rep = 0; rep < nrep; ++rep) {
      if (rep) xcd_barrier(xb);
#else
    {
#endif
        prep_rows(p);
        prep_cache(p);
        for (int t0_ = VT_FIRST; t0_ < 2048; t0_ += gridDim.x * 2) conv_tile(p, min(t0_ + VT_OFF, 2047));
    }
  }
  if (lo <= 3 && 3 + 1 < hi) xcd_barrier(xb);
  PH(4) if (lo <= 4 && 4 < hi) {
#if (REPMASK >> 4) & 1
    int nrep = 2; asm volatile("" : "+s"(nrep));
    for (int rep = 0; rep < nrep; ++rep) {
      if (rep) xcd_barrier(xb);
#else
    {
#endif
        ph_gemm_qkv(p);
        for (int t0_ = VT_FIRST; t0_ < 512; t0_ += gridDim.x * 2) chunk_state_item(p, min(t0_ + VT_OFF, 511));
    }
  }
  if (lo <= 4 && 4 + 1 < hi) xcd_barrier(xb);
  PH(5) if (lo <= 5 && 5 < hi) {
#if (REPMASK >> 5) & 1
    int nrep = 2; asm volatile("" : "+s"(nrep));
    for (int rep = 0; rep < nrep; ++rep) {
      if (rep) xcd_barrier(xb);
#else
    {
#endif
        scan_states(p);
    }
  }
  if (lo <= 5 && 5 + 1 < hi) xcd_barrier(xb);
  PH(6) if (lo <= 6 && 6 < hi) {
#if (REPMASK >> 6) & 1
    int nrep = 2; asm volatile("" : "+s"(nrep));
    for (int rep = 0; rep < nrep; ++rep) {
      if (rep) xcd_barrier(xb);
#else
    {
#endif
        for (int t = blockIdx.x; t < 512; t += gridDim.x) attn8_item(p, t);
        for (int t0_ = VT_FIRST; t0_ < 512; t0_ += gridDim.x * 2) ssd_y_item(p, min(t0_ + VT_OFF, 511));
    }
  }
  if (lo <= 6 && 6 + 1 < hi) xcd_barrier(xb);
  PH(7) if (lo <= 7 && 7 < hi) {
#if (REPMASK >> 7) & 1
    int nrep = 2; asm volatile("" : "+s"(nrep));
    for (int rep = 0; rep < nrep; ++rep) {
      if (rep) xcd_barrier(xb);
#else
    {
#endif
        ph_gemm8_splitk(p, WSB(OFF_CAT), 1024, WSB(OFF_WOUT), 1024, 512, WSB(OFF_R1), WSB(OFF_R1) + (size_t)8192 * 1024);
    }
  }
  if (lo <= 7 && 7 + 1 < hi) xcd_barrier(xb);
  PH(8) if (lo <= 8 && 8 < hi) {
#if (REPMASK >> 8) & 1
    int nrep = 2; asm volatile("" : "+s"(nrep));
    for (int rep = 0; rep < nrep; ++rep) {
      if (rep) xcd_barrier(xb);
#else
    {
#endif
        rowop<true, true, true, false, true>(p, WSB(OFF_R1), WSB(OFF_R1) + (size_t)8192 * 1024, p.n_post_mix, 2, p.n_pre_ffn, 3, 4, 0, 0);
    }
  }
  if (lo <= 8 && 8 + 1 < hi) xcd_barrier(xb);
  PH(9) if (lo <= 9 && 9 < hi) {
#if (REPMASK >> 9) & 1
    int nrep = 2; asm volatile("" : "+s"(nrep));
    for (int rep = 0; rep < nrep; ++rep) {
      if (rep) xcd_barrier(xb);
#else
    {
#endif
        ph_gemm_ffn_up(p, 0);
    }
  }
  if (lo <= 9 && 9 + 1 < hi) xcd_barrier(xb);
  PH(10) if (lo <= 10 && 10 < hi) {
#if (REPMASK >> 10) & 1
    int nrep = 2; asm volatile("" : "+s"(nrep));
    for (int rep = 0; rep < nrep; ++rep) {
      if (rep) xcd_barrier(xb);
#else
    {
#endif
        ph_gemm8_splitk(p, WSB(OFF_R1), 2816, WSB(OFF_WDN), 2816, 1408, WSB(OFF_R2), WSB(OFF_R2) + (size_t)8192 * 1024);
    }
  }
  if (lo <= 10 && 10 + 1 < hi) xcd_barrier(xb);
  PH(11) if (lo <= 11 && 11 < hi) {
#if (REPMASK >> 11) & 1
    int nrep = 2; asm volatile("" : "+s"(nrep));
    for (int rep = 0; rep < nrep; ++rep) {
      if (rep) xcd_barrier(xb);
#else
    {
#endif
        rowop<true, true, false, false, true>(p, WSB(OFF_R2), WSB(OFF_R2) + (size_t)8192 * 1024, p.n_post_ffn, 5, p.n_pre_mix + 1024, 0, 1, 0, 1);
    }
  }
  if (lo <= 11 && 11 + 1 < hi) xcd_barrier(xb);
  PH(12) if (lo <= 12 && 12 < hi) {
#if (REPMASK >> 12) & 1
    int nrep = 2; asm volatile("" : "+s"(nrep));
    for (int rep = 0; rep < nrep; ++rep) {
      if (rep) xcd_barrier(xb);
#else
    {
#endif
    }
  }
  PH(13) if (lo <= 13 && 13 < hi) {
#if (REPMASK >> 13) & 1
    int nrep = 2; asm volatile("" : "+s"(nrep));
    for (int rep = 0; rep < nrep; ++rep) {
      if (rep) xcd_barrier(xb);
#else
    {
#endif
        ph_gemm_pool(p);
    }
  }
  if (lo <= 13 && 13 + 1 < hi) xcd_barrier(xb);
  PH(14) if (lo <= 14 && 14 < hi) {
#if (REPMASK >> 14) & 1
    int nrep = 2; asm volatile("" : "+s"(nrep));
    for (int rep = 0; rep < nrep; ++rep) {
      if (rep) xcd_barrier(xb);
#else
    {
#endif
        rowop<true, true, false, false, false, true>(p, WSB(OFF_R1), nullptr, p.n_post_mix + 1024, 2, p.n_pre_ffn + 1024, 3, 4, 1, 1);
    }
  }
  if (lo <= 14 && 14 + 1 < hi) xcd_barrier(xb);
  PH(15) if (lo <= 15 && 15 < hi) {
#if (REPMASK >> 15) & 1
    int nrep = 2; asm volatile("" : "+s"(nrep));
    for (int rep = 0; rep < nrep; ++rep) {
      if (rep) xcd_barrier(xb);
#else
    {
#endif
        ph_gemm_ffn_up(p, 1);
    }
  }
  if (lo <= 15 && 15 + 1 < hi) xcd_barrier(xb);
  PH(16) if (lo <= 16 && 16 < hi) {
#if (REPMASK >> 16) & 1
    int nrep = 2; asm volatile("" : "+s"(nrep));
    for (int rep = 0; rep < nrep; ++rep) {
      if (rep) xcd_barrier(xb);
#else
    {
#endif
        ph_gemm8_splitk(p, WSB(OFF_R1), 2816, WSB(OFF_WDN) + (size_t)1024 * 2816, 2816, 1408, WSB(OFF_R2), WSB(OFF_R2) + (size_t)8192 * 1024);
    }
  }
  if (lo <= 16 && 16 + 1 < hi) xcd_barrier(xb);
  PH(17) if (lo <= 17 && 17 < hi) {
#if (REPMASK >> 17) & 1
    int nrep = 2; asm volatile("" : "+s"(nrep));
    for (int rep = 0; rep < nrep; ++rep) {
      if (rep) xcd_barrier(xb);
#else
    {
#endif
        rowop<true, false, false, true, true>(p, WSB(OFF_R2), WSB(OFF_R2) + (size_t)8192 * 1024, p.n_post_ffn + 1024, 5, nullptr, 0, 0, 1, 1);
    }
  }
}

extern "C" void kernel_launch(void* const* d_in, const int* in_sizes, int n_in, void* d_out, int out_size, void* d_ws,
                              size_t ws_size, hipStream_t stream) {
  P p{};
  const float** f = (const float**)&p;
  for (int i = 0; i < 33; ++i) f[i] = (const float*)d_in[i];
  p.out = (float*)d_out;
  p.ws = (char*)d_ws;
  static int grid_blocks = 0;
  if (!grid_blocks) {
    int dev = 0, cus = 0, per_cu = 0;
    hipGetDevice(&dev);
    hipDeviceGetAttribute(&cus, hipDeviceAttributeMultiprocessorCount, dev);
    hipOccupancyMaxActiveBlocksPerMultiprocessor(&per_cu, mega, 512, 0);
    if (per_cu > 1) per_cu = 1;
    if (per_cu < 1) per_cu = 1;
    grid_blocks = cus * per_cu;
  }
  hipMemsetAsync((char*)d_ws + OFF_BAR, 0, XCD_BAR_WORDS * 4, stream);
#if SINGLE_LAUNCH
  int lo = 0, hi = NPHASE;
  void* args[] = {&p, &lo, &hi};
  hipError_t e = hipLaunchCooperativeKernel((void*)mega, dim3(grid_blocks), dim3(512), args, 0, stream);
  if (e != hipSuccess) fprintf(stderr, "cooperative launch failed: %s (grid %d)\n", hipGetErrorString(e), grid_blocks);
#else
  for (int ph = 0; ph < NPHASE; ++ph) mega<<<grid_blocks, 512, 0, stream>>>(p, ph, ph + 1);
#endif
}
```

```cpp
#include <hip/hip_runtime.h>
#include <hip/hip_cooperative_groups.h>
#include <stdint.h>
#include <stdio.h>
namespace cg = cooperative_groups;

#ifndef SINGLE_LAUNCH
#define SINGLE_LAUNCH 1
#endif

typedef __attribute__((ext_vector_type(8))) short bf16x8;
typedef __attribute__((ext_vector_type(4))) float f32x4;
typedef unsigned short bf16_t;

#define DEVI __device__ __forceinline__

constexpr size_t OFF_WIN   = 0;
constexpr size_t OFF_WUQ   = OFF_WIN   + (size_t)2176*1024*2;
constexpr size_t OFF_WUKV  = OFF_WUQ   + (size_t)768*256*2;
constexpr size_t OFF_WOUT  = OFF_WUKV  + (size_t)1024*256*2;
constexpr size_t OFF_WPOOL = OFF_WOUT  + (size_t)1024*1024*2;
constexpr size_t OFF_WGU   = OFF_WPOOL + (size_t)4*256*256*2;
constexpr size_t OFF_WDN   = OFF_WGU   + (size_t)2*5632*1024*2;
constexpr size_t OFF_MOD   = OFF_WDN   + (size_t)2*1024*2816*2;
constexpr size_t OFF_R1    = OFF_MOD   + (size_t)2*3*6144*4;
constexpr size_t OFF_DTRAW = OFF_R1    + (size_t)8192*2080*2;
constexpr size_t OFF_R2    = OFF_R1    + (size_t)8192*2096*4;
constexpr size_t OFF_H     = OFF_R2    + (size_t)8192*1024*4;
constexpr size_t OFF_CAT   = OFF_H     + (size_t)8192*1024*2;
constexpr size_t OFF_Q     = OFF_CAT   + (size_t)8192*1024*2;
constexpr size_t OFF_KN    = OFF_Q     + (size_t)8192*768*2;
constexpr size_t OFF_VT    = OFF_KN    + (size_t)8704*512*2;
constexpr size_t OFF_CQN   = OFF_VT    + (size_t)8704*512*2;
constexpr size_t OFF_CKV   = OFF_CQN   + (size_t)8192*256*2;
constexpr size_t OFF_KPE   = OFF_CKV   + (size_t)8704*256*2;
constexpr size_t OFF_XS    = OFF_KPE   + (size_t)8704*32*2;
constexpr size_t OFF_XST   = OFF_XS    + (size_t)8192*512*2;
constexpr size_t OFF_BM    = OFF_XST   + (size_t)8192*512*2;
constexpr size_t OFF_BT    = OFF_BM    + (size_t)8192*256*2;
constexpr size_t OFF_CM    = OFF_BT    + (size_t)8192*256*2;
constexpr size_t OFF_DTV   = OFF_CM    + (size_t)8192*256*2;
constexpr size_t OFF_CUM   = OFF_DTV   + (size_t)2*8192*8*4;
constexpr size_t OFF_TOT   = OFF_CUM   + (size_t)2*8192*8*4;
constexpr size_t OFF_BAR   = OFF_TOT   + 4096;
constexpr size_t OFF_XR    = OFF_BAR   + 16384;
constexpr size_t OFF_END   = OFF_XR    + (size_t)8192*1024*2;
static_assert(OFF_END <= ((size_t)256 << 20), "workspace map exceeds 256 MiB");

constexpr size_t OUT_CKV = 8388608, OUT_KR = 9437184, OUT_SF = 9568256, OUT_SB = 10616832;

struct P {
  const float *x_prompt, *x_sample, *c, *cache_ckv, *cache_kr, *st_f, *st_b, *c_ctx;
  const float *w_mod, *b_mod, *n_pre_mix, *n_post_mix, *n_pre_ffn, *n_post_ffn;
  const float *w_in, *q_norm, *w_uq, *kv_norm, *w_ukv, *conv_w, *conv_b, *dtb_f, *dtb_b, *alog_f, *alog_b;
  const float *ssd_d, *ssd_norm, *w_out, *pool_w, *pool_scale, *w_gate, *w_up, *w_down;
  float* out;
  char* ws;
};

#define WSB(off) ((bf16_t*)(p.ws + (off)))
#define WSF(off) ((float*)(p.ws + (off)))

typedef __bf16 hwbf16x2 __attribute__((ext_vector_type(2)));
typedef float hwf32x2 __attribute__((ext_vector_type(2)));
DEVI bf16_t f2bf(float f) {
  __bf16 r = (__bf16)f;
  return __builtin_bit_cast(bf16_t, r);
}
DEVI float bf2f(bf16_t b) { return __uint_as_float(((unsigned)b) << 16); }
DEVI unsigned pack2(float a, float b) {
  hwf32x2 v = {a, b};
  hwbf16x2 r = __builtin_convertvector(v, hwbf16x2);
  return __builtin_bit_cast(unsigned, r);
}
DEVI float silu(float x) { return x / (1.f + __expf(-x)); }
DEVI float wave_sum(float v) {
#pragma unroll
  for (int o = 32; o > 0; o >>= 1) v += __shfl_xor(v, o, 64);
  return v;
}
DEVI f32x4 mfma16(bf16x8 a, bf16x8 b, f32x4 c) { return __builtin_amdgcn_mfma_f32_16x16x32_bf16(a, b, c, 0, 0, 0); }

DEVI float rope_freq(int m) { return exp2f(-(float)m * 1.6609640474436813f); }
DEVI void fast_sincos(float ang, float& sn, float& cs) {
  float rev = ang * 0.15915494309189535f;
  rev -= rintf(rev);
  sn = __builtin_amdgcn_sinf(rev);
  cs = __builtin_amdgcn_cosf(rev);
}
typedef unsigned hwu32x2 __attribute__((ext_vector_type(2)));
DEVI float quad_max(float x) {
  hwu32x2 r = __builtin_amdgcn_permlane16_swap(__float_as_uint(x), __float_as_uint(x), false, false);
  x = fmaxf(__uint_as_float(r[0]), __uint_as_float(r[1]));
  r = __builtin_amdgcn_permlane32_swap(__float_as_uint(x), __float_as_uint(x), false, false);
  return fmaxf(__uint_as_float(r[0]), __uint_as_float(r[1]));
}
DEVI float quad_sum(float x) {
  hwu32x2 r = __builtin_amdgcn_permlane16_swap(__float_as_uint(x), __float_as_uint(x), false, false);
  x = __uint_as_float(r[0]) + __uint_as_float(r[1]);
  r = __builtin_amdgcn_permlane32_swap(__float_as_uint(x), __float_as_uint(x), false, false);
  return __uint_as_float(r[0]) + __uint_as_float(r[1]);
}
#define VB ((int)(threadIdx.x >> 8))
#define VT_PAIRG (gridDim.x == 256u)
#define VT_FIRST ((int)(VT_PAIRG ? blockIdx.x : blockIdx.x * 2u))
#define VT_OFF ((int)(VT_PAIRG ? VB * gridDim.x : VB))
DEVI int opaque_tid() { int t = threadIdx.x & 255; asm volatile("" : "+v"(t)); return t; }
typedef float nt_f4 __attribute__((ext_vector_type(4)));
typedef unsigned nt_u2 __attribute__((ext_vector_type(2)));
DEVI float4 ld_nt_f4(const float* p) { const nt_f4 v = __builtin_nontemporal_load((const nt_f4*)p); return make_float4(v[0], v[1], v[2], v[3]); }
DEVI uint2 ld_nt_u2(const bf16_t* p) { const nt_u2 v = __builtin_nontemporal_load((const nt_u2*)p); return make_uint2(v[0], v[1]); }
DEVI int swz_tile(int t, int T) {
  int q = T >> 3, r = T & 7, x = t & 7, off = t >> 3;
  return (x < r ? x * (q + 1) : r * (q + 1) + (x - r) * q) + off;
}

__shared__ __attribute__((aligned(16))) char g_smem[2 * 73728];
#define NOINL __device__ __forceinline__

constexpr int LDT = 72;
constexpr int TILE_E = 128 * LDT;

template <class Epi>
DEVI void gemm_tile(const bf16_t* __restrict__ A, int lda, const bf16_t* __restrict__ B, int ldb, int K,
                    int m0, int n0, char* smem, Epi epi) {
  const int tid = opaque_tid(), lane = tid & 63, wave = tid >> 6, wm = wave >> 1, wn = wave & 1;
  const int lr = lane & 15, lg = lane >> 4;
  bf16_t* sA = (bf16_t*)smem;
  bf16_t* sB = sA + 2 * TILE_E;
  f32x4 acc[4][4];
#pragma unroll
  for (int i = 0; i < 4; ++i)
#pragma unroll
    for (int j = 0; j < 4; ++j) acc[i][j] = (f32x4){0.f, 0.f, 0.f, 0.f};
  const int lrow = tid >> 3, lkc = (tid & 7) * 8;
  const bf16_t* gA = A + (size_t)(m0 + lrow) * lda + lkc;
  const bf16_t* gB = B + (size_t)(n0 + lrow) * ldb + lkc;
  uint4 ra[4], rb[4];
#pragma unroll
  for (int i = 0; i < 4; ++i) {
    ra[i] = *(const uint4*)(gA + (size_t)(32 * i) * lda);
    rb[i] = *(const uint4*)(gB + (size_t)(32 * i) * ldb);
  }
#pragma unroll
  for (int i = 0; i < 4; ++i) {
    *(uint4*)(sA + (lrow + 32 * i) * LDT + lkc) = ra[i];
    *(uint4*)(sB + (lrow + 32 * i) * LDT + lkc) = rb[i];
  }
  __syncthreads();
  const int nk = K >> 6;
  for (int kt = 0; kt < nk; ++kt) {
    const int cur = kt & 1;
    if (kt + 1 < nk) {
      const int k0 = (kt + 1) << 6;
#pragma unroll
      for (int i = 0; i < 4; ++i) {
        ra[i] = *(const uint4*)(gA + (size_t)(32 * i) * lda + k0);
        rb[i] = *(const uint4*)(gB + (size_t)(32 * i) * ldb + k0);
      }
    }
    const bf16_t* cA = sA + cur * TILE_E + (wm * 64 + lr) * LDT + lg * 8;
    const bf16_t* cB = sB + cur * TILE_E + (wn * 64 + lr) * LDT + lg * 8;
#pragma unroll
    for (int ks = 0; ks < 2; ++ks) {
      bf16x8 af[4], bfr[4];
#pragma unroll
      for (int i = 0; i < 4; ++i) {
        af[i] = *(const bf16x8*)(cA + i * 16 * LDT + ks * 32);
        bfr[i] = *(const bf16x8*)(cB + i * 16 * LDT + ks * 32);
      }
#pragma unroll
      for (int i = 0; i < 4; ++i)
#pragma unroll
        for (int j = 0; j < 4; ++j) acc[i][j] = mfma16(af[i], bfr[j], acc[i][j]);
    }
    if (kt + 1 < nk) {
      const int nx = cur ^ 1;
#pragma unroll
      for (int i = 0; i < 4; ++i) {
        *(uint4*)(sA + nx * TILE_E + (lrow + 32 * i) * LDT + lkc) = ra[i];
        *(uint4*)(sB + nx * TILE_E + (lrow + 32 * i) * LDT + lkc) = rb[i];
      }
    }
    __syncthreads();
  }
#pragma unroll
  for (int i = 0; i < 4; ++i)
#pragma unroll
    for (int j = 0; j < 4; j += 2)
      epi(m0 + wm * 64 + i * 16 + lg * 4, n0 + wn * 64 + j * 16 + lr, acc[i][j], acc[i][j + 1]);
}

struct TileInfo { const bf16_t* a; const bf16_t* b; int m0, n0, ctx; };
template <class TileFn, class Epi>
DEVI void gemm_stream(int T, int lda, int ldb, int K, char* smem, TileFn tf, Epi epi) {
  int t0 = VT_FIRST;
  if (t0 >= T) return;
  int t = min(t0 + VT_OFF, T - 1);
  const int tid = opaque_tid(), lane = tid & 63, wave = tid >> 6, wm = wave >> 1, wn = wave & 1;
  const int lr = lane & 15, lg = lane >> 4;
  bf16_t* sA = (bf16_t*)smem;
  bf16_t* sB = sA + 2 * TILE_E;
  const int lrow = tid >> 3, lkc = (tid & 7) * 8;
  TileInfo ti = tf(t);
  const bf16_t* gA = ti.a + (size_t)lrow * lda + lkc;
  const bf16_t* gB = ti.b + (size_t)lrow * ldb + lkc;
  int m0 = ti.m0, n0 = ti.n0, ctx = ti.ctx;
  uint4 ra0, ra1, ra2, ra3, rb0, rb1, rb2, rb3;
  uint4 rc0, rc1, rc2, rc3, rd0, rd1, rd2, rd3;
#define GS_LOAD0(pa, pb) \
  ra0 = *(const uint4*)((pa)); ra1 = *(const uint4*)((pa) + (size_t)32 * lda); \
  ra2 = *(const uint4*)((pa) + (size_t)64 * lda); ra3 = *(const uint4*)((pa) + (size_t)96 * lda); \
  rb0 = *(const uint4*)((pb)); rb1 = *(const uint4*)((pb) + (size_t)32 * ldb); \
  rb2 = *(const uint4*)((pb) + (size_t)64 * ldb); rb3 = *(const uint4*)((pb) + (size_t)96 * ldb);
#define GS_LOAD1(pa, pb) \
  rc0 = *(const uint4*)((pa)); rc1 = *(const uint4*)((pa) + (size_t)32 * lda); \
  rc2 = *(const uint4*)((pa) + (size_t)64 * lda); rc3 = *(const uint4*)((pa) + (size_t)96 * lda); \
  rd0 = *(const uint4*)((pb)); rd1 = *(const uint4*)((pb) + (size_t)32 * ldb); \
  rd2 = *(const uint4*)((pb) + (size_t)64 * ldb); rd3 = *(const uint4*)((pb) + (size_t)96 * ldb);
#define GS_WRITE0(buf) { \
  bf16_t* wa = sA + (buf) * TILE_E + lrow * LDT + lkc; bf16_t* wb = sB + (buf) * TILE_E + lrow * LDT + lkc; \
  *(uint4*)(wa) = ra0; *(uint4*)(wa + 32 * LDT) = ra1; *(uint4*)(wa + 64 * LDT) = ra2; *(uint4*)(wa + 96 * LDT) = ra3; \
  *(uint4*)(wb) = rb0; *(uint4*)(wb + 32 * LDT) = rb1; *(uint4*)(wb + 64 * LDT) = rb2; *(uint4*)(wb + 96 * LDT) = rb3; }
#define GS_WRITE1(buf) { \
  bf16_t* wa = sA + (buf) * TILE_E + lrow * LDT + lkc; bf16_t* wb = sB + (buf) * TILE_E + lrow * LDT + lkc; \
  *(uint4*)(wa) = rc0; *(uint4*)(wa + 32 * LDT) = rc1; *(uint4*)(wa + 64 * LDT) = rc2; *(uint4*)(wa + 96 * LDT) = rc3; \
  *(uint4*)(wb) = rd0; *(uint4*)(wb + 32 * LDT) = rd1; *(uint4*)(wb + 64 * LDT) = rd2; *(uint4*)(wb + 96 * LDT) = rd3; }
#define GS_COMPUTE(buf) { \
    const bf16_t* cA = sA + (buf) * TILE_E + (wm * 64 + lr) * LDT + lg * 8; \
    const bf16_t* cB = sB + (buf) * TILE_E + (wn * 64 + lr) * LDT + lg * 8; \
    _Pragma("unroll") for (int ks = 0; ks < 2; ++ks) { \
      bf16x8 af[4], bfr[4]; \
      _Pragma("unroll") for (int i = 0; i < 4; ++i) { \
        af[i] = *(const bf16x8*)(cA + i * 16 * LDT + ks * 32); \
        bfr[i] = *(const bf16x8*)(cB + i * 16 * LDT + ks * 32); \
      } \
      __builtin_amdgcn_s_setprio(1); \
      _Pragma("unroll") for (int i = 0; i < 4; ++i) \
        _Pragma("unroll") for (int j = 0; j < 4; ++j) acc[i][j] = mfma16(af[i], bfr[j], acc[i][j]); \
      __builtin_amdgcn_s_setprio(0); \
    } }
  GS_LOAD0(gA, gB)
  GS_WRITE0(0)
  GS_LOAD1(gA + 64, gB + 64)
  __syncthreads();
  const int nk = K >> 6;
  for (;;) {
    f32x4 acc[4][4];
#pragma unroll
    for (int i = 0; i < 4; ++i)
#pragma unroll
      for (int j = 0; j < 4; ++j) acc[i][j] = (f32x4){0.f, 0.f, 0.f, 0.f};
    const int t0n = t0 + gridDim.x * 2;
    const bool have_next = t0n < T;
    const int tn = min(t0n + VT_OFF, T - 1);
    const bf16_t *nA = gA, *nB = gB;
    int nm0 = 0, nn0 = 0, nctx = 0;
    if (have_next) {
      const TileInfo tj = tf(tn);
      nA = tj.a + (size_t)lrow * lda + lkc;
      nB = tj.b + (size_t)lrow * ldb + lkc;
      nm0 = tj.m0; nn0 = tj.n0; nctx = tj.ctx;
    }
    for (int kt = 0; kt < nk; kt += 2) {
      {
        const bool wrap = (kt + 2 >= nk);
        const bf16_t* pa = wrap ? nA : gA + ((kt + 2) << 6);
        const bf16_t* pb = wrap ? nB : gB + ((kt + 2) << 6);
        GS_LOAD0(pa, pb)
        GS_COMPUTE(0)
        GS_WRITE1(1)
        __syncthreads();
      }
      {
        const bool wrap = (kt + 3 >= nk);
        const bf16_t* pa = wrap ? nA + 64 : gA + ((kt + 3) << 6);
        const bf16_t* pb = wrap ? nB + 64 : gB + ((kt + 3) << 6);
        GS_LOAD1(pa, pb)
        GS_COMPUTE(1)
        GS_WRITE0(0)
        __syncthreads();
      }
    }
#pragma unroll
    for (int i = 0; i < 4; ++i)
#pragma unroll
      for (int j = 0; j < 4; j += 2)
        epi(ctx, m0 + wm * 64 + i * 16 + lg * 4, n0 + wn * 64 + j * 16 + lr, acc[i][j], acc[i][j + 1]);
    if (!have_next) break;
    t = tn; t0 = t0n; gA = nA; gB = nB; m0 = nm0; n0 = nn0; ctx = nctx;
  }
}

constexpr int T8_E = 256 * LDT;
template <class TileFn, class Epi>
DEVI void gemm8_stream(int T, int lda, int ldb, int K, TileFn tf, Epi epi) {
  int t = blockIdx.x;
  if (t >= T) return;
  int tid = threadIdx.x; asm volatile("" : "+v"(tid));
  const int lane = tid & 63, wave = tid >> 6, wr = wave >> 2, wc = wave & 3;
  const int lr = lane & 15, lg = lane >> 4;
  bf16_t* sA = (bf16_t*)g_smem;
  bf16_t* sB = sA + 2 * T8_E;
  const int lrow = tid >> 3, lkc = (tid & 7) * 8;
  TileInfo ti = tf(t);
  const unsigned offA = ((unsigned)lrow * (unsigned)lda + (unsigned)lkc) * 2u;
  const unsigned offB = ((unsigned)lrow * (unsigned)ldb + (unsigned)lkc) * 2u;
  const char* gA = (const char*)ti.a;
  const char* gB = (const char*)ti.b;
  const size_t rsA = (size_t)64 * lda * 2, rsB = (size_t)64 * ldb * 2;
  int m0 = ti.m0, n0 = ti.n0, ctx = ti.ctx;
  uint4 ra0, ra1, ra2, ra3, rb0, rb1, rb2, rb3;
  uint4 rc0, rc1, rc2, rc3, rd0, rd1, rd2, rd3;
#define G8_LOAD(pa, pb) \
  ra0 = *(const uint4*)((pa) + offA); ra1 = *(const uint4*)((pa) + rsA + offA); \
  ra2 = *(const uint4*)((pa) + 2 * rsA + offA); ra3 = *(const uint4*)((pa) + 3 * rsA + offA); \
  rb0 = *(const uint4*)((pb) + offB); rb1 = *(const uint4*)((pb) + rsB + offB); \
  rb2 = *(const uint4*)((pb) + 2 * rsB + offB); rb3 = *(const uint4*)((pb) + 3 * rsB + offB);
#define G8_WRITE(buf) { \
  bf16_t* wa = sA + (buf) * T8_E + lrow * LDT + lkc; bf16_t* wb = sB + (buf) * T8_E + lrow * LDT + lkc; \
  *(uint4*)(wa) = ra0; *(uint4*)(wa + 64 * LDT) = ra1; *(uint4*)(wa + 128 * LDT) = ra2; *(uint4*)(wa + 192 * LDT) = ra3; \
  *(uint4*)(wb) = rb0; *(uint4*)(wb + 64 * LDT) = rb1; *(uint4*)(wb + 128 * LDT) = rb2; *(uint4*)(wb + 192 * LDT) = rb3; }
#define G8_LOAD1(pa, pb) \
  rc0 = *(const uint4*)((pa) + offA); rc1 = *(const uint4*)((pa) + rsA + offA); \
  rc2 = *(const uint4*)((pa) + 2 * rsA + offA); rc3 = *(const uint4*)((pa) + 3 * rsA + offA); \
  rd0 = *(const uint4*)((pb) + offB); rd1 = *(const uint4*)((pb) + rsB + offB); \
  rd2 = *(const uint4*)((pb) + 2 * rsB + offB); rd3 = *(const uint4*)((pb) + 3 * rsB + offB);
#define G8_WRITE1(buf) { \
  bf16_t* wa = sA + (buf) * T8_E + lrow * LDT + lkc; bf16_t* wb = sB + (buf) * T8_E + lrow * LDT + lkc; \
  *(uint4*)(wa) = rc0; *(uint4*)(wa + 64 * LDT) = rc1; *(uint4*)(wa + 128 * LDT) = rc2; *(uint4*)(wa + 192 * LDT) = rc3; \
  *(uint4*)(wb) = rd0; *(uint4*)(wb + 64 * LDT) = rd1; *(uint4*)(wb + 128 * LDT) = rd2; *(uint4*)(wb + 192 * LDT) = rd3; }
#define G8_COMPUTE(buf) { \
      const bf16_t* cA = sA + (buf) * T8_E + (wr * 128 + lr) * LDT + lg * 8; \
      const bf16_t* cB = sB + (buf) * T8_E + (wc * 64 + lr) * LDT + lg * 8; \
      _Pragma("unroll") for (int ks = 0; ks < 2; ++ks) { \
        bf16x8 bfr[4]; \
        _Pragma("unroll") for (int j = 0; j < 4; ++j) bfr[j] = *(const bf16x8*)(cB + j * 16 * LDT + ks * 32); \
        _Pragma("unroll") for (int h = 0; h < 2; ++h) { \
          bf16x8 af[4]; \
          _Pragma("unroll") for (int i = 0; i < 4; ++i) af[i] = *(const bf16x8*)(cA + (h * 4 + i) * 16 * LDT + ks * 32); \
          _Pragma("unroll") for (int i = 0; i < 4; ++i) \
            _Pragma("unroll") for (int j = 0; j < 4; ++j) acc[h * 4 + i][j] = mfma16(af[i], bfr[j], acc[h * 4 + i][j]); \
        } \
      } }
  G8_LOAD(gA, gB)
  G8_WRITE(0)
  G8_LOAD1(gA + 128, gB + 128)
  __syncthreads();
  const int nk = K >> 6;
  for (;;) {
    f32x4 acc[8][4];
#pragma unroll
    for (int i = 0; i < 8; ++i)
#pragma unroll
      for (int j = 0; j < 4; ++j) acc[i][j] = (f32x4){0.f, 0.f, 0.f, 0.f};
    const int tn = t + gridDim.x;
    const bool have_next = tn < T;
    const char *nA = gA, *nB = gB;
    int nm0 = 0, nn0 = 0, nctx = 0;
    if (have_next) {
      const TileInfo tj = tf(tn);
      nA = (const char*)tj.a;
      nB = (const char*)tj.b;
      nm0 = tj.m0; nn0 = tj.n0; nctx = tj.ctx;
    }
#pragma unroll 1
    for (int kt = 0; kt < nk; kt += 2) {
      {
        const bool wrap = (kt + 2 >= nk);
        const char* pa = wrap ? nA : gA + ((kt + 2) << 7);
        const char* pb = wrap ? nB : gB + ((kt + 2) << 7);
        G8_LOAD(pa, pb)
        G8_COMPUTE(0)
        G8_WRITE1(1)
        __syncthreads();
      }
      {
        const bool wrap = (kt + 3 >= nk);
        const char* pa = wrap ? nA + 128 : gA + ((kt + 3) << 7);
        const char* pb = wrap ? nB + 128 : gB + ((kt + 3) << 7);
        G8_LOAD1(pa, pb)
        G8_COMPUTE(1)
        G8_WRITE(0)
        __syncthreads();
      }
    }
#pragma unroll
    for (int i = 0; i < 8; ++i)
#pragma unroll
      for (int j = 0; j < 4; j += 2)
        epi(ctx, m0 + wr * 128 + i * 16 + lg * 4, n0 + wc * 64 + j * 16 + lr, acc[i][j], acc[i][j + 1]);
    if (!have_next) break;
    t = tn; gA = nA; gB = nB; m0 = nm0; n0 = nn0; ctx = nctx;
  }
}

DEVI void tile_mn(int t, int nM, int nN, int& m, int& n) {
  int id = swz_tile(t, nM * nN);
  int per = 8 * nN;
  int gq = id / per, rem = id - gq * per;
  int gsz = min(8, nM - gq * 8);
  m = gq * 8 + rem % gsz;
  n = rem / gsz;
}

NOINL void gemv_tile(const P& p, int t) {
  char* smem = g_smem + VB * 73728;
  const int tid = opaque_tid();
  float* sv = (float*)smem;
  float* red = sv + 3072;
  const int l = t / 192, n0 = (t % 192) * 32;
  for (int i = tid; i < 3072; i += 256) {
    int v = i >> 10, k = i & 1023;
    float cv = (v == 0) ? p.c_ctx[k] : p.c[(v - 1) * 1024 + k];
    sv[i] = cv / (1.f + expf(-cv));
  }
  __syncthreads();
  const int cgp = tid & 7, ks = tid >> 3;
  const float* w = p.w_mod + (size_t)l * 1024 * 6144 + n0 + cgp * 4;
  float a0[4] = {0, 0, 0, 0}, a1[4] = {0, 0, 0, 0}, a2[4] = {0, 0, 0, 0};
#pragma unroll 16
  for (int kk = 0; kk < 32; ++kk) {
    const int k = ks * 32 + kk;
    const float4 wv = ld_nt_f4(w + (size_t)k * 6144);
    const float s0 = sv[k], s1 = sv[1024 + k], s2 = sv[2048 + k];
    a0[0] += s0 * wv.x; a0[1] += s0 * wv.y; a0[2] += s0 * wv.z; a0[3] += s0 * wv.w;
    a1[0] += s1 * wv.x; a1[1] += s1 * wv.y; a1[2] += s1 * wv.z; a1[3] += s1 * wv.w;
    a2[0] += s2 * wv.x; a2[1] += s2 * wv.y; a2[2] += s2 * wv.z; a2[3] += s2 * wv.w;
  }
#pragma unroll
  for (int j = 0; j < 4; ++j) {
    red[(ks * 3 + 0) * 32 + cgp * 4 + j] = a0[j];
    red[(ks * 3 + 1) * 32 + cgp * 4 + j] = a1[j];
    red[(ks * 3 + 2) * 32 + cgp * 4 + j] = a2[j];
  }
  __syncthreads();
  if (tid < 96) {
    const int v = tid >> 5, col = tid & 31;
    float s = 0.f;
    for (int q = 0; q < 32; ++q) s += red[(q * 3 + v) * 32 + col];
    s += p.b_mod[l * 6144 + n0 + col];
    WSF(OFF_MOD)[(l * 3 + v) * 6144 + n0 + col] = s;
  }
  __syncthreads();
}

NOINL void transpose_tile(const P& p, int t) {
  char* smem = g_smem + VB * 73728;
  const int tid = opaque_tid();
  const float* src; bf16_t* dst; int K, N, ntn, mode = 0;
  if (t < 544) { src = p.w_in; dst = WSB(OFF_WIN); K = 1024; N = 2096; ntn = 34; }
  else if ((t -= 544) < 48) { src = p.w_uq; dst = WSB(OFF_WUQ); K = 256; N = 768; ntn = 12; }
  else if ((t -= 48) < 64) { src = p.w_ukv; dst = WSB(OFF_WUKV); K = 256; N = 1024; ntn = 16; }
  else if ((t -= 64) < 256) { src = p.w_out; dst = WSB(OFF_WOUT); K = 1024; N = 1024; ntn = 16; }
  else if ((t -= 256) < 64) { int g = t >> 4; t &= 15; src = p.pool_w + (size_t)g * 65536; dst = WSB(OFF_WPOOL) + (size_t)g * 65536; K = 256; N = 256; ntn = 4; }
  else if ((t -= 64) < 1408) { int l = t / 704; t -= l * 704; src = p.w_gate + (size_t)l * 1024 * 2816; dst = WSB(OFF_WGU) + (size_t)l * 5632 * 1024; K = 1024; N = 2816; ntn = 44; mode = 1; }
  else if ((t -= 1408) < 1408) { int l = t / 704; t -= l * 704; src = p.w_up + (size_t)l * 1024 * 2816; dst = WSB(OFF_WGU) + (size_t)l * 5632 * 1024; K = 1024; N = 2816; ntn = 44; mode = 2; }
  else { t -= 1408; int l = t / 704; t -= l * 704; src = p.w_down + (size_t)l * 2816 * 1024; dst = WSB(OFF_WDN) + (size_t)l * 1024 * 2816; K = 2816; N = 1024; ntn = 16; }
  const int kt = t / ntn, nt_ = t - kt * ntn;
  const int k0 = kt * 64, n0 = nt_ * 64;
  float* tile = (float*)smem;
  {
    const int nn = tid & 63, kk0 = tid >> 6;
    const int n = n0 + nn;
    const int nc = n < N ? n : N - 1;
    float v[16];
#pragma unroll
    for (int i = 0; i < 16; ++i) v[i] = __builtin_nontemporal_load(src + (size_t)(k0 + kk0 + 4 * i) * N + nc);
#pragma unroll
    for (int i = 0; i < 16; ++i) tile[(kk0 + 4 * i) * 65 + nn] = (n < N) ? v[i] : 0.f;
  }
  __syncthreads();
#pragma unroll
  for (int i = 0; i < 2; ++i) {
    const int id = tid + 256 * i;
    const int nn = id >> 3, kc = id & 7;
    const int n = n0 + nn;
    uint4 pk;
    pk.x = pack2(tile[(kc * 8 + 0) * 65 + nn], tile[(kc * 8 + 1) * 65 + nn]);
    pk.y = pack2(tile[(kc * 8 + 2) * 65 + nn], tile[(kc * 8 + 3) * 65 + nn]);
    pk.z = pack2(tile[(kc * 8 + 4) * 65 + nn], tile[(kc * 8 + 5) * 65 + nn]);
    pk.w = pack2(tile[(kc * 8 + 6) * 65 + nn], tile[(kc * 8 + 7) * 65 + nn]);
    int drow = n;
    if (mode == 1) drow = (n >> 4) * 32 + (n & 15);
    else if (mode == 2) drow = (n >> 4) * 32 + 16 + (n & 15);
    *(uint4*)(dst + (size_t)drow * K + k0 + kc * 8) = pk;
  }
  __syncthreads();
}

template <bool UPD, bool MOD, bool FIRST, bool LASTW, bool TWO, bool POOL = false>
DEVI void rowop(const P& p, const bf16_t* msrc, const bf16_t* msrc2, const float* wpost, int gate_idx, const float* wpre, int shift_idx,
                int scale_idx, int layer_g, int layer_m) {
  const int lane = threadIdx.x & 63, wave = threadIdx.x >> 6;
  const float* modg = WSF(OFF_MOD) + (size_t)layer_g * 3 * 6144;
  const float* modm = WSF(OFF_MOD) + (size_t)layer_m * 3 * 6144;
  bf16_t* hbuf = WSB(OFF_H);
  for (int r = blockIdx.x * 8 + wave; r < 8192; r += gridDim.x * 8) {
    const int v = r < 4096 ? 0 : 1 + ((r - 4096) >> 11);
    const float* mvg = modg + v * 6144;
    const float* mvm = modm + v * 6144;
    float4 x[4];
    if (FIRST) {
      const float* xin = r < 4096 ? p.x_prompt + (size_t)r * 1024 : p.x_sample + (size_t)(r - 4096) * 1024;
#pragma unroll
      for (int i = 0; i < 4; ++i) x[i] = ld_nt_f4(xin + lane * 4 + 256 * i);
    } else {
#pragma unroll
      for (int i = 0; i < 4; ++i) {
        const uint2 xb = ld_nt_u2(WSB(OFF_XR) + (size_t)r * 1024 + lane * 4 + 256 * i);
        x[i].x = __uint_as_float(xb.x << 16); x[i].y = __uint_as_float(xb.x & 0xffff0000u);
        x[i].z = __uint_as_float(xb.y << 16); x[i].w = __uint_as_float(xb.y & 0xffff0000u);
      }
    }
    if (UPD) {
      float4 m[4];
      float ss = 0.f;
      int ps0 = 0, pL = 0;
      if (POOL) { if (r < 4096) { ps0 = r & ~255; pL = 256; } else { ps0 = 4096 + ((r - 4096) & ~2047); pL = 2048; } }
#pragma unroll
      for (int i = 0; i < 4; ++i) {
        if (POOL) {
          constexpr int dummy = 0; (void)dummy;
          const int W2 = 1 << i;
          const int t = r - ps0;
          const int lo = max(t - W2, 0), hi = min(t + W2, pL);
          float a0 = 0.f, a1 = 0.f, a2 = 0.f, a3 = 0.f;
          uint2 ctr = make_uint2(0u, 0u);
#pragma unroll
          for (int k = 0; k < 2 * W2; ++k) {
            const int u = t - W2 + k;
            const int uc = min(max(u, 0), pL - 1);
            const uint2 g = *(const uint2*)(msrc + (size_t)(ps0 + uc) * 1024 + lane * 4 + 256 * i);
            const float w = (u >= 0 && u < pL) ? 1.f : 0.f;
            a0 += w * __uint_as_float(g.x << 16); a1 += w * __uint_as_float(g.x & 0xffff0000u);
            a2 += w * __uint_as_float(g.y << 16); a3 += w * __uint_as_float(g.y & 0xffff0000u);
            if (k == W2) ctr = g;
          }
          const float inv = 1.f / (float)(hi - lo);
          m[i].x = a0 * inv - __uint_as_float(ctr.x << 16); m[i].y = a1 * inv - __uint_as_float(ctr.x & 0xffff0000u);
          m[i].z = a2 * inv - __uint_as_float(ctr.y << 16); m[i].w = a3 * inv - __uint_as_float(ctr.y & 0xffff0000u);
          ss += m[i].x * m[i].x + m[i].y * m[i].y + m[i].z * m[i].z + m[i].w * m[i].w;
          continue;
        }
        const uint2 mb = ld_nt_u2(msrc + (size_t)r * 1024 + lane * 4 + 256 * i);
        m[i].x = __uint_as_float(mb.x << 16); m[i].y = __uint_as_float(mb.x & 0xffff0000u);
        m[i].z = __uint_as_float(mb.y << 16); m[i].w = __uint_as_float(mb.y & 0xffff0000u);
        if (TWO) {
          const uint2 mc = ld_nt_u2(msrc2 + (size_t)r * 1024 + lane * 4 + 256 * i);
          m[i].x += __uint_as_float(mc.x << 16); m[i].y += __uint_as_float(mc.x & 0xffff0000u);
          m[i].z += __uint_as_float(mc.y << 16); m[i].w += __uint_as_float(mc.y & 0xffff0000u);
        }
        ss += m[i].x * m[i].x + m[i].y * m[i].y + m[i].z * m[i].z + m[i].w * m[i].w;
      }
      ss = wave_sum(ss);
      const float rs = rsqrtf(ss * (1.f / 1024.f) + 1e-6f);
#pragma unroll
      for (int i = 0; i < 4; ++i) {
        const int col = lane * 4 + 256 * i;
        const float4 wp = *(const float4*)(wpost + col);
        const float4 g = *(const float4*)(mvg + gate_idx * 1024 + col);
        x[i].x += g.x * (m[i].x * rs * wp.x);
        x[i].y += g.y * (m[i].y * rs * wp.y);
        x[i].z += g.z * (m[i].z * rs * wp.z);
        x[i].w += g.w * (m[i].w * rs * wp.w);
        if (LASTW) *(float4*)(p.out + (size_t)r * 1024 + col) = x[i];
        else {
          uint2 xo;
          xo.x = pack2(x[i].x, x[i].y);
          xo.y = pack2(x[i].z, x[i].w);
          *(uint2*)(WSB(OFF_XR) + (size_t)r * 1024 + col) = xo;
        }
      }
    }
    if (MOD) {
      float ss = 0.f;
#pragma unroll
      for (int i = 0; i < 4; ++i) ss += x[i].x * x[i].x + x[i].y * x[i].y + x[i].z * x[i].z + x[i].w * x[i].w;
      ss = wave_sum(ss);
      const float rs = rsqrtf(ss * (1.f / 1024.f) + 1e-6f);
#pragma unroll
      for (int i = 0; i < 4; ++i) {
        const int col = lane * 4 + 256 * i;
        const float4 wp = *(const float4*)(wpre + col);
        const float4 sh = *(const float4*)(mvm + shift_idx * 1024 + col);
        const float4 sc = *(const float4*)(mvm + scale_idx * 1024 + col);
        uint2 o;
        o.x = pack2(x[i].x * rs * wp.x * (1.f + sc.x) + sh.x, x[i].y * rs * wp.y * (1.f + sc.y) + sh.y);
        o.y = pack2(x[i].z * rs * wp.z * (1.f + sc.z) + sh.z, x[i].w * rs * wp.w * (1.f + sc.w) + sh.w);
        *(uint2*)(hbuf + (size_t)r * 1024 + col) = o;
      }
    }
  }
}

NOINL void prep_rows(const P& p) {
  const int lane = threadIdx.x & 63, wave = threadIdx.x >> 6;
  const bf16_t* proj = WSB(OFF_R1);
  for (int r = blockIdx.x * 8 + wave; r < 8192; r += gridDim.x * 8) {
    const bf16_t* pr = proj + (size_t)r * 2080;
    const int kvrow = r < 4096 ? r : 4096 + ((r - 4096) >> 11) * 2304 + 256 + ((r - 4096) & 2047);
    const uint2 rq = *(const uint2*)(pr + lane * 4);
    const uint2 rk = *(const uint2*)(pr + 256 + lane * 4);
    const float4 ld_cq = make_float4(__uint_as_float(rq.x << 16), __uint_as_float(rq.x & 0xffff0000u), __uint_as_float(rq.y << 16), __uint_as_float(rq.y & 0xffff0000u));
    const float4 ld_ckv = make_float4(__uint_as_float(rk.x << 16), __uint_as_float(rk.x & 0xffff0000u), __uint_as_float(rk.y << 16), __uint_as_float(rk.y & 0xffff0000u));
    const float ld_kpe = bf2f(pr[512 + (lane & 31)]);
    const float ld_dt = WSF(OFF_DTRAW)[(size_t)r * 16 + (lane & 15)];
    {
      const float4 a = ld_cq;
      float ss = wave_sum(a.x * a.x + a.y * a.y + a.z * a.z + a.w * a.w);
      const float rs = rsqrtf(ss * (1.f / 256.f) + 1e-6f);
      const float4 g = *(const float4*)(p.q_norm + lane * 4);
      uint2 o;
      o.x = pack2(a.x * rs * g.x, a.y * rs * g.y);
      o.y = pack2(a.z * rs * g.z, a.w * rs * g.w);
      *(uint2*)(WSB(OFF_CQN) + (size_t)r * 256 + lane * 4) = o;
    }
    {
      const float4 a = ld_ckv;
      float ss = wave_sum(a.x * a.x + a.y * a.y + a.z * a.z + a.w * a.w);
      const float rs = rsqrtf(ss * (1.f / 256.f) + 1e-6f);
      const float4 g = *(const float4*)(p.kv_norm + lane * 4);
      float4 vv;
      vv.x = a.x * rs * g.x; vv.y = a.y * rs * g.y; vv.z = a.z * rs * g.z; vv.w = a.w * rs * g.w;
      if (r < 4096) *(float4*)(p.out + OUT_CKV + (size_t)r * 256 + lane * 4) = vv;
      uint2 o;
      o.x = pack2(vv.x, vv.y);
      o.y = pack2(vv.z, vv.w);
      *(uint2*)(WSB(OFF_CKV) + (size_t)kvrow * 256 + lane * 4) = o;
    }
    {
      const float kv = (lane < 32) ? ld_kpe : 0.f;
      const float partner = __shfl_xor(kv, 16, 64);
      if (r < 4096) {
        if (lane < 32) {
          p.out[OUT_KR + (size_t)r * 32 + lane] = kv;
          WSB(OFF_KPE)[(size_t)kvrow * 32 + lane] = f2bf(kv);
        }
      } else {
        const int t = (r - 4096) & 2047;
        const int ii = lane & 15;
        const float pos = (ii < 8) ? (float)(t >> 6) : (float)(t & 63);
        const float fr = rope_freq(ii & 7);
        const float ang = pos * fr;
        float cs, sn;
        fast_sincos(ang, sn, cs);
        const float o = (lane < 16) ? (kv * cs - partner * sn) : (partner * sn + kv * cs);
        if (lane < 32) WSB(OFF_KPE)[(size_t)kvrow * 32 + lane] = f2bf(o);
      }
    }
    if (lane < 16) {
      const int dir = lane >> 3, hh = lane & 7;
      const float raw = ld_dt + (dir ? p.dtb_b[hh] : p.dtb_f[hh]);
      const float sp = raw > 20.f ? raw : log1pf(expf(raw));
      WSF(OFF_DTV)[((size_t)dir * 8192 + r) * 8 + hh] = sp;
    }
  }
}

NOINL void prep_cache(const P& p) {
  const int gt = blockIdx.x * 512 + threadIdx.x, gs = gridDim.x * 512;
  for (int i = gt; i < 2 * 256 * 256; i += gs) {
    int b = i >> 16, rem = i & 65535;
    WSB(OFF_CKV)[(size_t)(4096 + b * 2304) * 256 + rem] = f2bf(p.cache_ckv[i]);
  }
  for (int i = gt; i < 2 * 256 * 32; i += gs) {
    int b = i >> 13, rem = i & 8191;
    WSB(OFF_KPE)[(size_t)(4096 + b * 2304) * 32 + rem] = f2bf(p.cache_kr[i]);
  }
}

NOINL void conv_tile(const P& p, int t) {
  char* smem = g_smem + VB * 73728;
  const int tid = opaque_tid();
  float* sin_ = (float*)smem;
  float* sout = sin_ + 68 * 64;
  const int tt_ = t >> 4, ct = t & 15;
  const int r0 = tt_ * 64, c0 = ct * 64;
  int s0, s1;
  if (r0 < 4096) { s0 = r0 & ~255; s1 = s0 + 256; } else { s0 = 4096 + ((r0 - 4096) & ~2047); s1 = s0 + 2048; }
  const bf16_t* proj = WSB(OFF_R1);
  {
    const int rr0 = tid >> 6, cc = tid & 63;
    float v[17];
#pragma unroll
    for (int k = 0; k < 17; ++k) {
      const int r = r0 - 2 + rr0 + 4 * k;
      const int rc = r < s0 ? s0 : (r >= s1 ? s1 - 1 : r);
      v[k] = bf2f(proj[(size_t)rc * 2080 + 1056 + c0 + cc]);
    }
#pragma unroll
    for (int k = 0; k < 17; ++k) {
      const int r = r0 - 2 + rr0 + 4 * k;
      sin_[(rr0 + 4 * k) * 64 + cc] = (r >= s0 && r < s1) ? v[k] : 0.f;
    }
  }
  __syncthreads();
  {
    const int cc = tid & 63, tq = tid >> 6;
    const int c = c0 + cc;
    const float w0 = p.conv_w[c], w1 = p.conv_w[1024 + c], w2 = p.conv_w[2048 + c], w3 = p.conv_w[3072 + c],
                w4 = p.conv_w[4096 + c], bias = p.conv_b[c];
#pragma unroll 4
    for (int i = 0; i < 16; ++i) {
      const int tt = tq * 16 + i;
      float y = bias + w0 * sin_[tt * 64 + cc] + w1 * sin_[(tt + 1) * 64 + cc] + w2 * sin_[(tt + 2) * 64 + cc] +
                w3 * sin_[(tt + 3) * 64 + cc] + w4 * sin_[(tt + 4) * 64 + cc];
      y = y / (1.f + __expf(-y));
      sout[tt * 65 + cc] = y;
      const bf16_t b = f2bf(y);
      const size_t r = r0 + tt;
      if (c < 512) WSB(OFF_XS)[r * 512 + c] = b;
      else if (c < 768) WSB(OFF_BM)[r * 256 + (c - 512)] = b;
      else WSB(OFF_CM)[r * 256 + (c - 768)] = b;
    }
  }
  __syncthreads();
  if (c0 < 768) {
    const int cl = tid >> 2, q4 = tid & 3;
    uint4 o0, o1;
    const float* sp = sout + (q4 * 16) * 65 + cl;
    o0.x = pack2(sp[0 * 65], sp[1 * 65]);   o0.y = pack2(sp[2 * 65], sp[3 * 65]);
    o0.z = pack2(sp[4 * 65], sp[5 * 65]);   o0.w = pack2(sp[6 * 65], sp[7 * 65]);
    o1.x = pack2(sp[8 * 65], sp[9 * 65]);   o1.y = pack2(sp[10 * 65], sp[11 * 65]);
    o1.z = pack2(sp[12 * 65], sp[13 * 65]); o1.w = pack2(sp[14 * 65], sp[15 * 65]);
    bf16_t* dst = (c0 < 512) ? WSB(OFF_XST) + (size_t)(c0 + cl) * 8192 : WSB(OFF_BT) + (size_t)(c0 - 512 + cl) * 8192;
    dst += r0 + q4 * 16;
    *(uint4*)(dst) = o0;
    *(uint4*)(dst + 8) = o1;
  }
  __syncthreads();
}

NOINL void chunk_state_item(const P& p, int item) {
  char* smem = g_smem + VB * 73728;
  const int tid = opaque_tid(), lane = tid & 63, wave = tid >> 6, lr = lane & 15, lg = lane >> 4;
  const int cidx = item >> 3, hh = item & 7, g = hh >> 2;
  const int r0 = cidx * 128;
  constexpr int LDS_ = 136;
  bf16_t* sAs = (bf16_t*)smem;
  bf16_t* sBs = sAs + 2 * 64 * LDS_;
  float* fa = (float*)(sBs + 128 * LDS_);
  float* fcum = fa + 256;
  float* fw = fa + 512;
  float* fdt = fa + 768;
  {
    const int dir = tid >> 7, j = tid & 127;
    const float dt = WSF(OFF_DTV)[((size_t)dir * 8192 + r0 + j) * 8 + hh];
    const float Aco = -expf(dir ? p.alog_b[hh] : p.alog_f[hh]);
    fa[tid] = dt * Aco;
    fdt[tid] = dt;
  }
  __syncthreads();
  {
    const int dir = tid >> 7, j = tid & 127;
    float s = 0.f;
    const float4* fa4 = (const float4*)(fa + dir * 128);
    if (dir == 0) {
      const int nb = (j + 1) >> 2;
      for (int k4 = 0; k4 < nb; ++k4) { const float4 v = fa4[k4]; s += (v.x + v.y) + (v.z + v.w); }
      for (int k = nb * 4; k <= j; ++k) s += fa[k];
    } else {
      const int fb = (j + 3) >> 2;
      for (int k4 = 31; k4 >= fb; --k4) { const float4 v = fa4[k4]; s += (v.x + v.y) + (v.z + v.w); }
      for (int k = j; k < fb * 4; ++k) s += fa[128 + k];
    }
    fcum[tid] = s;
    WSF(OFF_CUM)[((size_t)dir * 8192 + r0 + j) * 8 + hh] = s;
  }
  __syncthreads();
  {
    const int dir = tid >> 7;
    const float ce = dir ? fcum[128] : fcum[127];
    fw[tid] = __expf(ce - fcum[tid]) * fdt[tid];
    if ((tid & 127) == 0) WSF(OFF_TOT)[(dir * 64 + cidx) * 8 + hh] = __expf(ce);
  }
  __syncthreads();
#pragma unroll
  for (int i = 0; i < 4; ++i) {
    const int id = tid + 256 * i;
    const int pp = id >> 4, jc = (id & 15) * 8;
    const uint4 raw = *(const uint4*)(WSB(OFF_XST) + (size_t)(hh * 64 + pp) * 8192 + r0 + jc);
    const unsigned rw[4] = {raw.x, raw.y, raw.z, raw.w};
    unsigned of[4], ob[4];
#pragma unroll
    for (int q = 0; q < 4; ++q) {
      const float x0 = __uint_as_float(rw[q] << 16), x1 = __uint_as_float(rw[q] & 0xffff0000u);
      of[q] = pack2(x0 * fw[jc + 2 * q], x1 * fw[jc + 2 * q + 1]);
      ob[q] = pack2(x0 * fw[128 + jc + 2 * q], x1 * fw[128 + jc + 2 * q + 1]);
    }
    *(uint4*)(sAs + pp * LDS_ + jc) = make_uint4(of[0], of[1], of[2], of[3]);
    *(uint4*)(sAs + 64 * LDS_ + pp * LDS_ + jc) = make_uint4(ob[0], ob[1], ob[2], ob[3]);
  }
#pragma unroll
  for (int i = 0; i < 8; ++i) {
    const int id = tid + 256 * i;
    const int nn = id >> 4, jc = (id & 15) * 8;
    *(uint4*)(sBs + nn * LDS_ + jc) = *(const uint4*)(WSB(OFF_BT) + (size_t)(g * 128 + nn) * 8192 + r0 + jc);
  }
  __syncthreads();
  {
    const int dir = wave >> 1, nh = wave & 1;
    f32x4 acc[4][4];
#pragma unroll
    for (int i = 0; i < 4; ++i)
#pragma unroll
      for (int j = 0; j < 4; ++j) acc[i][j] = (f32x4){0.f, 0.f, 0.f, 0.f};
    const bf16_t* cA = sAs + dir * 64 * LDS_ + lr * LDS_ + lg * 8;
    const bf16_t* cB = sBs + (nh * 64 + lr) * LDS_ + lg * 8;
#pragma unroll 1
    for (int ks = 0; ks < 4; ++ks) {
      bf16x8 af[4], bfr[4];
#pragma unroll
      for (int i = 0; i < 4; ++i) {
        af[i] = *(const bf16x8*)(cA + i * 16 * LDS_ + ks * 32);
        bfr[i] = *(const bf16x8*)(cB + i * 16 * LDS_ + ks * 32);
      }
#pragma unroll
      for (int i = 0; i < 4; ++i)
#pragma unroll
        for (int j = 0; j < 4; ++j) acc[i][j] = mfma16(af[i], bfr[j], acc[i][j]);
    }
    float* S = WSF(OFF_R2) + ((size_t)(dir * 64 + cidx) * 8 + hh) * 8192 + (lg * 4) * 128 + nh * 64 + lr;
#pragma unroll
    for (int i = 0; i < 4; ++i) {
#pragma unroll
      for (int q = 0; q < 4; ++q) {
#pragma unroll
        for (int j = 0; j < 4; ++j) S[j * 16] = acc[i][j][q];
        S += 128;
      }
      S += 12 * 128;
      __builtin_amdgcn_sched_barrier(0);
    }
  }
  __syncthreads();
}

template <int NB>
DEVI void scan_group(const P& p, float4& h, int dir, int cb, int nc, int c0, int hh, size_t eoff) {
  float4 sv[NB];
  float d[NB];
  size_t base[NB];
#pragma unroll
  for (int k = 0; k < NB; ++k) {
    const int c = c0 + k;
    const int cidx = cb + (dir ? nc - 1 - c : c);
    base[k] = ((size_t)(dir * 64 + cidx) * 8 + hh) * 8192 + eoff;
    d[k] = WSF(OFF_TOT)[(dir * 64 + cidx) * 8 + hh];
    sv[k] = ld_nt_f4(WSF(OFF_R2) + base[k]);
  }
#pragma unroll
  for (int k = 0; k < NB; ++k) {
    uint2 o;
    o.x = pack2(h.x, h.y);
    o.y = pack2(h.z, h.w);
    *(uint2*)(WSB(OFF_H) + base[k]) = o;
    h.x = d[k] * h.x + sv[k].x; h.y = d[k] * h.y + sv[k].y; h.z = d[k] * h.z + sv[k].z; h.w = d[k] * h.w + sv[k].w;
  }
}

NOINL void scan_states(const P& p) {
  const int total = 2 * 18 * 8 * 64 * 32;
  for (int idx = blockIdx.x * 512 + threadIdx.x; idx < total; idx += gridDim.x * 512) {
    const int n4 = idx & 31, pp = (idx >> 5) & 63, hh = (idx >> 11) & 7;
    const int sd = idx >> 14;
    const int s = sd % 18, dir = sd / 18;
    const int nc = s < 16 ? 2 : 16;
    const int cb = s < 16 ? s * 2 : 32 + (s - 16) * 16;
    float4 h = make_float4(0.f, 0.f, 0.f, 0.f);
    const size_t eoff = (size_t)pp * 128 + n4 * 4;
    if (s >= 16) {
      const float* st = (dir ? p.st_b : p.st_f) + ((size_t)((s - 16) * 8 + hh) * 64 + pp) * 128 + n4 * 4;
      h = *(const float4*)st;
      scan_group<8>(p, h, dir, cb, nc, 0, hh, eoff);
      scan_group<8>(p, h, dir, cb, nc, 8, hh, eoff);
    } else {
      scan_group<2>(p, h, dir, cb, nc, 0, hh, eoff);
      float* o = p.out + (dir ? OUT_SB : OUT_SF) + ((size_t)(s * 8 + hh) * 64 + pp) * 128 + n4 * 4;
      *(float4*)o = h;
    }
  }
}

NOINL void attn_item(const P& p, int id) {
  char* smem = g_smem + VB * 73728;
  const int tid = opaque_tid(), lane = tid & 63, wave = tid >> 6, lr = lane & 15, lg = lane >> 4;
  int row0, kvbase, Lk, hh;
  if (id < 512) { hh = id & 7; const int b = (id >> 3) & 1; const int qb = id >> 4; row0 = 4096 + b * 2048 + qb * 64; kvbase = 4096 + b * 2304; Lk = 2304; }
  else { const int i2 = id - 512; hh = i2 & 7; const int rest = i2 >> 3; const int b = rest >> 2; const int qb = rest & 3; row0 = b * 256 + qb * 64; kvbase = b * 256; Lk = 256; }
  constexpr int LDK = 104, LDV = 72;
  constexpr int KVBUF = 64 * LDK + 64 * LDV;
  bf16_t* sKV = (bf16_t*)smem;
  const int qrow = row0 + wave * 16 + lr;
  bf16x8 qf[3];
#pragma unroll
  for (int ks = 0; ks < 3; ++ks) qf[ks] = *(const bf16x8*)(WSB(OFF_Q) + (size_t)qrow * 768 + hh * 96 + ks * 32 + lg * 8);
  f32x4 oacc[4];
#pragma unroll
  for (int i = 0; i < 4; ++i) oacc[i] = (f32x4){0.f, 0.f, 0.f, 0.f};
  float mrun = -1e30f, lrun = 0.f;
  const int nkt = Lk >> 6;
  const int kkey0 = tid / 12, kcc0 = tid - kkey0 * 12;
  const int c1 = tid + 256, kkey1 = c1 / 12, kcc1 = c1 - kkey1 * 12;
  const int c2 = tid + 512, kkey2 = c2 / 12, kcc2 = c2 - kkey2 * 12;
  const bf16_t* kn = WSB(OFF_KN);
  const bf16_t* kp = WSB(OFF_KPE);
  const bf16_t* ksrc0 = (kcc0 < 8) ? kn + (size_t)(kvbase + kkey0) * 512 + hh * 64 + kcc0 * 8 : kp + (size_t)(kvbase + kkey0) * 32 + (kcc0 - 8) * 8;
  const bf16_t* ksrc1 = (kcc1 < 8) ? kn + (size_t)(kvbase + kkey1) * 512 + hh * 64 + kcc1 * 8 : kp + (size_t)(kvbase + kkey1) * 32 + (kcc1 - 8) * 8;
  const bf16_t* ksrc2 = (kcc2 < 8) ? kn + (size_t)(kvbase + kkey2) * 512 + hh * 64 + kcc2 * 8 : kp + (size_t)(kvbase + kkey2) * 32 + (kcc2 - 8) * 8;
  const int kst0 = (kcc0 < 8) ? 512 * 64 : 32 * 64, kst1 = (kcc1 < 8) ? 512 * 64 : 32 * 64, kst2 = (kcc2 < 8) ? 512 * 64 : 32 * 64;
  const int vd0 = tid >> 3, vcc = tid & 7;
  const bf16_t* vsrc0 = WSB(OFF_VT) + (size_t)(hh * 64 + vd0) * 8704 + kvbase + vcc * 8;
  const bf16_t* vsrc1 = vsrc0 + (size_t)32 * 8704;
  uint4 rk0, rk1, rk2, rv0, rv1;
#define AT_LOAD(kt) { const int _k = (kt); \
    rk0 = *(const uint4*)(ksrc0 + (size_t)_k * kst0); rk1 = *(const uint4*)(ksrc1 + (size_t)_k * kst1); \
    rk2 = *(const uint4*)(ksrc2 + (size_t)_k * kst2); \
    rv0 = *(const uint4*)(vsrc0 + _k * 64); rv1 = *(const uint4*)(vsrc1 + _k * 64); }
#define AT_WRITE(buf) { bf16_t* _b = sKV + (buf) * KVBUF; \
    *(uint4*)(_b + kkey0 * LDK + kcc0 * 8) = rk0; *(uint4*)(_b + kkey1 * LDK + kcc1 * 8) = rk1; \
    *(uint4*)(_b + kkey2 * LDK + kcc2 * 8) = rk2; \
    *(uint4*)(_b + 64 * LDK + vd0 * LDV + vcc * 8) = rv0; *(uint4*)(_b + 64 * LDK + (vd0 + 32) * LDV + vcc * 8) = rv1; }
  AT_LOAD(0)
  AT_WRITE(0)
  __syncthreads();
  for (int kt = 0; kt < nkt; ++kt) {
    const int ktn = min(kt + 1, nkt - 1);
    AT_LOAD(ktn)
#if ATPROBE == 5
    { uint4 d0 = *(const volatile uint4*)(ksrc0 + (size_t)ktn * kst0), d1 = *(const volatile uint4*)(ksrc1 + (size_t)ktn * kst1), d2 = *(const volatile uint4*)(ksrc2 + (size_t)ktn * kst2);
      uint4 d3 = *(const volatile uint4*)(vsrc0 + ktn * 64), d4 = *(const volatile uint4*)(vsrc1 + ktn * 64);
      asm volatile("" :: "v"(d0), "v"(d1), "v"(d2), "v"(d3), "v"(d4)); }
#endif
    const bf16_t* sK = sKV + (kt & 1) * KVBUF;
    const bf16_t* sV = sK + 64 * LDK;
    f32x4 sacc[4];
#pragma unroll
    for (int n = 0; n < 4; ++n) sacc[n] = (f32x4){0.f, 0.f, 0.f, 0.f};
#pragma unroll
    for (int ks = 0; ks < 3; ++ks)
#pragma unroll
      for (int n = 0; n < 4; ++n) {
        const bf16x8 a = *(const bf16x8*)(sK + (n * 16 + lr) * LDK + ks * 32 + lg * 8);
        sacc[n] = mfma16(a, qf[ks], sacc[n]);
      }
#if ATPROBE == 2
    {
      f32x4 dacc[4];
#pragma unroll
      for (int n = 0; n < 4; ++n) dacc[n] = (f32x4){0.f, 0.f, 0.f, 0.f};
#pragma unroll
      for (int ks = 0; ks < 3; ++ks)
#pragma unroll
        for (int n = 0; n < 4; ++n) {
          const bf16x8 a = *(const volatile bf16x8*)(sK + (n * 16 + lr) * LDK + ks * 32 + lg * 8);
          dacc[n] = mfma16(a, qf[ks], dacc[n]);
        }
#pragma unroll
      for (int n = 0; n < 4; ++n) asm volatile("" :: "v"(dacc[n]));
    }
#endif
    float mx = sacc[0][0];
#pragma unroll
    for (int n = 0; n < 4; ++n)
#pragma unroll
      for (int q = 0; q < 4; ++q) mx = fmaxf(mx, sacc[n][q]);
    mx = quad_max(mx);
    const float mnew = fmaxf(mrun, mx);
    const float alpha = __builtin_amdgcn_exp2f(mrun - mnew);
    mrun = mnew;
    float ps = 0.f;
#pragma unroll
    for (int n = 0; n < 4; ++n)
#pragma unroll
      for (int q = 0; q < 4; ++q) {
#if ATPROBE == 1
        { float e2 = __builtin_amdgcn_exp2f(sacc[n][q] - mrun); asm volatile("" :: "v"(e2)); }
#endif
        const float e = __builtin_amdgcn_exp2f(sacc[n][q] - mnew); sacc[n][q] = e; ps += e; }
    lrun = lrun * alpha + ps;
#pragma unroll
    for (int i = 0; i < 4; ++i)
#pragma unroll
      for (int q = 0; q < 4; ++q) oacc[i][q] *= alpha;
#pragma unroll
    for (int ks = 0; ks < 2; ++ks) {
      union { bf16x8 v; unsigned u[4]; } pf;
      pf.u[0] = pack2(sacc[2 * ks][0], sacc[2 * ks][1]);
      pf.u[1] = pack2(sacc[2 * ks][2], sacc[2 * ks][3]);
      pf.u[2] = pack2(sacc[2 * ks + 1][0], sacc[2 * ks + 1][1]);
      pf.u[3] = pack2(sacc[2 * ks + 1][2], sacc[2 * ks + 1][3]);
#pragma unroll
      for (int m = 0; m < 4; ++m) {
        union { bf16x8 v; uint2 h[2]; } av;
        const bf16_t* vp = sV + (m * 16 + lr) * LDV + ks * 32 + lg * 4;
        av.h[0] = *(const uint2*)(vp);
        av.h[1] = *(const uint2*)(vp + 16);
        oacc[m] = mfma16(av.v, pf.v, oacc[m]);
      }
    }
    __builtin_amdgcn_sched_barrier(0);
    AT_WRITE((kt + 1) & 1)
#if ATPROBE == 3
    AT_WRITE((kt + 1) & 1)
#endif
#if ATPROBE == 4
    __syncthreads();
#endif
    __syncthreads();
  }
  lrun = quad_sum(lrun);
  const float inv = 1.f / lrun;
#pragma unroll
  for (int m = 0; m < 4; ++m) {
    uint2 o;
    o.x = pack2(oacc[m][0] * inv, oacc[m][1] * inv);
    o.y = pack2(oacc[m][2] * inv, oacc[m][3] * inv);
    *(uint2*)(WSB(OFF_CAT) + (size_t)qrow * 1024 + hh * 64 + m * 16 + lg * 4) = o;
  }
}

NOINL void attn8_item(const P& p, int id) {
  int tid = threadIdx.x; asm volatile("" : "+v"(tid));
  const int lane = tid & 63, wave = tid >> 6, lr = lane & 15, lg = lane >> 4;
  int row0, kvbase, Lk, hh;
  if (id < 256) { hh = id & 7; const int b = (id >> 3) & 1; const int qb = id >> 4; row0 = 4096 + b * 2048 + qb * 128; kvbase = 4096 + b * 2304; Lk = 2304; }
  else { const int i2 = id - 256; hh = i2 & 7; const int rest = i2 >> 3; const int b = rest >> 1; const int qb = rest & 1; row0 = b * 256 + qb * 128; kvbase = b * 256; Lk = 256; }
  constexpr int LDK = 104, LDV = 136;
  constexpr int KVBUF = 128 * LDK + 64 * LDV;
  bf16_t* sKV = (bf16_t*)g_smem;
  const int qrow = row0 + wave * 16 + lr;
  bf16x8 qf[3];
#pragma unroll
  for (int ks = 0; ks < 3; ++ks) qf[ks] = *(const bf16x8*)(WSB(OFF_Q) + (size_t)qrow * 768 + hh * 96 + ks * 32 + lg * 8);
  f32x4 oacc[4];
#pragma unroll
  for (int i = 0; i < 4; ++i) oacc[i] = (f32x4){0.f, 0.f, 0.f, 0.f};
  float mrun = -1e30f, lrun = 0.f;
  const int nkt = Lk >> 7;
  const int kkey0 = tid / 12, kcc0 = tid - kkey0 * 12;
  const int c1 = tid + 512, kkey1 = c1 / 12, kcc1 = c1 - kkey1 * 12;
  const int c2 = tid + 1024, kkey2 = c2 / 12, kcc2 = c2 - kkey2 * 12;
  const bf16_t* kn = WSB(OFF_KN);
  const bf16_t* kp = WSB(OFF_KPE);
  const bf16_t* ksrc0 = (kcc0 < 8) ? kn + (size_t)(kvbase + kkey0) * 512 + hh * 64 + kcc0 * 8 : kp + (size_t)(kvbase + kkey0) * 32 + (kcc0 - 8) * 8;
  const bf16_t* ksrc1 = (kcc1 < 8) ? kn + (size_t)(kvbase + kkey1) * 512 + hh * 64 + kcc1 * 8 : kp + (size_t)(kvbase + kkey1) * 32 + (kcc1 - 8) * 8;
  const bf16_t* ksrc2 = (kcc2 < 8) ? kn + (size_t)(kvbase + kkey2) * 512 + hh * 64 + kcc2 * 8 : kp + (size_t)(kvbase + kkey2) * 32 + (kcc2 - 8) * 8;
  const int kst0 = (kcc0 < 8) ? 512 * 128 : 32 * 128, kst1 = (kcc1 < 8) ? 512 * 128 : 32 * 128, kst2 = (kcc2 < 8) ? 512 * 128 : 32 * 128;
  const int vd0 = tid >> 4, vcc = tid & 15;
  const bf16_t* vsrc0 = WSB(OFF_VT) + (size_t)(hh * 64 + vd0) * 8704 + kvbase + vcc * 8;
  const bf16_t* vsrc1 = vsrc0 + (size_t)32 * 8704;
  uint4 rk0, rk1, rk2, rv0, rv1;
#define A8_LOAD(kt) { const int _k = (kt); \
    rk0 = *(const uint4*)(ksrc0 + (size_t)_k * kst0); rk1 = *(const uint4*)(ksrc1 + (size_t)_k * kst1); \
    rk2 = *(const uint4*)(ksrc2 + (size_t)_k * kst2); \
    rv0 = *(const uint4*)(vsrc0 + _k * 128); rv1 = *(const uint4*)(vsrc1 + _k * 128); }
#define A8_WRITE(buf) { bf16_t* _b = sKV + (buf) * KVBUF; \
    *(uint4*)(_b + kkey0 * LDK + kcc0 * 8) = rk0; *(uint4*)(_b + kkey1 * LDK + kcc1 * 8) = rk1; \
    *(uint4*)(_b + kkey2 * LDK + kcc2 * 8) = rk2; \
    *(uint4*)(_b + 128 * LDK + vd0 * LDV + vcc * 8) = rv0; *(uint4*)(_b + 128 * LDK + (vd0 + 32) * LDV + vcc * 8) = rv1; }
  A8_LOAD(0)
  A8_WRITE(0)
  __syncthreads();
  for (int kt = 0; kt < nkt; ++kt) {
    const int ktn = min(kt + 1, nkt - 1);
    A8_LOAD(ktn)
    const bf16_t* sK = sKV + (kt & 1) * KVBUF;
    const bf16_t* sV = sK + 128 * LDK;
    f32x4 sacc[8];
#pragma unroll
    for (int n = 0; n < 8; ++n) sacc[n] = (f32x4){0.f, 0.f, 0.f, 0.f};
#pragma unroll
    for (int ks = 0; ks < 3; ++ks)
#pragma unroll
      for (int n = 0; n < 8; ++n) {
        const bf16x8 a = *(const bf16x8*)(sK + (n * 16 + lr) * LDK + ks * 32 + lg * 8);
        sacc[n] = mfma16(a, qf[ks], sacc[n]);
      }
    float mx = sacc[0][0];
#pragma unroll
    for (int n = 0; n < 8; ++n)
#pragma unroll
      for (int q = 0; q < 4; ++q) mx = fmaxf(mx, sacc[n][q]);
    mx = quad_max(mx);
    const float mnew = fmaxf(mrun, mx);
    const float alpha = __builtin_amdgcn_exp2f(mrun - mnew);
    mrun = mnew;
    float ps0 = 0.f, ps1 = 0.f;
#pragma unroll
    for (int n = 0; n < 8; n += 2)
#pragma unroll
      for (int q = 0; q < 4; ++q) {
        const float e0 = __builtin_amdgcn_exp2f(sacc[n][q] - mnew); sacc[n][q] = e0; ps0 += e0;
        const float e1 = __builtin_amdgcn_exp2f(sacc[n + 1][q] - mnew); sacc[n + 1][q] = e1; ps1 += e1;
      }
    lrun = lrun * alpha + (ps0 + ps1);
#pragma unroll
    for (int i = 0; i < 4; ++i)
#pragma unroll
      for (int q = 0; q < 4; ++q) oacc[i][q] *= alpha;
#pragma unroll
    for (int ks = 0; ks < 4; ++ks) {
      union { bf16x8 v; unsigned u[4]; } pf;
      pf.u[0] = pack2(sacc[2 * ks][0], sacc[2 * ks][1]);
      pf.u[1] = pack2(sacc[2 * ks][2], sacc[2 * ks][3]);
      pf.u[2] = pack2(sacc[2 * ks + 1][0], sacc[2 * ks + 1][1]);
      pf.u[3] = pack2(sacc[2 * ks + 1][2], sacc[2 * ks + 1][3]);
#pragma unroll
      for (int m = 0; m < 4; ++m) {
        union { bf16x8 v; uint2 h[2]; } av;
        const bf16_t* vp = sV + (m * 16 + lr) * LDV + ks * 32 + lg * 4;
        av.h[0] = *(const uint2*)(vp);
        av.h[1] = *(const uint2*)(vp + 16);
        oacc[m] = mfma16(av.v, pf.v, oacc[m]);
      }
    }
    __builtin_amdgcn_sched_barrier(0);
    A8_WRITE((kt + 1) & 1)
    __syncthreads();
  }
  lrun = quad_sum(lrun);
  const float inv = 1.f / lrun;
#pragma unroll
  for (int m = 0; m < 4; ++m) {
    uint2 o;
    o.x = pack2(oacc[m][0] * inv, oacc[m][1] * inv);
    o.y = pack2(oacc[m][2] * inv, oacc[m][3] * inv);
    *(uint2*)(WSB(OFF_CAT) + (size_t)qrow * 1024 + hh * 64 + m * 16 + lg * 4) = o;
  }
}

NOINL void ssd_y_item(const P& p, int item) {
  char* smem = g_smem + VB * 73728;
  const int tid = opaque_tid(), lane = tid & 63, wave = tid >> 6, lr = lane & 15, lg = lane >> 4;
  const int cidx = item >> 3, qt = (item >> 1) & 3, half = qt >> 1, g = item & 1;
  const int r0 = cidx * 128;
  const int hh = g * 4 + wave;
  constexpr int LDC = 136, LDM = 72;
  bf16_t* sC = (bf16_t*)smem;
  bf16_t* sB = sC + 64 * LDC;
  bf16_t* sM = sB + 64 * LDC + wave * 64 * LDM;
  float* rowss = (float*)((bf16_t*)smem + 2 * 64 * LDC + 4 * 64 * LDM);
  const float* cum = WSF(OFF_CUM);
  const float* dtv = WSF(OFF_DTV);
  const int srow = tid >> 4, scol = (tid & 15) * 8;
  uint4 pb0, pb1, pb2, pb3;
  {
    const bf16_t* cs = WSB(OFF_CM) + (size_t)(r0 + qt * 32 + srow) * 256 + g * 128 + scol;
    const bf16_t* bs = WSB(OFF_BM) + (size_t)(r0 + srow) * 256 + g * 128 + scol;
    const uint4 c0 = *(const uint4*)(cs), c1 = *(const uint4*)(cs + 16 * 256);
    const uint4 b0 = *(const uint4*)(bs), b1 = *(const uint4*)(bs + 16 * 256), b2 = *(const uint4*)(bs + 32 * 256), b3 = *(const uint4*)(bs + 48 * 256);
    pb0 = *(const uint4*)(bs + 64 * 256); pb1 = *(const uint4*)(bs + 80 * 256); pb2 = *(const uint4*)(bs + 96 * 256); pb3 = *(const uint4*)(bs + 112 * 256);
    bf16_t* wc = sC + srow * LDC + scol;
    bf16_t* wb = sB + srow * LDC + scol;
    *(uint4*)(wc) = c0; *(uint4*)(wc + 16 * LDC) = c1;
    *(uint4*)(wb) = b0; *(uint4*)(wb + 16 * LDC) = b1; *(uint4*)(wb + 32 * LDC) = b2; *(uint4*)(wb + 48 * LDC) = b3;
  }
  __syncthreads();
  f32x4 Y[2][4];
#pragma unroll
  for (int i = 0; i < 2; ++i)
#pragma unroll
    for (int j = 0; j < 4; ++j) Y[i][j] = (f32x4){0.f, 0.f, 0.f, 0.f};
#pragma unroll 1
  for (int jh = 0; jh < 2; ++jh) {
    if (jh == 1) {
      __syncthreads();
      bf16_t* wb = sB + srow * LDC + scol;
      *(uint4*)(wb) = pb0; *(uint4*)(wb + 16 * LDC) = pb1; *(uint4*)(wb + 32 * LDC) = pb2; *(uint4*)(wb + 48 * LDC) = pb3;
      __syncthreads();
    }
#pragma unroll 1
    for (int dir = 0; dir < 2; ++dir) {
      const bool use = dir == 0 ? (jh <= half) : (jh >= half);
      if (!use) continue;
      bf16x8 xf[2][4];
#pragma unroll
      for (int ks = 0; ks < 2; ++ks)
#pragma unroll
        for (int pt = 0; pt < 4; ++pt)
          xf[ks][pt] = *(const bf16x8*)(WSB(OFF_XST) + (size_t)(hh * 64 + pt * 16 + lr) * 8192 + r0 + jh * 64 + ks * 32 + lg * 8);
      float ci[2], cj[4][4], dj[4][4];
#pragma unroll
      for (int it = 0; it < 2; ++it) ci[it] = cum[((size_t)dir * 8192 + r0 + qt * 32 + it * 16 + lr) * 8 + hh];
#pragma unroll
      for (int jt = 0; jt < 4; ++jt)
#pragma unroll
        for (int q = 0; q < 4; ++q) {
          const size_t tj = (size_t)dir * 8192 + r0 + jh * 64 + jt * 16 + lg * 4 + q;
          cj[jt][q] = cum[tj * 8 + hh];
          dj[jt][q] = dtv[tj * 8 + hh];
        }
#pragma unroll
      for (int it = 0; it < 2; ++it) {
        f32x4 cb[4];
#pragma unroll
        for (int jt = 0; jt < 4; ++jt) cb[jt] = (f32x4){0.f, 0.f, 0.f, 0.f};
#pragma unroll
        for (int ks = 0; ks < 4; ++ks) {
          const bf16x8 b = *(const bf16x8*)(sC + (it * 16 + lr) * LDC + ks * 32 + lg * 8);
#pragma unroll
          for (int jt = 0; jt < 4; ++jt) {
            const bf16x8 a = *(const bf16x8*)(sB + (jt * 16 + lr) * LDC + ks * 32 + lg * 8);
            cb[jt] = mfma16(a, b, cb[jt]);
          }
        }
        const int ti = qt * 32 + it * 16 + lr;
#pragma unroll
        for (int jt = 0; jt < 4; ++jt) {
          float v[4];
#pragma unroll
          for (int q = 0; q < 4; ++q) {
            const int tj = jh * 64 + jt * 16 + lg * 4 + q;
            const bool ok = dir == 0 ? (tj <= ti) : (tj >= ti);
            v[q] = ok ? cb[jt][q] * __expf(ci[it] - cj[jt][q]) * dj[jt][q] : 0.f;
          }
          uint2 o;
          o.x = pack2(v[0], v[1]);
          o.y = pack2(v[2], v[3]);
          *(uint2*)(sM + (it * 16 + lr) * LDM + jt * 16 + lg * 4) = o;
        }
        __builtin_amdgcn_sched_barrier(0);
      }
      asm volatile("s_waitcnt lgkmcnt(0)" ::: "memory");
#pragma unroll
      for (int ks = 0; ks < 2; ++ks) {
        bf16x8 af[2];
#pragma unroll
        for (int it = 0; it < 2; ++it) af[it] = *(const bf16x8*)(sM + (it * 16 + lr) * LDM + ks * 32 + lg * 8);
#pragma unroll
        for (int it = 0; it < 2; ++it)
#pragma unroll
          for (int pt = 0; pt < 4; ++pt) Y[it][pt] = mfma16(af[it], xf[ks][pt], Y[it][pt]);
      }
      asm volatile("s_waitcnt lgkmcnt(0)" ::: "memory");
      __builtin_amdgcn_sched_barrier(0);
    }
  }
#pragma unroll 1
  for (int dir = 0; dir < 2; ++dir) {
    const bf16_t* hp = WSB(OFF_H) + ((size_t)(dir * 64 + cidx) * 8 + hh) * 8192;
    float ei[2][4];
#pragma unroll
    for (int it = 0; it < 2; ++it)
#pragma unroll
      for (int q = 0; q < 4; ++q)
        ei[it][q] = __expf(cum[((size_t)dir * 8192 + r0 + qt * 32 + it * 16 + lg * 4 + q) * 8 + hh]);
#pragma unroll
    for (int pt = 0; pt < 4; ++pt) {
      bf16x8 bfr[4];
#pragma unroll
      for (int ks = 0; ks < 4; ++ks) bfr[ks] = *(const bf16x8*)(hp + (size_t)(pt * 16 + lr) * 128 + ks * 32 + lg * 8);
      f32x4 T[2];
#pragma unroll
      for (int it = 0; it < 2; ++it) T[it] = (f32x4){0.f, 0.f, 0.f, 0.f};
#pragma unroll
      for (int ks = 0; ks < 4; ++ks)
#pragma unroll
        for (int it = 0; it < 2; ++it) {
          const bf16x8 a = *(const bf16x8*)(sC + (it * 16 + lr) * LDC + ks * 32 + lg * 8);
          T[it] = mfma16(a, bfr[ks], T[it]);
        }
#pragma unroll
      for (int it = 0; it < 2; ++it)
#pragma unroll
        for (int q = 0; q < 4; ++q) Y[it][pt][q] += ei[it][q] * T[it][q];
    }
    __builtin_amdgcn_sched_barrier(0);
  }
  const float dsk = p.ssd_d[hh];
  const bf16_t* proj = WSB(OFF_R1);
#pragma unroll
  for (int i = 0; i < 2; ++i) {
#pragma unroll
    for (int q = 0; q < 4; ++q) {
      const int il = i * 16 + lg * 4 + q;
      const size_t r = (size_t)r0 + qt * 32 + il;
      float ss = 0.f;
#pragma unroll
      for (int j = 0; j < 4; ++j) {
        const int ch = hh * 64 + j * 16 + lr;
        const float xs = bf2f(WSB(OFF_XS)[r * 512 + ch]);
        const float z = bf2f(proj[r * 2080 + 544 + ch]);
        const float y = (Y[i][j][q] + dsk * xs) * silu(z);
        Y[i][j][q] = y;
        ss += y * y;
      }
      ss += __shfl_xor(ss, 1, 64);
      ss += __shfl_xor(ss, 2, 64);
      ss += __shfl_xor(ss, 4, 64);
      ss += __shfl_xor(ss, 8, 64);
      if (lr == 0) rowss[wave * 64 + il] = ss;
    }
    __builtin_amdgcn_sched_barrier(0);
  }
  __syncthreads();
#pragma unroll
  for (int i = 0; i < 2; ++i) {
#pragma unroll
    for (int q = 0; q < 4; ++q) {
      const int il = i * 16 + lg * 4 + q;
      const size_t r = (size_t)r0 + qt * 32 + il;
      const float tot = rowss[il] + rowss[64 + il] + rowss[128 + il] + rowss[192 + il];
      const float rs = rsqrtf(tot * (1.f / 256.f) + 1e-6f);
#pragma unroll
      for (int j = 0; j < 4; ++j) {
        const int ch = hh * 64 + j * 16 + lr;
        WSB(OFF_CAT)[r * 1024 + 512 + ch] = f2bf(Y[i][j][q] * rs * p.ssd_norm[ch]);
      }
    }
    __builtin_amdgcn_sched_barrier(0);
  }
  __syncthreads();
}

template <int W2>
DEVI void pool_item(const bf16_t* __restrict__ h, bf16_t* __restrict__ dst, int r, int cc) {
  int s0, L;
  if (r < 4096) { s0 = r & ~255; L = 256; } else { s0 = 4096 + ((r - 4096) & ~2047); L = 2048; }
  const int t = r - s0;
  const int lo = max(t - W2, 0), hi = min(t + W2, L);
  uint4 v[2 * W2];
#pragma unroll
  for (int k = 0; k < 2 * W2; ++k) {
    const int u = min(max(t - W2 + k, 0), L - 1);
    v[k] = *(const uint4*)(h + (size_t)(s0 + u) * 1024 + cc);
  }
  float acc[8] = {0, 0, 0, 0, 0, 0, 0, 0};
#pragma unroll
  for (int k = 0; k < 2 * W2; ++k) {
    const int u = t - W2 + k;
    const float m = (u >= 0 && u < L) ? 1.f : 0.f;
    acc[0] += m * __uint_as_float(v[k].x << 16); acc[1] += m * __uint_as_float(v[k].x & 0xffff0000u);
    acc[2] += m * __uint_as_float(v[k].y << 16); acc[3] += m * __uint_as_float(v[k].y & 0xffff0000u);
    acc[4] += m * __uint_as_float(v[k].z << 16); acc[5] += m * __uint_as_float(v[k].z & 0xffff0000u);
    acc[6] += m * __uint_as_float(v[k].w << 16); acc[7] += m * __uint_as_float(v[k].w & 0xffff0000u);
  }
  const float inv = 1.f / (float)(hi - lo);
  const uint4 c = v[W2];
  uint4 o;
  o.x = pack2(acc[0] * inv - __uint_as_float(c.x << 16), acc[1] * inv - __uint_as_float(c.x & 0xffff0000u));
  o.y = pack2(acc[2] * inv - __uint_as_float(c.y << 16), acc[3] * inv - __uint_as_float(c.y & 0xffff0000u));
  o.z = pack2(acc[4] * inv - __uint_as_float(c.z << 16), acc[5] * inv - __uint_as_float(c.z & 0xffff0000u));
  o.w = pack2(acc[6] * inv - __uint_as_float(c.w << 16), acc[7] * inv - __uint_as_float(c.w & 0xffff0000u));
  *(uint4*)(dst + (size_t)r * 1024 + cc) = o;
}

NOINL void pool_phase(const P& p) {
  const bf16_t* h = WSB(OFF_H);
  bf16_t* dst = WSB(OFF_CAT);
  const int total = 8192 * 128;
  for (int idx = blockIdx.x * 512 + threadIdx.x; idx < total; idx += gridDim.x * 512) {
    const int c32 = idx & 31, rlo = (idx >> 5) & 1, gi = (idx >> 6) & 3, rhi = idx >> 8;
    const int r = rhi * 2 + rlo, cc = gi * 256 + c32 * 8;
    if (gi == 0) pool_item<1>(h, dst, r, cc);
    else if (gi == 1) pool_item<2>(h, dst, r, cc);
    else if (gi == 2) pool_item<4>(h, dst, r, cc);
    else pool_item<8>(h, dst, r, cc);
  }
}

NOINL void ph_gemm_proj(const P& p) {
  bf16_t* proj = WSB(OFF_R1);
  float* dtraw = WSF(OFF_DTRAW);
  const bf16_t* A = WSB(OFF_H);
  const bf16_t* B = WSB(OFF_WIN);
  auto epi_main = [&](int ctx, int row, int col, f32x4 v0, f32x4 v1) {
#pragma unroll
    for (int q = 0; q < 4; ++q) {
      proj[(size_t)(row + q) * 2080 + col] = f2bf(v0[q]);
      proj[(size_t)(row + q) * 2080 + col + 16] = f2bf(v1[q]);
    }
  };
  auto epi = [&](int ctx, int row, int col, f32x4 v0, f32x4 v1) {
#pragma unroll
    for (int q = 0; q < 4; ++q) {
      if (col < 2080) proj[(size_t)(row + q) * 2080 + col] = f2bf(v0[q]);
      else if (col < 2096) dtraw[(size_t)(row + q) * 16 + (col - 2080)] = v0[q];
      if (col + 16 < 2080) proj[(size_t)(row + q) * 2080 + col + 16] = f2bf(v1[q]);
      else if (col + 16 < 2096) dtraw[(size_t)(row + q) * 16 + (col + 16 - 2080)] = v1[q];
    }
  };
  gemm8_stream(256, 1024, 1024, 1024,
    [=](int t) {
      TileInfo r;
      int m, n; tile_mn(t, 32, 8, m, n);
      r.m0 = m * 256; r.n0 = n * 256; r.ctx = 0;
      r.a = A + (size_t)r.m0 * 1024; r.b = B + (size_t)r.n0 * 1024;
      return r;
    }, epi_main);
  gemm_stream(64, 1024, 1024, 1024, g_smem + VB * 73728,
    [=](int t) {
      TileInfo r;
      r.m0 = t * 128; r.n0 = 2048; r.ctx = 0;
      r.a = A + (size_t)r.m0 * 1024; r.b = B + (size_t)2048 * 1024;
      return r;
    }, epi);
}

NOINL void ph_gemm_f32out(const P& p, const bf16_t* A, int lda, const bf16_t* B, int ldb, int K, bf16_t* C, int N) {
  const int nN = N / 128;
  gemm_stream(64 * nN, lda, ldb, K, g_smem + VB * 73728,
    [=](int t) {
      TileInfo r;
      int m, n; tile_mn(t, 64, nN, m, n);
      r.m0 = m * 128; r.n0 = n * 128; r.ctx = 0;
      r.a = A + (size_t)r.m0 * lda; r.b = B + (size_t)r.n0 * ldb;
      return r;
    },
    [&](int ctx, int row, int col, f32x4 v0, f32x4 v1) {
#pragma unroll
      for (int q = 0; q < 4; ++q) {
        C[(size_t)(row + q) * N + col] = f2bf(v0[q]);
        C[(size_t)(row + q) * N + col + 16] = f2bf(v1[q]);
      }
    });
}

NOINL void ph_gemm8_splitk(const P& p, const bf16_t* A, int lda, const bf16_t* B, int ldb, int Khalf, bf16_t* C0, bf16_t* C1) {
  gemm8_stream(256, lda, ldb, Khalf,
    [=](int t) {
      TileInfo r;
      const int id = swz_tile(t, 256);
      const int ks = id >> 7, rem = id & 127;
      r.m0 = (rem >> 2) * 256; r.n0 = (rem & 3) * 256; r.ctx = ks;
      r.a = A + (size_t)r.m0 * lda + (size_t)ks * Khalf; r.b = B + (size_t)r.n0 * ldb + (size_t)ks * Khalf;
      return r;
    },
    [&](int ks, int row, int col, f32x4 v0, f32x4 v1) {
      bf16_t* C = ks ? C1 : C0;
#pragma unroll
      for (int q = 0; q < 4; ++q) {
        C[(size_t)(row + q) * 1024 + col] = f2bf(v0[q]);
        C[(size_t)(row + q) * 1024 + col + 16] = f2bf(v1[q]);
      }
    });
}

NOINL void ph_gemm_qkv(const P& p) {
  bf16_t* qo = WSB(OFF_Q);
  bf16_t* kn = WSB(OFF_KN);
  bf16_t* vt = WSB(OFF_VT);
  const bf16_t* Aq = WSB(OFF_CQN);
  const bf16_t* Bq = WSB(OFF_WUQ);
  const bf16_t* Ak = WSB(OFF_CKV);
  const bf16_t* Bk = WSB(OFF_WUKV);
  gemm_stream(384 + 544, 256, 256, 256, g_smem + VB * 73728,
    [=](int t) {
      TileInfo r;
      int m, n;
      if (t < 384) {
        tile_mn(t, 64, 6, m, n);
        r.m0 = m * 128; r.n0 = n * 128; r.ctx = 0;
        r.a = Aq + (size_t)r.m0 * 256; r.b = Bq + (size_t)r.n0 * 256;
      } else {
        tile_mn(t - 384, 68, 8, m, n);
        r.m0 = m * 128; r.n0 = n * 128; r.ctx = 1;
        r.a = Ak + (size_t)r.m0 * 256; r.b = Bk + (size_t)r.n0 * 256;
      }
      return r;
    },
    [&](int ctx, int row, int col, f32x4 v0, f32x4 v1) {
      if (ctx == 0) {
        const float scl = 0.10206207261596575f * 1.4426950408889634f;
        const int tn = col >> 4;
        const bool rope = ((tn % 6) == 4) && (row >= 4096);
        const int ii = col & 15;
        const float fr = rope_freq(ii & 7);
#pragma unroll
        for (int q = 0; q < 4; ++q) {
          float a = v0[q], b = v1[q];
          if (rope) {
            const int tt = (row + q - 4096) & 2047;
            const float pos = (ii < 8) ? (float)(tt >> 6) : (float)(tt & 63);
            const float ang = pos * fr;
            float cs, sn;
            fast_sincos(ang, sn, cs);
            const float x1 = a, x2 = b;
            a = x1 * cs - x2 * sn;
            b = x1 * sn + x2 * cs;
          }
          qo[(size_t)(row + q) * 768 + col] = f2bf(a * scl);
          qo[(size_t)(row + q) * 768 + col + 16] = f2bf(b * scl);
        }
      } else {
        const int hh = col >> 7, j = col & 127;
        if (j < 64) {
#pragma unroll
          for (int q = 0; q < 4; ++q) {
            kn[(size_t)(row + q) * 512 + hh * 64 + j] = f2bf(v0[q]);
            kn[(size_t)(row + q) * 512 + hh * 64 + j + 16] = f2bf(v1[q]);
          }
        } else {
          uint2 o0, o1;
          o0.x = pack2(v0[0], v0[1]); o0.y = pack2(v0[2], v0[3]);
          o1.x = pack2(v1[0], v1[1]); o1.y = pack2(v1[2], v1[3]);
          *(uint2*)(vt + (size_t)(hh * 64 + j - 64) * 8704 + row) = o0;
          *(uint2*)(vt + (size_t)(hh * 64 + j - 64 + 16) * 8704 + row) = o1;
        }
      }
    });
}

NOINL void ph_gemm_ffn_up(const P& p, int layer) {
  bf16_t* gu = WSB(OFF_R1);
  const bf16_t* A = WSB(OFF_H);
  const bf16_t* B = WSB(OFF_WGU) + (size_t)layer * 5632 * 1024;
  gemm8_stream(32 * 22, 1024, 1024, 1024,
    [=](int t) {
      TileInfo r;
      int m, n; tile_mn(t, 32, 22, m, n);
      r.m0 = m * 256; r.n0 = n * 256; r.ctx = 0;
      r.a = A + (size_t)r.m0 * 1024; r.b = B + (size_t)r.n0 * 1024;
      return r;
    },
    [&](int ctx, int row, int col, f32x4 v0, f32x4 v1) {
      const int oc = (col >> 5) * 16 + (col & 15);
#pragma unroll
      for (int q = 0; q < 4; ++q) gu[(size_t)(row + q) * 2816 + oc] = f2bf(silu(v0[q]) * v1[q]);
    });
}

NOINL void ph_gemm_pool(const P& p) {
  bf16_t* mix = WSB(OFF_R1);
  const bf16_t* A = WSB(OFF_H);
  const bf16_t* B = WSB(OFF_WPOOL);
  gemm_stream(512, 1024, 256, 256, g_smem + VB * 73728,
    [=](int t) {
      TileInfo r;
      const int id = swz_tile(t, 512);
      const int g = id >> 7, rem = id & 127;
      r.m0 = (rem >> 1) * 128; r.n0 = (rem & 1) * 128; r.ctx = g;
      r.a = A + (size_t)r.m0 * 1024 + g * 256; r.b = B + (size_t)g * 65536 + (size_t)r.n0 * 256;
      return r;
    },
    [&](int g, int row, int col, f32x4 v0, f32x4 v1) {
      const int c0 = g * 256 + col;
      const float s0 = p.pool_scale[c0], s1 = p.pool_scale[c0 + 16];
#pragma unroll
      for (int q = 0; q < 4; ++q) {
        mix[(size_t)(row + q) * 1024 + c0] = f2bf(v0[q] * s0);
        mix[(size_t)(row + q) * 1024 + c0 + 16] = f2bf(v1[q] * s1);
      }
    });
}


#define XB_TMO      128
#define XB_XCNT(j)  (256  + 64 * (j))
#define XB_XSUB(j)  (1280 + 64 * (j))
#define XB_XGEN(j)  (2304 + 64 * (j))
#define XB_TOP      3328
#define XB_TOPGEN   3392
#define XCD_BAR_WORDS 3456
#define XB_SPIN_CAP (1u << 22)
#define LAS __attribute__((address_space(3)))
DEVI unsigned xb_ld(unsigned* p) { return __hip_atomic_load(p, __ATOMIC_RELAXED, __HIP_MEMORY_SCOPE_AGENT); }
DEVI unsigned xb_add(unsigned* p, unsigned v) { return __hip_atomic_fetch_add(p, v, __ATOMIC_RELAXED, __HIP_MEMORY_SCOPE_AGENT); }
DEVI unsigned xb_xcc_id() { return (unsigned)__builtin_amdgcn_s_getreg((3 << 11) | 20) & 0xFu; }
#define XB_SPIN(cond, bar) do { unsigned _sp = 0; while (cond) { __builtin_amdgcn_s_sleep(1); \
    if ((++_sp & 255u) == 0u) { if (xb_ld(&(bar)[XB_TMO])) break; if (_sp > XB_SPIN_CAP) { atomicAdd(&(bar)[XB_TMO], 1u); break; } } } } while (0)
struct XcdBarrier { unsigned* bar; unsigned x; volatile LAS unsigned* st; };
DEVI XcdBarrier xcd_barrier_post(unsigned* bar, volatile LAS unsigned* st) {
  XcdBarrier b; b.bar = bar; b.x = xb_xcc_id(); b.st = st;
  if (threadIdx.x == 0) (void)xb_add(&bar[XB_XCNT(b.x)], 1u);
  return b;
}
DEVI void xcd_barrier_complete(unsigned* bar, unsigned x, unsigned& nloc, unsigned& nx) {
  const unsigned G = gridDim.x * gridDim.y * gridDim.z;
  unsigned sum, cnt, mine, sp = 0u;
  for (;;) {
    sum = 0u; cnt = 0u; mine = 0u;
#pragma unroll
    for (unsigned j = 0; j < 16; ++j) { const unsigned c = xb_ld(&bar[XB_XCNT(j)]); sum += c; cnt += (c > 0u) ? 1u : 0u; mine = (j == x) ? c : mine; }
    if (sum == G) break;
    __builtin_amdgcn_s_sleep(1);
    if ((++sp & 255u) == 0u) { if (xb_ld(&bar[XB_TMO])) break; if (sp > XB_SPIN_CAP) { atomicAdd(&bar[XB_TMO], 1u); break; } }
  }
  nloc = mine > 0u ? mine : 1u; nx = cnt > 0u ? cnt : 1u;
}
DEVI void xcd_barrier(const XcdBarrier& b) {
  asm volatile("s_waitcnt vmcnt(0)" ::: "memory");
  __syncthreads();
  if (threadIdx.x == 0) {
    unsigned* bar = b.bar;
    __builtin_amdgcn_s_waitcnt(0);
    unsigned nloc = b.st[0], nx = b.st[1];
    if (nloc == 0u) { xcd_barrier_complete(bar, b.x, nloc, nx); b.st[0] = nloc; b.st[1] = nx; }
    const unsigned old = xb_add(&bar[XB_XSUB(b.x)], 1u);
    const unsigned gen = old / nloc;
    if (old + 1u == (gen + 1u) * nloc) {
      __builtin_amdgcn_fence(__ATOMIC_RELEASE, "agent");
      asm volatile("s_waitcnt vmcnt(0)" ::: "memory");
      const unsigned og = xb_add(&bar[XB_TOP], 1u);
      const unsigned tg = og / nx;
      if (og + 1u == (tg + 1u) * nx) xb_add(&bar[XB_TOPGEN], 1u);
      else XB_SPIN(xb_ld(&bar[XB_TOPGEN]) == tg, bar);
      __builtin_amdgcn_fence(__ATOMIC_ACQUIRE, "agent");
      xb_add(&bar[XB_XGEN(b.x)], 1u);
      asm volatile("s_waitcnt vmcnt(0)" ::: "memory");
    } else {
      XB_SPIN(xb_ld(&bar[XB_XGEN(b.x)]) == gen, bar);
      __builtin_amdgcn_fence(__ATOMIC_ACQUIRE, "agent");
      asm volatile("s_waitcnt vmcnt(0)" ::: "memory");
    }
  }
  __syncthreads();
}

constexpr int NPHASE = 18;
#ifndef REPMASK
#define REPMASK 0
#endif
#ifndef ATPROBE
#define ATPROBE 0
#endif
#ifndef P6PROBE
#define P6PROBE 1
#endif
#ifndef PHMASK
#define PHMASK 0x3ffff
#endif
#define PH(n) if constexpr ((PHMASK >> (n)) & 1)

__global__ void __launch_bounds__(512, 2) mega(P p, int lo, int hi) {
  __shared__ uint4 xb_words;
  if (threadIdx.x == 0) xb_words = make_uint4(0u, 0u, 0u, 0u);
  __syncthreads();
  XcdBarrier xb = xcd_barrier_post((unsigned*)(p.ws + OFF_BAR), (volatile LAS unsigned*)&xb_words);
  if (lo < 0) cg::this_grid().sync();
  PH(0) if (lo <= 0 && 0 < hi) {
#if (REPMASK >> 0) & 1
    int nrep = 2; asm volatile("" : "+s"(nrep));
    for (int rep = 0; rep < nrep; ++rep) {
      if (rep) xcd_barrier(xb);
#else
    {
#endif
        for (int t0_ = blockIdx.x * 2; t0_ < 384 + 5200; t0_ += gridDim.x * 2) {
          const int t = min(t0_ + VB, 384 + 5200 - 1);
          if (t < 384) gemv_tile(p, t); else transpose_tile(p, t - 384);
        }
    }
  }
  if (lo <= 0 && 0 + 1 < hi) xcd_barrier(xb);
  PH(1) if (lo <= 1 && 1 < hi) {
#if (REPMASK >> 1) & 1
    int nrep = 2; asm volatile("" : "+s"(nrep));
    for (int rep = 0; rep < nrep; ++rep) {
      if (rep) xcd_barrier(xb);
#else
    {
#endif
        rowop<false, true, true, false, false>(p, nullptr, nullptr, nullptr, 0, p.n_pre_mix, 0, 1, 0, 0);
    }
  }
  if (lo <= 1 && 1 + 1 < hi) xcd_barrier(xb);
  PH(2) if (lo <= 2 && 2 < hi) {
#if (REPMASK >> 2) & 1
    int nrep = 2; asm volatile("" : "+s"(nrep));
    for (int rep = 0; rep < nrep; ++rep) {
      if (rep) xcd_barrier(xb);
#else
    {
#endif
        ph_gemm_proj(p);
    }
  }
  if (lo <= 2 && 2 + 1 < hi) xcd_barrier(xb);
  PH(3) if (lo <= 3 && 3 < hi) {
#if (REPMASK >> 3) & 1
    int nrep = 2; asm volatile("" : "+s"(nrep));
    for (int rep = 0; rep < nrep; ++rep) {
      if (rep) xcd_barrier(xb);
#else
    {
#endif
        prep_rows(p);
        prep_cache(p);
        for (int t0_ = VT_FIRST; t0_ < 2048; t0_ += gridDim.x * 2) conv_tile(p, min(t0_ + VT_OFF, 2047));
    }
  }
  if (lo <= 3 && 3 + 1 < hi) xcd_barrier(xb);
  PH(4) if (lo <= 4 && 4 < hi) {
#if (REPMASK >> 4) & 1
    int nrep = 2; asm volatile("" : "+s"(nrep));
    for (int rep = 0; rep < nrep; ++rep) {
      if (rep) xcd_barrier(xb);
#else
    {
#endif
        ph_gemm_qkv(p);
        for (int t0_ = VT_FIRST; t0_ < 512; t0_ += gridDim.x * 2) chunk_state_item(p, min(t0_ + VT_OFF, 511));
    }
  }
  if (lo <= 4 && 4 + 1 < hi) xcd_barrier(xb);
  PH(5) if (lo <= 5 && 5 < hi) {
#if (REPMASK >> 5) & 1
    int nrep = 2; asm volatile("" : "+s"(nrep));
    for (int rep = 0; rep < nrep; ++rep) {
      if (rep) xcd_barrier(xb);
#else
    {
#endif
        scan_states(p);
    }
  }
  if (lo <= 5 && 5 + 1 < hi) xcd_barrier(xb);
  PH(6) if (lo <= 6 && 6 < hi) {
#if (REPMASK >> 6) & 1
    int nrep = 2; asm volatile("" : "+s"(nrep));
    for (int rep = 0; rep < nrep; ++rep) {
      if (rep) xcd_barrier(xb);
#else
    {
#endif
        for (int t = blockIdx.x; t < 512; t += gridDim.x) attn8_item(p, t);
        for (int t0_ = VT_FIRST; t0_ < 512; t0_ += gridDim.x * 2) ssd_y_item(p, min(t0_ + VT_OFF, 511));
    }
  }
  if (lo <= 6 && 6 + 1 < hi) xcd_barrier(xb);
  PH(7) if (lo <= 7 && 7 < hi) {
#if (REPMASK >> 7) & 1
    int nrep = 2; asm volatile("" : "+s"(nrep));
    for (int rep = 0; rep < nrep; ++rep) {
      if (rep) xcd_barrier(xb);
#else
    {
#endif
        ph_gemm8_splitk(p, WSB(OFF_CAT), 1024, WSB(OFF_WOUT), 1024, 512, WSB(OFF_R1), WSB(OFF_R1) + (size_t)8192 * 1024);
    }
  }
  if (lo <= 7 && 7 + 1 < hi) xcd_barrier(xb);
  PH(8) if (lo <= 8 && 8 < hi) {
#if (REPMASK >> 8) & 1
    int nrep = 2; asm volatile("" : "+s"(nrep));
    for (int rep = 0; rep < nrep; ++rep) {
      if (rep) xcd_barrier(xb);
#else
    {
#endif
        rowop<true, true, true, false, true>(p, WSB(OFF_R1), WSB(OFF_R1) + (size_t)8192 * 1024, p.n_post_mix, 2, p.n_pre_ffn, 3, 4, 0, 0);
    }
  }
  if (lo <= 8 && 8 + 1 < hi) xcd_barrier(xb);
  PH(9) if (lo <= 9 && 9 < hi) {
#if (REPMASK >> 9) & 1
    int nrep = 2; asm volatile("" : "+s"(nrep));
    for (int rep = 0; rep < nrep; ++rep) {
      if (rep) xcd_barrier(xb);
#else
    {
#endif
        ph_gemm_ffn_up(p, 0);
    }
  }
  if (lo <= 9 && 9 + 1 < hi) xcd_barrier(xb);
  PH(10) if (lo <= 10 && 10 < hi) {
#if (REPMASK >> 10) & 1
    int nrep = 2; asm volatile("" : "+s"(nrep));
    for (int rep = 0; rep < nrep; ++rep) {
      if (rep) xcd_barrier(xb);
#else
    {
#endif
        ph_gemm8_splitk(p, WSB(OFF_R1), 2816, WSB(OFF_WDN), 2816, 1408, WSB(OFF_R2), WSB(OFF_R2) + (size_t)8192 * 1024);
    }
  }
  if (lo <= 10 && 10 + 1 < hi) xcd_barrier(xb);
  PH(11) if (lo <= 11 && 11 < hi) {
#if (REPMASK >> 11) & 1
    int nrep = 2; asm volatile("" : "+s"(nrep));
    for (int rep = 0; rep < nrep; ++rep) {
      if (rep) xcd_barrier(xb);
#else
    {
#endif
        rowop<true, true, false, false, true>(p, WSB(OFF_R2), WSB(OFF_R2) + (size_t)8192 * 1024, p.n_post_ffn, 5, p.n_pre_mix + 1024, 0, 1, 0, 1);
    }
  }
  if (lo <= 11 && 11 + 1 < hi) xcd_barrier(xb);
  PH(12) if (lo <= 12 && 12 < hi) {
#if (REPMASK >> 12) & 1
    int nrep = 2; asm volatile("" : "+s"(nrep));
    for (int rep = 0; rep < nrep; ++rep) {
      if (rep) xcd_barrier(xb);
#else
    {
#endif
    }
  }
  PH(13) if (lo <= 13 && 13 < hi) {
#if (REPMASK >> 13) & 1
    int nrep = 2; asm volatile("" : "+s"(nrep));
    for (int rep = 0; rep < nrep; ++rep) {
      if (rep) xcd_barrier(xb);
#else
    {
#endif
        ph_gemm_pool(p);
    }
  }
  if (lo <= 13 && 13 + 1 < hi) xcd_barrier(xb);
  PH(14) if (lo <= 14 && 14 < hi) {
#if (REPMASK >> 14) & 1
    int nrep = 2; asm volatile("" : "+s"(nrep));
    for (int rep = 0; rep < nrep; ++rep) {
      if (rep) xcd_barrier(xb);
#else
    {
#endif
        rowop<true, true, false, false, false, true>(p, WSB(OFF_R1), nullptr, p.n_post_mix + 1024, 2, p.n_pre_ffn + 1024, 3, 4, 1, 1);
    }
  }
  if (lo <= 14 && 14 + 1 < hi) xcd_barrier(xb);
  PH(15) if (lo <= 15 && 15 < hi) {
#if (REPMASK >> 15) & 1
    int nrep = 2; asm volatile("" : "+s"(nrep));
    for (int rep = 0; rep < nrep; ++rep) {
      if (rep) xcd_barrier(xb);
#else
    {
#endif
        ph_gemm_ffn_up(p, 1);
    }
  }
  if (lo <= 15 && 15 + 1 < hi) xcd_barrier(xb);
  PH(16) if (lo <= 16 && 16 < hi) {
#if (REPMASK >> 16) & 1
    int nrep = 2; asm volatile("" : "+s"(nrep));
    for (int rep = 0; rep < nrep; ++rep) {
      if (rep) xcd_barrier(xb);
#else
    {
#endif
        ph_gemm8_splitk(p, WSB(OFF_R1), 2816, WSB(OFF_WDN) + (size_t)1024 * 2816, 2816, 1408, WSB(OFF_R2), WSB(OFF_R2) + (size_t)8192 * 1024);
    }
  }
  if (lo <= 16 && 16 + 1 < hi) xcd_barrier(xb);
  PH(17) if (lo <= 17 && 17 < hi) {
#if (REPMASK >> 17) & 1
    int nrep = 2; asm volatile("" : "+s"(nrep));
    for (int rep = 0; rep < nrep; ++rep) {
      if (rep) xcd_barrier(xb);
#else
    {
#endif
        rowop<true, false, false, true, true>(p, WSB(OFF_R2), WSB(OFF_R2) + (size_t)8192 * 1024, p.n_post_ffn + 1024, 5, nullptr, 0, 0, 1, 1);
    }
  }
}

extern "C" void kernel_launch(void* const* d_in, const int* in_sizes, int n_in, void* d_out, int out_size, void* d_ws,
                              size_t ws_size, hipStream_t stream) {
  P p{};
  const float** f = (const float**)&p;
  for (int i = 0; i < 33; ++i) f[i] = (const float*)d_in[i];
  p.out = (float*)d_out;
  p.ws = (char*)d_ws;
  static int grid_blocks = 0;
  if (!grid_blocks) {
    int dev = 0, cus = 0, per_cu = 0;
    hipGetDevice(&dev);
    hipDeviceGetAttribute(&cus, hipDeviceAttributeMultiprocessorCount, dev);
    hipOccupancyMaxActiveBlocksPerMultiprocessor(&per_cu, mega, 512, 0);
    if (per_cu > 1) per_cu = 1;
    if (per_cu < 1) per_cu = 1;
    grid_blocks = cus * per_cu;
  }
  hipMemsetAsync((char*)d_ws + OFF_BAR, 0, XCD_BAR_WORDS * 4, stream);
#if SINGLE_LAUNCH
  int lo = 0, hi = NPHASE;
  void* args[] = {&p, &lo, &hi};
  hipError_t e = hipLaunchCooperativeKernel((void*)mega, dim3(grid_blocks), dim3(512), args, 0, stream);
  if (e != hipSuccess) fprintf(stderr, "cooperative launch failed: %s (grid %d)\n", hipGetErrorString(e), grid_blocks);
#else
  for (int ph = 0; ph < NPHASE; ++ph) mega<<<grid_blocks, 512, 0, stream>>>(p, ph, ph + 1);
#endif
}
```

```cpp
#include <hip/hip_runtime.h>
#include <hip/hip_cooperative_groups.h>
#include <stdint.h>
#include <stdio.h>
namespace cg = cooperative_groups;

#ifndef SINGLE_LAUNCH
#define SINGLE_LAUNCH 1
#endif

typedef __attribute__((ext_vector_type(8))) short bf16x8;
typedef __attribute__((ext_vector_type(4))) float f32x4;
typedef unsigned short bf16_t;

#define DEVI __device__ __forceinline__

constexpr size_t OFF_WIN   = 0;
constexpr size_t OFF_WUQ   = OFF_WIN   + (size_t)2176*1024*2;
constexpr size_t OFF_WUKV  = OFF_WUQ   + (size_t)768*256*2;
constexpr size_t OFF_WOUT  = OFF_WUKV  + (size_t)1024*256*2;
constexpr size_t OFF_WPOOL = OFF_WOUT  + (size_t)1024*1024*2;
constexpr size_t OFF_WGU   = OFF_WPOOL + (size_t)4*256*256*2;
constexpr size_t OFF_WDN   = OFF_WGU   + (size_t)2*5632*1024*2;
constexpr size_t OFF_MOD   = OFF_WDN   + (size_t)2*1024*2816*2;
constexpr size_t OFF_R1    = OFF_MOD   + (size_t)2*3*6144*4;
constexpr size_t OFF_DTRAW = OFF_R1    + (size_t)8192*2080*2;
constexpr size_t OFF_R2    = OFF_R1    + (size_t)8192*2096*4;
constexpr size_t OFF_H     = OFF_R2    + (size_t)8192*1024*4;
constexpr size_t OFF_CAT   = OFF_H     + (size_t)8192*1024*2;
constexpr size_t OFF_Q     = OFF_CAT   + (size_t)8192*1024*2;
constexpr size_t OFF_KN    = OFF_Q     + (size_t)8192*768*2;
constexpr size_t OFF_VT    = OFF_KN    + (size_t)8704*512*2;
constexpr size_t OFF_CQN   = OFF_VT    + (size_t)8704*512*2;
constexpr size_t OFF_CKV   = OFF_CQN   + (size_t)8192*256*2;
constexpr size_t OFF_KPE   = OFF_CKV   + (size_t)8704*256*2;
constexpr size_t OFF_XS    = OFF_KPE   + (size_t)8704*32*2;
constexpr size_t OFF_XST   = OFF_XS    + (size_t)8192*512*2;
constexpr size_t OFF_BM    = OFF_XST   + (size_t)8192*512*2;
constexpr size_t OFF_BT    = OFF_BM    + (size_t)8192*256*2;
constexpr size_t OFF_CM    = OFF_BT    + (size_t)8192*256*2;
constexpr size_t OFF_DTV   = OFF_CM    + (size_t)8192*256*2;
constexpr size_t OFF_CUM   = OFF_DTV   + (size_t)2*8192*8*4;
constexpr size_t OFF_TOT   = OFF_CUM   + (size_t)2*8192*8*4;
constexpr size_t OFF_BAR   = OFF_TOT   + 4096;
constexpr size_t OFF_XR    = OFF_BAR   + 16384;
constexpr size_t OFF_END   = OFF_XR    + (size_t)8192*1024*2;
static_assert(OFF_END <= ((size_t)256 << 20), "workspace map exceeds 256 MiB");

constexpr size_t OUT_CKV = 8388608, OUT_KR = 9437184, OUT_SF = 9568256, OUT_SB = 10616832;

struct P {
  const float *x_prompt, *x_sample, *c, *cache_ckv, *cache_kr, *st_f, *st_b, *c_ctx;
  const float *w_mod, *b_mod, *n_pre_mix, *n_post_mix, *n_pre_ffn, *n_post_ffn;
  const float *w_in, *q_norm, *w_uq, *kv_norm, *w_ukv, *conv_w, *conv_b, *dtb_f, *dtb_b, *alog_f, *alog_b;
  const float *ssd_d, *ssd_norm, *w_out, *pool_w, *pool_scale, *w_gate, *w_up, *w_down;
  float* out;
  char* ws;
};

#define WSB(off) ((bf16_t*)(p.ws + (off)))
#define WSF(off) ((float*)(p.ws + (off)))

typedef __bf16 hwbf16x2 __attribute__((ext_vector_type(2)));
typedef float hwf32x2 __attribute__((ext_vector_type(2)));
DEVI bf16_t f2bf(float f) {
  __bf16 r = (__bf16)f;
  return __builtin_bit_cast(bf16_t, r);
}
DEVI float bf2f(bf16_t b) { return __uint_as_float(((unsigned)b) << 16); }
DEVI unsigned pack2(float a, float b) {
  hwf32x2 v = {a, b};
  hwbf16x2 r = __builtin_convertvector(v, hwbf16x2);
  return __builtin_bit_cast(unsigned, r);
}
DEVI float silu(float x) { return x / (1.f + __expf(-x)); }
DEVI float wave_sum(float v) {
#pragma unroll
  for (int o = 32; o > 0; o >>= 1) v += __shfl_xor(v, o, 64);
  return v;
}
DEVI f32x4 mfma16(bf16x8 a, bf16x8 b, f32x4 c) { return __builtin_amdgcn_mfma_f32_16x16x32_bf16(a, b, c, 0, 0, 0); }

DEVI float rope_freq(int m) { return exp2f(-(float)m * 1.6609640474436813f); }
DEVI void fast_sincos(float ang, float& sn, float& cs) {
  float rev = ang * 0.15915494309189535f;
  rev -= rintf(rev);
  sn = __builtin_amdgcn_sinf(rev);
  cs = __builtin_amdgcn_cosf(rev);
}
typedef unsigned hwu32x2 __attribute__((ext_vector_type(2)));
DEVI float quad_max(float x) {
  hwu32x2 r = __builtin_amdgcn_permlane16_swap(__float_as_uint(x), __float_as_uint(x), false, false);
  x = fmaxf(__uint_as_float(r[0]), __uint_as_float(r[1]));
  r = __builtin_amdgcn_permlane32_swap(__float_as_uint(x), __float_as_uint(x), false, false);
  return fmaxf(__uint_as_float(r[0]), __uint_as_float(r[1]));
}
DEVI float quad_sum(float x) {
  hwu32x2 r = __builtin_amdgcn_permlane16_swap(__float_as_uint(x), __float_as_uint(x), false, false);
  x = __uint_as_float(r[0]) + __uint_as_float(r[1]);
  r = __builtin_amdgcn_permlane32_swap(__float_as_uint(x), __float_as_uint(x), false, false);
  return __uint_as_float(r[0]) + __uint_as_float(r[1]);
}
#define VB ((int)(threadIdx.x >> 8))
#define VT_PAIRG (gridDim.x == 256u)
#define VT_FIRST ((int)(VT_PAIRG ? blockIdx.x : blockIdx.x * 2u))
#define VT_OFF ((int)(VT_PAIRG ? VB * gridDim.x : VB))
DEVI int opaque_tid() { int t = threadIdx.x & 255; asm volatile("" : "+v"(t)); return t; }
typedef float nt_f4 __attribute__((ext_vector_type(4)));
typedef unsigned nt_u2 __attribute__((ext_vector_type(2)));
DEVI float4 ld_nt_f4(const float* p) { const nt_f4 v = __builtin_nontemporal_load((const nt_f4*)p); return make_float4(v[0], v[1], v[2], v[3]); }
DEVI uint2 ld_nt_u2(const bf16_t* p) { const nt_u2 v = __builtin_nontemporal_load((const nt_u2*)p); return make_uint2(v[0], v[1]); }
DEVI int swz_tile(int t, int T) {
  int q = T >> 3, r = T & 7, x = t & 7, off = t >> 3;
  return (x < r ? x * (q + 1) : r * (q + 1) + (x - r) * q) + off;
}

__shared__ __attribute__((aligned(16))) char g_smem[2 * 73728];
#define NOINL __device__ __forceinline__

constexpr int LDT = 72;
constexpr int TILE_E = 128 * LDT;

template <class Epi>
DEVI void gemm_tile(const bf16_t* __restrict__ A, int lda, const bf16_t* __restrict__ B, int ldb, int K,
                    int m0, int n0, char* smem, Epi epi) {
  const int tid = opaque_tid(), lane = tid & 63, wave = tid >> 6, wm = wave >> 1, wn = wave & 1;
  const int lr = lane & 15, lg = lane >> 4;
  bf16_t* sA = (bf16_t*)smem;
  bf16_t* sB = sA + 2 * TILE_E;
  f32x4 acc[4][4];
#pragma unroll
  for (int i = 0; i < 4; ++i)
#pragma unroll
    for (int j = 0; j < 4; ++j) acc[i][j] = (f32x4){0.f, 0.f, 0.f, 0.f};
  const int lrow = tid >> 3, lkc = (tid & 7) * 8;
  const bf16_t* gA = A + (size_t)(m0 + lrow) * lda + lkc;
  const bf16_t* gB = B + (size_t)(n0 + lrow) * ldb + lkc;
  uint4 ra[4], rb[4];
#pragma unroll
  for (int i = 0; i < 4; ++i) {
    ra[i] = *(const uint4*)(gA + (size_t)(32 * i) * lda);
    rb[i] = *(const uint4*)(gB + (size_t)(32 * i) * ldb);
  }
#pragma unroll
  for (int i = 0; i < 4; ++i) {
    *(uint4*)(sA + (lrow + 32 * i) * LDT + lkc) = ra[i];
    *(uint4*)(sB + (lrow + 32 * i) * LDT + lkc) = rb[i];
  }
  __syncthreads();
  const int nk = K >> 6;
  for (int kt = 0; kt < nk; ++kt) {
    const int cur = kt & 1;
    if (kt + 1 < nk) {
      const int k0 = (kt + 1) << 6;
#pragma unroll
      for (int i = 0; i < 4; ++i) {
        ra[i] = *(const uint4*)(gA + (size_t)(32 * i) * lda + k0);
        rb[i] = *(const uint4*)(gB + (size_t)(32 * i) * ldb + k0);
      }
    }
    const bf16_t* cA = sA + cur * TILE_E + (wm * 64 + lr) * LDT + lg * 8;
    const bf16_t* cB = sB + cur * TILE_E + (wn * 64 + lr) * LDT + lg * 8;
#pragma unroll
    for (int ks = 0; ks < 2; ++ks) {
      bf16x8 af[4], bfr[4];
#pragma unroll
      for (int i = 0; i < 4; ++i) {
        af[i] = *(const bf16x8*)(cA + i * 16 * LDT + ks * 32);
        bfr[i] = *(const bf16x8*)(cB + i * 16 * LDT + ks * 32);
      }
#pragma unroll
      for (int i = 0; i < 4; ++i)
#pragma unroll
        for (int j = 0; j < 4; ++j) acc[i][j] = mfma16(af[i], bfr[j], acc[i][j]);
    }
    if (kt + 1 < nk) {
      const int nx = cur ^ 1;
#pragma unroll
      for (int i = 0; i < 4; ++i) {
        *(uint4*)(sA + nx * TILE_E + (lrow + 32 * i) * LDT + lkc) = ra[i];
        *(uint4*)(sB + nx * TILE_E + (lrow + 32 * i) * LDT + lkc) = rb[i];
      }
    }
    __syncthreads();
  }
#pragma unroll
  for (int i = 0; i < 4; ++i)
#pragma unroll
    for (int j = 0; j < 4; j += 2)
      epi(m0 + wm * 64 + i * 16 + lg * 4, n0 + wn * 64 + j * 16 + lr, acc[i][j], acc[i][j + 1]);
}

struct TileInfo { const bf16_t* a; const bf16_t* b; int m0, n0, ctx; };
template <class TileFn, class Epi>
DEVI void gemm_stream(int T, int lda, int ldb, int K, char* smem, TileFn tf, Epi epi) {
  int t0 = VT_FIRST;
  if (t0 >= T) return;
  int t = min(t0 + VT_OFF, T - 1);
  const int tid = opaque_tid(), lane = tid & 63, wave = tid >> 6, wm = wave >> 1, wn = wave & 1;
  const int lr = lane & 15, lg = lane >> 4;
  bf16_t* sA = (bf16_t*)smem;
  bf16_t* sB = sA + 2 * TILE_E;
  const int lrow = tid >> 3, lkc = (tid & 7) * 8;
  TileInfo ti = tf(t);
  const bf16_t* gA = ti.a + (size_t)lrow * lda + lkc;
  const bf16_t* gB = ti.b + (size_t)lrow * ldb + lkc;
  int m0 = ti.m0, n0 = ti.n0, ctx = ti.ctx;
  uint4 ra0, ra1, ra2, ra3, rb0, rb1, rb2, rb3;
  uint4 rc0, rc1, rc2, rc3, rd0, rd1, rd2, rd3;
#define GS_LOAD0(pa, pb) \
  ra0 = *(const uint4*)((pa)); ra1 = *(const uint4*)((pa) + (size_t)32 * lda); \
  ra2 = *(const uint4*)((pa) + (size_t)64 * lda); ra3 = *(const uint4*)((pa) + (size_t)96 * lda); \
  rb0 = *(const uint4*)((pb)); rb1 = *(const uint4*)((pb) + (size_t)32 * ldb); \
  rb2 = *(const uint4*)((pb) + (size_t)64 * ldb); rb3 = *(const uint4*)((pb) + (size_t)96 * ldb);
#define GS_LOAD1(pa, pb) \
  rc0 = *(const uint4*)((pa)); rc1 = *(const uint4*)((pa) + (size_t)32 * lda); \
  rc2 = *(const uint4*)((pa) + (size_t)64 * lda); rc3 = *(const uint4*)((pa) + (size_t)96 * lda); \
  rd0 = *(const uint4*)((pb)); rd1 = *(const uint4*)((pb) + (size_t)32 * ldb); \
  rd2 = *(const uint4*)((pb) + (size_t)64 * ldb); rd3 = *(const uint4*)((pb) + (size_t)96 * ldb);
#define GS_WRITE0(buf) { \
  bf16_t* wa = sA + (buf) * TILE_E + lrow * LDT + lkc; bf16_t* wb = sB + (buf) * TILE_E + lrow * LDT + lkc; \
  *(uint4*)(wa) = ra0; *(uint4*)(wa + 32 * LDT) = ra1; *(uint4*)(wa + 64 * LDT) = ra2; *(uint4*)(wa + 96 * LDT) = ra3; \
  *(uint4*)(wb) = rb0; *(uint4*)(wb + 32 * LDT) = rb1; *(uint4*)(wb + 64 * LDT) = rb2; *(uint4*)(wb + 96 * LDT) = rb3; }
#define GS_WRITE1(buf) { \
  bf16_t* wa = sA + (buf) * TILE_E + lrow * LDT + lkc; bf16_t* wb = sB + (buf) * TILE_E + lrow * LDT + lkc; \
  *(uint4*)(wa) = rc0; *(uint4*)(wa + 32 * LDT) = rc1; *(uint4*)(wa + 64 * LDT) = rc2; *(uint4*)(wa + 96 * LDT) = rc3; \
  *(uint4*)(wb) = rd0; *(uint4*)(wb + 32 * LDT) = rd1; *(uint4*)(wb + 64 * LDT) = rd2; *(uint4*)(wb + 96 * LDT) = rd3; }
#define GS_COMPUTE(buf) { \
    const bf16_t* cA = sA + (buf) * TILE_E + (wm * 64 + lr) * LDT + lg * 8; \
    const bf16_t* cB = sB + (buf) * TILE_E + (wn * 64 + lr) * LDT + lg * 8; \
    _Pragma("unroll") for (int ks = 0; ks < 2; ++ks) { \
      bf16x8 af[4], bfr[4]; \
      _Pragma("unroll") for (int i = 0; i < 4; ++i) { \
        af[i] = *(const bf16x8*)(cA + i * 16 * LDT + ks * 32); \
        bfr[i] = *(const bf16x8*)(cB + i * 16 * LDT + ks * 32); \
      } \
      __builtin_amdgcn_s_setprio(1); \
      _Pragma("unroll") for (int i = 0; i < 4; ++i) \
        _Pragma("unroll") for (int j = 0; j < 4; ++j) acc[i][j] = mfma16(af[i], bfr[j], acc[i][j]); \
      __builtin_amdgcn_s_setprio(0); \
    } }
  GS_LOAD0(gA, gB)
  GS_WRITE0(0)
  GS_LOAD1(gA + 64, gB + 64)
  __syncthreads();
  const int nk = K >> 6;
  for (;;) {
    f32x4 acc[4][4];
#pragma unroll
    for (int i = 0; i < 4; ++i)
#pragma unroll
      for (int j = 0; j < 4; ++j) acc[i][j] = (f32x4){0.f, 0.f, 0.f, 0.f};
    const int t0n = t0 + gridDim.x * 2;
    const bool have_next = t0n < T;
    const int tn = min(t0n + VT_OFF, T - 1);
    const bf16_t *nA = gA, *nB = gB;
    int nm0 = 0, nn0 = 0, nctx = 0;
    if (have_next) {
      const TileInfo tj = tf(tn);
      nA = tj.a + (size_t)lrow * lda + lkc;
      nB = tj.b + (size_t)lrow * ldb + lkc;
      nm0 = tj.m0; nn0 = tj.n0; nctx = tj.ctx;
    }
    for (int kt = 0; kt < nk; kt += 2) {
      {
        const bool wrap = (kt + 2 >= nk);
        const bf16_t* pa = wrap ? nA : gA + ((kt + 2) << 6);
        const bf16_t* pb = wrap ? nB : gB + ((kt + 2) << 6);
        GS_LOAD0(pa, pb)
        GS_COMPUTE(0)
        GS_WRITE1(1)
        __syncthreads();
      }
      {
        const bool wrap = (kt + 3 >= nk);
        const bf16_t* pa = wrap ? nA + 64 : gA + ((kt + 3) << 6);
        const bf16_t* pb = wrap ? nB + 64 : gB + ((kt + 3) << 6);
        GS_LOAD1(pa, pb)
        GS_COMPUTE(1)
        GS_WRITE0(0)
        __syncthreads();
      }
    }
#pragma unroll
    for (int i = 0; i < 4; ++i)
#pragma unroll
      for (int j = 0; j < 4; j += 2)
        epi(ctx, m0 + wm * 64 + i * 16 + lg * 4, n0 + wn * 64 + j * 16 + lr, acc[i][j], acc[i][j + 1]);
    if (!have_next) break;
    t = tn; t0 = t0n; gA = nA; gB = nB; m0 = nm0; n0 = nn0; ctx = nctx;
  }
}

constexpr int T8_E = 256 * LDT;
template <class TileFn, class Epi>
DEVI void gemm8_stream(int T, int lda, int ldb, int K, TileFn tf, Epi epi) {
  int t = blockIdx.x;
  if (t >= T) return;
  int tid = threadIdx.x; asm volatile("" : "+v"(tid));
  const int lane = tid & 63, wave = tid >> 6, wr = wave >> 2, wc = wave & 3;
  const int lr = lane & 15, lg = lane >> 4;
  bf16_t* sA = (bf16_t*)g_smem;
  bf16_t* sB = sA + 2 * T8_E;
  const int lrow = tid >> 3, lkc = (tid & 7) * 8;
  TileInfo ti = tf(t);
  const unsigned offA = ((unsigned)lrow * (unsigned)lda + (unsigned)lkc) * 2u;
  const unsigned offB = ((unsigned)lrow * (unsigned)ldb + (unsigned)lkc) * 2u;
  const char* gA = (const char*)ti.a;
  const char* gB = (const char*)ti.b;
  const size_t rsA = (size_t)64 * lda * 2, rsB = (size_t)64 * ldb * 2;
  int m0 = ti.m0, n0 = ti.n0, ctx = ti.ctx;
  uint4 ra0, ra1, ra2, ra3, rb0, rb1, rb2, rb3;
  uint4 rc0, rc1, rc2, rc3, rd0, rd1, rd2, rd3;
#define G8_LOAD(pa, pb) \
  ra0 = *(const uint4*)((pa) + offA); ra1 = *(const uint4*)((pa) + rsA + offA); \
  ra2 = *(const uint4*)((pa) + 2 * rsA + offA); ra3 = *(const uint4*)((pa) + 3 * rsA + offA); \
  rb0 = *(const uint4*)((pb) + offB); rb1 = *(const uint4*)((pb) + rsB + offB); \
  rb2 = *(const uint4*)((pb) + 2 * rsB + offB); rb3 = *(const uint4*)((pb) + 3 * rsB + offB);
#define G8_WRITE(buf) { \
  bf16_t* wa = sA + (buf) * T8_E + lrow * LDT + lkc; bf16_t* wb = sB + (buf) * T8_E + lrow * LDT + lkc; \
  *(uint4*)(wa) = ra0; *(uint4*)(wa + 64 * LDT) = ra1; *(uint4*)(wa + 128 * LDT) = ra2; *(uint4*)(wa + 192 * LDT) = ra3; \
  *(uint4*)(wb) = rb0; *(uint4*)(wb + 64 * LDT) = rb1; *(uint4*)(wb + 128 * LDT) = rb2; *(uint4*)(wb + 192 * LDT) = rb3; }
#define G8_LOAD1(pa, pb) \
  rc0 = *(const uint4*)((pa) + offA); rc1 = *(const uint4*)((pa) + rsA + offA); \
  rc2 = *(const uint4*)((pa) + 2 * rsA + offA); rc3 = *(const uint4*)((pa) + 3 * rsA + offA); \
  rd0 = *(const uint4*)((pb) + offB); rd1 = *(const uint4*)((pb) + rsB + offB); \
  rd2 = *(const uint4*)((pb) + 2 * rsB + offB); rd3 = *(const uint4*)((pb) + 3 * rsB + offB);
#define G8_WRITE1(buf) { \
  bf16_t* wa = sA + (buf) * T8_E + lrow * LDT + lkc; bf16_t* wb = sB + (buf) * T8_E + lrow * LDT + lkc; \
  *(uint4*)(wa) = rc0; *(uint4*)(wa + 64 * LDT) = rc1; *(uint4*)(wa + 128 * LDT) = rc2; *(uint4*)(wa + 192 * LDT) = rc3; \
  *(uint4*)(wb) = rd0; *(uint4*)(wb + 64 * LDT) = rd1; *(uint4*)(wb + 128 * LDT) = rd2; *(uint4*)(wb + 192 * LDT) = rd3; }
#define G8_COMPUTE(buf) { \
      const bf16_t* cA = sA + (buf) * T8_E + (wr * 128 + lr) * LDT + lg * 8; \
      const bf16_t* cB = sB + (buf) * T8_E + (wc * 64 + lr) * LDT + lg * 8; \
      _Pragma("unroll") for (int ks = 0; ks < 2; ++ks) { \
        bf16x8 bfr[4]; \
        _Pragma("unroll") for (int j = 0; j < 4; ++j) bfr[j] = *(const bf16x8*)(cB + j * 16 * LDT + ks * 32); \
        _Pragma("unroll") for (int h = 0; h < 2; ++h) { \
          bf16x8 af[4]; \
          _Pragma("unroll") for (int i = 0; i < 4; ++i) af[i] = *(const bf16x8*)(cA + (h * 4 + i) * 16 * LDT + ks * 32); \
          _Pragma("unroll") for (int i = 0; i < 4; ++i) \
            _Pragma("unroll") for (int j = 0; j < 4; ++j) acc[h * 4 + i][j] = mfma16(af[i], bfr[j], acc[h * 4 + i][j]); \
        } \
      } }
  G8_LOAD(gA, gB)
  G8_WRITE(0)
  G8_LOAD1(gA + 128, gB + 128)
  __syncthreads();
  const int nk = K >> 6;
  for (;;) {
    f32x4 acc[8][4];
#pragma unroll
    for (int i = 0; i < 8; ++i)
#pragma unroll
      for (int j = 0; j < 4; ++j) acc[i][j] = (f32x4){0.f, 0.f, 0.f, 0.f};
    const int tn = t + gridDim.x;
    const bool have_next = tn < T;
    const char *nA = gA, *nB = gB;
    int nm0 = 0, nn0 = 0, nctx = 0;
    if (have_next) {
      const TileInfo tj = tf(tn);
      nA = (const char*)tj.a;
      nB = (const char*)tj.b;
      nm0 = tj.m0; nn0 = tj.n0; nctx = tj.ctx;
    }
#pragma unroll 1
    for (int kt = 0; kt < nk; kt += 2) {
      {
        const bool wrap = (kt + 2 >= nk);
        const char* pa = wrap ? nA : gA + ((kt + 2) << 7);
        const char* pb = wrap ? nB : gB + ((kt + 2) << 7);
        G8_LOAD(pa, pb)
        G8_COMPUTE(0)
        G8_WRITE1(1)
        __syncthreads();
      }
      {
        const bool wrap = (kt + 3 >= nk);
        const char* pa = wrap ? nA + 128 : gA + ((kt + 3) << 7);
        const char* pb = wrap ? nB + 128 : gB + ((kt + 3) << 7);
        G8_LOAD1(pa, pb)
        G8_COMPUTE(1)
        G8_WRITE(0)
        __syncthreads();
      }
    }
#pragma unroll
    for (int i = 0; i < 8; ++i)
#pragma unroll
      for (int j = 0; j < 4; j += 2)
        epi(ctx, m0 + wr * 128 + i * 16 + lg * 4, n0 + wc * 64 + j * 16 + lr, acc[i][j], acc[i][j + 1]);
    if (!have_next) break;
    t = tn; gA = nA; gB = nB; m0 = nm0; n0 = nn0; ctx = nctx;
  }
}

DEVI void tile_mn(int t, int nM, int nN, int& m, int& n) {
  int id = swz_tile(t, nM * nN);
  int per = 8 * nN;
  int gq = id / per, rem = id - gq * per;
  int gsz = min(8, nM - gq * 8);
  m = gq * 8 + rem % gsz;
  n = rem / gsz;
}

NOINL void gemv_tile(const P& p, int t) {
  char* smem = g_smem + VB * 73728;
  const int tid = opaque_tid();
  float* sv = (float*)smem;
  float* red = sv + 3072;
  const int l = t / 192, n0 = (t % 192) * 32;
  for (int i = tid; i < 3072; i += 256) {
    int v = i >> 10, k = i & 1023;
    float cv = (v == 0) ? p.c_ctx[k] : p.c[(v - 1) * 1024 + k];
    sv[i] = cv / (1.f + expf(-cv));
  }
  __syncthreads();
  const int cgp = tid & 7, ks = tid >> 3;
  const float* w = p.w_mod + (size_t)l * 1024 * 6144 + n0 + cgp * 4;
  float a0[4] = {0, 0, 0, 0}, a1[4] = {0, 0, 0, 0}, a2[4] = {0, 0, 0, 0};
#pragma unroll
  for (int kk = 0; kk < 32; ++kk) {
    const int k = ks * 32 + kk;
    const float4 wv = ld_nt_f4(w + (size_t)k * 6144);
    const float s0 = sv[k], s1 = sv[1024 + k], s2 = sv[2048 + k];
    a0[0] += s0 * wv.x; a0[1] += s0 * wv.y; a0[2] += s0 * wv.z; a0[3] += s0 * wv.w;
    a1[0] += s1 * wv.x; a1[1] += s1 * wv.y; a1[2] += s1 * wv.z; a1[3] += s1 * wv.w;
    a2[0] += s2 * wv.x; a2[1] += s2 * wv.y; a2[2] += s2 * wv.z; a2[3] += s2 * wv.w;
  }
#pragma unroll
  for (int j = 0; j < 4; ++j) {
    red[(ks * 3 + 0) * 32 + cgp * 4 + j] = a0[j];
    red[(ks * 3 + 1) * 32 + cgp * 4 + j] = a1[j];
    red[(ks * 3 + 2) * 32 + cgp * 4 + j] = a2[j];
  }
  __syncthreads();
  if (tid < 96) {
    const int v = tid >> 5, col = tid & 31;
    float s = 0.f;
    for (int q = 0; q < 32; ++q) s += red[(q * 3 + v) * 32 + col];
    s += p.b_mod[l * 6144 + n0 + col];
    WSF(OFF_MOD)[(l * 3 + v) * 6144 + n0 + col] = s;
  }
  __syncthreads();
}

NOINL void transpose_tile(const P& p, int t) {
  char* smem = g_smem + VB * 73728;
  const int tid = opaque_tid();
  const float* src; bf16_t* dst; int K, N, ntn, mode = 0;
  if (t < 544) { src = p.w_in; dst = WSB(OFF_WIN); K = 1024; N = 2096; ntn = 34; }
  else if ((t -= 544) < 48) { src = p.w_uq; dst = WSB(OFF_WUQ); K = 256; N = 768; ntn = 12; }
  else if ((t -= 48) < 64) { src = p.w_ukv; dst = WSB(OFF_WUKV); K = 256; N = 1024; ntn = 16; }
  else if ((t -= 64) < 256) { src = p.w_out; dst = WSB(OFF_WOUT); K = 1024; N = 1024; ntn = 16; }
  else if ((t -= 256) < 64) { int g = t >> 4; t &= 15; src = p.pool_w + (size_t)g * 65536; dst = WSB(OFF_WPOOL) + (size_t)g * 65536; K = 256; N = 256; ntn = 4; }
  else if ((t -= 64) < 1408) { int l = t / 704; t -= l * 704; src = p.w_gate + (size_t)l * 1024 * 2816; dst = WSB(OFF_WGU) + (size_t)l * 5632 * 1024; K = 1024; N = 2816; ntn = 44; mode = 1; }
  else if ((t -= 1408) < 1408) { int l = t / 704; t -= l * 704; src = p.w_up + (size_t)l * 1024 * 2816; dst = WSB(OFF_WGU) + (size_t)l * 5632 * 1024; K = 1024; N = 2816; ntn = 44; mode = 2; }
  else { t -= 1408; int l = t / 704; t -= l * 704; src = p.w_down + (size_t)l * 2816 * 1024; dst = WSB(OFF_WDN) + (size_t)l * 1024 * 2816; K = 2816; N = 1024; ntn = 16; }
  const int kt = t / ntn, nt_ = t - kt * ntn;
  const int k0 = kt * 64, n0 = nt_ * 64;
  float* tile = (float*)smem;
  {
    const int nn = tid & 63, kk0 = tid >> 6;
    const int n = n0 + nn;
    const int nc = n < N ? n : N - 1;
    float v[16];
#pragma unroll
    for (int i = 0; i < 16; ++i) v[i] = __builtin_nontemporal_load(src + (size_t)(k0 + kk0 + 4 * i) * N + nc);
#pragma unroll
    for (int i = 0; i < 16; ++i) tile[(kk0 + 4 * i) * 65 + nn] = (n < N) ? v[i] : 0.f;
  }
  __syncthreads();
#pragma unroll
  for (int i = 0; i < 2; ++i) {
    const int id = tid + 256 * i;
    const int nn = id >> 3, kc = id & 7;
    const int n = n0 + nn;
    uint4 pk;
    pk.x = pack2(tile[(kc * 8 + 0) * 65 + nn], tile[(kc * 8 + 1) * 65 + nn]);
    pk.y = pack2(tile[(kc * 8 + 2) * 65 + nn], tile[(kc * 8 + 3) * 65 + nn]);
    pk.z = pack2(tile[(kc * 8 + 4) * 65 + nn], tile[(kc * 8 + 5) * 65 + nn]);
    pk.w = pack2(tile[(kc * 8 + 6) * 65 + nn], tile[(kc * 8 + 7) * 65 + nn]);
    int drow = n;
    if (mode == 1) drow = (n >> 4) * 32 + (n & 15);
    else if (mode == 2) drow = (n >> 4) * 32 + 16 + (n & 15);
    *(uint4*)(dst + (size_t)drow * K + k0 + kc * 8) = pk;
  }
  __syncthreads();
}

template <bool UPD, bool MOD, bool FIRST, bool LASTW, bool TWO, bool POOL = false>
DEVI void rowop(const P& p, const bf16_t* msrc, const bf16_t* msrc2, const float* wpost, int gate_idx, const float* wpre, int shift_idx,
                int scale_idx, int layer_g, int layer_m) {
  const int lane = threadIdx.x & 63, wave = threadIdx.x >> 6;
  const float* modg = WSF(OFF_MOD) + (size_t)layer_g * 3 * 6144;
  const float* modm = WSF(OFF_MOD) + (size_t)layer_m * 3 * 6144;
  bf16_t* hbuf = WSB(OFF_H);
  for (int r = blockIdx.x * 8 + wave; r < 8192; r += gridDim.x * 8) {
    const int v = r < 4096 ? 0 : 1 + ((r - 4096) >> 11);
    const float* mvg = modg + v * 6144;
    const float* mvm = modm + v * 6144;
    float4 x[4];
    if (FIRST) {
      const float* xin = r < 4096 ? p.x_prompt + (size_t)r * 1024 : p.x_sample + (size_t)(r - 4096) * 1024;
#pragma unroll
      for (int i = 0; i < 4; ++i) x[i] = ld_nt_f4(xin + lane * 4 + 256 * i);
    } else {
#pragma unroll
      for (int i = 0; i < 4; ++i) {
        const uint2 xb = ld_nt_u2(WSB(OFF_XR) + (size_t)r * 1024 + lane * 4 + 256 * i);
        x[i].x = __uint_as_float(xb.x << 16); x[i].y = __uint_as_float(xb.x & 0xffff0000u);
        x[i].z = __uint_as_float(xb.y << 16); x[i].w = __uint_as_float(xb.y & 0xffff0000u);
      }
    }
    if (UPD) {
      float4 m[4];
      float ss = 0.f;
      int ps0 = 0, pL = 0;
      if (POOL) { if (r < 4096) { ps0 = r & ~255; pL = 256; } else { ps0 = 4096 + ((r - 4096) & ~2047); pL = 2048; } }
#pragma unroll
      for (int i = 0; i < 4; ++i) {
        if (POOL) {
          constexpr int dummy = 0; (void)dummy;
          const int W2 = 1 << i;
          const int t = r - ps0;
          const int lo = max(t - W2, 0), hi = min(t + W2, pL);
          float a0 = 0.f, a1 = 0.f, a2 = 0.f, a3 = 0.f;
          uint2 ctr = make_uint2(0u, 0u);
#pragma unroll
          for (int k = 0; k < 2 * W2; ++k) {
            const int u = t - W2 + k;
            const int uc = min(max(u, 0), pL - 1);
            const uint2 g = *(const uint2*)(msrc + (size_t)(ps0 + uc) * 1024 + lane * 4 + 256 * i);
            const float w = (u >= 0 && u < pL) ? 1.f : 0.f;
            a0 += w * __uint_as_float(g.x << 16); a1 += w * __uint_as_float(g.x & 0xffff0000u);
            a2 += w * __uint_as_float(g.y << 16); a3 += w * __uint_as_float(g.y & 0xffff0000u);
            if (k == W2) ctr = g;
          }
          const float inv = 1.f / (float)(hi - lo);
          m[i].x = a0 * inv - __uint_as_float(ctr.x << 16); m[i].y = a1 * inv - __uint_as_float(ctr.x & 0xffff0000u);
          m[i].z = a2 * inv - __uint_as_float(ctr.y << 16); m[i].w = a3 * inv - __uint_as_float(ctr.y & 0xffff0000u);
          ss += m[i].x * m[i].x + m[i].y * m[i].y + m[i].z * m[i].z + m[i].w * m[i].w;
          continue;
        }
        const uint2 mb = ld_nt_u2(msrc + (size_t)r * 1024 + lane * 4 + 256 * i);
        m[i].x = __uint_as_float(mb.x << 16); m[i].y = __uint_as_float(mb.x & 0xffff0000u);
        m[i].z = __uint_as_float(mb.y << 16); m[i].w = __uint_as_float(mb.y & 0xffff0000u);
        if (TWO) {
          const uint2 mc = ld_nt_u2(msrc2 + (size_t)r * 1024 + lane * 4 + 256 * i);
          m[i].x += __uint_as_float(mc.x << 16); m[i].y += __uint_as_float(mc.x & 0xffff0000u);
          m[i].z += __uint_as_float(mc.y << 16); m[i].w += __uint_as_float(mc.y & 0xffff0000u);
        }
        ss += m[i].x * m[i].x + m[i].y * m[i].y + m[i].z * m[i].z + m[i].w * m[i].w;
      }
      ss = wave_sum(ss);
      const float rs = rsqrtf(ss * (1.f / 1024.f) + 1e-6f);
#pragma unroll
      for (int i = 0; i < 4; ++i) {
        const int col = lane * 4 + 256 * i;
        const float4 wp = *(const float4*)(wpost + col);
        const float4 g = *(const float4*)(mvg + gate_idx * 1024 + col);
        x[i].x += g.x * (m[i].x * rs * wp.x);
        x[i].y += g.y * (m[i].y * rs * wp.y);
        x[i].z += g.z * (m[i].z * rs * wp.z);
        x[i].w += g.w * (m[i].w * rs * wp.w);
        if (LASTW) *(float4*)(p.out + (size_t)r * 1024 + col) = x[i];
        else {
          uint2 xo;
          xo.x = pack2(x[i].x, x[i].y);
          xo.y = pack2(x[i].z, x[i].w);
          *(uint2*)(WSB(OFF_XR) + (size_t)r * 1024 + col) = xo;
        }
      }
    }
    if (MOD) {
      float ss = 0.f;
#pragma unroll
      for (int i = 0; i < 4; ++i) ss += x[i].x * x[i].x + x[i].y * x[i].y + x[i].z * x[i].z + x[i].w * x[i].w;
      ss = wave_sum(ss);
      const float rs = rsqrtf(ss * (1.f / 1024.f) + 1e-6f);
#pragma unroll
      for (int i = 0; i < 4; ++i) {
        const int col = lane * 4 + 256 * i;
        const float4 wp = *(const float4*)(wpre + col);
        const float4 sh = *(const float4*)(mvm + shift_idx * 1024 + col);
        const float4 sc = *(const float4*)(mvm + scale_idx * 1024 + col);
        uint2 o;
        o.x = pack2(x[i].x * rs * wp.x * (1.f + sc.x) + sh.x, x[i].y * rs * wp.y * (1.f + sc.y) + sh.y);
        o.y = pack2(x[i].z * rs * wp.z * (1.f + sc.z) + sh.z, x[i].w * rs * wp.w * (1.f + sc.w) + sh.w);
        *(uint2*)(hbuf + (size_t)r * 1024 + col) = o;
      }
    }
  }
}

NOINL void prep_rows(const P& p) {
  const int lane = threadIdx.x & 63, wave = threadIdx.x >> 6;
  const bf16_t* proj = WSB(OFF_R1);
  for (int r = blockIdx.x * 8 + wave; r < 8192; r += gridDim.x * 8) {
    const bf16_t* pr = proj + (size_t)r * 2080;
    const int kvrow = r < 4096 ? r : 4096 + ((r - 4096) >> 11) * 2304 + 256 + ((r - 4096) & 2047);
    const uint2 rq = *(const uint2*)(pr + lane * 4);
    const uint2 rk = *(const uint2*)(pr + 256 + lane * 4);
    const float4 ld_cq = make_float4(__uint_as_float(rq.x << 16), __uint_as_float(rq.x & 0xffff0000u), __uint_as_float(rq.y << 16), __uint_as_float(rq.y & 0xffff0000u));
    const float4 ld_ckv = make_float4(__uint_as_float(rk.x << 16), __uint_as_float(rk.x & 0xffff0000u), __uint_as_float(rk.y << 16), __uint_as_float(rk.y & 0xffff0000u));
    const float ld_kpe = bf2f(pr[512 + (lane & 31)]);
    const float ld_dt = WSF(OFF_DTRAW)[(size_t)r * 16 + (lane & 15)];
    {
      const float4 a = ld_cq;
      float ss = wave_sum(a.x * a.x + a.y * a.y + a.z * a.z + a.w * a.w);
      const float rs = rsqrtf(ss * (1.f / 256.f) + 1e-6f);
      const float4 g = *(const float4*)(p.q_norm + lane * 4);
      uint2 o;
      o.x = pack2(a.x * rs * g.x, a.y * rs * g.y);
      o.y = pack2(a.z * rs * g.z, a.w * rs * g.w);
      *(uint2*)(WSB(OFF_CQN) + (size_t)r * 256 + lane * 4) = o;
    }
    {
      const float4 a = ld_ckv;
      float ss = wave_sum(a.x * a.x + a.y * a.y + a.z * a.z + a.w * a.w);
      const float rs = rsqrtf(ss * (1.f / 256.f) + 1e-6f);
      const float4 g = *(const float4*)(p.kv_norm + lane * 4);
      float4 vv;
      vv.x = a.x * rs * g.x; vv.y = a.y * rs * g.y; vv.z = a.z * rs * g.z; vv.w = a.w * rs * g.w;
      if (r < 4096) *(float4*)(p.out + OUT_CKV + (size_t)r * 256 + lane * 4) = vv;
      uint2 o;
      o.x = pack2(vv.x, vv.y);
      o.y = pack2(vv.z, vv.w);
      *(uint2*)(WSB(OFF_CKV) + (size_t)kvrow * 256 + lane * 4) = o;
    }
    {
      const float kv = (lane < 32) ? ld_kpe : 0.f;
      const float partner = __shfl_xor(kv, 16, 64);
      if (r < 4096) {
        if (lane < 32) {
          p.out[OUT_KR + (size_t)r * 32 + lane] = kv;
          WSB(OFF_KPE)[(size_t)kvrow * 32 + lane] = f2bf(kv);
        }
      } else {
        const int t = (r - 4096) & 2047;
        const int ii = lane & 15;
        const float pos = (ii < 8) ? (float)(t >> 6) : (float)(t & 63);
        const float fr = rope_freq(ii & 7);
        const float ang = pos * fr;
        float cs, sn;
        fast_sincos(ang, sn, cs);
        const float o = (lane < 16) ? (kv * cs - partner * sn) : (partner * sn + kv * cs);
        if (lane < 32) WSB(OFF_KPE)[(size_t)kvrow * 32 + lane] = f2bf(o);
      }
    }
    if (lane < 16) {
      const int dir = lane >> 3, hh = lane & 7;
      const float raw = ld_dt + (dir ? p.dtb_b[hh] : p.dtb_f[hh]);
      const float sp = raw > 20.f ? raw : log1pf(expf(raw));
      WSF(OFF_DTV)[((size_t)dir * 8192 + r) * 8 + hh] = sp;
    }
  }
}

NOINL void prep_cache(const P& p) {
  const int gt = blockIdx.x * 512 + threadIdx.x, gs = gridDim.x * 512;
  for (int i = gt; i < 2 * 256 * 256; i += gs) {
    int b = i >> 16, rem = i & 65535;
    WSB(OFF_CKV)[(size_t)(4096 + b * 2304) * 256 + rem] = f2bf(p.cache_ckv[i]);
  }
  for (int i = gt; i < 2 * 256 * 32; i += gs) {
    int b = i >> 13, rem = i & 8191;
    WSB(OFF_KPE)[(size_t)(4096 + b * 2304) * 32 + rem] = f2bf(p.cache_kr[i]);
  }
}

NOINL void conv_tile(const P& p, int t) {
  char* smem = g_smem + VB * 73728;
  const int tid = opaque_tid();
  float* sin_ = (float*)smem;
  float* sout = sin_ + 68 * 64;
  const int tt_ = t >> 4, ct = t & 15;
  const int r0 = tt_ * 64, c0 = ct * 64;
  int s0, s1;
  if (r0 < 4096) { s0 = r0 & ~255; s1 = s0 + 256; } else { s0 = 4096 + ((r0 - 4096) & ~2047); s1 = s0 + 2048; }
  const bf16_t* proj = WSB(OFF_R1);
  {
    const int rr0 = tid >> 6, cc = tid & 63;
    float v[17];
#pragma unroll
    for (int k = 0; k < 17; ++k) {
      const int r = r0 - 2 + rr0 + 4 * k;
      const int rc = r < s0 ? s0 : (r >= s1 ? s1 - 1 : r);
      v[k] = bf2f(proj[(size_t)rc * 2080 + 1056 + c0 + cc]);
    }
#pragma unroll
    for (int k = 0; k < 17; ++k) {
      const int r = r0 - 2 + rr0 + 4 * k;
      sin_[(rr0 + 4 * k) * 64 + cc] = (r >= s0 && r < s1) ? v[k] : 0.f;
    }
  }
  __syncthreads();
  {
    const int cc = tid & 63, tq = tid >> 6;
    const int c = c0 + cc;
    const float w0 = p.conv_w[c], w1 = p.conv_w[1024 + c], w2 = p.conv_w[2048 + c], w3 = p.conv_w[3072 + c],
                w4 = p.conv_w[4096 + c], bias = p.conv_b[c];
#pragma unroll 4
    for (int i = 0; i < 16; ++i) {
      const int tt = tq * 16 + i;
      float y = bias + w0 * sin_[tt * 64 + cc] + w1 * sin_[(tt + 1) * 64 + cc] + w2 * sin_[(tt + 2) * 64 + cc] +
                w3 * sin_[(tt + 3) * 64 + cc] + w4 * sin_[(tt + 4) * 64 + cc];
      y = y / (1.f + __expf(-y));
      sout[tt * 65 + cc] = y;
      const bf16_t b = f2bf(y);
      const size_t r = r0 + tt;
      if (c < 512) WSB(OFF_XS)[r * 512 + c] = b;
      else if (c < 768) WSB(OFF_BM)[r * 256 + (c - 512)] = b;
      else WSB(OFF_CM)[r * 256 + (c - 768)] = b;
    }
  }
  __syncthreads();
  if (c0 < 768) {
    const int cl = tid >> 2, q4 = tid & 3;
    uint4 o0, o1;
    const float* sp = sout + (q4 * 16) * 65 + cl;
    o0.x = pack2(sp[0 * 65], sp[1 * 65]);   o0.y = pack2(sp[2 * 65], sp[3 * 65]);
    o0.z = pack2(sp[4 * 65], sp[5 * 65]);   o0.w = pack2(sp[6 * 65], sp[7 * 65]);
    o1.x = pack2(sp[8 * 65], sp[9 * 65]);   o1.y = pack2(sp[10 * 65], sp[11 * 65]);
    o1.z = pack2(sp[12 * 65], sp[13 * 65]); o1.w = pack2(sp[14 * 65], sp[15 * 65]);
    bf16_t* dst = (c0 < 512) ? WSB(OFF_XST) + (size_t)(c0 + cl) * 8192 : WSB(OFF_BT) + (size_t)(c0 - 512 + cl) * 8192;
    dst += r0 + q4 * 16;
    *(uint4*)(dst) = o0;
    *(uint4*)(dst + 8) = o1;
  }
  __syncthreads();
}

NOINL void chunk_state_item(const P& p, int item) {
  char* smem = g_smem + VB * 73728;
  const int tid = opaque_tid(), lane = tid & 63, wave = tid >> 6, lr = lane & 15, lg = lane >> 4;
  const int cidx = item >> 3, hh = item & 7, g = hh >> 2;
  const int r0 = cidx * 128;
  constexpr int LDS_ = 136;
  bf16_t* sAs = (bf16_t*)smem;
  bf16_t* sBs = sAs + 2 * 64 * LDS_;
  float* fa = (float*)(sBs + 128 * LDS_);
  float* fcum = fa + 256;
  float* fw = fa + 512;
  float* fdt = fa + 768;
  {
    const int dir = tid >> 7, j = tid & 127;
    const float dt = WSF(OFF_DTV)[((size_t)dir * 8192 + r0 + j) * 8 + hh];
    const float Aco = -expf(dir ? p.alog_b[hh] : p.alog_f[hh]);
    fa[tid] = dt * Aco;
    fdt[tid] = dt;
  }
  __syncthreads();
  {
    const int dir = tid >> 7, j = tid & 127;
    float s = 0.f;
    const float4* fa4 = (const float4*)(fa + dir * 128);
    if (dir == 0) {
      const int nb = (j + 1) >> 2;
      for (int k4 = 0; k4 < nb; ++k4) { const float4 v = fa4[k4]; s += (v.x + v.y) + (v.z + v.w); }
      for (int k = nb * 4; k <= j; ++k) s += fa[k];
    } else {
      const int fb = (j + 3) >> 2;
      for (int k4 = 31; k4 >= fb; --k4) { const float4 v = fa4[k4]; s += (v.x + v.y) + (v.z + v.w); }
      for (int k = j; k < fb * 4; ++k) s += fa[128 + k];
    }
    fcum[tid] = s;
    WSF(OFF_CUM)[((size_t)dir * 8192 + r0 + j) * 8 + hh] = s;
  }
  __syncthreads();
  {
    const int dir = tid >> 7;
    const float ce = dir ? fcum[128] : fcum[127];
    fw[tid] = __expf(ce - fcum[tid]) * fdt[tid];
    if ((tid & 127) == 0) WSF(OFF_TOT)[(dir * 64 + cidx) * 8 + hh] = __expf(ce);
  }
  __syncthreads();
#pragma unroll
  for (int i = 0; i < 4; ++i) {
    const int id = tid + 256 * i;
    const int pp = id >> 4, jc = (id & 15) * 8;
    const uint4 raw = *(const uint4*)(WSB(OFF_XST) + (size_t)(hh * 64 + pp) * 8192 + r0 + jc);
    const unsigned rw[4] = {raw.x, raw.y, raw.z, raw.w};
    unsigned of[4], ob[4];
#pragma unroll
    for (int q = 0; q < 4; ++q) {
      const float x0 = __uint_as_float(rw[q] << 16), x1 = __uint_as_float(rw[q] & 0xffff0000u);
      of[q] = pack2(x0 * fw[jc + 2 * q], x1 * fw[jc + 2 * q + 1]);
      ob[q] = pack2(x0 * fw[128 + jc + 2 * q], x1 * fw[128 + jc + 2 * q + 1]);
    }
    *(uint4*)(sAs + pp * LDS_ + jc) = make_uint4(of[0], of[1], of[2], of[3]);
    *(uint4*)(sAs + 64 * LDS_ + pp * LDS_ + jc) = make_uint4(ob[0], ob[1], ob[2], ob[3]);
  }
#pragma unroll
  for (int i = 0; i < 8; ++i) {
    const int id = tid + 256 * i;
    const int nn = id >> 4, jc = (id & 15) * 8;
    *(uint4*)(sBs + nn * LDS_ + jc) = *(const uint4*)(WSB(OFF_BT) + (size_t)(g * 128 + nn) * 8192 + r0 + jc);
  }
  __syncthreads();
  {
    const int dir = wave >> 1, nh = wave & 1;
    f32x4 acc[4][4];
#pragma unroll
    for (int i = 0; i < 4; ++i)
#pragma unroll
      for (int j = 0; j < 4; ++j) acc[i][j] = (f32x4){0.f, 0.f, 0.f, 0.f};
    const bf16_t* cA = sAs + dir * 64 * LDS_ + lr * LDS_ + lg * 8;
    const bf16_t* cB = sBs + (nh * 64 + lr) * LDS_ + lg * 8;
#pragma unroll 1
    for (int ks = 0; ks < 4; ++ks) {
      bf16x8 af[4], bfr[4];
#pragma unroll
      for (int i = 0; i < 4; ++i) {
        af[i] = *(const bf16x8*)(cA + i * 16 * LDS_ + ks * 32);
        bfr[i] = *(const bf16x8*)(cB + i * 16 * LDS_ + ks * 32);
      }
#pragma unroll
      for (int i = 0; i < 4; ++i)
#pragma unroll
        for (int j = 0; j < 4; ++j) acc[i][j] = mfma16(af[i], bfr[j], acc[i][j]);
    }
    float* S = WSF(OFF_R2) + ((size_t)(dir * 64 + cidx) * 8 + hh) * 8192 + (lg * 4) * 128 + nh * 64 + lr;
#pragma unroll
    for (int i = 0; i < 4; ++i) {
#pragma unroll
      for (int q = 0; q < 4; ++q) {
#pragma unroll
        for (int j = 0; j < 4; ++j) S[j * 16] = acc[i][j][q];
        S += 128;
      }
      S += 12 * 128;
      __builtin_amdgcn_sched_barrier(0);
    }
  }
  __syncthreads();
}

template <int NB>
DEVI void scan_group(const P& p, float4& h, int dir, int cb, int nc, int c0, int hh, size_t eoff) {
  float4 sv[NB];
  float d[NB];
  size_t base[NB];
#pragma unroll
  for (int k = 0; k < NB; ++k) {
    const int c = c0 + k;
    const int cidx = cb + (dir ? nc - 1 - c : c);
    base[k] = ((size_t)(dir * 64 + cidx) * 8 + hh) * 8192 + eoff;
    d[k] = WSF(OFF_TOT)[(dir * 64 + cidx) * 8 + hh];
    sv[k] = ld_nt_f4(WSF(OFF_R2) + base[k]);
  }
#pragma unroll
  for (int k = 0; k < NB; ++k) {
    uint2 o;
    o.x = pack2(h.x, h.y);
    o.y = pack2(h.z, h.w);
    *(uint2*)(WSB(OFF_H) + base[k]) = o;
    h.x = d[k] * h.x + sv[k].x; h.y = d[k] * h.y + sv[k].y; h.z = d[k] * h.z + sv[k].z; h.w = d[k] * h.w + sv[k].w;
  }
}

NOINL void scan_states(const P& p) {
  const int total = 2 * 18 * 8 * 64 * 32;
  for (int idx = blockIdx.x * 512 + threadIdx.x; idx < total; idx += gridDim.x * 512) {
    const int n4 = idx & 31, pp = (idx >> 5) & 63, hh = (idx >> 11) & 7;
    const int sd = idx >> 14;
    const int s = sd % 18, dir = sd / 18;
    const int nc = s < 16 ? 2 : 16;
    const int cb = s < 16 ? s * 2 : 32 + (s - 16) * 16;
    float4 h = make_float4(0.f, 0.f, 0.f, 0.f);
    const size_t eoff = (size_t)pp * 128 + n4 * 4;
    if (s >= 16) {
      const float* st = (dir ? p.st_b : p.st_f) + ((size_t)((s - 16) * 8 + hh) * 64 + pp) * 128 + n4 * 4;
      h = *(const float4*)st;
      scan_group<8>(p, h, dir, cb, nc, 0, hh, eoff);
      scan_group<8>(p, h, dir, cb, nc, 8, hh, eoff);
    } else {
      scan_group<2>(p, h, dir, cb, nc, 0, hh, eoff);
      float* o = p.out + (dir ? OUT_SB : OUT_SF) + ((size_t)(s * 8 + hh) * 64 + pp) * 128 + n4 * 4;
      *(float4*)o = h;
    }
  }
}

NOINL void attn_item(const P& p, int id) {
  char* smem = g_smem + VB * 73728;
  const int tid = opaque_tid(), lane = tid & 63, wave = tid >> 6, lr = lane & 15, lg = lane >> 4;
  int row0, kvbase, Lk, hh;
  if (id < 512) { hh = id & 7; const int b = (id >> 3) & 1; const int qb = id >> 4; row0 = 4096 + b * 2048 + qb * 64; kvbase = 4096 + b * 2304; Lk = 2304; }
  else { const int i2 = id - 512; hh = i2 & 7; const int rest = i2 >> 3; const int b = rest >> 2; const int qb = rest & 3; row0 = b * 256 + qb * 64; kvbase = b * 256; Lk = 256; }
  constexpr int LDK = 104, LDV = 72;
  constexpr int KVBUF = 64 * LDK + 64 * LDV;
  bf16_t* sKV = (bf16_t*)smem;
  const int qrow = row0 + wave * 16 + lr;
  bf16x8 qf[3];
#pragma unroll
  for (int ks = 0; ks < 3; ++ks) qf[ks] = *(const bf16x8*)(WSB(OFF_Q) + (size_t)qrow * 768 + hh * 96 + ks * 32 + lg * 8);
  f32x4 oacc[4];
#pragma unroll
  for (int i = 0; i < 4; ++i) oacc[i] = (f32x4){0.f, 0.f, 0.f, 0.f};
  float mrun = -1e30f, lrun = 0.f;
  const int nkt = Lk >> 6;
  const int kkey0 = tid / 12, kcc0 = tid - kkey0 * 12;
  const int c1 = tid + 256, kkey1 = c1 / 12, kcc1 = c1 - kkey1 * 12;
  const int c2 = tid + 512, kkey2 = c2 / 12, kcc2 = c2 - kkey2 * 12;
  const bf16_t* kn = WSB(OFF_KN);
  const bf16_t* kp = WSB(OFF_KPE);
  const bf16_t* ksrc0 = (kcc0 < 8) ? kn + (size_t)(kvbase + kkey0) * 512 + hh * 64 + kcc0 * 8 : kp + (size_t)(kvbase + kkey0) * 32 + (kcc0 - 8) * 8;
  const bf16_t* ksrc1 = (kcc1 < 8) ? kn + (size_t)(kvbase + kkey1) * 512 + hh * 64 + kcc1 * 8 : kp + (size_t)(kvbase + kkey1) * 32 + (kcc1 - 8) * 8;
  const bf16_t* ksrc2 = (kcc2 < 8) ? kn + (size_t)(kvbase + kkey2) * 512 + hh * 64 + kcc2 * 8 : kp + (size_t)(kvbase + kkey2) * 32 + (kcc2 - 8) * 8;
  const int kst0 = (kcc0 < 8) ? 512 * 64 : 32 * 64, kst1 = (kcc1 < 8) ? 512 * 64 : 32 * 64, kst2 = (kcc2 < 8) ? 512 * 64 : 32 * 64;
  const int vd0 = tid >> 3, vcc = tid & 7;
  const bf16_t* vsrc0 = WSB(OFF_VT) + (size_t)(hh * 64 + vd0) * 8704 + kvbase + vcc * 8;
  const bf16_t* vsrc1 = vsrc0 + (size_t)32 * 8704;
  uint4 rk0, rk1, rk2, rv0, rv1;
#define AT_LOAD(kt) { const int _k = (kt); \
    rk0 = *(const uint4*)(ksrc0 + (size_t)_k * kst0); rk1 = *(const uint4*)(ksrc1 + (size_t)_k * kst1); \
    rk2 = *(const uint4*)(ksrc2 + (size_t)_k * kst2); \
    rv0 = *(const uint4*)(vsrc0 + _k * 64); rv1 = *(const uint4*)(vsrc1 + _k * 64); }
#define AT_WRITE(buf) { bf16_t* _b = sKV + (buf) * KVBUF; \
    *(uint4*)(_b + kkey0 * LDK + kcc0 * 8) = rk0; *(uint4*)(_b + kkey1 * LDK + kcc1 * 8) = rk1; \
    *(uint4*)(_b + kkey2 * LDK + kcc2 * 8) = rk2; \
    *(uint4*)(_b + 64 * LDK + vd0 * LDV + vcc * 8) = rv0; *(uint4*)(_b + 64 * LDK + (vd0 + 32) * LDV + vcc * 8) = rv1; }
  AT_LOAD(0)
  AT_WRITE(0)
  __syncthreads();
  for (int kt = 0; kt < nkt; ++kt) {
    const int ktn = min(kt + 1, nkt - 1);
    AT_LOAD(ktn)
#if ATPROBE == 5
    { uint4 d0 = *(const volatile uint4*)(ksrc0 + (size_t)ktn * kst0), d1 = *(const volatile uint4*)(ksrc1 + (size_t)ktn * kst1), d2 = *(const volatile uint4*)(ksrc2 + (size_t)ktn * kst2);
      uint4 d3 = *(const volatile uint4*)(vsrc0 + ktn * 64), d4 = *(const volatile uint4*)(vsrc1 + ktn * 64);
      asm volatile("" :: "v"(d0), "v"(d1), "v"(d2), "v"(d3), "v"(d4)); }
#endif
    const bf16_t* sK = sKV + (kt & 1) * KVBUF;
    const bf16_t* sV = sK + 64 * LDK;
    f32x4 sacc[4];
#pragma unroll
    for (int n = 0; n < 4; ++n) sacc[n] = (f32x4){0.f, 0.f, 0.f, 0.f};
#pragma unroll
    for (int ks = 0; ks < 3; ++ks)
#pragma unroll
      for (int n = 0; n < 4; ++n) {
        const bf16x8 a = *(const bf16x8*)(sK + (n * 16 + lr) * LDK + ks * 32 + lg * 8);
        sacc[n] = mfma16(a, qf[ks], sacc[n]);
      }
#if ATPROBE == 2
    {
      f32x4 dacc[4];
#pragma unroll
      for (int n = 0; n < 4; ++n) dacc[n] = (f32x4){0.f, 0.f, 0.f, 0.f};
#pragma unroll
      for (int ks = 0; ks < 3; ++ks)
#pragma unroll
        for (int n = 0; n < 4; ++n) {
          const bf16x8 a = *(const volatile bf16x8*)(sK + (n * 16 + lr) * LDK + ks * 32 + lg * 8);
          dacc[n] = mfma16(a, qf[ks], dacc[n]);
        }
#pragma unroll
      for (int n = 0; n < 4; ++n) asm volatile("" :: "v"(dacc[n]));
    }
#endif
    float mx = sacc[0][0];
#pragma unroll
    for (int n = 0; n < 4; ++n)
#pragma unroll
      for (int q = 0; q < 4; ++q) mx = fmaxf(mx, sacc[n][q]);
    mx = quad_max(mx);
    const float mnew = fmaxf(mrun, mx);
    const float alpha = __builtin_amdgcn_exp2f(mrun - mnew);
    mrun = mnew;
    float ps = 0.f;
#pragma unroll
    for (int n = 0; n < 4; ++n)
#pragma unroll
      for (int q = 0; q < 4; ++q) {
#if ATPROBE == 1
        { float e2 = __builtin_amdgcn_exp2f(sacc[n][q] - mrun); asm volatile("" :: "v"(e2)); }
#endif
        const float e = __builtin_amdgcn_exp2f(sacc[n][q] - mnew); sacc[n][q] = e; ps += e; }
    lrun = lrun * alpha + ps;
#pragma unroll
    for (int i = 0; i < 4; ++i)
#pragma unroll
      for (int q = 0; q < 4; ++q) oacc[i][q] *= alpha;
#pragma unroll
    for (int ks = 0; ks < 2; ++ks) {
      union { bf16x8 v; unsigned u[4]; } pf;
      pf.u[0] = pack2(sacc[2 * ks][0], sacc[2 * ks][1]);
      pf.u[1] = pack2(sacc[2 * ks][2], sacc[2 * ks][3]);
      pf.u[2] = pack2(sacc[2 * ks + 1][0], sacc[2 * ks + 1][1]);
      pf.u[3] = pack2(sacc[2 * ks + 1][2], sacc[2 * ks + 1][3]);
#pragma unroll
      for (int m = 0; m < 4; ++m) {
        union { bf16x8 v; uint2 h[2]; } av;
        const bf16_t* vp = sV + (m * 16 + lr) * LDV + ks * 32 + lg * 4;
        av.h[0] = *(const uint2*)(vp);
        av.h[1] = *(const uint2*)(vp + 16);
        oacc[m] = mfma16(av.v, pf.v, oacc[m]);
      }
    }
    __builtin_amdgcn_sched_barrier(0);
    AT_WRITE((kt + 1) & 1)
#if ATPROBE == 3
    AT_WRITE((kt + 1) & 1)
#endif
#if ATPROBE == 4
    __syncthreads();
#endif
    __syncthreads();
  }
  lrun = quad_sum(lrun);
  const float inv = 1.f / lrun;
#pragma unroll
  for (int m = 0; m < 4; ++m) {
    uint2 o;
    o.x = pack2(oacc[m][0] * inv, oacc[m][1] * inv);
    o.y = pack2(oacc[m][2] * inv, oacc[m][3] * inv);
    *(uint2*)(WSB(OFF_CAT) + (size_t)qrow * 1024 + hh * 64 + m * 16 + lg * 4) = o;
  }
}

NOINL void attn8_item(const P& p, int id) {
  int tid = threadIdx.x; asm volatile("" : "+v"(tid));
  const int lane = tid & 63, wave = tid >> 6, lr = lane & 15, lg = lane >> 4;
  int row0, kvbase, Lk, hh;
  if (id < 256) { hh = id & 7; const int b = (id >> 3) & 1; const int qb = id >> 4; row0 = 4096 + b * 2048 + qb * 128; kvbase = 4096 + b * 2304; Lk = 2304; }
  else { const int i2 = id - 256; hh = i2 & 7; const int rest = i2 >> 3; const int b = rest >> 1; const int qb = rest & 1; row0 = b * 256 + qb * 128; kvbase = b * 256; Lk = 256; }
  constexpr int LDK = 104, LDV = 136;
  constexpr int KVBUF = 128 * LDK + 64 * LDV;
  bf16_t* sKV = (bf16_t*)g_smem;
  const int qrow = row0 + wave * 16 + lr;
  bf16x8 qf[3];
#pragma unroll
  for (int ks = 0; ks < 3; ++ks) qf[ks] = *(const bf16x8*)(WSB(OFF_Q) + (size_t)qrow * 768 + hh * 96 + ks * 32 + lg * 8);
  f32x4 oacc[4];
#pragma unroll
  for (int i = 0; i < 4; ++i) oacc[i] = (f32x4){0.f, 0.f, 0.f, 0.f};
  float mrun = -1e30f, lrun = 0.f;
  const int nkt = Lk >> 7;
  const int kkey0 = tid / 12, kcc0 = tid - kkey0 * 12;
  const int c1 = tid + 512, kkey1 = c1 / 12, kcc1 = c1 - kkey1 * 12;
  const int c2 = tid + 1024, kkey2 = c2 / 12, kcc2 = c2 - kkey2 * 12;
  const bf16_t* kn = WSB(OFF_KN);
  const bf16_t* kp = WSB(OFF_KPE);
  const bf16_t* ksrc0 = (kcc0 < 8) ? kn + (size_t)(kvbase + kkey0) * 512 + hh * 64 + kcc0 * 8 : kp + (size_t)(kvbase + kkey0) * 32 + (kcc0 - 8) * 8;
  const bf16_t* ksrc1 = (kcc1 < 8) ? kn + (size_t)(kvbase + kkey1) * 512 + hh * 64 + kcc1 * 8 : kp + (size_t)(kvbase + kkey1) * 32 + (kcc1 - 8) * 8;
  const bf16_t* ksrc2 = (kcc2 < 8) ? kn + (size_t)(kvbase + kkey2) * 512 + hh * 64 + kcc2 * 8 : kp + (size_t)(kvbase + kkey2) * 32 + (kcc2 - 8) * 8;
  const int kst0 = (kcc0 < 8) ? 512 * 128 : 32 * 128, kst1 = (kcc1 < 8) ? 512 * 128 : 32 * 128, kst2 = (kcc2 < 8) ? 512 * 128 : 32 * 128;
  const int vd0 = tid >> 4, vcc = tid & 15;
  const bf16_t* vsrc0 = WSB(OFF_VT) + (size_t)(hh * 64 + vd0) * 8704 + kvbase + vcc * 8;
  const bf16_t* vsrc1 = vsrc0 + (size_t)32 * 8704;
  uint4 rk0, rk1, rk2, rv0, rv1;
#define A8_LOAD(kt) { const int _k = (kt); \
    rk0 = *(const uint4*)(ksrc0 + (size_t)_k * kst0); rk1 = *(const uint4*)(ksrc1 + (size_t)_k * kst1); \
    rk2 = *(const uint4*)(ksrc2 + (size_t)_k * kst2); \
    rv0 = *(const uint4*)(vsrc0 + _k * 128); rv1 = *(const uint4*)(vsrc1 + _k * 128); }
#define A8_WRITE(buf) { bf16_t* _b = sKV + (buf) * KVBUF; \
    *(uint4*)(_b + kkey0 * LDK + kcc0 * 8) = rk0; *(uint4*)(_b + kkey1 * LDK + kcc1 * 8) = rk1; \
    *(uint4*)(_b + kkey2 * LDK + kcc2 * 8) = rk2; \
    *(uint4*)(_b + 128 * LDK + vd0 * LDV + vcc * 8) = rv0; *(uint4*)(_b + 128 * LDK + (vd0 + 32) * LDV + vcc * 8) = rv1; }
  A8_LOAD(0)
  A8_WRITE(0)
  __syncthreads();
  for (int kt = 0; kt < nkt; ++kt) {
    const int ktn = min(kt + 1, nkt - 1);
    A8_LOAD(ktn)
    const bf16_t* sK = sKV + (kt & 1) * KVBUF;
    const bf16_t* sV = sK + 128 * LDK;
    f32x4 sacc[8];
#pragma unroll
    for (int n = 0; n < 8; ++n) sacc[n] = (f32x4){0.f, 0.f, 0.f, 0.f};
#pragma unroll
    for (int ks = 0; ks < 3; ++ks)
#pragma unroll
      for (int n = 0; n < 8; ++n) {
        const bf16x8 a = *(const bf16x8*)(sK + (n * 16 + lr) * LDK + ks * 32 + lg * 8);
        sacc[n] = mfma16(a, qf[ks], sacc[n]);
      }
    float mx = sacc[0][0];
#pragma unroll
    for (int n = 0; n < 8; ++n)
#pragma unroll
      for (int q = 0; q < 4; ++q) mx = fmaxf(mx, sacc[n][q]);
    mx = quad_max(mx);
    const float mnew = fmaxf(mrun, mx);
    const float alpha = __builtin_amdgcn_exp2f(mrun - mnew);
    mrun = mnew;
    float ps0 = 0.f, ps1 = 0.f;
#pragma unroll
    for (int n = 0; n < 8; n += 2)
#pragma unroll
      for (int q = 0; q < 4; ++q) {
        const float e0 = __builtin_amdgcn_exp2f(sacc[n][q] - mnew); sacc[n][q] = e0; ps0 += e0;
        const float e1 = __builtin_amdgcn_exp2f(sacc[n + 1][q] - mnew); sacc[n + 1][q] = e1; ps1 += e1;
      }
    lrun = lrun * alpha + (ps0 + ps1);
#pragma unroll
    for (int i = 0; i < 4; ++i)
#pragma unroll
      for (int q = 0; q < 4; ++q) oacc[i][q] *= alpha;
#pragma unroll
    for (int ks = 0; ks < 4; ++ks) {
      union { bf16x8 v; unsigned u[4]; } pf;
      pf.u[0] = pack2(sacc[2 * ks][0], sacc[2 * ks][1]);
      pf.u[1] = pack2(sacc[2 * ks][2], sacc[2 * ks][3]);
      pf.u[2] = pack2(sacc[2 * ks + 1][0], sacc[2 * ks + 1][1]);
      pf.u[3] = pack2(sacc[2 * ks + 1][2], sacc[2 * ks + 1][3]);
#pragma unroll
      for (int m = 0; m < 4; ++m) {
        union { bf16x8 v; uint2 h[2]; } av;
        const bf16_t* vp = sV + (m * 16 + lr) * LDV + ks * 32 + lg * 4;
        av.h[0] = *(const uint2*)(vp);
        av.h[1] = *(const uint2*)(vp + 16);
        oacc[m] = mfma16(av.v, pf.v, oacc[m]);
      }
    }
    __builtin_amdgcn_sched_barrier(0);
    A8_WRITE((kt + 1) & 1)
    __syncthreads();
  }
  lrun = quad_sum(lrun);
  const float inv = 1.f / lrun;
#pragma unroll
  for (int m = 0; m < 4; ++m) {
    uint2 o;
    o.x = pack2(oacc[m][0] * inv, oacc[m][1] * inv);
    o.y = pack2(oacc[m][2] * inv, oacc[m][3] * inv);
    *(uint2*)(WSB(OFF_CAT) + (size_t)qrow * 1024 + hh * 64 + m * 16 + lg * 4) = o;
  }
}

NOINL void ssd_y_item(const P& p, int item) {
  char* smem = g_smem + VB * 73728;
  const int tid = opaque_tid(), lane = tid & 63, wave = tid >> 6, lr = lane & 15, lg = lane >> 4;
  const int cidx = item >> 3, qt = (item >> 1) & 3, half = qt >> 1, g = item & 1;
  const int r0 = cidx * 128;
  const int hh = g * 4 + wave;
  constexpr int LDC = 136, LDM = 72;
  bf16_t* sC = (bf16_t*)smem;
  bf16_t* sB = sC + 64 * LDC;
  bf16_t* sM = sB + 64 * LDC + wave * 64 * LDM;
  float* rowss = (float*)((bf16_t*)smem + 2 * 64 * LDC + 4 * 64 * LDM);
  const float* cum = WSF(OFF_CUM);
  const float* dtv = WSF(OFF_DTV);
  const int srow = tid >> 4, scol = (tid & 15) * 8;
  uint4 pb0, pb1, pb2, pb3;
  {
    const bf16_t* cs = WSB(OFF_CM) + (size_t)(r0 + qt * 32 + srow) * 256 + g * 128 + scol;
    const bf16_t* bs = WSB(OFF_BM) + (size_t)(r0 + srow) * 256 + g * 128 + scol;
    const uint4 c0 = *(const uint4*)(cs), c1 = *(const uint4*)(cs + 16 * 256);
    const uint4 b0 = *(const uint4*)(bs), b1 = *(const uint4*)(bs + 16 * 256), b2 = *(const uint4*)(bs + 32 * 256), b3 = *(const uint4*)(bs + 48 * 256);
    pb0 = *(const uint4*)(bs + 64 * 256); pb1 = *(const uint4*)(bs + 80 * 256); pb2 = *(const uint4*)(bs + 96 * 256); pb3 = *(const uint4*)(bs + 112 * 256);
    bf16_t* wc = sC + srow * LDC + scol;
    bf16_t* wb = sB + srow * LDC + scol;
    *(uint4*)(wc) = c0; *(uint4*)(wc + 16 * LDC) = c1;
    *(uint4*)(wb) = b0; *(uint4*)(wb + 16 * LDC) = b1; *(uint4*)(wb + 32 * LDC) = b2; *(uint4*)(wb + 48 * LDC) = b3;
  }
  __syncthreads();
  f32x4 Y[2][4];
#pragma unroll
  for (int i = 0; i < 2; ++i)
#pragma unroll
    for (int j = 0; j < 4; ++j) Y[i][j] = (f32x4){0.f, 0.f, 0.f, 0.f};
#pragma unroll 1
  for (int jh = 0; jh < 2; ++jh) {
    if (jh == 1) {
      __syncthreads();
      bf16_t* wb = sB + srow * LDC + scol;
      *(uint4*)(wb) = pb0; *(uint4*)(wb + 16 * LDC) = pb1; *(uint4*)(wb + 32 * LDC) = pb2; *(uint4*)(wb + 48 * LDC) = pb3;
      __syncthreads();
    }
#pragma unroll 1
    for (int dir = 0; dir < 2; ++dir) {
      const bool use = dir == 0 ? (jh <= half) : (jh >= half);
      if (!use) continue;
      bf16x8 xf[2][4];
#pragma unroll
      for (int ks = 0; ks < 2; ++ks)
#pragma unroll
        for (int pt = 0; pt < 4; ++pt)
          xf[ks][pt] = *(const bf16x8*)(WSB(OFF_XST) + (size_t)(hh * 64 + pt * 16 + lr) * 8192 + r0 + jh * 64 + ks * 32 + lg * 8);
      float ci[2], cj[4][4], dj[4][4];
#pragma unroll
      for (int it = 0; it < 2; ++it) ci[it] = cum[((size_t)dir * 8192 + r0 + qt * 32 + it * 16 + lr) * 8 + hh];
#pragma unroll
      for (int jt = 0; jt < 4; ++jt)
#pragma unroll
        for (int q = 0; q < 4; ++q) {
          const size_t tj = (size_t)dir * 8192 + r0 + jh * 64 + jt * 16 + lg * 4 + q;
          cj[jt][q] = cum[tj * 8 + hh];
          dj[jt][q] = dtv[tj * 8 + hh];
        }
#pragma unroll
      for (int it = 0; it < 2; ++it) {
        f32x4 cb[4];
#pragma unroll
        for (int jt = 0; jt < 4; ++jt) cb[jt] = (f32x4){0.f, 0.f, 0.f, 0.f};
#pragma unroll
        for (int ks = 0; ks < 4; ++ks) {
          const bf16x8 b = *(const bf16x8*)(sC + (it * 16 + lr) * LDC + ks * 32 + lg * 8);
#pragma unroll
          for (int jt = 0; jt < 4; ++jt) {
            const bf16x8 a = *(const bf16x8*)(sB + (jt * 16 + lr) * LDC + ks * 32 + lg * 8);
            cb[jt] = mfma16(a, b, cb[jt]);
          }
        }
        const int ti = qt * 32 + it * 16 + lr;
#pragma unroll
        for (int jt = 0; jt < 4; ++jt) {
          float v[4];
#pragma unroll
          for (int q = 0; q < 4; ++q) {
            const int tj = jh * 64 + jt * 16 + lg * 4 + q;
            const bool ok = dir == 0 ? (tj <= ti) : (tj >= ti);
            v[q] = ok ? cb[jt][q] * __expf(ci[it] - cj[jt][q]) * dj[jt][q] : 0.f;
          }
          uint2 o;
          o.x = pack2(v[0], v[1]);
          o.y = pack2(v[2], v[3]);
          *(uint2*)(sM + (it * 16 + lr) * LDM + jt * 16 + lg * 4) = o;
        }
        __builtin_amdgcn_sched_barrier(0);
      }
      asm volatile("s_waitcnt lgkmcnt(0)" ::: "memory");
#pragma unroll
      for (int ks = 0; ks < 2; ++ks) {
        bf16x8 af[2];
#pragma unroll
        for (int it = 0; it < 2; ++it) af[it] = *(const bf16x8*)(sM + (it * 16 + lr) * LDM + ks * 32 + lg * 8);
#pragma unroll
        for (int it = 0; it < 2; ++it)
#pragma unroll
          for (int pt = 0; pt < 4; ++pt) Y[it][pt] = mfma16(af[it], xf[ks][pt], Y[it][pt]);
      }
      asm volatile("s_waitcnt lgkmcnt(0)" ::: "memory");
      __builtin_amdgcn_sched_barrier(0);
    }
  }
#pragma unroll 1
  for (int dir = 0; dir < 2; ++dir) {
    const bf16_t* hp = WSB(OFF_H) + ((size_t)(dir * 64 + cidx) * 8 + hh) * 8192;
    float ei[2][4];
#pragma unroll
    for (int it = 0; it < 2; ++it)
#pragma unroll
      for (int q = 0; q < 4; ++q)
        ei[it][q] = __expf(cum[((size_t)dir * 8192 + r0 + qt * 32 + it * 16 + lg * 4 + q) * 8 + hh]);
#pragma unroll
    for (int pt = 0; pt < 4; ++pt) {
      bf16x8 bfr[4];
#pragma unroll
      for (int ks = 0; ks < 4; ++ks) bfr[ks] = *(const bf16x8*)(hp + (size_t)(pt * 16 + lr) * 128 + ks * 32 + lg * 8);
      f32x4 T[2];
#pragma unroll
      for (int it = 0; it < 2; ++it) T[it] = (f32x4){0.f, 0.f, 0.f, 0.f};
#pragma unroll
      for (int ks = 0; ks < 4; ++ks)
#pragma unroll
        for (int it = 0; it < 2; ++it) {
          const bf16x8 a = *(const bf16x8*)(sC + (it * 16 + lr) * LDC + ks * 32 + lg * 8);
          T[it] = mfma16(a, bfr[ks], T[it]);
        }
#pragma unroll
      for (int it = 0; it < 2; ++it)
#pragma unroll
        for (int q = 0; q < 4; ++q) Y[it][pt][q] += ei[it][q] * T[it][q];
    }
    __builtin_amdgcn_sched_barrier(0);
  }
  const float dsk = p.ssd_d[hh];
  const bf16_t* proj = WSB(OFF_R1);
#pragma unroll
  for (int i = 0; i < 2; ++i) {
#pragma unroll
    for (int q = 0; q < 4; ++q) {
      const int il = i * 16 + lg * 4 + q;
      const size_t r = (size_t)r0 + qt * 32 + il;
      float ss = 0.f;
#pragma unroll
      for (int j = 0; j < 4; ++j) {
        const int ch = hh * 64 + j * 16 + lr;
        const float xs = bf2f(WSB(OFF_XS)[r * 512 + ch]);
        const float z = bf2f(proj[r * 2080 + 544 + ch]);
        const float y = (Y[i][j][q] + dsk * xs) * silu(z);
        Y[i][j][q] = y;
        ss += y * y;
      }
      ss += __shfl_xor(ss, 1, 64);
      ss += __shfl_xor(ss, 2, 64);
      ss += __shfl_xor(ss, 4, 64);
      ss += __shfl_xor(ss, 8, 64);
      if (lr == 0) rowss[wave * 64 + il] = ss;
    }
    __builtin_amdgcn_sched_barrier(0);
  }
  __syncthreads();
#pragma unroll
  for (int i = 0; i < 2; ++i) {
#pragma unroll
    for (int q = 0; q < 4; ++q) {
      const int il = i * 16 + lg * 4 + q;
      const size_t r = (size_t)r0 + qt * 32 + il;
      const float tot = rowss[il] + rowss[64 + il] + rowss[128 + il] + rowss[192 + il];
      const float rs = rsqrtf(tot * (1.f / 256.f) + 1e-6f);
#pragma unroll
      for (int j = 0; j < 4; ++j) {
        const int ch = hh * 64 + j * 16 + lr;
        WSB(OFF_CAT)[r * 1024 + 512 + ch] = f2bf(Y[i][j][q] * rs * p.ssd_norm[ch]);
      }
    }
    __builtin_amdgcn_sched_barrier(0);
  }
  __syncthreads();
}

template <int W2>
DEVI void pool_item(const bf16_t* __restrict__ h, bf16_t* __restrict__ dst, int r, int cc) {
  int s0, L;
  if (r < 4096) { s0 = r & ~255; L = 256; } else { s0 = 4096 + ((r - 4096) & ~2047); L = 2048; }
  const int t = r - s0;
  const int lo = max(t - W2, 0), hi = min(t + W2, L);
  uint4 v[2 * W2];
#pragma unroll
  for (int k = 0; k < 2 * W2; ++k) {
    const int u = min(max(t - W2 + k, 0), L - 1);
    v[k] = *(const uint4*)(h + (size_t)(s0 + u) * 1024 + cc);
  }
  float acc[8] = {0, 0, 0, 0, 0, 0, 0, 0};
#pragma unroll
  for (int k = 0; k < 2 * W2; ++k) {
    const int u = t - W2 + k;
    const float m = (u >= 0 && u < L) ? 1.f : 0.f;
    acc[0] += m * __uint_as_float(v[k].x << 16); acc[1] += m * __uint_as_float(v[k].x & 0xffff0000u);
    acc[2] += m * __uint_as_float(v[k].y << 16); acc[3] += m * __uint_as_float(v[k].y & 0xffff0000u);
    acc[4] += m * __uint_as_float(v[k].z << 16); acc[5] += m * __uint_as_float(v[k].z & 0xffff0000u);
    acc[6] += m * __uint_as_float(v[k].w << 16); acc[7] += m * __uint_as_float(v[k].w & 0xffff0000u);
  }
  const float inv = 1.f / (float)(hi - lo);
  const uint4 c = v[W2];
  uint4 o;
  o.x = pack2(acc[0] * inv - __uint_as_float(c.x << 16), acc[1] * inv - __uint_as_float(c.x & 0xffff0000u));
  o.y = pack2(acc[2] * inv - __uint_as_float(c.y << 16), acc[3] * inv - __uint_as_float(c.y & 0xffff0000u));
  o.z = pack2(acc[4] * inv - __uint_as_float(c.z << 16), acc[5] * inv - __uint_as_float(c.z & 0xffff0000u));
  o.w = pack2(acc[6] * inv - __uint_as_float(c.w << 16), acc[7] * inv - __uint_as_float(c.w & 0xffff0000u));
  *(uint4*)(dst + (size_t)r * 1024 + cc) = o;
}

NOINL void pool_phase(const P& p) {
  const bf16_t* h = WSB(OFF_H);
  bf16_t* dst = WSB(OFF_CAT);
  const int total = 8192 * 128;
  for (int idx = blockIdx.x * 512 + threadIdx.x; idx < total; idx += gridDim.x * 512) {
    const int c32 = idx & 31, rlo = (idx >> 5) & 1, gi = (idx >> 6) & 3, rhi = idx >> 8;
    const int r = rhi * 2 + rlo, cc = gi * 256 + c32 * 8;
    if (gi == 0) pool_item<1>(h, dst, r, cc);
    else if (gi == 1) pool_item<2>(h, dst, r, cc);
    else if (gi == 2) pool_item<4>(h, dst, r, cc);
    else pool_item<8>(h, dst, r, cc);
  }
}

NOINL void ph_gemm_proj(const P& p) {
  bf16_t* proj = WSB(OFF_R1);
  float* dtraw = WSF(OFF_DTRAW);
  const bf16_t* A = WSB(OFF_H);
  const bf16_t* B = WSB(OFF_WIN);
  auto epi_main = [&](int ctx, int row, int col, f32x4 v0, f32x4 v1) {
#pragma unroll
    for (int q = 0; q < 4; ++q) {
      proj[(size_t)(row + q) * 2080 + col] = f2bf(v0[q]);
      proj[(size_t)(row + q) * 2080 + col + 16] = f2bf(v1[q]);
    }
  };
  auto epi = [&](int ctx, int row, int col, f32x4 v0, f32x4 v1) {
#pragma unroll
    for (int q = 0; q < 4; ++q) {
      if (col < 2080) proj[(size_t)(row + q) * 2080 + col] = f2bf(v0[q]);
      else if (col < 2096) dtraw[(size_t)(row + q) * 16 + (col - 2080)] = v0[q];
      if (col + 16 < 2080) proj[(size_t)(row + q) * 2080 + col + 16] = f2bf(v1[q]);
      else if (col + 16 < 2096) dtraw[(size_t)(row + q) * 16 + (col + 16 - 2080)] = v1[q];
    }
  };
  gemm8_stream(256, 1024, 1024, 1024,
    [=](int t) {
      TileInfo r;
      int m, n; tile_mn(t, 32, 8, m, n);
      r.m0 = m * 256; r.n0 = n * 256; r.ctx = 0;
      r.a = A + (size_t)r.m0 * 1024; r.b = B + (size_t)r.n0 * 1024;
      return r;
    }, epi_main);
  gemm_stream(64, 1024, 1024, 1024, g_smem + VB * 73728,
    [=](int t) {
      TileInfo r;
      r.m0 = t * 128; r.n0 = 2048; r.ctx = 0;
      r.a = A + (size_t)r.m0 * 1024; r.b = B + (size_t)2048 * 1024;
      return r;
    }, epi);
}

NOINL void ph_gemm_f32out(const P& p, const bf16_t* A, int lda, const bf16_t* B, int ldb, int K, bf16_t* C, int N) {
  const int nN = N / 128;
  gemm_stream(64 * nN, lda, ldb, K, g_smem + VB * 73728,
    [=](int t) {
      TileInfo r;
      int m, n; tile_mn(t, 64, nN, m, n);
      r.m0 = m * 128; r.n0 = n * 128; r.ctx = 0;
      r.a = A + (size_t)r.m0 * lda; r.b = B + (size_t)r.n0 * ldb;
      return r;
    },
    [&](int ctx, int row, int col, f32x4 v0, f32x4 v1) {
#pragma unroll
      for (int q = 0; q < 4; ++q) {
        C[(size_t)(row + q) * N + col] = f2bf(v0[q]);
        C[(size_t)(row + q) * N + col + 16] = f2bf(v1[q]);
      }
    });
}

NOINL void ph_gemm8_splitk(const P& p, const bf16_t* A, int lda, const bf16_t* B, int ldb, int Khalf, bf16_t* C0, bf16_t* C1) {
  gemm8_stream(256, lda, ldb, Khalf,
    [=](int t) {
      TileInfo r;
      const int id = swz_tile(t, 256);
      const int ks = id >> 7, rem = id & 127;
      r.m0 = (rem >> 2) * 256; r.n0 = (rem & 3) * 256; r.ctx = ks;
      r.a = A + (size_t)r.m0 * lda + (size_t)ks * Khalf; r.b = B + (size_t)r.n0 * ldb + (size_t)ks * Khalf;
      return r;
    },
    [&](int ks, int row, int col, f32x4 v0, f32x4 v1) {
      bf16_t* C = ks ? C1 : C0;
#pragma unroll
      for (int q = 0; q < 4; ++q) {
        C[(size_t)(row + q) * 1024 + col] = f2bf(v0[q]);
        C[(size_t)(row + q) * 1024 + col + 16] = f2bf(v1[q]);
      }
    });
}

NOINL void ph_gemm_qkv(const P& p) {
  bf16_t* qo = WSB(OFF_Q);
  bf16_t* kn = WSB(OFF_KN);
  bf16_t* vt = WSB(OFF_VT);
  const bf16_t* Aq = WSB(OFF_CQN);
  const bf16_t* Bq = WSB(OFF_WUQ);
  const bf16_t* Ak = WSB(OFF_CKV);
  const bf16_t* Bk = WSB(OFF_WUKV);
  gemm_stream(384 + 544, 256, 256, 256, g_smem + VB * 73728,
    [=](int t) {
      TileInfo r;
      int m, n;
      if (t < 384) {
        tile_mn(t, 64, 6, m, n);
        r.m0 = m * 128; r.n0 = n * 128; r.ctx = 0;
        r.a = Aq + (size_t)r.m0 * 256; r.b = Bq + (size_t)r.n0 * 256;
      } else {
        tile_mn(t - 384, 68, 8, m, n);
        r.m0 = m * 128; r.n0 = n * 128; r.ctx = 1;
        r.a = Ak + (size_t)r.m0 * 256; r.b = Bk + (size_t)r.n0 * 256;
      }
      return r;
    },
    [&](int ctx, int row, int col, f32x4 v0, f32x4 v1) {
      if (ctx == 0) {
        const float scl = 0.10206207261596575f * 1.4426950408889634f;
        const int tn = col >> 4;
        const bool rope = ((tn % 6) == 4) && (row >= 4096);
        const int ii = col & 15;
        const float fr = rope_freq(ii & 7);
#pragma unroll
        for (int q = 0; q < 4; ++q) {
          float a = v0[q], b = v1[q];
          if (rope) {
            const int tt = (row + q - 4096) & 2047;
            const float pos = (ii < 8) ? (float)(tt >> 6) : (float)(tt & 63);
            const float ang = pos * fr;
            float cs, sn;
            fast_sincos(ang, sn, cs);
            const float x1 = a, x2 = b;
            a = x1 * cs - x2 * sn;
            b = x1 * sn + x2 * cs;
          }
          qo[(size_t)(row + q) * 768 + col] = f2bf(a * scl);
          qo[(size_t)(row + q) * 768 + col + 16] = f2bf(b * scl);
        }
      } else {
        const int hh = col >> 7, j = col & 127;
        if (j < 64) {
#pragma unroll
          for (int q = 0; q < 4; ++q) {
            kn[(size_t)(row + q) * 512 + hh * 64 + j] = f2bf(v0[q]);
            kn[(size_t)(row + q) * 512 + hh * 64 + j + 16] = f2bf(v1[q]);
          }
        } else {
          uint2 o0, o1;
          o0.x = pack2(v0[0], v0[1]); o0.y = pack2(v0[2], v0[3]);
          o1.x = pack2(v1[0], v1[1]); o1.y = pack2(v1[2], v1[3]);
          *(uint2*)(vt + (size_t)(hh * 64 + j - 64) * 8704 + row) = o0;
          *(uint2*)(vt + (size_t)(hh * 64 + j - 64 + 16) * 8704 + row) = o1;
        }
      }
    });
}

NOINL void ph_gemm_ffn_up(const P& p, int layer) {
  bf16_t* gu = WSB(OFF_R1);
  const bf16_t* A = WSB(OFF_H);
  const bf16_t* B = WSB(OFF_WGU) + (size_t)layer * 5632 * 1024;
  gemm8_stream(32 * 22, 1024, 1024, 1024,
    [=](int t) {
      TileInfo r;
      int m, n; tile_mn(t, 32, 22, m, n);
      r.m0 = m * 256; r.n0 = n * 256; r.ctx = 0;
      r.a = A + (size_t)r.m0 * 1024; r.b = B + (size_t)r.n0 * 1024;
      return r;
    },
    [&](int ctx, int row, int col, f32x4 v0, f32x4 v1) {
      const int oc = (col >> 5) * 16 + (col & 15);
#pragma unroll
      for (int q = 0; q < 4; ++q) gu[(size_t)(row + q) * 2816 + oc] = f2bf(silu(v0[q]) * v1[q]);
    });
}

NOINL void ph_gemm_pool(const P& p) {
  bf16_t* mix = WSB(OFF_R1);
  const bf16_t* A = WSB(OFF_H);
  const bf16_t* B = WSB(OFF_WPOOL);
  gemm_stream(512, 1024, 256, 256, g_smem + VB * 73728,
    [=](int t) {
      TileInfo r;
      const int id = swz_tile(t, 512);
      const int g = id >> 7, rem = id & 127;
      r.m0 = (rem >> 1) * 128; r.n0 = (rem & 1) * 128; r.ctx = g;
      r.a = A + (size_t)r.m0 * 1024 + g * 256; r.b = B + (size_t)g * 65536 + (size_t)r.n0 * 256;
      return r;
    },
    [&](int g, int row, int col, f32x4 v0, f32x4 v1) {
      const int c0 = g * 256 + col;
      const float s0 = p.pool_scale[c0], s1 = p.pool_scale[c0 + 16];
#pragma unroll
      for (int q = 0; q < 4; ++q) {
        mix[(size_t)(row + q) * 1024 + c0] = f2bf(v0[q] * s0);
        mix[(size_t)(row + q) * 1024 + c0 + 16] = f2bf(v1[q] * s1);
      }
    });
}


#define XB_TMO      128
#define XB_XCNT(j)  (256  + 64 * (j))
#define XB_XSUB(j)  (1280 + 64 * (j))
#define XB_XGEN(j)  (2304 + 64 * (j))
#define XB_TOP      3328
#define XB_TOPGEN   3392
#define XCD_BAR_WORDS 3456
#define XB_SPIN_CAP (1u << 22)
#define LAS __attribute__((address_space(3)))
DEVI unsigned xb_ld(unsigned* p) { return __hip_atomic_load(p, __ATOMIC_RELAXED, __HIP_MEMORY_SCOPE_AGENT); }
DEVI unsigned xb_add(unsigned* p, unsigned v) { return __hip_atomic_fetch_add(p, v, __ATOMIC_RELAXED, __HIP_MEMORY_SCOPE_AGENT); }
DEVI unsigned xb_xcc_id() { return (unsigned)__builtin_amdgcn_s_getreg((3 << 11) | 20) & 0xFu; }
#define XB_SPIN(cond, bar) do { unsigned _sp = 0; while (cond) { __builtin_amdgcn_s_sleep(1); \
    if ((++_sp & 255u) == 0u) { if (xb_ld(&(bar)[XB_TMO])) break; if (_sp > XB_SPIN_CAP) { atomicAdd(&(bar)[XB_TMO], 1u); break; } } } } while (0)
struct XcdBarrier { unsigned* bar; unsigned x; volatile LAS unsigned* st; };
DEVI XcdBarrier xcd_barrier_post(unsigned* bar, volatile LAS unsigned* st) {
  XcdBarrier b; b.bar = bar; b.x = xb_xcc_id(); b.st = st;
  if (threadIdx.x == 0) (void)xb_add(&bar[XB_XCNT(b.x)], 1u);
  return b;
}
DEVI void xcd_barrier_complete(unsigned* bar, unsigned x, unsigned& nloc, unsigned& nx) {
  const unsigned G = gridDim.x * gridDim.y * gridDim.z;
  unsigned sum, cnt, mine, sp = 0u;
  for (;;) {
    sum = 0u; cnt = 0u; mine = 0u;
#pragma unroll
    for (unsigned j = 0; j < 16; ++j) { const unsigned c = xb_ld(&bar[XB_XCNT(j)]); sum += c; cnt += (c > 0u) ? 1u : 0u; mine = (j == x) ? c : mine; }
    if (sum == G) break;
    __builtin_amdgcn_s_sleep(1);
    if ((++sp & 255u) == 0u) { if (xb_ld(&bar[XB_TMO])) break; if (sp > XB_SPIN_CAP) { atomicAdd(&bar[XB_TMO], 1u); break; } }
  }
  nloc = mine > 0u ? mine : 1u; nx = cnt > 0u ? cnt : 1u;
}
DEVI void xcd_barrier(const XcdBarrier& b) {
  asm volatile("s_waitcnt vmcnt(0)" ::: "memory");
  __syncthreads();
  if (threadIdx.x == 0) {
    unsigned* bar = b.bar;
    __builtin_amdgcn_s_waitcnt(0);
    unsigned nloc = b.st[0], nx = b.st[1];
    if (nloc == 0u) { xcd_barrier_complete(bar, b.x, nloc, nx); b.st[0] = nloc; b.st[1] = nx; }
    const unsigned old = xb_add(&bar[XB_XSUB(b.x)], 1u);
    const unsigned gen = old / nloc;
    if (old + 1u == (gen + 1u) * nloc) {
      __builtin_amdgcn_fence(__ATOMIC_RELEASE, "agent");
      asm volatile("s_waitcnt vmcnt(0)" ::: "memory");
      const unsigned og = xb_add(&bar[XB_TOP], 1u);
      const unsigned tg = og / nx;
      if (og + 1u == (tg + 1u) * nx) xb_add(&bar[XB_TOPGEN], 1u);
      else XB_SPIN(xb_ld(&bar[XB_TOPGEN]) == tg, bar);
      __builtin_amdgcn_fence(__ATOMIC_ACQUIRE, "agent");
      xb_add(&bar[XB_XGEN(b.x)], 1u);
      asm volatile("s_waitcnt vmcnt(0)" ::: "memory");
    } else {
      XB_SPIN(xb_ld(&bar[XB_XGEN(b.x)]) == gen, bar);
      __builtin_amdgcn_fence(__ATOMIC_ACQUIRE, "agent");
      asm volatile("s_waitcnt vmcnt(0)" ::: "memory");
    }
  }
  __syncthreads();
}

constexpr int NPHASE = 18;
#ifndef REPMASK
#define REPMASK 0
#endif
#ifndef ATPROBE
#define ATPROBE 0
#endif
#ifndef P6PROBE
#define P6PROBE 1
#endif
#ifndef PHMASK
#define PHMASK 0x3ffff
#endif
#define PH(n) if constexpr ((PHMASK >> (n)) & 1)

__global__ void __launch_bounds__(512, 2) mega(P p, int lo, int hi) {
  __shared__ uint4 xb_words;
  if (threadIdx.x == 0) xb_words = make_uint4(0u, 0u, 0u, 0u);
  __syncthreads();
  XcdBarrier xb = xcd_barrier_post((unsigned*)(p.ws + OFF_BAR), (volatile LAS unsigned*)&xb_words);
  if (lo < 0) cg::this_grid().sync();
  PH(0) if (lo <= 0 && 0 < hi) {
#if (REPMASK >> 0) & 1
    int nrep = 2; asm volatile("" : "+s"(nrep));
    for (int rep = 0; rep < nrep; ++rep) {
      if (rep) xcd_barrier(xb);
#else
    {
#endif
        for (int t0_ = blockIdx.x * 2; t0_ < 384 + 5200; t0_ += gridDim.x * 2) {
          const int t = min(t0_ + VB, 384 + 5200 - 1);
          if (t < 384) gemv_tile(p, t); else transpose_tile(p, t - 384);
        }
    }
  }
  if (lo <= 0 && 0 + 1 < hi) xcd_barrier(xb);
  PH(1) if (lo <= 1 && 1 < hi) {
#if (REPMASK >> 1) & 1
    int nrep = 2; asm volatile("" : "+s"(nrep));
    for (int rep = 0; rep < nrep; ++rep) {
      if (rep) xcd_barrier(xb);
#else
    {
#endif
        rowop<false, true, true, false, false>(p, nullptr, nullptr, nullptr, 0, p.n_pre_mix, 0, 1, 0, 0);
    }
  }
  if (lo <= 1 && 1 + 1 < hi) xcd_barrier(xb);
  PH(2) if (lo <= 2 && 2 < hi) {
#if (REPMASK >> 2) & 1
    int nrep = 2; asm volatile("" : "+s"(nrep));
    for (int rep = 0; rep < nrep; ++rep) {
      if (rep) xcd_barrier(xb);
#else
    {
#endif
        ph_gemm_proj(p);
    }
  }
  if (lo <= 2 && 2 + 1 < hi) xcd_barrier(xb);
  PH(3) if (lo <= 3 && 3 < hi) {
#if (REPMASK >> 3) & 1
    int nrep = 2; asm volatile("" : "+s"(nrep));
    for (int rep = 0; rep < nrep; ++rep) {
      if (rep) xcd_barrier(xb);
#else
    {
#endif
        prep_rows(p);
        prep_cache(p);
        for (int t0_ = VT_FIRST; t0_ < 2048; t0_ += gridDim.x * 2) conv_tile(p, min(t0_ + VT_OFF, 2047));
    }
  }
  if (lo <= 3 && 3 + 1 < hi) xcd_barrier(xb);
  PH(4) if (lo <= 4 && 4 < hi) {
#if (REPMASK >> 4) & 1
    int nrep = 2; asm volatile("" : "+s"(nrep));
    for (int rep = 0; rep < nrep; ++rep) {
      if (rep) xcd_barrier(xb);
#else
    {
#endif
        ph_gemm_qkv(p);
        for (int t0_ = VT_FIRST; t0_ < 512; t0_ += gridDim.x * 2) chunk_state_item(p, min(t0_ + VT_OFF, 511));
    }
  }
  if (lo <= 4 && 4 + 1 < hi) xcd_barrier(xb);
  PH(5) if (lo <= 5 && 5 < hi) {
#if (REPMASK >> 5) & 1
    int nrep = 2; asm volatile("" : "+s"(nrep));
    for (int rep = 0; rep < nrep; ++rep) {
      if (rep) xcd_barrier(xb);
#else
    {
#endif
        scan_states(p);
    }
  }
  if (lo <= 5 && 5 + 1 < hi) xcd_barrier(xb);
  PH(6) if (lo <= 6 && 6 < hi) {
#if (REPMASK >> 6) & 1
    int nrep = 2; asm volatile("" : "+s"(nrep));
    for (int rep = 0; rep < nrep; ++rep) {
      if (rep) xcd_barrier(xb);
#else
    {
#endif
        for (int t = blockIdx.x; t < 512; t += gridDim.x) attn8_item(p, t);
        for (int t0_ = VT_FIRST; t0_ < 512; t0_ += gridDim.x * 2) ssd_y_item(p, min(t0_ + VT_OFF, 511));
    }
  }
  if (lo <= 6 && 6 + 1 < hi) xcd_barrier(xb);
  PH(7) if (lo <= 7 && 7 < hi) {
#if (REPMASK >> 7) & 1
    int nrep = 2; asm volatile("" : "+s"(nrep));
    for (int rep = 0; rep < nrep; ++rep) {
      if (rep) xcd_barrier(xb);
#else
    {
#endif
        ph_gemm8_splitk(p, WSB(OFF_CAT), 1024, WSB(OFF_WOUT), 1024, 512, WSB(OFF_R1), WSB(OFF_R1) + (size_t)8192 * 1024);
    }
  }
  if (lo <= 7 && 7 + 1 < hi) xcd_barrier(xb);
  PH(8) if (lo <= 8 && 8 < hi) {
#if (REPMASK >> 8) & 1
    int nrep = 2; asm volatile("" : "+s"(nrep));
    for (int rep = 0; rep < nrep; ++rep) {
      if (rep) xcd_barrier(xb);
#else
    {
#endif
        rowop<true, true, true, false, true>(p, WSB(OFF_R1), WSB(OFF_R1) + (size_t)8192 * 1024, p.n_post_mix, 2, p.n_pre_ffn, 3, 4, 0, 0);
    }
  }
  if (lo <= 8 && 8 + 1 < hi) xcd_barrier(xb);
  PH(9) if (lo <= 9 && 9 < hi) {
#if (REPMASK >> 9) & 1
    int nrep = 2; asm volatile("" : "+s"(nrep));
    for (int rep = 0; rep < nrep; ++rep) {
      if (rep) xcd_barrier(xb);
#else
    {
#endif
        ph_gemm_ffn_up(p, 0);
    }
  }
  if (lo <= 9 && 9 + 1 < hi) xcd_barrier(xb);
  PH(10) if (lo <= 10 && 10 < hi) {
#if (REPMASK >> 10) & 1
    int nrep = 2; asm volatile("" : "+s"(nrep));
    for (int rep = 0; rep < nrep; ++rep) {
      if (rep) xcd_barrier(xb);
#else
    {
#endif
        ph_gemm8_splitk(p, WSB(OFF_R1), 2816, WSB(OFF_WDN), 2816, 1408, WSB(OFF_R2), WSB(OFF_R2) + (size_t)8192 * 1024);
    }
  }
  if (lo <= 10 && 10 + 1 < hi) xcd_barrier(xb);
  PH(11) if (lo <= 11 && 11 < hi) {
#if (REPMASK >> 11) & 1
    int nrep = 2; asm volatile("" : "+s"(nrep));
    for (int rep = 0; rep < nrep; ++rep) {
      if (rep) xcd_barrier(xb);
#else
    {
#endif
        rowop<true, true, false, false, true>(p, WSB(OFF_R2), WSB(OFF_R2) + (size_t)8192 * 1024, p.n_post_ffn, 5, p.n_pre_mix + 1024, 0, 1, 0, 1);
    }
  }
  if (lo <= 11 && 11 + 1 < hi) xcd_barrier(xb);
  PH(12) if (lo <= 12 && 12 < hi) {
#if (REPMASK >> 12) & 1
    int nrep = 2; asm volatile("" : "+s"(nrep));
    for (int rep = 0; rep < nrep; ++rep) {
      if (rep) xcd_barrier(xb);
#else
    {
#endif
    }
  }
  PH(13) if (lo <= 13 && 13 < hi) {
#if (REPMASK >> 13) & 1
    int nrep = 2; asm volatile("" : "+s"(nrep));
    for (int rep = 0; rep < nrep; ++rep) {
      if (rep) xcd_barrier(xb);
#else
    {
#endif
        ph_gemm_pool(p);
    }
  }
  if (lo <= 13 && 13 + 1 < hi) xcd_barrier(xb);
  PH(14) if (lo <= 14 && 14 < hi) {
#if (REPMASK >> 14) & 1
    int nrep = 2; asm volatile("" : "+s"(nrep));
    for (int rep = 0; rep < nrep; ++rep) {
      if (rep) xcd_barrier(xb);
#else
    {
#endif
        rowop<true, true, false, false, false, true>(p, WSB(OFF_R1), nullptr, p.n_post_mix + 1024, 2, p.n_pre_ffn + 1024, 3, 4, 1, 1);
    }
  }
  if (lo <= 14 && 14 + 1 < hi) xcd_barrier(xb);
  PH(15) if (lo <= 15 && 15 < hi) {
#if (REPMASK >> 15) & 1
    int nrep = 2; asm volatile("" : "+s"(nrep));
    for (int rep = 0; rep < nrep; ++rep) {
      if (rep) xcd_barrier(xb);
#else
    {
#endif
        ph_gemm_ffn_up(p, 1);
    }
  }
  if (lo <= 15 && 15 + 1 < hi) xcd_barrier(xb);
  PH(16) if (lo <= 16 && 16 < hi) {
#if (REPMASK >> 16) & 1
    int nrep = 2; asm volatile("" : "+s"(nrep));
    for (int rep = 0; rep < nrep; ++rep) {
      if (rep) xcd_barrier(xb);
#else
    {
#endif
        ph_gemm8_splitk(p, WSB(OFF_R1), 2816, WSB(OFF_WDN) + (size_t)1024 * 2816, 2816, 1408, WSB(OFF_R2), WSB(OFF_R2) + (size_t)8192 * 1024);
    }
  }
  if (lo <= 16 && 16 + 1 < hi) xcd_barrier(xb);
  PH(17) if (lo <= 17 && 17 < hi) {
#if (REPMASK >> 17) & 1
    int nrep = 2; asm volatile("" : "+s"(nrep));
    for (int rep = 0; rep < nrep; ++rep) {
      if (rep) xcd_barrier(xb);
#else
    {
#endif
        rowop<true, false, false, true, true>(p, WSB(OFF_R2), WSB(OFF_R2) + (size_t)8192 * 1024, p.n_post_ffn + 1024, 5, nullptr, 0, 0, 1, 1);
    }
  }
}

extern "C" void kernel_launch(void* const* d_in, const int* in_sizes, int n_in, void* d_out, int out_size, void* d_ws,
                              size_t ws_size, hipStream_t stream) {
  P p{};
  const float** f = (const float**)&p;
  for (int i = 0; i < 33; ++i) f[i] = (const float*)d_in[i];
  p.out = (float*)d_out;
  p.ws = (char*)d_ws;
  static int grid_blocks = 0;
  if (!grid_blocks) {
    int dev = 0, cus = 0, per_cu = 0;
    hipGetDevice(&dev);
    hipDeviceGetAttribute(&cus, hipDeviceAttributeMultiprocessorCount, dev);
    hipOccupancyMaxActiveBlocksPerMultiprocessor(&per_cu, mega, 512, 0);
    if (per_cu > 1) per_cu = 1;
    if (per_cu < 1) per_cu = 1;
    grid_blocks = cus * per_cu;
  }
  hipMemsetAsync((char*)d_ws + OFF_BAR, 0, XCD_BAR_WORDS * 4, stream);
#if SINGLE_LAUNCH
  int lo = 0, hi = NPHASE;
  void* args[] = {&p, &lo, &hi};
  hipError_t e = hipLaunchCooperativeKernel((void*)mega, dim3(grid_blocks), dim3(512), args, 0, stream);
  if (e != hipSuccess) fprintf(stderr, "cooperative launch failed: %s (grid %d)\n", hipGetErrorString(e), grid_blocks);
#else
  for (int ph = 0; ph < NPHASE; ++ph) mega<<<grid_blocks, 512, 0, stream>>>(p, ph, ph + 1);
#endif
}
```
